# Optimizing an MI355X kernel written in HIP

```python
import jax, jax.numpy as jnp
from jax import lax
import numpy as np

D_MODEL = 2048
BATCH = 2
SEQ = 8192
DEPTH = 1

MEM_LEN = 256
EPS = 1e-6
RWKV_DIM = 1024
RWKV_HEAD = 64
RWKV_HEADS = RWKV_DIM // RWKV_HEAD
LORA_W = 64
LORA_A = 64
LORA_G = 160
RWKV_COLS = 3 * RWKV_DIM + LORA_W + LORA_A + LORA_G
GN_EPS = 64e-5
LRU_DIM = 1024
LRU_BLOCKS = 16
LRU_BW = LRU_DIM // LRU_BLOCKS
CONV_W = 4
RG_C = 8.0
XA_HEADS = 4
XA_HEAD_DIM = 256
XA_DIM = XA_HEADS * XA_HEAD_DIM
N_BRANCH = 3
IN_COLS = RWKV_COLS + 2 * LRU_DIM + XA_DIM + N_BRANCH * D_MODEL
N_EXPERTS = 32
TOP_K = 4
D_EXPERT = D_MODEL
SWIGLU_LIMIT = 7.0
SWIGLU_ALPHA = 1.702
EXPERT_BLOCK = 512

kernel_name = "hybrid_rwkv7_rglru_memxattn_moe_block"


def rms_norm(x, g):
    xf = x.astype(jnp.float32)
    return xf * lax.rsqrt(jnp.mean(xf * xf, axis=-1, keepdims=True) + EPS) * g.astype(jnp.float32)


def token_shift(p):
    return jnp.pad(p, ((0, 0), (1, 0), (0, 0)))[:, :-1]


def rwkv7_scan(r, w, k, v, a, b):
    bsz = r.shape[0]

    def step(state, inp):
        r_t, w_t, k_t, v_t, a_t, b_t = inp
        sa = jnp.einsum('bhvk,bhk->bhv', state, a_t)
        state = (state * w_t[:, :, None, :] + sa[..., None] * b_t[:, :, None, :]
                 + v_t[..., None] * k_t[:, :, None, :])
        return state, jnp.einsum('bhvk,bhk->bhv', state, r_t)

    xs = tuple(jnp.moveaxis(t, 1, 0) for t in (r, w, k, v, a, b))
    s0 = jnp.zeros((bsz, RWKV_HEADS, RWKV_HEAD, RWKV_HEAD), jnp.float32)
    _, y = lax.scan(step, s0, xs)
    return jnp.moveaxis(y, 0, 1)


def rwkv7_branch(p, mu, w0, w2, a0, a2, g2, k_k, k_a, r_k, ln_w, ln_b):
    bsz, seq, _ = p.shape
    p = p + (token_shift(p) - p) * mu
    c = RWKV_DIM
    r, k, v, w_lo, a_lo, g_lo = jnp.split(
        p, [c, 2 * c, 3 * c, 3 * c + LORA_W, 3 * c + LORA_W + LORA_A], axis=-1)
    w = -jax.nn.softplus(-(w0 + jnp.tanh(w_lo) @ w2)) - 0.5
    decay = jnp.exp(-jnp.exp(w))
    a = jax.nn.sigmoid(a0 + a_lo @ a2)
    g = jax.nn.sigmoid(g_lo) @ g2
    hs = (bsz, seq, RWKV_HEADS, RWKV_HEAD)
    kk = (k * k_k).reshape(hs)
    kk = kk * lax.rsqrt(jnp.maximum(jnp.sum(kk * kk, axis=-1, keepdims=True), 1e-24))
    a_h = a.reshape(hs)
    k = (k * (1.0 + (a - 1.0) * k_a)).reshape(hs)
    r = r.reshape(hs)
    v = v.reshape(hs)
    y = rwkv7_scan(r, decay.reshape(hs), k, v, -kk, kk * a_h)
    mean = jnp.mean(y, axis=-1, keepdims=True)
    var = jnp.mean(jnp.square(y - mean), axis=-1, keepdims=True)
    y = ((y - mean) * lax.rsqrt(var + GN_EPS)).reshape(bsz, seq, RWKV_DIM) * ln_w + ln_b
    bonus = jnp.sum(r * k * r_k, axis=-1, keepdims=True) * v
    return (y + bonus.reshape(bsz, seq, RWKV_DIM)) * g


def causal_conv(x, w, b):
    seq = x.shape[1]
    xp = jnp.pad(x, ((0, 0), (CONV_W - 1, 0), (0, 0)))
    y = b + xp[:, CONV_W - 1:CONV_W - 1 + seq] * w[0]
    for j in range(1, CONV_W):
        y = y + xp[:, CONV_W - 1 - j:CONV_W - 1 - j + seq] * w[j]
    return y


def rglru_branch(px, py, conv_w, conv_b, w_r, b_r, w_i, b_i, lam):
    bsz, seq, _ = px.shape
    xc = causal_conv(px, conv_w, conv_b)
    xb = xc.reshape(bsz, seq, LRU_BLOCKS, LRU_BW)
    gate_r = jax.nn.sigmoid(jnp.einsum('bsnw,nwv->bsnv', xb, w_r).reshape(bsz, seq, LRU_DIM) + b_r)
    gate_i = jax.nn.sigmoid(jnp.einsum('bsnw,nwv->bsnv', xb, w_i).reshape(bsz, seq, LRU_DIM) + b_i)
    log_a = -RG_C * gate_r * jax.nn.softplus(-lam)
    a = jnp.exp(log_a)
    mult = jnp.sqrt(jnp.maximum(1.0 - jnp.exp(2.0 * log_a), 0.0))
    mult = mult.at[:, 0].set(1.0)
    bx = mult * gate_i * xc

    def combine(lhs, rhs):
        a1, b1 = lhs
        a2, b2 = rhs
        return a1 * a2, a2 * b1 + b2

    _, h = lax.associative_scan(combine, (a, bx), axis=1)
    return h * jax.nn.gelu(py)


def memory_xattn(q_cols, mem, g_mem, w_mk, w_mv):
    bsz, seq, _ = q_cols.shape
    mn = rms_norm(mem, g_mem)
    q = q_cols.reshape(bsz, seq, XA_HEADS, XA_HEAD_DIM)
    k = (mn @ w_mk).reshape(bsz, -1, XA_HEADS, XA_HEAD_DIM)
    v = (mn @ w_mv).reshape(bsz, -1, XA_HEADS, XA_HEAD_DIM)
    s = jnp.einsum('bshd,bmhd->bhsm', q, k).astype(jnp.float32) * (XA_HEAD_DIM ** -0.5)
    pr = jax.nn.softmax(s, axis=-1)
    return jnp.einsum('bhsm,bmhd->bshd', pr, v).reshape(bsz, seq, XA_DIM)


def moe(xn, w_router, b_router, w_gate, b_gate, w_up, b_up, w_down, b_down):
    bsz, seq, d = xn.shape
    n_tok = bsz * seq
    n_assign = n_tok * TOP_K
    xt = xn.reshape(n_tok, d)
    logits = (xt @ w_router).astype(jnp.float32) + b_router
    top_val, top_idx = lax.top_k(logits, TOP_K)
    gates = jax.nn.softmax(top_val, axis=-1)
    e_flat = top_idx.reshape(-1)
    tok_flat = jnp.arange(n_assign, dtype=jnp.int32) // TOP_K
    g_flat = gates.reshape(-1)
    order = jnp.argsort(e_flat)
    e_sorted = e_flat[order]
    tok_sorted = tok_flat[order]
    g_sorted = g_flat[order]
    counts = jnp.bincount(e_flat, length=N_EXPERTS)
    padded = ((counts + EXPERT_BLOCK - 1) // EXPERT_BLOCK) * EXPERT_BLOCK
    start = jnp.cumsum(counts) - counts
    pend = jnp.cumsum(padded)
    pstart = pend - padded
    rank = jnp.arange(n_assign, dtype=jnp.int32) - start[e_sorted]
    dest = pstart[e_sorted] + rank
    n_rows = (-(-n_assign // EXPERT_BLOCK)) * EXPERT_BLOCK + N_EXPERTS * EXPERT_BLOCK
    n_blocks = n_rows // EXPERT_BLOCK
    rows = jnp.zeros((n_rows, d), xt.dtype).at[dest].set(xt[tok_sorted])
    block_start = jnp.arange(n_blocks, dtype=jnp.int32) * EXPERT_BLOCK
    block_e = jnp.minimum(jnp.searchsorted(pend, block_start, side='right'), N_EXPERTS - 1)

    def expert_block(args):
        xb, e = args
        hg = jnp.minimum(xb @ w_gate[e] + b_gate[e], SWIGLU_LIMIT)
        hu = jnp.clip(xb @ w_up[e] + b_up[e], -SWIGLU_LIMIT, SWIGLU_LIMIT)
        hh = (hu + 1.0) * hg * jax.nn.sigmoid(SWIGLU_ALPHA * hg)
        return hh @ w_down[e] + b_down[e]

    out_rows = lax.map(expert_block, (rows.reshape(n_blocks, EXPERT_BLOCK, d), block_e))
    out_rows = out_rows.reshape(n_rows, d)
    contrib = out_rows[dest].astype(jnp.float32) * g_sorted[:, None]
    y = jnp.zeros((n_tok, d), jnp.float32).at[tok_sorted].add(contrib)
    return y.reshape(bsz, seq, d)


def setup_inputs(seed: int = 0) -> dict:
    key = jax.random.key(seed)
    ks = iter(jax.random.split(key, 64))
    f32 = jnp.float32

    def nrm(shape, scale):
        return jax.random.normal(next(ks), shape, f32) * scale

    def gain(shape):
        return 1.0 + nrm(shape, 0.05)

    L = DEPTH
    x = nrm((BATCH, SEQ, D_MODEL), 1.0)
    mem = nrm((BATCH, MEM_LEN, D_MODEL), 1.0)
    lam_u = jax.random.uniform(next(ks), (L, LRU_DIM), f32, 0.9, 0.999)
    mu = jax.random.uniform(next(ks), (L, RWKV_COLS), f32)
    return {
        "x": x,
        "mem": mem,
        "g_mix": gain((L, D_MODEL)),
        "w_in": nrm((L, D_MODEL, IN_COLS), D_MODEL ** -0.5),
        "mu_rwkv": mu,
        "rwkv_w0": jnp.linspace(-6.0, -1.0, RWKV_DIM, dtype=f32)[None] + nrm((L, RWKV_DIM), 0.1),
        "rwkv_w2": nrm((L, LORA_W, RWKV_DIM), 0.1 * LORA_W ** -0.5),
        "rwkv_a0": nrm((L, RWKV_DIM), 0.1),
        "rwkv_a2": nrm((L, LORA_A, RWKV_DIM), LORA_A ** -0.5),
        "rwkv_g2": nrm((L, LORA_G, RWKV_DIM), LORA_G ** -0.5),
        "rwkv_k_k": 0.85 + nrm((L, RWKV_DIM), 0.05),
        "rwkv_k_a": 1.0 + nrm((L, RWKV_DIM), 0.05),
        "rwkv_r_k": nrm((L, RWKV_HEADS, RWKV_HEAD), 0.1),
        "rwkv_ln_w": gain((L, RWKV_DIM)),
        "rwkv_ln_b": nrm((L, RWKV_DIM), 0.02),
        "w_rwkv_out": nrm((L, RWKV_DIM, D_MODEL), RWKV_DIM ** -0.5),
        "lru_conv_w": nrm((L, CONV_W, LRU_DIM), CONV_W ** -0.5),
        "lru_conv_b": nrm((L, LRU_DIM), 0.02),
        "lru_w_r": nrm((L, LRU_BLOCKS, LRU_BW, LRU_BW), LRU_BW ** -0.5),
        "lru_b_r": nrm((L, LRU_DIM), 0.02),
        "lru_w_i": nrm((L, LRU_BLOCKS, LRU_BW, LRU_BW), LRU_BW ** -0.5),
        "lru_b_i": nrm((L, LRU_DIM), 0.02),
        "lru_lambda": jnp.log(lam_u) - jnp.log1p(-lam_u),
        "w_lru_out": nrm((L, LRU_DIM, D_MODEL), LRU_DIM ** -0.5),
        "g_mem": gain((L, D_MODEL)),
        "w_mem_k": nrm((L, D_MODEL, XA_DIM), D_MODEL ** -0.5),
        "w_mem_v": nrm((L, D_MODEL, XA_DIM), D_MODEL ** -0.5),
        "w_xa_out": nrm((L, XA_DIM, D_MODEL), XA_DIM ** -0.5),
        "w_o": nrm((L, D_MODEL, D_MODEL), D_MODEL ** -0.5),
        "g_ffn": gain((L, D_MODEL)),
        "w_router": nrm((L, D_MODEL, N_EXPERTS), D_MODEL ** -0.5),
        "b_router": nrm((L, N_EXPERTS), 0.01),
        "w_gate": nrm((L, N_EXPERTS, D_MODEL, D_EXPERT), D_MODEL ** -0.5),
        "b_gate": nrm((L, N_EXPERTS, D_EXPERT), 0.02),
        "w_up": nrm((L, N_EXPERTS, D_MODEL, D_EXPERT), D_MODEL ** -0.5),
        "b_up": nrm((L, N_EXPERTS, D_EXPERT), 0.02),
        "w_down": nrm((L, N_EXPERTS, D_EXPERT, D_MODEL), D_EXPERT ** -0.5),
        "b_down": nrm((L, N_EXPERTS, D_MODEL), 0.02),
        "g_final": gain((D_MODEL,)),
    }


def reference(x, mem, g_mix, w_in, mu_rwkv, rwkv_w0, rwkv_w2, rwkv_a0, rwkv_a2, rwkv_g2,
              rwkv_k_k, rwkv_k_a, rwkv_r_k, rwkv_ln_w, rwkv_ln_b, w_rwkv_out,
              lru_conv_w, lru_conv_b, lru_w_r, lru_b_r, lru_w_i, lru_b_i, lru_lambda, w_lru_out,
              g_mem, w_mem_k, w_mem_v, w_xa_out, w_o, g_ffn, w_router, b_router,
              w_gate, b_gate, w_up, b_up, w_down, b_down, g_final):
    bsz, seq, _ = x.shape
    h = x.astype(jnp.float32)
    c0 = RWKV_COLS
    c1 = c0 + LRU_DIM
    c2 = c1 + LRU_DIM
    c3 = c2 + XA_DIM
    for l in range(DEPTH):
        xn = rms_norm(h, g_mix[l])
        p = xn @ w_in[l]
        p_rwkv, p_lx, p_ly, p_q, p_gate = jnp.split(p, [c0, c1, c2, c3], axis=-1)
        y_a = rwkv7_branch(p_rwkv, mu_rwkv[l], rwkv_w0[l], rwkv_w2[l], rwkv_a0[l], rwkv_a2[l],
                           rwkv_g2[l], rwkv_k_k[l], rwkv_k_a[l], rwkv_r_k[l], rwkv_ln_w[l], rwkv_ln_b[l])
        y_b = rglru_branch(p_lx, p_ly, lru_conv_w[l], lru_conv_b[l], lru_w_r[l], lru_b_r[l],
                           lru_w_i[l], lru_b_i[l], lru_lambda[l])
        y_c = memory_xattn(p_q, mem, g_mem[l], w_mem_k[l], w_mem_v[l])
        gates = jax.nn.sigmoid(p_gate.astype(jnp.float32)).reshape(bsz, seq, N_BRANCH, D_MODEL)
        merged = (gates[:, :, 0] * (y_a @ w_rwkv_out[l])
                  + gates[:, :, 1] * (y_b @ w_lru_out[l])
                  + gates[:, :, 2] * (y_c @ w_xa_out[l]))
        h = h + (merged @ w_o[l]).astype(jnp.float32)
        h = h + moe(rms_norm(h, g_ffn[l]), w_router[l], b_router[l], w_gate[l], b_gate[l],
                    w_up[l], b_up[l], w_down[l], b_down[l])
    return rms_norm(h, g_final).astype(x.dtype)
```

```cpp
#include <hip/hip_runtime.h>
#include <cstdio>
#include <cstdint>
namespace pg8 {
#define PG8_LAS __attribute__((address_space(3)))
typedef unsigned short bf16_t;
typedef short bf16x8 __attribute__((ext_vector_type(8)));
typedef float f32x4 __attribute__((ext_vector_type(4)));
typedef unsigned u32x4 __attribute__((ext_vector_type(4)));
constexpr int BM = 256, BK = 64, HALF = 128, HTB = HALF * BK * 2  , STAGE_BYTES = 8 * HTB, NXCD = 8, WGM = 8;

__host__ __device__ __forceinline__ int lds_byte(int r, int c) { const int st = (r >> 4) * 2 + (c >> 5), rr = r & 15, cc = c & 31, ob = rr * 64 + cc * 2; return st * 1024 + (ob ^ (((ob >> 9) & 1) << 5)); }
__host__ __device__ __forceinline__ void stage_rc(int b, int& R, int& C) { const int st = b / 1024, sb = b % 1024, swz = sb ^ (((sb >> 9) & 1) << 5); R = (st >> 1) * 16 + swz / 64; C = (st & 1) * 32 + (swz % 64) / 2; }
__host__ __device__ __forceinline__ int perm32(int rho) { const int n = rho >> 4, i = rho & 15; return 8 * (i >> 2) + 4 * n + (i & 3); }

struct Unit { int pm, pn; };
struct Gemm { const bf16_t* A; const bf16_t* Bt; int M, N, K; };

struct StaticOrder {
    int nM, nN, nwg, G, c;
    __host__ __device__ void init(int M, int N, int G_, int c_) { nM = M / BM; nN = N / BM; nwg = nM * nN; G = G_; c = c_; }
    __host__ __device__ bool next(int i, Unit& u) const {
        const long L = (long)i * G + c; if (L >= nwg) return false;
        int wgid = (int)L; { const int q = nwg / NXCD, r = nwg % NXCD, xcd = wgid % NXCD, off = wgid / NXCD; wgid = (xcd < r ? xcd * (q + 1) : r * (q + 1) + (xcd - r) * q) + off; }
        const int nig = WGM * nN, gid = wgid / nig, fm = gid * WGM, gsz = (nM - fm) < WGM ? (nM - fm) : WGM;
        u.pm = fm + ((wgid % nig) % gsz); u.pn = (wgid % nig) / gsz; return true;
    }
    __device__ __forceinline__ void a_ready(const Unit&) const {}
    __device__ __forceinline__ void done(const Unit&) const {}
};
__device__ __forceinline__ unsigned cvt_pk_bf16(float lo, float hi) { unsigned r; asm volatile("v_cvt_pk_bf16_f32 %0, %1, %2" : "=v"(r) : "v"(lo), "v"(hi)); return r; }
typedef float f32x2 __attribute__((ext_vector_type(2)));
__device__ __forceinline__ f32x2 gelu_pk(f32x2 v) {
    const f32x2 av = __builtin_elementwise_abs(v), d = av * 0.2316418882f + 1.0f;
    f32x2 t; t.x = __builtin_amdgcn_rcpf(d.x); t.y = __builtin_amdgcn_rcpf(d.y);
    f32x2 q = t * 0.5307027145f + (-0.7265760135f); q = q * t + 0.7107068705f; q = q * t + (-0.142248368f); q = q * t + 0.127414796f; q = q * t;
    const f32x2 s = (v * v) * (-0.72134752044f);
    f32x2 e; e.x = __builtin_amdgcn_exp2f(s.x); e.y = __builtin_amdgcn_exp2f(s.y);
    const f32x2 m = v * (q * e), r = v - m;
    f32x2 o; o.x = v.x < 0.f ? m.x : r.x; o.y = v.y < 0.f ? m.y : r.y; return o;
}

template <int ACT  > struct EpiBf16 {
    static constexpr bool PERM = true, AFTER_DRAIN = false; static_assert(ACT == 0 || ACT == 1, "EpiBf16: ACT is 0 (none) or 1 (gelu_pk)");
    bf16_t* O; int ldc; const float* bias; int split_cols; size_t split_stride; float scale0;
    __device__ __forceinline__ void operator()(const f32x4 (&acc)[2][2][4][2], const Unit& u, int wr, int wc, int fr, int fq) const {
        const int row0 = u.pm * BM + wr * 64 + fr; int colt = u.pn * BM; bf16_t* base = O;
        float sc = 1.f; if (split_cols) { const int t = colt / split_cols; base += (size_t)t * split_stride; colt -= t * split_cols; if (t == 0) sc = scale0; }
        const int col0 = colt + wc * 32 + 8 * fq, bcol0 = u.pn * BM + wc * 32 + 8 * fq;
        f32x4 bv[2][2];
#pragma unroll
        for (int bj = 0; bj < 2; ++bj)
#pragma unroll
            for (int n = 0; n < 2; ++n) bv[bj][n] = bias ? *(const f32x4*)(bias + bcol0 + bj * HALF + 4 * n) : (f32x4){0.f, 0.f, 0.f, 0.f};
#pragma unroll
        for (int ai = 0; ai < 2; ++ai)
#pragma unroll
            for (int m = 0; m < 4; ++m) { bf16_t* rowp = base + (size_t)(row0 + ai * HALF + m * 16) * ldc + col0;
#pragma unroll
                for (int bj = 0; bj < 2; ++bj) { f32x4 v0 = acc[ai][bj][m][0] + bv[bj][0], v1 = acc[ai][bj][m][1] + bv[bj][1];
                    if (ACT == 1) { f32x2 a = gelu_pk((f32x2){v0[0], v0[1]}), b = gelu_pk((f32x2){v0[2], v0[3]}), c = gelu_pk((f32x2){v1[0], v1[1]}), d = gelu_pk((f32x2){v1[2], v1[3]});
                        v0 = (f32x4){a.x, a.y, b.x, b.y}; v1 = (f32x4){c.x, c.y, d.x, d.y}; }
                    v0 = v0 * sc; v1 = v1 * sc; u32x4 w; w.x = cvt_pk_bf16(v0[0], v0[1]); w.y = cvt_pk_bf16(v0[2], v0[3]); w.z = cvt_pk_bf16(v1[0], v1[1]); w.w = cvt_pk_bf16(v1[2], v1[3]);
                    *(u32x4*)(rowp + bj * HALF) = w; } }
    }
};

__device__ __forceinline__ float bf_lo(unsigned w) { return __builtin_bit_cast(float, w << 16); }
__device__ __forceinline__ float bf_hi(unsigned w) { return __builtin_bit_cast(float, w & 0xffff0000u); }
__device__ __forceinline__ float fsigmoid(float x) { return __builtin_amdgcn_rcpf(1.0f + __expf(-x)); }
typedef unsigned u32x2 __attribute__((ext_vector_type(2)));

struct EpiF32 {
    static constexpr bool PERM = false, AFTER_DRAIN = false;
    float* C; int ldc;
    __device__ __forceinline__ void operator()(const f32x4 (&acc)[2][2][4][2], const Unit& u, int wr, int wc, int fr, int fq) const {
        const int row0 = u.pm * BM + wr * 64 + fr, col0 = u.pn * BM + wc * 32 + 4 * fq;
#pragma unroll
        for (int ai = 0; ai < 2; ++ai)
#pragma unroll
            for (int m = 0; m < 4; ++m) { float* rowp = C + (size_t)(row0 + ai * HALF + m * 16) * ldc + col0;
#pragma unroll
                for (int bj = 0; bj < 2; ++bj)
#pragma unroll
                    for (int n = 0; n < 2; ++n) *(f32x4*)(rowp + bj * HALF + n * 16) = acc[ai][bj][m][n]; }
    }
};
struct EpiRes {
    static constexpr bool PERM = false, AFTER_DRAIN = false;
    const float* X; float* C; int ldc;
    __device__ __forceinline__ void operator()(const f32x4 (&acc)[2][2][4][2], const Unit& u, int wr, int wc, int fr, int fq) const {
        const int row0 = u.pm * BM + wr * 64 + fr, col0 = u.pn * BM + wc * 32 + 4 * fq;
#pragma unroll
        for (int ai = 0; ai < 2; ++ai)
#pragma unroll
            for (int m = 0; m < 4; ++m) { const size_t off = (size_t)(row0 + ai * HALF + m * 16) * ldc + col0;
#pragma unroll
                for (int bj = 0; bj < 2; ++bj)
#pragma unroll
                    for (int n = 0; n < 2; ++n) { const f32x4 xv = *(const f32x4*)(X + off + bj * HALF + n * 16); *(f32x4*)(C + off + bj * HALF + n * 16) = acc[ai][bj][m][n] + xv; }
                asm volatile("" ::: "memory"); }
    }
};
struct EpiKV {
    static constexpr bool PERM = false, AFTER_DRAIN = false;
    bf16_t* Kb; bf16_t* VT;
    __device__ __forceinline__ void operator()(const f32x4 (&acc)[2][2][4][2], const Unit& u, int wr, int wc, int fr, int fq) const {
        const int row0 = u.pm * BM + wr * 64 + fr, col0 = u.pn * BM + wc * 32 + 4 * fq;
#pragma unroll
        for (int ai = 0; ai < 2; ++ai)
#pragma unroll
            for (int m = 0; m < 4; ++m) { const int r = row0 + ai * HALF + m * 16;
#pragma unroll
                for (int bj = 0; bj < 2; ++bj)
#pragma unroll
                    for (int n = 0; n < 2; ++n) { const f32x4 v = acc[ai][bj][m][n]; const int c = col0 + bj * HALF + n * 16;
                        if (u.pn < 4) { u32x2 w; w.x = cvt_pk_bf16(v[0], v[1]); w.y = cvt_pk_bf16(v[2], v[3]); *(u32x2*)(Kb + (size_t)r * 1024 + c) = w; }
                        else { const int cc = c - 1024, h = cc >> 8, d = cc & 255, b = r >> 8, mm = r & 255;
                            const int idx = (mm >> 5) * 32 + ((mm >> 2) & 3) * 8 + ((mm >> 4) & 1) * 4 + (mm & 3);
                            bf16_t* o = VT + ((size_t)((b * 4 + h) * 256 + d)) * 256 + idx;
                            const unsigned w0 = cvt_pk_bf16(v[0], v[1]), w1 = cvt_pk_bf16(v[2], v[3]);
                            o[0] = (bf16_t)(w0 & 0xffffu); o[256] = (bf16_t)(w0 >> 16); o[512] = (bf16_t)(w1 & 0xffffu); o[768] = (bf16_t)(w1 >> 16); } } }
    }
};
struct EpiBranch {
    static constexpr bool PERM = false, AFTER_DRAIN = false;
    const bf16_t* P; int ldp; int gcol0; float* macc; bf16_t* merged;
    __device__ __forceinline__ void operator()(const f32x4 (&acc)[2][2][4][2], const Unit& u, int wr, int wc, int fr, int fq) const {
        const int br = u.pm >> 6, pm = u.pm & 63, pn = u.pn & 7;
        const int row0 = pm * BM + wr * 64 + fr, col0 = pn * BM + wc * 32 + 4 * fq;
#pragma unroll
        for (int ai = 0; ai < 2; ++ai)
#pragma unroll
            for (int m = 0; m < 4; ++m) { const int r = row0 + ai * HALF + m * 16; const bf16_t* prow = P + (size_t)r * ldp + gcol0 + br * 2048;
#pragma unroll
                for (int bj = 0; bj < 2; ++bj)
#pragma unroll
                    for (int n = 0; n < 2; ++n) { const int c = col0 + bj * HALF + n * 16; const u32x2 gw = *(const u32x2*)(prow + c);
                        f32x4 g; g[0] = fsigmoid(bf_lo(gw.x)); g[1] = fsigmoid(bf_hi(gw.x)); g[2] = fsigmoid(bf_lo(gw.y)); g[3] = fsigmoid(bf_hi(gw.y));
                        f32x4 v = acc[ai][bj][m][n] * g; float* mp = macc + (size_t)r * 2048 + c;
                        if (br > 0) v = v + *(const f32x4*)mp;
                        if (br < 2) *(f32x4*)mp = v;
                        else { u32x2 w; w.x = cvt_pk_bf16(v[0], v[1]); w.y = cvt_pk_bf16(v[2], v[3]); *(u32x2*)(merged + (size_t)r * 2048 + c) = w; } }
                asm volatile("" ::: "memory"); }
    }
};
struct EpiSwiglu {
    static constexpr bool PERM = true, AFTER_DRAIN = false;
    bf16_t* H; const float* bg; const float* bu;
    __device__ __forceinline__ void operator()(const f32x4 (&acc)[2][2][4][2], const Unit& u, int wr, int wc, int fr, int fq) const {
        const int e = u.pn >> 4, ct = u.pn & 15;
        const int row0 = u.pm * BM + wr * 64 + fr, col0 = ct * 128 + wc * 32 + 8 * fq;
        f32x4 bgv[2], buv[2];
#pragma unroll
        for (int n = 0; n < 2; ++n) { bgv[n] = *(const f32x4*)(bg + (size_t)e * 2048 + col0 + 4 * n); buv[n] = *(const f32x4*)(bu + (size_t)e * 2048 + col0 + 4 * n); }
#pragma unroll
        for (int ai = 0; ai < 2; ++ai)
#pragma unroll
            for (int m = 0; m < 4; ++m) { bf16_t* rowp = H + (size_t)(row0 + ai * HALF + m * 16) * 2048 + col0;
                f32x4 o[2];
#pragma unroll
                for (int n = 0; n < 2; ++n) { const f32x4 g = acc[ai][0][m][n] + bgv[n], up = acc[ai][1][m][n] + buv[n];
#pragma unroll
                    for (int j = 0; j < 4; ++j) { const float hg = fminf(g[j], 7.0f), hu = fminf(fmaxf(up[j], -7.0f), 7.0f); o[n][j] = (hu + 1.0f) * hg * fsigmoid(1.702f * hg); } }
                u32x4 w; w.x = cvt_pk_bf16(o[0][0], o[0][1]); w.y = cvt_pk_bf16(o[0][2], o[0][3]); w.z = cvt_pk_bf16(o[1][0], o[1][1]); w.w = cvt_pk_bf16(o[1][2], o[1][3]);
                *(u32x4*)rowp = w; }
    }
};
struct EpiDown {
    static constexpr bool PERM = true, AFTER_DRAIN = false;
    bf16_t* O; const float* bd; const float* rowgate;
    __device__ __forceinline__ void operator()(const f32x4 (&acc)[2][2][4][2], const Unit& u, int wr, int wc, int fr, int fq) const {
        const int e = u.pn >> 3, ct = u.pn & 7;
        const int row0 = u.pm * BM + wr * 64 + fr, col0 = ct * BM + wc * 32 + 8 * fq;
        f32x4 bv[2][2];
#pragma unroll
        for (int bj = 0; bj < 2; ++bj)
#pragma unroll
            for (int n = 0; n < 2; ++n) bv[bj][n] = *(const f32x4*)(bd + (size_t)e * 2048 + col0 + bj * HALF + 4 * n);
#pragma unroll
        for (int ai = 0; ai < 2; ++ai)
#pragma unroll
            for (int m = 0; m < 4; ++m) { const int r = row0 + ai * HALF + m * 16; const float gs = rowgate[r]; bf16_t* rowp = O + (size_t)r * 2048 + col0;
#pragma unroll
                for (int bj = 0; bj < 2; ++bj) { const f32x4 v0 = (acc[ai][bj][m][0] + bv[bj][0]) * gs, v1 = (acc[ai][bj][m][1] + bv[bj][1]) * gs;
                    u32x4 w; w.x = cvt_pk_bf16(v0[0], v0[1]); w.y = cvt_pk_bf16(v0[2], v0[3]); w.z = cvt_pk_bf16(v1[0], v1[1]); w.w = cvt_pk_bf16(v1[2], v1[3]);
                    *(u32x4*)(rowp + bj * HALF) = w; } }
    }
};
struct BranchOrder {
    StaticOrder so;
    __device__ void init(int G_, int c_) { so.init(16384, 2048, G_, c_); }
    __device__ bool next(int i, Unit& u) const { const int br = i % 3; Unit t; if (!so.next(i / 3, t)) return false; u.pm = br * 64 + t.pm; u.pn = br * 8 + t.pn; return true; }
    __device__ __forceinline__ void a_ready(const Unit&) const {}
    __device__ __forceinline__ void done(const Unit&) const {}
};
struct MoeOrder {
    StaticOrder so; const int* tile_e; int nN;
    __device__ void init(int ntiles, int nN_, int G_, int c_, const int* te) { so.init(ntiles * BM, nN_ * BM, G_, c_); tile_e = te; nN = nN_; }
    __device__ bool next(int i, Unit& u) const { Unit t; if (!so.next(i, t)) return false; u.pm = t.pm; u.pn = tile_e[t.pm] * nN + t.pn; return true; }
    __device__ __forceinline__ void a_ready(const Unit&) const {}
    __device__ __forceinline__ void done(const Unit&) const {}
};
template <class Epi, class Sched, bool ALIGN_EPI = false, bool SP2 = false>
__device__ __forceinline__ void gemm_phase(PG8_LAS unsigned char* lds, const Gemm g, const Sched& S, const Epi& E) {
    const int tid = threadIdx.x, wid = __builtin_amdgcn_readfirstlane(tid >> 6), lane = tid & 63, wr = wid >> 2, wc = wid & 3, fr = lane & 15, fq = lane >> 4;
    const int K = g.K, nt = K / BK;
    unsigned voffA[2], voffB[2];
#pragma unroll
    for (int i = 0; i < 2; ++i) { int R, C; stage_rc(tid * 16 + i * 8192, R, C); const int Rb = Epi::PERM ? ((R & ~31) + perm32(R & 31)) : R;
        voffA[i] = (unsigned)(R * K + C) * 2u; voffB[i] = (unsigned)(Rb * K + C) * 2u; }
    const size_t kstep = (size_t)(BK * 2);
    const size_t hstep = (size_t)HALF * K * 2;
    const size_t tstep = 2 * hstep;
    const unsigned ldsw = (unsigned)wid * 1024u;
    const int aoff = lds_byte(wr * 64 + fr, fq * 8), boff = lds_byte(wc * 32 + fr, fq * 8);
#define PG8_SA(b, h) (((b) * 2 + (h)) * HTB)
#define PG8_SB(b, h) ((4 + (b) * 2 + (h)) * HTB)
#define PG8_STAGE(bufoff, gbase, voff) do { _Pragma("unroll") for (int _i = 0; _i < 2; ++_i) \
        __builtin_amdgcn_global_load_lds((const unsigned*)((const char*)(gbase) + (voff)[_i]), (PG8_LAS unsigned*)(lds + (bufoff) + ldsw + _i * 8192), 16, 0, 0); } while (0)
#define PG8_LDA(dst, b, h) do { _Pragma("unroll") for (int m = 0; m < 4; ++m) _Pragma("unroll") for (int k = 0; k < 2; ++k) dst[m][k] = *(const PG8_LAS bf16x8*)(lds + PG8_SA(b, h) + aoff + m * 2048 + k * 1024); } while (0)
#define PG8_LDB(dst, b, h) do { _Pragma("unroll") for (int n = 0; n < 2; ++n) _Pragma("unroll") for (int k = 0; k < 2; ++k) dst[n][k] = *(const PG8_LAS bf16x8*)(lds + PG8_SB(b, h) + boff + n * 2048 + k * 1024); } while (0)
#define PG8_MMA(ai, bj, At, Bt) do { __builtin_amdgcn_s_setprio(1); _Pragma("unroll") for (int m = 0; m < 4; ++m) _Pragma("unroll") for (int n = 0; n < 2; ++n) _Pragma("unroll") for (int k = 0; k < 2; ++k) \
        acc[ai][bj][m][n] = __builtin_amdgcn_mfma_f32_16x16x32_bf16(Bt[n][k], At[m][k], acc[ai][bj][m][n], 0, 0, 0); __builtin_amdgcn_s_setprio(0); } while (0)
#define PG8_WAIT_V(n) asm volatile("s_waitcnt vmcnt(" #n ")" ::: "memory")
#define PG8_WAIT_L(n) asm volatile("s_waitcnt lgkmcnt(" #n ")" ::: "memory")
#define PG8_BAR __builtin_amdgcn_s_barrier()
#define PG8_SCHED __builtin_amdgcn_sched_barrier(0)
    Unit cur, nxt; int ui = 0;
    if (!S.next(0, cur)) return;
    f32x4 acc[2][2][4][2];
#pragma unroll
    for (int a = 0; a < 2; ++a)
#pragma unroll
        for (int b = 0; b < 2; ++b)
#pragma unroll
            for (int m = 0; m < 4; ++m)
#pragma unroll
                for (int n = 0; n < 2; ++n) acc[a][b][m][n] = (f32x4){0.f, 0.f, 0.f, 0.f};
    bf16x8 At[4][2], B0[2][2], B1[2][2];
    const char* cA = (const char*)g.A + (size_t)cur.pm * tstep; const char* cB = (const char*)g.Bt + (size_t)cur.pn * tstep;
    S.a_ready(cur);
    if constexpr (SP2) {
        PG8_STAGE(PG8_SB(0, 0), cB, voffB); PG8_STAGE(PG8_SB(0, 1), cB + hstep, voffB); PG8_STAGE(PG8_SA(0, 0), cA, voffA); PG8_STAGE(PG8_SA(0, 1), cA + hstep, voffA);
        if (wr == 1) PG8_BAR;
        PG8_WAIT_V(2); PG8_BAR;
        PG8_STAGE(PG8_SB(1, 0), cB + kstep, voffB); PG8_STAGE(PG8_SA(1, 0), cA + kstep, voffA); PG8_STAGE(PG8_SB(1, 1), cB + hstep + kstep, voffB);
        PG8_WAIT_V(6); PG8_BAR;
    } else {
        PG8_STAGE(PG8_SB(0, 0), cB, voffB); PG8_STAGE(PG8_SA(0, 0), cA, voffA); PG8_STAGE(PG8_SB(0, 1), cB + hstep, voffB); PG8_STAGE(PG8_SA(0, 1), cA + hstep, voffA);
        if (wr == 1) PG8_BAR;
        PG8_WAIT_V(4); PG8_BAR;
        PG8_STAGE(PG8_SB(1, 0), cB + kstep, voffB); PG8_STAGE(PG8_SA(1, 0), cA + kstep, voffA); PG8_STAGE(PG8_SB(1, 1), cB + hstep + kstep, voffB);
        PG8_WAIT_V(6); PG8_BAR;
    }
    for (;;) {
        const bool has_next = S.next(ui + 1, nxt);
        const char* nA = has_next ? (const char*)g.A + (size_t)nxt.pm * tstep : cA; const char* nB = has_next ? (const char*)g.Bt + (size_t)nxt.pn * tstep : cB;
        for (int t = 0; t < nt; t += 2) {
            const bool last = (t == nt - 2);
            const char* a1 = cA + (size_t)(t + 1) * kstep;
            const char* a2 = last ? nA : cA + (size_t)(t + 2) * kstep; const char* b2 = last ? nB : cB + (size_t)(t + 2) * kstep;
            const char* a3 = a2 + kstep; const char* b3 = b2 + kstep;
            if (last && has_next) S.a_ready(nxt);
            if constexpr (SP2) {
            PG8_LDB(B0, 0, 0); PG8_LDB(B1, 0, 1); PG8_SCHED; PG8_LDA(At, 0, 0); PG8_STAGE(PG8_SA(1, 1), a1 + hstep, voffA);
            PG8_WAIT_V(8); PG8_WAIT_L(0); PG8_BAR; PG8_MMA(0, 0, At, B0); PG8_MMA(0, 1, At, B1); PG8_BAR; PG8_SCHED;
            PG8_LDA(At, 0, 1); PG8_STAGE(PG8_SB(0, 0), b2, voffB); PG8_STAGE(PG8_SB(0, 1), b2 + hstep, voffB); PG8_STAGE(PG8_SA(0, 0), a2, voffA);
            PG8_WAIT_V(8); PG8_WAIT_L(0); PG8_BAR; PG8_MMA(1, 0, At, B0); PG8_MMA(1, 1, At, B1); PG8_BAR; PG8_SCHED;
            PG8_LDB(B0, 1, 0); PG8_LDB(B1, 1, 1); PG8_SCHED; PG8_LDA(At, 1, 0); PG8_STAGE(PG8_SA(0, 1), a2 + hstep, voffA);
            PG8_WAIT_V(8); PG8_WAIT_L(0); PG8_BAR; PG8_MMA(0, 0, At, B0); PG8_MMA(0, 1, At, B1); PG8_BAR; PG8_SCHED;
            PG8_LDA(At, 1, 1); PG8_STAGE(PG8_SB(1, 0), b3, voffB); PG8_STAGE(PG8_SB(1, 1), b3 + hstep, voffB); PG8_STAGE(PG8_SA(1, 0), a3, voffA);
            PG8_WAIT_V(8); PG8_WAIT_L(0); PG8_BAR; PG8_MMA(1, 0, At, B0); PG8_MMA(1, 1, At, B1); PG8_BAR; PG8_SCHED;
            } else {
            PG8_LDB(B0, 0, 0); PG8_SCHED; PG8_LDA(At, 0, 0); PG8_STAGE(PG8_SA(1, 1), a1 + hstep, voffA);
            PG8_WAIT_L(8); PG8_BAR; PG8_WAIT_L(0); PG8_MMA(0, 0, At, B0); PG8_BAR; PG8_SCHED;
            PG8_LDB(B1, 0, 1); PG8_STAGE(PG8_SB(0, 0), b2, voffB);
            PG8_BAR; PG8_WAIT_L(0); PG8_MMA(0, 1, At, B1); PG8_BAR;
            PG8_LDA(At, 0, 1); PG8_STAGE(PG8_SA(0, 0), a2, voffA);
            PG8_BAR; PG8_WAIT_L(0); PG8_MMA(1, 0, At, B0); PG8_BAR; PG8_SCHED;
            PG8_STAGE(PG8_SB(0, 1), b2 + hstep, voffB);
            PG8_WAIT_V(6); PG8_BAR; PG8_MMA(1, 1, At, B1); PG8_BAR;
            PG8_LDB(B0, 1, 0); PG8_SCHED; PG8_LDA(At, 1, 0); PG8_STAGE(PG8_SA(0, 1), a2 + hstep, voffA);
            PG8_WAIT_L(8); PG8_BAR; PG8_WAIT_L(0); PG8_MMA(0, 0, At, B0); PG8_BAR; PG8_SCHED;
            PG8_LDB(B1, 1, 1); PG8_STAGE(PG8_SB(1, 0), b3, voffB);
            PG8_BAR; PG8_WAIT_L(0); PG8_MMA(0, 1, At, B1); PG8_BAR;
            PG8_LDA(At, 1, 1); PG8_STAGE(PG8_SA(1, 0), a3, voffA);
            PG8_BAR; PG8_WAIT_L(0); PG8_MMA(1, 0, At, B0); PG8_BAR; PG8_SCHED;
            PG8_STAGE(PG8_SB(1, 1), b3 + hstep, voffB);
            PG8_WAIT_V(6); PG8_BAR; PG8_MMA(1, 1, At, B1); PG8_BAR;
            }
        }
        if constexpr (ALIGN_EPI) { if (wr == 0) PG8_BAR; }
        if constexpr (!Epi::AFTER_DRAIN) { E(acc, cur, wr, wc, fr, fq); S.done(cur); }
        if (!has_next) break;
#pragma unroll
        for (int a = 0; a < 2; ++a)
#pragma unroll
            for (int b = 0; b < 2; ++b)
#pragma unroll
                for (int m = 0; m < 4; ++m)
#pragma unroll
                    for (int n = 0; n < 2; ++n) acc[a][b][m][n] = (f32x4){0.f, 0.f, 0.f, 0.f};
        cur = nxt; cA = nA; cB = nB; ++ui;
        if constexpr (ALIGN_EPI) { if (wr == 1) PG8_BAR; }
    }
    PG8_WAIT_V(0);
    if constexpr (!ALIGN_EPI) { if (wr == 0) PG8_BAR; }
    PG8_BAR;
    if constexpr (Epi::AFTER_DRAIN) { E.fused(acc, cur, wr, wc, fr, fq, lds, wid, lane); S.done(cur); }
#undef PG8_SA
#undef PG8_SB
#undef PG8_STAGE
#undef PG8_LDA
#undef PG8_LDB
#undef PG8_MMA
#undef PG8_WAIT_V
#undef PG8_WAIT_L
#undef PG8_BAR
#undef PG8_SCHED
}
}

constexpr int NWAVES = 8;
constexpr int BATCH = 2, SEQ = 8192, T = BATCH * SEQ, D = 2048;
constexpr int RWKV_COLS = 3360, IN_COLS = 12576;
constexpr int NP = 12800;
constexpr int PC_LX = 3584, PC_LY = 4608, PC_Q = 5632, PC_G = 6656;
constexpr int NE = 32, MAXROWS = 65536 + NE * 256;
constexpr int LORA_K = 384;
constexpr float EPS = 1e-6f, GN_EPS = 64e-5f;

constexpr size_t MiB = 1u << 20;
constexpr size_t WS_CTL = 0, CTL_ZERO_BYTES = 1 * MiB;
constexpr size_t WS_WIN = 1 * MiB, WS_WMKV = 51 * MiB, WS_WLORA = 59 * MiB, WS_WBR = 62 * MiB, WS_WO = 74 * MiB, WS_WR = 82 * MiB, WS_LW = 83 * MiB;
constexpr size_t WS_WGU = 84 * MiB, WS_WD = 596 * MiB;
constexpr size_t WS_XN = 852 * MiB;
constexpr size_t WS_P = 916 * MiB;
constexpr size_t WS_LORAOUT = 1316 * MiB;
constexpr size_t WS_SCAN = 1508 * MiB;
constexpr size_t WS_YABC = 1892 * MiB;
constexpr size_t WS_MISC = 1988 * MiB;
constexpr size_t WS_MN = WS_MISC, WS_KMEM = WS_MISC + 2 * MiB, WS_VT = WS_MISC + 3 * MiB, WS_LRUC = WS_MISC + 4 * MiB  , WS_BONUS = WS_MISC + 7 * MiB;
constexpr size_t WS_PICK = WS_MISC + 8 * MiB  , WS_ROWTAB = WS_MISC + 9 * MiB  ;
constexpr size_t WS_END = 2000 * MiB;
constexpr size_t WS_MACC = WS_LORAOUT, WS_MERGED = 1444 * MiB, WS_H1 = WS_SCAN, WS_XS = WS_P, WS_OROW = WS_P, WS_HH = 1204 * MiB;
constexpr int CW_BAR = 4096, CW_CNT = 8192, CW_NTILES = 8192 + 64, CW_TILEE = 8192 + 128;

constexpr int LDS_BYTES = 147456;
constexpr int MISC_OFF = 143360;

#define GAS __attribute__((address_space(1)))
#define LAS __attribute__((address_space(3)))
typedef unsigned short bf16;
typedef unsigned v4u __attribute__((ext_vector_type(4)));
typedef unsigned v2u __attribute__((ext_vector_type(2)));
typedef float f32x4 __attribute__((ext_vector_type(4)));
typedef float f32x2 __attribute__((ext_vector_type(2)));
typedef short bf16x8 __attribute__((ext_vector_type(8)));
#define LDS_WAIT() asm volatile("s_waitcnt lgkmcnt(0)" ::: "memory")
#define VM_WAIT() asm volatile("s_waitcnt vmcnt(0)" ::: "memory")
__device__ __forceinline__ unsigned f2bf(float f) { unsigned u = __builtin_bit_cast(unsigned, f); return (u + 0x7fffu + ((u >> 16) & 1u)) >> 16; }
__device__ __forceinline__ unsigned pk2(float lo, float hi) { return f2bf(lo) | (f2bf(hi) << 16); }
__device__ __forceinline__ float bflo(unsigned w) { return __builtin_bit_cast(float, w << 16); }
__device__ __forceinline__ float bfhi(unsigned w) { return __builtin_bit_cast(float, w & 0xffff0000u); }
__device__ __forceinline__ float bf1(bf16 b) { return __builtin_bit_cast(float, (unsigned)b << 16); }
__device__ __forceinline__ float sigm(float x) { return 1.0f / (1.0f + __expf(-x)); }
__device__ __forceinline__ float softplusf(float x) { return fmaxf(x, 0.f) + log1pf(__expf(-fabsf(x))); }
__device__ __forceinline__ float wave_sum(float v) {
#pragma unroll
    for (int o = 1; o < 64; o <<= 1) v += __shfl_xor(v, o);
    return v;
}
template <int CTRL> __device__ __forceinline__ float dppf(float x) { return __builtin_bit_cast(float, __builtin_amdgcn_mov_dpp(__builtin_bit_cast(int, x), CTRL, 0xf, 0xf, true)); }
__device__ __forceinline__ float row16_sum(float v) {
    v += dppf<0xB1>(v); v += dppf<0x4E>(v); v += dppf<0x141>(v); v += dppf<0x140>(v); return v;
}
#define XB_TMO      128
#define XB_XCNT(j)  (256  + 64 * (j))
#define XB_XSUB(j)  (1280 + 64 * (j))
#define XB_XGEN(j)  (2304 + 64 * (j))
#define XB_TOP      3328
#define XB_TOPGEN   3392
#define XCD_BAR_WORDS 3456
#define XB_SPIN_CAP (1u << 18)

__device__ __forceinline__ unsigned xb_ld(unsigned* p)              { return __hip_atomic_load(p, __ATOMIC_RELAXED, __HIP_MEMORY_SCOPE_AGENT); }
__device__ __forceinline__ unsigned xb_add(unsigned* p, unsigned v) { return __hip_atomic_fetch_add(p, v, __ATOMIC_RELAXED, __HIP_MEMORY_SCOPE_AGENT); }
__device__ __forceinline__ unsigned xb_xcc_id() { return (unsigned)__builtin_amdgcn_s_getreg((3 << 11) | 20) & 0xFu; }
#define XB_SPIN(cond, bar) do { unsigned _sp = 0; while (cond) { __builtin_amdgcn_s_sleep(1); \
    if ((++_sp & 255u) == 0u) { if (xb_ld(&(bar)[XB_TMO])) break; if (_sp > XB_SPIN_CAP) { atomicAdd(&(bar)[XB_TMO], 1u); break; } } } } while (0)

struct XcdBarrier {
    unsigned* bar; unsigned x;
    volatile LAS unsigned* st;
};

__device__ __forceinline__ XcdBarrier xcd_barrier_post(unsigned* bar, volatile LAS unsigned* st) {
    XcdBarrier b; b.bar = bar; b.x = xb_xcc_id(); b.st = st;
    if (threadIdx.x == 0) (void)xb_add(&bar[XB_XCNT(b.x)], 1u);
    return b;
}
__device__ __forceinline__ void xcd_barrier_complete(unsigned* bar, unsigned x, unsigned& nloc, unsigned& nx) {
    const unsigned G = gridDim.x * gridDim.y * gridDim.z;
    unsigned sum, cnt, mine, sp = 0u;
    for (;;) {
        sum = 0u; cnt = 0u; mine = 0u;
#pragma unroll
        for (unsigned j = 0; j < 16; ++j) { const unsigned c = xb_ld(&bar[XB_XCNT(j)]); sum += c; cnt += (c > 0u) ? 1u : 0u; mine = (j == x) ? c : mine; }
        if (sum == G) break;
        __builtin_amdgcn_s_sleep(1);
        if ((++sp & 255u) == 0u) { if (xb_ld(&bar[XB_TMO])) break; if (sp > XB_SPIN_CAP) { atomicAdd(&bar[XB_TMO], 1u); break; } }
    }
    nloc = mine > 0u ? mine : 1u; nx = cnt > 0u ? cnt : 1u;
}

__device__ __forceinline__ void xcd_barrier(const XcdBarrier& b) {
    asm volatile("s_waitcnt vmcnt(0)" ::: "memory");
    __syncthreads();
    if (threadIdx.x == 0) {
        unsigned* bar = b.bar;
        __builtin_amdgcn_s_waitcnt(0);
        unsigned nloc = b.st[0], nx = b.st[1];
        if (nloc == 0u) { xcd_barrier_complete(bar, b.x, nloc, nx); b.st[0] = nloc; b.st[1] = nx; }
        const unsigned old = xb_add(&bar[XB_XSUB(b.x)], 1u);
        const unsigned gen = old / nloc;
        if (old + 1u == (gen + 1u) * nloc) {
            __builtin_amdgcn_fence(__ATOMIC_RELEASE, "agent");
            asm volatile("s_waitcnt vmcnt(0)" ::: "memory");
            const unsigned og = xb_add(&bar[XB_TOP], 1u);
            const unsigned tg = og / nx;
            if (og + 1u == (tg + 1u) * nx) xb_add(&bar[XB_TOPGEN], 1u);
            else XB_SPIN(xb_ld(&bar[XB_TOPGEN]) == tg, bar);
            __builtin_amdgcn_fence(__ATOMIC_ACQUIRE, "agent");
            xb_add(&bar[XB_XGEN(b.x)], 1u);
            asm volatile("s_waitcnt vmcnt(0)" ::: "memory");
        } else {
            XB_SPIN(xb_ld(&bar[XB_XGEN(b.x)]) == gen, bar);
            __builtin_amdgcn_fence(__ATOMIC_ACQUIRE, "agent");
            asm volatile("s_waitcnt vmcnt(0)" ::: "memory");
        }
    }
    __syncthreads();
}

struct Frame {
    LAS unsigned char* lds;
    volatile LAS unsigned* MISC;
    int tid, lane, wave, vcu, G;
};
struct Args { const float* in[39]; float* out; unsigned char* ws; int ph_lo, ph_hi; };
enum { I_X = 0, I_MEM, I_GMIX, I_WIN, I_MU, I_W0, I_W2, I_A0, I_A2, I_G2, I_KK, I_KA, I_RK, I_LNW, I_LNB, I_WRO, I_CONVW, I_CONVB, I_LWR, I_LBR, I_LWI, I_LBI, I_LAM, I_WLO,
       I_GMEM, I_WMK, I_WMV, I_WXO, I_WOUT, I_GFFN, I_WROUTER, I_BROUTER, I_WGATE, I_BGATE, I_WUP, I_BUP, I_WDOWN, I_BDOWN, I_GFINAL };


__device__ __forceinline__ const float* inp(int k) {
    typedef const volatile unsigned long long __attribute__((address_space(4))) ka_t;
    ka_t* ka = (ka_t*)__builtin_amdgcn_kernarg_segment_ptr();
    return (const float*)ka[k];
}
__device__ __forceinline__ void transpose_item(const float* W, int N, int k0, int n0, bf16* WT, int Kd, int drow0, LAS float* scr, int lane) {
#pragma unroll 16
    for (int i = 0; i < 32; ++i) { const int kk = 2 * i + (lane >> 5); scr[kk * 33 + (lane & 31)] = W[(size_t)(k0 + kk) * N + n0 + (lane & 31)]; }
    LDS_WAIT(); asm volatile("" ::: "memory");
    const int c = lane & 7;
#pragma unroll
    for (int j = 0; j < 4; ++j) { const int n = (lane >> 3) + 8 * j; const LAS float* s = scr + (8 * c) * 33 + n;
        v4u o; o.x = pk2(s[0 * 33], s[1 * 33]); o.y = pk2(s[2 * 33], s[3 * 33]); o.z = pk2(s[4 * 33], s[5 * 33]); o.w = pk2(s[6 * 33], s[7 * 33]);
        *(GAS v4u*)(WT + (size_t)(drow0 + n) * Kd + k0 + 8 * c) = o; }
    LDS_WAIT(); asm volatile("" ::: "memory");
}
__device__ __forceinline__ void rms_row_to_bf16(const float* xrow, const float* gain, bf16* orow, int lane) {
    const GAS f32x4* xr = (const GAS f32x4*)xrow + lane; const GAS f32x4* gr = (const GAS f32x4*)gain + lane;
    f32x4 v[8]; float s = 0.f;
#pragma unroll
    for (int j = 0; j < 8; ++j) { v[j] = xr[64 * j]; s += (v[j].x * v[j].x + v[j].y * v[j].y) + (v[j].z * v[j].z + v[j].w * v[j].w); }
    const float rstd = 1.0f / sqrtf(wave_sum(s) * (1.f / D) + EPS);
    GAS v2u* o8 = (GAS v2u*)orow + lane;
#pragma unroll
    for (int j = 0; j < 8; ++j) { const f32x4 g = gr[64 * j]; v2u w; w.x = pk2(v[j].x * rstd * g.x, v[j].y * rstd * g.y); w.y = pk2(v[j].z * rstd * g.z, v[j].w * rstd * g.w); o8[64 * j] = w; }
}

__device__ __forceinline__ void p0_prologue(const Frame& F, const Args& a) {
    unsigned char* ws = a.ws;
    LAS float* scr = (LAS float*)(F.lds + F.wave * 16384);
    const int gw = F.vcu * NWAVES + F.wave, NGW = F.G * NWAVES;
    constexpr int I_IN = 32 * (IN_COLS / 32), I_MK = 32 * 32, I_BR = 16 * 64, I_O = 32 * 64;
    constexpr int NITEMS = I_IN + 2 * I_MK + 3 * I_BR + I_O;
    for (int it = gw; it < NITEMS; it += NGW) {
        int r = it;
        if (r < I_IN) { const int nb = IN_COLS / 32, kb = r / nb, n0 = 32 * (r % nb); transpose_item(inp(I_WIN), IN_COLS, 64 * kb, n0, (bf16*)(ws + WS_WIN), D, n0 + (n0 >= RWKV_COLS ? 224 : 0), scr, F.lane); continue; } r -= I_IN;
        if (r < I_MK) { transpose_item(inp(I_WMK), 1024, 64 * (r / 32), 32 * (r % 32), (bf16*)(ws + WS_WMKV), D, 32 * (r % 32), scr, F.lane); continue; } r -= I_MK;
        if (r < I_MK) { transpose_item(inp(I_WMV), 1024, 64 * (r / 32), 32 * (r % 32), (bf16*)(ws + WS_WMKV), D, 1024 + 32 * (r % 32), scr, F.lane); continue; } r -= I_MK;
        if (r < I_BR) { transpose_item(inp(I_WRO), 2048, 64 * (r / 64), 32 * (r % 64), (bf16*)(ws + WS_WBR), 1024, 32 * (r % 64), scr, F.lane); continue; } r -= I_BR;
        if (r < I_BR) { transpose_item(inp(I_WLO), 2048, 64 * (r / 64), 32 * (r % 64), (bf16*)(ws + WS_WBR) + (size_t)2048 * 1024, 1024, 32 * (r % 64), scr, F.lane); continue; } r -= I_BR;
        if (r < I_BR) { transpose_item(inp(I_WXO), 2048, 64 * (r / 64), 32 * (r % 64), (bf16*)(ws + WS_WBR) + (size_t)2 * 2048 * 1024, 1024, 32 * (r % 64), scr, F.lane); continue; } r -= I_BR;
        transpose_item(inp(I_WOUT), 2048, 64 * (r / 64), 32 * (r % 64), (bf16*)(ws + WS_WO), D, 32 * (r % 64), scr, F.lane);
    }
    for (int m = gw; m < T; m += NGW) rms_row_to_bf16(inp(I_X) + (size_t)m * D, inp(I_GMIX), (bf16*)(ws + WS_XN) + (size_t)m * D, F.lane);
    for (int m = gw; m < 512; m += NGW) rms_row_to_bf16(inp(I_MEM) + (size_t)m * D, inp(I_GMEM), (bf16*)(ws + WS_MN) + (size_t)m * D, F.lane);
    const int gt = F.vcu * (NWAVES * 64) + F.tid, NGT = F.G * NWAVES * 64;
    { bf16* wz = (bf16*)(ws + WS_WIN) + (size_t)RWKV_COLS * D; for (int i = gt; i < 224 * D / 2; i += NGT) ((GAS unsigned*)wz)[i] = 0u; }
    { bf16* wl = (bf16*)(ws + WS_WLORA);
      for (int i = gt; i < 3072 * LORA_K; i += NGT) { const int n = i / LORA_K, k = i % LORA_K; float v = 0.f;
          if (n < 1024) { if (k < 64) v = inp(I_W2)[k * 1024 + n]; }
          else if (n < 2048) { if (k >= 64 && k < 128) v = inp(I_A2)[(k - 64) * 1024 + (n - 1024)]; }
          else { if (k >= 128 && k < 288) v = inp(I_G2)[(k - 128) * 1024 + (n - 2048)]; }
          wl[i] = (bf16)f2bf(v); } }
    { bf16* wr = (bf16*)(ws + WS_WR);
      for (int i = gt; i < 32 * D; i += NGT) { const int e = i / D, k = i % D; const float w = inp(I_WROUTER)[k * 32 + e]; const unsigned hi = f2bf(w); const float r = w - __builtin_bit_cast(float, hi << 16);
          wr[i] = (bf16)hi; wr[32 * D + i] = (bf16)f2bf(r); } }
    { const float* lwi_p = inp(I_LWI); const float* lwr_p = inp(I_LWR); bf16* lw = (bf16*)(ws + WS_LW);
      for (int i = gt; i < 2 * 16 * 4 * 2 * 64 * 8; i += NGT) { const int j = i & 7, ln = (i >> 3) & 63, ks = (i >> 9) & 1, vbo = (i >> 10) & 3, n = (i >> 12) & 15, mat = i >> 16;
          const int w = 32 * ks + 16 * (j >> 2) + 4 * (ln >> 4) + (j & 3), v = 16 * vbo + (ln & 15);
          lw[i] = (bf16)f2bf((mat ? lwi_p : lwr_p)[(n * 64 + w) * 64 + v]); } }
}

__device__ __forceinline__ void moe_weight_convert(const Frame& F, const Args& a, int w0) {
    unsigned char* ws = a.ws;
    LAS float* scr = (LAS float*)(F.lds + F.wave * 16384);
    const int nw = NWAVES - w0, gw = F.vcu * nw + (F.wave - w0), NGW = F.G * nw;
    constexpr int PER = 2048;
    for (int it = gw; it < NE * 3 * PER; it += NGW) {
        const int e = it / (3 * PER), r = it % (3 * PER), which = r / PER, q = r % PER, k0 = 64 * (q / 64), n0 = 32 * (q % 64);
        if (which == 0) transpose_item(inp(I_WGATE) + (size_t)e * D * D, D, k0, n0, (bf16*)(ws + WS_WGU) + (size_t)e * 4096 * D, D, (n0 >> 7) * 256 + (n0 & 127), scr, F.lane);
        else if (which == 1) transpose_item(inp(I_WUP) + (size_t)e * D * D, D, k0, n0, (bf16*)(ws + WS_WGU) + (size_t)e * 4096 * D, D, (n0 >> 7) * 256 + 128 + (n0 & 127), scr, F.lane);
        else transpose_item(inp(I_WDOWN) + (size_t)e * D * D, D, k0, n0, (bf16*)(ws + WS_WD) + (size_t)e * 2048 * D, D, n0, scr, F.lane);
    }
}

__device__ __forceinline__ void r1_lora_in(const Frame& F, const Args& a) {
    const bf16* P = (const bf16*)(a.ws + WS_P); bf16* L = (bf16*)(a.ws + WS_XN);
    const float* mu = inp(I_MU);
    const int gw = F.vcu * NWAVES + F.wave, NGW = F.G * NWAVES;
    for (int m = gw; m < T; m += NGW) {
        const bool first = (m % SEQ) == 0;
#pragma unroll
        for (int j = 0; j < 6; ++j) { const int k = F.lane + 64 * j; float o = 0.f;
            if (k < 288) { const int c = 3072 + k; const float cur = bf1(P[(size_t)m * NP + c]); const float prev = first ? 0.f : bf1(P[(size_t)(m - 1) * NP + c]);
                const float x = cur + (prev - cur) * mu[c]; o = k < 64 ? tanhf(x) : (k < 128 ? x : sigm(x)); }
            L[(size_t)m * LORA_K + k] = (bf16)f2bf(o); }
    }
}

__device__ __forceinline__ void r3_scan_inputs(const Frame& F, const Args& a) {
    const bf16* P = (const bf16*)(a.ws + WS_P); const float* LO = (const float*)(a.ws + WS_LORAOUT);
    float* SR = (float*)(a.ws + WS_SCAN); float* SD = SR + (size_t)T * 1024; float* SK = SD + (size_t)T * 1024; float* SV = SK + (size_t)T * 1024; float* SA = SV + (size_t)T * 1024; float* SB = SA + (size_t)T * 1024;
    float* BON = (float*)(a.ws + WS_BONUS);
    const float* mu = inp(I_MU);
    const int gw = F.vcu * NWAVES + F.wave, NGW = F.G * NWAVES;
    for (int m = gw; m < T; m += NGW) {
        const bool first = (m % SEQ) == 0;
        const bf16* pc = P + (size_t)m * NP; const bf16* pp = P + (size_t)(m - (first ? 0 : 1)) * NP;
        for (int h = 0; h < 16; ++h) { const int c = h * 64 + F.lane;
            const float cr = bf1(pc[c]), ck = bf1(pc[1024 + c]), cv = bf1(pc[2048 + c]);
            const float qr = first ? 0.f : bf1(pp[c]), qk = first ? 0.f : bf1(pp[1024 + c]), qv = first ? 0.f : bf1(pp[2048 + c]);
            const float r = cr + (qr - cr) * mu[c], k = ck + (qk - ck) * mu[1024 + c], v = cv + (qv - cv) * mu[2048 + c];
            const float wpre = inp(I_W0)[c] + LO[(size_t)m * 3072 + c];
            const float w = -softplusf(-wpre) - 0.5f; const float dec = __expf(-__expf(w));
            const float ag = sigm(inp(I_A0)[c] + LO[(size_t)m * 3072 + 1024 + c]);
            const float kk = k * inp(I_KK)[c]; const float ss = wave_sum(kk * kk); const float kkn = kk * (1.0f / sqrtf(fmaxf(ss, 1e-24f)));
            const float km = k * (1.0f + (ag - 1.0f) * inp(I_KA)[c]);
            const float bo = wave_sum(r * km * inp(I_RK)[c]);
            const size_t o = (size_t)m * 1024 + c;
            SR[o] = r; SD[o] = dec; SK[o] = km; SV[o] = v; SA[o] = -kkn; SB[o] = kkn * ag;
            if (F.lane == 0) BON[m * 16 + h] = bo; }
    }
}

__device__ __forceinline__ void r4_scan(const Frame& F, const Args& a) {
    const GAS char* SR = (const GAS char*)(a.ws + WS_SCAN); constexpr size_t ASZ = (size_t)T * 1024 * 4;
    float* YT = (float*)(a.ws + WS_XN);
    constexpr int DEPTH = 4;
    for (int rb = F.vcu; rb < 256; rb += F.G) {
        const int row = rb * 8 + F.wave * 4 + (F.lane >> 4), ksub = F.lane & 15, bh = rb >> 3, vi = row & 63, b = bh >> 4, h = bh & 15;
        const size_t base = ((size_t)b * SEQ * 1024 + h * 64) * 4;
        const GAS char* pr = SR + base; const GAS char* pd = SR + ASZ + base; const GAS char* pk = SR + 2 * ASZ + base; const GAS char* pv = SR + 3 * ASZ + base; const GAS char* pa = SR + 4 * ASZ + base; const GAS char* pb = SR + 5 * ASZ + base;
        const unsigned lo16 = (unsigned)ksub * 16u, lov = (unsigned)vi * 4u;
#define SC_LD4(dst, p, t) do { const GAS char* q_ = (p) + (size_t)(t) * 4096; asm volatile("" : "+s"(q_)); dst = *(const GAS f32x4*)(q_ + lo16); } while (0)
#define SC_LD1(dst, p, t) do { const GAS char* q_ = (p) + (size_t)(t) * 4096; asm volatile("" : "+s"(q_)); dst = *(const GAS float*)(q_ + lov); } while (0)
        f32x4 bd[DEPTH], bk[DEPTH], ba[DEPTH], bb[DEPTH], br[DEPTH]; float bv[DEPTH];
#pragma unroll
        for (int u = 0; u < DEPTH; ++u) { SC_LD4(bd[u], pd, u); SC_LD4(bk[u], pk, u); SC_LD4(ba[u], pa, u); SC_LD4(bb[u], pb, u); SC_LD4(br[u], pr, u); SC_LD1(bv[u], pv, u); }
        f32x4 S = {0.f, 0.f, 0.f, 0.f}; float ykeep = 0.f;
        GAS float* yrow = (GAS float*)YT + (size_t)row * SEQ;
#pragma unroll 1
        for (int t0 = 0; t0 < SEQ; t0 += 16) {
#pragma unroll
            for (int u = 0; u < 16; ++u) { const int s = u % DEPTH;
                const f32x4 d4 = bd[s], k4 = bk[s], a4 = ba[s], b4 = bb[s], r4 = br[s]; const float vv = bv[s];
                { const int tn = t0 + u + DEPTH;
                  SC_LD4(bd[s], pd, tn); SC_LD4(bk[s], pk, tn); SC_LD4(ba[s], pa, tn); SC_LD4(bb[s], pb, tn); SC_LD4(br[s], pr, tn); SC_LD1(bv[s], pv, tn); }
                float sa = (S[0] * a4[0] + S[1] * a4[1]) + (S[2] * a4[2] + S[3] * a4[3]);
                sa = row16_sum(sa);
#pragma unroll
                for (int i = 0; i < 4; ++i) S[i] = S[i] * d4[i] + (sa * b4[i] + vv * k4[i]);
                float y = (S[0] * r4[0] + S[1] * r4[1]) + (S[2] * r4[2] + S[3] * r4[3]);
                y = row16_sum(y);
                ykeep = (ksub == u) ? y : ykeep;
                asm volatile("" : "+v"(S[0]), "+v"(S[1]), "+v"(S[2]), "+v"(S[3]), "+v"(ykeep) :: "memory"); }
            yrow[t0 + ksub] = ykeep;
        }
#undef SC_LD4
#undef SC_LD1
    }
}

__device__ __forceinline__ void r5_finish(const Frame& F, const Args& a) {
    const float* YT = (const float*)(a.ws + WS_XN); const float* LO = (const float*)(a.ws + WS_LORAOUT); const float* SV = (const float*)(a.ws + WS_SCAN) + (size_t)3 * T * 1024; const float* BON = (const float*)(a.ws + WS_BONUS);
    bf16* YA = (bf16*)(a.ws + WS_YABC);
    LAS float* scr = (LAS float*)(F.lds + F.wave * 16640);
    const int gw = F.vcu * NWAVES + F.wave, NGW = F.G * NWAVES;
    for (int it = gw; it < 32 * 128; it += NGW) {
        const int bh = it >> 7, tt = it & 127, t0 = tt * 64, b = bh >> 4, h = bh & 15;
        float y[64]; float s = 0.f;
#pragma unroll
        for (int v = 0; v < 64; ++v) { y[v] = YT[(size_t)(bh * 64 + v) * SEQ + t0 + F.lane]; s += y[v]; }
        const float mean = s * (1.f / 64.f); float q = 0.f;
#pragma unroll
        for (int v = 0; v < 64; ++v) { const float d = y[v] - mean; q += d * d; }
        const float rstd = 1.0f / sqrtf(q * (1.f / 64.f) + GN_EPS);
#pragma unroll
        for (int v = 0; v < 64; ++v) scr[F.lane * 65 + v] = (y[v] - mean) * rstd;
        LDS_WAIT(); asm volatile("" ::: "memory");
        const int c = h * 64 + F.lane; const float lw = inp(I_LNW)[c], lb = inp(I_LNB)[c];
        for (int ti = 0; ti < 64; ++ti) { const int m = b * SEQ + t0 + ti;
            const float yn = scr[ti * 65 + F.lane];
            const float o = (yn * lw + lb + BON[m * 16 + h] * SV[(size_t)m * 1024 + c]) * LO[(size_t)m * 3072 + 2048 + c];
            YA[(size_t)m * 1024 + c] = (bf16)f2bf(o); }
        LDS_WAIT(); asm volatile("" ::: "memory");
    }
}

__device__ __forceinline__ float gelu_tanh(float x) { const float u = 0.7978845608028654f * (x + 0.044715f * x * x * x); const float t = 1.0f - 2.0f / (1.0f + __expf(2.0f * u)); return 0.5f * x * (1.0f + t); }
template <int CTRL> __device__ __forceinline__ float dpp_keep(float old, float x) { return __builtin_bit_cast(float, __builtin_amdgcn_update_dpp(__builtin_bit_cast(int, old), __builtin_bit_cast(int, x), CTRL, 0xf, 0xf, false)); }
template <bool FINAL> __device__ __forceinline__ void lru_pass(const Frame& F, const Args& a) {
    const bf16* P = (const bf16*)(a.ws + WS_P); const bf16* LW = (const bf16*)(a.ws + WS_LW);
    float* CA = (float*)(a.ws + WS_LRUC); float* CB = CA + 256 * 1024; const float* HIN = CB + 256 * 1024;
    bf16* YB = (bf16*)(a.ws + WS_YABC) + (size_t)T * 1024;
    const int gw = F.vcu * NWAVES + F.wave, NGW = F.G * NWAVES, tq = F.lane & 15, kq = F.lane >> 4;
    for (int it = gw; it < 256 * 16; it += NGW) {
        const int tt = it >> 4, n = it & 15, m0 = tt * 64, cb = n * 64 + 4 * kq;
        const bool seq0 = (m0 % SEQ) == 0;
        float hcar[4][4];
        float aprod[4][4];
#pragma unroll
        for (int vb = 0; vb < 4; ++vb)
#pragma unroll
            for (int i = 0; i < 4; ++i) { hcar[vb][i] = FINAL ? HIN[tt * 1024 + cb + 16 * vb + i] : 0.f; aprod[vb][i] = 1.f; }
        for (int tb = 0; tb < 4; ++tb) {
            const int m = m0 + 16 * tb + tq, tseq = m % SEQ;
            f32x4 xc[4];
#pragma unroll
            for (int vb = 0; vb < 4; ++vb) { const int c = cb + 16 * vb; f32x4 acc = *(const f32x4*)(inp(I_CONVB) + c);
#pragma unroll
                for (int j = 0; j < 4; ++j) { if (tseq - j >= 0) { const v2u pw = *(const v2u*)(P + (size_t)(m - j) * NP + PC_LX + c); const f32x4 cw = *(const f32x4*)(inp(I_CONVW) + j * 1024 + c);
                        acc[0] += cw[0] * bflo(pw.x); acc[1] += cw[1] * bfhi(pw.x); acc[2] += cw[2] * bflo(pw.y); acc[3] += cw[3] * bfhi(pw.y); } }
                xc[vb] = acc; }
            bf16x8 bfrag[2];
#pragma unroll
            for (int ks = 0; ks < 2; ++ks) { v4u w; w.x = pk2(xc[2 * ks][0], xc[2 * ks][1]); w.y = pk2(xc[2 * ks][2], xc[2 * ks][3]); w.z = pk2(xc[2 * ks + 1][0], xc[2 * ks + 1][1]); w.w = pk2(xc[2 * ks + 1][2], xc[2 * ks + 1][3]); bfrag[ks] = __builtin_bit_cast(bf16x8, w); }
#pragma unroll
            for (int vb = 0; vb < 4; ++vb) {
                f32x4 gr = {0.f, 0.f, 0.f, 0.f}, gi = {0.f, 0.f, 0.f, 0.f};
#pragma unroll
                for (int ks = 0; ks < 2; ++ks) { const bf16x8 wr_ = *(const bf16x8*)(LW + ((((size_t)(0 * 16 + n) * 4 + vb) * 2 + ks) * 64 + F.lane) * 8); const bf16x8 wi_ = *(const bf16x8*)(LW + ((((size_t)(1 * 16 + n) * 4 + vb) * 2 + ks) * 64 + F.lane) * 8);
                    gr = __builtin_amdgcn_mfma_f32_16x16x32_bf16(wr_, bfrag[ks], gr, 0, 0, 0); gi = __builtin_amdgcn_mfma_f32_16x16x32_bf16(wi_, bfrag[ks], gi, 0, 0, 0); }
                const int c = cb + 16 * vb;
                const f32x4 brv = *(const f32x4*)(inp(I_LBR) + c), biv = *(const f32x4*)(inp(I_LBI) + c), lam = *(const f32x4*)(inp(I_LAM) + c);
                v2u pyw; if (FINAL) pyw = *(const v2u*)(P + (size_t)m * NP + PC_LY + c);
                float hout[4];
#pragma unroll
                for (int i = 0; i < 4; ++i) {
                    const float g_r = sigm(gr[i] + brv[i]), g_i = sigm(gi[i] + biv[i]);
                    const float log_a = -8.0f * g_r * softplusf(-lam[i]);
                    float av = __expf(log_a); float mult = sqrtf(fmaxf(1.0f - __expf(2.0f * log_a), 0.f)); if (tseq == 0) mult = 1.0f;
                    float bv = mult * g_i * xc[vb][i];
                    { float pa = dpp_keep<0x111>(1.0f, av), pb = dpp_keep<0x111>(0.0f, bv); bv = av * pb + bv; av = av * pa; }
                    { float pa = dpp_keep<0x112>(1.0f, av), pb = dpp_keep<0x112>(0.0f, bv); bv = av * pb + bv; av = av * pa; }
                    { float pa = dpp_keep<0x114>(1.0f, av), pb = dpp_keep<0x114>(0.0f, bv); bv = av * pb + bv; av = av * pa; }
                    { float pa = dpp_keep<0x118>(1.0f, av), pb = dpp_keep<0x118>(0.0f, bv); bv = av * pb + bv; av = av * pa; }
                    const float hv = bv + av * hcar[vb][i];
                    const int l15 = (F.lane & 48) | 15;
                    const float hend = __shfl(hv, l15), aend = __shfl(av, l15);
                    hcar[vb][i] = hend; aprod[vb][i] *= aend; hout[i] = hv; }
                if (FINAL) { const float y0 = hout[0] * gelu_tanh(bflo(pyw.x)), y1 = hout[1] * gelu_tanh(bfhi(pyw.x)), y2 = hout[2] * gelu_tanh(bflo(pyw.y)), y3 = hout[3] * gelu_tanh(bfhi(pyw.y));
                    v2u w; w.x = pk2(y0, y1); w.y = pk2(y2, y3); *(v2u*)(YB + (size_t)m * 1024 + c) = w; }
            }
        }
        if (!FINAL && tq == 0) {
#pragma unroll
            for (int vb = 0; vb < 4; ++vb) { f32x4 pa, pb;
#pragma unroll
                for (int i = 0; i < 4; ++i) { pa[i] = aprod[vb][i]; pb[i] = hcar[vb][i]; }
                *(f32x4*)(CA + tt * 1024 + cb + 16 * vb) = pa; *(f32x4*)(CB + tt * 1024 + cb + 16 * vb) = pb; }
        }
        (void)seq0;
    }
}
__device__ __forceinline__ void lru_carry(const Frame& F, const Args& a) {
    const float* CA = (const float*)(a.ws + WS_LRUC); const float* CB = CA + 256 * 1024; float* HIN = (float*)CB + 256 * 1024;
    const int gt = F.vcu * (NWAVES * 64) + F.tid;
    if (gt < 2048) { const int b = gt >> 10, c = gt & 1023; float h = 0.f;
        for (int k = 0; k < 128; ++k) { const int tt = b * 128 + k; HIN[tt * 1024 + c] = h; h = CA[tt * 1024 + c] * h + CB[tt * 1024 + c]; } }
}

__device__ __forceinline__ void xattn_phase(const Frame& F, const Args& a) {
    const bf16* P = (const bf16*)(a.ws + WS_P); const bf16* KM = (const bf16*)(a.ws + WS_KMEM); const bf16* VT = (const bf16*)(a.ws + WS_VT);
    bf16* YC = (bf16*)(a.ws + WS_YABC) + (size_t)2 * T * 1024;
    const int gw = F.vcu * NWAVES + F.wave, NGW = F.G * NWAVES, tq = F.lane & 15, kq = F.lane >> 4;
    for (int it = gw; it < 4 * 1024; it += NGW) {
        const int h = it >> 10, tg = it & 1023, m0 = tg * 16, b = m0 / SEQ;
        bf16x8 qf[8];
#pragma unroll
        for (int ks = 0; ks < 8; ++ks) qf[ks] = *(const bf16x8*)(P + (size_t)(m0 + tq) * NP + PC_Q + h * 256 + 32 * ks + 8 * kq);
        f32x4 s[16];
#pragma unroll
        for (int mb = 0; mb < 16; ++mb) { f32x4 acc = {0.f, 0.f, 0.f, 0.f}; const bf16* kp = KM + (size_t)(b * 256 + 16 * mb + tq) * 1024 + h * 256 + 8 * kq;
#pragma unroll
            for (int ks = 0; ks < 8; ++ks) acc = __builtin_amdgcn_mfma_f32_16x16x32_bf16(*(const bf16x8*)(kp + 32 * ks), qf[ks], acc, 0, 0, 0);
            s[mb] = acc; asm volatile("" ::: "memory"); }
        float mx = -3.0e38f;
#pragma unroll
        for (int mb = 0; mb < 16; ++mb) { s[mb] = s[mb] * 0.0625f; mx = fmaxf(mx, fmaxf(fmaxf(s[mb][0], s[mb][1]), fmaxf(s[mb][2], s[mb][3]))); }
        mx = fmaxf(mx, __shfl_xor(mx, 16)); mx = fmaxf(mx, __shfl_xor(mx, 32));
        float sum = 0.f;
#pragma unroll
        for (int mb = 0; mb < 16; ++mb) {
#pragma unroll
            for (int i = 0; i < 4; ++i) { s[mb][i] = __expf(s[mb][i] - mx); sum += s[mb][i]; } }
        sum += __shfl_xor(sum, 16); sum += __shfl_xor(sum, 32);
        const float inv = 1.0f / sum;
        bf16x8 pf[8];
#pragma unroll
        for (int ks = 0; ks < 8; ++ks) { v4u w; w.x = pk2(s[2 * ks][0] * inv, s[2 * ks][1] * inv); w.y = pk2(s[2 * ks][2] * inv, s[2 * ks][3] * inv); w.z = pk2(s[2 * ks + 1][0] * inv, s[2 * ks + 1][1] * inv); w.w = pk2(s[2 * ks + 1][2] * inv, s[2 * ks + 1][3] * inv); pf[ks] = __builtin_bit_cast(bf16x8, w); }
#pragma unroll
        for (int db = 0; db < 16; ++db) { f32x4 acc = {0.f, 0.f, 0.f, 0.f}; const bf16* vp = VT + ((size_t)((b * 4 + h) * 256 + 16 * db + tq)) * 256 + 8 * kq;
#pragma unroll
            for (int ks = 0; ks < 8; ++ks) acc = __builtin_amdgcn_mfma_f32_16x16x32_bf16(*(const bf16x8*)(vp + 32 * ks), pf[ks], acc, 0, 0, 0);
            v2u w; w.x = pk2(acc[0], acc[1]); w.y = pk2(acc[2], acc[3]);
            *(v2u*)(YC + (size_t)(m0 + tq) * 1024 + h * 256 + 16 * db + 4 * kq) = w; asm volatile("" ::: "memory"); }
    }
}

__device__ __forceinline__ void router_phase(const Frame& F, const Args& a) {
    const float* H1 = (const float*)(a.ws + WS_H1); bf16* XN2 = (bf16*)(a.ws + WS_XN); const bf16* WR = (const bf16*)(a.ws + WS_WR);
    int* pick_e = (int*)(a.ws + WS_PICK); int* pick_rank = pick_e + 65536; float* pick_gate = (float*)(pick_rank + 65536);
    unsigned* gcnt = (unsigned*)(a.ws + WS_CTL) + CW_CNT;
    LAS float* lg = (LAS float*)(F.lds + F.wave * 4096);
    LAS unsigned* lcnt = (LAS unsigned*)(F.lds + 65536);
    const int tq = F.lane & 15, kq = F.lane >> 4;
    for (int g0 = F.vcu * 4; g0 < 1024; g0 += F.G * 4) {
        if (F.tid < 64) lcnt[F.tid] = 0u;
        __syncthreads();
        int me = 0, mrank = 0; float mgate = 0.f; int e4[4]; float g4[4]; int r4[4];
        const int m0 = (g0 + F.wave) * 16;
        if (F.wave < 4) {
            float myr = 0.f;
            for (int j = 0; j < 16; ++j) { const GAS f32x4* xr = (const GAS f32x4*)(H1 + (size_t)(m0 + j) * D) + F.lane; float s = 0.f;
#pragma unroll
                for (int q = 0; q < 8; ++q) { const f32x4 v = xr[64 * q]; s += (v.x * v.x + v.y * v.y) + (v.z * v.z + v.w * v.w); }
                const float rs = 1.0f / sqrtf(wave_sum(s) * (1.f / D) + EPS); if (tq == j) myr = rs; }
            f32x4 acc[2] = {{0.f, 0.f, 0.f, 0.f}, {0.f, 0.f, 0.f, 0.f}};
            const float* hrow = H1 + (size_t)(m0 + tq) * D + 8 * kq; const float* grow = inp(I_GFFN) + 8 * kq; bf16* xrow = XN2 + (size_t)(m0 + tq) * D + 8 * kq;
            for (int ks = 0; ks < 64; ++ks) {
                const f32x4 x0 = *(const f32x4*)(hrow + 32 * ks), x1 = *(const f32x4*)(hrow + 32 * ks + 4), g0v = *(const f32x4*)(grow + 32 * ks), g1v = *(const f32x4*)(grow + 32 * ks + 4);
                v4u w; w.x = pk2(x0[0] * myr * g0v[0], x0[1] * myr * g0v[1]); w.y = pk2(x0[2] * myr * g0v[2], x0[3] * myr * g0v[3]); w.z = pk2(x1[0] * myr * g1v[0], x1[1] * myr * g1v[1]); w.w = pk2(x1[2] * myr * g1v[2], x1[3] * myr * g1v[3]);
                *(v4u*)(xrow + 32 * ks) = w; const bf16x8 af = __builtin_bit_cast(bf16x8, w);
#pragma unroll
                for (int eh = 0; eh < 2; ++eh) { const bf16* wp = WR + (size_t)(16 * eh + tq) * D + 32 * ks + 8 * kq;
                    acc[eh] = __builtin_amdgcn_mfma_f32_16x16x32_bf16(af, *(const bf16x8*)wp, acc[eh], 0, 0, 0);
                    acc[eh] = __builtin_amdgcn_mfma_f32_16x16x32_bf16(af, *(const bf16x8*)(wp + 32 * D), acc[eh], 0, 0, 0); } }
#pragma unroll
            for (int eh = 0; eh < 2; ++eh)
#pragma unroll
                for (int i = 0; i < 4; ++i) lg[(4 * kq + i) * 33 + 16 * eh + tq] = acc[eh][i] + inp(I_BROUTER)[16 * eh + tq];
            LDS_WAIT(); asm volatile("" ::: "memory");
            if (F.lane < 16) { float v[32];
#pragma unroll
                for (int e = 0; e < 32; ++e) v[e] = lg[F.lane * 33 + e];
                float tv[4];
#pragma unroll
                for (int k = 0; k < 4; ++k) { float best = -3.0e38f; int bi = 0;
#pragma unroll
                    for (int e = 0; e < 32; ++e) { if (v[e] > best) { best = v[e]; bi = e; } }
                    tv[k] = best; e4[k] = bi;
#pragma unroll
                    for (int e = 0; e < 32; ++e) { if (e == bi) v[e] = -3.0e38f; } }
                float den = 0.f;
#pragma unroll
                for (int k = 0; k < 4; ++k) { g4[k] = __expf(tv[k] - tv[0]); den += g4[k]; }
#pragma unroll
                for (int k = 0; k < 4; ++k) { g4[k] = g4[k] / den; r4[k] = (int)atomicAdd((unsigned*)&lcnt[e4[k]], 1u); } }
        }
        __syncthreads();
        if (F.tid < 32) lcnt[32 + F.tid] = atomicAdd(&gcnt[F.tid], lcnt[F.tid]);
        __syncthreads();
        if (F.wave < 4 && F.lane < 16) {
#pragma unroll
            for (int k = 0; k < 4; ++k) { const int pi = (m0 + F.lane) * 4 + k; pick_e[pi] = e4[k]; pick_rank[pi] = (int)lcnt[32 + e4[k]] + r4[k]; pick_gate[pi] = g4[k]; } }
        __syncthreads();
        (void)me; (void)mrank; (void)mgate;
    }
}

__device__ __forceinline__ void scatter_phase(const Frame& F, const Args& a) {
    const bf16* XN2 = (const bf16*)(a.ws + WS_XN); bf16* XS = (bf16*)(a.ws + WS_XS);
    const int* pick_e = (const int*)(a.ws + WS_PICK); const int* pick_rank = pick_e + 65536; const float* pick_gate = (const float*)(pick_rank + 65536); int* pos = (int*)(pick_gate + 65536);
    float* gate_of_row = (float*)(a.ws + WS_ROWTAB);
    unsigned* ctl = (unsigned*)(a.ws + WS_CTL);
    LAS int* pst = (LAS int*)(F.lds);
    if (F.tid == 0) { int acc = 0; for (int e = 0; e < NE; ++e) { pst[e] = acc; const int c = (int)ctl[CW_CNT + e]; const int nt = (c + 255) >> 8;
            if (blockIdx.x == 0) for (int k = 0; k < nt; ++k) ctl[CW_TILEE + (acc >> 8) + k] = (unsigned)e;
            acc += nt << 8; }
        if (blockIdx.x == 0) ctl[CW_NTILES] = (unsigned)(acc >> 8); }
    __syncthreads();
    const int gw = F.vcu * NWAVES + F.wave, NGW = F.G * NWAVES;
    for (int pi = gw; pi < 65536; pi += NGW) {
        const int e = pick_e[pi], row = pst[e] + pick_rank[pi], tok = pi >> 2;
        if (F.lane == 0) { pos[pi] = row; gate_of_row[row] = pick_gate[pi]; }
        const GAS v4u* src = (const GAS v4u*)(XN2 + (size_t)tok * D) + F.lane; GAS v4u* dst = (GAS v4u*)(XS + (size_t)row * D) + F.lane;
#pragma unroll
        for (int q = 0; q < 4; ++q) dst[64 * q] = src[64 * q];
    }
}

__device__ __forceinline__ void final_phase(const Frame& F, const Args& a) {
    const float* H1 = (const float*)(a.ws + WS_H1); const bf16* OR = (const bf16*)(a.ws + WS_OROW);
    const int* pos = (const int*)(a.ws + WS_PICK) + 3 * 65536;
    const int gw = F.vcu * NWAVES + F.wave, NGW = F.G * NWAVES;
    for (int m = gw; m < T; m += NGW) {
        const GAS f32x4* xr = (const GAS f32x4*)(H1 + (size_t)m * D) + F.lane; const GAS f32x4* gr = (const GAS f32x4*)inp(I_GFINAL) + F.lane;
        f32x4 v[8];
#pragma unroll
        for (int j = 0; j < 8; ++j) v[j] = xr[64 * j];
#pragma unroll
        for (int k = 0; k < 4; ++k) { const int row = pos[m * 4 + k]; const GAS v2u* orp = (const GAS v2u*)(OR + (size_t)row * D) + F.lane;
#pragma unroll
            for (int j = 0; j < 8; ++j) { const v2u w = orp[64 * j]; v[j].x += bflo(w.x); v[j].y += bfhi(w.x); v[j].z += bflo(w.y); v[j].w += bfhi(w.y); } }
        float s = 0.f;
#pragma unroll
        for (int j = 0; j < 8; ++j) s += (v[j].x * v[j].x + v[j].y * v[j].y) + (v[j].z * v[j].z + v[j].w * v[j].w);
        const float rstd = 1.0f / sqrtf(wave_sum(s) * (1.f / D) + EPS);
        GAS f32x4* o = (GAS f32x4*)(a.out + (size_t)m * D) + F.lane;
#pragma unroll
        for (int j = 0; j < 8; ++j) { const f32x4 g = gr[64 * j]; o[64 * j] = (f32x4){v[j].x * rstd * g.x, v[j].y * rstd * g.y, v[j].z * rstd * g.z, v[j].w * rstd * g.w}; }
    }
}

#ifndef MK_N_LAUNCHES
#define MK_N_LAUNCHES 1
#endif
constexpr int NPH = 14;
__global__ void __launch_bounds__(NWAVES * 64, 2) fwd(Args args) {
    extern __shared__ __attribute__((aligned(16))) unsigned char lds[];
#define NEWFRAME() Frame F; { int tz = threadIdx.x; asm volatile("" : "+v"(tz)); F.lds = (LAS unsigned char*)lds; F.MISC = (volatile LAS unsigned*)(F.lds + MISC_OFF); F.tid = tz; F.lane = tz & 63; F.wave = __builtin_amdgcn_readfirstlane(tz >> 6); \
        F.G = gridDim.x; const int bx = blockIdx.x; F.vcu = (F.G % 8 == 0) ? (bx % 8) * (F.G / 8) + bx / 8 : bx; }
    unsigned char* ws = args.ws;
    unsigned* ctl = (unsigned*)(ws + WS_CTL);
    for (int u = threadIdx.x; u < (LDS_BYTES - MISC_OFF) / 4; u += NWAVES * 64) ((LAS unsigned*)((LAS unsigned char*)lds + MISC_OFF))[u] = 0u;
    __syncthreads();
    const int lo = args.ph_lo, hi = args.ph_hi;
    XcdBarrier bar; bar.bar = ctl + CW_BAR; bar.x = 0; bar.st = nullptr;
    if (hi - lo > 1) bar = xcd_barrier_post(ctl + CW_BAR, (volatile LAS unsigned*)((LAS unsigned char*)lds + MISC_OFF) + 8);
#ifndef PHMASK
#define PHMASK 0xFFFF
#endif
#define IN(k) (((PHMASK >> (k)) & 1) && lo <= (k) && (k) < hi)
#define SEAM(k) do { if (IN(k) && IN((k) + 1)) xcd_barrier(bar); } while (0)

    if (IN(0)) { NEWFRAME(); p0_prologue(F, args); } SEAM(0);
    if (IN(1)) { NEWFRAME();
        { pg8::Gemm g{(const bf16*)(ws + WS_XN), (const bf16*)(ws + WS_WIN), T, NP, D}; pg8::StaticOrder S; S.init(T, NP, F.G, (int)blockIdx.x);
          pg8::EpiBf16<0> E{(bf16*)(ws + WS_P), NP, nullptr, 0, 0, 1.f};
          pg8::gemm_phase<pg8::EpiBf16<0>, pg8::StaticOrder, true, true>(F.lds, g, S, E); }
        __syncthreads();
        { pg8::Gemm g{(const bf16*)(ws + WS_MN), (const bf16*)(ws + WS_WMKV), 512, 2048, D}; pg8::StaticOrder S; S.init(512, 2048, F.G, (int)((blockIdx.x + F.G / 2) % F.G));
          pg8::EpiKV E{(bf16*)(ws + WS_KMEM), (bf16*)(ws + WS_VT)};
          pg8::gemm_phase<pg8::EpiKV, pg8::StaticOrder, true, true>(F.lds, g, S, E); }
    } SEAM(1);
    if (IN(2)) { NEWFRAME();
#ifndef NO_R1
 r1_lora_in(F, args);
#endif
#ifndef NO_LRU
 lru_pass<false>(F, args);
#endif
#ifndef NO_XA
 xattn_phase(F, args);
#endif
 } SEAM(2);
    if (IN(3)) { NEWFRAME();
        lru_carry(F, args);
        { pg8::Gemm g{(const bf16*)(ws + WS_XN), (const bf16*)(ws + WS_WLORA), T, 3072, LORA_K}; pg8::StaticOrder S; S.init(T, 3072, F.G, (int)blockIdx.x);
          pg8::EpiF32 E{(float*)(ws + WS_LORAOUT), 3072};
          pg8::gemm_phase<pg8::EpiF32, pg8::StaticOrder, true, true>(F.lds, g, S, E); }
    } SEAM(3);
    if (IN(4)) { NEWFRAME(); r3_scan_inputs(F, args); lru_pass<true>(F, args); } SEAM(4);
    if (IN(5)) { NEWFRAME();
#ifndef NO_SCAN
 if (F.wave < 2) r4_scan(F, args);
#endif
#ifndef NO_CONV
 if (F.wave >= 2) moe_weight_convert(F, args, 2);
#endif
 } SEAM(5);
    if (IN(6)) { NEWFRAME(); r5_finish(F, args); } SEAM(6);
    if (IN(7)) { NEWFRAME();
        pg8::Gemm g{(const bf16*)(ws + WS_YABC), (const bf16*)(ws + WS_WBR), 3 * T, 3 * 2048, 1024}; pg8::BranchOrder S; S.init(F.G, (int)blockIdx.x);
        pg8::EpiBranch E{(const bf16*)(ws + WS_P), NP, PC_G, (float*)(ws + WS_MACC), (bf16*)(ws + WS_MERGED)};
        pg8::gemm_phase<pg8::EpiBranch, pg8::BranchOrder, true, true>(F.lds, g, S, E);
    } SEAM(7);
    if (IN(8)) { NEWFRAME();
        pg8::Gemm g{(const bf16*)(ws + WS_MERGED), (const bf16*)(ws + WS_WO), T, D, D}; pg8::StaticOrder S; S.init(T, D, F.G, (int)blockIdx.x);
        pg8::EpiRes E{inp(I_X), (float*)(ws + WS_H1), D};
        pg8::gemm_phase<pg8::EpiRes, pg8::StaticOrder, true, true>(F.lds, g, S, E);
    } SEAM(8);
    if (IN(9)) { NEWFRAME(); router_phase(F, args); } SEAM(9);
    if (IN(10)) { NEWFRAME(); scatter_phase(F, args); } SEAM(10);
    if (IN(11)) { NEWFRAME();
        const int ntiles = (int)__hip_atomic_load(ctl + CW_NTILES, __ATOMIC_RELAXED, __HIP_MEMORY_SCOPE_AGENT);
        pg8::Gemm g{(const bf16*)(ws + WS_XS), (const bf16*)(ws + WS_WGU), ntiles * 256, NE * 4096, D}; pg8::MoeOrder S; S.init(ntiles, 16, F.G, (int)blockIdx.x, (const int*)(ctl + CW_TILEE));
        pg8::EpiSwiglu E{(bf16*)(ws + WS_HH), inp(I_BGATE), inp(I_BUP)};
        pg8::gemm_phase<pg8::EpiSwiglu, pg8::MoeOrder, true, true>(F.lds, g, S, E);
    } SEAM(11);
    if (IN(12)) { NEWFRAME();
        const int ntiles = (int)__hip_atomic_load(ctl + CW_NTILES, __ATOMIC_RELAXED, __HIP_MEMORY_SCOPE_AGENT);
        pg8::Gemm g{(const bf16*)(ws + WS_HH), (const bf16*)(ws + WS_WD), ntiles * 256, NE * 2048, D}; pg8::MoeOrder S; S.init(ntiles, 8, F.G, (int)blockIdx.x, (const int*)(ctl + CW_TILEE));
        pg8::EpiDown E{(bf16*)(ws + WS_OROW), inp(I_BDOWN), (const float*)(ws + WS_ROWTAB)};
        pg8::gemm_phase<pg8::EpiDown, pg8::MoeOrder, true, true>(F.lds, g, S, E);
    } SEAM(12);
    if (IN(13)) { NEWFRAME(); final_phase(F, args); }
#undef IN
#undef SEAM
}

extern "C" void kernel_launch(void* const* d_in, const int* in_sizes, int n_in, void* d_out, int out_size, void* d_ws, size_t ws_size, hipStream_t stream) {
    static int grid = 0;
    if (grid == 0) {
        if (n_in != 39 || out_size != T * D || ws_size < WS_END) { fprintf(stderr, "kernel_launch: built for 39 inputs, out of %d floats, >= %zu bytes of workspace; got n_in %d, out %d, ws %zu; nothing launched\n", T * D, (size_t)WS_END, n_in, out_size, ws_size); grid = -1; return; }
        int dev = 0, cus = 0, per_cu = 0;
        if (hipGetDevice(&dev) != hipSuccess || hipDeviceGetAttribute(&cus, hipDeviceAttributeMultiprocessorCount, dev) != hipSuccess) { fprintf(stderr, "kernel_launch: device query failed\n"); grid = -1; return; }
        if (hipFuncSetAttribute((const void*)fwd, hipFuncAttributeMaxDynamicSharedMemorySize, LDS_BYTES) != hipSuccess) { fprintf(stderr, "kernel_launch: hipFuncSetAttribute failed\n"); grid = -1; return; }
        if (hipOccupancyMaxActiveBlocksPerMultiprocessor(&per_cu, (const void*)fwd, NWAVES * 64, LDS_BYTES) != hipSuccess || per_cu < 1)
            fprintf(stderr, "kernel_launch: note: occupancy query reports %d workgroups per CU\n", per_cu);
        (void)hipGetLastError();
        grid = cus;
    }
    if (grid < 0) return;
    (void)in_sizes;
    if (hipMemsetAsync((char*)d_ws + WS_CTL, 0, CTL_ZERO_BYTES, stream) != hipSuccess) { fprintf(stderr, "kernel_launch: hipMemsetAsync failed\n"); return; }
    Args a{};
    for (int i = 0; i < 39; ++i) a.in[i] = (const float*)d_in[i];
    a.out = (float*)d_out; a.ws = (unsigned char*)d_ws;
#if MK_N_LAUNCHES == 1
    a.ph_lo = 0; a.ph_hi = NPH;
    hipLaunchKernelGGL(fwd, dim3(grid), dim3(NWAVES * 64), LDS_BYTES, stream, a);
#else
    for (int k = 0; k < NPH; ++k) { a.ph_lo = k; a.ph_hi = k + 1; hipLaunchKernelGGL(fwd, dim3(grid), dim3(NWAVES * 64), LDS_BYTES, stream, a); }
#endif
    const hipError_t le = hipPeekAtLastError();
    if (le != hipSuccess) fprintf(stderr, "kernel_launch: launch failed: %s\n", hipGetErrorName(le));
}
```

```cpp
#include <hip/hip_runtime.h>
#include <cstdio>
#include <cstdint>
namespace pg8 {
#define PG8_LAS __attribute__((address_space(3)))
typedef unsigned short bf16_t;
typedef short bf16x8 __attribute__((ext_vector_type(8)));
typedef float f32x4 __attribute__((ext_vector_type(4)));
typedef unsigned u32x4 __attribute__((ext_vector_type(4)));
constexpr int BM = 256, BK = 64, HALF = 128, HTB = HALF * BK * 2  , STAGE_BYTES = 8 * HTB, NXCD = 8, WGM = 8;

__host__ __device__ __forceinline__ int lds_byte(int r, int c) { const int st = (r >> 4) * 2 + (c >> 5), rr = r & 15, cc = c & 31, ob = rr * 64 + cc * 2; return st * 1024 + (ob ^ (((ob >> 9) & 1) << 5)); }
__host__ __device__ __forceinline__ void stage_rc(int b, int& R, int& C) { const int st = b / 1024, sb = b % 1024, swz = sb ^ (((sb >> 9) & 1) << 5); R = (st >> 1) * 16 + swz / 64; C = (st & 1) * 32 + (swz % 64) / 2; }
__host__ __device__ __forceinline__ int perm32(int rho) { const int n = rho >> 4, i = rho & 15; return 8 * (i >> 2) + 4 * n + (i & 3); }

struct Unit { int pm, pn; };
struct Gemm { const bf16_t* A; const bf16_t* Bt; int M, N, K; };

struct StaticOrder {
    int nM, nN, nwg, G, c;
    __host__ __device__ void init(int M, int N, int G_, int c_) { nM = M / BM; nN = N / BM; nwg = nM * nN; G = G_; c = c_; }
    __host__ __device__ bool next(int i, Unit& u) const {
        const long L = (long)i * G + c; if (L >= nwg) return false;
        int wgid = (int)L; { const int q = nwg / NXCD, r = nwg % NXCD, xcd = wgid % NXCD, off = wgid / NXCD; wgid = (xcd < r ? xcd * (q + 1) : r * (q + 1) + (xcd - r) * q) + off; }
        const int nig = WGM * nN, gid = wgid / nig, fm = gid * WGM, gsz = (nM - fm) < WGM ? (nM - fm) : WGM;
        u.pm = fm + ((wgid % nig) % gsz); u.pn = (wgid % nig) / gsz; return true;
    }
    __device__ __forceinline__ void a_ready(const Unit&) const {}
    __device__ __forceinline__ void done(const Unit&) const {}
};
__device__ __forceinline__ unsigned cvt_pk_bf16(float lo, float hi) { unsigned r; asm volatile("v_cvt_pk_bf16_f32 %0, %1, %2" : "=v"(r) : "v"(lo), "v"(hi)); return r; }
typedef float f32x2 __attribute__((ext_vector_type(2)));
__device__ __forceinline__ f32x2 gelu_pk(f32x2 v) {
    const f32x2 av = __builtin_elementwise_abs(v), d = av * 0.2316418882f + 1.0f;
    f32x2 t; t.x = __builtin_amdgcn_rcpf(d.x); t.y = __builtin_amdgcn_rcpf(d.y);
    f32x2 q = t * 0.5307027145f + (-0.7265760135f); q = q * t + 0.7107068705f; q = q * t + (-0.142248368f); q = q * t + 0.127414796f; q = q * t;
    const f32x2 s = (v * v) * (-0.72134752044f);
    f32x2 e; e.x = __builtin_amdgcn_exp2f(s.x); e.y = __builtin_amdgcn_exp2f(s.y);
    const f32x2 m = v * (q * e), r = v - m;
    f32x2 o; o.x = v.x < 0.f ? m.x : r.x; o.y = v.y < 0.f ? m.y : r.y; return o;
}

template <int ACT  > struct EpiBf16 {
    static constexpr bool PERM = true, AFTER_DRAIN = false; static_assert(ACT == 0 || ACT == 1, "EpiBf16: ACT is 0 (none) or 1 (gelu_pk)");
    bf16_t* O; int ldc; const float* bias; int split_cols; size_t split_stride; float scale0;
    __device__ __forceinline__ void operator()(const f32x4 (&acc)[2][2][4][2], const Unit& u, int wr, int wc, int fr, int fq) const {
        const int row0 = u.pm * BM + wr * 64 + fr; int colt = u.pn * BM; bf16_t* base = O;
        float sc = 1.f; if (split_cols) { const int t = colt / split_cols; base += (size_t)t * split_stride; colt -= t * split_cols; if (t == 0) sc = scale0; }
        const int col0 = colt + wc * 32 + 8 * fq, bcol0 = u.pn * BM + wc * 32 + 8 * fq;
        f32x4 bv[2][2];
#pragma unroll
        for (int bj = 0; bj < 2; ++bj)
#pragma unroll
            for (int n = 0; n < 2; ++n) bv[bj][n] = bias ? *(const f32x4*)(bias + bcol0 + bj * HALF + 4 * n) : (f32x4){0.f, 0.f, 0.f, 0.f};
#pragma unroll
        for (int ai = 0; ai < 2; ++ai)
#pragma unroll
            for (int m = 0; m < 4; ++m) { bf16_t* rowp = base + (size_t)(row0 + ai * HALF + m * 16) * ldc + col0;
#pragma unroll
                for (int bj = 0; bj < 2; ++bj) { f32x4 v0 = acc[ai][bj][m][0] + bv[bj][0], v1 = acc[ai][bj][m][1] + bv[bj][1];
                    if (ACT == 1) { f32x2 a = gelu_pk((f32x2){v0[0], v0[1]}), b = gelu_pk((f32x2){v0[2], v0[3]}), c = gelu_pk((f32x2){v1[0], v1[1]}), d = gelu_pk((f32x2){v1[2], v1[3]});
                        v0 = (f32x4){a.x, a.y, b.x, b.y}; v1 = (f32x4){c.x, c.y, d.x, d.y}; }
                    v0 = v0 * sc; v1 = v1 * sc; u32x4 w; w.x = cvt_pk_bf16(v0[0], v0[1]); w.y = cvt_pk_bf16(v0[2], v0[3]); w.z = cvt_pk_bf16(v1[0], v1[1]); w.w = cvt_pk_bf16(v1[2], v1[3]);
                    *(u32x4*)(rowp + bj * HALF) = w; } }
    }
};

__device__ __forceinline__ float bf_lo(unsigned w) { return __builtin_bit_cast(float, w << 16); }
__device__ __forceinline__ float bf_hi(unsigned w) { return __builtin_bit_cast(float, w & 0xffff0000u); }
__device__ __forceinline__ float fsigmoid(float x) { return __builtin_amdgcn_rcpf(1.0f + __expf(-x)); }
typedef unsigned u32x2 __attribute__((ext_vector_type(2)));

struct EpiF32 {
    static constexpr bool PERM = false, AFTER_DRAIN = false;
    float* C; int ldc;
    __device__ __forceinline__ void operator()(const f32x4 (&acc)[2][2][4][2], const Unit& u, int wr, int wc, int fr, int fq) const {
        const int row0 = u.pm * BM + wr * 64 + fr, col0 = u.pn * BM + wc * 32 + 4 * fq;
#pragma unroll
        for (int ai = 0; ai < 2; ++ai)
#pragma unroll
            for (int m = 0; m < 4; ++m) { float* rowp = C + (size_t)(row0 + ai * HALF + m * 16) * ldc + col0;
#pragma unroll
                for (int bj = 0; bj < 2; ++bj)
#pragma unroll
                    for (int n = 0; n < 2; ++n) *(f32x4*)(rowp + bj * HALF + n * 16) = acc[ai][bj][m][n]; }
    }
};
struct EpiRes {
    static constexpr bool PERM = false, AFTER_DRAIN = false;
    const float* X; float* C; int ldc;
    __device__ __forceinline__ void operator()(const f32x4 (&acc)[2][2][4][2], const Unit& u, int wr, int wc, int fr, int fq) const {
        const int row0 = u.pm * BM + wr * 64 + fr, col0 = u.pn * BM + wc * 32 + 4 * fq;
#pragma unroll
        for (int ai = 0; ai < 2; ++ai)
#pragma unroll
            for (int m = 0; m < 4; ++m) { const size_t off = (size_t)(row0 + ai * HALF + m * 16) * ldc + col0;
#pragma unroll
                for (int bj = 0; bj < 2; ++bj)
#pragma unroll
                    for (int n = 0; n < 2; ++n) { const f32x4 xv = *(const f32x4*)(X + off + bj * HALF + n * 16); *(f32x4*)(C + off + bj * HALF + n * 16) = acc[ai][bj][m][n] + xv; }
                asm volatile("" ::: "memory"); }
    }
};
struct EpiKV {
    static constexpr bool PERM = false, AFTER_DRAIN = false;
    bf16_t* Kb; bf16_t* VT;
    __device__ __forceinline__ void operator()(const f32x4 (&acc)[2][2][4][2], const Unit& u, int wr, int wc, int fr, int fq) const {
        const int row0 = u.pm * BM + wr * 64 + fr, col0 = u.pn * BM + wc * 32 + 4 * fq;
#pragma unroll
        for (int ai = 0; ai < 2; ++ai)
#pragma unroll
            for (int m = 0; m < 4; ++m) { const int r = row0 + ai * HALF + m * 16;
#pragma unroll
                for (int bj = 0; bj < 2; ++bj)
#pragma unroll
                    for (int n = 0; n < 2; ++n) { const f32x4 v = acc[ai][bj][m][n]; const int c = col0 + bj * HALF + n * 16;
                        if (u.pn < 4) { u32x2 w; w.x = cvt_pk_bf16(v[0], v[1]); w.y = cvt_pk_bf16(v[2], v[3]); *(u32x2*)(Kb + (size_t)r * 1024 + c) = w; }
                        else { const int cc = c - 1024, h = cc >> 8, d = cc & 255, b = r >> 8, mm = r & 255;
                            const int idx = (mm >> 5) * 32 + ((mm >> 2) & 3) * 8 + ((mm >> 4) & 1) * 4 + (mm & 3);
                            bf16_t* o = VT + ((size_t)((b * 4 + h) * 256 + d)) * 256 + idx;
                            const unsigned w0 = cvt_pk_bf16(v[0], v[1]), w1 = cvt_pk_bf16(v[2], v[3]);
                            o[0] = (bf16_t)(w0 & 0xffffu); o[256] = (bf16_t)(w0 >> 16); o[512] = (bf16_t)(w1 & 0xffffu); o[768] = (bf16_t)(w1 >> 16); } } }
    }
};
struct EpiBranch {
    static constexpr bool PERM = false, AFTER_DRAIN = false;
    const bf16_t* P; int ldp; int gcol0; float* macc; bf16_t* merged;
    __device__ __forceinline__ void operator()(const f32x4 (&acc)[2][2][4][2], const Unit& u, int wr, int wc, int fr, int fq) const {
        const int br = u.pm >> 6, pm = u.pm & 63, pn = u.pn & 7;
        const int row0 = pm * BM + wr * 64 + fr, col0 = pn * BM + wc * 32 + 4 * fq;
#pragma unroll
        for (int ai = 0; ai < 2; ++ai)
#pragma unroll
            for (int m = 0; m < 4; ++m) { const int r = row0 + ai * HALF + m * 16; const bf16_t* prow = P + (size_t)r * ldp + gcol0 + br * 2048;
#pragma unroll
                for (int bj = 0; bj < 2; ++bj)
#pragma unroll
                    for (int n = 0; n < 2; ++n) { const int c = col0 + bj * HALF + n * 16; const u32x2 gw = *(const u32x2*)(prow + c);
                        f32x4 g; g[0] = fsigmoid(bf_lo(gw.x)); g[1] = fsigmoid(bf_hi(gw.x)); g[2] = fsigmoid(bf_lo(gw.y)); g[3] = fsigmoid(bf_hi(gw.y));
                        f32x4 v = acc[ai][bj][m][n] * g; float* mp = macc + (size_t)r * 2048 + c;
                        if (br > 0) v = v + *(const f32x4*)mp;
                        if (br < 2) *(f32x4*)mp = v;
                        else { u32x2 w; w.x = cvt_pk_bf16(v[0], v[1]); w.y = cvt_pk_bf16(v[2], v[3]); *(u32x2*)(merged + (size_t)r * 2048 + c) = w; } }
                asm volatile("" ::: "memory"); }
    }
};
struct EpiSwiglu {
    static constexpr bool PERM = true, AFTER_DRAIN = false;
    bf16_t* H; const float* bg; const float* bu;
    __device__ __forceinline__ void operator()(const f32x4 (&acc)[2][2][4][2], const Unit& u, int wr, int wc, int fr, int fq) const {
        const int e = u.pn >> 4, ct = u.pn & 15;
        const int row0 = u.pm * BM + wr * 64 + fr, col0 = ct * 128 + wc * 32 + 8 * fq;
        f32x4 bgv[2], buv[2];
#pragma unroll
        for (int n = 0; n < 2; ++n) { bgv[n] = *(const f32x4*)(bg + (size_t)e * 2048 + col0 + 4 * n); buv[n] = *(const f32x4*)(bu + (size_t)e * 2048 + col0 + 4 * n); }
#pragma unroll
        for (int ai = 0; ai < 2; ++ai)
#pragma unroll
            for (int m = 0; m < 4; ++m) { bf16_t* rowp = H + (size_t)(row0 + ai * HALF + m * 16) * 2048 + col0;
                f32x4 o[2];
#pragma unroll
                for (int n = 0; n < 2; ++n) { const f32x4 g = acc[ai][0][m][n] + bgv[n], up = acc[ai][1][m][n] + buv[n];
#pragma unroll
                    for (int j = 0; j < 4; ++j) { const float hg = fminf(g[j], 7.0f), hu = fminf(fmaxf(up[j], -7.0f), 7.0f); o[n][j] = (hu + 1.0f) * hg * fsigmoid(1.702f * hg); } }
                u32x4 w; w.x = cvt_pk_bf16(o[0][0], o[0][1]); w.y = cvt_pk_bf16(o[0][2], o[0][3]); w.z = cvt_pk_bf16(o[1][0], o[1][1]); w.w = cvt_pk_bf16(o[1][2], o[1][3]);
                *(u32x4*)rowp = w; }
    }
};
struct EpiDown {
    static constexpr bool PERM = true, AFTER_DRAIN = false;
    bf16_t* O; const float* bd; const float* rowgate;
    __device__ __forceinline__ void operator()(const f32x4 (&acc)[2][2][4][2], const Unit& u, int wr, int wc, int fr, int fq) const {
        const int e = u.pn >> 3, ct = u.pn & 7;
        const int row0 = u.pm * BM + wr * 64 + fr, col0 = ct * BM + wc * 32 + 8 * fq;
        f32x4 bv[2][2];
#pragma unroll
        for (int bj = 0; bj < 2; ++bj)
#pragma unroll
            for (int n = 0; n < 2; ++n) bv[bj][n] = *(const f32x4*)(bd + (size_t)e * 2048 + col0 + bj * HALF + 4 * n);
#pragma unroll
        for (int ai = 0; ai < 2; ++ai)
#pragma unroll
            for (int m = 0; m < 4; ++m) { const int r = row0 + ai * HALF + m * 16; const float gs = rowgate[r]; bf16_t* rowp = O + (size_t)r * 2048 + col0;
#pragma unroll
                for (int bj = 0; bj < 2; ++bj) { const f32x4 v0 = (acc[ai][bj][m][0] + bv[bj][0]) * gs, v1 = (acc[ai][bj][m][1] + bv[bj][1]) * gs;
                    u32x4 w; w.x = cvt_pk_bf16(v0[0], v0[1]); w.y = cvt_pk_bf16(v0[2], v0[3]); w.z = cvt_pk_bf16(v1[0], v1[1]); w.w = cvt_pk_bf16(v1[2], v1[3]);
                    *(u32x4*)(rowp + bj * HALF) = w; } }
    }
};
struct BranchOrder {
    StaticOrder so;
    __device__ void init(int G_, int c_) { so.init(16384, 2048, G_, c_); }
    __device__ bool next(int i, Unit& u) const { const int br = i % 3; Unit t; if (!so.next(i / 3, t)) return false; u.pm = br * 64 + t.pm; u.pn = br * 8 + t.pn; return true; }
    __device__ __forceinline__ void a_ready(const Unit&) const {}
    __device__ __forceinline__ void done(const Unit&) const {}
};
struct MoeOrder {
    StaticOrder so; const int* tile_e; int nN;
    __device__ void init(int ntiles, int nN_, int G_, int c_, const int* te) { so.init(ntiles * BM, nN_ * BM, G_, c_); tile_e = te; nN = nN_; }
    __device__ bool next(int i, Unit& u) const { Unit t; if (!so.next(i, t)) return false; u.pm = t.pm; u.pn = tile_e[t.pm] * nN + t.pn; return true; }
    __device__ __forceinline__ void a_ready(const Unit&) const {}
    __device__ __forceinline__ void done(const Unit&) const {}
};
template <class Epi, class Sched, bool ALIGN_EPI = false, bool SP2 = false>
__device__ __forceinline__ void gemm_phase(PG8_LAS unsigned char* lds, const Gemm g, const Sched& S, const Epi& E) {
    const int tid = threadIdx.x, wid = __builtin_amdgcn_readfirstlane(tid >> 6), lane = tid & 63, wr = wid >> 2, wc = wid & 3, fr = lane & 15, fq = lane >> 4;
    const int K = g.K, nt = K / BK;
    unsigned voffA[2], voffB[2];
#pragma unroll
    for (int i = 0; i < 2; ++i) { int R, C; stage_rc(tid * 16 + i * 8192, R, C); const int Rb = Epi::PERM ? ((R & ~31) + perm32(R & 31)) : R;
        voffA[i] = (unsigned)(R * K + C) * 2u; voffB[i] = (unsigned)(Rb * K + C) * 2u; }
    const size_t kstep = (size_t)(BK * 2);
    const size_t hstep = (size_t)HALF * K * 2;
    const size_t tstep = 2 * hstep;
    const unsigned ldsw = (unsigned)wid * 1024u;
    const int aoff = lds_byte(wr * 64 + fr, fq * 8), boff = lds_byte(wc * 32 + fr, fq * 8);
#define PG8_SA(b, h) (((b) * 2 + (h)) * HTB)
#define PG8_SB(b, h) ((4 + (b) * 2 + (h)) * HTB)
#define PG8_STAGE(bufoff, gbase, voff) do { _Pragma("unroll") for (int _i = 0; _i < 2; ++_i) \
        __builtin_amdgcn_global_load_lds((const unsigned*)((const char*)(gbase) + (voff)[_i]), (PG8_LAS unsigned*)(lds + (bufoff) + ldsw + _i * 8192), 16, 0, 0); } while (0)
#define PG8_LDA(dst, b, h) do { _Pragma("unroll") for (int m = 0; m < 4; ++m) _Pragma("unroll") for (int k = 0; k < 2; ++k) dst[m][k] = *(const PG8_LAS bf16x8*)(lds + PG8_SA(b, h) + aoff + m * 2048 + k * 1024); } while (0)
#define PG8_LDB(dst, b, h) do { _Pragma("unroll") for (int n = 0; n < 2; ++n) _Pragma("unroll") for (int k = 0; k < 2; ++k) dst[n][k] = *(const PG8_LAS bf16x8*)(lds + PG8_SB(b, h) + boff + n * 2048 + k * 1024); } while (0)
#define PG8_MMA(ai, bj, At, Bt) do { __builtin_amdgcn_s_setprio(1); _Pragma("unroll") for (int m = 0; m < 4; ++m) _Pragma("unroll") for (int n = 0; n < 2; ++n) _Pragma("unroll") for (int k = 0; k < 2; ++k) \
        acc[ai][bj][m][n] = __builtin_amdgcn_mfma_f32_16x16x32_bf16(Bt[n][k], At[m][k], acc[ai][bj][m][n], 0, 0, 0); __builtin_amdgcn_s_setprio(0); } while (0)
#define PG8_WAIT_V(n) asm volatile("s_waitcnt vmcnt(" #n ")" ::: "memory")
#define PG8_WAIT_L(n) asm volatile("s_waitcnt lgkmcnt(" #n ")" ::: "memory")
#define PG8_BAR __builtin_amdgcn_s_barrier()
#define PG8_SCHED __builtin_amdgcn_sched_barrier(0)
    Unit cur, nxt; int ui = 0;
    if (!S.next(0, cur)) return;
    f32x4 acc[2][2][4][2];
#pragma unroll
    for (int a = 0; a < 2; ++a)
#pragma unroll
        for (int b = 0; b < 2; ++b)
#pragma unroll
            for (int m = 0; m < 4; ++m)
#pragma unroll
                for (int n = 0; n < 2; ++n) acc[a][b][m][n] = (f32x4){0.f, 0.f, 0.f, 0.f};
    bf16x8 At[4][2], B0[2][2], B1[2][2];
    const char* cA = (const char*)g.A + (size_t)cur.pm * tstep; const char* cB = (const char*)g.Bt + (size_t)cur.pn * tstep;
    S.a_ready(cur);
    if constexpr (SP2) {
        PG8_STAGE(PG8_SB(0, 0), cB, voffB); PG8_STAGE(PG8_SB(0, 1), cB + hstep, voffB); PG8_STAGE(PG8_SA(0, 0), cA, voffA); PG8_STAGE(PG8_SA(0, 1), cA + hstep, voffA);
        if (wr == 1) PG8_BAR;
        PG8_WAIT_V(2); PG8_BAR;
        PG8_STAGE(PG8_SB(1, 0), cB + kstep, voffB); PG8_STAGE(PG8_SA(1, 0), cA + kstep, voffA); PG8_STAGE(PG8_SB(1, 1), cB + hstep + kstep, voffB);
        PG8_WAIT_V(6); PG8_BAR;
    } else {
        PG8_STAGE(PG8_SB(0, 0), cB, voffB); PG8_STAGE(PG8_SA(0, 0), cA, voffA); PG8_STAGE(PG8_SB(0, 1), cB + hstep, voffB); PG8_STAGE(PG8_SA(0, 1), cA + hstep, voffA);
        if (wr == 1) PG8_BAR;
        PG8_WAIT_V(4); PG8_BAR;
        PG8_STAGE(PG8_SB(1, 0), cB + kstep, voffB); PG8_STAGE(PG8_SA(1, 0), cA + kstep, voffA); PG8_STAGE(PG8_SB(1, 1), cB + hstep + kstep, voffB);
        PG8_WAIT_V(6); PG8_BAR;
    }
    for (;;) {
        const bool has_next = S.next(ui + 1, nxt);
        const char* nA = has_next ? (const char*)g.A + (size_t)nxt.pm * tstep : cA; const char* nB = has_next ? (const char*)g.Bt + (size_t)nxt.pn * tstep : cB;
        for (int t = 0; t < nt; t += 2) {
            const bool last = (t == nt - 2);
            const char* a1 = cA + (size_t)(t + 1) * kstep;
            const char* a2 = last ? nA : cA + (size_t)(t + 2) * kstep; const char* b2 = last ? nB : cB + (size_t)(t + 2) * kstep;
            const char* a3 = a2 + kstep; const char* b3 = b2 + kstep;
            if (last && has_next) S.a_ready(nxt);
            if constexpr (SP2) {
            PG8_LDB(B0, 0, 0); PG8_LDB(B1, 0, 1); PG8_SCHED; PG8_LDA(At, 0, 0); PG8_STAGE(PG8_SA(1, 1), a1 + hstep, voffA);
            PG8_WAIT_V(8); PG8_WAIT_L(0); PG8_BAR; PG8_MMA(0, 0, At, B0); PG8_MMA(0, 1, At, B1); PG8_BAR; PG8_SCHED;
            PG8_LDA(At, 0, 1); PG8_STAGE(PG8_SB(0, 0), b2, voffB); PG8_STAGE(PG8_SB(0, 1), b2 + hstep, voffB); PG8_STAGE(PG8_SA(0, 0), a2, voffA);
            PG8_WAIT_V(8); PG8_WAIT_L(0); PG8_BAR; PG8_MMA(1, 0, At, B0); PG8_MMA(1, 1, At, B1); PG8_BAR; PG8_SCHED;
            PG8_LDB(B0, 1, 0); PG8_LDB(B1, 1, 1); PG8_SCHED; PG8_LDA(At, 1, 0); PG8_STAGE(PG8_SA(0, 1), a2 + hstep, voffA);
            PG8_WAIT_V(8); PG8_WAIT_L(0); PG8_BAR; PG8_MMA(0, 0, At, B0); PG8_MMA(0, 1, At, B1); PG8_BAR; PG8_SCHED;
            PG8_LDA(At, 1, 1); PG8_STAGE(PG8_SB(1, 0), b3, voffB); PG8_STAGE(PG8_SB(1, 1), b3 + hstep, voffB); PG8_STAGE(PG8_SA(1, 0), a3, voffA);
            PG8_WAIT_V(8); PG8_WAIT_L(0); PG8_BAR; PG8_MMA(1, 0, At, B0); PG8_MMA(1, 1, At, B1); PG8_BAR; PG8_SCHED;
            } else {
            PG8_LDB(B0, 0, 0); PG8_SCHED; PG8_LDA(At, 0, 0); PG8_STAGE(PG8_SA(1, 1), a1 + hstep, voffA);
            PG8_WAIT_L(8); PG8_BAR; PG8_WAIT_L(0); PG8_MMA(0, 0, At, B0); PG8_BAR; PG8_SCHED;
            PG8_LDB(B1, 0, 1); PG8_STAGE(PG8_SB(0, 0), b2, voffB);
            PG8_BAR; PG8_WAIT_L(0); PG8_MMA(0, 1, At, B1); PG8_BAR;
            PG8_LDA(At, 0, 1); PG8_STAGE(PG8_SA(0, 0), a2, voffA);
            PG8_BAR; PG8_WAIT_L(0); PG8_MMA(1, 0, At, B0); PG8_BAR; PG8_SCHED;
            PG8_STAGE(PG8_SB(0, 1), b2 + hstep, voffB);
            PG8_WAIT_V(6); PG8_BAR; PG8_MMA(1, 1, At, B1); PG8_BAR;
            PG8_LDB(B0, 1, 0); PG8_SCHED; PG8_LDA(At, 1, 0); PG8_STAGE(PG8_SA(0, 1), a2 + hstep, voffA);
            PG8_WAIT_L(8); PG8_BAR; PG8_WAIT_L(0); PG8_MMA(0, 0, At, B0); PG8_BAR; PG8_SCHED;
            PG8_LDB(B1, 1, 1); PG8_STAGE(PG8_SB(1, 0), b3, voffB);
            PG8_BAR; PG8_WAIT_L(0); PG8_MMA(0, 1, At, B1); PG8_BAR;
            PG8_LDA(At, 1, 1); PG8_STAGE(PG8_SA(1, 0), a3, voffA);
            PG8_BAR; PG8_WAIT_L(0); PG8_MMA(1, 0, At, B0); PG8_BAR; PG8_SCHED;
            PG8_STAGE(PG8_SB(1, 1), b3 + hstep, voffB);
            PG8_WAIT_V(6); PG8_BAR; PG8_MMA(1, 1, At, B1); PG8_BAR;
            }
        }
        if constexpr (ALIGN_EPI) { if (wr == 0) PG8_BAR; }
        if constexpr (!Epi::AFTER_DRAIN) { E(acc, cur, wr, wc, fr, fq); S.done(cur); }
        if (!has_next) break;
#pragma unroll
        for (int a = 0; a < 2; ++a)
#pragma unroll
            for (int b = 0; b < 2; ++b)
#pragma unroll
                for (int m = 0; m < 4; ++m)
#pragma unroll
                    for (int n = 0; n < 2; ++n) acc[a][b][m][n] = (f32x4){0.f, 0.f, 0.f, 0.f};
        cur = nxt; cA = nA; cB = nB; ++ui;
        if constexpr (ALIGN_EPI) { if (wr == 1) PG8_BAR; }
    }
    PG8_WAIT_V(0);
    if constexpr (!ALIGN_EPI) { if (wr == 0) PG8_BAR; }
    PG8_BAR;
    if constexpr (Epi::AFTER_DRAIN) { E.fused(acc, cur, wr, wc, fr, fq, lds, wid, lane); S.done(cur); }
#undef PG8_SA
#undef PG8_SB
#undef PG8_STAGE
#undef PG8_LDA
#undef PG8_LDB
#undef PG8_MMA
#undef PG8_WAIT_V
#undef PG8_WAIT_L
#undef PG8_BAR
#undef PG8_SCHED
}
}

constexpr int NWAVES = 8;
constexpr int BATCH = 2, SEQ = 8192, T = BATCH * SEQ, D = 2048;
constexpr int RWKV_COLS = 3360, IN_COLS = 12576;
constexpr int NP = 12800;
constexpr int PC_LX = 3584, PC_LY = 4608, PC_Q = 5632, PC_G = 6656;
constexpr int NE = 32, MAXROWS = 65536 + NE * 256;
constexpr int LORA_K = 384;
constexpr float EPS = 1e-6f, GN_EPS = 64e-5f;

constexpr size_t MiB = 1u << 20;
constexpr size_t WS_CTL = 0, CTL_ZERO_BYTES = 1 * MiB;
constexpr size_t WS_WIN = 1 * MiB, WS_WMKV = 51 * MiB, WS_WLORA = 59 * MiB, WS_WBR = 62 * MiB, WS_WO = 74 * MiB, WS_WR = 82 * MiB, WS_LW = 83 * MiB;
constexpr size_t WS_WGU = 84 * MiB, WS_WD = 596 * MiB;
constexpr size_t WS_XN = 852 * MiB;
constexpr size_t WS_P = 916 * MiB;
constexpr size_t WS_LORAOUT = 1316 * MiB;
constexpr size_t WS_SCAN = 1508 * MiB;
constexpr size_t WS_YABC = 1892 * MiB;
constexpr size_t WS_MISC = 1988 * MiB;
constexpr size_t WS_MN = WS_MISC, WS_KMEM = WS_MISC + 2 * MiB, WS_VT = WS_MISC + 3 * MiB, WS_LRUC = WS_MISC + 4 * MiB  , WS_BONUS = WS_MISC + 7 * MiB;
constexpr size_t WS_PICK = WS_MISC + 8 * MiB  , WS_ROWTAB = WS_MISC + 9 * MiB  ;
constexpr size_t WS_END = 2000 * MiB;
constexpr size_t WS_MACC = WS_LORAOUT, WS_MERGED = 1444 * MiB, WS_H1 = WS_SCAN, WS_XS = WS_P, WS_OROW = WS_P, WS_HH = 1204 * MiB;
constexpr int CW_BAR = 4096, CW_CNT = 8192, CW_NTILES = 8192 + 64, CW_TILEE = 8192 + 128;

constexpr int LDS_BYTES = 147456;
constexpr int MISC_OFF = 143360;

#define GAS __attribute__((address_space(1)))
#define LAS __attribute__((address_space(3)))
typedef unsigned short bf16;
typedef unsigned v4u __attribute__((ext_vector_type(4)));
typedef unsigned v2u __attribute__((ext_vector_type(2)));
typedef float f32x4 __attribute__((ext_vector_type(4)));
typedef float f32x2 __attribute__((ext_vector_type(2)));
typedef short bf16x8 __attribute__((ext_vector_type(8)));
#define LDS_WAIT() asm volatile("s_waitcnt lgkmcnt(0)" ::: "memory")
#define VM_WAIT() asm volatile("s_waitcnt vmcnt(0)" ::: "memory")
__device__ __forceinline__ unsigned f2bf(float f) { unsigned u = __builtin_bit_cast(unsigned, f); return (u + 0x7fffu + ((u >> 16) & 1u)) >> 16; }
__device__ __forceinline__ unsigned pk2(float lo, float hi) { return f2bf(lo) | (f2bf(hi) << 16); }
__device__ __forceinline__ float bflo(unsigned w) { return __builtin_bit_cast(float, w << 16); }
__device__ __forceinline__ float bfhi(unsigned w) { return __builtin_bit_cast(float, w & 0xffff0000u); }
__device__ __forceinline__ float bf1(bf16 b) { return __builtin_bit_cast(float, (unsigned)b << 16); }
__device__ __forceinline__ float sigm(float x) { return 1.0f / (1.0f + __expf(-x)); }
__device__ __forceinline__ float softplusf(float x) { return fmaxf(x, 0.f) + log1pf(__expf(-fabsf(x))); }
__device__ __forceinline__ float wave_sum(float v) {
#pragma unroll
    for (int o = 1; o < 64; o <<= 1) v += __shfl_xor(v, o);
    return v;
}
template <int CTRL> __device__ __forceinline__ float dppf(float x) { return __builtin_bit_cast(float, __builtin_amdgcn_mov_dpp(__builtin_bit_cast(int, x), CTRL, 0xf, 0xf, true)); }
__device__ __forceinline__ float row16_sum(float v) {
    v += dppf<0xB1>(v); v += dppf<0x4E>(v); v += dppf<0x141>(v); v += dppf<0x140>(v); return v;
}
#define XB_TMO      128
#define XB_XCNT(j)  (256  + 64 * (j))
#define XB_XSUB(j)  (1280 + 64 * (j))
#define XB_XGEN(j)  (2304 + 64 * (j))
#define XB_TOP      3328
#define XB_TOPGEN   3392
#define XCD_BAR_WORDS 3456
#define XB_SPIN_CAP (1u << 18)

__device__ __forceinline__ unsigned xb_ld(unsigned* p)              { return __hip_atomic_load(p, __ATOMIC_RELAXED, __HIP_MEMORY_SCOPE_AGENT); }
__device__ __forceinline__ unsigned xb_add(unsigned* p, unsigned v) { return __hip_atomic_fetch_add(p, v, __ATOMIC_RELAXED, __HIP_MEMORY_SCOPE_AGENT); }
__device__ __forceinline__ unsigned xb_xcc_id() { return (unsigned)__builtin_amdgcn_s_getreg((3 << 11) | 20) & 0xFu; }
#define XB_SPIN(cond, bar) do { unsigned _sp = 0; while (cond) { __builtin_amdgcn_s_sleep(1); \
    if ((++_sp & 255u) == 0u) { if (xb_ld(&(bar)[XB_TMO])) break; if (_sp > XB_SPIN_CAP) { atomicAdd(&(bar)[XB_TMO], 1u); break; } } } } while (0)

struct XcdBarrier {
    unsigned* bar; unsigned x;
    volatile LAS unsigned* st;
};

__device__ __forceinline__ XcdBarrier xcd_barrier_post(unsigned* bar, volatile LAS unsigned* st) {
    XcdBarrier b; b.bar = bar; b.x = xb_xcc_id(); b.st = st;
    if (threadIdx.x == 0) (void)xb_add(&bar[XB_XCNT(b.x)], 1u);
    return b;
}
__device__ __forceinline__ void xcd_barrier_complete(unsigned* bar, unsigned x, unsigned& nloc, unsigned& nx) {
    const unsigned G = gridDim.x * gridDim.y * gridDim.z;
    unsigned sum, cnt, mine, sp = 0u;
    for (;;) {
        sum = 0u; cnt = 0u; mine = 0u;
#pragma unroll
        for (unsigned j = 0; j < 16; ++j) { const unsigned c = xb_ld(&bar[XB_XCNT(j)]); sum += c; cnt += (c > 0u) ? 1u : 0u; mine = (j == x) ? c : mine; }
        if (sum == G) break;
        __builtin_amdgcn_s_sleep(1);
        if ((++sp & 255u) == 0u) { if (xb_ld(&bar[XB_TMO])) break; if (sp > XB_SPIN_CAP) { atomicAdd(&bar[XB_TMO], 1u); break; } }
    }
    nloc = mine > 0u ? mine : 1u; nx = cnt > 0u ? cnt : 1u;
}

__device__ __forceinline__ void xcd_barrier(const XcdBarrier& b) {
    asm volatile("s_waitcnt vmcnt(0)" ::: "memory");
    __syncthreads();
    if (threadIdx.x == 0) {
        unsigned* bar = b.bar;
        __builtin_amdgcn_s_waitcnt(0);
        unsigned nloc = b.st[0], nx = b.st[1];
        if (nloc == 0u) { xcd_barrier_complete(bar, b.x, nloc, nx); b.st[0] = nloc; b.st[1] = nx; }
        const unsigned old = xb_add(&bar[XB_XSUB(b.x)], 1u);
        const unsigned gen = old / nloc;
        if (old + 1u == (gen + 1u) * nloc) {
            __builtin_amdgcn_fence(__ATOMIC_RELEASE, "agent");
            asm volatile("s_waitcnt vmcnt(0)" ::: "memory");
            const unsigned og = xb_add(&bar[XB_TOP], 1u);
            const unsigned tg = og / nx;
            if (og + 1u == (tg + 1u) * nx) xb_add(&bar[XB_TOPGEN], 1u);
            else XB_SPIN(xb_ld(&bar[XB_TOPGEN]) == tg, bar);
            __builtin_amdgcn_fence(__ATOMIC_ACQUIRE, "agent");
            xb_add(&bar[XB_XGEN(b.x)], 1u);
            asm volatile("s_waitcnt vmcnt(0)" ::: "memory");
        } else {
            XB_SPIN(xb_ld(&bar[XB_XGEN(b.x)]) == gen, bar);
            __builtin_amdgcn_fence(__ATOMIC_ACQUIRE, "agent");
            asm volatile("s_waitcnt vmcnt(0)" ::: "memory");
        }
    }
    __syncthreads();
}

struct Frame {
    LAS unsigned char* lds;
    volatile LAS unsigned* MISC;
    int tid, lane, wave, vcu, G;
};
struct Args { const float* in[39]; float* out; unsigned char* ws; int ph_lo, ph_hi; };
enum { I_X = 0, I_MEM, I_GMIX, I_WIN, I_MU, I_W0, I_W2, I_A0, I_A2, I_G2, I_KK, I_KA, I_RK, I_LNW, I_LNB, I_WRO, I_CONVW, I_CONVB, I_LWR, I_LBR, I_LWI, I_LBI, I_LAM, I_WLO,
       I_GMEM, I_WMK, I_WMV, I_WXO, I_WOUT, I_GFFN, I_WROUTER, I_BROUTER, I_WGATE, I_BGATE, I_WUP, I_BUP, I_WDOWN, I_BDOWN, I_GFINAL };


__device__ __forceinline__ const float* inp(int k) {
    typedef const volatile unsigned long long __attribute__((address_space(4))) ka_t;
    ka_t* ka = (ka_t*)__builtin_amdgcn_kernarg_segment_ptr();
    return (const float*)ka[k];
}
template <int NB> __device__ __forceinline__ void transpose_item(const float* W, int N, int k0, int n0, bf16* WT, int Kd, int drow0, int lane) {
    constexpr int LPR = NB / 4, G = 64 / LPR, KR = 64 / G;
    const int g = lane / LPR, c = lane % LPR;
    const GAS float* src = (const GAS float*)W + (size_t)(k0 + KR * g) * N + n0 + 4 * c;
    f32x4 ld[KR];
#pragma unroll
    for (int i = 0; i < KR; ++i) ld[i] = *(const GAS f32x4*)(src + (size_t)i * N);
    GAS bf16* dst = (GAS bf16*)WT + (size_t)(drow0 + 4 * c) * Kd + k0 + KR * g;
#pragma unroll
    for (int j = 0; j < 4; ++j)
#pragma unroll
        for (int q = 0; q < KR / 8; ++q) { v4u o; o.x = pk2(ld[8 * q + 0][j], ld[8 * q + 1][j]); o.y = pk2(ld[8 * q + 2][j], ld[8 * q + 3][j]); o.z = pk2(ld[8 * q + 4][j], ld[8 * q + 5][j]); o.w = pk2(ld[8 * q + 6][j], ld[8 * q + 7][j]);
            *(GAS v4u*)(dst + (size_t)j * Kd + 8 * q) = o; }
}
__device__ __forceinline__ void rms_row_to_bf16(const float* xrow, const float* gain, bf16* orow, int lane) {
    const GAS f32x4* xr = (const GAS f32x4*)xrow + lane; const GAS f32x4* gr = (const GAS f32x4*)gain + lane;
    f32x4 v[8]; float s = 0.f;
#pragma unroll
    for (int j = 0; j < 8; ++j) { v[j] = xr[64 * j]; s += (v[j].x * v[j].x + v[j].y * v[j].y) + (v[j].z * v[j].z + v[j].w * v[j].w); }
    const float rstd = 1.0f / sqrtf(wave_sum(s) * (1.f / D) + EPS);
    GAS v2u* o8 = (GAS v2u*)orow + lane;
#pragma unroll
    for (int j = 0; j < 8; ++j) { const f32x4 g = gr[64 * j]; v2u w; w.x = pk2(v[j].x * rstd * g.x, v[j].y * rstd * g.y); w.y = pk2(v[j].z * rstd * g.z, v[j].w * rstd * g.w); o8[64 * j] = w; }
}

__device__ __forceinline__ void p0_prologue(const Frame& F, const Args& a) {
    unsigned char* ws = a.ws;
    const int gw = F.vcu * NWAVES + F.wave, NGW = F.G * NWAVES;
    constexpr int I_IN = 32 * (IN_COLS / 32), I_MK = 32 * 32, I_BR = 16 * 64, I_O = 32 * 64;
    constexpr int NITEMS = I_IN + 2 * I_MK + 3 * I_BR + I_O;
    for (int it = gw; it < NITEMS; it += NGW) {
        int r = it;
        if (r < I_IN) { const int nb = IN_COLS / 32, kb = r / nb, n0 = 32 * (r % nb); transpose_item<32>(inp(I_WIN), IN_COLS, 64 * kb, n0, (bf16*)(ws + WS_WIN), D, n0 + (n0 >= RWKV_COLS ? 224 : 0), F.lane); continue; } r -= I_IN;
        if (r < I_MK) { transpose_item<32>(inp(I_WMK), 1024, 64 * (r / 32), 32 * (r % 32), (bf16*)(ws + WS_WMKV), D, 32 * (r % 32), F.lane); continue; } r -= I_MK;
        if (r < I_MK) { transpose_item<32>(inp(I_WMV), 1024, 64 * (r / 32), 32 * (r % 32), (bf16*)(ws + WS_WMKV), D, 1024 + 32 * (r % 32), F.lane); continue; } r -= I_MK;
        if (r < I_BR) { transpose_item<32>(inp(I_WRO), 2048, 64 * (r / 64), 32 * (r % 64), (bf16*)(ws + WS_WBR), 1024, 32 * (r % 64), F.lane); continue; } r -= I_BR;
        if (r < I_BR) { transpose_item<32>(inp(I_WLO), 2048, 64 * (r / 64), 32 * (r % 64), (bf16*)(ws + WS_WBR) + (size_t)2048 * 1024, 1024, 32 * (r % 64), F.lane); continue; } r -= I_BR;
        if (r < I_BR) { transpose_item<32>(inp(I_WXO), 2048, 64 * (r / 64), 32 * (r % 64), (bf16*)(ws + WS_WBR) + (size_t)2 * 2048 * 1024, 1024, 32 * (r % 64), F.lane); continue; } r -= I_BR;
        transpose_item<32>(inp(I_WOUT), 2048, 64 * (r / 64), 32 * (r % 64), (bf16*)(ws + WS_WO), D, 32 * (r % 64), F.lane);
    }
    for (int m = gw; m < T; m += NGW) rms_row_to_bf16(inp(I_X) + (size_t)m * D, inp(I_GMIX), (bf16*)(ws + WS_XN) + (size_t)m * D, F.lane);
    for (int m = gw; m < 512; m += NGW) rms_row_to_bf16(inp(I_MEM) + (size_t)m * D, inp(I_GMEM), (bf16*)(ws + WS_MN) + (size_t)m * D, F.lane);
    const int gt = F.vcu * (NWAVES * 64) + F.tid, NGT = F.G * NWAVES * 64;
    { bf16* wz = (bf16*)(ws + WS_WIN) + (size_t)RWKV_COLS * D; for (int i = gt; i < 224 * D / 2; i += NGT) ((GAS unsigned*)wz)[i] = 0u; }
    { bf16* wl = (bf16*)(ws + WS_WLORA);
      for (int i = gt; i < 3072 * LORA_K; i += NGT) { const int n = i / LORA_K, k = i % LORA_K; float v = 0.f;
          if (n < 1024) { if (k < 64) v = inp(I_W2)[k * 1024 + n]; }
          else if (n < 2048) { if (k >= 64 && k < 128) v = inp(I_A2)[(k - 64) * 1024 + (n - 1024)]; }
          else { if (k >= 128 && k < 288) v = inp(I_G2)[(k - 128) * 1024 + (n - 2048)]; }
          wl[i] = (bf16)f2bf(v); } }
    { bf16* wr = (bf16*)(ws + WS_WR);
      for (int i = gt; i < 32 * D; i += NGT) { const int e = i / D, k = i % D; const float w = inp(I_WROUTER)[k * 32 + e]; const unsigned hi = f2bf(w); const float r = w - __builtin_bit_cast(float, hi << 16);
          wr[i] = (bf16)hi; wr[32 * D + i] = (bf16)f2bf(r); } }
    { const float* lwi_p = inp(I_LWI); const float* lwr_p = inp(I_LWR); bf16* lw = (bf16*)(ws + WS_LW);
      for (int i = gt; i < 2 * 16 * 4 * 2 * 64 * 8; i += NGT) { const int j = i & 7, ln = (i >> 3) & 63, ks = (i >> 9) & 1, vbo = (i >> 10) & 3, n = (i >> 12) & 15, mat = i >> 16;
          const int w = 32 * ks + 16 * (j >> 2) + 4 * (ln >> 4) + (j & 3), v = 16 * vbo + (ln & 15);
          lw[i] = (bf16)f2bf((mat ? lwi_p : lwr_p)[(n * 64 + w) * 64 + v]); } }
}

__device__ __forceinline__ void moe_weight_convert(const Frame& F, const Args& a, int w0) {
    unsigned char* ws = a.ws;
    const float* wg = inp(I_WGATE); const float* wu = inp(I_WUP); const float* wd = inp(I_WDOWN);
    const int nw = NWAVES - w0, gw = F.vcu * nw + (F.wave - w0), NGW = F.G * nw;
    constexpr int PER = 1024;
    for (int it = gw; it < NE * 3 * PER; it += NGW) {
        const int e = it / (3 * PER), r = it % (3 * PER), which = r / PER, q = r % PER, k0 = 64 * (q / 32), n0 = 64 * (q % 32);
        if (which == 0) transpose_item<64>(wg + (size_t)e * D * D, D, k0, n0, (bf16*)(ws + WS_WGU) + (size_t)e * 4096 * D, D, (n0 >> 7) * 256 + (n0 & 127), F.lane);
        else if (which == 1) transpose_item<64>(wu + (size_t)e * D * D, D, k0, n0, (bf16*)(ws + WS_WGU) + (size_t)e * 4096 * D, D, (n0 >> 7) * 256 + 128 + (n0 & 127), F.lane);
        else transpose_item<64>(wd + (size_t)e * D * D, D, k0, n0, (bf16*)(ws + WS_WD) + (size_t)e * 2048 * D, D, n0, F.lane);
    }
}

__device__ __forceinline__ void r1_lora_in(const Frame& F, const Args& a) {
    const bf16* P = (const bf16*)(a.ws + WS_P); bf16* L = (bf16*)(a.ws + WS_XN);
    const float* mu = inp(I_MU);
    const int gw = F.vcu * NWAVES + F.wave, NGW = F.G * NWAVES;
    for (int m = gw; m < T; m += NGW) {
        const bool first = (m % SEQ) == 0;
#pragma unroll
        for (int j = 0; j < 6; ++j) { const int k = F.lane + 64 * j; float o = 0.f;
            if (k < 288) { const int c = 3072 + k; const float cur = bf1(P[(size_t)m * NP + c]); const float prev = first ? 0.f : bf1(P[(size_t)(m - 1) * NP + c]);
                const float x = cur + (prev - cur) * mu[c]; o = k < 64 ? tanhf(x) : (k < 128 ? x : sigm(x)); }
            L[(size_t)m * LORA_K + k] = (bf16)f2bf(o); }
    }
}

__device__ __forceinline__ f32x4 bf4(v2u w) { return (f32x4){bflo(w.x), bfhi(w.x), bflo(w.y), bfhi(w.y)}; }
__device__ __forceinline__ void r3_scan_inputs(const Frame& F, const Args& a) {
    const GAS bf16* P = (const GAS bf16*)(a.ws + WS_P); const GAS float* LO = (const GAS float*)(a.ws + WS_LORAOUT);
    GAS float* SR = (GAS float*)(a.ws + WS_SCAN); constexpr size_t AS = (size_t)T * 1024;
    GAS float* BON = (GAS float*)(a.ws + WS_BONUS);
    const GAS float* mu = (const GAS float*)inp(I_MU); const GAS float* w0 = (const GAS float*)inp(I_W0); const GAS float* a0 = (const GAS float*)inp(I_A0);
    const GAS float* kkp = (const GAS float*)inp(I_KK); const GAS float* kap = (const GAS float*)inp(I_KA); const GAS float* rkp = (const GAS float*)inp(I_RK);
    const int gw = F.vcu * NWAVES + F.wave, NGW = F.G * NWAVES;
    for (int m = gw; m < T; m += NGW) {
        const bool first = (m % SEQ) == 0;
        const GAS bf16* pc = P + (size_t)m * NP; const GAS bf16* pp = P + (size_t)(m - (first ? 0 : 1)) * NP;
#pragma unroll 1
        for (int hp = 0; hp < 4; ++hp) { const int c = hp * 256 + F.lane * 4;
            const f32x4 cr = bf4(*(const GAS v2u*)(pc + c)), ck = bf4(*(const GAS v2u*)(pc + 1024 + c)), cv = bf4(*(const GAS v2u*)(pc + 2048 + c));
            f32x4 qr = bf4(*(const GAS v2u*)(pp + c)), qk = bf4(*(const GAS v2u*)(pp + 1024 + c)), qv = bf4(*(const GAS v2u*)(pp + 2048 + c));
            if (first) { qr = (f32x4){0.f, 0.f, 0.f, 0.f}; qk = qr; qv = qr; }
            const f32x4 r = cr + (qr - cr) * *(const GAS f32x4*)(mu + c), k = ck + (qk - ck) * *(const GAS f32x4*)(mu + 1024 + c), v = cv + (qv - cv) * *(const GAS f32x4*)(mu + 2048 + c);
            const f32x4 wpre = *(const GAS f32x4*)(w0 + c) + *(const GAS f32x4*)(LO + (size_t)m * 3072 + c), apre = *(const GAS f32x4*)(a0 + c) + *(const GAS f32x4*)(LO + (size_t)m * 3072 + 1024 + c);
            const f32x4 kkw = *(const GAS f32x4*)(kkp + c), kaw = *(const GAS f32x4*)(kap + c), rkw = *(const GAS f32x4*)(rkp + c);
            f32x4 dec, ag, kk, km; float ss = 0.f, bo = 0.f;
#pragma unroll
            for (int j = 0; j < 4; ++j) {
                dec[j] = __expf(-0.6065306597126334f * __builtin_amdgcn_rcpf(1.0f + __expf(-wpre[j])));
                ag[j] = __builtin_amdgcn_rcpf(1.0f + __expf(-apre[j]));
                kk[j] = k[j] * kkw[j]; ss += kk[j] * kk[j];
                km[j] = k[j] * (1.0f + (ag[j] - 1.0f) * kaw[j]); bo += r[j] * km[j] * rkw[j]; }
            ss = row16_sum(ss); bo = row16_sum(bo);
            const float inv = 1.0f / sqrtf(fmaxf(ss, 1e-24f));
            const f32x4 kkn = kk * inv;
            const size_t o = (size_t)m * 1024 + c;
            *(GAS f32x4*)(SR + o) = r; *(GAS f32x4*)(SR + AS + o) = dec; *(GAS f32x4*)(SR + 2 * AS + o) = km; *(GAS f32x4*)(SR + 3 * AS + o) = v; *(GAS f32x4*)(SR + 4 * AS + o) = -kkn; *(GAS f32x4*)(SR + 5 * AS + o) = kkn * ag;
            if ((F.lane & 15) == 0) BON[m * 16 + hp * 4 + (F.lane >> 4)] = bo; }
    }
}

__device__ __forceinline__ void r4_scan(const Frame& F, const Args& a) {
    constexpr size_t ASZ = (size_t)T * 1024 * 4;
    float* YT = (float*)(a.ws + WS_XN);
    __builtin_amdgcn_s_setprio(3);
    for (int rb = F.vcu; rb < 256; rb += F.G) {
        const int row = rb * 8 + F.wave * 4 + (F.lane >> 4), ksub = F.lane & 15, bh = rb >> 3, vi = row & 63, b = bh >> 4, h = bh & 15;
        const GAS char* gsrc = (const GAS char*)(a.ws + WS_SCAN) + ((size_t)b * SEQ * 1024 + h * 64) * 4 + (size_t)(F.lane >> 4) * 4096 + (F.lane & 15) * 16;
        LAS unsigned char* ring = F.lds + F.wave * 49152;
        const LAS unsigned char* rd4 = ring + ksub * 16; const LAS unsigned char* rdv = ring + 3 * 8192 + vi * 4;
#define SC_DMA(tg) do { _Pragma("unroll") for (int ar_ = 0; ar_ < 6; ++ar_) \
            __builtin_amdgcn_global_load_lds((const GAS unsigned*)(gsrc + (size_t)ar_ * ASZ + (size_t)(tg) * 4096), (LAS unsigned*)(ring + ar_ * 8192 + ((tg) & 31) * 256), 16, 0, 0); } while (0)
#define SC_RD(s_, tq) do { const int so_ = ((tq) & 31) * 256; br[s_] = *(const LAS f32x4*)(rd4 + so_); bd[s_] = *(const LAS f32x4*)(rd4 + 8192 + so_); bk[s_] = *(const LAS f32x4*)(rd4 + 2 * 8192 + so_); \
            ba[s_] = *(const LAS f32x4*)(rd4 + 4 * 8192 + so_); bb[s_] = *(const LAS f32x4*)(rd4 + 5 * 8192 + so_); bv[s_] = *(const LAS float*)(rdv + so_); } while (0)
        f32x4 bd[2], bk[2], ba[2], bb[2], br[2]; float bv[2];
#pragma unroll
        for (int g = 0; g < 6; ++g) SC_DMA(4 * g);
        asm volatile("s_waitcnt vmcnt(0)" ::: "memory");
        SC_RD(0, 0); SC_RD(1, 1);
        f32x2 S01 = {0.f, 0.f}, S23 = {0.f, 0.f}; float ykeep = 0.f, yp = 0.f;
        GAS float* yrow = (GAS float*)YT + (size_t)row * SEQ;
#pragma unroll 1
        for (int t0 = 0; t0 < SEQ; t0 += 32) {
#pragma unroll
            for (int u = 0; u < 32; ++u) { const int s = u & 1;
                const f32x4 d4 = bd[s], k4 = bk[s], a4 = ba[s], b4 = bb[s], r4 = br[s]; const float vv = bv[s];
                if ((u & 3) == 0) SC_DMA(t0 + u + 24);
                if ((u & 3) == 2) asm volatile("s_waitcnt vmcnt(30)" ::: "memory");
                SC_RD(s, t0 + u + 2);
                f32x2 p = S01 * (f32x2){a4[0], a4[1]}; p = S23 * (f32x2){a4[2], a4[3]} + p;
                float sa = p.x + p.y;
                sa += dppf<0xB1>(sa); yp += dppf<0xB1>(yp); sa += dppf<0x4E>(sa); yp += dppf<0x4E>(yp); sa += dppf<0x141>(sa); yp += dppf<0x141>(yp); sa += dppf<0x140>(sa); yp += dppf<0x140>(yp);
                ykeep = (ksub == ((u + 15) & 15)) ? yp : ykeep;
                if ((u & 15) == 0) { if (t0 + u > 0) yrow[t0 + u - 16 + ksub] = ykeep; }
                f32x2 t01 = (f32x2){k4[0], k4[1]} * vv, t23 = (f32x2){k4[2], k4[3]} * vv;
                t01 = (f32x2){b4[0], b4[1]} * sa + t01; t23 = (f32x2){b4[2], b4[3]} * sa + t23;
                S01 = S01 * (f32x2){d4[0], d4[1]} + t01; S23 = S23 * (f32x2){d4[2], d4[3]} + t23;
                f32x2 q = S01 * (f32x2){r4[0], r4[1]}; q = S23 * (f32x2){r4[2], r4[3]} + q;
                yp = q.x + q.y;
                asm volatile("" : "+v"(S01), "+v"(S23), "+v"(ykeep), "+v"(yp) :: "memory"); }
        }
        yp = row16_sum(yp); ykeep = (ksub == 15) ? yp : ykeep; yrow[SEQ - 16 + ksub] = ykeep;
        asm volatile("s_waitcnt vmcnt(0)" ::: "memory");
#undef SC_DMA
#undef SC_RD
    }
    __builtin_amdgcn_s_setprio(0);
}

__device__ __forceinline__ void r5_finish(const Frame& F, const Args& a) {
    const float* YT = (const float*)(a.ws + WS_XN); const float* LO = (const float*)(a.ws + WS_LORAOUT); const float* SV = (const float*)(a.ws + WS_SCAN) + (size_t)3 * T * 1024; const float* BON = (const float*)(a.ws + WS_BONUS);
    bf16* YA = (bf16*)(a.ws + WS_YABC);
    LAS float* scr = (LAS float*)(F.lds + F.wave * 16640);
    const int gw = F.vcu * NWAVES + F.wave, NGW = F.G * NWAVES;
    for (int it = gw; it < 32 * 128; it += NGW) {
        const int bh = it >> 7, tt = it & 127, t0 = tt * 64, b = bh >> 4, h = bh & 15;
        float y[64]; float s = 0.f;
#pragma unroll
        for (int v = 0; v < 64; ++v) { y[v] = YT[(size_t)(bh * 64 + v) * SEQ + t0 + F.lane]; s += y[v]; }
        const float mean = s * (1.f / 64.f); float q = 0.f;
#pragma unroll
        for (int v = 0; v < 64; ++v) { const float d = y[v] - mean; q += d * d; }
        const float rstd = 1.0f / sqrtf(q * (1.f / 64.f) + GN_EPS);
#pragma unroll
        for (int v = 0; v < 64; ++v) scr[F.lane * 65 + v] = (y[v] - mean) * rstd;
        LDS_WAIT(); asm volatile("" ::: "memory");
        const int c = h * 64 + F.lane; const float lw = inp(I_LNW)[c], lb = inp(I_LNB)[c];
        for (int ti = 0; ti < 64; ++ti) { const int m = b * SEQ + t0 + ti;
            const float yn = scr[ti * 65 + F.lane];
            const float o = (yn * lw + lb + BON[m * 16 + h] * SV[(size_t)m * 1024 + c]) * LO[(size_t)m * 3072 + 2048 + c];
            YA[(size_t)m * 1024 + c] = (bf16)f2bf(o); }
        LDS_WAIT(); asm volatile("" ::: "memory");
    }
}

__device__ __forceinline__ float gelu_tanh(float x) { const float u = 0.7978845608028654f * (x + 0.044715f * x * x * x); const float t = 1.0f - 2.0f / (1.0f + __expf(2.0f * u)); return 0.5f * x * (1.0f + t); }
template <int CTRL> __device__ __forceinline__ float dpp_keep(float old, float x) { return __builtin_bit_cast(float, __builtin_amdgcn_update_dpp(__builtin_bit_cast(int, old), __builtin_bit_cast(int, x), CTRL, 0xf, 0xf, false)); }
template <bool FINAL> __device__ __forceinline__ void lru_pass(const Frame& F, const Args& a) {
    const bf16* P = (const bf16*)(a.ws + WS_P); const bf16* LW = (const bf16*)(a.ws + WS_LW);
    float* CA = (float*)(a.ws + WS_LRUC); float* CB = CA + 256 * 1024; const float* HIN = CB + 256 * 1024;
    bf16* YB = (bf16*)(a.ws + WS_YABC) + (size_t)T * 1024;
    const int gw = F.vcu * NWAVES + F.wave, NGW = F.G * NWAVES, tq = F.lane & 15, kq = F.lane >> 4;
    for (int it = gw; it < 256 * 16; it += NGW) {
        const int tt = it >> 4, n = it & 15, m0 = tt * 64, cb = n * 64 + 4 * kq;
        const bool seq0 = (m0 % SEQ) == 0;
        float hcar[4][4];
        float aprod[4][4];
#pragma unroll
        for (int vb = 0; vb < 4; ++vb)
#pragma unroll
            for (int i = 0; i < 4; ++i) { hcar[vb][i] = FINAL ? HIN[tt * 1024 + cb + 16 * vb + i] : 0.f; aprod[vb][i] = 1.f; }
        for (int tb = 0; tb < 4; ++tb) {
            const int m = m0 + 16 * tb + tq, tseq = m % SEQ;
            f32x4 xc[4];
#pragma unroll
            for (int vb = 0; vb < 4; ++vb) { const int c = cb + 16 * vb; f32x4 acc = *(const f32x4*)(inp(I_CONVB) + c);
#pragma unroll
                for (int j = 0; j < 4; ++j) { if (tseq - j >= 0) { const v2u pw = *(const v2u*)(P + (size_t)(m - j) * NP + PC_LX + c); const f32x4 cw = *(const f32x4*)(inp(I_CONVW) + j * 1024 + c);
                        acc[0] += cw[0] * bflo(pw.x); acc[1] += cw[1] * bfhi(pw.x); acc[2] += cw[2] * bflo(pw.y); acc[3] += cw[3] * bfhi(pw.y); } }
                xc[vb] = acc; }
            bf16x8 bfrag[2];
#pragma unroll
            for (int ks = 0; ks < 2; ++ks) { v4u w; w.x = pk2(xc[2 * ks][0], xc[2 * ks][1]); w.y = pk2(xc[2 * ks][2], xc[2 * ks][3]); w.z = pk2(xc[2 * ks + 1][0], xc[2 * ks + 1][1]); w.w = pk2(xc[2 * ks + 1][2], xc[2 * ks + 1][3]); bfrag[ks] = __builtin_bit_cast(bf16x8, w); }
#pragma unroll
            for (int vb = 0; vb < 4; ++vb) {
                f32x4 gr = {0.f, 0.f, 0.f, 0.f}, gi = {0.f, 0.f, 0.f, 0.f};
#pragma unroll
                for (int ks = 0; ks < 2; ++ks) { const bf16x8 wr_ = *(const bf16x8*)(LW + ((((size_t)(0 * 16 + n) * 4 + vb) * 2 + ks) * 64 + F.lane) * 8); const bf16x8 wi_ = *(const bf16x8*)(LW + ((((size_t)(1 * 16 + n) * 4 + vb) * 2 + ks) * 64 + F.lane) * 8);
                    gr = __builtin_amdgcn_mfma_f32_16x16x32_bf16(wr_, bfrag[ks], gr, 0, 0, 0); gi = __builtin_amdgcn_mfma_f32_16x16x32_bf16(wi_, bfrag[ks], gi, 0, 0, 0); }
                const int c = cb + 16 * vb;
                const f32x4 brv = *(const f32x4*)(inp(I_LBR) + c), biv = *(const f32x4*)(inp(I_LBI) + c), lam = *(const f32x4*)(inp(I_LAM) + c);
                v2u pyw; if (FINAL) pyw = *(const v2u*)(P + (size_t)m * NP + PC_LY + c);
                float hout[4];
#pragma unroll
                for (int i = 0; i < 4; ++i) {
                    const float g_r = sigm(gr[i] + brv[i]), g_i = sigm(gi[i] + biv[i]);
                    const float log_a = -8.0f * g_r * softplusf(-lam[i]);
                    float av = __expf(log_a); float mult = sqrtf(fmaxf(1.0f - __expf(2.0f * log_a), 0.f)); if (tseq == 0) mult = 1.0f;
                    float bv = mult * g_i * xc[vb][i];
                    { float pa = dpp_keep<0x111>(1.0f, av), pb = dpp_keep<0x111>(0.0f, bv); bv = av * pb + bv; av = av * pa; }
                    { float pa = dpp_keep<0x112>(1.0f, av), pb = dpp_keep<0x112>(0.0f, bv); bv = av * pb + bv; av = av * pa; }
                    { float pa = dpp_keep<0x114>(1.0f, av), pb = dpp_keep<0x114>(0.0f, bv); bv = av * pb + bv; av = av * pa; }
                    { float pa = dpp_keep<0x118>(1.0f, av), pb = dpp_keep<0x118>(0.0f, bv); bv = av * pb + bv; av = av * pa; }
                    const float hv = bv + av * hcar[vb][i];
                    const int l15 = (F.lane & 48) | 15;
                    const float hend = __shfl(hv, l15), aend = __shfl(av, l15);
                    hcar[vb][i] = hend; aprod[vb][i] *= aend; hout[i] = hv; }
                if (FINAL) { const float y0 = hout[0] * gelu_tanh(bflo(pyw.x)), y1 = hout[1] * gelu_tanh(bfhi(pyw.x)), y2 = hout[2] * gelu_tanh(bflo(pyw.y)), y3 = hout[3] * gelu_tanh(bfhi(pyw.y));
                    v2u w; w.x = pk2(y0, y1); w.y = pk2(y2, y3); *(v2u*)(YB + (size_t)m * 1024 + c) = w; }
            }
        }
        if (!FINAL && tq == 0) {
#pragma unroll
            for (int vb = 0; vb < 4; ++vb) { f32x4 pa, pb;
#pragma unroll
                for (int i = 0; i < 4; ++i) { pa[i] = aprod[vb][i]; pb[i] = hcar[vb][i]; }
                *(f32x4*)(CA + tt * 1024 + cb + 16 * vb) = pa; *(f32x4*)(CB + tt * 1024 + cb + 16 * vb) = pb; }
        }
        (void)seq0;
    }
}
__device__ __forceinline__ void lru_carry(const Frame& F, const Args& a) {
    const float* CA = (const float*)(a.ws + WS_LRUC); const float* CB = CA + 256 * 1024; float* HIN = (float*)CB + 256 * 1024;
    const int gt = F.vcu * (NWAVES * 64) + F.tid;
    if (gt < 2048) { const int b = gt >> 10, c = gt & 1023; float h = 0.f;
        for (int k = 0; k < 128; ++k) { const int tt = b * 128 + k; HIN[tt * 1024 + c] = h; h = CA[tt * 1024 + c] * h + CB[tt * 1024 + c]; } }
}

__device__ __forceinline__ void xattn_phase(const Frame& F, const Args& a) {
    const bf16* P = (const bf16*)(a.ws + WS_P); const bf16* KM = (const bf16*)(a.ws + WS_KMEM); const bf16* VT = (const bf16*)(a.ws + WS_VT);
    bf16* YC = (bf16*)(a.ws + WS_YABC) + (size_t)2 * T * 1024;
    const int gw = F.vcu * NWAVES + F.wave, NGW = F.G * NWAVES, tq = F.lane & 15, kq = F.lane >> 4;
    for (int it = gw; it < 4 * 1024; it += NGW) {
        const int h = it >> 10, tg = it & 1023, m0 = tg * 16, b = m0 / SEQ;
        bf16x8 qf[8];
#pragma unroll
        for (int ks = 0; ks < 8; ++ks) qf[ks] = *(const bf16x8*)(P + (size_t)(m0 + tq) * NP + PC_Q + h * 256 + 32 * ks + 8 * kq);
        f32x4 s[16];
#pragma unroll
        for (int mb = 0; mb < 16; ++mb) { f32x4 acc = {0.f, 0.f, 0.f, 0.f}; const bf16* kp = KM + (size_t)(b * 256 + 16 * mb + tq) * 1024 + h * 256 + 8 * kq;
#pragma unroll
            for (int ks = 0; ks < 8; ++ks) acc = __builtin_amdgcn_mfma_f32_16x16x32_bf16(*(const bf16x8*)(kp + 32 * ks), qf[ks], acc, 0, 0, 0);
            s[mb] = acc; asm volatile("" ::: "memory"); }
        float mx = -3.0e38f;
#pragma unroll
        for (int mb = 0; mb < 16; ++mb) { s[mb] = s[mb] * 0.0625f; mx = fmaxf(mx, fmaxf(fmaxf(s[mb][0], s[mb][1]), fmaxf(s[mb][2], s[mb][3]))); }
        mx = fmaxf(mx, __shfl_xor(mx, 16)); mx = fmaxf(mx, __shfl_xor(mx, 32));
        float sum = 0.f;
#pragma unroll
        for (int mb = 0; mb < 16; ++mb) {
#pragma unroll
            for (int i = 0; i < 4; ++i) { s[mb][i] = __expf(s[mb][i] - mx); sum += s[mb][i]; } }
        sum += __shfl_xor(sum, 16); sum += __shfl_xor(sum, 32);
        const float inv = 1.0f / sum;
        bf16x8 pf[8];
#pragma unroll
        for (int ks = 0; ks < 8; ++ks) { v4u w; w.x = pk2(s[2 * ks][0] * inv, s[2 * ks][1] * inv); w.y = pk2(s[2 * ks][2] * inv, s[2 * ks][3] * inv); w.z = pk2(s[2 * ks + 1][0] * inv, s[2 * ks + 1][1] * inv); w.w = pk2(s[2 * ks + 1][2] * inv, s[2 * ks + 1][3] * inv); pf[ks] = __builtin_bit_cast(bf16x8, w); }
#pragma unroll
        for (int db = 0; db < 16; ++db) { f32x4 acc = {0.f, 0.f, 0.f, 0.f}; const bf16* vp = VT + ((size_t)((b * 4 + h) * 256 + 16 * db + tq)) * 256 + 8 * kq;
#pragma unroll
            for (int ks = 0; ks < 8; ++ks) acc = __builtin_amdgcn_mfma_f32_16x16x32_bf16(*(const bf16x8*)(vp + 32 * ks), pf[ks], acc, 0, 0, 0);
            v2u w; w.x = pk2(acc[0], acc[1]); w.y = pk2(acc[2], acc[3]);
            *(v2u*)(YC + (size_t)(m0 + tq) * 1024 + h * 256 + 16 * db + 4 * kq) = w; asm volatile("" ::: "memory"); }
    }
}

__device__ __forceinline__ void router_phase(const Frame& F, const Args& a) {
    const float* H1 = (const float*)(a.ws + WS_H1); bf16* XN2 = (bf16*)(a.ws + WS_XN); const bf16* WR = (const bf16*)(a.ws + WS_WR);
    int* pick_e = (int*)(a.ws + WS_PICK); int* pick_rank = pick_e + 65536; float* pick_gate = (float*)(pick_rank + 65536);
    unsigned* gcnt = (unsigned*)(a.ws + WS_CTL) + CW_CNT;
    LAS float* lg = (LAS float*)(F.lds + F.wave * 4096);
    LAS unsigned* lcnt = (LAS unsigned*)(F.lds + 65536);
    const int tq = F.lane & 15, kq = F.lane >> 4;
    for (int g0 = F.vcu * 4; g0 < 1024; g0 += F.G * 4) {
        if (F.tid < 64) lcnt[F.tid] = 0u;
        __syncthreads();
        int me = 0, mrank = 0; float mgate = 0.f; int e4[4]; float g4[4]; int r4[4];
        const int m0 = (g0 + F.wave) * 16;
        if (F.wave < 4) {
            float myr = 0.f;
            for (int j = 0; j < 16; ++j) { const GAS f32x4* xr = (const GAS f32x4*)(H1 + (size_t)(m0 + j) * D) + F.lane; float s = 0.f;
#pragma unroll
                for (int q = 0; q < 8; ++q) { const f32x4 v = xr[64 * q]; s += (v.x * v.x + v.y * v.y) + (v.z * v.z + v.w * v.w); }
                const float rs = 1.0f / sqrtf(wave_sum(s) * (1.f / D) + EPS); if (tq == j) myr = rs; }
            f32x4 acc[2] = {{0.f, 0.f, 0.f, 0.f}, {0.f, 0.f, 0.f, 0.f}};
            const float* hrow = H1 + (size_t)(m0 + tq) * D + 8 * kq; const float* grow = inp(I_GFFN) + 8 * kq; bf16* xrow = XN2 + (size_t)(m0 + tq) * D + 8 * kq;
            for (int ks = 0; ks < 64; ++ks) {
                const f32x4 x0 = *(const f32x4*)(hrow + 32 * ks), x1 = *(const f32x4*)(hrow + 32 * ks + 4), g0v = *(const f32x4*)(grow + 32 * ks), g1v = *(const f32x4*)(grow + 32 * ks + 4);
                v4u w; w.x = pk2(x0[0] * myr * g0v[0], x0[1] * myr * g0v[1]); w.y = pk2(x0[2] * myr * g0v[2], x0[3] * myr * g0v[3]); w.z = pk2(x1[0] * myr * g1v[0], x1[1] * myr * g1v[1]); w.w = pk2(x1[2] * myr * g1v[2], x1[3] * myr * g1v[3]);
                *(v4u*)(xrow + 32 * ks) = w; const bf16x8 af = __builtin_bit_cast(bf16x8, w);
#pragma unroll
                for (int eh = 0; eh < 2; ++eh) { const bf16* wp = WR + (size_t)(16 * eh + tq) * D + 32 * ks + 8 * kq;
                    acc[eh] = __builtin_amdgcn_mfma_f32_16x16x32_bf16(af, *(const bf16x8*)wp, acc[eh], 0, 0, 0);
                    acc[eh] = __builtin_amdgcn_mfma_f32_16x16x32_bf16(af, *(const bf16x8*)(wp + 32 * D), acc[eh], 0, 0, 0); } }
#pragma unroll
            for (int eh = 0; eh < 2; ++eh)
#pragma unroll
                for (int i = 0; i < 4; ++i) lg[(4 * kq + i) * 33 + 16 * eh + tq] = acc[eh][i] + inp(I_BROUTER)[16 * eh + tq];
            LDS_WAIT(); asm volatile("" ::: "memory");
            if (F.lane < 16) { float v[32];
#pragma unroll
                for (int e = 0; e < 32; ++e) v[e] = lg[F.lane * 33 + e];
                float tv[4];
#pragma unroll
                for (int k = 0; k < 4; ++k) { float best = -3.0e38f; int bi = 0;
#pragma unroll
                    for (int e = 0; e < 32; ++e) { if (v[e] > best) { best = v[e]; bi = e; } }
                    tv[k] = best; e4[k] = bi;
#pragma unroll
                    for (int e = 0; e < 32; ++e) { if (e == bi) v[e] = -3.0e38f; } }
                float den = 0.f;
#pragma unroll
                for (int k = 0; k < 4; ++k) { g4[k] = __expf(tv[k] - tv[0]); den += g4[k]; }
#pragma unroll
                for (int k = 0; k < 4; ++k) { g4[k] = g4[k] / den; r4[k] = (int)atomicAdd((unsigned*)&lcnt[e4[k]], 1u); } }
        }
        __syncthreads();
        if (F.tid < 32) lcnt[32 + F.tid] = atomicAdd(&gcnt[F.tid], lcnt[F.tid]);
        __syncthreads();
        if (F.wave < 4 && F.lane < 16) {
#pragma unroll
            for (int k = 0; k < 4; ++k) { const int pi = (m0 + F.lane) * 4 + k; pick_e[pi] = e4[k]; pick_rank[pi] = (int)lcnt[32 + e4[k]] + r4[k]; pick_gate[pi] = g4[k]; } }
        __syncthreads();
        (void)me; (void)mrank; (void)mgate;
    }
}

__device__ __forceinline__ void scatter_phase(const Frame& F, const Args& a) {
    const bf16* XN2 = (const bf16*)(a.ws + WS_XN); bf16* XS = (bf16*)(a.ws + WS_XS);
    const int* pick_e = (const int*)(a.ws + WS_PICK); const int* pick_rank = pick_e + 65536; const float* pick_gate = (const float*)(pick_rank + 65536); int* pos = (int*)(pick_gate + 65536);
    float* gate_of_row = (float*)(a.ws + WS_ROWTAB);
    unsigned* ctl = (unsigned*)(a.ws + WS_CTL);
    LAS int* pst = (LAS int*)(F.lds);
    if (F.tid == 0) { int acc = 0; for (int e = 0; e < NE; ++e) { pst[e] = acc; const int c = (int)ctl[CW_CNT + e]; const int nt = (c + 255) >> 8;
            if (blockIdx.x == 0) for (int k = 0; k < nt; ++k) ctl[CW_TILEE + (acc >> 8) + k] = (unsigned)e;
            acc += nt << 8; }
        if (blockIdx.x == 0) ctl[CW_NTILES] = (unsigned)(acc >> 8); }
    __syncthreads();
    const int gw = F.vcu * NWAVES + F.wave, NGW = F.G * NWAVES;
    for (int pi = gw; pi < 65536; pi += NGW) {
        const int e = pick_e[pi], row = pst[e] + pick_rank[pi], tok = pi >> 2;
        if (F.lane == 0) { pos[pi] = row; gate_of_row[row] = pick_gate[pi]; }
        const GAS v4u* src = (const GAS v4u*)(XN2 + (size_t)tok * D) + F.lane; GAS v4u* dst = (GAS v4u*)(XS + (size_t)row * D) + F.lane;
#pragma unroll
        for (int q = 0; q < 4; ++q) dst[64 * q] = src[64 * q];
    }
}

__device__ __forceinline__ void final_phase(const Frame& F, const Args& a) {
    const float* H1 = (const float*)(a.ws + WS_H1); const bf16* OR = (const bf16*)(a.ws + WS_OROW);
    const int* pos = (const int*)(a.ws + WS_PICK) + 3 * 65536;
    const int gw = F.vcu * NWAVES + F.wave, NGW = F.G * NWAVES;
    for (int m = gw; m < T; m += NGW) {
        const GAS f32x4* xr = (const GAS f32x4*)(H1 + (size_t)m * D) + F.lane; const GAS f32x4* gr = (const GAS f32x4*)inp(I_GFINAL) + F.lane;
        f32x4 v[8];
#pragma unroll
        for (int j = 0; j < 8; ++j) v[j] = xr[64 * j];
#pragma unroll
        for (int k = 0; k < 4; ++k) { const int row = pos[m * 4 + k]; const GAS v2u* orp = (const GAS v2u*)(OR + (size_t)row * D) + F.lane;
#pragma unroll
            for (int j = 0; j < 8; ++j) { const v2u w = orp[64 * j]; v[j].x += bflo(w.x); v[j].y += bfhi(w.x); v[j].z += bflo(w.y); v[j].w += bfhi(w.y); } }
        float s = 0.f;
#pragma unroll
        for (int j = 0; j < 8; ++j) s += (v[j].x * v[j].x + v[j].y * v[j].y) + (v[j].z * v[j].z + v[j].w * v[j].w);
        const float rstd = 1.0f / sqrtf(wave_sum(s) * (1.f / D) + EPS);
        GAS f32x4* o = (GAS f32x4*)(a.out + (size_t)m * D) + F.lane;
#pragma unroll
        for (int j = 0; j < 8; ++j) { const f32x4 g = gr[64 * j]; o[64 * j] = (f32x4){v[j].x * rstd * g.x, v[j].y * rstd * g.y, v[j].z * rstd * g.z, v[j].w * rstd * g.w}; }
    }
}

#ifndef MK_N_LAUNCHES
#define MK_N_LAUNCHES 1
#endif
constexpr int NPH = 14;
__global__ void __launch_bounds__(NWAVES * 64, 2) fwd(Args args) {
    extern __shared__ __attribute__((aligned(16))) unsigned char lds[];
#define NEWFRAME() Frame F; { int tz = threadIdx.x; asm volatile("" : "+v"(tz)); F.lds = (LAS unsigned char*)lds; F.MISC = (volatile LAS unsigned*)(F.lds + MISC_OFF); F.tid = tz; F.lane = tz & 63; F.wave = __builtin_amdgcn_readfirstlane(tz >> 6); \
        F.G = gridDim.x; const int bx = blockIdx.x; F.vcu = (F.G % 8 == 0) ? (bx % 8) * (F.G / 8) + bx / 8 : bx; }
    unsigned char* ws = args.ws;
    unsigned* ctl = (unsigned*)(ws + WS_CTL);
    for (int u = threadIdx.x; u < (LDS_BYTES - MISC_OFF) / 4; u += NWAVES * 64) ((LAS unsigned*)((LAS unsigned char*)lds + MISC_OFF))[u] = 0u;
    __syncthreads();
    const int lo = args.ph_lo, hi = args.ph_hi;
    XcdBarrier bar; bar.bar = ctl + CW_BAR; bar.x = 0; bar.st = nullptr;
    if (hi - lo > 1) bar = xcd_barrier_post(ctl + CW_BAR, (volatile LAS unsigned*)((LAS unsigned char*)lds + MISC_OFF) + 8);
#ifndef PHMASK
#define PHMASK 0xFFFF
#endif
#define IN(k) (((PHMASK >> (k)) & 1) && lo <= (k) && (k) < hi)
#define SEAM(k) do { if (IN(k) && IN((k) + 1)) xcd_barrier(bar); } while (0)

    if (IN(0)) { NEWFRAME(); p0_prologue(F, args); } SEAM(0);
    if (IN(1)) { NEWFRAME();
        { pg8::Gemm g{(const bf16*)(ws + WS_XN), (const bf16*)(ws + WS_WIN), T, NP, D}; pg8::StaticOrder S; S.init(T, NP, F.G, (int)blockIdx.x);
          pg8::EpiBf16<0> E{(bf16*)(ws + WS_P), NP, nullptr, 0, 0, 1.f};
          pg8::gemm_phase<pg8::EpiBf16<0>, pg8::StaticOrder, true, true>(F.lds, g, S, E); }
        __syncthreads();
        { pg8::Gemm g{(const bf16*)(ws + WS_MN), (const bf16*)(ws + WS_WMKV), 512, 2048, D}; pg8::StaticOrder S; S.init(512, 2048, F.G, (int)((blockIdx.x + F.G / 2) % F.G));
          pg8::EpiKV E{(bf16*)(ws + WS_KMEM), (bf16*)(ws + WS_VT)};
          pg8::gemm_phase<pg8::EpiKV, pg8::StaticOrder, true, true>(F.lds, g, S, E); }
    } SEAM(1);
    if (IN(2)) { NEWFRAME();
#ifndef NO_R1
 r1_lora_in(F, args);
#endif
#ifndef NO_LRU
 lru_pass<false>(F, args);
#endif
#ifndef NO_XA
 xattn_phase(F, args);
#endif
 } SEAM(2);
    if (IN(3)) { NEWFRAME();
        lru_carry(F, args);
        { pg8::Gemm g{(const bf16*)(ws + WS_XN), (const bf16*)(ws + WS_WLORA), T, 3072, LORA_K}; pg8::StaticOrder S; S.init(T, 3072, F.G, (int)blockIdx.x);
          pg8::EpiF32 E{(float*)(ws + WS_LORAOUT), 3072};
          pg8::gemm_phase<pg8::EpiF32, pg8::StaticOrder, true, true>(F.lds, g, S, E); }
    } SEAM(3);
    if (IN(4)) { NEWFRAME(); r3_scan_inputs(F, args); lru_pass<true>(F, args); } SEAM(4);
    if (IN(5)) { NEWFRAME();
#ifndef NO_SCAN
 if (F.wave < 2) r4_scan(F, args);
#endif
#ifndef NO_CONV
 if (F.wave >= 2) moe_weight_convert(F, args, 2);
#endif
 } SEAM(5);
    if (IN(6)) { NEWFRAME(); r5_finish(F, args); } SEAM(6);
    if (IN(7)) { NEWFRAME();
        pg8::Gemm g{(const bf16*)(ws + WS_YABC), (const bf16*)(ws + WS_WBR), 3 * T, 3 * 2048, 1024}; pg8::BranchOrder S; S.init(F.G, (int)blockIdx.x);
        pg8::EpiBranch E{(const bf16*)(ws + WS_P), NP, PC_G, (float*)(ws + WS_MACC), (bf16*)(ws + WS_MERGED)};
        pg8::gemm_phase<pg8::EpiBranch, pg8::BranchOrder, true, true>(F.lds, g, S, E);
    } SEAM(7);
    if (IN(8)) { NEWFRAME();
        pg8::Gemm g{(const bf16*)(ws + WS_MERGED), (const bf16*)(ws + WS_WO), T, D, D}; pg8::StaticOrder S; S.init(T, D, F.G, (int)blockIdx.x);
        pg8::EpiRes E{inp(I_X), (float*)(ws + WS_H1), D};
        pg8::gemm_phase<pg8::EpiRes, pg8::StaticOrder, true, true>(F.lds, g, S, E);
    } SEAM(8);
    if (IN(9)) { NEWFRAME(); router_phase(F, args); } SEAM(9);
    if (IN(10)) { NEWFRAME(); scatter_phase(F, args); } SEAM(10);
    if (IN(11)) { NEWFRAME();
        const int ntiles = (int)__hip_atomic_load(ctl + CW_NTILES, __ATOMIC_RELAXED, __HIP_MEMORY_SCOPE_AGENT);
        pg8::Gemm g{(const bf16*)(ws + WS_XS), (const bf16*)(ws + WS_WGU), ntiles * 256, NE * 4096, D}; pg8::MoeOrder S; S.init(ntiles, 16, F.G, (int)blockIdx.x, (const int*)(ctl + CW_TILEE));
        pg8::EpiSwiglu E{(bf16*)(ws + WS_HH), inp(I_BGATE), inp(I_BUP)};
        pg8::gemm_phase<pg8::EpiSwiglu, pg8::MoeOrder, true, true>(F.lds, g, S, E);
    } SEAM(11);
    if (IN(12)) { NEWFRAME();
        const int ntiles = (int)__hip_atomic_load(ctl + CW_NTILES, __ATOMIC_RELAXED, __HIP_MEMORY_SCOPE_AGENT);
        pg8::Gemm g{(const bf16*)(ws + WS_HH), (const bf16*)(ws + WS_WD), ntiles * 256, NE * 2048, D}; pg8::MoeOrder S; S.init(ntiles, 8, F.G, (int)blockIdx.x, (const int*)(ctl + CW_TILEE));
        pg8::EpiDown E{(bf16*)(ws + WS_OROW), inp(I_BDOWN), (const float*)(ws + WS_ROWTAB)};
        pg8::gemm_phase<pg8::EpiDown, pg8::MoeOrder, true, true>(F.lds, g, S, E);
    } SEAM(12);
    if (IN(13)) { NEWFRAME(); final_phase(F, args); }
#ifdef PROBE_EXTRA_PHASE
    if (lo == 14) { NEWFRAME(); if (F.wave < 2) r4_scan(F, args); }
    if (lo == 15) { NEWFRAME(); if (F.wave >= 2) moe_weight_convert(F, args, 2); }
    if (lo == 16) { NEWFRAME(); moe_weight_convert(F, args, 0); }
#endif
#undef IN
#undef SEAM
}

extern "C" void kernel_launch(void* const* d_in, const int* in_sizes, int n_in, void* d_out, int out_size, void* d_ws, size_t ws_size, hipStream_t stream) {
    static int grid = 0;
    if (grid == 0) {
        if (n_in != 39 || out_size != T * D || ws_size < WS_END) { fprintf(stderr, "kernel_launch: built for 39 inputs, out of %d floats, >= %zu bytes of workspace; got n_in %d, out %d, ws %zu; nothing launched\n", T * D, (size_t)WS_END, n_in, out_size, ws_size); grid = -1; return; }
        int dev = 0, cus = 0, per_cu = 0;
        if (hipGetDevice(&dev) != hipSuccess || hipDeviceGetAttribute(&cus, hipDeviceAttributeMultiprocessorCount, dev) != hipSuccess) { fprintf(stderr, "kernel_launch: device query failed\n"); grid = -1; return; }
        if (hipFuncSetAttribute((const void*)fwd, hipFuncAttributeMaxDynamicSharedMemorySize, LDS_BYTES) != hipSuccess) { fprintf(stderr, "kernel_launch: hipFuncSetAttribute failed\n"); grid = -1; return; }
        if (hipOccupancyMaxActiveBlocksPerMultiprocessor(&per_cu, (const void*)fwd, NWAVES * 64, LDS_BYTES) != hipSuccess || per_cu < 1)
            fprintf(stderr, "kernel_launch: note: occupancy query reports %d workgroups per CU\n", per_cu);
        (void)hipGetLastError();
        grid = cus;
    }
    if (grid < 0) return;
    (void)in_sizes;
    if (hipMemsetAsync((char*)d_ws + WS_CTL, 0, CTL_ZERO_BYTES, stream) != hipSuccess) { fprintf(stderr, "kernel_launch: hipMemsetAsync failed\n"); return; }
    Args a{};
    for (int i = 0; i < 39; ++i) a.in[i] = (const float*)d_in[i];
    a.out = (float*)d_out; a.ws = (unsigned char*)d_ws;
#if MK_N_LAUNCHES == 1
    a.ph_lo = 0; a.ph_hi = NPH;
    hipLaunchKernelGGL(fwd, dim3(grid), dim3(NWAVES * 64), LDS_BYTES, stream, a);
#else
    for (int k = 0; k < NPH; ++k) { a.ph_lo = k; a.ph_hi = k + 1; int reps = 1;
#ifdef PROBE_REP_PHASE
        if (k == PROBE_REP_PHASE) reps = 1 + PROBE_REP_N;
#endif
        for (int r = 0; r < reps; ++r) hipLaunchKernelGGL(fwd, dim3(grid), dim3(NWAVES * 64), LDS_BYTES, stream, a); }
#ifdef PROBE_EXTRA_PHASE
    for (int r = 0; r < PROBE_REP_N; ++r) { a.ph_lo = PROBE_EXTRA_PHASE; a.ph_hi = PROBE_EXTRA_PHASE + 1; hipLaunchKernelGGL(fwd, dim3(grid), dim3(NWAVES * 64), LDS_BYTES, stream, a); }
#endif
#endif
    const hipError_t le = hipPeekAtLastError();
    if (le != hipSuccess) fprintf(stderr, "kernel_launch: launch failed: %s\n", hipGetErrorName(le));
}
```

```cpp
#include <hip/hip_runtime.h>
#include <cstdio>
#include <cstdint>
namespace pg8 {
#define PG8_LAS __attribute__((address_space(3)))
typedef unsigned short bf16_t;
typedef short bf16x8 __attribute__((ext_vector_type(8)));
typedef float f32x4 __attribute__((ext_vector_type(4)));
typedef unsigned u32x4 __attribute__((ext_vector_type(4)));
constexpr int BM = 256, BK = 64, HALF = 128, HTB = HALF * BK * 2  , STAGE_BYTES = 8 * HTB, NXCD = 8, WGM = 8;

__host__ __device__ __forceinline__ int lds_byte(int r, int c) { const int st = (r >> 4) * 2 + (c >> 5), rr = r & 15, cc = c & 31, ob = rr * 64 + cc * 2; return st * 1024 + (ob ^ (((ob >> 9) & 1) << 5)); }
__host__ __device__ __forceinline__ void stage_rc(int b, int& R, int& C) { const int st = b / 1024, sb = b % 1024, swz = sb ^ (((sb >> 9) & 1) << 5); R = (st >> 1) * 16 + swz / 64; C = (st & 1) * 32 + (swz % 64) / 2; }
__host__ __device__ __forceinline__ int perm32(int rho) { const int n = rho >> 4, i = rho & 15; return 8 * (i >> 2) + 4 * n + (i & 3); }

struct Unit { int pm, pn; };
struct Gemm { const bf16_t* A; const bf16_t* Bt; int M, N, K; };

struct StaticOrder {
    int nM, nN, nwg, G, c;
    __host__ __device__ void init(int M, int N, int G_, int c_) { nM = M / BM; nN = N / BM; nwg = nM * nN; G = G_; c = c_; }
    __host__ __device__ bool next(int i, Unit& u) const {
        const long L = (long)i * G + c; if (L >= nwg) return false;
        int wgid = (int)L; { const int q = nwg / NXCD, r = nwg % NXCD, xcd = wgid % NXCD, off = wgid / NXCD; wgid = (xcd < r ? xcd * (q + 1) : r * (q + 1) + (xcd - r) * q) + off; }
        const int nig = WGM * nN, gid = wgid / nig, fm = gid * WGM, gsz = (nM - fm) < WGM ? (nM - fm) : WGM;
        u.pm = fm + ((wgid % nig) % gsz); u.pn = (wgid % nig) / gsz; return true;
    }
    __device__ __forceinline__ void a_ready(const Unit&) const {}
    __device__ __forceinline__ void done(const Unit&) const {}
};
__device__ __forceinline__ unsigned cvt_pk_bf16(float lo, float hi) { unsigned r; asm volatile("v_cvt_pk_bf16_f32 %0, %1, %2" : "=v"(r) : "v"(lo), "v"(hi)); return r; }
typedef float f32x2 __attribute__((ext_vector_type(2)));
__device__ __forceinline__ f32x2 gelu_pk(f32x2 v) {
    const f32x2 av = __builtin_elementwise_abs(v), d = av * 0.2316418882f + 1.0f;
    f32x2 t; t.x = __builtin_amdgcn_rcpf(d.x); t.y = __builtin_amdgcn_rcpf(d.y);
    f32x2 q = t * 0.5307027145f + (-0.7265760135f); q = q * t + 0.7107068705f; q = q * t + (-0.142248368f); q = q * t + 0.127414796f; q = q * t;
    const f32x2 s = (v * v) * (-0.72134752044f);
    f32x2 e; e.x = __builtin_amdgcn_exp2f(s.x); e.y = __builtin_amdgcn_exp2f(s.y);
    const f32x2 m = v * (q * e), r = v - m;
    f32x2 o; o.x = v.x < 0.f ? m.x : r.x; o.y = v.y < 0.f ? m.y : r.y; return o;
}

template <int ACT  > struct EpiBf16 {
    static constexpr bool PERM = true, AFTER_DRAIN = false; static constexpr int MIDK = 0; static_assert(ACT == 0 || ACT == 1, "EpiBf16: ACT is 0 (none) or 1 (gelu_pk)");
    bf16_t* O; int ldc; const float* bias; int split_cols; size_t split_stride; float scale0;
    __device__ __forceinline__ void operator()(const f32x4 (&acc)[2][2][4][2], const Unit& u, int wr, int wc, int fr, int fq) const {
        const int row0 = u.pm * BM + wr * 64 + fr; int colt = u.pn * BM; bf16_t* base = O;
        float sc = 1.f; if (split_cols) { const int t = colt / split_cols; base += (size_t)t * split_stride; colt -= t * split_cols; if (t == 0) sc = scale0; }
        const int col0 = colt + wc * 32 + 8 * fq, bcol0 = u.pn * BM + wc * 32 + 8 * fq;
        f32x4 bv[2][2];
#pragma unroll
        for (int bj = 0; bj < 2; ++bj)
#pragma unroll
            for (int n = 0; n < 2; ++n) bv[bj][n] = bias ? *(const f32x4*)(bias + bcol0 + bj * HALF + 4 * n) : (f32x4){0.f, 0.f, 0.f, 0.f};
#pragma unroll
        for (int ai = 0; ai < 2; ++ai)
#pragma unroll
            for (int m = 0; m < 4; ++m) { bf16_t* rowp = base + (size_t)(row0 + ai * HALF + m * 16) * ldc + col0;
#pragma unroll
                for (int bj = 0; bj < 2; ++bj) { f32x4 v0 = acc[ai][bj][m][0] + bv[bj][0], v1 = acc[ai][bj][m][1] + bv[bj][1];
                    if (ACT == 1) { f32x2 a = gelu_pk((f32x2){v0[0], v0[1]}), b = gelu_pk((f32x2){v0[2], v0[3]}), c = gelu_pk((f32x2){v1[0], v1[1]}), d = gelu_pk((f32x2){v1[2], v1[3]});
                        v0 = (f32x4){a.x, a.y, b.x, b.y}; v1 = (f32x4){c.x, c.y, d.x, d.y}; }
                    v0 = v0 * sc; v1 = v1 * sc; u32x4 w; w.x = cvt_pk_bf16(v0[0], v0[1]); w.y = cvt_pk_bf16(v0[2], v0[3]); w.z = cvt_pk_bf16(v1[0], v1[1]); w.w = cvt_pk_bf16(v1[2], v1[3]);
                    *(u32x4*)(rowp + bj * HALF) = w; } }
    }
};

__device__ __forceinline__ float bf_lo(unsigned w) { return __builtin_bit_cast(float, w << 16); }
__device__ __forceinline__ float bf_hi(unsigned w) { return __builtin_bit_cast(float, w & 0xffff0000u); }
__device__ __forceinline__ float fsigmoid(float x) { return __builtin_amdgcn_rcpf(1.0f + __expf(-x)); }
typedef unsigned u32x2 __attribute__((ext_vector_type(2)));

struct EpiF32 {
    static constexpr bool PERM = false, AFTER_DRAIN = false; static constexpr int MIDK = 0;
    float* C; int ldc;
    __device__ __forceinline__ void operator()(const f32x4 (&acc)[2][2][4][2], const Unit& u, int wr, int wc, int fr, int fq) const {
        const int row0 = u.pm * BM + wr * 64 + fr, col0 = u.pn * BM + wc * 32 + 4 * fq;
#pragma unroll
        for (int ai = 0; ai < 2; ++ai)
#pragma unroll
            for (int m = 0; m < 4; ++m) { float* rowp = C + (size_t)(row0 + ai * HALF + m * 16) * ldc + col0;
#pragma unroll
                for (int bj = 0; bj < 2; ++bj)
#pragma unroll
                    for (int n = 0; n < 2; ++n) *(f32x4*)(rowp + bj * HALF + n * 16) = acc[ai][bj][m][n]; }
    }
};
struct EpiRes {
    static constexpr bool PERM = false, AFTER_DRAIN = false; static constexpr int MIDK = 0;
    const float* X; float* C; int ldc;
    __device__ __forceinline__ void operator()(const f32x4 (&acc)[2][2][4][2], const Unit& u, int wr, int wc, int fr, int fq) const {
        const int row0 = u.pm * BM + wr * 64 + fr, col0 = u.pn * BM + wc * 32 + 4 * fq;
#pragma unroll
        for (int ai = 0; ai < 2; ++ai)
#pragma unroll
            for (int m = 0; m < 4; ++m) { const size_t off = (size_t)(row0 + ai * HALF + m * 16) * ldc + col0;
#pragma unroll
                for (int bj = 0; bj < 2; ++bj)
#pragma unroll
                    for (int n = 0; n < 2; ++n) { const f32x4 xv = *(const f32x4*)(X + off + bj * HALF + n * 16); *(f32x4*)(C + off + bj * HALF + n * 16) = acc[ai][bj][m][n] + xv; }
                asm volatile("" ::: "memory"); }
    }
};
struct EpiKV {
    static constexpr bool PERM = false, AFTER_DRAIN = false; static constexpr int MIDK = 0;
    bf16_t* Kb; bf16_t* VT;
    __device__ __forceinline__ void operator()(const f32x4 (&acc)[2][2][4][2], const Unit& u, int wr, int wc, int fr, int fq) const {
        const int row0 = u.pm * BM + wr * 64 + fr, col0 = u.pn * BM + wc * 32 + 4 * fq;
#pragma unroll
        for (int ai = 0; ai < 2; ++ai)
#pragma unroll
            for (int m = 0; m < 4; ++m) { const int r = row0 + ai * HALF + m * 16;
#pragma unroll
                for (int bj = 0; bj < 2; ++bj)
#pragma unroll
                    for (int n = 0; n < 2; ++n) { const f32x4 v = acc[ai][bj][m][n]; const int c = col0 + bj * HALF + n * 16;
                        if (u.pn < 4) { u32x2 w; w.x = cvt_pk_bf16(v[0], v[1]); w.y = cvt_pk_bf16(v[2], v[3]); *(u32x2*)(Kb + (size_t)r * 1024 + c) = w; }
                        else { const int cc = c - 1024, h = cc >> 8, d = cc & 255, b = r >> 8, mm = r & 255;
                            const int idx = (mm >> 5) * 32 + ((mm >> 2) & 3) * 8 + ((mm >> 4) & 1) * 4 + (mm & 3);
                            bf16_t* o = VT + ((size_t)((b * 4 + h) * 256 + d)) * 256 + idx;
                            const unsigned w0 = cvt_pk_bf16(v[0], v[1]), w1 = cvt_pk_bf16(v[2], v[3]);
                            o[0] = (bf16_t)(w0 & 0xffffu); o[256] = (bf16_t)(w0 >> 16); o[512] = (bf16_t)(w1 & 0xffffu); o[768] = (bf16_t)(w1 >> 16); } } }
    }
};
struct EpiBranch {
    static constexpr bool PERM = false, AFTER_DRAIN = false; static constexpr int MIDK = 0;
    const bf16_t* P; int ldp; int gcol0; float* macc; bf16_t* merged;
    __device__ __forceinline__ void operator()(const f32x4 (&acc)[2][2][4][2], const Unit& u, int wr, int wc, int fr, int fq) const {
        const int br = u.pm >> 6, pm = u.pm & 63, pn = u.pn & 7;
        const int row0 = pm * BM + wr * 64 + fr, col0 = pn * BM + wc * 32 + 4 * fq;
#pragma unroll
        for (int ai = 0; ai < 2; ++ai)
#pragma unroll
            for (int m = 0; m < 4; ++m) { const int r = row0 + ai * HALF + m * 16; const bf16_t* prow = P + (size_t)r * ldp + gcol0 + br * 2048;
#pragma unroll
                for (int bj = 0; bj < 2; ++bj)
#pragma unroll
                    for (int n = 0; n < 2; ++n) { const int c = col0 + bj * HALF + n * 16; const u32x2 gw = *(const u32x2*)(prow + c);
                        f32x4 g; g[0] = fsigmoid(bf_lo(gw.x)); g[1] = fsigmoid(bf_hi(gw.x)); g[2] = fsigmoid(bf_lo(gw.y)); g[3] = fsigmoid(bf_hi(gw.y));
                        f32x4 v = acc[ai][bj][m][n] * g; float* mp = macc + (size_t)r * 2048 + c;
                        if (br > 0) v = v + *(const f32x4*)mp;
                        if (br < 2) *(f32x4*)mp = v;
                        else { u32x2 w; w.x = cvt_pk_bf16(v[0], v[1]); w.y = cvt_pk_bf16(v[2], v[3]); *(u32x2*)(merged + (size_t)r * 2048 + c) = w; } }
                asm volatile("" ::: "memory"); }
    }
};
struct EpiSwiglu {
    static constexpr bool PERM = true, AFTER_DRAIN = false; static constexpr int MIDK = 0;
    bf16_t* H; const float* bg; const float* bu;
    __device__ __forceinline__ void operator()(const f32x4 (&acc)[2][2][4][2], const Unit& u, int wr, int wc, int fr, int fq) const {
        const int e = u.pn >> 4, ct = u.pn & 15;
        const int row0 = u.pm * BM + wr * 64 + fr, col0 = ct * 128 + wc * 32 + 8 * fq;
        f32x4 bgv[2], buv[2];
#pragma unroll
        for (int n = 0; n < 2; ++n) { bgv[n] = *(const f32x4*)(bg + (size_t)e * 2048 + col0 + 4 * n); buv[n] = *(const f32x4*)(bu + (size_t)e * 2048 + col0 + 4 * n); }
#pragma unroll
        for (int ai = 0; ai < 2; ++ai)
#pragma unroll
            for (int m = 0; m < 4; ++m) { bf16_t* rowp = H + (size_t)(row0 + ai * HALF + m * 16) * 2048 + col0;
                f32x4 o[2];
#pragma unroll
                for (int n = 0; n < 2; ++n) { const f32x4 g = acc[ai][0][m][n] + bgv[n], up = acc[ai][1][m][n] + buv[n];
#pragma unroll
                    for (int j = 0; j < 4; ++j) { const float hg = fminf(g[j], 7.0f), hu = fminf(fmaxf(up[j], -7.0f), 7.0f); o[n][j] = (hu + 1.0f) * hg * fsigmoid(1.702f * hg); } }
                u32x4 w; w.x = cvt_pk_bf16(o[0][0], o[0][1]); w.y = cvt_pk_bf16(o[0][2], o[0][3]); w.z = cvt_pk_bf16(o[1][0], o[1][1]); w.w = cvt_pk_bf16(o[1][2], o[1][3]);
                *(u32x4*)rowp = w; }
    }
};
struct EpiDown {
    static constexpr bool PERM = true, AFTER_DRAIN = false; static constexpr int MIDK = 0;
    bf16_t* O; const float* bd; const float* rowgate;
    __device__ __forceinline__ void operator()(const f32x4 (&acc)[2][2][4][2], const Unit& u, int wr, int wc, int fr, int fq) const {
        const int e = u.pn >> 3, ct = u.pn & 7;
        const int row0 = u.pm * BM + wr * 64 + fr, col0 = ct * BM + wc * 32 + 8 * fq;
        f32x4 bv[2][2];
#pragma unroll
        for (int bj = 0; bj < 2; ++bj)
#pragma unroll
            for (int n = 0; n < 2; ++n) bv[bj][n] = *(const f32x4*)(bd + (size_t)e * 2048 + col0 + bj * HALF + 4 * n);
#pragma unroll
        for (int ai = 0; ai < 2; ++ai)
#pragma unroll
            for (int m = 0; m < 4; ++m) { const int r = row0 + ai * HALF + m * 16; const float gs = rowgate[r]; bf16_t* rowp = O + (size_t)r * 2048 + col0;
#pragma unroll
                for (int bj = 0; bj < 2; ++bj) { const f32x4 v0 = (acc[ai][bj][m][0] + bv[bj][0]) * gs, v1 = (acc[ai][bj][m][1] + bv[bj][1]) * gs;
                    u32x4 w; w.x = cvt_pk_bf16(v0[0], v0[1]); w.y = cvt_pk_bf16(v0[2], v0[3]); w.z = cvt_pk_bf16(v1[0], v1[1]); w.w = cvt_pk_bf16(v1[2], v1[3]);
                    *(u32x4*)(rowp + bj * HALF) = w; } }
    }
};

struct EpiBranch2 {
    static constexpr bool PERM = false, AFTER_DRAIN = false; static constexpr int MIDK = 16;
    const bf16_t* P; int ldp; int gcol0; bf16_t* merged;
    __device__ __forceinline__ void mid(f32x4 (&acc)[2][2][4][2], const Unit& u, int which, int, int, int, int) const {
        int tz = threadIdx.x; asm volatile("" : "+v"(tz));
        const int wid_ = tz >> 6, lane_ = tz & 63, wr = wid_ >> 2, wc = wid_ & 3, fr = lane_ & 15, fq = lane_ >> 4;
        const int row0 = u.pm * BM + wr * 64 + fr, col0 = u.pn * BM + wc * 32 + 4 * fq;
#pragma unroll
        for (int ai = 0; ai < 2; ++ai)
#pragma unroll
            for (int m = 0; m < 4; ++m) { const bf16_t* prow = P + (size_t)(row0 + ai * HALF + m * 16) * ldp + gcol0 + (which - 1) * 2048;
#pragma unroll
                for (int bj = 0; bj < 2; ++bj)
#pragma unroll
                    for (int n = 0; n < 2; ++n) { const int c = col0 + bj * HALF + n * 16; const u32x2 ga = *(const u32x2*)(prow + c), gb = *(const u32x2*)(prow + 2048 + c);
                        const float a_[4] = {bf_lo(ga.x), bf_hi(ga.x), bf_lo(ga.y), bf_hi(ga.y)}, b_[4] = {bf_lo(gb.x), bf_hi(gb.x), bf_lo(gb.y), bf_hi(gb.y)};
#pragma unroll
                        for (int j = 0; j < 4; ++j) { const float ea = __expf(-fminf(fmaxf(a_[j], -30.f), 30.f)), eb = __expf(-fminf(fmaxf(b_[j], -30.f), 30.f));
                            acc[ai][bj][m][n][j] *= (1.0f + eb) * __builtin_amdgcn_rcpf(1.0f + ea); } }
                asm volatile("" ::: "memory"); }
    }
    __device__ __forceinline__ void operator()(const f32x4 (&acc)[2][2][4][2], const Unit& u, int wr, int wc, int fr, int fq) const {
        const int row0 = u.pm * BM + wr * 64 + fr, col0 = u.pn * BM + wc * 32 + 4 * fq;
#pragma unroll
        for (int ai = 0; ai < 2; ++ai)
#pragma unroll
            for (int m = 0; m < 4; ++m) { const int r = row0 + ai * HALF + m * 16; const bf16_t* prow = P + (size_t)r * ldp + gcol0 + 2 * 2048;
#pragma unroll
                for (int bj = 0; bj < 2; ++bj)
#pragma unroll
                    for (int n = 0; n < 2; ++n) { const int c = col0 + bj * HALF + n * 16; const u32x2 gw = *(const u32x2*)(prow + c);
                        const float g_[4] = {bf_lo(gw.x), bf_hi(gw.x), bf_lo(gw.y), bf_hi(gw.y)}; f32x4 v = acc[ai][bj][m][n];
#pragma unroll
                        for (int j = 0; j < 4; ++j) v[j] *= __builtin_amdgcn_rcpf(1.0f + __expf(-fminf(fmaxf(g_[j], -30.f), 30.f)));
                        u32x2 w; w.x = cvt_pk_bf16(v[0], v[1]); w.y = cvt_pk_bf16(v[2], v[3]); *(u32x2*)(merged + (size_t)r * 2048 + c) = w; }
                asm volatile("" ::: "memory"); }
    }
};
struct BranchOrder {
    StaticOrder so;
    __device__ void init(int G_, int c_) { so.init(16384, 2048, G_, c_); }
    __device__ bool next(int i, Unit& u) const { const int br = i % 3; Unit t; if (!so.next(i / 3, t)) return false; u.pm = br * 64 + t.pm; u.pn = br * 8 + t.pn; return true; }
    __device__ __forceinline__ void a_ready(const Unit&) const {}
    __device__ __forceinline__ void done(const Unit&) const {}
};
struct MoeOrder {
    StaticOrder so; const int* tile_e; int nN;
    __device__ void init(int ntiles, int nN_, int G_, int c_, const int* te) { so.init(ntiles * BM, nN_ * BM, G_, c_); tile_e = te; nN = nN_; }
    __device__ bool next(int i, Unit& u) const { Unit t; if (!so.next(i, t)) return false; u.pm = t.pm; u.pn = tile_e[t.pm] * nN + t.pn; return true; }
    __device__ __forceinline__ void a_ready(const Unit&) const {}
    __device__ __forceinline__ void done(const Unit&) const {}
};
template <class Epi, class Sched, bool ALIGN_EPI = false, bool SP2 = false>
__device__ __forceinline__ void gemm_phase(PG8_LAS unsigned char* lds, const Gemm g, const Sched& S, const Epi& E) {
    const int tid = threadIdx.x, wid = __builtin_amdgcn_readfirstlane(tid >> 6), lane = tid & 63, wr = wid >> 2, wc = wid & 3, fr = lane & 15, fq = lane >> 4;
    const int K = g.K, nt = K / BK;
    unsigned voffA[2], voffB[2];
#pragma unroll
    for (int i = 0; i < 2; ++i) { int R, C; stage_rc(tid * 16 + i * 8192, R, C); const int Rb = Epi::PERM ? ((R & ~31) + perm32(R & 31)) : R;
        voffA[i] = (unsigned)(R * K + C) * 2u; voffB[i] = (unsigned)(Rb * K + C) * 2u; }
    const size_t kstep = (size_t)(BK * 2);
    const size_t hstep = (size_t)HALF * K * 2;
    const size_t tstep = 2 * hstep;
    const unsigned ldsw = (unsigned)wid * 1024u;
    const int aoff = lds_byte(wr * 64 + fr, fq * 8), boff = lds_byte(wc * 32 + fr, fq * 8);
#define PG8_SA(b, h) (((b) * 2 + (h)) * HTB)
#define PG8_SB(b, h) ((4 + (b) * 2 + (h)) * HTB)
#define PG8_STAGE(bufoff, gbase, voff) do { _Pragma("unroll") for (int _i = 0; _i < 2; ++_i) \
        __builtin_amdgcn_global_load_lds((const unsigned*)((const char*)(gbase) + (voff)[_i]), (PG8_LAS unsigned*)(lds + (bufoff) + ldsw + _i * 8192), 16, 0, 0); } while (0)
#define PG8_LDA(dst, b, h) do { _Pragma("unroll") for (int m = 0; m < 4; ++m) _Pragma("unroll") for (int k = 0; k < 2; ++k) dst[m][k] = *(const PG8_LAS bf16x8*)(lds + PG8_SA(b, h) + aoff + m * 2048 + k * 1024); } while (0)
#define PG8_LDB(dst, b, h) do { _Pragma("unroll") for (int n = 0; n < 2; ++n) _Pragma("unroll") for (int k = 0; k < 2; ++k) dst[n][k] = *(const PG8_LAS bf16x8*)(lds + PG8_SB(b, h) + boff + n * 2048 + k * 1024); } while (0)
#define PG8_MMA(ai, bj, At, Bt) do { __builtin_amdgcn_s_setprio(1); _Pragma("unroll") for (int m = 0; m < 4; ++m) _Pragma("unroll") for (int n = 0; n < 2; ++n) _Pragma("unroll") for (int k = 0; k < 2; ++k) \
        acc[ai][bj][m][n] = __builtin_amdgcn_mfma_f32_16x16x32_bf16(Bt[n][k], At[m][k], acc[ai][bj][m][n], 0, 0, 0); __builtin_amdgcn_s_setprio(0); } while (0)
#define PG8_WAIT_V(n) asm volatile("s_waitcnt vmcnt(" #n ")" ::: "memory")
#define PG8_WAIT_L(n) asm volatile("s_waitcnt lgkmcnt(" #n ")" ::: "memory")
#define PG8_BAR __builtin_amdgcn_s_barrier()
#define PG8_SCHED __builtin_amdgcn_sched_barrier(0)
    Unit cur, nxt; int ui = 0;
    if (!S.next(0, cur)) return;
    f32x4 acc[2][2][4][2];
#pragma unroll
    for (int a = 0; a < 2; ++a)
#pragma unroll
        for (int b = 0; b < 2; ++b)
#pragma unroll
            for (int m = 0; m < 4; ++m)
#pragma unroll
                for (int n = 0; n < 2; ++n) acc[a][b][m][n] = (f32x4){0.f, 0.f, 0.f, 0.f};
    bf16x8 At[4][2], B0[2][2], B1[2][2];
    const char* cA = (const char*)g.A + (size_t)cur.pm * tstep; const char* cB = (const char*)g.Bt + (size_t)cur.pn * tstep;
    S.a_ready(cur);
    if constexpr (SP2) {
        PG8_STAGE(PG8_SB(0, 0), cB, voffB); PG8_STAGE(PG8_SB(0, 1), cB + hstep, voffB); PG8_STAGE(PG8_SA(0, 0), cA, voffA); PG8_STAGE(PG8_SA(0, 1), cA + hstep, voffA);
        if (wr == 1) PG8_BAR;
        PG8_WAIT_V(2); PG8_BAR;
        PG8_STAGE(PG8_SB(1, 0), cB + kstep, voffB); PG8_STAGE(PG8_SA(1, 0), cA + kstep, voffA); PG8_STAGE(PG8_SB(1, 1), cB + hstep + kstep, voffB);
        PG8_WAIT_V(6); PG8_BAR;
    } else {
        PG8_STAGE(PG8_SB(0, 0), cB, voffB); PG8_STAGE(PG8_SA(0, 0), cA, voffA); PG8_STAGE(PG8_SB(0, 1), cB + hstep, voffB); PG8_STAGE(PG8_SA(0, 1), cA + hstep, voffA);
        if (wr == 1) PG8_BAR;
        PG8_WAIT_V(4); PG8_BAR;
        PG8_STAGE(PG8_SB(1, 0), cB + kstep, voffB); PG8_STAGE(PG8_SA(1, 0), cA + kstep, voffA); PG8_STAGE(PG8_SB(1, 1), cB + hstep + kstep, voffB);
        PG8_WAIT_V(6); PG8_BAR;
    }
    for (;;) {
        const bool has_next = S.next(ui + 1, nxt);
        const char* nA = has_next ? (const char*)g.A + (size_t)nxt.pm * tstep : cA; const char* nB = has_next ? (const char*)g.Bt + (size_t)nxt.pn * tstep : cB;
        for (int t = 0; t < nt; t += 2) {
            const bool last = (t == nt - 2);
            const char* a1 = cA + (size_t)(t + 1) * kstep;
            const char* a2 = last ? nA : cA + (size_t)(t + 2) * kstep; const char* b2 = last ? nB : cB + (size_t)(t + 2) * kstep;
            const char* a3 = a2 + kstep; const char* b3 = b2 + kstep;
            if (last && has_next) S.a_ready(nxt);
            if constexpr (Epi::MIDK > 0) { if (t == Epi::MIDK || t == 2 * Epi::MIDK) E.mid(acc, cur, t / Epi::MIDK, wr, wc, fr, fq); }
            if constexpr (SP2) {
            PG8_LDB(B0, 0, 0); PG8_LDB(B1, 0, 1); PG8_SCHED; PG8_LDA(At, 0, 0); PG8_STAGE(PG8_SA(1, 1), a1 + hstep, voffA);
            PG8_WAIT_V(8); PG8_WAIT_L(0); PG8_BAR; PG8_MMA(0, 0, At, B0); PG8_MMA(0, 1, At, B1); PG8_BAR; PG8_SCHED;
            PG8_LDA(At, 0, 1); PG8_STAGE(PG8_SB(0, 0), b2, voffB); PG8_STAGE(PG8_SB(0, 1), b2 + hstep, voffB); PG8_STAGE(PG8_SA(0, 0), a2, voffA);
            PG8_WAIT_V(8); PG8_WAIT_L(0); PG8_BAR; PG8_MMA(1, 0, At, B0); PG8_MMA(1, 1, At, B1); PG8_BAR; PG8_SCHED;
            PG8_LDB(B0, 1, 0); PG8_LDB(B1, 1, 1); PG8_SCHED; PG8_LDA(At, 1, 0); PG8_STAGE(PG8_SA(0, 1), a2 + hstep, voffA);
            PG8_WAIT_V(8); PG8_WAIT_L(0); PG8_BAR; PG8_MMA(0, 0, At, B0); PG8_MMA(0, 1, At, B1); PG8_BAR; PG8_SCHED;
            PG8_LDA(At, 1, 1); PG8_STAGE(PG8_SB(1, 0), b3, voffB); PG8_STAGE(PG8_SB(1, 1), b3 + hstep, voffB); PG8_STAGE(PG8_SA(1, 0), a3, voffA);
            PG8_WAIT_V(8); PG8_WAIT_L(0); PG8_BAR; PG8_MMA(1, 0, At, B0); PG8_MMA(1, 1, At, B1); PG8_BAR; PG8_SCHED;
            } else {
            PG8_LDB(B0, 0, 0); PG8_SCHED; PG8_LDA(At, 0, 0); PG8_STAGE(PG8_SA(1, 1), a1 + hstep, voffA);
            PG8_WAIT_L(8); PG8_BAR; PG8_WAIT_L(0); PG8_MMA(0, 0, At, B0); PG8_BAR; PG8_SCHED;
            PG8_LDB(B1, 0, 1); PG8_STAGE(PG8_SB(0, 0), b2, voffB);
            PG8_BAR; PG8_WAIT_L(0); PG8_MMA(0, 1, At, B1); PG8_BAR;
            PG8_LDA(At, 0, 1); PG8_STAGE(PG8_SA(0, 0), a2, voffA);
            PG8_BAR; PG8_WAIT_L(0); PG8_MMA(1, 0, At, B0); PG8_BAR; PG8_SCHED;
            PG8_STAGE(PG8_SB(0, 1), b2 + hstep, voffB);
            PG8_WAIT_V(6); PG8_BAR; PG8_MMA(1, 1, At, B1); PG8_BAR;
            PG8_LDB(B0, 1, 0); PG8_SCHED; PG8_LDA(At, 1, 0); PG8_STAGE(PG8_SA(0, 1), a2 + hstep, voffA);
            PG8_WAIT_L(8); PG8_BAR; PG8_WAIT_L(0); PG8_MMA(0, 0, At, B0); PG8_BAR; PG8_SCHED;
            PG8_LDB(B1, 1, 1); PG8_STAGE(PG8_SB(1, 0), b3, voffB);
            PG8_BAR; PG8_WAIT_L(0); PG8_MMA(0, 1, At, B1); PG8_BAR;
            PG8_LDA(At, 1, 1); PG8_STAGE(PG8_SA(1, 0), a3, voffA);
            PG8_BAR; PG8_WAIT_L(0); PG8_MMA(1, 0, At, B0); PG8_BAR; PG8_SCHED;
            PG8_STAGE(PG8_SB(1, 1), b3 + hstep, voffB);
            PG8_WAIT_V(6); PG8_BAR; PG8_MMA(1, 1, At, B1); PG8_BAR;
            }
        }
        if constexpr (ALIGN_EPI) { if (wr == 0) PG8_BAR; }
        if constexpr (!Epi::AFTER_DRAIN) { E(acc, cur, wr, wc, fr, fq); S.done(cur); }
        if (!has_next) break;
#pragma unroll
        for (int a = 0; a < 2; ++a)
#pragma unroll
            for (int b = 0; b < 2; ++b)
#pragma unroll
                for (int m = 0; m < 4; ++m)
#pragma unroll
                    for (int n = 0; n < 2; ++n) acc[a][b][m][n] = (f32x4){0.f, 0.f, 0.f, 0.f};
        cur = nxt; cA = nA; cB = nB; ++ui;
        if constexpr (ALIGN_EPI) { if (wr == 1) PG8_BAR; }
    }
    PG8_WAIT_V(0);
    if constexpr (!ALIGN_EPI) { if (wr == 0) PG8_BAR; }
    PG8_BAR;
    if constexpr (Epi::AFTER_DRAIN) { E.fused(acc, cur, wr, wc, fr, fq, lds, wid, lane); S.done(cur); }
#undef PG8_SA
#undef PG8_SB
#undef PG8_STAGE
#undef PG8_LDA
#undef PG8_LDB
#undef PG8_MMA
#undef PG8_WAIT_V
#undef PG8_WAIT_L
#undef PG8_BAR
#undef PG8_SCHED
}
}

constexpr int NWAVES = 8;
constexpr int BATCH = 2, SEQ = 8192, T = BATCH * SEQ, D = 2048;
constexpr int RWKV_COLS = 3360, IN_COLS = 12576;
constexpr int NP = 12800;
constexpr int PC_LX = 3584, PC_LY = 4608, PC_Q = 5632, PC_G = 6656;
constexpr int NE = 32, MAXROWS = 65536 + NE * 256;
constexpr int LORA_K = 384;
constexpr float EPS = 1e-6f, GN_EPS = 64e-5f;

constexpr size_t MiB = 1u << 20;
constexpr size_t WS_CTL = 0, CTL_ZERO_BYTES = 1 * MiB;
constexpr size_t WS_WIN = 1 * MiB, WS_WMKV = 51 * MiB, WS_WLORA = 59 * MiB, WS_WBR = 62 * MiB, WS_WO = 74 * MiB, WS_WR = 82 * MiB, WS_LW = 83 * MiB;
constexpr size_t WS_WGU = 84 * MiB, WS_WD = 596 * MiB;
constexpr size_t WS_XN = 852 * MiB;
constexpr size_t WS_P = 916 * MiB;
constexpr size_t WS_LORAOUT = 1316 * MiB;
constexpr size_t WS_SCAN = 1508 * MiB;
constexpr size_t WS_YABC = 1892 * MiB;
constexpr size_t WS_MISC = 1988 * MiB;
constexpr size_t WS_MN = WS_MISC, WS_KMEM = WS_MISC + 2 * MiB, WS_VT = WS_MISC + 3 * MiB, WS_LRUC = WS_MISC + 4 * MiB  , WS_BONUS = WS_MISC + 7 * MiB;
constexpr size_t WS_PICK = WS_MISC + 8 * MiB  , WS_ROWTAB = WS_MISC + 9 * MiB  , WS_SPL = WS_ROWTAB + 512 * 1024  ;
constexpr size_t WS_END = 2000 * MiB;
constexpr size_t WS_MACC = WS_LORAOUT, WS_MERGED = 1444 * MiB, WS_H1 = WS_SCAN, WS_XS = WS_P, WS_OROW = WS_P, WS_HH = 1204 * MiB;
constexpr int CW_BAR = 4096, CW_CNT = 8192, CW_NTILES = 8192 + 64, CW_TILEE = 8192 + 128;

constexpr int LDS_BYTES = 147456;
constexpr int MISC_OFF = 143360;

#define GAS __attribute__((address_space(1)))
#define LAS __attribute__((address_space(3)))
typedef unsigned short bf16;
typedef unsigned v4u __attribute__((ext_vector_type(4)));
typedef unsigned v2u __attribute__((ext_vector_type(2)));
typedef float f32x4 __attribute__((ext_vector_type(4)));
typedef float f32x2 __attribute__((ext_vector_type(2)));
typedef short bf16x8 __attribute__((ext_vector_type(8)));
#define LDS_WAIT() asm volatile("s_waitcnt lgkmcnt(0)" ::: "memory")
#define VM_WAIT() asm volatile("s_waitcnt vmcnt(0)" ::: "memory")
__device__ __forceinline__ unsigned f2bf(float f) { unsigned u = __builtin_bit_cast(unsigned, f); return (u + 0x7fffu + ((u >> 16) & 1u)) >> 16; }
__device__ __forceinline__ unsigned pk2(float lo, float hi) { return f2bf(lo) | (f2bf(hi) << 16); }
__device__ __forceinline__ float bflo(unsigned w) { return __builtin_bit_cast(float, w << 16); }
__device__ __forceinline__ float bfhi(unsigned w) { return __builtin_bit_cast(float, w & 0xffff0000u); }
__device__ __forceinline__ float bf1(bf16 b) { return __builtin_bit_cast(float, (unsigned)b << 16); }
__device__ __forceinline__ float sigm(float x) { return __builtin_amdgcn_rcpf(1.0f + __expf(-x)); }
__device__ __forceinline__ float fast_tanh(float x) { const float e = __expf(2.0f * x); return 1.0f - 2.0f * __builtin_amdgcn_rcpf(e + 1.0f); }
__device__ __forceinline__ float softplusf(float x) { return fmaxf(x, 0.f) + log1pf(__expf(-fabsf(x))); }
__device__ __forceinline__ float wave_sum(float v) {
#pragma unroll
    for (int o = 1; o < 64; o <<= 1) v += __shfl_xor(v, o);
    return v;
}
template <int CTRL> __device__ __forceinline__ float dppf(float x) { return __builtin_bit_cast(float, __builtin_amdgcn_mov_dpp(__builtin_bit_cast(int, x), CTRL, 0xf, 0xf, true)); }
__device__ __forceinline__ float row16_sum(float v) {
    v += dppf<0xB1>(v); v += dppf<0x4E>(v); v += dppf<0x141>(v); v += dppf<0x140>(v); return v;
}
#define XB_TMO      128
#define XB_XCNT(j)  (256  + 64 * (j))
#define XB_XSUB(j)  (1280 + 64 * (j))
#define XB_XGEN(j)  (2304 + 64 * (j))
#define XB_TOP      3328
#define XB_TOPGEN   3392
#define XCD_BAR_WORDS 3456
#define XB_SPIN_CAP (1u << 18)

__device__ __forceinline__ unsigned xb_ld(unsigned* p)              { return __hip_atomic_load(p, __ATOMIC_RELAXED, __HIP_MEMORY_SCOPE_AGENT); }
__device__ __forceinline__ unsigned xb_add(unsigned* p, unsigned v) { return __hip_atomic_fetch_add(p, v, __ATOMIC_RELAXED, __HIP_MEMORY_SCOPE_AGENT); }
__device__ __forceinline__ unsigned xb_xcc_id() { return (unsigned)__builtin_amdgcn_s_getreg((3 << 11) | 20) & 0xFu; }
#define XB_SPIN(cond, bar) do { unsigned _sp = 0; while (cond) { __builtin_amdgcn_s_sleep(1); \
    if ((++_sp & 255u) == 0u) { if (xb_ld(&(bar)[XB_TMO])) break; if (_sp > XB_SPIN_CAP) { atomicAdd(&(bar)[XB_TMO], 1u); break; } } } } while (0)

struct XcdBarrier {
    unsigned* bar; unsigned x;
    volatile LAS unsigned* st;
};

__device__ __forceinline__ XcdBarrier xcd_barrier_post(unsigned* bar, volatile LAS unsigned* st) {
    XcdBarrier b; b.bar = bar; b.x = xb_xcc_id(); b.st = st;
    if (threadIdx.x == 0) (void)xb_add(&bar[XB_XCNT(b.x)], 1u);
    return b;
}
__device__ __forceinline__ void xcd_barrier_complete(unsigned* bar, unsigned x, unsigned& nloc, unsigned& nx) {
    const unsigned G = gridDim.x * gridDim.y * gridDim.z;
    unsigned sum, cnt, mine, sp = 0u;
    for (;;) {
        sum = 0u; cnt = 0u; mine = 0u;
#pragma unroll
        for (unsigned j = 0; j < 16; ++j) { const unsigned c = xb_ld(&bar[XB_XCNT(j)]); sum += c; cnt += (c > 0u) ? 1u : 0u; mine = (j == x) ? c : mine; }
        if (sum == G) break;
        __builtin_amdgcn_s_sleep(1);
        if ((++sp & 255u) == 0u) { if (xb_ld(&bar[XB_TMO])) break; if (sp > XB_SPIN_CAP) { atomicAdd(&bar[XB_TMO], 1u); break; } }
    }
    nloc = mine > 0u ? mine : 1u; nx = cnt > 0u ? cnt : 1u;
}

__device__ __forceinline__ void xcd_barrier(const XcdBarrier& b) {
    asm volatile("s_waitcnt vmcnt(0)" ::: "memory");
    __syncthreads();
    if (threadIdx.x == 0) {
        unsigned* bar = b.bar;
        __builtin_amdgcn_s_waitcnt(0);
        unsigned nloc = b.st[0], nx = b.st[1];
        if (nloc == 0u) { xcd_barrier_complete(bar, b.x, nloc, nx); b.st[0] = nloc; b.st[1] = nx; }
        const unsigned old = xb_add(&bar[XB_XSUB(b.x)], 1u);
        const unsigned gen = old / nloc;
        if (old + 1u == (gen + 1u) * nloc) {
            __builtin_amdgcn_fence(__ATOMIC_RELEASE, "agent");
            asm volatile("s_waitcnt vmcnt(0)" ::: "memory");
            const unsigned og = xb_add(&bar[XB_TOP], 1u);
            const unsigned tg = og / nx;
            if (og + 1u == (tg + 1u) * nx) xb_add(&bar[XB_TOPGEN], 1u);
            else XB_SPIN(xb_ld(&bar[XB_TOPGEN]) == tg, bar);
            __builtin_amdgcn_fence(__ATOMIC_ACQUIRE, "agent");
            xb_add(&bar[XB_XGEN(b.x)], 1u);
            asm volatile("s_waitcnt vmcnt(0)" ::: "memory");
        } else {
            XB_SPIN(xb_ld(&bar[XB_XGEN(b.x)]) == gen, bar);
            __builtin_amdgcn_fence(__ATOMIC_ACQUIRE, "agent");
            asm volatile("s_waitcnt vmcnt(0)" ::: "memory");
        }
    }
    __syncthreads();
}

struct Frame {
    LAS unsigned char* lds;
    volatile LAS unsigned* MISC;
    int tid, lane, wave, vcu, G;
};
struct Args { const float* in[39]; float* out; unsigned char* ws; int ph_lo, ph_hi; };
enum { I_X = 0, I_MEM, I_GMIX, I_WIN, I_MU, I_W0, I_W2, I_A0, I_A2, I_G2, I_KK, I_KA, I_RK, I_LNW, I_LNB, I_WRO, I_CONVW, I_CONVB, I_LWR, I_LBR, I_LWI, I_LBI, I_LAM, I_WLO,
       I_GMEM, I_WMK, I_WMV, I_WXO, I_WOUT, I_GFFN, I_WROUTER, I_BROUTER, I_WGATE, I_BGATE, I_WUP, I_BUP, I_WDOWN, I_BDOWN, I_GFINAL };


__device__ __forceinline__ const float* inp(int k) {
    typedef const volatile unsigned long long __attribute__((address_space(4))) ka_t;
    ka_t* ka = (ka_t*)__builtin_amdgcn_kernarg_segment_ptr();
    return (const float*)ka[k];
}
template <int NB> __device__ __forceinline__ void transpose_item(const float* W, int N, int k0, int n0, bf16* WT, int Kd, int drow0, int lane, int kdo = 0) {
    constexpr int LPR = NB / 4, G = 64 / LPR, KR = 64 / G;
    const int g = lane / LPR, c = lane % LPR;
    const GAS float* src = (const GAS float*)W + (size_t)(k0 + KR * g) * N + n0 + 4 * c;
    f32x4 ld[KR];
#pragma unroll
    for (int i = 0; i < KR; ++i) ld[i] = *(const GAS f32x4*)(src + (size_t)i * N);
    GAS bf16* dst = (GAS bf16*)WT + (size_t)(drow0 + 4 * c) * Kd + kdo + k0 + KR * g;
#pragma unroll
    for (int j = 0; j < 4; ++j)
#pragma unroll
        for (int q = 0; q < KR / 8; ++q) { v4u o; o.x = pk2(ld[8 * q + 0][j], ld[8 * q + 1][j]); o.y = pk2(ld[8 * q + 2][j], ld[8 * q + 3][j]); o.z = pk2(ld[8 * q + 4][j], ld[8 * q + 5][j]); o.w = pk2(ld[8 * q + 6][j], ld[8 * q + 7][j]);
            *(GAS v4u*)(dst + (size_t)j * Kd + 8 * q) = o; }
}
__device__ __forceinline__ void rms_row_to_bf16(const float* xrow, const float* gain, bf16* orow, int lane) {
    const GAS f32x4* xr = (const GAS f32x4*)xrow + lane; const GAS f32x4* gr = (const GAS f32x4*)gain + lane;
    f32x4 v[8]; float s = 0.f;
#pragma unroll
    for (int j = 0; j < 8; ++j) { v[j] = xr[64 * j]; s += (v[j].x * v[j].x + v[j].y * v[j].y) + (v[j].z * v[j].z + v[j].w * v[j].w); }
    const float rstd = 1.0f / sqrtf(wave_sum(s) * (1.f / D) + EPS);
    GAS v2u* o8 = (GAS v2u*)orow + lane;
#pragma unroll
    for (int j = 0; j < 8; ++j) { const f32x4 g = gr[64 * j]; v2u w; w.x = pk2(v[j].x * rstd * g.x, v[j].y * rstd * g.y); w.y = pk2(v[j].z * rstd * g.z, v[j].w * rstd * g.w); o8[64 * j] = w; }
}

__device__ __forceinline__ void p0_prologue(const Frame& F, const Args& a) {
    unsigned char* ws = a.ws;
    const int gw = F.vcu * NWAVES + F.wave, NGW = F.G * NWAVES;
    constexpr int I_IN = 32 * (IN_COLS / 32), I_MK = 32 * 32, I_BR = 16 * 64, I_O = 32 * 64;
    constexpr int NITEMS = I_IN + 2 * I_MK + 3 * I_BR + I_O;
    for (int it = gw; it < NITEMS; it += NGW) {
        int r = it;
        if (r < I_IN) { const int nb = IN_COLS / 32, kb = r / nb, n0 = 32 * (r % nb); transpose_item<32>(inp(I_WIN), IN_COLS, 64 * kb, n0, (bf16*)(ws + WS_WIN), D, n0 + (n0 >= RWKV_COLS ? 224 : 0), F.lane); continue; } r -= I_IN;
        if (r < I_MK) { transpose_item<32>(inp(I_WMK), 1024, 64 * (r / 32), 32 * (r % 32), (bf16*)(ws + WS_WMKV), D, 32 * (r % 32), F.lane); continue; } r -= I_MK;
        if (r < I_MK) { transpose_item<32>(inp(I_WMV), 1024, 64 * (r / 32), 32 * (r % 32), (bf16*)(ws + WS_WMKV), D, 1024 + 32 * (r % 32), F.lane); continue; } r -= I_MK;
        if (r < I_BR) { transpose_item<32>(inp(I_WRO), 2048, 64 * (r / 64), 32 * (r % 64), (bf16*)(ws + WS_WBR), 3072, 32 * (r % 64), F.lane, 0); continue; } r -= I_BR;
        if (r < I_BR) { transpose_item<32>(inp(I_WLO), 2048, 64 * (r / 64), 32 * (r % 64), (bf16*)(ws + WS_WBR), 3072, 32 * (r % 64), F.lane, 1024); continue; } r -= I_BR;
        if (r < I_BR) { transpose_item<32>(inp(I_WXO), 2048, 64 * (r / 64), 32 * (r % 64), (bf16*)(ws + WS_WBR), 3072, 32 * (r % 64), F.lane, 2048); continue; } r -= I_BR;
        transpose_item<32>(inp(I_WOUT), 2048, 64 * (r / 64), 32 * (r % 64), (bf16*)(ws + WS_WO), D, 32 * (r % 64), F.lane);
    }
    for (int m = gw; m < T; m += NGW) rms_row_to_bf16(inp(I_X) + (size_t)m * D, inp(I_GMIX), (bf16*)(ws + WS_XN) + (size_t)m * D, F.lane);
    for (int m = gw; m < 512; m += NGW) rms_row_to_bf16(inp(I_MEM) + (size_t)m * D, inp(I_GMEM), (bf16*)(ws + WS_MN) + (size_t)m * D, F.lane);
    const int gt = F.vcu * (NWAVES * 64) + F.tid, NGT = F.G * NWAVES * 64;
    { bf16* wz = (bf16*)(ws + WS_WIN) + (size_t)RWKV_COLS * D; for (int i = gt; i < 224 * D / 2; i += NGT) ((GAS unsigned*)wz)[i] = 0u; }
    { bf16* wl = (bf16*)(ws + WS_WLORA);
      for (int i = gt; i < 3072 * LORA_K; i += NGT) { const int n = i / LORA_K, k = i % LORA_K; float v = 0.f;
          if (n < 1024) { if (k < 64) v = inp(I_W2)[k * 1024 + n]; }
          else if (n < 2048) { if (k >= 64 && k < 128) v = inp(I_A2)[(k - 64) * 1024 + (n - 1024)]; }
          else { if (k >= 128 && k < 288) v = inp(I_G2)[(k - 128) * 1024 + (n - 2048)]; }
          wl[i] = (bf16)f2bf(v); } }
    { const float* lam = inp(I_LAM); float* spl = (float*)(ws + WS_SPL); for (int i = gt; i < 1024; i += NGT) spl[i] = softplusf(-lam[i]); }
    { bf16* wr = (bf16*)(ws + WS_WR);
      for (int i = gt; i < 32 * D; i += NGT) { const int e = i / D, k = i % D; const float w = inp(I_WROUTER)[k * 32 + e]; const unsigned hi = f2bf(w); const float r = w - __builtin_bit_cast(float, hi << 16);
          wr[i] = (bf16)hi; wr[32 * D + i] = (bf16)f2bf(r); } }
    { const float* lwi_p = inp(I_LWI); const float* lwr_p = inp(I_LWR); bf16* lw = (bf16*)(ws + WS_LW);
      for (int i = gt; i < 2 * 16 * 4 * 2 * 64 * 8; i += NGT) { const int j = i & 7, ln = (i >> 3) & 63, ks = (i >> 9) & 1, vbo = (i >> 10) & 3, n = (i >> 12) & 15, mat = i >> 16;
          const int w = 32 * ks + 16 * (j >> 2) + 4 * (ln >> 4) + (j & 3), v = 16 * vbo + (ln & 15);
          lw[i] = (bf16)f2bf((mat ? lwi_p : lwr_p)[(n * 64 + w) * 64 + v]); } }
}

__device__ __forceinline__ void moe_weight_convert(const Frame& F, const Args& a, int w0) {
    unsigned char* ws = a.ws;
    const float* wg = inp(I_WGATE); const float* wu = inp(I_WUP); const float* wd = inp(I_WDOWN);
    const int nw = NWAVES - w0, gw = F.vcu * nw + (F.wave - w0), NGW = F.G * nw;
    constexpr int PER = 1024;
    for (int it = gw; it < NE * 3 * PER; it += NGW) {
        const int e = it / (3 * PER), r = it % (3 * PER), which = r / PER, q = r % PER, k0 = 64 * (q / 32), n0 = 64 * (q % 32);
        if (which == 0) transpose_item<64>(wg + (size_t)e * D * D, D, k0, n0, (bf16*)(ws + WS_WGU) + (size_t)e * 4096 * D, D, (n0 >> 7) * 256 + (n0 & 127), F.lane);
        else if (which == 1) transpose_item<64>(wu + (size_t)e * D * D, D, k0, n0, (bf16*)(ws + WS_WGU) + (size_t)e * 4096 * D, D, (n0 >> 7) * 256 + 128 + (n0 & 127), F.lane);
        else transpose_item<64>(wd + (size_t)e * D * D, D, k0, n0, (bf16*)(ws + WS_WD) + (size_t)e * 2048 * D, D, n0, F.lane);
    }
}

__device__ __forceinline__ void r1_lora_in(const Frame& F, const Args& a) {
    const bf16* P = (const bf16*)(a.ws + WS_P); bf16* L = (bf16*)(a.ws + WS_XN);
    const float* mu = inp(I_MU);
    const int gw = F.vcu * NWAVES + F.wave, NGW = F.G * NWAVES;
    for (int m = gw; m < T; m += NGW) {
        const bool first = (m % SEQ) == 0;
#pragma unroll
        for (int j = 0; j < 6; ++j) { const int k = F.lane + 64 * j; float o = 0.f;
            if (k < 288) { const int c = 3072 + k; const float cur = bf1(P[(size_t)m * NP + c]); const float prev = first ? 0.f : bf1(P[(size_t)(m - 1) * NP + c]);
                const float x = cur + (prev - cur) * mu[c]; o = k < 64 ? fast_tanh(x) : (k < 128 ? x : sigm(x)); }
            L[(size_t)m * LORA_K + k] = (bf16)f2bf(o); }
    }
}

__device__ __forceinline__ f32x4 bf4(v2u w) { return (f32x4){bflo(w.x), bfhi(w.x), bflo(w.y), bfhi(w.y)}; }
__device__ __forceinline__ void r3_scan_inputs(const Frame& F, const Args& a) {
    const GAS bf16* P = (const GAS bf16*)(a.ws + WS_P); const GAS float* LO = (const GAS float*)(a.ws + WS_LORAOUT);
    GAS float* SR = (GAS float*)(a.ws + WS_SCAN); constexpr size_t AS = (size_t)T * 1024;
    GAS float* BON = (GAS float*)(a.ws + WS_BONUS);
    const GAS float* mu = (const GAS float*)inp(I_MU); const GAS float* w0 = (const GAS float*)inp(I_W0); const GAS float* a0 = (const GAS float*)inp(I_A0);
    const GAS float* kkp = (const GAS float*)inp(I_KK); const GAS float* kap = (const GAS float*)inp(I_KA); const GAS float* rkp = (const GAS float*)inp(I_RK);
    const int gw = F.vcu * NWAVES + F.wave, NGW = F.G * NWAVES;
    for (int m = gw; m < T; m += NGW) {
        const bool first = (m % SEQ) == 0;
        const GAS bf16* pc = P + (size_t)m * NP; const GAS bf16* pp = P + (size_t)(m - (first ? 0 : 1)) * NP;
#pragma unroll 1
        for (int hp = 0; hp < 4; ++hp) { const int c = hp * 256 + F.lane * 4;
            const f32x4 cr = bf4(*(const GAS v2u*)(pc + c)), ck = bf4(*(const GAS v2u*)(pc + 1024 + c)), cv = bf4(*(const GAS v2u*)(pc + 2048 + c));
            f32x4 qr = bf4(*(const GAS v2u*)(pp + c)), qk = bf4(*(const GAS v2u*)(pp + 1024 + c)), qv = bf4(*(const GAS v2u*)(pp + 2048 + c));
            if (first) { qr = (f32x4){0.f, 0.f, 0.f, 0.f}; qk = qr; qv = qr; }
            const f32x4 r = cr + (qr - cr) * *(const GAS f32x4*)(mu + c), k = ck + (qk - ck) * *(const GAS f32x4*)(mu + 1024 + c), v = cv + (qv - cv) * *(const GAS f32x4*)(mu + 2048 + c);
            const f32x4 wpre = *(const GAS f32x4*)(w0 + c) + *(const GAS f32x4*)(LO + (size_t)m * 3072 + c), apre = *(const GAS f32x4*)(a0 + c) + *(const GAS f32x4*)(LO + (size_t)m * 3072 + 1024 + c);
            const f32x4 kkw = *(const GAS f32x4*)(kkp + c), kaw = *(const GAS f32x4*)(kap + c), rkw = *(const GAS f32x4*)(rkp + c);
            f32x4 dec, ag, kk, km; float ss = 0.f, bo = 0.f;
#pragma unroll
            for (int j = 0; j < 4; ++j) {
                dec[j] = __expf(-0.6065306597126334f * __builtin_amdgcn_rcpf(1.0f + __expf(-wpre[j])));
                ag[j] = __builtin_amdgcn_rcpf(1.0f + __expf(-apre[j]));
                kk[j] = k[j] * kkw[j]; ss += kk[j] * kk[j];
                km[j] = k[j] * (1.0f + (ag[j] - 1.0f) * kaw[j]); bo += r[j] * km[j] * rkw[j]; }
            ss = row16_sum(ss); bo = row16_sum(bo);
            const float inv = 1.0f / sqrtf(fmaxf(ss, 1e-24f));
            const f32x4 kkn = kk * inv;
            const size_t o = (size_t)m * 1024 + c;
            *(GAS f32x4*)(SR + o) = r; *(GAS f32x4*)(SR + AS + o) = dec; *(GAS f32x4*)(SR + 2 * AS + o) = km; *(GAS f32x4*)(SR + 3 * AS + o) = v; *(GAS f32x4*)(SR + 4 * AS + o) = -kkn; *(GAS f32x4*)(SR + 5 * AS + o) = kkn * ag;
            if ((F.lane & 15) == 0) BON[m * 16 + hp * 4 + (F.lane >> 4)] = bo; }
    }
}

template <int VAR> __device__ __forceinline__ void r4_scan(const Frame& F, const Args& a) {
    constexpr size_t ASZ = (size_t)T * 1024 * 4;
    float* YT = (float*)(a.ws + WS_XN);
    __builtin_amdgcn_s_setprio(3);
    for (int rb = F.vcu; rb < 256; rb += F.G) {
        const int row = rb * 8 + F.wave * 4 + (F.lane >> 4), ksub = F.lane & 15, bh = rb >> 3, vi = row & 63, b = bh >> 4, h = bh & 15;
        const GAS char* gsrc = (const GAS char*)(a.ws + WS_SCAN) + ((size_t)b * SEQ * 1024 + h * 64) * 4 + (size_t)(F.lane >> 4) * 4096 + (F.lane & 15) * 16;
        LAS unsigned char* ring = F.lds + F.wave * 49152;
        const LAS unsigned char* rd4 = ring + ksub * 16; const LAS unsigned char* rdv = ring + 3 * 8192 + vi * 4;
#define SC_DMA(tg) do { _Pragma("unroll") for (int ar_ = 0; ar_ < 6; ++ar_) \
            __builtin_amdgcn_global_load_lds((const GAS unsigned*)(gsrc + (size_t)ar_ * ASZ + (size_t)(tg) * 4096), (LAS unsigned*)(ring + ar_ * 8192 + ((tg) & 31) * 256), 16, 0, 0); } while (0)
#define SC_RD(s_, tq) do { const int so_ = ((tq) & 31) * 256; br[s_] = *(const LAS f32x4*)(rd4 + so_); bd[s_] = *(const LAS f32x4*)(rd4 + 8192 + so_); bk[s_] = *(const LAS f32x4*)(rd4 + 2 * 8192 + so_); \
            ba[s_] = *(const LAS f32x4*)(rd4 + 4 * 8192 + so_); bb[s_] = *(const LAS f32x4*)(rd4 + 5 * 8192 + so_); bv[s_] = *(const LAS float*)(rdv + so_); } while (0)
        f32x4 bd[2], bk[2], ba[2], bb[2], br[2]; float bv[2];
#pragma unroll
        for (int g = 0; g < 6; ++g) SC_DMA(4 * g);
        asm volatile("s_waitcnt vmcnt(0)" ::: "memory");
        SC_RD(0, 0);
        f32x2 S01 = {0.f, 0.f}, S23 = {0.f, 0.f}; float ykeep = 0.f, yp = 0.f;
        GAS float* yrow = (GAS float*)YT + (size_t)row * SEQ;
#pragma unroll 1
        for (int t0 = 0; t0 < SEQ; t0 += 32) {
#pragma unroll
            for (int u = 0; u < 32; ++u) { const int s = u & 1;
                f32x4 d4 = bd[s], k4 = bk[s], a4 = ba[s], b4 = bb[s], r4 = br[s]; float vv = bv[s];
                asm volatile("" : "+v"(d4), "+v"(k4), "+v"(a4), "+v"(b4), "+v"(r4), "+v"(vv));
                if (VAR != 3 && (u & 3) == 0) SC_DMA(t0 + u + 24);
                if ((u & 3) == 3) asm volatile("s_waitcnt vmcnt(30)" ::: "memory");
                if (VAR != 2) SC_RD(s ^ 1, t0 + u + 1);
                f32x2 p = S01 * (f32x2){a4[0], a4[1]}; p = S23 * (f32x2){a4[2], a4[3]} + p;
                float sa = p.x + p.y;
                if (VAR != 1) { sa += dppf<0xB1>(sa); yp += dppf<0xB1>(yp); sa += dppf<0x4E>(sa); yp += dppf<0x4E>(yp); sa += dppf<0x141>(sa); yp += dppf<0x141>(yp); sa += dppf<0x140>(sa); yp += dppf<0x140>(yp); }
                ykeep = (ksub == ((u + 15) & 15)) ? yp : ykeep;
                if ((u & 15) == 0) { if (t0 + u > 0) yrow[t0 + u - 16 + ksub] = ykeep; }
                f32x2 t01 = (f32x2){k4[0], k4[1]} * vv, t23 = (f32x2){k4[2], k4[3]} * vv;
                t01 = (f32x2){b4[0], b4[1]} * sa + t01; t23 = (f32x2){b4[2], b4[3]} * sa + t23;
                S01 = S01 * (f32x2){d4[0], d4[1]} + t01; S23 = S23 * (f32x2){d4[2], d4[3]} + t23;
                f32x2 q = S01 * (f32x2){r4[0], r4[1]}; q = S23 * (f32x2){r4[2], r4[3]} + q;
                yp = q.x + q.y;
                asm volatile("" : "+v"(S01), "+v"(S23), "+v"(ykeep), "+v"(yp) :: "memory"); }
        }
        yp = row16_sum(yp); ykeep = (ksub == 15) ? yp : ykeep; yrow[SEQ - 16 + ksub] = ykeep;
        asm volatile("s_waitcnt vmcnt(0)" ::: "memory");
#undef SC_DMA
#undef SC_RD
    }
    __builtin_amdgcn_s_setprio(0);
}

__device__ __forceinline__ void r5_finish(const Frame& F, const Args& a) {
    const float* YT = (const float*)(a.ws + WS_XN); const float* LO = (const float*)(a.ws + WS_LORAOUT); const float* SV = (const float*)(a.ws + WS_SCAN) + (size_t)3 * T * 1024; const float* BON = (const float*)(a.ws + WS_BONUS);
    bf16* YA = (bf16*)(a.ws + WS_YABC);
    LAS float* scr = (LAS float*)(F.lds + F.wave * 16640);
    const int gw = F.vcu * NWAVES + F.wave, NGW = F.G * NWAVES;
    for (int it = gw; it < 32 * 128; it += NGW) {
        const int bh = it >> 7, tt = it & 127, t0 = tt * 64, b = bh >> 4, h = bh & 15;
        float y[64]; float s = 0.f;
#pragma unroll
        for (int v = 0; v < 64; ++v) { y[v] = YT[(size_t)(bh * 64 + v) * SEQ + t0 + F.lane]; s += y[v]; }
        const float mean = s * (1.f / 64.f); float q = 0.f;
#pragma unroll
        for (int v = 0; v < 64; ++v) { const float d = y[v] - mean; q += d * d; }
        const float rstd = 1.0f / sqrtf(q * (1.f / 64.f) + GN_EPS);
#pragma unroll
        for (int v = 0; v < 64; ++v) scr[F.lane * 65 + v] = (y[v] - mean) * rstd;
        LDS_WAIT(); asm volatile("" ::: "memory");
        const int c = h * 64 + F.lane; const float lw = inp(I_LNW)[c], lb = inp(I_LNB)[c];
        for (int ti = 0; ti < 64; ++ti) { const int m = b * SEQ + t0 + ti;
            const float yn = scr[ti * 65 + F.lane];
            const float o = (yn * lw + lb + BON[m * 16 + h] * SV[(size_t)m * 1024 + c]) * LO[(size_t)m * 3072 + 2048 + c];
            YA[(size_t)m * 3072 + c] = (bf16)f2bf(o); }
        LDS_WAIT(); asm volatile("" ::: "memory");
    }
}

__device__ __forceinline__ float gelu_tanh(float x) { const float u = 0.7978845608028654f * (x + 0.044715f * x * x * x); return 0.5f * x * (1.0f + fast_tanh(u)); }
template <int CTRL> __device__ __forceinline__ float dpp_keep(float old, float x) { return __builtin_bit_cast(float, __builtin_amdgcn_update_dpp(__builtin_bit_cast(int, old), __builtin_bit_cast(int, x), CTRL, 0xf, 0xf, false)); }
template <bool FINAL> __device__ __forceinline__ void lru_pass(const Frame& F, const Args& a) {
    const bf16* P = (const bf16*)(a.ws + WS_P); const bf16* LW = (const bf16*)(a.ws + WS_LW);
    float* CA = (float*)(a.ws + WS_LRUC); float* CB = CA + 256 * 1024; const float* HIN = CB + 256 * 1024;
    bf16* YB = (bf16*)(a.ws + WS_YABC) + 1024;
    const GAS float* lbr_p = (const GAS float*)inp(I_LBR); const GAS float* lbi_p = (const GAS float*)inp(I_LBI); const GAS float* spl_p = (const GAS float*)(a.ws + WS_SPL);
    const GAS float* cvb_p = (const GAS float*)inp(I_CONVB); const GAS float* cvw_p = (const GAS float*)inp(I_CONVW);
    const int gw = F.vcu * NWAVES + F.wave, NGW = F.G * NWAVES, tq = F.lane & 15, kq = F.lane >> 4;
    for (int it = gw; it < 256 * 16; it += NGW) {
        const int tt = it >> 4, n = it & 15, m0 = tt * 64, cb = n * 64 + 4 * kq;
        const bool seq0 = (m0 % SEQ) == 0;
        float hcar[4][4];
        float aprod[4][4];
#pragma unroll
        for (int vb = 0; vb < 4; ++vb)
#pragma unroll
            for (int i = 0; i < 4; ++i) { hcar[vb][i] = FINAL ? HIN[tt * 1024 + cb + 16 * vb + i] : 0.f; aprod[vb][i] = 1.f; }
#pragma unroll 1
        for (int tb = 0; tb < 4; ++tb) {
            asm volatile("" ::: "memory");
            const int m = m0 + 16 * tb + tq, tseq = m % SEQ;
            f32x4 xc[4];
#pragma unroll
            for (int vb = 0; vb < 4; ++vb) { const int c = cb + 16 * vb; f32x4 acc = *(const GAS f32x4*)(cvb_p + c);
#pragma unroll
                for (int j = 0; j < 4; ++j) { if (tseq - j >= 0) { const v2u pw = *(const GAS v2u*)((const GAS bf16*)P + (size_t)(m - j) * NP + PC_LX + c); const f32x4 cw = *(const GAS f32x4*)(cvw_p + j * 1024 + c);
                        acc[0] += cw[0] * bflo(pw.x); acc[1] += cw[1] * bfhi(pw.x); acc[2] += cw[2] * bflo(pw.y); acc[3] += cw[3] * bfhi(pw.y); } }
                xc[vb] = acc; }
            bf16x8 bfrag[2];
#pragma unroll
            for (int ks = 0; ks < 2; ++ks) { v4u w; w.x = pk2(xc[2 * ks][0], xc[2 * ks][1]); w.y = pk2(xc[2 * ks][2], xc[2 * ks][3]); w.z = pk2(xc[2 * ks + 1][0], xc[2 * ks + 1][1]); w.w = pk2(xc[2 * ks + 1][2], xc[2 * ks + 1][3]); bfrag[ks] = __builtin_bit_cast(bf16x8, w); }
#pragma unroll
            for (int vb = 0; vb < 4; ++vb) {
                f32x4 gr = {0.f, 0.f, 0.f, 0.f}, gi = {0.f, 0.f, 0.f, 0.f};
#pragma unroll
                for (int ks = 0; ks < 2; ++ks) { const bf16x8 wr_ = *(const bf16x8*)(LW + ((((size_t)(0 * 16 + n) * 4 + vb) * 2 + ks) * 64 + F.lane) * 8); const bf16x8 wi_ = *(const bf16x8*)(LW + ((((size_t)(1 * 16 + n) * 4 + vb) * 2 + ks) * 64 + F.lane) * 8);
                    gr = __builtin_amdgcn_mfma_f32_16x16x32_bf16(wr_, bfrag[ks], gr, 0, 0, 0); gi = __builtin_amdgcn_mfma_f32_16x16x32_bf16(wi_, bfrag[ks], gi, 0, 0, 0); }
                const int c = cb + 16 * vb;
                const f32x4 brv = *(const GAS f32x4*)(lbr_p + c), biv = *(const GAS f32x4*)(lbi_p + c); const f32x4 spl = *(const GAS f32x4*)(spl_p + c);
                v2u pyw; if (FINAL) pyw = *(const v2u*)(P + (size_t)m * NP + PC_LY + c);
                float hout[4];
#pragma unroll
                for (int i = 0; i < 4; ++i) {
                    const float g_r = sigm(gr[i] + brv[i]), g_i = sigm(gi[i] + biv[i]);
                    const float log_a = -8.0f * g_r * spl[i];
                    float av = __expf(log_a); float mult = __builtin_amdgcn_sqrtf(fmaxf(1.0f - av * av, 0.f)); if (tseq == 0) mult = 1.0f;
                    float bv = mult * g_i * xc[vb][i];
                    { float pa = dpp_keep<0x111>(1.0f, av), pb = dpp_keep<0x111>(0.0f, bv); bv = av * pb + bv; av = av * pa; }
                    { float pa = dpp_keep<0x112>(1.0f, av), pb = dpp_keep<0x112>(0.0f, bv); bv = av * pb + bv; av = av * pa; }
                    { float pa = dpp_keep<0x114>(1.0f, av), pb = dpp_keep<0x114>(0.0f, bv); bv = av * pb + bv; av = av * pa; }
                    { float pa = dpp_keep<0x118>(1.0f, av), pb = dpp_keep<0x118>(0.0f, bv); bv = av * pb + bv; av = av * pa; }
                    const float hv = bv + av * hcar[vb][i];
                    const int l15 = (F.lane & 48) | 15;
                    const float hend = __shfl(hv, l15), aend = __shfl(av, l15);
                    hcar[vb][i] = hend; if (!FINAL) aprod[vb][i] *= aend; hout[i] = hv; }
                if (FINAL) { const float y0 = hout[0] * gelu_tanh(bflo(pyw.x)), y1 = hout[1] * gelu_tanh(bfhi(pyw.x)), y2 = hout[2] * gelu_tanh(bflo(pyw.y)), y3 = hout[3] * gelu_tanh(bfhi(pyw.y));
                    v2u w; w.x = pk2(y0, y1); w.y = pk2(y2, y3); *(v2u*)(YB + (size_t)m * 3072 + c) = w; }
            }
        }
        if (!FINAL && tq == 0) {
#pragma unroll
            for (int vb = 0; vb < 4; ++vb) { f32x4 pa, pb;
#pragma unroll
                for (int i = 0; i < 4; ++i) { pa[i] = aprod[vb][i]; pb[i] = hcar[vb][i]; }
                *(f32x4*)(CA + tt * 1024 + cb + 16 * vb) = pa; *(f32x4*)(CB + tt * 1024 + cb + 16 * vb) = pb; }
        }
        (void)seq0;
    }
}
__device__ __forceinline__ void lru_carry(const Frame& F, const Args& a) {
    const float* CA = (const float*)(a.ws + WS_LRUC); const float* CB = CA + 256 * 1024; float* HIN = (float*)CB + 256 * 1024;
    const int gt = F.vcu * (NWAVES * 64) + F.tid;
    if (gt < 2048) { const int b = gt >> 10, c = gt & 1023; float h = 0.f;
        for (int k = 0; k < 128; ++k) { const int tt = b * 128 + k; HIN[tt * 1024 + c] = h; h = CA[tt * 1024 + c] * h + CB[tt * 1024 + c]; } }
}

__device__ __forceinline__ void xattn_phase(const Frame& F, const Args& a) {
    const bf16* P = (const bf16*)(a.ws + WS_P); const bf16* KM = (const bf16*)(a.ws + WS_KMEM); const bf16* VT = (const bf16*)(a.ws + WS_VT);
    bf16* YC = (bf16*)(a.ws + WS_YABC) + 2048;
    const int gw = F.vcu * NWAVES + F.wave, NGW = F.G * NWAVES, tq = F.lane & 15, kq = F.lane >> 4;
    for (int it = gw; it < 4 * 1024; it += NGW) {
        const int h = it >> 10, tg = it & 1023, m0 = tg * 16, b = m0 / SEQ;
        bf16x8 qf[8];
#pragma unroll
        for (int ks = 0; ks < 8; ++ks) qf[ks] = *(const bf16x8*)(P + (size_t)(m0 + tq) * NP + PC_Q + h * 256 + 32 * ks + 8 * kq);
        f32x4 s[16];
#pragma unroll
        for (int mb = 0; mb < 16; ++mb) { f32x4 acc = {0.f, 0.f, 0.f, 0.f}; const bf16* kp = KM + (size_t)(b * 256 + 16 * mb + tq) * 1024 + h * 256 + 8 * kq;
#pragma unroll
            for (int ks = 0; ks < 8; ++ks) acc = __builtin_amdgcn_mfma_f32_16x16x32_bf16(*(const bf16x8*)(kp + 32 * ks), qf[ks], acc, 0, 0, 0);
            s[mb] = acc; asm volatile("" ::: "memory"); }
        float mx = -3.0e38f;
#pragma unroll
        for (int mb = 0; mb < 16; ++mb) { s[mb] = s[mb] * 0.0625f; mx = fmaxf(mx, fmaxf(fmaxf(s[mb][0], s[mb][1]), fmaxf(s[mb][2], s[mb][3]))); }
        mx = fmaxf(mx, __shfl_xor(mx, 16)); mx = fmaxf(mx, __shfl_xor(mx, 32));
        float sum = 0.f;
#pragma unroll
        for (int mb = 0; mb < 16; ++mb) {
#pragma unroll
            for (int i = 0; i < 4; ++i) { s[mb][i] = __expf(s[mb][i] - mx); sum += s[mb][i]; } }
        sum += __shfl_xor(sum, 16); sum += __shfl_xor(sum, 32);
        const float inv = 1.0f / sum;
        bf16x8 pf[8];
#pragma unroll
        for (int ks = 0; ks < 8; ++ks) { v4u w; w.x = pk2(s[2 * ks][0] * inv, s[2 * ks][1] * inv); w.y = pk2(s[2 * ks][2] * inv, s[2 * ks][3] * inv); w.z = pk2(s[2 * ks + 1][0] * inv, s[2 * ks + 1][1] * inv); w.w = pk2(s[2 * ks + 1][2] * inv, s[2 * ks + 1][3] * inv); pf[ks] = __builtin_bit_cast(bf16x8, w); }
#pragma unroll
        for (int db = 0; db < 16; ++db) { f32x4 acc = {0.f, 0.f, 0.f, 0.f}; const bf16* vp = VT + ((size_t)((b * 4 + h) * 256 + 16 * db + tq)) * 256 + 8 * kq;
#pragma unroll
            for (int ks = 0; ks < 8; ++ks) acc = __builtin_amdgcn_mfma_f32_16x16x32_bf16(*(const bf16x8*)(vp + 32 * ks), pf[ks], acc, 0, 0, 0);
            v2u w; w.x = pk2(acc[0], acc[1]); w.y = pk2(acc[2], acc[3]);
            *(v2u*)(YC + (size_t)(m0 + tq) * 3072 + h * 256 + 16 * db + 4 * kq) = w; asm volatile("" ::: "memory"); }
    }
}

__device__ __forceinline__ void router_phase(const Frame& F, const Args& a) {
    const float* H1 = (const float*)(a.ws + WS_H1); bf16* XN2 = (bf16*)(a.ws + WS_XN); const bf16* WR = (const bf16*)(a.ws + WS_WR);
    int* pick_e = (int*)(a.ws + WS_PICK); int* pick_rank = pick_e + 65536; float* pick_gate = (float*)(pick_rank + 65536);
    unsigned* gcnt = (unsigned*)(a.ws + WS_CTL) + CW_CNT;
    LAS float* lg = (LAS float*)(F.lds + F.wave * 4096);
    LAS unsigned* lcnt = (LAS unsigned*)(F.lds + 65536);
    const int tq = F.lane & 15, kq = F.lane >> 4;
    for (int g0 = F.vcu * 4; g0 < 1024; g0 += F.G * 4) {
        if (F.tid < 64) lcnt[F.tid] = 0u;
        __syncthreads();
        int me = 0, mrank = 0; float mgate = 0.f; int e4[4]; float g4[4]; int r4[4];
        const int m0 = (g0 + F.wave) * 16;
        if (F.wave < 4) {
            float myr = 0.f;
            for (int j = 0; j < 16; ++j) { const GAS f32x4* xr = (const GAS f32x4*)(H1 + (size_t)(m0 + j) * D) + F.lane; float s = 0.f;
#pragma unroll
                for (int q = 0; q < 8; ++q) { const f32x4 v = xr[64 * q]; s += (v.x * v.x + v.y * v.y) + (v.z * v.z + v.w * v.w); }
                const float rs = 1.0f / sqrtf(wave_sum(s) * (1.f / D) + EPS); if (tq == j) myr = rs; }
            f32x4 acc[2] = {{0.f, 0.f, 0.f, 0.f}, {0.f, 0.f, 0.f, 0.f}};
            const float* hrow = H1 + (size_t)(m0 + tq) * D + 8 * kq; const float* grow = inp(I_GFFN) + 8 * kq; bf16* xrow = XN2 + (size_t)(m0 + tq) * D + 8 * kq;
            for (int ks = 0; ks < 64; ++ks) {
                const f32x4 x0 = *(const f32x4*)(hrow + 32 * ks), x1 = *(const f32x4*)(hrow + 32 * ks + 4), g0v = *(const f32x4*)(grow + 32 * ks), g1v = *(const f32x4*)(grow + 32 * ks + 4);
                v4u w; w.x = pk2(x0[0] * myr * g0v[0], x0[1] * myr * g0v[1]); w.y = pk2(x0[2] * myr * g0v[2], x0[3] * myr * g0v[3]); w.z = pk2(x1[0] * myr * g1v[0], x1[1] * myr * g1v[1]); w.w = pk2(x1[2] * myr * g1v[2], x1[3] * myr * g1v[3]);
                *(v4u*)(xrow + 32 * ks) = w; const bf16x8 af = __builtin_bit_cast(bf16x8, w);
#pragma unroll
                for (int eh = 0; eh < 2; ++eh) { const bf16* wp = WR + (size_t)(16 * eh + tq) * D + 32 * ks + 8 * kq;
                    acc[eh] = __builtin_amdgcn_mfma_f32_16x16x32_bf16(af, *(const bf16x8*)wp, acc[eh], 0, 0, 0);
                    acc[eh] = __builtin_amdgcn_mfma_f32_16x16x32_bf16(af, *(const bf16x8*)(wp + 32 * D), acc[eh], 0, 0, 0); } }
#pragma unroll
            for (int eh = 0; eh < 2; ++eh)
#pragma unroll
                for (int i = 0; i < 4; ++i) lg[(4 * kq + i) * 33 + 16 * eh + tq] = acc[eh][i] + inp(I_BROUTER)[16 * eh + tq];
            LDS_WAIT(); asm volatile("" ::: "memory");
            if (F.lane < 16) { float v[32];
#pragma unroll
                for (int e = 0; e < 32; ++e) v[e] = lg[F.lane * 33 + e];
                float tv[4];
#pragma unroll
                for (int k = 0; k < 4; ++k) { float best = -3.0e38f; int bi = 0;
#pragma unroll
                    for (int e = 0; e < 32; ++e) { if (v[e] > best) { best = v[e]; bi = e; } }
                    tv[k] = best; e4[k] = bi;
#pragma unroll
                    for (int e = 0; e < 32; ++e) { if (e == bi) v[e] = -3.0e38f; } }
                float den = 0.f;
#pragma unroll
                for (int k = 0; k < 4; ++k) { g4[k] = __expf(tv[k] - tv[0]); den += g4[k]; }
#pragma unroll
                for (int k = 0; k < 4; ++k) { g4[k] = g4[k] / den; r4[k] = (int)atomicAdd((unsigned*)&lcnt[e4[k]], 1u); } }
        }
        __syncthreads();
        if (F.tid < 32) lcnt[32 + F.tid] = atomicAdd(&gcnt[F.tid], lcnt[F.tid]);
        __syncthreads();
        if (F.wave < 4 && F.lane < 16) {
#pragma unroll
            for (int k = 0; k < 4; ++k) { const int pi = (m0 + F.lane) * 4 + k; pick_e[pi] = e4[k]; pick_rank[pi] = (int)lcnt[32 + e4[k]] + r4[k]; pick_gate[pi] = g4[k]; } }
        __syncthreads();
        (void)me; (void)mrank; (void)mgate;
    }
}

__device__ __forceinline__ void scatter_phase(const Frame& F, const Args& a) {
    const bf16* XN2 = (const bf16*)(a.ws + WS_XN); bf16* XS = (bf16*)(a.ws + WS_XS);
    const int* pick_e = (const int*)(a.ws + WS_PICK); const int* pick_rank = pick_e + 65536; const float* pick_gate = (const float*)(pick_rank + 65536); int* pos = (int*)(pick_gate + 65536);
    float* gate_of_row = (float*)(a.ws + WS_ROWTAB);
    unsigned* ctl = (unsigned*)(a.ws + WS_CTL);
    LAS int* pst = (LAS int*)(F.lds);
    if (F.tid == 0) { int acc = 0; for (int e = 0; e < NE; ++e) { pst[e] = acc; const int c = (int)ctl[CW_CNT + e]; const int nt = (c + 255) >> 8;
            if (blockIdx.x == 0) for (int k = 0; k < nt; ++k) ctl[CW_TILEE + (acc >> 8) + k] = (unsigned)e;
            acc += nt << 8; }
        if (blockIdx.x == 0) ctl[CW_NTILES] = (unsigned)(acc >> 8); }
    __syncthreads();
    const int gw = F.vcu * NWAVES + F.wave, NGW = F.G * NWAVES;
    for (int pi = gw; pi < 65536; pi += NGW) {
        const int e = pick_e[pi], row = pst[e] + pick_rank[pi], tok = pi >> 2;
        if (F.lane == 0) { pos[pi] = row; gate_of_row[row] = pick_gate[pi]; }
        const GAS v4u* src = (const GAS v4u*)(XN2 + (size_t)tok * D) + F.lane; GAS v4u* dst = (GAS v4u*)(XS + (size_t)row * D) + F.lane;
#pragma unroll
        for (int q = 0; q < 4; ++q) dst[64 * q] = src[64 * q];
    }
}

__device__ __forceinline__ void final_phase(const Frame& F, const Args& a) {
    const float* H1 = (const float*)(a.ws + WS_H1); const bf16* OR = (const bf16*)(a.ws + WS_OROW);
    const int* pos = (const int*)(a.ws + WS_PICK) + 3 * 65536;
    const int gw = F.vcu * NWAVES + F.wave, NGW = F.G * NWAVES;
    for (int m = gw; m < T; m += NGW) {
        const GAS f32x4* xr = (const GAS f32x4*)(H1 + (size_t)m * D) + F.lane; const GAS f32x4* gr = (const GAS f32x4*)inp(I_GFINAL) + F.lane;
        f32x4 v[8];
#pragma unroll
        for (int j = 0; j < 8; ++j) v[j] = xr[64 * j];
#pragma unroll
        for (int k = 0; k < 4; ++k) { const int row = pos[m * 4 + k]; const GAS v2u* orp = (const GAS v2u*)(OR + (size_t)row * D) + F.lane;
#pragma unroll
            for (int j = 0; j < 8; ++j) { const v2u w = orp[64 * j]; v[j].x += bflo(w.x); v[j].y += bfhi(w.x); v[j].z += bflo(w.y); v[j].w += bfhi(w.y); } }
        float s = 0.f;
#pragma unroll
        for (int j = 0; j < 8; ++j) s += (v[j].x * v[j].x + v[j].y * v[j].y) + (v[j].z * v[j].z + v[j].w * v[j].w);
        const float rstd = 1.0f / sqrtf(wave_sum(s) * (1.f / D) + EPS);
        GAS f32x4* o = (GAS f32x4*)(a.out + (size_t)m * D) + F.lane;
#pragma unroll
        for (int j = 0; j < 8; ++j) { const f32x4 g = gr[64 * j]; o[64 * j] = (f32x4){v[j].x * rstd * g.x, v[j].y * rstd * g.y, v[j].z * rstd * g.z, v[j].w * rstd * g.w}; }
    }
}

#ifndef MK_N_LAUNCHES
#define MK_N_LAUNCHES 1
#endif
constexpr int NPH = 14;
__global__ void __launch_bounds__(NWAVES * 64, 2) fwd(Args args) {
    extern __shared__ __attribute__((aligned(16))) unsigned char lds[];
#define NEWFRAME() Frame F; { int tz = threadIdx.x; asm volatile("" : "+v"(tz)); F.lds = (LAS unsigned char*)lds; F.MISC = (volatile LAS unsigned*)(F.lds + MISC_OFF); F.tid = tz; F.lane = tz & 63; F.wave = __builtin_amdgcn_readfirstlane(tz >> 6); \
        F.G = gridDim.x; const int bx = blockIdx.x; F.vcu = (F.G % 8 == 0) ? (bx % 8) * (F.G / 8) + bx / 8 : bx; }
    unsigned char* ws = args.ws;
    unsigned* ctl = (unsigned*)(ws + WS_CTL);
    for (int u = threadIdx.x; u < (LDS_BYTES - MISC_OFF) / 4; u += NWAVES * 64) ((LAS unsigned*)((LAS unsigned char*)lds + MISC_OFF))[u] = 0u;
    __syncthreads();
    const int lo = args.ph_lo, hi = args.ph_hi;
    XcdBarrier bar; bar.bar = ctl + CW_BAR; bar.x = 0; bar.st = nullptr;
    if (hi - lo > 1) bar = xcd_barrier_post(ctl + CW_BAR, (volatile LAS unsigned*)((LAS unsigned char*)lds + MISC_OFF) + 8);
#ifndef PHMASK
#define PHMASK 0xFFFF
#endif
#define IN(k) (((PHMASK >> (k)) & 1) && lo <= (k) && (k) < hi)
#define SEAM(k) do { if (IN(k) && IN((k) + 1)) xcd_barrier(bar); } while (0)

    if (IN(0)) { NEWFRAME(); p0_prologue(F, args); } SEAM(0);
    if (IN(1)) { NEWFRAME();
        { pg8::Gemm g{(const bf16*)(ws + WS_XN), (const bf16*)(ws + WS_WIN), T, NP, D}; pg8::StaticOrder S; S.init(T, NP, F.G, (int)blockIdx.x);
          pg8::EpiBf16<0> E{(bf16*)(ws + WS_P), NP, nullptr, 0, 0, 1.f};
          pg8::gemm_phase<pg8::EpiBf16<0>, pg8::StaticOrder, true, true>(F.lds, g, S, E); }
        __syncthreads();
        { pg8::Gemm g{(const bf16*)(ws + WS_MN), (const bf16*)(ws + WS_WMKV), 512, 2048, D}; pg8::StaticOrder S; S.init(512, 2048, F.G, (int)((blockIdx.x + F.G / 2) % F.G));
          pg8::EpiKV E{(bf16*)(ws + WS_KMEM), (bf16*)(ws + WS_VT)};
          pg8::gemm_phase<pg8::EpiKV, pg8::StaticOrder, true, true>(F.lds, g, S, E); }
    } SEAM(1);
    if (IN(2)) { NEWFRAME();
#ifndef NO_R1
 r1_lora_in(F, args);
#endif
#ifndef NO_LRU
 lru_pass<false>(F, args);
#endif
#ifndef NO_XA
 xattn_phase(F, args);
#endif
 } SEAM(2);
    if (IN(3)) { NEWFRAME();
        lru_carry(F, args);
        { pg8::Gemm g{(const bf16*)(ws + WS_XN), (const bf16*)(ws + WS_WLORA), T, 3072, LORA_K}; pg8::StaticOrder S; S.init(T, 3072, F.G, (int)blockIdx.x);
          pg8::EpiF32 E{(float*)(ws + WS_LORAOUT), 3072};
          pg8::gemm_phase<pg8::EpiF32, pg8::StaticOrder, true, true>(F.lds, g, S, E); }
    } SEAM(3);
    if (IN(4)) { NEWFRAME(); r3_scan_inputs(F, args); lru_pass<true>(F, args); } SEAM(4);
    if (IN(5)) { NEWFRAME();
#ifndef NO_SCAN
 if (F.wave < 2) r4_scan<0>(F, args);
#endif
#ifndef NO_CONV
 if (F.wave >= 2) moe_weight_convert(F, args, 2);
#endif
 } SEAM(5);
    if (IN(6)) { NEWFRAME(); r5_finish(F, args); } SEAM(6);
    if (IN(7)) { NEWFRAME();
        pg8::Gemm g{(const bf16*)(ws + WS_YABC), (const bf16*)(ws + WS_WBR), T, 2048, 3072}; pg8::StaticOrder S; S.init(T, 2048, F.G, (int)blockIdx.x);
        pg8::EpiBranch2 E{(const bf16*)(ws + WS_P), NP, PC_G, (bf16*)(ws + WS_MERGED)};
        pg8::gemm_phase<pg8::EpiBranch2, pg8::StaticOrder, true, true>(F.lds, g, S, E);
    } SEAM(7);
    if (IN(8)) { NEWFRAME();
        pg8::Gemm g{(const bf16*)(ws + WS_MERGED), (const bf16*)(ws + WS_WO), T, D, D}; pg8::StaticOrder S; S.init(T, D, F.G, (int)blockIdx.x);
        pg8::EpiRes E{inp(I_X), (float*)(ws + WS_H1), D};
        pg8::gemm_phase<pg8::EpiRes, pg8::StaticOrder, true, true>(F.lds, g, S, E);
    } SEAM(8);
    if (IN(9)) { NEWFRAME(); router_phase(F, args); } SEAM(9);
    if (IN(10)) { NEWFRAME(); scatter_phase(F, args); } SEAM(10);
    if (IN(11)) { NEWFRAME();
        const int ntiles = (int)__hip_atomic_load(ctl + CW_NTILES, __ATOMIC_RELAXED, __HIP_MEMORY_SCOPE_AGENT);
        pg8::Gemm g{(const bf16*)(ws + WS_XS), (const bf16*)(ws + WS_WGU), ntiles * 256, NE * 4096, D}; pg8::MoeOrder S; S.init(ntiles, 16, F.G, (int)blockIdx.x, (const int*)(ctl + CW_TILEE));
        pg8::EpiSwiglu E{(bf16*)(ws + WS_HH), inp(I_BGATE), inp(I_BUP)};
        pg8::gemm_phase<pg8::EpiSwiglu, pg8::MoeOrder, true, true>(F.lds, g, S, E);
    } SEAM(11);
    if (IN(12)) { NEWFRAME();
        const int ntiles = (int)__hip_atomic_load(ctl + CW_NTILES, __ATOMIC_RELAXED, __HIP_MEMORY_SCOPE_AGENT);
        pg8::Gemm g{(const bf16*)(ws + WS_HH), (const bf16*)(ws + WS_WD), ntiles * 256, NE * 2048, D}; pg8::MoeOrder S; S.init(ntiles, 8, F.G, (int)blockIdx.x, (const int*)(ctl + CW_TILEE));
        pg8::EpiDown E{(bf16*)(ws + WS_OROW), inp(I_BDOWN), (const float*)(ws + WS_ROWTAB)};
        pg8::gemm_phase<pg8::EpiDown, pg8::MoeOrder, true, true>(F.lds, g, S, E);
    } SEAM(12);
    if (IN(13)) { NEWFRAME(); final_phase(F, args); }
#ifdef PROBE_EXTRA_PHASE
    if (lo == 14) { NEWFRAME(); if (F.wave < 2) r4_scan<0>(F, args); }
    if (lo == 15) { NEWFRAME(); if (F.wave >= 2) moe_weight_convert(F, args, 2); }
    if (lo == 16) { NEWFRAME(); moe_weight_convert(F, args, 0); }
    if (lo == 17) { NEWFRAME(); if (F.wave < 2) r4_scan<1>(F, args); }
    if (lo == 18) { NEWFRAME(); if (F.wave < 2) r4_scan<2>(F, args); }
    if (lo == 19) { NEWFRAME(); if (F.wave < 2) r4_scan<3>(F, args); }
#endif
#undef IN
#undef SEAM
}

extern "C" void kernel_launch(void* const* d_in, const int* in_sizes, int n_in, void* d_out, int out_size, void* d_ws, size_t ws_size, hipStream_t stream) {
    static int grid = 0;
    if (grid == 0) {
        if (n_in != 39 || out_size != T * D || ws_size < WS_END) { fprintf(stderr, "kernel_launch: built for 39 inputs, out of %d floats, >= %zu bytes of workspace; got n_in %d, out %d, ws %zu; nothing launched\n", T * D, (size_t)WS_END, n_in, out_size, ws_size); grid = -1; return; }
        int dev = 0, cus = 0, per_cu = 0;
        if (hipGetDevice(&dev) != hipSuccess || hipDeviceGetAttribute(&cus, hipDeviceAttributeMultiprocessorCount, dev) != hipSuccess) { fprintf(stderr, "kernel_launch: device query failed\n"); grid = -1; return; }
        if (hipFuncSetAttribute((const void*)fwd, hipFuncAttributeMaxDynamicSharedMemorySize, LDS_BYTES) != hipSuccess) { fprintf(stderr, "kernel_launch: hipFuncSetAttribute failed\n"); grid = -1; return; }
        if (hipOccupancyMaxActiveBlocksPerMultiprocessor(&per_cu, (const void*)fwd, NWAVES * 64, LDS_BYTES) != hipSuccess || per_cu < 1)
            fprintf(stderr, "kernel_launch: note: occupancy query reports %d workgroups per CU\n", per_cu);
        (void)hipGetLastError();
        grid = cus;
    }
    if (grid < 0) return;
    (void)in_sizes;
    if (hipMemsetAsync((char*)d_ws + WS_CTL, 0, CTL_ZERO_BYTES, stream) != hipSuccess) { fprintf(stderr, "kernel_launch: hipMemsetAsync failed\n"); return; }
    Args a{};
    for (int i = 0; i < 39; ++i) a.in[i] = (const float*)d_in[i];
    a.out = (float*)d_out; a.ws = (unsigned char*)d_ws;
#if MK_N_LAUNCHES == 1
    a.ph_lo = 0; a.ph_hi = NPH;
    hipLaunchKernelGGL(fwd, dim3(grid), dim3(NWAVES * 64), LDS_BYTES, stream, a);
#else
    for (int k = 0; k < NPH; ++k) { a.ph_lo = k; a.ph_hi = k + 1; int reps = 1;
#ifdef PROBE_REP_PHASE
        if (k == PROBE_REP_PHASE) reps = 1 + PROBE_REP_N;
#endif
        for (int r = 0; r < reps; ++r) hipLaunchKernelGGL(fwd, dim3(grid), dim3(NWAVES * 64), LDS_BYTES, stream, a); }
#ifdef PROBE_EXTRA_PHASE
    for (int r = 0; r < PROBE_REP_N; ++r) { a.ph_lo = PROBE_EXTRA_PHASE; a.ph_hi = PROBE_EXTRA_PHASE + 1; hipLaunchKernelGGL(fwd, dim3(grid), dim3(NWAVES * 64), LDS_BYTES, stream, a); }
#endif
#endif
    const hipError_t le = hipPeekAtLastError();
    if (le != hipSuccess) fprintf(stderr, "kernel_launch: launch failed: %s\n", hipGetErrorName(le));
}
```

```cpp
#include <hip/hip_runtime.h>
#include <cstdio>
#include <cstdint>
namespace pg8 {
#define PG8_LAS __attribute__((address_space(3)))
typedef unsigned short bf16_t;
typedef short bf16x8 __attribute__((ext_vector_type(8)));
typedef float f32x4 __attribute__((ext_vector_type(4)));
typedef unsigned u32x4 __attribute__((ext_vector_type(4)));
constexpr int BM = 256, BK = 64, HALF = 128, HTB = HALF * BK * 2  , STAGE_BYTES = 8 * HTB, NXCD = 8, WGM = 8;

__host__ __device__ __forceinline__ int lds_byte(int r, int c) { const int st = (r >> 4) * 2 + (c >> 5), rr = r & 15, cc = c & 31, ob = rr * 64 + cc * 2; return st * 1024 + (ob ^ (((ob >> 9) & 1) << 5)); }
__host__ __device__ __forceinline__ void stage_rc(int b, int& R, int& C) { const int st = b / 1024, sb = b % 1024, swz = sb ^ (((sb >> 9) & 1) << 5); R = (st >> 1) * 16 + swz / 64; C = (st & 1) * 32 + (swz % 64) / 2; }
__host__ __device__ __forceinline__ int perm32(int rho) { const int n = rho >> 4, i = rho & 15; return 8 * (i >> 2) + 4 * n + (i & 3); }

struct Unit { int pm, pn; };
struct Gemm { const bf16_t* A; const bf16_t* Bt; int M, N, K; };

struct StaticOrder {
    static constexpr bool GATHER = false; __device__ __forceinline__ int arow(const Unit&, int) const { return 0; }
    int nM, nN, nwg, G, c;
    __host__ __device__ void init(int M, int N, int G_, int c_) { nM = M / BM; nN = N / BM; nwg = nM * nN; G = G_; c = c_; }
    __host__ __device__ bool next(int i, Unit& u) const {
        const long L = (long)i * G + c; if (L >= nwg) return false;
        int wgid = (int)L; { const int q = nwg / NXCD, r = nwg % NXCD, xcd = wgid % NXCD, off = wgid / NXCD; wgid = (xcd < r ? xcd * (q + 1) : r * (q + 1) + (xcd - r) * q) + off; }
        const int nig = WGM * nN, gid = wgid / nig, fm = gid * WGM, gsz = (nM - fm) < WGM ? (nM - fm) : WGM;
        u.pm = fm + ((wgid % nig) % gsz); u.pn = (wgid % nig) / gsz; return true;
    }
    __device__ __forceinline__ void a_ready(const Unit&) const {}
    __device__ __forceinline__ void done(const Unit&) const {}
};
__device__ __forceinline__ unsigned cvt_pk_bf16(float lo, float hi) { unsigned r; asm volatile("v_cvt_pk_bf16_f32 %0, %1, %2" : "=v"(r) : "v"(lo), "v"(hi)); return r; }
typedef float f32x2 __attribute__((ext_vector_type(2)));
__device__ __forceinline__ f32x2 gelu_pk(f32x2 v) {
    const f32x2 av = __builtin_elementwise_abs(v), d = av * 0.2316418882f + 1.0f;
    f32x2 t; t.x = __builtin_amdgcn_rcpf(d.x); t.y = __builtin_amdgcn_rcpf(d.y);
    f32x2 q = t * 0.5307027145f + (-0.7265760135f); q = q * t + 0.7107068705f; q = q * t + (-0.142248368f); q = q * t + 0.127414796f; q = q * t;
    const f32x2 s = (v * v) * (-0.72134752044f);
    f32x2 e; e.x = __builtin_amdgcn_exp2f(s.x); e.y = __builtin_amdgcn_exp2f(s.y);
    const f32x2 m = v * (q * e), r = v - m;
    f32x2 o; o.x = v.x < 0.f ? m.x : r.x; o.y = v.y < 0.f ? m.y : r.y; return o;
}

template <int ACT  > struct EpiBf16 {
    static constexpr bool PERM = true, AFTER_DRAIN = false; static constexpr int MIDK = 0; static_assert(ACT == 0 || ACT == 1, "EpiBf16: ACT is 0 (none) or 1 (gelu_pk)");
    bf16_t* O; int ldc; const float* bias; int split_cols; size_t split_stride; float scale0;
    __device__ __forceinline__ void operator()(const f32x4 (&acc)[2][2][4][2], const Unit& u, int wr, int wc, int fr, int fq) const {
        const int row0 = u.pm * BM + wr * 64 + fr; int colt = u.pn * BM; bf16_t* base = O;
        float sc = 1.f; if (split_cols) { const int t = colt / split_cols; base += (size_t)t * split_stride; colt -= t * split_cols; if (t == 0) sc = scale0; }
        const int col0 = colt + wc * 32 + 8 * fq, bcol0 = u.pn * BM + wc * 32 + 8 * fq;
        f32x4 bv[2][2];
#pragma unroll
        for (int bj = 0; bj < 2; ++bj)
#pragma unroll
            for (int n = 0; n < 2; ++n) bv[bj][n] = bias ? *(const f32x4*)(bias + bcol0 + bj * HALF + 4 * n) : (f32x4){0.f, 0.f, 0.f, 0.f};
#pragma unroll
        for (int ai = 0; ai < 2; ++ai)
#pragma unroll
            for (int m = 0; m < 4; ++m) { bf16_t* rowp = base + (size_t)(row0 + ai * HALF + m * 16) * ldc + col0;
#pragma unroll
                for (int bj = 0; bj < 2; ++bj) { f32x4 v0 = acc[ai][bj][m][0] + bv[bj][0], v1 = acc[ai][bj][m][1] + bv[bj][1];
                    if (ACT == 1) { f32x2 a = gelu_pk((f32x2){v0[0], v0[1]}), b = gelu_pk((f32x2){v0[2], v0[3]}), c = gelu_pk((f32x2){v1[0], v1[1]}), d = gelu_pk((f32x2){v1[2], v1[3]});
                        v0 = (f32x4){a.x, a.y, b.x, b.y}; v1 = (f32x4){c.x, c.y, d.x, d.y}; }
                    v0 = v0 * sc; v1 = v1 * sc; u32x4 w; w.x = cvt_pk_bf16(v0[0], v0[1]); w.y = cvt_pk_bf16(v0[2], v0[3]); w.z = cvt_pk_bf16(v1[0], v1[1]); w.w = cvt_pk_bf16(v1[2], v1[3]);
                    *(u32x4*)(rowp + bj * HALF) = w; } }
    }
};

__device__ __forceinline__ float bf_lo(unsigned w) { return __builtin_bit_cast(float, w << 16); }
__device__ __forceinline__ float bf_hi(unsigned w) { return __builtin_bit_cast(float, w & 0xffff0000u); }
__device__ __forceinline__ float fsigmoid(float x) { return __builtin_amdgcn_rcpf(1.0f + __expf(-x)); }
typedef unsigned u32x2 __attribute__((ext_vector_type(2)));

struct EpiF32 {
    static constexpr bool PERM = false, AFTER_DRAIN = false; static constexpr int MIDK = 0;
    float* C; int ldc;
    __device__ __forceinline__ void operator()(const f32x4 (&acc)[2][2][4][2], const Unit& u, int wr, int wc, int fr, int fq) const {
        const int row0 = u.pm * BM + wr * 64 + fr, col0 = u.pn * BM + wc * 32 + 4 * fq;
#pragma unroll
        for (int ai = 0; ai < 2; ++ai)
#pragma unroll
            for (int m = 0; m < 4; ++m) { float* rowp = C + (size_t)(row0 + ai * HALF + m * 16) * ldc + col0;
#pragma unroll
                for (int bj = 0; bj < 2; ++bj)
#pragma unroll
                    for (int n = 0; n < 2; ++n) *(f32x4*)(rowp + bj * HALF + n * 16) = acc[ai][bj][m][n]; }
    }
};
struct EpiRes {
    static constexpr bool PERM = false, AFTER_DRAIN = false; static constexpr int MIDK = 0;
    const float* X; float* C; int ldc;
    __device__ __forceinline__ void operator()(const f32x4 (&acc)[2][2][4][2], const Unit& u, int wr, int wc, int fr, int fq) const {
        const int row0 = u.pm * BM + wr * 64 + fr, col0 = u.pn * BM + wc * 32 + 4 * fq;
#pragma unroll
        for (int ai = 0; ai < 2; ++ai)
#pragma unroll
            for (int m = 0; m < 4; ++m) { const size_t off = (size_t)(row0 + ai * HALF + m * 16) * ldc + col0;
#pragma unroll
                for (int bj = 0; bj < 2; ++bj)
#pragma unroll
                    for (int n = 0; n < 2; ++n) { const f32x4 xv = *(const f32x4*)(X + off + bj * HALF + n * 16); *(f32x4*)(C + off + bj * HALF + n * 16) = acc[ai][bj][m][n] + xv; }
                asm volatile("" ::: "memory"); }
    }
};
struct EpiKV {
    static constexpr bool PERM = false, AFTER_DRAIN = false; static constexpr int MIDK = 0;
    bf16_t* Kb; bf16_t* VT;
    __device__ __forceinline__ void operator()(const f32x4 (&acc)[2][2][4][2], const Unit& u, int wr, int wc, int fr, int fq) const {
        const int row0 = u.pm * BM + wr * 64 + fr, col0 = u.pn * BM + wc * 32 + 4 * fq;
#pragma unroll
        for (int ai = 0; ai < 2; ++ai)
#pragma unroll
            for (int m = 0; m < 4; ++m) { const int r = row0 + ai * HALF + m * 16;
#pragma unroll
                for (int bj = 0; bj < 2; ++bj)
#pragma unroll
                    for (int n = 0; n < 2; ++n) { const f32x4 v = acc[ai][bj][m][n]; const int c = col0 + bj * HALF + n * 16;
                        if (u.pn < 4) { u32x2 w; w.x = cvt_pk_bf16(v[0], v[1]); w.y = cvt_pk_bf16(v[2], v[3]); *(u32x2*)(Kb + (size_t)r * 1024 + c) = w; }
                        else { const int cc = c - 1024, h = cc >> 8, d = cc & 255, b = r >> 8, mm = r & 255;
                            const int idx = (mm >> 5) * 32 + ((mm >> 2) & 3) * 8 + ((mm >> 4) & 1) * 4 + (mm & 3);
                            bf16_t* o = VT + ((size_t)((b * 4 + h) * 256 + d)) * 256 + idx;
                            const unsigned w0 = cvt_pk_bf16(v[0], v[1]), w1 = cvt_pk_bf16(v[2], v[3]);
                            o[0] = (bf16_t)(w0 & 0xffffu); o[256] = (bf16_t)(w0 >> 16); o[512] = (bf16_t)(w1 & 0xffffu); o[768] = (bf16_t)(w1 >> 16); } } }
    }
};
struct EpiBranch {
    static constexpr bool PERM = false, AFTER_DRAIN = false; static constexpr int MIDK = 0;
    const bf16_t* P; int ldp; int gcol0; float* macc; bf16_t* merged;
    __device__ __forceinline__ void operator()(const f32x4 (&acc)[2][2][4][2], const Unit& u, int wr, int wc, int fr, int fq) const {
        const int br = u.pm >> 6, pm = u.pm & 63, pn = u.pn & 7;
        const int row0 = pm * BM + wr * 64 + fr, col0 = pn * BM + wc * 32 + 4 * fq;
#pragma unroll
        for (int ai = 0; ai < 2; ++ai)
#pragma unroll
            for (int m = 0; m < 4; ++m) { const int r = row0 + ai * HALF + m * 16; const bf16_t* prow = P + (size_t)r * ldp + gcol0 + br * 2048;
#pragma unroll
                for (int bj = 0; bj < 2; ++bj)
#pragma unroll
                    for (int n = 0; n < 2; ++n) { const int c = col0 + bj * HALF + n * 16; const u32x2 gw = *(const u32x2*)(prow + c);
                        f32x4 g; g[0] = fsigmoid(bf_lo(gw.x)); g[1] = fsigmoid(bf_hi(gw.x)); g[2] = fsigmoid(bf_lo(gw.y)); g[3] = fsigmoid(bf_hi(gw.y));
                        f32x4 v = acc[ai][bj][m][n] * g; float* mp = macc + (size_t)r * 2048 + c;
                        if (br > 0) v = v + *(const f32x4*)mp;
                        if (br < 2) *(f32x4*)mp = v;
                        else { u32x2 w; w.x = cvt_pk_bf16(v[0], v[1]); w.y = cvt_pk_bf16(v[2], v[3]); *(u32x2*)(merged + (size_t)r * 2048 + c) = w; } }
                asm volatile("" ::: "memory"); }
    }
};
struct EpiSwiglu {
    static constexpr bool PERM = true, AFTER_DRAIN = false; static constexpr int MIDK = 0;
    bf16_t* H; const float* bg; const float* bu;
    __device__ __forceinline__ void operator()(const f32x4 (&acc)[2][2][4][2], const Unit& u, int wr, int wc, int fr, int fq) const {
        const int e = u.pn >> 4, ct = u.pn & 15;
        const int row0 = u.pm * BM + wr * 64 + fr, col0 = ct * 128 + wc * 32 + 8 * fq;
        f32x4 bgv[2], buv[2];
#pragma unroll
        for (int n = 0; n < 2; ++n) { bgv[n] = *(const f32x4*)(bg + (size_t)e * 2048 + col0 + 4 * n); buv[n] = *(const f32x4*)(bu + (size_t)e * 2048 + col0 + 4 * n); }
#pragma unroll
        for (int ai = 0; ai < 2; ++ai)
#pragma unroll
            for (int m = 0; m < 4; ++m) { bf16_t* rowp = H + (size_t)(row0 + ai * HALF + m * 16) * 2048 + col0;
                f32x4 o[2];
#pragma unroll
                for (int n = 0; n < 2; ++n) { const f32x4 g = acc[ai][0][m][n] + bgv[n], up = acc[ai][1][m][n] + buv[n];
#pragma unroll
                    for (int j = 0; j < 4; ++j) { const float hg = fminf(g[j], 7.0f), hu = fminf(fmaxf(up[j], -7.0f), 7.0f); o[n][j] = (hu + 1.0f) * hg * fsigmoid(1.702f * hg); } }
                u32x4 w; w.x = cvt_pk_bf16(o[0][0], o[0][1]); w.y = cvt_pk_bf16(o[0][2], o[0][3]); w.z = cvt_pk_bf16(o[1][0], o[1][1]); w.w = cvt_pk_bf16(o[1][2], o[1][3]);
                *(u32x4*)rowp = w; }
    }
};
struct EpiDown {
    static constexpr bool PERM = true, AFTER_DRAIN = false; static constexpr int MIDK = 0;
    bf16_t* O; const float* bd; const float* rowgate;
    __device__ __forceinline__ void operator()(const f32x4 (&acc)[2][2][4][2], const Unit& u, int wr, int wc, int fr, int fq) const {
        const int e = u.pn >> 3, ct = u.pn & 7;
        const int row0 = u.pm * BM + wr * 64 + fr, col0 = ct * BM + wc * 32 + 8 * fq;
        f32x4 bv[2][2];
#pragma unroll
        for (int bj = 0; bj < 2; ++bj)
#pragma unroll
            for (int n = 0; n < 2; ++n) bv[bj][n] = *(const f32x4*)(bd + (size_t)e * 2048 + col0 + bj * HALF + 4 * n);
#pragma unroll
        for (int ai = 0; ai < 2; ++ai)
#pragma unroll
            for (int m = 0; m < 4; ++m) { const int r = row0 + ai * HALF + m * 16; const float gs = rowgate[r]; bf16_t* rowp = O + (size_t)r * 2048 + col0;
#pragma unroll
                for (int bj = 0; bj < 2; ++bj) { const f32x4 v0 = (acc[ai][bj][m][0] + bv[bj][0]) * gs, v1 = (acc[ai][bj][m][1] + bv[bj][1]) * gs;
                    u32x4 w; w.x = cvt_pk_bf16(v0[0], v0[1]); w.y = cvt_pk_bf16(v0[2], v0[3]); w.z = cvt_pk_bf16(v1[0], v1[1]); w.w = cvt_pk_bf16(v1[2], v1[3]);
                    *(u32x4*)(rowp + bj * HALF) = w; } }
    }
};

struct EpiBranch2 {
    static constexpr bool PERM = false, AFTER_DRAIN = false; static constexpr int MIDK = 16;
    const bf16_t* P; int ldp; int gcol0; bf16_t* merged;
    __device__ __forceinline__ void mid(f32x4 (&acc)[2][2][4][2], const Unit& u, int which, int, int, int, int) const {
        int tz = threadIdx.x; asm volatile("" : "+v"(tz));
        const int wid_ = tz >> 6, lane_ = tz & 63, wr = wid_ >> 2, wc = wid_ & 3, fr = lane_ & 15, fq = lane_ >> 4;
        const int row0 = u.pm * BM + wr * 64 + fr, col0 = u.pn * BM + wc * 32 + 4 * fq;
#pragma unroll
        for (int ai = 0; ai < 2; ++ai)
#pragma unroll
            for (int m = 0; m < 4; ++m) { const bf16_t* prow = P + (size_t)(row0 + ai * HALF + m * 16) * ldp + gcol0 + (which - 1) * 2048;
#pragma unroll
                for (int bj = 0; bj < 2; ++bj)
#pragma unroll
                    for (int n = 0; n < 2; ++n) { const int c = col0 + bj * HALF + n * 16; const u32x2 ga = *(const u32x2*)(prow + c), gb = *(const u32x2*)(prow + 2048 + c);
                        const float a_[4] = {bf_lo(ga.x), bf_hi(ga.x), bf_lo(ga.y), bf_hi(ga.y)}, b_[4] = {bf_lo(gb.x), bf_hi(gb.x), bf_lo(gb.y), bf_hi(gb.y)};
#pragma unroll
                        for (int j = 0; j < 4; ++j) { const float ea = __expf(-fminf(fmaxf(a_[j], -30.f), 30.f)), eb = __expf(-fminf(fmaxf(b_[j], -30.f), 30.f));
                            acc[ai][bj][m][n][j] *= (1.0f + eb) * __builtin_amdgcn_rcpf(1.0f + ea); } }
                asm volatile("" ::: "memory"); }
    }
    __device__ __forceinline__ void operator()(const f32x4 (&acc)[2][2][4][2], const Unit& u, int wr, int wc, int fr, int fq) const {
        const int row0 = u.pm * BM + wr * 64 + fr, col0 = u.pn * BM + wc * 32 + 4 * fq;
#pragma unroll
        for (int ai = 0; ai < 2; ++ai)
#pragma unroll
            for (int m = 0; m < 4; ++m) { const int r = row0 + ai * HALF + m * 16; const bf16_t* prow = P + (size_t)r * ldp + gcol0 + 2 * 2048;
#pragma unroll
                for (int bj = 0; bj < 2; ++bj)
#pragma unroll
                    for (int n = 0; n < 2; ++n) { const int c = col0 + bj * HALF + n * 16; const u32x2 gw = *(const u32x2*)(prow + c);
                        const float g_[4] = {bf_lo(gw.x), bf_hi(gw.x), bf_lo(gw.y), bf_hi(gw.y)}; f32x4 v = acc[ai][bj][m][n];
#pragma unroll
                        for (int j = 0; j < 4; ++j) v[j] *= __builtin_amdgcn_rcpf(1.0f + __expf(-fminf(fmaxf(g_[j], -30.f), 30.f)));
                        u32x2 w; w.x = cvt_pk_bf16(v[0], v[1]); w.y = cvt_pk_bf16(v[2], v[3]); *(u32x2*)(merged + (size_t)r * 2048 + c) = w; }
                asm volatile("" ::: "memory"); }
    }
};
struct BranchOrder {                              static constexpr bool GATHER = false; __device__ __forceinline__ int arow(const Unit&, int) const { return 0; }
    StaticOrder so;
    __device__ void init(int G_, int c_) { so.init(16384, 2048, G_, c_); }
    __device__ bool next(int i, Unit& u) const { const int br = i % 3; Unit t; if (!so.next(i / 3, t)) return false; u.pm = br * 64 + t.pm; u.pn = br * 8 + t.pn; return true; }
    __device__ __forceinline__ void a_ready(const Unit&) const {}
    __device__ __forceinline__ void done(const Unit&) const {}
};
template <bool GATH> struct MoeOrder {
    static constexpr bool GATHER = GATH;
    StaticOrder so; const int* tile_e; const int* tok; int nN;
    __device__ void init(int ntiles, int nN_, int G_, int c_, const int* te, const int* tk) { so.init(ntiles * BM, nN_ * BM, G_, c_); tile_e = te; tok = tk; nN = nN_; }
    __device__ bool next(int i, Unit& u) const { Unit t; if (!so.next(i, t)) return false; u.pm = t.pm; u.pn = tile_e[t.pm] * nN + t.pn; return true; }
    __device__ __forceinline__ int arow(const Unit& u, int r) const { return tok[u.pm * BM + r]; }
    __device__ __forceinline__ void a_ready(const Unit&) const {}
    __device__ __forceinline__ void done(const Unit&) const {}
};
template <class Epi, class Sched, bool ALIGN_EPI = false, bool SP2 = false>
__device__ __forceinline__ void gemm_phase(PG8_LAS unsigned char* lds, const Gemm g, const Sched& S, const Epi& E) {
    const int tid = threadIdx.x, wid = __builtin_amdgcn_readfirstlane(tid >> 6), lane = tid & 63, wr = wid >> 2, wc = wid & 3, fr = lane & 15, fq = lane >> 4;
    const int K = g.K, nt = K / BK;
    unsigned voffA[2], voffB[2];
#pragma unroll
    for (int i = 0; i < 2; ++i) { int R, C; stage_rc(tid * 16 + i * 8192, R, C); const int Rb = Epi::PERM ? ((R & ~31) + perm32(R & 31)) : R;
        voffA[i] = (unsigned)(R * K + C) * 2u; voffB[i] = (unsigned)(Rb * K + C) * 2u; }
    unsigned vc[2][2] = {{0u, 0u}, {0u, 0u}}, vn[2][2] = {{0u, 0u}, {0u, 0u}};
#define PG8_ROWS(dst, un) do { if constexpr (Sched::GATHER) { _Pragma("unroll") for (int _h = 0; _h < 2; ++_h) _Pragma("unroll") for (int _i = 0; _i < 2; ++_i) { int R_, C_; stage_rc(tid * 16 + _i * 8192, R_, C_); \
        dst[_h][_i] = (unsigned)(S.arow(un, _h * HALF + R_) * K + C_) * 2u; } } } while (0)
#define PG8_STAGE_A(bufoff, abase, half, nx) do { if constexpr (Sched::GATHER) { unsigned vo_[2]; vo_[0] = (nx) ? vn[half][0] : vc[half][0]; vo_[1] = (nx) ? vn[half][1] : vc[half][1]; PG8_STAGE(bufoff, abase, vo_); } \
        else { PG8_STAGE(bufoff, (abase) + (half) * hstep, voffA); } } while (0)
    const size_t kstep = (size_t)(BK * 2);
    const size_t hstep = (size_t)HALF * K * 2;
    const size_t tstep = 2 * hstep;
    const unsigned ldsw = (unsigned)wid * 1024u;
    const int aoff = lds_byte(wr * 64 + fr, fq * 8), boff = lds_byte(wc * 32 + fr, fq * 8);
#define PG8_SA(b, h) (((b) * 2 + (h)) * HTB)
#define PG8_SB(b, h) ((4 + (b) * 2 + (h)) * HTB)
#define PG8_STAGE(bufoff, gbase, voff) do { _Pragma("unroll") for (int _i = 0; _i < 2; ++_i) \
        __builtin_amdgcn_global_load_lds((const unsigned*)((const char*)(gbase) + (voff)[_i]), (PG8_LAS unsigned*)(lds + (bufoff) + ldsw + _i * 8192), 16, 0, 0); } while (0)
#define PG8_LDA(dst, b, h) do { _Pragma("unroll") for (int m = 0; m < 4; ++m) _Pragma("unroll") for (int k = 0; k < 2; ++k) dst[m][k] = *(const PG8_LAS bf16x8*)(lds + PG8_SA(b, h) + aoff + m * 2048 + k * 1024); } while (0)
#define PG8_LDB(dst, b, h) do { _Pragma("unroll") for (int n = 0; n < 2; ++n) _Pragma("unroll") for (int k = 0; k < 2; ++k) dst[n][k] = *(const PG8_LAS bf16x8*)(lds + PG8_SB(b, h) + boff + n * 2048 + k * 1024); } while (0)
#define PG8_MMA(ai, bj, At, Bt) do { __builtin_amdgcn_s_setprio(1); _Pragma("unroll") for (int m = 0; m < 4; ++m) _Pragma("unroll") for (int n = 0; n < 2; ++n) _Pragma("unroll") for (int k = 0; k < 2; ++k) \
        acc[ai][bj][m][n] = __builtin_amdgcn_mfma_f32_16x16x32_bf16(Bt[n][k], At[m][k], acc[ai][bj][m][n], 0, 0, 0); __builtin_amdgcn_s_setprio(0); } while (0)
#define PG8_WAIT_V(n) asm volatile("s_waitcnt vmcnt(" #n ")" ::: "memory")
#define PG8_WAIT_L(n) asm volatile("s_waitcnt lgkmcnt(" #n ")" ::: "memory")
#define PG8_BAR __builtin_amdgcn_s_barrier()
#define PG8_SCHED __builtin_amdgcn_sched_barrier(0)
    Unit cur, nxt; int ui = 0;
    if (!S.next(0, cur)) return;
    f32x4 acc[2][2][4][2];
#pragma unroll
    for (int a = 0; a < 2; ++a)
#pragma unroll
        for (int b = 0; b < 2; ++b)
#pragma unroll
            for (int m = 0; m < 4; ++m)
#pragma unroll
                for (int n = 0; n < 2; ++n) acc[a][b][m][n] = (f32x4){0.f, 0.f, 0.f, 0.f};
    bf16x8 At[4][2], B0[2][2], B1[2][2];
    const char* cA = (const char*)g.A + (Sched::GATHER ? (size_t)0 : (size_t)cur.pm * tstep); const char* cB = (const char*)g.Bt + (size_t)cur.pn * tstep;
    PG8_ROWS(vc, cur);
    S.a_ready(cur);
    if constexpr (SP2) {
        PG8_STAGE(PG8_SB(0, 0), cB, voffB); PG8_STAGE(PG8_SB(0, 1), cB + hstep, voffB); PG8_STAGE_A(PG8_SA(0, 0), cA, 0, false); PG8_STAGE_A(PG8_SA(0, 1), cA, 1, false);
        if (wr == 1) PG8_BAR;
        PG8_WAIT_V(2); PG8_BAR;
        PG8_STAGE(PG8_SB(1, 0), cB + kstep, voffB); PG8_STAGE_A(PG8_SA(1, 0), cA + kstep, 0, false); PG8_STAGE(PG8_SB(1, 1), cB + hstep + kstep, voffB);
        PG8_WAIT_V(6); PG8_BAR;
    } else {
        PG8_STAGE(PG8_SB(0, 0), cB, voffB); PG8_STAGE_A(PG8_SA(0, 0), cA, 0, false); PG8_STAGE(PG8_SB(0, 1), cB + hstep, voffB); PG8_STAGE_A(PG8_SA(0, 1), cA, 1, false);
        if (wr == 1) PG8_BAR;
        PG8_WAIT_V(4); PG8_BAR;
        PG8_STAGE(PG8_SB(1, 0), cB + kstep, voffB); PG8_STAGE_A(PG8_SA(1, 0), cA + kstep, 0, false); PG8_STAGE(PG8_SB(1, 1), cB + hstep + kstep, voffB);
        PG8_WAIT_V(6); PG8_BAR;
    }
    for (;;) {
        const bool has_next = S.next(ui + 1, nxt);
        if (has_next) PG8_ROWS(vn, nxt);
        const char* nA = (has_next && !Sched::GATHER) ? (const char*)g.A + (size_t)nxt.pm * tstep : cA; const char* nB = has_next ? (const char*)g.Bt + (size_t)nxt.pn * tstep : cB;
        for (int t = 0; t < nt; t += 2) {
            const bool last = (t == nt - 2);
            const char* a1 = cA + (size_t)(t + 1) * kstep;
            const char* a2 = last ? nA : cA + (size_t)(t + 2) * kstep; const char* b2 = last ? nB : cB + (size_t)(t + 2) * kstep;
            const char* a3 = a2 + kstep; const char* b3 = b2 + kstep;
            if (last && has_next) S.a_ready(nxt);
            if constexpr (Epi::MIDK > 0) { if (t == Epi::MIDK || t == 2 * Epi::MIDK) E.mid(acc, cur, t / Epi::MIDK, wr, wc, fr, fq); }
            if constexpr (SP2) {
            PG8_LDB(B0, 0, 0); PG8_LDB(B1, 0, 1); PG8_SCHED; PG8_LDA(At, 0, 0); PG8_STAGE_A(PG8_SA(1, 1), a1, 1, false);
            PG8_WAIT_V(8); PG8_WAIT_L(0); PG8_BAR; PG8_MMA(0, 0, At, B0); PG8_MMA(0, 1, At, B1); PG8_BAR; PG8_SCHED;
            PG8_LDA(At, 0, 1); PG8_STAGE(PG8_SB(0, 0), b2, voffB); PG8_STAGE(PG8_SB(0, 1), b2 + hstep, voffB); PG8_STAGE_A(PG8_SA(0, 0), a2, 0, last);
            PG8_WAIT_V(8); PG8_WAIT_L(0); PG8_BAR; PG8_MMA(1, 0, At, B0); PG8_MMA(1, 1, At, B1); PG8_BAR; PG8_SCHED;
            PG8_LDB(B0, 1, 0); PG8_LDB(B1, 1, 1); PG8_SCHED; PG8_LDA(At, 1, 0); PG8_STAGE_A(PG8_SA(0, 1), a2, 1, last);
            PG8_WAIT_V(8); PG8_WAIT_L(0); PG8_BAR; PG8_MMA(0, 0, At, B0); PG8_MMA(0, 1, At, B1); PG8_BAR; PG8_SCHED;
            PG8_LDA(At, 1, 1); PG8_STAGE(PG8_SB(1, 0), b3, voffB); PG8_STAGE(PG8_SB(1, 1), b3 + hstep, voffB); PG8_STAGE_A(PG8_SA(1, 0), a3, 0, last);
            PG8_WAIT_V(8); PG8_WAIT_L(0); PG8_BAR; PG8_MMA(1, 0, At, B0); PG8_MMA(1, 1, At, B1); PG8_BAR; PG8_SCHED;
            } else {
            PG8_LDB(B0, 0, 0); PG8_SCHED; PG8_LDA(At, 0, 0); PG8_STAGE_A(PG8_SA(1, 1), a1, 1, false);
            PG8_WAIT_L(8); PG8_BAR; PG8_WAIT_L(0); PG8_MMA(0, 0, At, B0); PG8_BAR; PG8_SCHED;
            PG8_LDB(B1, 0, 1); PG8_STAGE(PG8_SB(0, 0), b2, voffB);
            PG8_BAR; PG8_WAIT_L(0); PG8_MMA(0, 1, At, B1); PG8_BAR;
            PG8_LDA(At, 0, 1); PG8_STAGE_A(PG8_SA(0, 0), a2, 0, last);
            PG8_BAR; PG8_WAIT_L(0); PG8_MMA(1, 0, At, B0); PG8_BAR; PG8_SCHED;
            PG8_STAGE(PG8_SB(0, 1), b2 + hstep, voffB);
            PG8_WAIT_V(6); PG8_BAR; PG8_MMA(1, 1, At, B1); PG8_BAR;
            PG8_LDB(B0, 1, 0); PG8_SCHED; PG8_LDA(At, 1, 0); PG8_STAGE_A(PG8_SA(0, 1), a2, 1, last);
            PG8_WAIT_L(8); PG8_BAR; PG8_WAIT_L(0); PG8_MMA(0, 0, At, B0); PG8_BAR; PG8_SCHED;
            PG8_LDB(B1, 1, 1); PG8_STAGE(PG8_SB(1, 0), b3, voffB);
            PG8_BAR; PG8_WAIT_L(0); PG8_MMA(0, 1, At, B1); PG8_BAR;
            PG8_LDA(At, 1, 1); PG8_STAGE_A(PG8_SA(1, 0), a3, 0, last);
            PG8_BAR; PG8_WAIT_L(0); PG8_MMA(1, 0, At, B0); PG8_BAR; PG8_SCHED;
            PG8_STAGE(PG8_SB(1, 1), b3 + hstep, voffB);
            PG8_WAIT_V(6); PG8_BAR; PG8_MMA(1, 1, At, B1); PG8_BAR;
            }
        }
        if constexpr (ALIGN_EPI) { if (wr == 0) PG8_BAR; }
        if constexpr (!Epi::AFTER_DRAIN) { E(acc, cur, wr, wc, fr, fq); S.done(cur); }
        if (!has_next) break;
#pragma unroll
        for (int a = 0; a < 2; ++a)
#pragma unroll
            for (int b = 0; b < 2; ++b)
#pragma unroll
                for (int m = 0; m < 4; ++m)
#pragma unroll
                    for (int n = 0; n < 2; ++n) acc[a][b][m][n] = (f32x4){0.f, 0.f, 0.f, 0.f};
        cur = nxt; cA = nA; cB = nB; ++ui;
        if constexpr (Sched::GATHER) { vc[0][0] = vn[0][0]; vc[0][1] = vn[0][1]; vc[1][0] = vn[1][0]; vc[1][1] = vn[1][1]; }
        if constexpr (ALIGN_EPI) { if (wr == 1) PG8_BAR; }
    }
    PG8_WAIT_V(0);
    if constexpr (!ALIGN_EPI) { if (wr == 0) PG8_BAR; }
    PG8_BAR;
    if constexpr (Epi::AFTER_DRAIN) { E.fused(acc, cur, wr, wc, fr, fq, lds, wid, lane); S.done(cur); }
#undef PG8_SA
#undef PG8_SB
#undef PG8_STAGE
#undef PG8_STAGE_A
#undef PG8_ROWS
#undef PG8_LDA
#undef PG8_LDB
#undef PG8_MMA
#undef PG8_WAIT_V
#undef PG8_WAIT_L
#undef PG8_BAR
#undef PG8_SCHED
}
}

constexpr int NWAVES = 8;
constexpr int BATCH = 2, SEQ = 8192, T = BATCH * SEQ, D = 2048;
constexpr int RWKV_COLS = 3360, IN_COLS = 12576;
constexpr int NP = 12800;
constexpr int PC_LX = 3584, PC_LY = 4608, PC_Q = 5632, PC_G = 6656;
constexpr int NE = 32, MAXROWS = 65536 + NE * 256;
constexpr int LORA_K = 384;
constexpr float EPS = 1e-6f, GN_EPS = 64e-5f;

constexpr size_t MiB = 1u << 20;
constexpr size_t WS_CTL = 0, CTL_ZERO_BYTES = 1 * MiB;
constexpr size_t WS_WIN = 1 * MiB, WS_WMKV = 51 * MiB, WS_WLORA = 59 * MiB, WS_WBR = 62 * MiB, WS_WO = 74 * MiB, WS_WR = 82 * MiB, WS_LW = 83 * MiB;
constexpr size_t WS_WGU = 84 * MiB, WS_WD = 596 * MiB;
constexpr size_t WS_XN = 852 * MiB;
constexpr size_t WS_P = 916 * MiB;
constexpr size_t WS_LORAOUT = 1316 * MiB;
constexpr size_t WS_SCAN = 1508 * MiB;
constexpr size_t WS_YABC = 1892 * MiB;
constexpr size_t WS_MISC = 1988 * MiB;
constexpr size_t WS_MN = WS_MISC, WS_KMEM = WS_MISC + 2 * MiB, WS_VT = WS_MISC + 3 * MiB, WS_LRUC = WS_MISC + 4 * MiB  , WS_BONUS = WS_MISC + 7 * MiB;
constexpr size_t WS_PICK = WS_MISC + 8 * MiB  , WS_ROWTAB = WS_MISC + 9 * MiB  , WS_SPL = WS_ROWTAB + 512 * 1024  ;
constexpr size_t WS_END = 2000 * MiB;
constexpr size_t WS_MACC = WS_LORAOUT, WS_MERGED = 1444 * MiB, WS_H1 = WS_SCAN, WS_XS = WS_P, WS_OROW = WS_P, WS_HH = 1204 * MiB;
constexpr int CW_BAR = 4096, CW_CNT = 8192, CW_NTILES = 8192 + 64, CW_TILEE = 8192 + 128;

constexpr int LDS_BYTES = 147456;
constexpr int MISC_OFF = 143360;

#define GAS __attribute__((address_space(1)))
#define LAS __attribute__((address_space(3)))
typedef unsigned short bf16;
typedef unsigned v4u __attribute__((ext_vector_type(4)));
typedef unsigned v2u __attribute__((ext_vector_type(2)));
typedef float f32x4 __attribute__((ext_vector_type(4)));
typedef float f32x2 __attribute__((ext_vector_type(2)));
typedef short bf16x8 __attribute__((ext_vector_type(8)));
#define LDS_WAIT() asm volatile("s_waitcnt lgkmcnt(0)" ::: "memory")
#define VM_WAIT() asm volatile("s_waitcnt vmcnt(0)" ::: "memory")
__device__ __forceinline__ unsigned f2bf(float f) { unsigned u = __builtin_bit_cast(unsigned, f); return (u + 0x7fffu + ((u >> 16) & 1u)) >> 16; }
__device__ __forceinline__ unsigned pk2(float lo, float hi) { return f2bf(lo) | (f2bf(hi) << 16); }
__device__ __forceinline__ float bflo(unsigned w) { return __builtin_bit_cast(float, w << 16); }
__device__ __forceinline__ float bfhi(unsigned w) { return __builtin_bit_cast(float, w & 0xffff0000u); }
__device__ __forceinline__ float bf1(bf16 b) { return __builtin_bit_cast(float, (unsigned)b << 16); }
__device__ __forceinline__ float sigm(float x) { return __builtin_amdgcn_rcpf(1.0f + __expf(-x)); }
__device__ __forceinline__ float fast_tanh(float x) { const float e = __expf(2.0f * x); return 1.0f - 2.0f * __builtin_amdgcn_rcpf(e + 1.0f); }
__device__ __forceinline__ float softplusf(float x) { return fmaxf(x, 0.f) + log1pf(__expf(-fabsf(x))); }
__device__ __forceinline__ float wave_sum(float v) {
#pragma unroll
    for (int o = 1; o < 64; o <<= 1) v += __shfl_xor(v, o);
    return v;
}
template <int CTRL> __device__ __forceinline__ float dppf(float x) { return __builtin_bit_cast(float, __builtin_amdgcn_mov_dpp(__builtin_bit_cast(int, x), CTRL, 0xf, 0xf, true)); }
__device__ __forceinline__ float row16_sum(float v) {
    v += dppf<0xB1>(v); v += dppf<0x4E>(v); v += dppf<0x141>(v); v += dppf<0x140>(v); return v;
}
#define XB_TMO      128
#define XB_XCNT(j)  (256  + 64 * (j))
#define XB_XSUB(j)  (1280 + 64 * (j))
#define XB_XGEN(j)  (2304 + 64 * (j))
#define XB_TOP      3328
#define XB_TOPGEN   3392
#define XCD_BAR_WORDS 3456
#define XB_SPIN_CAP (1u << 18)

__device__ __forceinline__ unsigned xb_ld(unsigned* p)              { return __hip_atomic_load(p, __ATOMIC_RELAXED, __HIP_MEMORY_SCOPE_AGENT); }
__device__ __forceinline__ unsigned xb_add(unsigned* p, unsigned v) { return __hip_atomic_fetch_add(p, v, __ATOMIC_RELAXED, __HIP_MEMORY_SCOPE_AGENT); }
__device__ __forceinline__ unsigned xb_xcc_id() { return (unsigned)__builtin_amdgcn_s_getreg((3 << 11) | 20) & 0xFu; }
#define XB_SPIN(cond, bar) do { unsigned _sp = 0; while (cond) { __builtin_amdgcn_s_sleep(1); \
    if ((++_sp & 255u) == 0u) { if (xb_ld(&(bar)[XB_TMO])) break; if (_sp > XB_SPIN_CAP) { atomicAdd(&(bar)[XB_TMO], 1u); break; } } } } while (0)

struct XcdBarrier {
    unsigned* bar; unsigned x;
    volatile LAS unsigned* st;
};

__device__ __forceinline__ XcdBarrier xcd_barrier_post(unsigned* bar, volatile LAS unsigned* st) {
    XcdBarrier b; b.bar = bar; b.x = xb_xcc_id(); b.st = st;
    if (threadIdx.x == 0) (void)xb_add(&bar[XB_XCNT(b.x)], 1u);
    return b;
}
__device__ __forceinline__ void xcd_barrier_complete(unsigned* bar, unsigned x, unsigned& nloc, unsigned& nx) {
    const unsigned G = gridDim.x * gridDim.y * gridDim.z;
    unsigned sum, cnt, mine, sp = 0u;
    for (;;) {
        sum = 0u; cnt = 0u; mine = 0u;
#pragma unroll
        for (unsigned j = 0; j < 16; ++j) { const unsigned c = xb_ld(&bar[XB_XCNT(j)]); sum += c; cnt += (c > 0u) ? 1u : 0u; mine = (j == x) ? c : mine; }
        if (sum == G) break;
        __builtin_amdgcn_s_sleep(1);
        if ((++sp & 255u) == 0u) { if (xb_ld(&bar[XB_TMO])) break; if (sp > XB_SPIN_CAP) { atomicAdd(&bar[XB_TMO], 1u); break; } }
    }
    nloc = mine > 0u ? mine : 1u; nx = cnt > 0u ? cnt : 1u;
}

__device__ __forceinline__ void xcd_barrier(const XcdBarrier& b) {
    asm volatile("s_waitcnt vmcnt(0)" ::: "memory");
    __syncthreads();
    if (threadIdx.x == 0) {
        unsigned* bar = b.bar;
        __builtin_amdgcn_s_waitcnt(0);
        unsigned nloc = b.st[0], nx = b.st[1];
        if (nloc == 0u) { xcd_barrier_complete(bar, b.x, nloc, nx); b.st[0] = nloc; b.st[1] = nx; }
        const unsigned old = xb_add(&bar[XB_XSUB(b.x)], 1u);
        const unsigned gen = old / nloc;
        if (old + 1u == (gen + 1u) * nloc) {
            __builtin_amdgcn_fence(__ATOMIC_RELEASE, "agent");
            asm volatile("s_waitcnt vmcnt(0)" ::: "memory");
            const unsigned og = xb_add(&bar[XB_TOP], 1u);
            const unsigned tg = og / nx;
            if (og + 1u == (tg + 1u) * nx) xb_add(&bar[XB_TOPGEN], 1u);
            else XB_SPIN(xb_ld(&bar[XB_TOPGEN]) == tg, bar);
            __builtin_amdgcn_fence(__ATOMIC_ACQUIRE, "agent");
            xb_add(&bar[XB_XGEN(b.x)], 1u);
            asm volatile("s_waitcnt vmcnt(0)" ::: "memory");
        } else {
            XB_SPIN(xb_ld(&bar[XB_XGEN(b.x)]) == gen, bar);
            __builtin_amdgcn_fence(__ATOMIC_ACQUIRE, "agent");
            asm volatile("s_waitcnt vmcnt(0)" ::: "memory");
        }
    }
    __syncthreads();
}

struct Frame {
    LAS unsigned char* lds;
    volatile LAS unsigned* MISC;
    int tid, lane, wave, vcu, G;
};
struct Args { const float* in[39]; float* out; unsigned char* ws; int ph_lo, ph_hi; };
enum { I_X = 0, I_MEM, I_GMIX, I_WIN, I_MU, I_W0, I_W2, I_A0, I_A2, I_G2, I_KK, I_KA, I_RK, I_LNW, I_LNB, I_WRO, I_CONVW, I_CONVB, I_LWR, I_LBR, I_LWI, I_LBI, I_LAM, I_WLO,
       I_GMEM, I_WMK, I_WMV, I_WXO, I_WOUT, I_GFFN, I_WROUTER, I_BROUTER, I_WGATE, I_BGATE, I_WUP, I_BUP, I_WDOWN, I_BDOWN, I_GFINAL };


__device__ __forceinline__ const float* inp(int k) {
    typedef const volatile unsigned long long __attribute__((address_space(4))) ka_t;
    ka_t* ka = (ka_t*)__builtin_amdgcn_kernarg_segment_ptr();
    return (const float*)ka[k];
}
template <int NB> __device__ __forceinline__ void transpose_item(const float* W, int N, int k0, int n0, bf16* WT, int Kd, int drow0, int lane, int kdo = 0) {
    constexpr int LPR = NB / 4, G = 64 / LPR, KR = 64 / G;
    const int g = lane / LPR, c = lane % LPR;
    const GAS float* src = (const GAS float*)W + (size_t)(k0 + KR * g) * N + n0 + 4 * c;
    f32x4 ld[KR];
#pragma unroll
    for (int i = 0; i < KR; ++i) ld[i] = *(const GAS f32x4*)(src + (size_t)i * N);
    GAS bf16* dst = (GAS bf16*)WT + (size_t)(drow0 + 4 * c) * Kd + kdo + k0 + KR * g;
#pragma unroll
    for (int j = 0; j < 4; ++j)
#pragma unroll
        for (int q = 0; q < KR / 8; ++q) { v4u o; o.x = pk2(ld[8 * q + 0][j], ld[8 * q + 1][j]); o.y = pk2(ld[8 * q + 2][j], ld[8 * q + 3][j]); o.z = pk2(ld[8 * q + 4][j], ld[8 * q + 5][j]); o.w = pk2(ld[8 * q + 6][j], ld[8 * q + 7][j]);
            *(GAS v4u*)(dst + (size_t)j * Kd + 8 * q) = o; }
}
__device__ __forceinline__ void rms_row_to_bf16(const float* xrow, const float* gain, bf16* orow, int lane) {
    const GAS f32x4* xr = (const GAS f32x4*)xrow + lane; const GAS f32x4* gr = (const GAS f32x4*)gain + lane;
    f32x4 v[8]; float s = 0.f;
#pragma unroll
    for (int j = 0; j < 8; ++j) { v[j] = xr[64 * j]; s += (v[j].x * v[j].x + v[j].y * v[j].y) + (v[j].z * v[j].z + v[j].w * v[j].w); }
    const float rstd = 1.0f / sqrtf(wave_sum(s) * (1.f / D) + EPS);
    GAS v2u* o8 = (GAS v2u*)orow + lane;
#pragma unroll
    for (int j = 0; j < 8; ++j) { const f32x4 g = gr[64 * j]; v2u w; w.x = pk2(v[j].x * rstd * g.x, v[j].y * rstd * g.y); w.y = pk2(v[j].z * rstd * g.z, v[j].w * rstd * g.w); o8[64 * j] = w; }
}

__device__ __forceinline__ void p0_prologue(const Frame& F, const Args& a) {
    unsigned char* ws = a.ws;
    const int gw = F.vcu * NWAVES + F.wave, NGW = F.G * NWAVES;
    constexpr int I_IN = 32 * (IN_COLS / 32), I_MK = 32 * 32, I_BR = 16 * 64, I_O = 32 * 64;
    constexpr int NITEMS = I_IN + 2 * I_MK + 3 * I_BR + I_O;
    for (int it = gw; it < NITEMS; it += NGW) {
        int r = it;
        if (r < I_IN) { const int nb = IN_COLS / 32, kb = r / nb, n0 = 32 * (r % nb); transpose_item<32>(inp(I_WIN), IN_COLS, 64 * kb, n0, (bf16*)(ws + WS_WIN), D, n0 + (n0 >= RWKV_COLS ? 224 : 0), F.lane); continue; } r -= I_IN;
        if (r < I_MK) { transpose_item<32>(inp(I_WMK), 1024, 64 * (r / 32), 32 * (r % 32), (bf16*)(ws + WS_WMKV), D, 32 * (r % 32), F.lane); continue; } r -= I_MK;
        if (r < I_MK) { transpose_item<32>(inp(I_WMV), 1024, 64 * (r / 32), 32 * (r % 32), (bf16*)(ws + WS_WMKV), D, 1024 + 32 * (r % 32), F.lane); continue; } r -= I_MK;
        if (r < I_BR) { transpose_item<32>(inp(I_WRO), 2048, 64 * (r / 64), 32 * (r % 64), (bf16*)(ws + WS_WBR), 3072, 32 * (r % 64), F.lane, 0); continue; } r -= I_BR;
        if (r < I_BR) { transpose_item<32>(inp(I_WLO), 2048, 64 * (r / 64), 32 * (r % 64), (bf16*)(ws + WS_WBR), 3072, 32 * (r % 64), F.lane, 1024); continue; } r -= I_BR;
        if (r < I_BR) { transpose_item<32>(inp(I_WXO), 2048, 64 * (r / 64), 32 * (r % 64), (bf16*)(ws + WS_WBR), 3072, 32 * (r % 64), F.lane, 2048); continue; } r -= I_BR;
        transpose_item<32>(inp(I_WOUT), 2048, 64 * (r / 64), 32 * (r % 64), (bf16*)(ws + WS_WO), D, 32 * (r % 64), F.lane);
    }
    for (int m = gw; m < T; m += NGW) rms_row_to_bf16(inp(I_X) + (size_t)m * D, inp(I_GMIX), (bf16*)(ws + WS_XN) + (size_t)m * D, F.lane);
    for (int m = gw; m < 512; m += NGW) rms_row_to_bf16(inp(I_MEM) + (size_t)m * D, inp(I_GMEM), (bf16*)(ws + WS_MN) + (size_t)m * D, F.lane);
    const int gt = F.vcu * (NWAVES * 64) + F.tid, NGT = F.G * NWAVES * 64;
    { bf16* wz = (bf16*)(ws + WS_WIN) + (size_t)RWKV_COLS * D; for (int i = gt; i < 224 * D / 2; i += NGT) ((GAS unsigned*)wz)[i] = 0u; }
    { bf16* wl = (bf16*)(ws + WS_WLORA);
      for (int i = gt; i < 3072 * LORA_K; i += NGT) { const int n = i / LORA_K, k = i % LORA_K; float v = 0.f;
          if (n < 1024) { if (k < 64) v = inp(I_W2)[k * 1024 + n]; }
          else if (n < 2048) { if (k >= 64 && k < 128) v = inp(I_A2)[(k - 64) * 1024 + (n - 1024)]; }
          else { if (k >= 128 && k < 288) v = inp(I_G2)[(k - 128) * 1024 + (n - 2048)]; }
          wl[i] = (bf16)f2bf(v); } }
    { const float* lam = inp(I_LAM); float* spl = (float*)(ws + WS_SPL); for (int i = gt; i < 1024; i += NGT) spl[i] = softplusf(-lam[i]); }
    { bf16* wr = (bf16*)(ws + WS_WR);
      for (int i = gt; i < 32 * D; i += NGT) { const int e = i / D, k = i % D; const float w = inp(I_WROUTER)[k * 32 + e]; const unsigned hi = f2bf(w); const float r = w - __builtin_bit_cast(float, hi << 16);
          wr[i] = (bf16)hi; wr[32 * D + i] = (bf16)f2bf(r); } }
    { const float* lwi_p = inp(I_LWI); const float* lwr_p = inp(I_LWR); bf16* lw = (bf16*)(ws + WS_LW);
      for (int i = gt; i < 2 * 16 * 4 * 2 * 64 * 8; i += NGT) { const int j = i & 7, ln = (i >> 3) & 63, ks = (i >> 9) & 1, vbo = (i >> 10) & 3, n = (i >> 12) & 15, mat = i >> 16;
          const int w = 32 * ks + 16 * (j >> 2) + 4 * (ln >> 4) + (j & 3), v = 16 * vbo + (ln & 15);
          lw[i] = (bf16)f2bf((mat ? lwi_p : lwr_p)[(n * 64 + w) * 64 + v]); } }
}

__device__ __forceinline__ void moe_weight_convert(const Frame& F, const Args& a, int w0) {
    unsigned char* ws = a.ws;
    const float* wg = inp(I_WGATE); const float* wu = inp(I_WUP); const float* wd = inp(I_WDOWN);
    const int nw = NWAVES - w0, gw = F.vcu * nw + (F.wave - w0), NGW = F.G * nw;
    constexpr int PER = 1024;
    for (int it = gw; it < NE * 3 * PER; it += NGW) {
        const int e = it / (3 * PER), r = it % (3 * PER), which = r / PER, q = r % PER, k0 = 64 * (q / 32), n0 = 64 * (q % 32);
        if (which == 0) transpose_item<64>(wg + (size_t)e * D * D, D, k0, n0, (bf16*)(ws + WS_WGU) + (size_t)e * 4096 * D, D, (n0 >> 7) * 256 + (n0 & 127), F.lane);
        else if (which == 1) transpose_item<64>(wu + (size_t)e * D * D, D, k0, n0, (bf16*)(ws + WS_WGU) + (size_t)e * 4096 * D, D, (n0 >> 7) * 256 + 128 + (n0 & 127), F.lane);
        else transpose_item<64>(wd + (size_t)e * D * D, D, k0, n0, (bf16*)(ws + WS_WD) + (size_t)e * 2048 * D, D, n0, F.lane);
    }
}

__device__ __forceinline__ void r1_lora_in(const Frame& F, const Args& a) {
    const bf16* P = (const bf16*)(a.ws + WS_P); bf16* L = (bf16*)(a.ws + WS_XN);
    const float* mu = inp(I_MU);
    const int gw = F.vcu * NWAVES + F.wave, NGW = F.G * NWAVES;
    for (int m = gw; m < T; m += NGW) {
        const bool first = (m % SEQ) == 0;
#pragma unroll
        for (int j = 0; j < 6; ++j) { const int k = F.lane + 64 * j; float o = 0.f;
            if (k < 288) { const int c = 3072 + k; const float cur = bf1(P[(size_t)m * NP + c]); const float prev = first ? 0.f : bf1(P[(size_t)(m - 1) * NP + c]);
                const float x = cur + (prev - cur) * mu[c]; o = k < 64 ? fast_tanh(x) : (k < 128 ? x : sigm(x)); }
            L[(size_t)m * LORA_K + k] = (bf16)f2bf(o); }
    }
}

__device__ __forceinline__ f32x4 bf4(v2u w) { return (f32x4){bflo(w.x), bfhi(w.x), bflo(w.y), bfhi(w.y)}; }
__device__ __forceinline__ void r3_scan_inputs(const Frame& F, const Args& a) {
    const GAS bf16* P = (const GAS bf16*)(a.ws + WS_P); const GAS float* LO = (const GAS float*)(a.ws + WS_LORAOUT);
    GAS float* SR = (GAS float*)(a.ws + WS_SCAN); constexpr size_t AS = (size_t)T * 1024;
    GAS float* BON = (GAS float*)(a.ws + WS_BONUS);
    const GAS float* mu = (const GAS float*)inp(I_MU); const GAS float* w0 = (const GAS float*)inp(I_W0); const GAS float* a0 = (const GAS float*)inp(I_A0);
    const GAS float* kkp = (const GAS float*)inp(I_KK); const GAS float* kap = (const GAS float*)inp(I_KA); const GAS float* rkp = (const GAS float*)inp(I_RK);
    const int gw = F.vcu * NWAVES + F.wave, NGW = F.G * NWAVES;
    for (int m = gw; m < T; m += NGW) {
        const bool first = (m % SEQ) == 0;
        const GAS bf16* pc = P + (size_t)m * NP; const GAS bf16* pp = P + (size_t)(m - (first ? 0 : 1)) * NP;
#pragma unroll 1
        for (int hp = 0; hp < 4; ++hp) { const int c = hp * 256 + F.lane * 4;
            const f32x4 cr = bf4(*(const GAS v2u*)(pc + c)), ck = bf4(*(const GAS v2u*)(pc + 1024 + c)), cv = bf4(*(const GAS v2u*)(pc + 2048 + c));
            f32x4 qr = bf4(*(const GAS v2u*)(pp + c)), qk = bf4(*(const GAS v2u*)(pp + 1024 + c)), qv = bf4(*(const GAS v2u*)(pp + 2048 + c));
            if (first) { qr = (f32x4){0.f, 0.f, 0.f, 0.f}; qk = qr; qv = qr; }
            const f32x4 r = cr + (qr - cr) * *(const GAS f32x4*)(mu + c), k = ck + (qk - ck) * *(const GAS f32x4*)(mu + 1024 + c), v = cv + (qv - cv) * *(const GAS f32x4*)(mu + 2048 + c);
            const f32x4 wpre = *(const GAS f32x4*)(w0 + c) + *(const GAS f32x4*)(LO + (size_t)m * 3072 + c), apre = *(const GAS f32x4*)(a0 + c) + *(const GAS f32x4*)(LO + (size_t)m * 3072 + 1024 + c);
            const f32x4 kkw = *(const GAS f32x4*)(kkp + c), kaw = *(const GAS f32x4*)(kap + c), rkw = *(const GAS f32x4*)(rkp + c);
            f32x4 dec, ag, kk, km; float ss = 0.f, bo = 0.f;
#pragma unroll
            for (int j = 0; j < 4; ++j) {
                dec[j] = __expf(-0.6065306597126334f * __builtin_amdgcn_rcpf(1.0f + __expf(-wpre[j])));
                ag[j] = __builtin_amdgcn_rcpf(1.0f + __expf(-apre[j]));
                kk[j] = k[j] * kkw[j]; ss += kk[j] * kk[j];
                km[j] = k[j] * (1.0f + (ag[j] - 1.0f) * kaw[j]); bo += r[j] * km[j] * rkw[j]; }
            ss = row16_sum(ss); bo = row16_sum(bo);
            const float inv = 1.0f / sqrtf(fmaxf(ss, 1e-24f));
            const f32x4 kkn = kk * inv;
            const size_t o = (size_t)m * 1024 + c;
            *(GAS f32x4*)(SR + o) = r; *(GAS f32x4*)(SR + AS + o) = dec; *(GAS f32x4*)(SR + 2 * AS + o) = km; *(GAS f32x4*)(SR + 3 * AS + o) = v; *(GAS f32x4*)(SR + 4 * AS + o) = -kkn; *(GAS f32x4*)(SR + 5 * AS + o) = kkn * ag;
            if ((F.lane & 15) == 0) BON[m * 16 + hp * 4 + (F.lane >> 4)] = bo; }
    }
}

template <int VAR> __device__ __forceinline__ void r4_scan(const Frame& F, const Args& a) {
    constexpr size_t ASZ = (size_t)T * 1024 * 4;
    float* YT = (float*)(a.ws + WS_XN);
    __builtin_amdgcn_s_setprio(3);
    for (int rb = F.vcu; rb < 256; rb += F.G) {
        const int row = rb * 8 + F.wave * 4 + (F.lane >> 4), ksub = F.lane & 15, bh = rb >> 3, vi = row & 63, b = bh >> 4, h = bh & 15;
        const GAS char* gsrc = (const GAS char*)(a.ws + WS_SCAN) + ((size_t)b * SEQ * 1024 + h * 64) * 4 + (size_t)(F.lane >> 4) * 4096 + (F.lane & 15) * 16;
        LAS unsigned char* ring = F.lds + F.wave * 49152;
        const LAS unsigned char* rd4 = ring + ksub * 16; const LAS unsigned char* rdv = ring + 3 * 8192 + vi * 4;
#define SC_DMA(tg) do { _Pragma("unroll") for (int ar_ = 0; ar_ < 6; ++ar_) \
            __builtin_amdgcn_global_load_lds((const GAS unsigned*)(gsrc + (size_t)ar_ * ASZ + (size_t)(tg) * 4096), (LAS unsigned*)(ring + ar_ * 8192 + ((tg) & 31) * 256), 16, 0, 0); } while (0)
#define SC_RD(s_, tq) do { const int so_ = ((tq) & 31) * 256; br[s_] = *(const LAS f32x4*)(rd4 + so_); bd[s_] = *(const LAS f32x4*)(rd4 + 8192 + so_); bk[s_] = *(const LAS f32x4*)(rd4 + 2 * 8192 + so_); \
            ba[s_] = *(const LAS f32x4*)(rd4 + 4 * 8192 + so_); bb[s_] = *(const LAS f32x4*)(rd4 + 5 * 8192 + so_); bv[s_] = *(const LAS float*)(rdv + so_); } while (0)
        f32x4 bd[2], bk[2], ba[2], bb[2], br[2]; float bv[2];
#pragma unroll
        for (int g = 0; g < 6; ++g) SC_DMA(4 * g);
        asm volatile("s_waitcnt vmcnt(0)" ::: "memory");
        SC_RD(0, 0); SC_RD(1, 1);
        f32x2 S01 = {0.f, 0.f}, S23 = {0.f, 0.f}; float ykeep = 0.f, yp = 0.f;
        GAS float* yrow = (GAS float*)YT + (size_t)row * SEQ;
#pragma unroll 1
        for (int t0 = 0; t0 < SEQ; t0 += 32) {
#pragma unroll
            for (int u = 0; u < 32; ++u) { const int s = u & 1;
                const f32x4 d4 = bd[s], k4 = bk[s], a4 = ba[s], b4 = bb[s], r4 = br[s]; const float vv = bv[s];
                if (VAR != 3 && (u & 3) == 0) SC_DMA(t0 + u + 24);
                if ((u & 3) == 2) asm volatile("s_waitcnt vmcnt(30)" ::: "memory");
                if (VAR != 2) SC_RD(s, t0 + u + 2);
                f32x2 p = S01 * (f32x2){a4[0], a4[1]}; p = S23 * (f32x2){a4[2], a4[3]} + p;
                float sa = p.x + p.y;
                if (VAR != 1) { sa += dppf<0xB1>(sa); yp += dppf<0xB1>(yp); sa += dppf<0x4E>(sa); yp += dppf<0x4E>(yp); sa += dppf<0x141>(sa); yp += dppf<0x141>(yp); sa += dppf<0x140>(sa); yp += dppf<0x140>(yp); }
                ykeep = (ksub == ((u + 15) & 15)) ? yp : ykeep;
                if ((u & 15) == 0) { if (t0 + u > 0) yrow[t0 + u - 16 + ksub] = ykeep; }
                f32x2 t01 = (f32x2){k4[0], k4[1]} * vv, t23 = (f32x2){k4[2], k4[3]} * vv;
                t01 = (f32x2){b4[0], b4[1]} * sa + t01; t23 = (f32x2){b4[2], b4[3]} * sa + t23;
                S01 = S01 * (f32x2){d4[0], d4[1]} + t01; S23 = S23 * (f32x2){d4[2], d4[3]} + t23;
                f32x2 q = S01 * (f32x2){r4[0], r4[1]}; q = S23 * (f32x2){r4[2], r4[3]} + q;
                yp = q.x + q.y;
                asm volatile("" : "+v"(S01), "+v"(S23), "+v"(ykeep), "+v"(yp) :: "memory"); }
        }
        yp = row16_sum(yp); ykeep = (ksub == 15) ? yp : ykeep; yrow[SEQ - 16 + ksub] = ykeep;
        asm volatile("s_waitcnt vmcnt(0)" ::: "memory");
#undef SC_DMA
#undef SC_RD
    }
    __builtin_amdgcn_s_setprio(0);
}

__device__ __forceinline__ void r5_finish(const Frame& F, const Args& a) {
    const float* YT = (const float*)(a.ws + WS_XN); const float* LO = (const float*)(a.ws + WS_LORAOUT); const float* SV = (const float*)(a.ws + WS_SCAN) + (size_t)3 * T * 1024; const float* BON = (const float*)(a.ws + WS_BONUS);
    bf16* YA = (bf16*)(a.ws + WS_YABC);
    LAS float* scr = (LAS float*)(F.lds + F.wave * 16640);
    const int gw = F.vcu * NWAVES + F.wave, NGW = F.G * NWAVES;
    for (int it = gw; it < 32 * 128; it += NGW) {
        const int bh = it >> 7, tt = it & 127, t0 = tt * 64, b = bh >> 4, h = bh & 15;
        float y[64]; float s = 0.f;
#pragma unroll
        for (int v = 0; v < 64; ++v) { y[v] = YT[(size_t)(bh * 64 + v) * SEQ + t0 + F.lane]; s += y[v]; }
        const float mean = s * (1.f / 64.f); float q = 0.f;
#pragma unroll
        for (int v = 0; v < 64; ++v) { const float d = y[v] - mean; q += d * d; }
        const float rstd = 1.0f / sqrtf(q * (1.f / 64.f) + GN_EPS);
#pragma unroll
        for (int v = 0; v < 64; ++v) scr[F.lane * 65 + v] = (y[v] - mean) * rstd;
        LDS_WAIT(); asm volatile("" ::: "memory");
        const int c = h * 64 + F.lane; const float lw = inp(I_LNW)[c], lb = inp(I_LNB)[c];
        for (int ti = 0; ti < 64; ++ti) { const int m = b * SEQ + t0 + ti;
            const float yn = scr[ti * 65 + F.lane];
            const float o = (yn * lw + lb + BON[m * 16 + h] * SV[(size_t)m * 1024 + c]) * LO[(size_t)m * 3072 + 2048 + c];
            YA[(size_t)m * 3072 + c] = (bf16)f2bf(o); }
        LDS_WAIT(); asm volatile("" ::: "memory");
    }
}

__device__ __forceinline__ float gelu_tanh(float x) { const float u = 0.7978845608028654f * (x + 0.044715f * x * x * x); return 0.5f * x * (1.0f + fast_tanh(u)); }
template <int CTRL> __device__ __forceinline__ float dpp_keep(float old, float x) { return __builtin_bit_cast(float, __builtin_amdgcn_update_dpp(__builtin_bit_cast(int, old), __builtin_bit_cast(int, x), CTRL, 0xf, 0xf, false)); }
template <bool FINAL> __device__ __forceinline__ void lru_pass(const Frame& F, const Args& a) {
    const bf16* P = (const bf16*)(a.ws + WS_P); const bf16* LW = (const bf16*)(a.ws + WS_LW);
    float* CA = (float*)(a.ws + WS_LRUC); float* CB = CA + 256 * 1024; const float* HIN = CB + 256 * 1024;
    bf16* YB = (bf16*)(a.ws + WS_YABC) + 1024;
    const GAS float* lbr_p = (const GAS float*)inp(I_LBR); const GAS float* lbi_p = (const GAS float*)inp(I_LBI); const GAS float* spl_p = (const GAS float*)(a.ws + WS_SPL);
    const GAS float* cvb_p = (const GAS float*)inp(I_CONVB); const GAS float* cvw_p = (const GAS float*)inp(I_CONVW);
    const int gw = F.vcu * NWAVES + F.wave, NGW = F.G * NWAVES, tq = F.lane & 15, kq = F.lane >> 4;
    for (int it = gw; it < 256 * 16; it += NGW) {
        const int tt = it >> 4, n = it & 15, m0 = tt * 64, cb = n * 64 + 4 * kq;
        const bool seq0 = (m0 % SEQ) == 0;
        float hcar[4][4];
        float aprod[4][4];
#pragma unroll
        for (int vb = 0; vb < 4; ++vb)
#pragma unroll
            for (int i = 0; i < 4; ++i) { hcar[vb][i] = FINAL ? HIN[tt * 1024 + cb + 16 * vb + i] : 0.f; aprod[vb][i] = 1.f; }
#pragma unroll 1
        for (int tb = 0; tb < 4; ++tb) {
            asm volatile("" ::: "memory");
            const int m = m0 + 16 * tb + tq, tseq = m % SEQ;
            f32x4 xc[4];
#pragma unroll
            for (int vb = 0; vb < 4; ++vb) { const int c = cb + 16 * vb; f32x4 acc = *(const GAS f32x4*)(cvb_p + c);
#pragma unroll
                for (int j = 0; j < 4; ++j) { if (tseq - j >= 0) { const v2u pw = *(const GAS v2u*)((const GAS bf16*)P + (size_t)(m - j) * NP + PC_LX + c); const f32x4 cw = *(const GAS f32x4*)(cvw_p + j * 1024 + c);
                        acc[0] += cw[0] * bflo(pw.x); acc[1] += cw[1] * bfhi(pw.x); acc[2] += cw[2] * bflo(pw.y); acc[3] += cw[3] * bfhi(pw.y); } }
                xc[vb] = acc; }
            bf16x8 bfrag[2];
#pragma unroll
            for (int ks = 0; ks < 2; ++ks) { v4u w; w.x = pk2(xc[2 * ks][0], xc[2 * ks][1]); w.y = pk2(xc[2 * ks][2], xc[2 * ks][3]); w.z = pk2(xc[2 * ks + 1][0], xc[2 * ks + 1][1]); w.w = pk2(xc[2 * ks + 1][2], xc[2 * ks + 1][3]); bfrag[ks] = __builtin_bit_cast(bf16x8, w); }
#pragma unroll
            for (int vb = 0; vb < 4; ++vb) {
                f32x4 gr = {0.f, 0.f, 0.f, 0.f}, gi = {0.f, 0.f, 0.f, 0.f};
#pragma unroll
                for (int ks = 0; ks < 2; ++ks) { const bf16x8 wr_ = *(const bf16x8*)(LW + ((((size_t)(0 * 16 + n) * 4 + vb) * 2 + ks) * 64 + F.lane) * 8); const bf16x8 wi_ = *(const bf16x8*)(LW + ((((size_t)(1 * 16 + n) * 4 + vb) * 2 + ks) * 64 + F.lane) * 8);
                    gr = __builtin_amdgcn_mfma_f32_16x16x32_bf16(wr_, bfrag[ks], gr, 0, 0, 0); gi = __builtin_amdgcn_mfma_f32_16x16x32_bf16(wi_, bfrag[ks], gi, 0, 0, 0); }
                const int c = cb + 16 * vb;
                const f32x4 brv = *(const GAS f32x4*)(lbr_p + c), biv = *(const GAS f32x4*)(lbi_p + c); const f32x4 spl = *(const GAS f32x4*)(spl_p + c);
                v2u pyw; if (FINAL) pyw = *(const v2u*)(P + (size_t)m * NP + PC_LY + c);
                float hout[4];
#pragma unroll
                for (int i = 0; i < 4; ++i) {
                    const float g_r = sigm(gr[i] + brv[i]), g_i = sigm(gi[i] + biv[i]);
                    const float log_a = -8.0f * g_r * spl[i];
                    float av = __expf(log_a); float mult = __builtin_amdgcn_sqrtf(fmaxf(1.0f - av * av, 0.f)); if (tseq == 0) mult = 1.0f;
                    float bv = mult * g_i * xc[vb][i];
                    { float pa = dpp_keep<0x111>(1.0f, av), pb = dpp_keep<0x111>(0.0f, bv); bv = av * pb + bv; av = av * pa; }
                    { float pa = dpp_keep<0x112>(1.0f, av), pb = dpp_keep<0x112>(0.0f, bv); bv = av * pb + bv; av = av * pa; }
                    { float pa = dpp_keep<0x114>(1.0f, av), pb = dpp_keep<0x114>(0.0f, bv); bv = av * pb + bv; av = av * pa; }
                    { float pa = dpp_keep<0x118>(1.0f, av), pb = dpp_keep<0x118>(0.0f, bv); bv = av * pb + bv; av = av * pa; }
                    const float hv = bv + av * hcar[vb][i];
                    const int l15 = (F.lane & 48) | 15;
                    const float hend = __shfl(hv, l15), aend = __shfl(av, l15);
                    hcar[vb][i] = hend; if (!FINAL) aprod[vb][i] *= aend; hout[i] = hv; }
                if (FINAL) { const float y0 = hout[0] * gelu_tanh(bflo(pyw.x)), y1 = hout[1] * gelu_tanh(bfhi(pyw.x)), y2 = hout[2] * gelu_tanh(bflo(pyw.y)), y3 = hout[3] * gelu_tanh(bfhi(pyw.y));
                    v2u w; w.x = pk2(y0, y1); w.y = pk2(y2, y3); *(v2u*)(YB + (size_t)m * 3072 + c) = w; }
            }
        }
        if (!FINAL && tq == 0) {
#pragma unroll
            for (int vb = 0; vb < 4; ++vb) { f32x4 pa, pb;
#pragma unroll
                for (int i = 0; i < 4; ++i) { pa[i] = aprod[vb][i]; pb[i] = hcar[vb][i]; }
                *(f32x4*)(CA + tt * 1024 + cb + 16 * vb) = pa; *(f32x4*)(CB + tt * 1024 + cb + 16 * vb) = pb; }
        }
        (void)seq0;
    }
}
__device__ __forceinline__ void lru_carry(const Frame& F, const Args& a) {
    const float* CA = (const float*)(a.ws + WS_LRUC); const float* CB = CA + 256 * 1024; float* HIN = (float*)CB + 256 * 1024;
    const int gt = F.vcu * (NWAVES * 64) + F.tid;
    if (gt < 2048) { const int b = gt >> 10, c = gt & 1023; float h = 0.f;
        for (int k = 0; k < 128; ++k) { const int tt = b * 128 + k; HIN[tt * 1024 + c] = h; h = CA[tt * 1024 + c] * h + CB[tt * 1024 + c]; } }
}

__device__ __forceinline__ void xattn_phase(const Frame& F, const Args& a) {
    const bf16* P = (const bf16*)(a.ws + WS_P); const bf16* KM = (const bf16*)(a.ws + WS_KMEM); const bf16* VT = (const bf16*)(a.ws + WS_VT);
    bf16* YC = (bf16*)(a.ws + WS_YABC) + 2048;
    const int gw = F.vcu * NWAVES + F.wave, NGW = F.G * NWAVES, tq = F.lane & 15, kq = F.lane >> 4;
    for (int it = gw; it < 4 * 1024; it += NGW) {
        const int h = it >> 10, tg = it & 1023, m0 = tg * 16, b = m0 / SEQ;
        bf16x8 qf[8];
#pragma unroll
        for (int ks = 0; ks < 8; ++ks) qf[ks] = *(const bf16x8*)(P + (size_t)(m0 + tq) * NP + PC_Q + h * 256 + 32 * ks + 8 * kq);
        f32x4 s[16];
#pragma unroll
        for (int mb = 0; mb < 16; ++mb) { f32x4 acc = {0.f, 0.f, 0.f, 0.f}; const bf16* kp = KM + (size_t)(b * 256 + 16 * mb + tq) * 1024 + h * 256 + 8 * kq;
#pragma unroll
            for (int ks = 0; ks < 8; ++ks) acc = __builtin_amdgcn_mfma_f32_16x16x32_bf16(*(const bf16x8*)(kp + 32 * ks), qf[ks], acc, 0, 0, 0);
            s[mb] = acc; asm volatile("" ::: "memory"); }
        float mx = -3.0e38f;
#pragma unroll
        for (int mb = 0; mb < 16; ++mb) { s[mb] = s[mb] * 0.0625f; mx = fmaxf(mx, fmaxf(fmaxf(s[mb][0], s[mb][1]), fmaxf(s[mb][2], s[mb][3]))); }
        mx = fmaxf(mx, __shfl_xor(mx, 16)); mx = fmaxf(mx, __shfl_xor(mx, 32));
        float sum = 0.f;
#pragma unroll
        for (int mb = 0; mb < 16; ++mb) {
#pragma unroll
            for (int i = 0; i < 4; ++i) { s[mb][i] = __expf(s[mb][i] - mx); sum += s[mb][i]; } }
        sum += __shfl_xor(sum, 16); sum += __shfl_xor(sum, 32);
        const float inv = 1.0f / sum;
        bf16x8 pf[8];
#pragma unroll
        for (int ks = 0; ks < 8; ++ks) { v4u w; w.x = pk2(s[2 * ks][0] * inv, s[2 * ks][1] * inv); w.y = pk2(s[2 * ks][2] * inv, s[2 * ks][3] * inv); w.z = pk2(s[2 * ks + 1][0] * inv, s[2 * ks + 1][1] * inv); w.w = pk2(s[2 * ks + 1][2] * inv, s[2 * ks + 1][3] * inv); pf[ks] = __builtin_bit_cast(bf16x8, w); }
#pragma unroll
        for (int db = 0; db < 16; ++db) { f32x4 acc = {0.f, 0.f, 0.f, 0.f}; const bf16* vp = VT + ((size_t)((b * 4 + h) * 256 + 16 * db + tq)) * 256 + 8 * kq;
#pragma unroll
            for (int ks = 0; ks < 8; ++ks) acc = __builtin_amdgcn_mfma_f32_16x16x32_bf16(*(const bf16x8*)(vp + 32 * ks), pf[ks], acc, 0, 0, 0);
            v2u w; w.x = pk2(acc[0], acc[1]); w.y = pk2(acc[2], acc[3]);
            *(v2u*)(YC + (size_t)(m0 + tq) * 3072 + h * 256 + 16 * db + 4 * kq) = w; asm volatile("" ::: "memory"); }
    }
}

__device__ __forceinline__ void router_phase(const Frame& F, const Args& a) {
    const float* H1 = (const float*)(a.ws + WS_H1); bf16* XN2 = (bf16*)(a.ws + WS_XN); const bf16* WR = (const bf16*)(a.ws + WS_WR);
    int* pick_e = (int*)(a.ws + WS_PICK); int* pick_rank = pick_e + 65536; float* pick_gate = (float*)(pick_rank + 65536);
    unsigned* gcnt = (unsigned*)(a.ws + WS_CTL) + CW_CNT;
    LAS float* lg = (LAS float*)(F.lds + F.wave * 4096);
    LAS unsigned* lcnt = (LAS unsigned*)(F.lds + 65536);
    const int tq = F.lane & 15, kq = F.lane >> 4;
    for (int g0 = F.vcu * 4; g0 < 1024; g0 += F.G * 4) {
        if (F.tid < 64) lcnt[F.tid] = 0u;
        __syncthreads();
        int me = 0, mrank = 0; float mgate = 0.f; int e4[4]; float g4[4]; int r4[4];
        const int m0 = (g0 + F.wave) * 16;
        if (F.wave < 4) {
            float myr = 0.f;
            for (int j = 0; j < 16; ++j) { const GAS f32x4* xr = (const GAS f32x4*)(H1 + (size_t)(m0 + j) * D) + F.lane; float s = 0.f;
#pragma unroll
                for (int q = 0; q < 8; ++q) { const f32x4 v = xr[64 * q]; s += (v.x * v.x + v.y * v.y) + (v.z * v.z + v.w * v.w); }
                const float rs = 1.0f / sqrtf(wave_sum(s) * (1.f / D) + EPS); if (tq == j) myr = rs; }
            f32x4 acc[2] = {{0.f, 0.f, 0.f, 0.f}, {0.f, 0.f, 0.f, 0.f}};
            const float* hrow = H1 + (size_t)(m0 + tq) * D + 8 * kq; const float* grow = inp(I_GFFN) + 8 * kq; bf16* xrow = XN2 + (size_t)(m0 + tq) * D + 8 * kq;
            for (int ks = 0; ks < 64; ++ks) {
                const f32x4 x0 = *(const f32x4*)(hrow + 32 * ks), x1 = *(const f32x4*)(hrow + 32 * ks + 4), g0v = *(const f32x4*)(grow + 32 * ks), g1v = *(const f32x4*)(grow + 32 * ks + 4);
                v4u w; w.x = pk2(x0[0] * myr * g0v[0], x0[1] * myr * g0v[1]); w.y = pk2(x0[2] * myr * g0v[2], x0[3] * myr * g0v[3]); w.z = pk2(x1[0] * myr * g1v[0], x1[1] * myr * g1v[1]); w.w = pk2(x1[2] * myr * g1v[2], x1[3] * myr * g1v[3]);
                *(v4u*)(xrow + 32 * ks) = w; const bf16x8 af = __builtin_bit_cast(bf16x8, w);
#pragma unroll
                for (int eh = 0; eh < 2; ++eh) { const bf16* wp = WR + (size_t)(16 * eh + tq) * D + 32 * ks + 8 * kq;
                    acc[eh] = __builtin_amdgcn_mfma_f32_16x16x32_bf16(af, *(const bf16x8*)wp, acc[eh], 0, 0, 0);
                    acc[eh] = __builtin_amdgcn_mfma_f32_16x16x32_bf16(af, *(const bf16x8*)(wp + 32 * D), acc[eh], 0, 0, 0); } }
#pragma unroll
            for (int eh = 0; eh < 2; ++eh)
#pragma unroll
                for (int i = 0; i < 4; ++i) lg[(4 * kq + i) * 33 + 16 * eh + tq] = acc[eh][i] + inp(I_BROUTER)[16 * eh + tq];
            LDS_WAIT(); asm volatile("" ::: "memory");
            if (F.lane < 16) { float v[32];
#pragma unroll
                for (int e = 0; e < 32; ++e) v[e] = lg[F.lane * 33 + e];
                float tv[4];
#pragma unroll
                for (int k = 0; k < 4; ++k) { float best = -3.0e38f; int bi = 0;
#pragma unroll
                    for (int e = 0; e < 32; ++e) { if (v[e] > best) { best = v[e]; bi = e; } }
                    tv[k] = best; e4[k] = bi;
#pragma unroll
                    for (int e = 0; e < 32; ++e) { if (e == bi) v[e] = -3.0e38f; } }
                float den = 0.f;
#pragma unroll
                for (int k = 0; k < 4; ++k) { g4[k] = __expf(tv[k] - tv[0]); den += g4[k]; }
#pragma unroll
                for (int k = 0; k < 4; ++k) { g4[k] = g4[k] / den; r4[k] = (int)atomicAdd((unsigned*)&lcnt[e4[k]], 1u); } }
        }
        __syncthreads();
        if (F.tid < 32) lcnt[32 + F.tid] = atomicAdd(&gcnt[F.tid], lcnt[F.tid]);
        __syncthreads();
        if (F.wave < 4 && F.lane < 16) {
#pragma unroll
            for (int k = 0; k < 4; ++k) { const int pi = (m0 + F.lane) * 4 + k; pick_e[pi] = e4[k]; pick_rank[pi] = (int)lcnt[32 + e4[k]] + r4[k]; pick_gate[pi] = g4[k]; } }
        __syncthreads();
        (void)me; (void)mrank; (void)mgate;
    }
}

__device__ __forceinline__ void scatter_phase(const Frame& F, const Args& a) {
    const int* pick_e = (const int*)(a.ws + WS_PICK); const int* pick_rank = pick_e + 65536; const float* pick_gate = (const float*)(pick_rank + 65536); int* pos = (int*)(pick_gate + 65536);
    float* gate_of_row = (float*)(a.ws + WS_ROWTAB); int* tok_of_row = (int*)(a.ws + WS_ROWTAB + 512 * 1024 + 8192);
    unsigned* ctl = (unsigned*)(a.ws + WS_CTL);
    LAS int* pst = (LAS int*)(F.lds);
    if (F.tid == 0) { int acc = 0; for (int e = 0; e < NE; ++e) { pst[e] = acc; const int c = (int)ctl[CW_CNT + e]; pst[32 + e] = c; const int nt = (c + 255) >> 8;
            if (blockIdx.x == 0) for (int k = 0; k < nt; ++k) ctl[CW_TILEE + (acc >> 8) + k] = (unsigned)e;
            acc += nt << 8; }
        if (blockIdx.x == 0) ctl[CW_NTILES] = (unsigned)(acc >> 8); }
    __syncthreads();
    const int gt = F.vcu * (NWAVES * 64) + F.tid, NGT = F.G * NWAVES * 64;
    for (int pi = gt; pi < 65536; pi += NGT) { const int e = pick_e[pi], row = pst[e] + pick_rank[pi]; pos[pi] = row; gate_of_row[row] = pick_gate[pi]; tok_of_row[row] = pi >> 2; }
    if (blockIdx.x == 0) for (int e = 0; e < NE; ++e) { const int r0 = pst[e] + pst[32 + e], r1 = pst[e] + (((pst[32 + e] + 255) >> 8) << 8);
        for (int r = r0 + F.tid; r < r1; r += NWAVES * 64) { tok_of_row[r] = 0; gate_of_row[r] = 0.f; } }
}

__device__ __forceinline__ void final_phase(const Frame& F, const Args& a) {
    const float* H1 = (const float*)(a.ws + WS_H1); const bf16* OR = (const bf16*)(a.ws + WS_OROW);
    const int* pos = (const int*)(a.ws + WS_PICK) + 3 * 65536;
    const int gw = F.vcu * NWAVES + F.wave, NGW = F.G * NWAVES;
    for (int m = gw; m < T; m += NGW) {
        const GAS f32x4* xr = (const GAS f32x4*)(H1 + (size_t)m * D) + F.lane; const GAS f32x4* gr = (const GAS f32x4*)inp(I_GFINAL) + F.lane;
        f32x4 v[8];
#pragma unroll
        for (int j = 0; j < 8; ++j) v[j] = xr[64 * j];
#pragma unroll
        for (int k = 0; k < 4; ++k) { const int row = pos[m * 4 + k]; const GAS v2u* orp = (const GAS v2u*)(OR + (size_t)row * D) + F.lane;
#pragma unroll
            for (int j = 0; j < 8; ++j) { const v2u w = orp[64 * j]; v[j].x += bflo(w.x); v[j].y += bfhi(w.x); v[j].z += bflo(w.y); v[j].w += bfhi(w.y); } }
        float s = 0.f;
#pragma unroll
        for (int j = 0; j < 8; ++j) s += (v[j].x * v[j].x + v[j].y * v[j].y) + (v[j].z * v[j].z + v[j].w * v[j].w);
        const float rstd = 1.0f / sqrtf(wave_sum(s) * (1.f / D) + EPS);
        GAS f32x4* o = (GAS f32x4*)(a.out + (size_t)m * D) + F.lane;
#pragma unroll
        for (int j = 0; j < 8; ++j) { const f32x4 g = gr[64 * j]; o[64 * j] = (f32x4){v[j].x * rstd * g.x, v[j].y * rstd * g.y, v[j].z * rstd * g.z, v[j].w * rstd * g.w}; }
    }
}

#ifndef MK_N_LAUNCHES
#define MK_N_LAUNCHES 1
#endif
constexpr int NPH = 14;
__global__ void __launch_bounds__(NWAVES * 64, 2) fwd(Args args) {
    extern __shared__ __attribute__((aligned(16))) unsigned char lds[];
#define NEWFRAME() Frame F; { int tz = threadIdx.x; asm volatile("" : "+v"(tz)); F.lds = (LAS unsigned char*)lds; F.MISC = (volatile LAS unsigned*)(F.lds + MISC_OFF); F.tid = tz; F.lane = tz & 63; F.wave = __builtin_amdgcn_readfirstlane(tz >> 6); \
        F.G = gridDim.x; const int bx = blockIdx.x; F.vcu = (F.G % 8 == 0) ? (bx % 8) * (F.G / 8) + bx / 8 : bx; }
    unsigned char* ws = args.ws;
    unsigned* ctl = (unsigned*)(ws + WS_CTL);
    for (int u = threadIdx.x; u < (LDS_BYTES - MISC_OFF) / 4; u += NWAVES * 64) ((LAS unsigned*)((LAS unsigned char*)lds + MISC_OFF))[u] = 0u;
    __syncthreads();
    const int lo = args.ph_lo, hi = args.ph_hi;
    XcdBarrier bar; bar.bar = ctl + CW_BAR; bar.x = 0; bar.st = nullptr;
    if (hi - lo > 1) bar = xcd_barrier_post(ctl + CW_BAR, (volatile LAS unsigned*)((LAS unsigned char*)lds + MISC_OFF) + 8);
#ifndef PHMASK
#define PHMASK 0xFFFF
#endif
#define IN(k) (((PHMASK >> (k)) & 1) && lo <= (k) && (k) < hi)
#define SEAM(k) do { if (IN(k) && IN((k) + 1)) xcd_barrier(bar); } while (0)

    if (IN(0)) { NEWFRAME(); p0_prologue(F, args); } SEAM(0);
    if (IN(1)) { NEWFRAME();
        { pg8::Gemm g{(const bf16*)(ws + WS_XN), (const bf16*)(ws + WS_WIN), T, NP, D}; pg8::StaticOrder S; S.init(T, NP, F.G, (int)blockIdx.x);
          pg8::EpiBf16<0> E{(bf16*)(ws + WS_P), NP, nullptr, 0, 0, 1.f};
          pg8::gemm_phase<pg8::EpiBf16<0>, pg8::StaticOrder, true, true>(F.lds, g, S, E); }
        __syncthreads();
        { pg8::Gemm g{(const bf16*)(ws + WS_MN), (const bf16*)(ws + WS_WMKV), 512, 2048, D}; pg8::StaticOrder S; S.init(512, 2048, F.G, (int)((blockIdx.x + F.G / 2) % F.G));
          pg8::EpiKV E{(bf16*)(ws + WS_KMEM), (bf16*)(ws + WS_VT)};
          pg8::gemm_phase<pg8::EpiKV, pg8::StaticOrder, true, true>(F.lds, g, S, E); }
    } SEAM(1);
    if (IN(2)) { NEWFRAME();
#ifndef NO_R1
 r1_lora_in(F, args);
#endif
#ifndef NO_LRU
 lru_pass<false>(F, args);
#endif
#ifndef NO_XA
 xattn_phase(F, args);
#endif
 } SEAM(2);
    if (IN(3)) { NEWFRAME();
        lru_carry(F, args);
        { pg8::Gemm g{(const bf16*)(ws + WS_XN), (const bf16*)(ws + WS_WLORA), T, 3072, LORA_K}; pg8::StaticOrder S; S.init(T, 3072, F.G, (int)blockIdx.x);
          pg8::EpiF32 E{(float*)(ws + WS_LORAOUT), 3072};
          pg8::gemm_phase<pg8::EpiF32, pg8::StaticOrder, true, true>(F.lds, g, S, E); }
    } SEAM(3);
    if (IN(4)) { NEWFRAME(); r3_scan_inputs(F, args); lru_pass<true>(F, args); } SEAM(4);
    if (IN(5)) { NEWFRAME();
#ifndef NO_SCAN
 if (F.wave < 2) r4_scan<0>(F, args);
#endif
#ifndef NO_CONV
 if (F.wave >= 2) moe_weight_convert(F, args, 2);
#endif
 } SEAM(5);
    if (IN(6)) { NEWFRAME(); r5_finish(F, args); } SEAM(6);
    if (IN(7)) { NEWFRAME();
        pg8::Gemm g{(const bf16*)(ws + WS_YABC), (const bf16*)(ws + WS_WBR), T, 2048, 3072}; pg8::StaticOrder S; S.init(T, 2048, F.G, (int)blockIdx.x);
        pg8::EpiBranch2 E{(const bf16*)(ws + WS_P), NP, PC_G, (bf16*)(ws + WS_MERGED)};
        pg8::gemm_phase<pg8::EpiBranch2, pg8::StaticOrder, true, true>(F.lds, g, S, E);
    } SEAM(7);
    if (IN(8)) { NEWFRAME();
        pg8::Gemm g{(const bf16*)(ws + WS_MERGED), (const bf16*)(ws + WS_WO), T, D, D}; pg8::StaticOrder S; S.init(T, D, F.G, (int)blockIdx.x);
        pg8::EpiRes E{inp(I_X), (float*)(ws + WS_H1), D};
        pg8::gemm_phase<pg8::EpiRes, pg8::StaticOrder, true, true>(F.lds, g, S, E);
    } SEAM(8);
    if (IN(9)) { NEWFRAME(); router_phase(F, args); } SEAM(9);
    if (IN(10)) { NEWFRAME(); scatter_phase(F, args); } SEAM(10);
    if (IN(11)) { NEWFRAME();
        const int ntiles = (int)__hip_atomic_load(ctl + CW_NTILES, __ATOMIC_RELAXED, __HIP_MEMORY_SCOPE_AGENT);
        pg8::Gemm g{(const bf16*)(ws + WS_XN), (const bf16*)(ws + WS_WGU), ntiles * 256, NE * 4096, D}; pg8::MoeOrder<true> S; S.init(ntiles, 16, F.G, (int)blockIdx.x, (const int*)(ctl + CW_TILEE), (const int*)(ws + WS_ROWTAB + 512 * 1024 + 8192));
        pg8::EpiSwiglu E{(bf16*)(ws + WS_HH), inp(I_BGATE), inp(I_BUP)};
        pg8::gemm_phase<pg8::EpiSwiglu, pg8::MoeOrder<true>, true, true>(F.lds, g, S, E);
    } SEAM(11);
    if (IN(12)) { NEWFRAME();
        const int ntiles = (int)__hip_atomic_load(ctl + CW_NTILES, __ATOMIC_RELAXED, __HIP_MEMORY_SCOPE_AGENT);
        pg8::Gemm g{(const bf16*)(ws + WS_HH), (const bf16*)(ws + WS_WD), ntiles * 256, NE * 2048, D}; pg8::MoeOrder<false> S; S.init(ntiles, 8, F.G, (int)blockIdx.x, (const int*)(ctl + CW_TILEE), nullptr);
        pg8::EpiDown E{(bf16*)(ws + WS_OROW), inp(I_BDOWN), (const float*)(ws + WS_ROWTAB)};
        pg8::gemm_phase<pg8::EpiDown, pg8::MoeOrder<false>, true, true>(F.lds, g, S, E);
    } SEAM(12);
    if (IN(13)) { NEWFRAME(); final_phase(F, args); }
#ifdef PROBE_EXTRA_PHASE
    if (lo == 14) { NEWFRAME(); if (F.wave < 2) r4_scan<0>(F, args); }
    if (lo == 15) { NEWFRAME(); if (F.wave >= 2) moe_weight_convert(F, args, 2); }
    if (lo == 16) { NEWFRAME(); moe_weight_convert(F, args, 0); }
    if (lo == 17) { NEWFRAME(); if (F.wave < 2) r4_scan<1>(F, args); }
    if (lo == 18) { NEWFRAME(); if (F.wave < 2) r4_scan<2>(F, args); }
    if (lo == 19) { NEWFRAME(); if (F.wave < 2) r4_scan<3>(F, args); }
#endif
#undef IN
#undef SEAM
}

extern "C" void kernel_launch(void* const* d_in, const int* in_sizes, int n_in, void* d_out, int out_size, void* d_ws, size_t ws_size, hipStream_t stream) {
    static int grid = 0;
    if (grid == 0) {
        if (n_in != 39 || out_size != T * D || ws_size < WS_END) { fprintf(stderr, "kernel_launch: built for 39 inputs, out of %d floats, >= %zu bytes of workspace; got n_in %d, out %d, ws %zu; nothing launched\n", T * D, (size_t)WS_END, n_in, out_size, ws_size); grid = -1; return; }
        int dev = 0, cus = 0, per_cu = 0;
        if (hipGetDevice(&dev) != hipSuccess || hipDeviceGetAttribute(&cus, hipDeviceAttributeMultiprocessorCount, dev) != hipSuccess) { fprintf(stderr, "kernel_launch: device query failed\n"); grid = -1; return; }
        if (hipFuncSetAttribute((const void*)fwd, hipFuncAttributeMaxDynamicSharedMemorySize, LDS_BYTES) != hipSuccess) { fprintf(stderr, "kernel_launch: hipFuncSetAttribute failed\n"); grid = -1; return; }
        if (hipOccupancyMaxActiveBlocksPerMultiprocessor(&per_cu, (const void*)fwd, NWAVES * 64, LDS_BYTES) != hipSuccess || per_cu < 1)
            fprintf(stderr, "kernel_launch: note: occupancy query reports %d workgroups per CU\n", per_cu);
        (void)hipGetLastError();
        grid = cus;
    }
    if (grid < 0) return;
    (void)in_sizes;
    if (hipMemsetAsync((char*)d_ws + WS_CTL, 0, CTL_ZERO_BYTES, stream) != hipSuccess) { fprintf(stderr, "kernel_launch: hipMemsetAsync failed\n"); return; }
    Args a{};
    for (int i = 0; i < 39; ++i) a.in[i] = (const float*)d_in[i];
    a.out = (float*)d_out; a.ws = (unsigned char*)d_ws;
#if MK_N_LAUNCHES == 1
    a.ph_lo = 0; a.ph_hi = NPH;
    hipLaunchKernelGGL(fwd, dim3(grid), dim3(NWAVES * 64), LDS_BYTES, stream, a);
#else
    for (int k = 0; k < NPH; ++k) { a.ph_lo = k; a.ph_hi = k + 1; int reps = 1;
#ifdef PROBE_REP_PHASE
        if (k == PROBE_REP_PHASE) reps = 1 + PROBE_REP_N;
#endif
        for (int r = 0; r < reps; ++r) hipLaunchKernelGGL(fwd, dim3(grid), dim3(NWAVES * 64), LDS_BYTES, stream, a); }
#ifdef PROBE_EXTRA_PHASE
    for (int r = 0; r < PROBE_REP_N; ++r) { a.ph_lo = PROBE_EXTRA_PHASE; a.ph_hi = PROBE_EXTRA_PHASE + 1; hipLaunchKernelGGL(fwd, dim3(grid), dim3(NWAVES * 64), LDS_BYTES, stream, a); }
#endif
#endif
    const hipError_t le = hipPeekAtLastError();
    if (le != hipSuccess) fprintf(stderr, "kernel_launch: launch failed: %s\n", hipGetErrorName(le));
}
```

```cpp
#include <hip/hip_runtime.h>
#include <cstdio>
#include <cstdint>
namespace pg8 {
#define PG8_LAS __attribute__((address_space(3)))
typedef unsigned short bf16_t;
typedef short bf16x8 __attribute__((ext_vector_type(8)));
typedef float f32x4 __attribute__((ext_vector_type(4)));
typedef unsigned u32x4 __attribute__((ext_vector_type(4)));
constexpr int BM = 256, BK = 64, HALF = 128, HTB = HALF * BK * 2  , STAGE_BYTES = 8 * HTB, NXCD = 8, WGM = 8;

__host__ __device__ __forceinline__ int lds_byte(int r, int c) { const int st = (r >> 4) * 2 + (c >> 5), rr = r & 15, cc = c & 31, ob = rr * 64 + cc * 2; return st * 1024 + (ob ^ (((ob >> 9) & 1) << 5)); }
__host__ __device__ __forceinline__ void stage_rc(int b, int& R, int& C) { const int st = b / 1024, sb = b % 1024, swz = sb ^ (((sb >> 9) & 1) << 5); R = (st >> 1) * 16 + swz / 64; C = (st & 1) * 32 + (swz % 64) / 2; }
__host__ __device__ __forceinline__ int perm32(int rho) { const int n = rho >> 4, i = rho & 15; return 8 * (i >> 2) + 4 * n + (i & 3); }

struct Unit { int pm, pn; };
struct Gemm { const bf16_t* A; const bf16_t* Bt; int M, N, K; };

struct StaticOrder {
    static constexpr bool GATHER = false; __device__ __forceinline__ int arow(const Unit&, int) const { return 0; }
    int nM, nN, nwg, G, c;
    __host__ __device__ void init(int M, int N, int G_, int c_) { nM = M / BM; nN = N / BM; nwg = nM * nN; G = G_; c = c_; }
    __host__ __device__ bool next(int i, Unit& u) const {
        const long L = (long)i * G + c; if (L >= nwg) return false;
        int wgid = (int)L; { const int q = nwg / NXCD, r = nwg % NXCD, xcd = wgid % NXCD, off = wgid / NXCD; wgid = (xcd < r ? xcd * (q + 1) : r * (q + 1) + (xcd - r) * q) + off; }
        const int nig = WGM * nN, gid = wgid / nig, fm = gid * WGM, gsz = (nM - fm) < WGM ? (nM - fm) : WGM;
        u.pm = fm + ((wgid % nig) % gsz); u.pn = (wgid % nig) / gsz; return true;
    }
    __device__ __forceinline__ void a_ready(const Unit&) const {}
    __device__ __forceinline__ void done(const Unit&) const {}
};
__device__ __forceinline__ unsigned cvt_pk_bf16(float lo, float hi) { unsigned r; asm volatile("v_cvt_pk_bf16_f32 %0, %1, %2" : "=v"(r) : "v"(lo), "v"(hi)); return r; }
typedef float f32x2 __attribute__((ext_vector_type(2)));
__device__ __forceinline__ f32x2 gelu_pk(f32x2 v) {
    const f32x2 av = __builtin_elementwise_abs(v), d = av * 0.2316418882f + 1.0f;
    f32x2 t; t.x = __builtin_amdgcn_rcpf(d.x); t.y = __builtin_amdgcn_rcpf(d.y);
    f32x2 q = t * 0.5307027145f + (-0.7265760135f); q = q * t + 0.7107068705f; q = q * t + (-0.142248368f); q = q * t + 0.127414796f; q = q * t;
    const f32x2 s = (v * v) * (-0.72134752044f);
    f32x2 e; e.x = __builtin_amdgcn_exp2f(s.x); e.y = __builtin_amdgcn_exp2f(s.y);
    const f32x2 m = v * (q * e), r = v - m;
    f32x2 o; o.x = v.x < 0.f ? m.x : r.x; o.y = v.y < 0.f ? m.y : r.y; return o;
}

template <int ACT  > struct EpiBf16 {
    static constexpr bool PERM = true, AFTER_DRAIN = false; static constexpr int MIDK = 0; static_assert(ACT == 0 || ACT == 1, "EpiBf16: ACT is 0 (none) or 1 (gelu_pk)");
    bf16_t* O; int ldc; const float* bias; int split_cols; size_t split_stride; float scale0;
    __device__ __forceinline__ void operator()(const f32x4 (&acc)[2][2][4][2], const Unit& u, int wr, int wc, int fr, int fq) const {
        const int row0 = u.pm * BM + wr * 64 + fr; int colt = u.pn * BM; bf16_t* base = O;
        float sc = 1.f; if (split_cols) { const int t = colt / split_cols; base += (size_t)t * split_stride; colt -= t * split_cols; if (t == 0) sc = scale0; }
        const int col0 = colt + wc * 32 + 8 * fq, bcol0 = u.pn * BM + wc * 32 + 8 * fq;
        f32x4 bv[2][2];
#pragma unroll
        for (int bj = 0; bj < 2; ++bj)
#pragma unroll
            for (int n = 0; n < 2; ++n) bv[bj][n] = bias ? *(const f32x4*)(bias + bcol0 + bj * HALF + 4 * n) : (f32x4){0.f, 0.f, 0.f, 0.f};
#pragma unroll
        for (int ai = 0; ai < 2; ++ai)
#pragma unroll
            for (int m = 0; m < 4; ++m) { bf16_t* rowp = base + (size_t)(row0 + ai * HALF + m * 16) * ldc + col0;
#pragma unroll
                for (int bj = 0; bj < 2; ++bj) { f32x4 v0 = acc[ai][bj][m][0] + bv[bj][0], v1 = acc[ai][bj][m][1] + bv[bj][1];
                    if (ACT == 1) { f32x2 a = gelu_pk((f32x2){v0[0], v0[1]}), b = gelu_pk((f32x2){v0[2], v0[3]}), c = gelu_pk((f32x2){v1[0], v1[1]}), d = gelu_pk((f32x2){v1[2], v1[3]});
                        v0 = (f32x4){a.x, a.y, b.x, b.y}; v1 = (f32x4){c.x, c.y, d.x, d.y}; }
                    v0 = v0 * sc; v1 = v1 * sc; u32x4 w; w.x = cvt_pk_bf16(v0[0], v0[1]); w.y = cvt_pk_bf16(v0[2], v0[3]); w.z = cvt_pk_bf16(v1[0], v1[1]); w.w = cvt_pk_bf16(v1[2], v1[3]);
                    *(u32x4*)(rowp + bj * HALF) = w; } }
    }
};

__device__ __forceinline__ float bf_lo(unsigned w) { return __builtin_bit_cast(float, w << 16); }
__device__ __forceinline__ float bf_hi(unsigned w) { return __builtin_bit_cast(float, w & 0xffff0000u); }
__device__ __forceinline__ float fsigmoid(float x) { return __builtin_amdgcn_rcpf(1.0f + __expf(-x)); }
typedef unsigned u32x2 __attribute__((ext_vector_type(2)));

struct EpiF32 {
    static constexpr bool PERM = false, AFTER_DRAIN = false; static constexpr int MIDK = 0;
    float* C; int ldc;
    __device__ __forceinline__ void operator()(const f32x4 (&acc)[2][2][4][2], const Unit& u, int wr, int wc, int fr, int fq) const {
        const int row0 = u.pm * BM + wr * 64 + fr, col0 = u.pn * BM + wc * 32 + 4 * fq;
#pragma unroll
        for (int ai = 0; ai < 2; ++ai)
#pragma unroll
            for (int m = 0; m < 4; ++m) { float* rowp = C + (size_t)(row0 + ai * HALF + m * 16) * ldc + col0;
#pragma unroll
                for (int bj = 0; bj < 2; ++bj)
#pragma unroll
                    for (int n = 0; n < 2; ++n) *(f32x4*)(rowp + bj * HALF + n * 16) = acc[ai][bj][m][n]; }
    }
};
struct EpiRes {
    static constexpr bool PERM = false, AFTER_DRAIN = false; static constexpr int MIDK = 0;
    const float* X; float* C; int ldc;
    __device__ __forceinline__ void operator()(const f32x4 (&acc)[2][2][4][2], const Unit& u, int wr, int wc, int fr, int fq) const {
        const int row0 = u.pm * BM + wr * 64 + fr, col0 = u.pn * BM + wc * 32 + 4 * fq;
#pragma unroll
        for (int ai = 0; ai < 2; ++ai)
#pragma unroll
            for (int m = 0; m < 4; ++m) { const size_t off = (size_t)(row0 + ai * HALF + m * 16) * ldc + col0;
#pragma unroll
                for (int bj = 0; bj < 2; ++bj)
#pragma unroll
                    for (int n = 0; n < 2; ++n) { const f32x4 xv = *(const f32x4*)(X + off + bj * HALF + n * 16); *(f32x4*)(C + off + bj * HALF + n * 16) = acc[ai][bj][m][n] + xv; }
                asm volatile("" ::: "memory"); }
    }
};
struct EpiKV {
    static constexpr bool PERM = false, AFTER_DRAIN = false; static constexpr int MIDK = 0;
    bf16_t* Kb; bf16_t* VT;
    __device__ __forceinline__ void operator()(const f32x4 (&acc)[2][2][4][2], const Unit& u, int wr, int wc, int fr, int fq) const {
        const int row0 = u.pm * BM + wr * 64 + fr, col0 = u.pn * BM + wc * 32 + 4 * fq;
#pragma unroll
        for (int ai = 0; ai < 2; ++ai)
#pragma unroll
            for (int m = 0; m < 4; ++m) { const int r = row0 + ai * HALF + m * 16;
#pragma unroll
                for (int bj = 0; bj < 2; ++bj)
#pragma unroll
                    for (int n = 0; n < 2; ++n) { const f32x4 v = acc[ai][bj][m][n]; const int c = col0 + bj * HALF + n * 16;
                        if (u.pn < 4) { u32x2 w; w.x = cvt_pk_bf16(v[0], v[1]); w.y = cvt_pk_bf16(v[2], v[3]); *(u32x2*)(Kb + (size_t)r * 1024 + c) = w; }
                        else { const int cc = c - 1024, h = cc >> 8, d = cc & 255, b = r >> 8, mm = r & 255;
                            const int idx = (mm >> 5) * 32 + ((mm >> 2) & 3) * 8 + ((mm >> 4) & 1) * 4 + (mm & 3);
                            bf16_t* o = VT + ((size_t)((b * 4 + h) * 256 + d)) * 256 + idx;
                            const unsigned w0 = cvt_pk_bf16(v[0], v[1]), w1 = cvt_pk_bf16(v[2], v[3]);
                            o[0] = (bf16_t)(w0 & 0xffffu); o[256] = (bf16_t)(w0 >> 16); o[512] = (bf16_t)(w1 & 0xffffu); o[768] = (bf16_t)(w1 >> 16); } } }
    }
};
struct EpiBranch {
    static constexpr bool PERM = false, AFTER_DRAIN = false; static constexpr int MIDK = 0;
    const bf16_t* P; int ldp; int gcol0; float* macc; bf16_t* merged;
    __device__ __forceinline__ void operator()(const f32x4 (&acc)[2][2][4][2], const Unit& u, int wr, int wc, int fr, int fq) const {
        const int br = u.pm >> 6, pm = u.pm & 63, pn = u.pn & 7;
        const int row0 = pm * BM + wr * 64 + fr, col0 = pn * BM + wc * 32 + 4 * fq;
#pragma unroll
        for (int ai = 0; ai < 2; ++ai)
#pragma unroll
            for (int m = 0; m < 4; ++m) { const int r = row0 + ai * HALF + m * 16; const bf16_t* prow = P + (size_t)r * ldp + gcol0 + br * 2048;
#pragma unroll
                for (int bj = 0; bj < 2; ++bj)
#pragma unroll
                    for (int n = 0; n < 2; ++n) { const int c = col0 + bj * HALF + n * 16; const u32x2 gw = *(const u32x2*)(prow + c);
                        f32x4 g; g[0] = fsigmoid(bf_lo(gw.x)); g[1] = fsigmoid(bf_hi(gw.x)); g[2] = fsigmoid(bf_lo(gw.y)); g[3] = fsigmoid(bf_hi(gw.y));
                        f32x4 v = acc[ai][bj][m][n] * g; float* mp = macc + (size_t)r * 2048 + c;
                        if (br > 0) v = v + *(const f32x4*)mp;
                        if (br < 2) *(f32x4*)mp = v;
                        else { u32x2 w; w.x = cvt_pk_bf16(v[0], v[1]); w.y = cvt_pk_bf16(v[2], v[3]); *(u32x2*)(merged + (size_t)r * 2048 + c) = w; } }
                asm volatile("" ::: "memory"); }
    }
};
struct EpiSwiglu {
    static constexpr bool PERM = true, AFTER_DRAIN = false; static constexpr int MIDK = 0;
    bf16_t* H; const float* bg; const float* bu;
    __device__ __forceinline__ void operator()(const f32x4 (&acc)[2][2][4][2], const Unit& u, int wr, int wc, int fr, int fq) const {
        const int e = u.pn >> 4, ct = u.pn & 15;
        const int row0 = u.pm * BM + wr * 64 + fr, col0 = ct * 128 + wc * 32 + 8 * fq;
        f32x4 bgv[2], buv[2];
#pragma unroll
        for (int n = 0; n < 2; ++n) { bgv[n] = *(const f32x4*)(bg + (size_t)e * 2048 + col0 + 4 * n); buv[n] = *(const f32x4*)(bu + (size_t)e * 2048 + col0 + 4 * n); }
#pragma unroll
        for (int ai = 0; ai < 2; ++ai)
#pragma unroll
            for (int m = 0; m < 4; ++m) { bf16_t* rowp = H + (size_t)(row0 + ai * HALF + m * 16) * 2048 + col0;
                f32x4 o[2];
#pragma unroll
                for (int n = 0; n < 2; ++n) { const f32x4 g = acc[ai][0][m][n] + bgv[n], up = acc[ai][1][m][n] + buv[n];
#pragma unroll
                    for (int j = 0; j < 4; ++j) { const float hg = fminf(g[j], 7.0f), hu = fminf(fmaxf(up[j], -7.0f), 7.0f); o[n][j] = (hu + 1.0f) * hg * fsigmoid(1.702f * hg); } }
                u32x4 w; w.x = cvt_pk_bf16(o[0][0], o[0][1]); w.y = cvt_pk_bf16(o[0][2], o[0][3]); w.z = cvt_pk_bf16(o[1][0], o[1][1]); w.w = cvt_pk_bf16(o[1][2], o[1][3]);
                *(u32x4*)rowp = w; }
    }
};
struct EpiDown {
    static constexpr bool PERM = true, AFTER_DRAIN = false; static constexpr int MIDK = 0;
    bf16_t* O; const float* bd; const float* rowgate;
    __device__ __forceinline__ void operator()(const f32x4 (&acc)[2][2][4][2], const Unit& u, int wr, int wc, int fr, int fq) const {
        const int e = u.pn >> 3, ct = u.pn & 7;
        const int row0 = u.pm * BM + wr * 64 + fr, col0 = ct * BM + wc * 32 + 8 * fq;
        f32x4 bv[2][2];
#pragma unroll
        for (int bj = 0; bj < 2; ++bj)
#pragma unroll
            for (int n = 0; n < 2; ++n) bv[bj][n] = *(const f32x4*)(bd + (size_t)e * 2048 + col0 + bj * HALF + 4 * n);
#pragma unroll
        for (int ai = 0; ai < 2; ++ai)
#pragma unroll
            for (int m = 0; m < 4; ++m) { const int r = row0 + ai * HALF + m * 16; const float gs = rowgate[r]; bf16_t* rowp = O + (size_t)r * 2048 + col0;
#pragma unroll
                for (int bj = 0; bj < 2; ++bj) { const f32x4 v0 = (acc[ai][bj][m][0] + bv[bj][0]) * gs, v1 = (acc[ai][bj][m][1] + bv[bj][1]) * gs;
                    u32x4 w; w.x = cvt_pk_bf16(v0[0], v0[1]); w.y = cvt_pk_bf16(v0[2], v0[3]); w.z = cvt_pk_bf16(v1[0], v1[1]); w.w = cvt_pk_bf16(v1[2], v1[3]);
                    *(u32x4*)(rowp + bj * HALF) = w; } }
    }
};

struct EpiBranch2 {
    static constexpr bool PERM = false, AFTER_DRAIN = false; static constexpr int MIDK = 16;
    const bf16_t* P; int ldp; int gcol0; bf16_t* merged;
    __device__ __forceinline__ void mid(f32x4 (&acc)[2][2][4][2], const Unit& u, int which, int, int, int, int) const {
        int tz = threadIdx.x; asm volatile("" : "+v"(tz));
        const int wid_ = tz >> 6, lane_ = tz & 63, wr = wid_ >> 2, wc = wid_ & 3, fr = lane_ & 15, fq = lane_ >> 4;
        const int row0 = u.pm * BM + wr * 64 + fr, col0 = u.pn * BM + wc * 32 + 4 * fq;
#pragma unroll
        for (int ai = 0; ai < 2; ++ai)
#pragma unroll
            for (int m = 0; m < 4; ++m) { const bf16_t* prow = P + (size_t)(row0 + ai * HALF + m * 16) * ldp + gcol0 + (which - 1) * 2048;
#pragma unroll
                for (int bj = 0; bj < 2; ++bj)
#pragma unroll
                    for (int n = 0; n < 2; ++n) { const int c = col0 + bj * HALF + n * 16; const u32x2 ga = *(const u32x2*)(prow + c), gb = *(const u32x2*)(prow + 2048 + c);
                        const float a_[4] = {bf_lo(ga.x), bf_hi(ga.x), bf_lo(ga.y), bf_hi(ga.y)}, b_[4] = {bf_lo(gb.x), bf_hi(gb.x), bf_lo(gb.y), bf_hi(gb.y)};
#pragma unroll
                        for (int j = 0; j < 4; ++j) { const float ea = __expf(-fminf(fmaxf(a_[j], -30.f), 30.f)), eb = __expf(-fminf(fmaxf(b_[j], -30.f), 30.f));
                            acc[ai][bj][m][n][j] *= (1.0f + eb) * __builtin_amdgcn_rcpf(1.0f + ea); } }
                asm volatile("" ::: "memory"); }
    }
    __device__ __forceinline__ void operator()(const f32x4 (&acc)[2][2][4][2], const Unit& u, int wr, int wc, int fr, int fq) const {
        const int row0 = u.pm * BM + wr * 64 + fr, col0 = u.pn * BM + wc * 32 + 4 * fq;
#pragma unroll
        for (int ai = 0; ai < 2; ++ai)
#pragma unroll
            for (int m = 0; m < 4; ++m) { const int r = row0 + ai * HALF + m * 16; const bf16_t* prow = P + (size_t)r * ldp + gcol0 + 2 * 2048;
#pragma unroll
                for (int bj = 0; bj < 2; ++bj)
#pragma unroll
                    for (int n = 0; n < 2; ++n) { const int c = col0 + bj * HALF + n * 16; const u32x2 gw = *(const u32x2*)(prow + c);
                        const float g_[4] = {bf_lo(gw.x), bf_hi(gw.x), bf_lo(gw.y), bf_hi(gw.y)}; f32x4 v = acc[ai][bj][m][n];
#pragma unroll
                        for (int j = 0; j < 4; ++j) v[j] *= __builtin_amdgcn_rcpf(1.0f + __expf(-fminf(fmaxf(g_[j], -30.f), 30.f)));
                        u32x2 w; w.x = cvt_pk_bf16(v[0], v[1]); w.y = cvt_pk_bf16(v[2], v[3]); *(u32x2*)(merged + (size_t)r * 2048 + c) = w; }
                asm volatile("" ::: "memory"); }
    }
};
struct BranchOrder {                              static constexpr bool GATHER = false; __device__ __forceinline__ int arow(const Unit&, int) const { return 0; }
    StaticOrder so;
    __device__ void init(int G_, int c_) { so.init(16384, 2048, G_, c_); }
    __device__ bool next(int i, Unit& u) const { const int br = i % 3; Unit t; if (!so.next(i / 3, t)) return false; u.pm = br * 64 + t.pm; u.pn = br * 8 + t.pn; return true; }
    __device__ __forceinline__ void a_ready(const Unit&) const {}
    __device__ __forceinline__ void done(const Unit&) const {}
};
template <bool GATH> struct MoeOrder {
    static constexpr bool GATHER = GATH;
    StaticOrder so; const int* tile_e; const int* tok; int nN;
    __device__ void init(int ntiles, int nN_, int G_, int c_, const int* te, const int* tk) { so.init(ntiles * BM, nN_ * BM, G_, c_); tile_e = te; tok = tk; nN = nN_; }
    __device__ bool next(int i, Unit& u) const { Unit t; if (!so.next(i, t)) return false; u.pm = t.pm; u.pn = tile_e[t.pm] * nN + t.pn; return true; }
    __device__ __forceinline__ int arow(const Unit& u, int r) const { return tok[u.pm * BM + r]; }
    __device__ __forceinline__ void a_ready(const Unit&) const {}
    __device__ __forceinline__ void done(const Unit&) const {}
};
template <class Epi, class Sched, bool ALIGN_EPI = false, bool SP2 = false>
__device__ __forceinline__ void gemm_phase(PG8_LAS unsigned char* lds, const Gemm g, const Sched& S, const Epi& E) {
    const int tid = threadIdx.x, wid = __builtin_amdgcn_readfirstlane(tid >> 6), lane = tid & 63, wr = wid >> 2, wc = wid & 3, fr = lane & 15, fq = lane >> 4;
    const int K = g.K, nt = K / BK;
    unsigned voffA[2], voffB[2];
#pragma unroll
    for (int i = 0; i < 2; ++i) { int R, C; stage_rc(tid * 16 + i * 8192, R, C); const int Rb = Epi::PERM ? ((R & ~31) + perm32(R & 31)) : R;
        voffA[i] = (unsigned)(R * K + C) * 2u; voffB[i] = (unsigned)(Rb * K + C) * 2u; }
    unsigned vc[2][2] = {{0u, 0u}, {0u, 0u}}, vn[2][2] = {{0u, 0u}, {0u, 0u}};
#define PG8_ROWS(dst, un) do { if constexpr (Sched::GATHER) { _Pragma("unroll") for (int _h = 0; _h < 2; ++_h) _Pragma("unroll") for (int _i = 0; _i < 2; ++_i) { int R_, C_; stage_rc(tid * 16 + _i * 8192, R_, C_); \
        dst[_h][_i] = (unsigned)(S.arow(un, _h * HALF + R_) * K + C_) * 2u; } } } while (0)
#define PG8_STAGE_A(bufoff, abase, half, nx) do { if constexpr (Sched::GATHER) { unsigned vo_[2]; vo_[0] = (nx) ? vn[half][0] : vc[half][0]; vo_[1] = (nx) ? vn[half][1] : vc[half][1]; PG8_STAGE(bufoff, abase, vo_); } \
        else { PG8_STAGE(bufoff, (abase) + (half) * hstep, voffA); } } while (0)
    const size_t kstep = (size_t)(BK * 2);
    const size_t hstep = (size_t)HALF * K * 2;
    const size_t tstep = 2 * hstep;
    const unsigned ldsw = (unsigned)wid * 1024u;
    const int aoff = lds_byte(wr * 64 + fr, fq * 8), boff = lds_byte(wc * 32 + fr, fq * 8);
#define PG8_SA(b, h) (((b) * 2 + (h)) * HTB)
#define PG8_SB(b, h) ((4 + (b) * 2 + (h)) * HTB)
#define PG8_STAGE(bufoff, gbase, voff) do { _Pragma("unroll") for (int _i = 0; _i < 2; ++_i) \
        __builtin_amdgcn_global_load_lds((const unsigned*)((const char*)(gbase) + (voff)[_i]), (PG8_LAS unsigned*)(lds + (bufoff) + ldsw + _i * 8192), 16, 0, 0); } while (0)
#define PG8_LDA(dst, b, h) do { _Pragma("unroll") for (int m = 0; m < 4; ++m) _Pragma("unroll") for (int k = 0; k < 2; ++k) dst[m][k] = *(const PG8_LAS bf16x8*)(lds + PG8_SA(b, h) + aoff + m * 2048 + k * 1024); } while (0)
#define PG8_LDB(dst, b, h) do { _Pragma("unroll") for (int n = 0; n < 2; ++n) _Pragma("unroll") for (int k = 0; k < 2; ++k) dst[n][k] = *(const PG8_LAS bf16x8*)(lds + PG8_SB(b, h) + boff + n * 2048 + k * 1024); } while (0)
#define PG8_MMA(ai, bj, At, Bt) do { __builtin_amdgcn_s_setprio(1); _Pragma("unroll") for (int m = 0; m < 4; ++m) _Pragma("unroll") for (int n = 0; n < 2; ++n) _Pragma("unroll") for (int k = 0; k < 2; ++k) \
        acc[ai][bj][m][n] = __builtin_amdgcn_mfma_f32_16x16x32_bf16(Bt[n][k], At[m][k], acc[ai][bj][m][n], 0, 0, 0); __builtin_amdgcn_s_setprio(0); } while (0)
#define PG8_WAIT_V(n) asm volatile("s_waitcnt vmcnt(" #n ")" ::: "memory")
#define PG8_WAIT_L(n) asm volatile("s_waitcnt lgkmcnt(" #n ")" ::: "memory")
#define PG8_BAR __builtin_amdgcn_s_barrier()
#define PG8_SCHED __builtin_amdgcn_sched_barrier(0)
    Unit cur, nxt; int ui = 0;
    if (!S.next(0, cur)) return;
    f32x4 acc[2][2][4][2];
#pragma unroll
    for (int a = 0; a < 2; ++a)
#pragma unroll
        for (int b = 0; b < 2; ++b)
#pragma unroll
            for (int m = 0; m < 4; ++m)
#pragma unroll
                for (int n = 0; n < 2; ++n) acc[a][b][m][n] = (f32x4){0.f, 0.f, 0.f, 0.f};
    bf16x8 At[4][2], B0[2][2], B1[2][2];
    const char* cA = (const char*)g.A + (Sched::GATHER ? (size_t)0 : (size_t)cur.pm * tstep); const char* cB = (const char*)g.Bt + (size_t)cur.pn * tstep;
    PG8_ROWS(vc, cur);
    S.a_ready(cur);
    if constexpr (SP2) {
        PG8_STAGE(PG8_SB(0, 0), cB, voffB); PG8_STAGE(PG8_SB(0, 1), cB + hstep, voffB); PG8_STAGE_A(PG8_SA(0, 0), cA, 0, false); PG8_STAGE_A(PG8_SA(0, 1), cA, 1, false);
        if (wr == 1) PG8_BAR;
        PG8_WAIT_V(2); PG8_BAR;
        PG8_STAGE(PG8_SB(1, 0), cB + kstep, voffB); PG8_STAGE_A(PG8_SA(1, 0), cA + kstep, 0, false); PG8_STAGE(PG8_SB(1, 1), cB + hstep + kstep, voffB);
        PG8_WAIT_V(6); PG8_BAR;
    } else {
        PG8_STAGE(PG8_SB(0, 0), cB, voffB); PG8_STAGE_A(PG8_SA(0, 0), cA, 0, false); PG8_STAGE(PG8_SB(0, 1), cB + hstep, voffB); PG8_STAGE_A(PG8_SA(0, 1), cA, 1, false);
        if (wr == 1) PG8_BAR;
        PG8_WAIT_V(4); PG8_BAR;
        PG8_STAGE(PG8_SB(1, 0), cB + kstep, voffB); PG8_STAGE_A(PG8_SA(1, 0), cA + kstep, 0, false); PG8_STAGE(PG8_SB(1, 1), cB + hstep + kstep, voffB);
        PG8_WAIT_V(6); PG8_BAR;
    }
    for (;;) {
        const bool has_next = S.next(ui + 1, nxt);
        if (has_next) PG8_ROWS(vn, nxt);
        const char* nA = (has_next && !Sched::GATHER) ? (const char*)g.A + (size_t)nxt.pm * tstep : cA; const char* nB = has_next ? (const char*)g.Bt + (size_t)nxt.pn * tstep : cB;
        for (int t = 0; t < nt; t += 2) {
            const bool last = (t == nt - 2);
            const char* a1 = cA + (size_t)(t + 1) * kstep;
            const char* a2 = last ? nA : cA + (size_t)(t + 2) * kstep; const char* b2 = last ? nB : cB + (size_t)(t + 2) * kstep;
            const char* a3 = a2 + kstep; const char* b3 = b2 + kstep;
            if (last && has_next) S.a_ready(nxt);
            if constexpr (Epi::MIDK > 0) { if (t == Epi::MIDK || t == 2 * Epi::MIDK) E.mid(acc, cur, t / Epi::MIDK, wr, wc, fr, fq); }
            if constexpr (SP2) {
            PG8_LDB(B0, 0, 0); PG8_LDB(B1, 0, 1); PG8_SCHED; PG8_LDA(At, 0, 0); PG8_STAGE_A(PG8_SA(1, 1), a1, 1, false);
            PG8_WAIT_V(8); PG8_WAIT_L(0); PG8_BAR; PG8_MMA(0, 0, At, B0); PG8_MMA(0, 1, At, B1); PG8_BAR; PG8_SCHED;
            PG8_LDA(At, 0, 1); PG8_STAGE(PG8_SB(0, 0), b2, voffB); PG8_STAGE(PG8_SB(0, 1), b2 + hstep, voffB); PG8_STAGE_A(PG8_SA(0, 0), a2, 0, last);
            PG8_WAIT_V(8); PG8_WAIT_L(0); PG8_BAR; PG8_MMA(1, 0, At, B0); PG8_MMA(1, 1, At, B1); PG8_BAR; PG8_SCHED;
            PG8_LDB(B0, 1, 0); PG8_LDB(B1, 1, 1); PG8_SCHED; PG8_LDA(At, 1, 0); PG8_STAGE_A(PG8_SA(0, 1), a2, 1, last);
            PG8_WAIT_V(8); PG8_WAIT_L(0); PG8_BAR; PG8_MMA(0, 0, At, B0); PG8_MMA(0, 1, At, B1); PG8_BAR; PG8_SCHED;
            PG8_LDA(At, 1, 1); PG8_STAGE(PG8_SB(1, 0), b3, voffB); PG8_STAGE(PG8_SB(1, 1), b3 + hstep, voffB); PG8_STAGE_A(PG8_SA(1, 0), a3, 0, last);
            PG8_WAIT_V(8); PG8_WAIT_L(0); PG8_BAR; PG8_MMA(1, 0, At, B0); PG8_MMA(1, 1, At, B1); PG8_BAR; PG8_SCHED;
            } else {
            PG8_LDB(B0, 0, 0); PG8_SCHED; PG8_LDA(At, 0, 0); PG8_STAGE_A(PG8_SA(1, 1), a1, 1, false);
            PG8_WAIT_L(8); PG8_BAR; PG8_WAIT_L(0); PG8_MMA(0, 0, At, B0); PG8_BAR; PG8_SCHED;
            PG8_LDB(B1, 0, 1); PG8_STAGE(PG8_SB(0, 0), b2, voffB);
            PG8_BAR; PG8_WAIT_L(0); PG8_MMA(0, 1, At, B1); PG8_BAR;
            PG8_LDA(At, 0, 1); PG8_STAGE_A(PG8_SA(0, 0), a2, 0, last);
            PG8_BAR; PG8_WAIT_L(0); PG8_MMA(1, 0, At, B0); PG8_BAR; PG8_SCHED;
            PG8_STAGE(PG8_SB(0, 1), b2 + hstep, voffB);
            PG8_WAIT_V(6); PG8_BAR; PG8_MMA(1, 1, At, B1); PG8_BAR;
            PG8_LDB(B0, 1, 0); PG8_SCHED; PG8_LDA(At, 1, 0); PG8_STAGE_A(PG8_SA(0, 1), a2, 1, last);
            PG8_WAIT_L(8); PG8_BAR; PG8_WAIT_L(0); PG8_MMA(0, 0, At, B0); PG8_BAR; PG8_SCHED;
            PG8_LDB(B1, 1, 1); PG8_STAGE(PG8_SB(1, 0), b3, voffB);
            PG8_BAR; PG8_WAIT_L(0); PG8_MMA(0, 1, At, B1); PG8_BAR;
            PG8_LDA(At, 1, 1); PG8_STAGE_A(PG8_SA(1, 0), a3, 0, last);
            PG8_BAR; PG8_WAIT_L(0); PG8_MMA(1, 0, At, B0); PG8_BAR; PG8_SCHED;
            PG8_STAGE(PG8_SB(1, 1), b3 + hstep, voffB);
            PG8_WAIT_V(6); PG8_BAR; PG8_MMA(1, 1, At, B1); PG8_BAR;
            }
        }
        if constexpr (ALIGN_EPI) { if (wr == 0) PG8_BAR; }
        if constexpr (!Epi::AFTER_DRAIN) { E(acc, cur, wr, wc, fr, fq); S.done(cur); }
        if (!has_next) break;
#pragma unroll
        for (int a = 0; a < 2; ++a)
#pragma unroll
            for (int b = 0; b < 2; ++b)
#pragma unroll
                for (int m = 0; m < 4; ++m)
#pragma unroll
                    for (int n = 0; n < 2; ++n) acc[a][b][m][n] = (f32x4){0.f, 0.f, 0.f, 0.f};
        cur = nxt; cA = nA; cB = nB; ++ui;
        if constexpr (Sched::GATHER) { vc[0][0] = vn[0][0]; vc[0][1] = vn[0][1]; vc[1][0] = vn[1][0]; vc[1][1] = vn[1][1]; }
        if constexpr (ALIGN_EPI) { if (wr == 1) PG8_BAR; }
    }
    PG8_WAIT_V(0);
    if constexpr (!ALIGN_EPI) { if (wr == 0) PG8_BAR; }
    PG8_BAR;
    if constexpr (Epi::AFTER_DRAIN) { E.fused(acc, cur, wr, wc, fr, fq, lds, wid, lane); S.done(cur); }
#undef PG8_SA
#undef PG8_SB
#undef PG8_STAGE
#undef PG8_STAGE_A
#undef PG8_ROWS
#undef PG8_LDA
#undef PG8_LDB
#undef PG8_MMA
#undef PG8_WAIT_V
#undef PG8_WAIT_L
#undef PG8_BAR
#undef PG8_SCHED
}
}

constexpr int NWAVES = 8;
constexpr int BATCH = 2, SEQ = 8192, T = BATCH * SEQ, D = 2048;
constexpr int RWKV_COLS = 3360, IN_COLS = 12576;
constexpr int NP = 12800;
constexpr int PC_LX = 3584, PC_LY = 4608, PC_Q = 5632, PC_G = 6656;
constexpr int NE = 32, MAXROWS = 65536 + NE * 256;
constexpr int LORA_K = 384;
constexpr float EPS = 1e-6f, GN_EPS = 64e-5f;

constexpr size_t MiB = 1u << 20;
constexpr size_t WS_CTL = 0, CTL_ZERO_BYTES = 1 * MiB;
constexpr size_t WS_WIN = 1 * MiB, WS_WMKV = 51 * MiB, WS_WLORA = 59 * MiB, WS_WBR = 62 * MiB, WS_WO = 74 * MiB, WS_WR = 82 * MiB, WS_LW = 83 * MiB;
constexpr size_t WS_WGU = 84 * MiB, WS_WD = 596 * MiB;
constexpr size_t WS_XN = 852 * MiB;
constexpr size_t WS_P = 916 * MiB;
constexpr size_t WS_LORAOUT = 1316 * MiB;
constexpr size_t WS_SCAN = 1508 * MiB;
constexpr size_t WS_YABC = 1892 * MiB;
constexpr size_t WS_MISC = 1988 * MiB;
constexpr size_t WS_MN = WS_MISC, WS_KMEM = WS_MISC + 2 * MiB, WS_VT = WS_MISC + 3 * MiB, WS_LRUC = WS_MISC + 4 * MiB  , WS_BONUS = WS_MISC + 7 * MiB;
constexpr size_t WS_PICK = WS_MISC + 8 * MiB  , WS_ROWTAB = WS_MISC + 9 * MiB  , WS_SPL = WS_ROWTAB + 512 * 1024  ;
constexpr size_t WS_END = 2000 * MiB;
constexpr size_t WS_MACC = WS_LORAOUT, WS_MERGED = 1444 * MiB, WS_H1 = WS_SCAN, WS_XS = WS_P, WS_OROW = WS_P, WS_HH = 1204 * MiB;
constexpr int CW_BAR = 4096, CW_CNT = 8192, CW_NTILES = 8192 + 64, CW_TILEE = 8192 + 128;

constexpr int LDS_BYTES = 147456;
constexpr int MISC_OFF = 143360;

#define GAS __attribute__((address_space(1)))
#define LAS __attribute__((address_space(3)))
typedef unsigned short bf16;
typedef unsigned v4u __attribute__((ext_vector_type(4)));
typedef unsigned v2u __attribute__((ext_vector_type(2)));
typedef float f32x4 __attribute__((ext_vector_type(4)));
typedef float f32x2 __attribute__((ext_vector_type(2)));
typedef short bf16x8 __attribute__((ext_vector_type(8)));
#define LDS_WAIT() asm volatile("s_waitcnt lgkmcnt(0)" ::: "memory")
#define VM_WAIT() asm volatile("s_waitcnt vmcnt(0)" ::: "memory")
__device__ __forceinline__ unsigned f2bf(float f) { unsigned u = __builtin_bit_cast(unsigned, f); return (u + 0x7fffu + ((u >> 16) & 1u)) >> 16; }
__device__ __forceinline__ unsigned pk2(float lo, float hi) { return f2bf(lo) | (f2bf(hi) << 16); }
__device__ __forceinline__ float bflo(unsigned w) { return __builtin_bit_cast(float, w << 16); }
__device__ __forceinline__ float bfhi(unsigned w) { return __builtin_bit_cast(float, w & 0xffff0000u); }
__device__ __forceinline__ float bf1(bf16 b) { return __builtin_bit_cast(float, (unsigned)b << 16); }
__device__ __forceinline__ float sigm(float x) { return __builtin_amdgcn_rcpf(1.0f + __expf(-x)); }
__device__ __forceinline__ float fast_tanh(float x) { const float e = __expf(2.0f * x); return 1.0f - 2.0f * __builtin_amdgcn_rcpf(e + 1.0f); }
__device__ __forceinline__ float softplusf(float x) { return fmaxf(x, 0.f) + log1pf(__expf(-fabsf(x))); }
__device__ __forceinline__ float wave_sum(float v) {
#pragma unroll
    for (int o = 1; o < 64; o <<= 1) v += __shfl_xor(v, o);
    return v;
}
template <int CTRL> __device__ __forceinline__ float dppf(float x) { return __builtin_bit_cast(float, __builtin_amdgcn_mov_dpp(__builtin_bit_cast(int, x), CTRL, 0xf, 0xf, true)); }
__device__ __forceinline__ float row16_sum(float v) {
    v += dppf<0xB1>(v); v += dppf<0x4E>(v); v += dppf<0x141>(v); v += dppf<0x140>(v); return v;
}
#define XB_TMO      128
#define XB_XCNT(j)  (256  + 64 * (j))
#define XB_XSUB(j)  (1280 + 64 * (j))
#define XB_XGEN(j)  (2304 + 64 * (j))
#define XB_TOP      3328
#define XB_TOPGEN   3392
#define XCD_BAR_WORDS 3456
#define XB_SPIN_CAP (1u << 18)

__device__ __forceinline__ unsigned xb_ld(unsigned* p)              { return __hip_atomic_load(p, __ATOMIC_RELAXED, __HIP_MEMORY_SCOPE_AGENT); }
__device__ __forceinline__ unsigned xb_add(unsigned* p, unsigned v) { return __hip_atomic_fetch_add(p, v, __ATOMIC_RELAXED, __HIP_MEMORY_SCOPE_AGENT); }
__device__ __forceinline__ unsigned xb_xcc_id() { return (unsigned)__builtin_amdgcn_s_getreg((3 << 11) | 20) & 0xFu; }
#define XB_SPIN(cond, bar) do { unsigned _sp = 0; while (cond) { __builtin_amdgcn_s_sleep(1); \
    if ((++_sp & 255u) == 0u) { if (xb_ld(&(bar)[XB_TMO])) break; if (_sp > XB_SPIN_CAP) { atomicAdd(&(bar)[XB_TMO], 1u); break; } } } } while (0)

struct XcdBarrier {
    unsigned* bar; unsigned x;
    volatile LAS unsigned* st;
};

__device__ __forceinline__ XcdBarrier xcd_barrier_post(unsigned* bar, volatile LAS unsigned* st) {
    XcdBarrier b; b.bar = bar; b.x = xb_xcc_id(); b.st = st;
    if (threadIdx.x == 0) (void)xb_add(&bar[XB_XCNT(b.x)], 1u);
    return b;
}
__device__ __forceinline__ void xcd_barrier_complete(unsigned* bar, unsigned x, unsigned& nloc, unsigned& nx) {
    const unsigned G = gridDim.x * gridDim.y * gridDim.z;
    unsigned sum, cnt, mine, sp = 0u;
    for (;;) {
        sum = 0u; cnt = 0u; mine = 0u;
#pragma unroll
        for (unsigned j = 0; j < 16; ++j) { const unsigned c = xb_ld(&bar[XB_XCNT(j)]); sum += c; cnt += (c > 0u) ? 1u : 0u; mine = (j == x) ? c : mine; }
        if (sum == G) break;
        __builtin_amdgcn_s_sleep(1);
        if ((++sp & 255u) == 0u) { if (xb_ld(&bar[XB_TMO])) break; if (sp > XB_SPIN_CAP) { atomicAdd(&bar[XB_TMO], 1u); break; } }
    }
    nloc = mine > 0u ? mine : 1u; nx = cnt > 0u ? cnt : 1u;
}

__device__ __forceinline__ void xcd_barrier(const XcdBarrier& b) {
    asm volatile("s_waitcnt vmcnt(0)" ::: "memory");
    __syncthreads();
    if (threadIdx.x == 0) {
        unsigned* bar = b.bar;
        __builtin_amdgcn_s_waitcnt(0);
        unsigned nloc = b.st[0], nx = b.st[1];
        if (nloc == 0u) { xcd_barrier_complete(bar, b.x, nloc, nx); b.st[0] = nloc; b.st[1] = nx; }
        const unsigned old = xb_add(&bar[XB_XSUB(b.x)], 1u);
        const unsigned gen = old / nloc;
        if (old + 1u == (gen + 1u) * nloc) {
            __builtin_amdgcn_fence(__ATOMIC_RELEASE, "agent");
            asm volatile("s_waitcnt vmcnt(0)" ::: "memory");
            const unsigned og = xb_add(&bar[XB_TOP], 1u);
            const unsigned tg = og / nx;
            if (og + 1u == (tg + 1u) * nx) xb_add(&bar[XB_TOPGEN], 1u);
            else XB_SPIN(xb_ld(&bar[XB_TOPGEN]) == tg, bar);
            __builtin_amdgcn_fence(__ATOMIC_ACQUIRE, "agent");
            xb_add(&bar[XB_XGEN(b.x)], 1u);
            asm volatile("s_waitcnt vmcnt(0)" ::: "memory");
        } else {
            XB_SPIN(xb_ld(&bar[XB_XGEN(b.x)]) == gen, bar);
            __builtin_amdgcn_fence(__ATOMIC_ACQUIRE, "agent");
            asm volatile("s_waitcnt vmcnt(0)" ::: "memory");
        }
    }
    __syncthreads();
}

struct Frame {
    LAS unsigned char* lds;
    volatile LAS unsigned* MISC;
    int tid, lane, wave, vcu, G;
};
struct Args { const float* in[39]; float* out; unsigned char* ws; int ph_lo, ph_hi; };
enum { I_X = 0, I_MEM, I_GMIX, I_WIN, I_MU, I_W0, I_W2, I_A0, I_A2, I_G2, I_KK, I_KA, I_RK, I_LNW, I_LNB, I_WRO, I_CONVW, I_CONVB, I_LWR, I_LBR, I_LWI, I_LBI, I_LAM, I_WLO,
       I_GMEM, I_WMK, I_WMV, I_WXO, I_WOUT, I_GFFN, I_WROUTER, I_BROUTER, I_WGATE, I_BGATE, I_WUP, I_BUP, I_WDOWN, I_BDOWN, I_GFINAL };


__device__ __forceinline__ const float* inp(int k) {
    typedef const volatile unsigned long long __attribute__((address_space(4))) ka_t;
    ka_t* ka = (ka_t*)__builtin_amdgcn_kernarg_segment_ptr();
    return (const float*)ka[k];
}
template <int NB> __device__ __forceinline__ void transpose_item(const float* W, int N, int k0, int n0, bf16* WT, int Kd, int drow0, int lane, int kdo = 0) {
    constexpr int LPR = NB / 4, G = 64 / LPR, KR = 64 / G;
    const int g = lane / LPR, c = lane % LPR;
    const GAS float* src = (const GAS float*)W + (size_t)(k0 + KR * g) * N + n0 + 4 * c;
    f32x4 ld[KR];
#pragma unroll
    for (int i = 0; i < KR; ++i) ld[i] = *(const GAS f32x4*)(src + (size_t)i * N);
    GAS bf16* dst = (GAS bf16*)WT + (size_t)(drow0 + 4 * c) * Kd + kdo + k0 + KR * g;
#pragma unroll
    for (int j = 0; j < 4; ++j)
#pragma unroll
        for (int q = 0; q < KR / 8; ++q) { v4u o; o.x = pk2(ld[8 * q + 0][j], ld[8 * q + 1][j]); o.y = pk2(ld[8 * q + 2][j], ld[8 * q + 3][j]); o.z = pk2(ld[8 * q + 4][j], ld[8 * q + 5][j]); o.w = pk2(ld[8 * q + 6][j], ld[8 * q + 7][j]);
            *(GAS v4u*)(dst + (size_t)j * Kd + 8 * q) = o; }
}
__device__ __forceinline__ void rms_row_to_bf16(const float* xrow, const float* gain, bf16* orow, int lane) {
    const GAS f32x4* xr = (const GAS f32x4*)xrow + lane; const GAS f32x4* gr = (const GAS f32x4*)gain + lane;
    f32x4 v[8]; float s = 0.f;
#pragma unroll
    for (int j = 0; j < 8; ++j) { v[j] = xr[64 * j]; s += (v[j].x * v[j].x + v[j].y * v[j].y) + (v[j].z * v[j].z + v[j].w * v[j].w); }
    const float rstd = 1.0f / sqrtf(wave_sum(s) * (1.f / D) + EPS);
    GAS v2u* o8 = (GAS v2u*)orow + lane;
#pragma unroll
    for (int j = 0; j < 8; ++j) { const f32x4 g = gr[64 * j]; v2u w; w.x = pk2(v[j].x * rstd * g.x, v[j].y * rstd * g.y); w.y = pk2(v[j].z * rstd * g.z, v[j].w * rstd * g.w); o8[64 * j] = w; }
}

__device__ __forceinline__ void p0_prologue(const Frame& F, const Args& a) {
    unsigned char* ws = a.ws;
    const int gw = F.vcu * NWAVES + F.wave, NGW = F.G * NWAVES;
    constexpr int I_IN = 32 * (IN_COLS / 32), I_MK = 32 * 32, I_BR = 16 * 64, I_O = 32 * 64;
    constexpr int NITEMS = I_IN + 2 * I_MK + 3 * I_BR + I_O;
    for (int it = gw; it < NITEMS; it += NGW) {
        int r = it;
        if (r < I_IN) { const int nb = IN_COLS / 32, kb = r / nb, n0 = 32 * (r % nb); transpose_item<32>(inp(I_WIN), IN_COLS, 64 * kb, n0, (bf16*)(ws + WS_WIN), D, n0 + (n0 >= RWKV_COLS ? 224 : 0), F.lane); continue; } r -= I_IN;
        if (r < I_MK) { transpose_item<32>(inp(I_WMK), 1024, 64 * (r / 32), 32 * (r % 32), (bf16*)(ws + WS_WMKV), D, 32 * (r % 32), F.lane); continue; } r -= I_MK;
        if (r < I_MK) { transpose_item<32>(inp(I_WMV), 1024, 64 * (r / 32), 32 * (r % 32), (bf16*)(ws + WS_WMKV), D, 1024 + 32 * (r % 32), F.lane); continue; } r -= I_MK;
        if (r < I_BR) { transpose_item<32>(inp(I_WRO), 2048, 64 * (r / 64), 32 * (r % 64), (bf16*)(ws + WS_WBR), 3072, 32 * (r % 64), F.lane, 0); continue; } r -= I_BR;
        if (r < I_BR) { transpose_item<32>(inp(I_WLO), 2048, 64 * (r / 64), 32 * (r % 64), (bf16*)(ws + WS_WBR), 3072, 32 * (r % 64), F.lane, 1024); continue; } r -= I_BR;
        if (r < I_BR) { transpose_item<32>(inp(I_WXO), 2048, 64 * (r / 64), 32 * (r % 64), (bf16*)(ws + WS_WBR), 3072, 32 * (r % 64), F.lane, 2048); continue; } r -= I_BR;
        transpose_item<32>(inp(I_WOUT), 2048, 64 * (r / 64), 32 * (r % 64), (bf16*)(ws + WS_WO), D, 32 * (r % 64), F.lane);
    }
    for (int m = gw; m < T; m += NGW) rms_row_to_bf16(inp(I_X) + (size_t)m * D, inp(I_GMIX), (bf16*)(ws + WS_XN) + (size_t)m * D, F.lane);
    for (int m = gw; m < 512; m += NGW) rms_row_to_bf16(inp(I_MEM) + (size_t)m * D, inp(I_GMEM), (bf16*)(ws + WS_MN) + (size_t)m * D, F.lane);
    const int gt = F.vcu * (NWAVES * 64) + F.tid, NGT = F.G * NWAVES * 64;
    { bf16* wz = (bf16*)(ws + WS_WIN) + (size_t)RWKV_COLS * D; for (int i = gt; i < 224 * D / 2; i += NGT) ((GAS unsigned*)wz)[i] = 0u; }
    { bf16* wl = (bf16*)(ws + WS_WLORA);
      for (int i = gt; i < 3072 * LORA_K; i += NGT) { const int n = i / LORA_K, k = i % LORA_K; float v = 0.f;
          if (n < 1024) { if (k < 64) v = inp(I_W2)[k * 1024 + n]; }
          else if (n < 2048) { if (k >= 64 && k < 128) v = inp(I_A2)[(k - 64) * 1024 + (n - 1024)]; }
          else { if (k >= 128 && k < 288) v = inp(I_G2)[(k - 128) * 1024 + (n - 2048)]; }
          wl[i] = (bf16)f2bf(v); } }
    { const float* lam = inp(I_LAM); float* spl = (float*)(ws + WS_SPL); for (int i = gt; i < 1024; i += NGT) spl[i] = softplusf(-lam[i]); }
    { bf16* wr = (bf16*)(ws + WS_WR);
      for (int i = gt; i < 32 * D; i += NGT) { const int e = i / D, k = i % D; const float w = inp(I_WROUTER)[k * 32 + e]; const unsigned hi = f2bf(w); const float r = w - __builtin_bit_cast(float, hi << 16);
          wr[i] = (bf16)hi; wr[32 * D + i] = (bf16)f2bf(r); } }
    { const float* lwi_p = inp(I_LWI); const float* lwr_p = inp(I_LWR); bf16* lw = (bf16*)(ws + WS_LW);
      for (int i = gt; i < 2 * 16 * 4 * 2 * 64 * 8; i += NGT) { const int j = i & 7, ln = (i >> 3) & 63, ks = (i >> 9) & 1, vbo = (i >> 10) & 3, n = (i >> 12) & 15, mat = i >> 16;
          const int w = 32 * ks + 16 * (j >> 2) + 4 * (ln >> 4) + (j & 3), v = 16 * vbo + (ln & 15);
          lw[i] = (bf16)f2bf((mat ? lwi_p : lwr_p)[(n * 64 + w) * 64 + v]); } }
}

__device__ __forceinline__ void moe_weight_convert(const Frame& F, const Args& a, int w0) {
    unsigned char* ws = a.ws;
    const float* wg = inp(I_WGATE); const float* wu = inp(I_WUP); const float* wd = inp(I_WDOWN);
    const int nw = NWAVES - w0, gw = F.vcu * nw + (F.wave - w0), NGW = F.G * nw;
    constexpr int PER = 1024;
    for (int it = gw; it < NE * 3 * PER; it += NGW) {
        const int e = it / (3 * PER), r = it % (3 * PER), which = r / PER, q = r % PER, k0 = 64 * (q / 32), n0 = 64 * (q % 32);
        if (which == 0) transpose_item<64>(wg + (size_t)e * D * D, D, k0, n0, (bf16*)(ws + WS_WGU) + (size_t)e * 4096 * D, D, (n0 >> 7) * 256 + (n0 & 127), F.lane);
        else if (which == 1) transpose_item<64>(wu + (size_t)e * D * D, D, k0, n0, (bf16*)(ws + WS_WGU) + (size_t)e * 4096 * D, D, (n0 >> 7) * 256 + 128 + (n0 & 127), F.lane);
        else transpose_item<64>(wd + (size_t)e * D * D, D, k0, n0, (bf16*)(ws + WS_WD) + (size_t)e * 2048 * D, D, n0, F.lane);
    }
}

__device__ __forceinline__ void r1_lora_in(const Frame& F, const Args& a) {
    const bf16* P = (const bf16*)(a.ws + WS_P); bf16* L = (bf16*)(a.ws + WS_XN);
    const float* mu = inp(I_MU);
    const int gw = F.vcu * NWAVES + F.wave, NGW = F.G * NWAVES;
    for (int m = gw; m < T; m += NGW) {
        const bool first = (m % SEQ) == 0;
#pragma unroll
        for (int j = 0; j < 6; ++j) { const int k = F.lane + 64 * j; float o = 0.f;
            if (k < 288) { const int c = 3072 + k; const float cur = bf1(P[(size_t)m * NP + c]); const float prev = first ? 0.f : bf1(P[(size_t)(m - 1) * NP + c]);
                const float x = cur + (prev - cur) * mu[c]; o = k < 64 ? fast_tanh(x) : (k < 128 ? x : sigm(x)); }
            L[(size_t)m * LORA_K + k] = (bf16)f2bf(o); }
    }
}

constexpr int REC_F = 2816, REC_AT = 0, REC_RT = 512, REC_BH = 1024, REC_KH = 1536, REC_WC = 2048, REC_N = 2112, REC_Q = 2176, REC_V8 = 2240;
__device__ __forceinline__ float wave_sum_fast(float v) { v = row16_sum(v); v += __shfl_xor(v, 16); v += __shfl_xor(v, 32); return v; }
__device__ __forceinline__ void r3_blocks(const Frame& F, const Args& a) {
    const GAS bf16* P = (const GAS bf16*)(a.ws + WS_P); const GAS float* LO = (const GAS float*)(a.ws + WS_LORAOUT);
    GAS float* REC = (GAS float*)(a.ws + WS_SCAN); GAS float* BON = (GAS float*)(a.ws + WS_BONUS);
    const GAS float* mu = (const GAS float*)inp(I_MU); const GAS float* w0 = (const GAS float*)inp(I_W0); const GAS float* a0 = (const GAS float*)inp(I_A0);
    const GAS float* kkp = (const GAS float*)inp(I_KK); const GAS float* kap = (const GAS float*)inp(I_KA); const GAS float* rkp = (const GAS float*)inp(I_RK);
    LAS float* G1 = (LAS float*)(F.lds + F.wave * 16384);
    LAS float* G2 = G1 + 2048;
    const int gw = F.vcu * NWAVES + F.wave, NGW = F.G * NWAVES, lane = F.lane;
#pragma unroll 1
    for (int it = gw; it < 32 * 1024; it += NGW) {
        const int bh = it >> 10, blk = it & 1023, b = bh >> 4, h = bh & 15, c = h * 64 + lane, m0 = b * SEQ + blk * 8;
        const float mur = mu[c], muk = mu[1024 + c], muv = mu[2048 + c], w0c = w0[c], a0c = a0[c], kkw = kkp[c], kaw = kap[c], rkw = rkp[c];
        float w[8], av[8], bv[8], kv[8], rv[8], vv[8], ag[8], kk[8], n2[8], bo[8];
        float pr = 0.f, pk = 0.f, pv = 0.f;
        if (blk > 0) { const GAS bf16* pp = P + (size_t)(m0 - 1) * NP; pr = bf1(pp[c]); pk = bf1(pp[1024 + c]); pv = bf1(pp[2048 + c]); }
#pragma unroll
        for (int t = 0; t < 8; ++t) { const GAS bf16* pc = P + (size_t)(m0 + t) * NP; const float cr = bf1(pc[c]), ck = bf1(pc[1024 + c]), cv = bf1(pc[2048 + c]);
            const float r = cr + (pr - cr) * mur, k = ck + (pk - ck) * muk, v = cv + (pv - cv) * muv; pr = cr; pk = ck; pv = cv;
            const float wpre = w0c + LO[(size_t)(m0 + t) * 3072 + c], apre = a0c + LO[(size_t)(m0 + t) * 3072 + 1024 + c];
            w[t] = __expf(-0.6065306597126334f * __builtin_amdgcn_rcpf(1.0f + __expf(-wpre)));
            ag[t] = __builtin_amdgcn_rcpf(1.0f + __expf(-apre));
            kk[t] = k * kkw; n2[t] = kk[t] * kk[t];
            kv[t] = k * (1.0f + (ag[t] - 1.0f) * kaw); rv[t] = r; vv[t] = v; bo[t] = r * kv[t] * rkw; }
#pragma unroll
        for (int t = 0; t < 8; ++t) { n2[t] = wave_sum_fast(n2[t]); bo[t] = wave_sum_fast(bo[t]); }
#pragma unroll
        for (int t = 0; t < 8; ++t) { const float kkn = kk[t] * (1.0f / sqrtf(fmaxf(n2[t], 1e-24f))); av[t] = -kkn; bv[t] = kkn * ag[t]; if (lane == 0) BON[(m0 + t) * 16 + h] = bo[t]; }
        float Pp[8]; Pp[0] = w[0];
#pragma unroll
        for (int t = 1; t < 8; ++t) Pp[t] = Pp[t - 1] * w[t];
        float bch[8], kch[8], ah[8], rh[8];
#pragma unroll
        for (int t = 0; t < 8; ++t) { const float pin = __builtin_amdgcn_rcpf(Pp[t]); bch[t] = bv[t] * pin; kch[t] = kv[t] * pin; ah[t] = av[t] * (t > 0 ? Pp[t - 1] : 1.0f); rh[t] = rv[t] * Pp[t]; }
        const int pos = (lane & 3) * 16 + (lane >> 2);
#pragma unroll
        for (int t = 0; t < 8; ++t) { G1[t * 64 + pos] = bch[t]; G1[(8 + t) * 64 + pos] = kch[t]; G1[(16 + t) * 64 + pos] = ah[t]; G1[(24 + t) * 64 + pos] = rh[t]; }
        LDS_WAIT(); asm volatile("" ::: "memory");
        f32x4 fa[4], fb[4];
#pragma unroll
        for (int q = 0; q < 4; ++q) { fa[q] = *(const LAS f32x4*)(G1 + (lane & 15) * 64 + (lane >> 4) * 16 + 4 * q); fb[q] = *(const LAS f32x4*)(G1 + (16 + (lane & 15)) * 64 + (lane >> 4) * 16 + 4 * q); }
        f32x4 dacc = {0.f, 0.f, 0.f, 0.f};
#pragma unroll
        for (int s2 = 0; s2 < 16; ++s2) dacc = __builtin_amdgcn_mfma_f32_16x16x4f32(fa[s2 >> 2][s2 & 3], fb[s2 >> 2][s2 & 3], dacc, 0, 0, 0);
        *(LAS f32x4*)(G2 + (lane & 15) * 16 + 4 * (lane >> 4)) = dacc;
        LDS_WAIT(); asm volatile("" ::: "memory");
        float M[8][8];
        { float Lm[8][8];
#pragma unroll
          for (int t = 1; t < 8; ++t) { const f32x4 l0 = *(const LAS f32x4*)(G2 + t * 16), l1 = *(const LAS f32x4*)(G2 + t * 16 + 4);
#pragma unroll
              for (int i = 0; i < 4; ++i) { Lm[t][i] = l0[i]; Lm[t][4 + i] = l1[i]; } }
#pragma unroll
          for (int t = 0; t < 8; ++t) { M[t][t] = 1.0f;
#pragma unroll
              for (int i = t - 1; i >= 0; --i) { float acc = 0.f;
#pragma unroll
                  for (int j = i; j < t; ++j) acc += Lm[t][j] * M[j][i];
                  M[t][i] = acc; } } }
        GAS float* rec = REC + ((size_t)bh * 1024 + blk) * REC_F;
#pragma unroll
        for (int t = 0; t < 8; ++t) { float acc = 0.f;
#pragma unroll
            for (int i = 0; i <= t; ++i) acc += M[t][i] * ah[i];
            rec[REC_AT + t * 64 + lane] = acc; }
        float Nm[8][8];
        { float Km[8][8];
#pragma unroll
          for (int t = 1; t < 8; ++t) { const f32x4 l0 = *(const LAS f32x4*)(G2 + t * 16 + 8), l1 = *(const LAS f32x4*)(G2 + t * 16 + 12);
#pragma unroll
              for (int i = 0; i < 4; ++i) { Km[t][i] = l0[i]; Km[t][4 + i] = l1[i]; } }
#pragma unroll
          for (int t = 0; t < 8; ++t)
#pragma unroll
              for (int i = 0; i < 8; ++i) { float acc = 0.f;
                  if (i < t) {
#pragma unroll
                      for (int j = i + 1; j <= t; ++j) acc += M[t][j] * Km[j][i]; }
                  Nm[t][i] = acc; } }
        float rb[8][8];
#pragma unroll
        for (int t = 0; t < 8; ++t) { const f32x4 l0 = *(const LAS f32x4*)(G2 + (8 + t) * 16), l1 = *(const LAS f32x4*)(G2 + (8 + t) * 16 + 4);
#pragma unroll
            for (int i = 0; i < 4; ++i) { rb[t][i] = l0[i]; rb[t][4 + i] = l1[i]; } }
#pragma unroll
        for (int t = 0; t < 8; ++t) { float acc = rh[t];
#pragma unroll
            for (int i = 0; i <= t; ++i) { float rm = 0.f;
#pragma unroll
                for (int j = i; j <= t; ++j) rm += rb[t][j] * M[j][i];
                acc += rm * ah[i]; }
            rec[REC_RT + t * 64 + lane] = acc; }
        float Qm[8][8];
#pragma unroll
        for (int t = 0; t < 8; ++t) { const f32x4 l0 = *(const LAS f32x4*)(G2 + (8 + t) * 16 + 8), l1 = *(const LAS f32x4*)(G2 + (8 + t) * 16 + 12);
#pragma unroll
            for (int i = 0; i < 8; ++i) { float acc = 0.f;
                if (i <= t) { acc = i < 4 ? l0[i & 3] : l1[i & 3];
#pragma unroll
                    for (int j = i + 1; j <= t; ++j) acc += rb[t][j] * Nm[j][i]; }
                Qm[t][i] = acc; } }
#pragma unroll
        for (int t = 0; t < 8; ++t) { rec[REC_BH + t * 64 + lane] = bch[t] * Pp[7]; rec[REC_KH + t * 64 + lane] = kch[t] * Pp[7]; }
        rec[REC_WC + lane] = Pp[7];
        if (lane == 0) {
#pragma unroll
            for (int t = 0; t < 8; ++t) { *(GAS f32x4*)(rec + REC_N + t * 8) = (f32x4){Nm[t][0], Nm[t][1], Nm[t][2], Nm[t][3]}; *(GAS f32x4*)(rec + REC_N + t * 8 + 4) = (f32x4){Nm[t][4], Nm[t][5], Nm[t][6], Nm[t][7]};
                *(GAS f32x4*)(rec + REC_Q + t * 8) = (f32x4){Qm[t][0], Qm[t][1], Qm[t][2], Qm[t][3]}; *(GAS f32x4*)(rec + REC_Q + t * 8 + 4) = (f32x4){Qm[t][4], Qm[t][5], Qm[t][6], Qm[t][7]}; } }
        *(GAS f32x4*)(rec + REC_V8 + lane * 8) = (f32x4){vv[0], vv[1], vv[2], vv[3]}; *(GAS f32x4*)(rec + REC_V8 + lane * 8 + 4) = (f32x4){vv[4], vv[5], vv[6], vv[7]};
        LDS_WAIT(); asm volatile("" ::: "memory");
    }
}

constexpr int SC_NS = 8, SC_RB = REC_F * 4, SC_SYNC = SC_NS * SC_RB;
template <int I> __device__ __forceinline__ float rowbc(float x) { return __builtin_bit_cast(float, __builtin_amdgcn_update_dpp(0, __builtin_bit_cast(int, x), 0x150 + I, 0xf, 0xf, false)); }
__device__ __forceinline__ unsigned lds_word(const volatile LAS unsigned* p) { return (unsigned)__builtin_amdgcn_readfirstlane((int)*p); }
__device__ __forceinline__ void r4_feeder(const Frame& F, const Args& a) {
    const int rb = F.vcu; if (rb >= 256) return;
    const int bh = rb >> 3;
    const GAS char* gsrc = (const GAS char*)(a.ws + WS_SCAN) + (size_t)bh * 1024 * SC_RB + F.lane * 16;
    LAS unsigned char* ring = F.lds;
    volatile LAS unsigned* sync = (volatile LAS unsigned*)(F.lds + SC_SYNC);
    bool dead = false;
#pragma unroll 1
    for (int B = 0; B < 1024; ++B) {
        if (B >= SC_NS && !dead) { unsigned spins = 0; for (;;) { const unsigned d0 = lds_word(sync + 16), d1 = lds_word(sync + 32); if ((int)(d0 < d1 ? d0 : d1) > B - SC_NS) break; if (++spins > (1u << 20)) { dead = true; break; } __builtin_amdgcn_s_sleep(2); } }
        LAS unsigned char* slot = ring + (B & (SC_NS - 1)) * SC_RB;
#pragma unroll
        for (int q = 0; q < 11; ++q) __builtin_amdgcn_global_load_lds((const GAS unsigned*)(gsrc + (size_t)B * SC_RB + q * 1024), (LAS unsigned*)(slot + q * 1024), 16, 0, 0);
        asm volatile("s_waitcnt vmcnt(55)" ::: "memory");
        if (B >= 5 && F.lane == 0) sync[0] = (unsigned)(B - 4);
    }
    asm volatile("s_waitcnt vmcnt(0)" ::: "memory");
    if (F.lane == 0) sync[0] = 1024u;
}
template <int VAR> __device__ __forceinline__ void r4_scan(const Frame& F, const Args& a) {
    float* YT = (float*)(a.ws + WS_XN);
    constexpr int RB = SC_RB;
    __builtin_amdgcn_s_setprio(3);
    const int rb = F.vcu;
    if (rb < 256) {
        const int row = rb * 8 + F.wave * 4 + (F.lane >> 4), j = F.lane & 15, vi = row & 63;
        const bool b3 = (j & 8) != 0, b2 = (j & 4) != 0, b1 = (j & 2) != 0, b0 = (j & 1) != 0;
        LAS unsigned char* ring = F.lds;
        volatile LAS unsigned* sync = (volatile LAS unsigned*)(F.lds + SC_SYNC);
        const LAS unsigned char* rdv = ring + j * 16;
        const LAS unsigned char* rdn = ring + REC_N * 4 + ((j & 7) * 8 + 4 * (j >> 3)) * 4;
        const LAS unsigned char* rd8 = ring + REC_V8 * 4 + vi * 32;
        unsigned have = 0; bool dead = (VAR == 1);
#define SC_NEED(n) do { unsigned spins_ = 0; while (have < (unsigned)(n) && !dead) { have = lds_word(sync); if (have >= (unsigned)(n)) break; if (++spins_ > (1u << 20)) { dead = true; break; } __builtin_amdgcn_s_sleep(1); } } while (0)
        f32x2 S01 = {0.f, 0.f}, S23 = {0.f, 0.f};
        GAS float* yrow = (GAS float*)YT + (size_t)row * SEQ;
#define SC_LDA(at_, so_) do { _Pragma("unroll") for (int t_ = 0; t_ < 8; ++t_) at_[t_] = *(const LAS f32x4*)(rdv + (so_) + REC_AT * 4 + t_ * 256); } while (0)
        f32x4 cat[8];
        SC_NEED(1); asm volatile("" ::: "memory");
        SC_LDA(cat, 0);
#pragma unroll 1
        for (int k0 = 0; k0 < 1024; k0 += SC_NS) {
#pragma unroll
            for (int u = 0; u < SC_NS; ++u) { const int so = u * RB, sn = ((u + 1) & (SC_NS - 1)) * RB;
                asm volatile("" : "+v"(cat[0]), "+v"(cat[1]), "+v"(cat[2]), "+v"(cat[3]), "+v"(cat[4]), "+v"(cat[5]), "+v"(cat[6]), "+v"(cat[7]));
                f32x4 crt[8];
#pragma unroll
                for (int t = 0; t < 8; ++t) crt[t] = *(const LAS f32x4*)(rdv + so + REC_RT * 4 + t * 256);
                f32x4 bhv[8], khv[8];
#pragma unroll
                for (int i = 0; i < 8; ++i) { bhv[i] = *(const LAS f32x4*)(rdv + so + REC_BH * 4 + i * 256); khv[i] = *(const LAS f32x4*)(rdv + so + REC_KH * 4 + i * 256); }
                f32x4 wcv = *(const LAS f32x4*)(rdv + so + REC_WC * 4);
                f32x4 cv0 = *(const LAS f32x4*)(rd8 + so), cv1 = *(const LAS f32x4*)(rd8 + so + 16), cnn = *(const LAS f32x4*)(rdn + so), cqq = *(const LAS f32x4*)(rdn + so + (REC_Q - REC_N) * 4);
                asm volatile("" ::: "memory");
                float d[16];
#pragma unroll
                for (int t = 0; t < 8; ++t) { const f32x4 at = cat[t]; f32x2 p = S01 * (f32x2){at[0], at[1]}; p = S23 * (f32x2){at[2], at[3]} + p; d[t] = p.x + p.y; }
#pragma unroll
                for (int t = 0; t < 8; ++t) { const f32x4 rt = crt[t]; f32x2 q = S01 * (f32x2){rt[0], rt[1]}; q = S23 * (f32x2){rt[2], rt[3]} + q; d[8 + t] = q.x + q.y; }
                float e[8], f[4], g[2];
#pragma unroll
                for (int i = 0; i < 8; ++i) { const float snd = b3 ? d[i] : d[8 + i], mine = b3 ? d[8 + i] : d[i]; e[i] = mine + dppf<0x128>(snd); }
#pragma unroll
                for (int i = 0; i < 4; ++i) { const float snd = b2 ? e[i] : e[4 + i], mine = b2 ? e[4 + i] : e[i]; f[i] = mine + dppf<0x141>(snd); }
#pragma unroll
                for (int i = 0; i < 2; ++i) { const float snd = b1 ? f[i] : f[2 + i], mine = b1 ? f[2 + i] : f[i]; g[i] = mine + dppf<0x4E>(snd); }
                float val; { const float snd = b0 ? g[0] : g[1], mine = b0 ? g[1] : g[0]; val = mine + dppf<0xB1>(snd); }
                const f32x4 v0 = cv0, v1 = cv1;
                const f32x4 vh = b3 ? v1 : v0;
                float nv = (cnn[0] * vh[0] + cnn[1] * vh[1]) + (cnn[2] * vh[2] + cnn[3] * vh[3]), qv = (cqq[0] * vh[0] + cqq[1] * vh[1]) + (cqq[2] * vh[2] + cqq[3] * vh[3]);
                nv += dppf<0x128>(nv); qv += dppf<0x128>(qv);
                val += b3 ? qv : nv;
                if (b3) yrow[(k0 + u) * 8 + (j - 8)] = val;
                asm volatile("" : "+v"(bhv[0]), "+v"(bhv[1]), "+v"(bhv[2]), "+v"(bhv[3]), "+v"(bhv[4]), "+v"(bhv[5]), "+v"(bhv[6]), "+v"(bhv[7]), "+v"(khv[0]), "+v"(khv[1]), "+v"(khv[2]), "+v"(khv[3]), "+v"(khv[4]), "+v"(khv[5]), "+v"(khv[6]), "+v"(khv[7]), "+v"(wcv), "+v"(cv0), "+v"(cv1));
                SC_NEED(k0 + u + 2 <= 1024 ? k0 + u + 2 : 1024); asm volatile("" ::: "memory");
                f32x4 nat[8];
                SC_LDA(nat, sn);
                asm volatile("" ::: "memory");
                const float sgv[8] = {rowbc<0>(val), rowbc<1>(val), rowbc<2>(val), rowbc<3>(val), rowbc<4>(val), rowbc<5>(val), rowbc<6>(val), rowbc<7>(val)};
                f32x2 T01 = {0.f, 0.f}, T23 = {0.f, 0.f}, U01 = {0.f, 0.f}, U23 = {0.f, 0.f};
#pragma unroll
                for (int i = 0; i < 8; ++i) { const float sg = sgv[i]; const float vi_ = i < 4 ? v0[i & 3] : v1[i & 3]; const f32x4 bh_ = bhv[i], kh_ = khv[i];
                    T01 = (f32x2){bh_[0], bh_[1]} * sg + T01; T23 = (f32x2){bh_[2], bh_[3]} * sg + T23;
                    U01 = (f32x2){kh_[0], kh_[1]} * vi_ + U01; U23 = (f32x2){kh_[2], kh_[3]} * vi_ + U23; }
                S01 = S01 * (f32x2){wcv[0], wcv[1]} + (T01 + U01); S23 = S23 * (f32x2){wcv[2], wcv[3]} + (T23 + U23);
                asm volatile("" : "+v"(S01), "+v"(S23) :: "memory");
                if (F.lane == 0) sync[16 * (F.wave + 1)] = (unsigned)(k0 + u + 1);
#pragma unroll
                for (int t = 0; t < 8; ++t) cat[t] = nat[t];
                }
        }
#undef SC_LDA
#undef SC_NEED
    }
    __builtin_amdgcn_s_setprio(0);
}

__device__ __forceinline__ void r5_finish(const Frame& F, const Args& a) {
    const float* YT = (const float*)(a.ws + WS_XN); const float* LO = (const float*)(a.ws + WS_LORAOUT); const bf16* P = (const bf16*)(a.ws + WS_P); const float* BON = (const float*)(a.ws + WS_BONUS);
    bf16* YA = (bf16*)(a.ws + WS_YABC);
    LAS float* scr = (LAS float*)(F.lds + F.wave * 16640);
    const int gw = F.vcu * NWAVES + F.wave, NGW = F.G * NWAVES;
    for (int it = gw; it < 32 * 128; it += NGW) {
        const int bh = it >> 7, tt = it & 127, t0 = tt * 64, b = bh >> 4, h = bh & 15;
        float y[64]; float s = 0.f;
#pragma unroll
        for (int v = 0; v < 64; ++v) { y[v] = YT[(size_t)(bh * 64 + v) * SEQ + t0 + F.lane]; s += y[v]; }
        const float mean = s * (1.f / 64.f); float q = 0.f;
#pragma unroll
        for (int v = 0; v < 64; ++v) { const float d = y[v] - mean; q += d * d; }
        const float rstd = 1.0f / sqrtf(q * (1.f / 64.f) + GN_EPS);
#pragma unroll
        for (int v = 0; v < 64; ++v) scr[F.lane * 65 + v] = (y[v] - mean) * rstd;
        LDS_WAIT(); asm volatile("" ::: "memory");
        const int c = h * 64 + F.lane; const float lw = inp(I_LNW)[c], lb = inp(I_LNB)[c], muv = inp(I_MU)[2048 + c];
        float pv = t0 > 0 ? bf1(P[(size_t)(b * SEQ + t0 - 1) * NP + 2048 + c]) : 0.f;
        for (int ti = 0; ti < 64; ++ti) { const int m = b * SEQ + t0 + ti;
            const float yn = scr[ti * 65 + F.lane];
            const float cv = bf1(P[(size_t)m * NP + 2048 + c]); const float vsh = cv + (pv - cv) * muv; pv = cv;
            const float o = (yn * lw + lb + BON[m * 16 + h] * vsh) * LO[(size_t)m * 3072 + 2048 + c];
            YA[(size_t)m * 3072 + c] = (bf16)f2bf(o); }
        LDS_WAIT(); asm volatile("" ::: "memory");
    }
}

__device__ __forceinline__ float gelu_tanh(float x) { const float u = 0.7978845608028654f * (x + 0.044715f * x * x * x); return 0.5f * x * (1.0f + fast_tanh(u)); }
template <int CTRL> __device__ __forceinline__ float dpp_keep(float old, float x) { return __builtin_bit_cast(float, __builtin_amdgcn_update_dpp(__builtin_bit_cast(int, old), __builtin_bit_cast(int, x), CTRL, 0xf, 0xf, false)); }
template <bool FINAL> __device__ __forceinline__ void lru_pass(const Frame& F, const Args& a, int w0 = 0) {
    const bf16* P = (const bf16*)(a.ws + WS_P); const bf16* LW = (const bf16*)(a.ws + WS_LW);
    float* CA = (float*)(a.ws + WS_LRUC); float* CB = CA + 256 * 1024; const float* HIN = CB + 256 * 1024;
    bf16* YB = (bf16*)(a.ws + WS_YABC) + 1024;
    const GAS float* lbr_p = (const GAS float*)inp(I_LBR); const GAS float* lbi_p = (const GAS float*)inp(I_LBI); const GAS float* spl_p = (const GAS float*)(a.ws + WS_SPL);
    const GAS float* cvb_p = (const GAS float*)inp(I_CONVB); const GAS float* cvw_p = (const GAS float*)inp(I_CONVW);
    const int gw = F.vcu * (NWAVES - w0) + (F.wave - w0), NGW = F.G * (NWAVES - w0), tq = F.lane & 15, kq = F.lane >> 4;
    for (int it = gw; it < 256 * 16; it += NGW) {
        const int tt = it >> 4, n = it & 15, m0 = tt * 64, cb = n * 64 + 4 * kq;
        const bool seq0 = (m0 % SEQ) == 0;
        float hcar[4][4];
        float aprod[4][4];
#pragma unroll
        for (int vb = 0; vb < 4; ++vb)
#pragma unroll
            for (int i = 0; i < 4; ++i) { hcar[vb][i] = FINAL ? HIN[tt * 1024 + cb + 16 * vb + i] : 0.f; aprod[vb][i] = 1.f; }
#pragma unroll 1
        for (int tb = 0; tb < 4; ++tb) {
            asm volatile("" ::: "memory");
            const int m = m0 + 16 * tb + tq, tseq = m % SEQ;
            f32x4 xc[4];
#pragma unroll
            for (int vb = 0; vb < 4; ++vb) { const int c = cb + 16 * vb; f32x4 acc = *(const GAS f32x4*)(cvb_p + c);
#pragma unroll
                for (int j = 0; j < 4; ++j) { if (tseq - j >= 0) { const v2u pw = *(const GAS v2u*)((const GAS bf16*)P + (size_t)(m - j) * NP + PC_LX + c); const f32x4 cw = *(const GAS f32x4*)(cvw_p + j * 1024 + c);
                        acc[0] += cw[0] * bflo(pw.x); acc[1] += cw[1] * bfhi(pw.x); acc[2] += cw[2] * bflo(pw.y); acc[3] += cw[3] * bfhi(pw.y); } }
                xc[vb] = acc; }
            bf16x8 bfrag[2];
#pragma unroll
            for (int ks = 0; ks < 2; ++ks) { v4u w; w.x = pk2(xc[2 * ks][0], xc[2 * ks][1]); w.y = pk2(xc[2 * ks][2], xc[2 * ks][3]); w.z = pk2(xc[2 * ks + 1][0], xc[2 * ks + 1][1]); w.w = pk2(xc[2 * ks + 1][2], xc[2 * ks + 1][3]); bfrag[ks] = __builtin_bit_cast(bf16x8, w); }
#pragma unroll
            for (int vb = 0; vb < 4; ++vb) {
                f32x4 gr = {0.f, 0.f, 0.f, 0.f}, gi = {0.f, 0.f, 0.f, 0.f};
#pragma unroll
                for (int ks = 0; ks < 2; ++ks) { const bf16x8 wr_ = *(const bf16x8*)(LW + ((((size_t)(0 * 16 + n) * 4 + vb) * 2 + ks) * 64 + F.lane) * 8); const bf16x8 wi_ = *(const bf16x8*)(LW + ((((size_t)(1 * 16 + n) * 4 + vb) * 2 + ks) * 64 + F.lane) * 8);
                    gr = __builtin_amdgcn_mfma_f32_16x16x32_bf16(wr_, bfrag[ks], gr, 0, 0, 0); gi = __builtin_amdgcn_mfma_f32_16x16x32_bf16(wi_, bfrag[ks], gi, 0, 0, 0); }
                const int c = cb + 16 * vb;
                const f32x4 brv = *(const GAS f32x4*)(lbr_p + c), biv = *(const GAS f32x4*)(lbi_p + c); const f32x4 spl = *(const GAS f32x4*)(spl_p + c);
                v2u pyw; if (FINAL) pyw = *(const v2u*)(P + (size_t)m * NP + PC_LY + c);
                float hout[4];
#pragma unroll
                for (int i = 0; i < 4; ++i) {
                    const float g_r = sigm(gr[i] + brv[i]), g_i = sigm(gi[i] + biv[i]);
                    const float log_a = -8.0f * g_r * spl[i];
                    float av = __expf(log_a); float mult = __builtin_amdgcn_sqrtf(fmaxf(1.0f - av * av, 0.f)); if (tseq == 0) mult = 1.0f;
                    float bv = mult * g_i * xc[vb][i];
                    { float pa = dpp_keep<0x111>(1.0f, av), pb = dpp_keep<0x111>(0.0f, bv); bv = av * pb + bv; av = av * pa; }
                    { float pa = dpp_keep<0x112>(1.0f, av), pb = dpp_keep<0x112>(0.0f, bv); bv = av * pb + bv; av = av * pa; }
                    { float pa = dpp_keep<0x114>(1.0f, av), pb = dpp_keep<0x114>(0.0f, bv); bv = av * pb + bv; av = av * pa; }
                    { float pa = dpp_keep<0x118>(1.0f, av), pb = dpp_keep<0x118>(0.0f, bv); bv = av * pb + bv; av = av * pa; }
                    const float hv = bv + av * hcar[vb][i];
                    const int l15 = (F.lane & 48) | 15;
                    const float hend = __shfl(hv, l15), aend = __shfl(av, l15);
                    hcar[vb][i] = hend; if (!FINAL) aprod[vb][i] *= aend; hout[i] = hv; }
                if (FINAL) { const float y0 = hout[0] * gelu_tanh(bflo(pyw.x)), y1 = hout[1] * gelu_tanh(bfhi(pyw.x)), y2 = hout[2] * gelu_tanh(bflo(pyw.y)), y3 = hout[3] * gelu_tanh(bfhi(pyw.y));
                    v2u w; w.x = pk2(y0, y1); w.y = pk2(y2, y3); *(v2u*)(YB + (size_t)m * 3072 + c) = w; }
            }
        }
        if (!FINAL && tq == 0) {
#pragma unroll
            for (int vb = 0; vb < 4; ++vb) { f32x4 pa, pb;
#pragma unroll
                for (int i = 0; i < 4; ++i) { pa[i] = aprod[vb][i]; pb[i] = hcar[vb][i]; }
                *(f32x4*)(CA + tt * 1024 + cb + 16 * vb) = pa; *(f32x4*)(CB + tt * 1024 + cb + 16 * vb) = pb; }
        }
        (void)seq0;
    }
}
__device__ __forceinline__ void lru_carry(const Frame& F, const Args& a) {
    const float* CA = (const float*)(a.ws + WS_LRUC); const float* CB = CA + 256 * 1024; float* HIN = (float*)CB + 256 * 1024;
    const int gt = F.vcu * (NWAVES * 64) + F.tid;
    if (gt < 2048) { const int b = gt >> 10, c = gt & 1023; float h = 0.f;
        for (int k = 0; k < 128; ++k) { const int tt = b * 128 + k; HIN[tt * 1024 + c] = h; h = CA[tt * 1024 + c] * h + CB[tt * 1024 + c]; } }
}

__device__ __forceinline__ void xattn_phase(const Frame& F, const Args& a, int w0 = 0) {
    const bf16* P = (const bf16*)(a.ws + WS_P); const bf16* KM = (const bf16*)(a.ws + WS_KMEM); const bf16* VT = (const bf16*)(a.ws + WS_VT);
    bf16* YC = (bf16*)(a.ws + WS_YABC) + 2048;
    const int gw = F.vcu * (NWAVES - w0) + (F.wave - w0), NGW = F.G * (NWAVES - w0), tq = F.lane & 15, kq = F.lane >> 4;
    for (int it = gw; it < 4 * 1024; it += NGW) {
        const int h = it >> 10, tg = it & 1023, m0 = tg * 16, b = m0 / SEQ;
        bf16x8 qf[8];
#pragma unroll
        for (int ks = 0; ks < 8; ++ks) qf[ks] = *(const bf16x8*)(P + (size_t)(m0 + tq) * NP + PC_Q + h * 256 + 32 * ks + 8 * kq);
        f32x4 s[16];
#pragma unroll
        for (int mb = 0; mb < 16; ++mb) { f32x4 acc = {0.f, 0.f, 0.f, 0.f}; const bf16* kp = KM + (size_t)(b * 256 + 16 * mb + tq) * 1024 + h * 256 + 8 * kq;
#pragma unroll
            for (int ks = 0; ks < 8; ++ks) acc = __builtin_amdgcn_mfma_f32_16x16x32_bf16(*(const bf16x8*)(kp + 32 * ks), qf[ks], acc, 0, 0, 0);
            s[mb] = acc; asm volatile("" ::: "memory"); }
        float mx = -3.0e38f;
#pragma unroll
        for (int mb = 0; mb < 16; ++mb) { s[mb] = s[mb] * 0.0625f; mx = fmaxf(mx, fmaxf(fmaxf(s[mb][0], s[mb][1]), fmaxf(s[mb][2], s[mb][3]))); }
        mx = fmaxf(mx, __shfl_xor(mx, 16)); mx = fmaxf(mx, __shfl_xor(mx, 32));
        float sum = 0.f;
#pragma unroll
        for (int mb = 0; mb < 16; ++mb) {
#pragma unroll
            for (int i = 0; i < 4; ++i) { s[mb][i] = __expf(s[mb][i] - mx); sum += s[mb][i]; } }
        sum += __shfl_xor(sum, 16); sum += __shfl_xor(sum, 32);
        const float inv = 1.0f / sum;
        bf16x8 pf[8];
#pragma unroll
        for (int ks = 0; ks < 8; ++ks) { v4u w; w.x = pk2(s[2 * ks][0] * inv, s[2 * ks][1] * inv); w.y = pk2(s[2 * ks][2] * inv, s[2 * ks][3] * inv); w.z = pk2(s[2 * ks + 1][0] * inv, s[2 * ks + 1][1] * inv); w.w = pk2(s[2 * ks + 1][2] * inv, s[2 * ks + 1][3] * inv); pf[ks] = __builtin_bit_cast(bf16x8, w); }
#pragma unroll
        for (int db = 0; db < 16; ++db) { f32x4 acc = {0.f, 0.f, 0.f, 0.f}; const bf16* vp = VT + ((size_t)((b * 4 + h) * 256 + 16 * db + tq)) * 256 + 8 * kq;
#pragma unroll
            for (int ks = 0; ks < 8; ++ks) acc = __builtin_amdgcn_mfma_f32_16x16x32_bf16(*(const bf16x8*)(vp + 32 * ks), pf[ks], acc, 0, 0, 0);
            v2u w; w.x = pk2(acc[0], acc[1]); w.y = pk2(acc[2], acc[3]);
            *(v2u*)(YC + (size_t)(m0 + tq) * 3072 + h * 256 + 16 * db + 4 * kq) = w; asm volatile("" ::: "memory"); }
    }
}

__device__ __forceinline__ void router_phase(const Frame& F, const Args& a) {
    const float* H1 = (const float*)(a.ws + WS_H1); bf16* XN2 = (bf16*)(a.ws + WS_XN); const bf16* WR = (const bf16*)(a.ws + WS_WR);
    int* pick_e = (int*)(a.ws + WS_PICK); int* pick_rank = pick_e + 65536; float* pick_gate = (float*)(pick_rank + 65536);
    unsigned* gcnt = (unsigned*)(a.ws + WS_CTL) + CW_CNT;
    LAS float* lg = (LAS float*)(F.lds + F.wave * 4096);
    LAS unsigned* lcnt = (LAS unsigned*)(F.lds + 65536);
    const int tq = F.lane & 15, kq = F.lane >> 4;
    for (int g0 = F.vcu * 4; g0 < 1024; g0 += F.G * 4) {
        if (F.tid < 64) lcnt[F.tid] = 0u;
        __syncthreads();
        int me = 0, mrank = 0; float mgate = 0.f; int e4[4]; float g4[4]; int r4[4];
        const int m0 = (g0 + F.wave) * 16;
        if (F.wave < 4) {
            float myr = 0.f;
            for (int j = 0; j < 16; ++j) { const GAS f32x4* xr = (const GAS f32x4*)(H1 + (size_t)(m0 + j) * D) + F.lane; float s = 0.f;
#pragma unroll
                for (int q = 0; q < 8; ++q) { const f32x4 v = xr[64 * q]; s += (v.x * v.x + v.y * v.y) + (v.z * v.z + v.w * v.w); }
                const float rs = 1.0f / sqrtf(wave_sum(s) * (1.f / D) + EPS); if (tq == j) myr = rs; }
            f32x4 acc[2] = {{0.f, 0.f, 0.f, 0.f}, {0.f, 0.f, 0.f, 0.f}};
            const float* hrow = H1 + (size_t)(m0 + tq) * D + 8 * kq; const float* grow = inp(I_GFFN) + 8 * kq; bf16* xrow = XN2 + (size_t)(m0 + tq) * D + 8 * kq;
            for (int ks = 0; ks < 64; ++ks) {
                const f32x4 x0 = *(const f32x4*)(hrow + 32 * ks), x1 = *(const f32x4*)(hrow + 32 * ks + 4), g0v = *(const f32x4*)(grow + 32 * ks), g1v = *(const f32x4*)(grow + 32 * ks + 4);
                v4u w; w.x = pk2(x0[0] * myr * g0v[0], x0[1] * myr * g0v[1]); w.y = pk2(x0[2] * myr * g0v[2], x0[3] * myr * g0v[3]); w.z = pk2(x1[0] * myr * g1v[0], x1[1] * myr * g1v[1]); w.w = pk2(x1[2] * myr * g1v[2], x1[3] * myr * g1v[3]);
                *(v4u*)(xrow + 32 * ks) = w; const bf16x8 af = __builtin_bit_cast(bf16x8, w);
#pragma unroll
                for (int eh = 0; eh < 2; ++eh) { const bf16* wp = WR + (size_t)(16 * eh + tq) * D + 32 * ks + 8 * kq;
                    acc[eh] = __builtin_amdgcn_mfma_f32_16x16x32_bf16(af, *(const bf16x8*)wp, acc[eh], 0, 0, 0);
                    acc[eh] = __builtin_amdgcn_mfma_f32_16x16x32_bf16(af, *(const bf16x8*)(wp + 32 * D), acc[eh], 0, 0, 0); } }
#pragma unroll
            for (int eh = 0; eh < 2; ++eh)
#pragma unroll
                for (int i = 0; i < 4; ++i) lg[(4 * kq + i) * 33 + 16 * eh + tq] = acc[eh][i] + inp(I_BROUTER)[16 * eh + tq];
            LDS_WAIT(); asm volatile("" ::: "memory");
            if (F.lane < 16) { float v[32];
#pragma unroll
                for (int e = 0; e < 32; ++e) v[e] = lg[F.lane * 33 + e];
                float tv[4];
#pragma unroll
                for (int k = 0; k < 4; ++k) { float best = -3.0e38f; int bi = 0;
#pragma unroll
                    for (int e = 0; e < 32; ++e) { if (v[e] > best) { best = v[e]; bi = e; } }
                    tv[k] = best; e4[k] = bi;
#pragma unroll
                    for (int e = 0; e < 32; ++e) { if (e == bi) v[e] = -3.0e38f; } }
                float den = 0.f;
#pragma unroll
                for (int k = 0; k < 4; ++k) { g4[k] = __expf(tv[k] - tv[0]); den += g4[k]; }
#pragma unroll
                for (int k = 0; k < 4; ++k) { g4[k] = g4[k] / den; r4[k] = (int)atomicAdd((unsigned*)&lcnt[e4[k]], 1u); } }
        }
        __syncthreads();
        if (F.tid < 32) lcnt[32 + F.tid] = atomicAdd(&gcnt[F.tid], lcnt[F.tid]);
        __syncthreads();
        if (F.wave < 4 && F.lane < 16) {
#pragma unroll
            for (int k = 0; k < 4; ++k) { const int pi = (m0 + F.lane) * 4 + k; pick_e[pi] = e4[k]; pick_rank[pi] = (int)lcnt[32 + e4[k]] + r4[k]; pick_gate[pi] = g4[k]; } }
        __syncthreads();
        (void)me; (void)mrank; (void)mgate;
    }
}

__device__ __forceinline__ void scatter_phase(const Frame& F, const Args& a) {
    const int* pick_e = (const int*)(a.ws + WS_PICK); const int* pick_rank = pick_e + 65536; const float* pick_gate = (const float*)(pick_rank + 65536); int* pos = (int*)(pick_gate + 65536);
    float* gate_of_row = (float*)(a.ws + WS_ROWTAB); int* tok_of_row = (int*)(a.ws + WS_ROWTAB + 512 * 1024 + 8192);
    unsigned* ctl = (unsigned*)(a.ws + WS_CTL);
    LAS int* pst = (LAS int*)(F.lds);
    if (F.tid == 0) { int acc = 0; for (int e = 0; e < NE; ++e) { pst[e] = acc; const int c = (int)ctl[CW_CNT + e]; pst[32 + e] = c; const int nt = (c + 255) >> 8;
            if (blockIdx.x == 0) for (int k = 0; k < nt; ++k) ctl[CW_TILEE + (acc >> 8) + k] = (unsigned)e;
            acc += nt << 8; }
        if (blockIdx.x == 0) ctl[CW_NTILES] = (unsigned)(acc >> 8); }
    __syncthreads();
    const int gt = F.vcu * (NWAVES * 64) + F.tid, NGT = F.G * NWAVES * 64;
    for (int pi = gt; pi < 65536; pi += NGT) { const int e = pick_e[pi], row = pst[e] + pick_rank[pi]; pos[pi] = row; gate_of_row[row] = pick_gate[pi]; tok_of_row[row] = pi >> 2; }
    if (blockIdx.x == 0) for (int e = 0; e < NE; ++e) { const int r0 = pst[e] + pst[32 + e], r1 = pst[e] + (((pst[32 + e] + 255) >> 8) << 8);
        for (int r = r0 + F.tid; r < r1; r += NWAVES * 64) { tok_of_row[r] = 0; gate_of_row[r] = 0.f; } }
}

__device__ __forceinline__ void final_phase(const Frame& F, const Args& a) {
    const float* H1 = (const float*)(a.ws + WS_H1); const bf16* OR = (const bf16*)(a.ws + WS_OROW);
    const int* pos = (const int*)(a.ws + WS_PICK) + 3 * 65536;
    const int gw = F.vcu * NWAVES + F.wave, NGW = F.G * NWAVES;
    for (int m = gw; m < T; m += NGW) {
        const GAS f32x4* xr = (const GAS f32x4*)(H1 + (size_t)m * D) + F.lane; const GAS f32x4* gr = (const GAS f32x4*)inp(I_GFINAL) + F.lane;
        f32x4 v[8];
#pragma unroll
        for (int j = 0; j < 8; ++j) v[j] = xr[64 * j];
#pragma unroll
        for (int k = 0; k < 4; ++k) { const int row = pos[m * 4 + k]; const GAS v2u* orp = (const GAS v2u*)(OR + (size_t)row * D) + F.lane;
#pragma unroll
            for (int j = 0; j < 8; ++j) { const v2u w = orp[64 * j]; v[j].x += bflo(w.x); v[j].y += bfhi(w.x); v[j].z += bflo(w.y); v[j].w += bfhi(w.y); } }
        float s = 0.f;
#pragma unroll
        for (int j = 0; j < 8; ++j) s += (v[j].x * v[j].x + v[j].y * v[j].y) + (v[j].z * v[j].z + v[j].w * v[j].w);
        const float rstd = 1.0f / sqrtf(wave_sum(s) * (1.f / D) + EPS);
        GAS f32x4* o = (GAS f32x4*)(a.out + (size_t)m * D) + F.lane;
#pragma unroll
        for (int j = 0; j < 8; ++j) { const f32x4 g = gr[64 * j]; o[64 * j] = (f32x4){v[j].x * rstd * g.x, v[j].y * rstd * g.y, v[j].z * rstd * g.z, v[j].w * rstd * g.w}; }
    }
}

#ifndef MK_N_LAUNCHES
#define MK_N_LAUNCHES 1
#endif
constexpr int NPH = 14;
__global__ void __launch_bounds__(NWAVES * 64, 2) fwd(Args args) {
    extern __shared__ __attribute__((aligned(16))) unsigned char lds[];
#define NEWFRAME() Frame F; { int tz = threadIdx.x; asm volatile("" : "+v"(tz)); F.lds = (LAS unsigned char*)lds; F.MISC = (volatile LAS unsigned*)(F.lds + MISC_OFF); F.tid = tz; F.lane = tz & 63; F.wave = __builtin_amdgcn_readfirstlane(tz >> 6); \
        F.G = gridDim.x; const int bx = blockIdx.x; F.vcu = (F.G % 8 == 0) ? (bx % 8) * (F.G / 8) + bx / 8 : bx; }
    unsigned char* ws = args.ws;
    unsigned* ctl = (unsigned*)(ws + WS_CTL);
    for (int u = threadIdx.x; u < (LDS_BYTES - MISC_OFF) / 4; u += NWAVES * 64) ((LAS unsigned*)((LAS unsigned char*)lds + MISC_OFF))[u] = 0u;
    __syncthreads();
    const int lo = args.ph_lo, hi = args.ph_hi;
    XcdBarrier bar; bar.bar = ctl + CW_BAR; bar.x = 0; bar.st = nullptr;
    if (hi - lo > 1) bar = xcd_barrier_post(ctl + CW_BAR, (volatile LAS unsigned*)((LAS unsigned char*)lds + MISC_OFF) + 8);
#ifndef PHMASK
#define PHMASK 0xFFFF
#endif
#define IN(k) (((PHMASK >> (k)) & 1) && lo <= (k) && (k) < hi)
#define SEAM(k) do { if (IN(k) && IN((k) + 1)) xcd_barrier(bar); } while (0)

    if (IN(0)) { NEWFRAME(); p0_prologue(F, args); } SEAM(0);
    if (IN(1)) { NEWFRAME();
        { pg8::Gemm g{(const bf16*)(ws + WS_XN), (const bf16*)(ws + WS_WIN), T, NP, D}; pg8::StaticOrder S; S.init(T, NP, F.G, (int)blockIdx.x);
          pg8::EpiBf16<0> E{(bf16*)(ws + WS_P), NP, nullptr, 0, 0, 1.f};
          pg8::gemm_phase<pg8::EpiBf16<0>, pg8::StaticOrder, true, true>(F.lds, g, S, E); }
        __syncthreads();
        { pg8::Gemm g{(const bf16*)(ws + WS_MN), (const bf16*)(ws + WS_WMKV), 512, 2048, D}; pg8::StaticOrder S; S.init(512, 2048, F.G, (int)((blockIdx.x + F.G / 2) % F.G));
          pg8::EpiKV E{(bf16*)(ws + WS_KMEM), (bf16*)(ws + WS_VT)};
          pg8::gemm_phase<pg8::EpiKV, pg8::StaticOrder, true, true>(F.lds, g, S, E); }
    } SEAM(1);
    if (IN(2)) { NEWFRAME();
#ifndef NO_R1
 r1_lora_in(F, args);
#endif
#ifndef NO_LRU
 lru_pass<false>(F, args);
#endif
 } SEAM(2);
    if (IN(3)) { NEWFRAME();
        lru_carry(F, args);
        { pg8::Gemm g{(const bf16*)(ws + WS_XN), (const bf16*)(ws + WS_WLORA), T, 3072, LORA_K}; pg8::StaticOrder S; S.init(T, 3072, F.G, (int)blockIdx.x);
          pg8::EpiF32 E{(float*)(ws + WS_LORAOUT), 3072};
          pg8::gemm_phase<pg8::EpiF32, pg8::StaticOrder, true, true>(F.lds, g, S, E); }
    } SEAM(3);
    if (IN(4)) { NEWFRAME(); r3_blocks(F, args); } SEAM(4);
    if (IN(5)) { NEWFRAME();
#ifndef NO_SCAN
 if (F.tid < 64) ((LAS unsigned*)(F.lds + SC_SYNC))[F.tid] = 0u; __syncthreads();
 if (F.wave < 2) r4_scan<0>(F, args); else if (F.wave == 2) r4_feeder(F, args);
#endif
#ifndef NO_CONV
 if (F.wave >= 3) { moe_weight_convert(F, args, 3); xattn_phase(F, args, 3); lru_pass<true>(F, args, 3); }
#endif
 } SEAM(5);
    if (IN(6)) { NEWFRAME(); r5_finish(F, args); } SEAM(6);
    if (IN(7)) { NEWFRAME();
        pg8::Gemm g{(const bf16*)(ws + WS_YABC), (const bf16*)(ws + WS_WBR), T, 2048, 3072}; pg8::StaticOrder S; S.init(T, 2048, F.G, (int)blockIdx.x);
        pg8::EpiBranch2 E{(const bf16*)(ws + WS_P), NP, PC_G, (bf16*)(ws + WS_MERGED)};
        pg8::gemm_phase<pg8::EpiBranch2, pg8::StaticOrder, true, true>(F.lds, g, S, E);
    } SEAM(7);
    if (IN(8)) { NEWFRAME();
        pg8::Gemm g{(const bf16*)(ws + WS_MERGED), (const bf16*)(ws + WS_WO), T, D, D}; pg8::StaticOrder S; S.init(T, D, F.G, (int)blockIdx.x);
        pg8::EpiRes E{inp(I_X), (float*)(ws + WS_H1), D};
        pg8::gemm_phase<pg8::EpiRes, pg8::StaticOrder, true, true>(F.lds, g, S, E);
    } SEAM(8);
    if (IN(9)) { NEWFRAME(); router_phase(F, args); } SEAM(9);
    if (IN(10)) { NEWFRAME(); scatter_phase(F, args); } SEAM(10);
    if (IN(11)) { NEWFRAME();
        const int ntiles = (int)__hip_atomic_load(ctl + CW_NTILES, __ATOMIC_RELAXED, __HIP_MEMORY_SCOPE_AGENT);
        pg8::Gemm g{(const bf16*)(ws + WS_XN), (const bf16*)(ws + WS_WGU), ntiles * 256, NE * 4096, D}; pg8::MoeOrder<true> S; S.init(ntiles, 16, F.G, (int)blockIdx.x, (const int*)(ctl + CW_TILEE), (const int*)(ws + WS_ROWTAB + 512 * 1024 + 8192));
        pg8::EpiSwiglu E{(bf16*)(ws + WS_HH), inp(I_BGATE), inp(I_BUP)};
        pg8::gemm_phase<pg8::EpiSwiglu, pg8::MoeOrder<true>, true, true>(F.lds, g, S, E);
    } SEAM(11);
    if (IN(12)) { NEWFRAME();
        const int ntiles = (int)__hip_atomic_load(ctl + CW_NTILES, __ATOMIC_RELAXED, __HIP_MEMORY_SCOPE_AGENT);
        pg8::Gemm g{(const bf16*)(ws + WS_HH), (const bf16*)(ws + WS_WD), ntiles * 256, NE * 2048, D}; pg8::MoeOrder<false> S; S.init(ntiles, 8, F.G, (int)blockIdx.x, (const int*)(ctl + CW_TILEE), nullptr);
        pg8::EpiDown E{(bf16*)(ws + WS_OROW), inp(I_BDOWN), (const float*)(ws + WS_ROWTAB)};
        pg8::gemm_phase<pg8::EpiDown, pg8::MoeOrder<false>, true, true>(F.lds, g, S, E);
    } SEAM(12);
    if (IN(13)) { NEWFRAME(); final_phase(F, args); }
#ifdef PROBE_EXTRA_PHASE
    if (lo == 14) { NEWFRAME(); if (F.tid < 64) ((LAS unsigned*)(F.lds + SC_SYNC))[F.tid] = 0u; __syncthreads(); if (F.wave < 2) r4_scan<0>(F, args); else if (F.wave == 2) r4_feeder(F, args); }
    if (lo == 17) { NEWFRAME(); if (F.wave < 2) r4_scan<1>(F, args); }
    if (lo == 15) { NEWFRAME(); if (F.wave >= 3) moe_weight_convert(F, args, 3); }
    if (lo == 16) { NEWFRAME(); moe_weight_convert(F, args, 0); }
#endif
#undef IN
#undef SEAM
}

extern "C" void kernel_launch(void* const* d_in, const int* in_sizes, int n_in, void* d_out, int out_size, void* d_ws, size_t ws_size, hipStream_t stream) {
    static int grid = 0;
    if (grid == 0) {
        if (n_in != 39 || out_size != T * D || ws_size < WS_END) { fprintf(stderr, "kernel_launch: built for 39 inputs, out of %d floats, >= %zu bytes of workspace; got n_in %d, out %d, ws %zu; nothing launched\n", T * D, (size_t)WS_END, n_in, out_size, ws_size); grid = -1; return; }
        int dev = 0, cus = 0, per_cu = 0;
        if (hipGetDevice(&dev) != hipSuccess || hipDeviceGetAttribute(&cus, hipDeviceAttributeMultiprocessorCount, dev) != hipSuccess) { fprintf(stderr, "kernel_launch: device query failed\n"); grid = -1; return; }
        if (hipFuncSetAttribute((const void*)fwd, hipFuncAttributeMaxDynamicSharedMemorySize, LDS_BYTES) != hipSuccess) { fprintf(stderr, "kernel_launch: hipFuncSetAttribute failed\n"); grid = -1; return; }
        if (hipOccupancyMaxActiveBlocksPerMultiprocessor(&per_cu, (const void*)fwd, NWAVES * 64, LDS_BYTES) != hipSuccess || per_cu < 1)
            fprintf(stderr, "kernel_launch: note: occupancy query reports %d workgroups per CU\n", per_cu);
        (void)hipGetLastError();
        grid = cus;
    }
    if (grid < 0) return;
    (void)in_sizes;
    if (hipMemsetAsync((char*)d_ws + WS_CTL, 0, CTL_ZERO_BYTES, stream) != hipSuccess) { fprintf(stderr, "kernel_launch: hipMemsetAsync failed\n"); return; }
    Args a{};
    for (int i = 0; i < 39; ++i) a.in[i] = (const float*)d_in[i];
    a.out = (float*)d_out; a.ws = (unsigned char*)d_ws;
#if MK_N_LAUNCHES == 1
    a.ph_lo = 0; a.ph_hi = NPH;
    hipLaunchKernelGGL(fwd, dim3(grid), dim3(NWAVES * 64), LDS_BYTES, stream, a);
#else
    for (int k = 0; k < NPH; ++k) { a.ph_lo = k; a.ph_hi = k + 1; int reps = 1;
#ifdef PROBE_REP_PHASE
        if (k == PROBE_REP_PHASE) reps = 1 + PROBE_REP_N;
#endif
        for (int r = 0; r < reps; ++r) hipLaunchKernelGGL(fwd, dim3(grid), dim3(NWAVES * 64), LDS_BYTES, stream, a); }
#ifdef PROBE_EXTRA_PHASE
    for (int r = 0; r < PROBE_REP_N; ++r) { a.ph_lo = PROBE_EXTRA_PHASE; a.ph_hi = PROBE_EXTRA_PHASE + 1; hipLaunchKernelGGL(fwd, dim3(grid), dim3(NWAVES * 64), LDS_BYTES, stream, a); }
#endif
#endif
    const hipError_t le = hipPeekAtLastError();
    if (le != hipSuccess) fprintf(stderr, "kernel_launch: launch failed: %s\n", hipGetErrorName(le));
}
```

```cpp
#include <hip/hip_runtime.h>
#include <cstdio>
#include <cstdint>
namespace pg8 {
#define PG8_LAS __attribute__((address_space(3)))
typedef unsigned short bf16_t;
typedef short bf16x8 __attribute__((ext_vector_type(8)));
typedef float f32x4 __attribute__((ext_vector_type(4)));
typedef unsigned u32x4 __attribute__((ext_vector_type(4)));
constexpr int BM = 256, BK = 64, HALF = 128, HTB = HALF * BK * 2  , STAGE_BYTES = 8 * HTB, NXCD = 8, WGM = 8;

__host__ __device__ __forceinline__ int lds_byte(int r, int c) { const int st = (r >> 4) * 2 + (c >> 5), rr = r & 15, cc = c & 31, ob = rr * 64 + cc * 2; return st * 1024 + (ob ^ (((ob >> 9) & 1) << 5)); }
__host__ __device__ __forceinline__ void stage_rc(int b, int& R, int& C) { const int st = b / 1024, sb = b % 1024, swz = sb ^ (((sb >> 9) & 1) << 5); R = (st >> 1) * 16 + swz / 64; C = (st & 1) * 32 + (swz % 64) / 2; }
__host__ __device__ __forceinline__ int perm32(int rho) { const int n = rho >> 4, i = rho & 15; return 8 * (i >> 2) + 4 * n + (i & 3); }

struct Unit { int pm, pn; };
struct Gemm { const bf16_t* A; const bf16_t* Bt; int M, N, K; };

struct StaticOrder {
    static constexpr bool GATHER = false; __device__ __forceinline__ int arow(const Unit&, int) const { return 0; }
    int nM, nN, nwg, G, c;
    __host__ __device__ void init(int M, int N, int G_, int c_) { nM = M / BM; nN = N / BM; nwg = nM * nN; G = G_; c = c_; }
    __host__ __device__ bool next(int i, Unit& u) const {
        const long L = (long)i * G + c; if (L >= nwg) return false;
        int wgid = (int)L; { const int q = nwg / NXCD, r = nwg % NXCD, xcd = wgid % NXCD, off = wgid / NXCD; wgid = (xcd < r ? xcd * (q + 1) : r * (q + 1) + (xcd - r) * q) + off; }
        const int nig = WGM * nN, gid = wgid / nig, fm = gid * WGM, gsz = (nM - fm) < WGM ? (nM - fm) : WGM;
        u.pm = fm + ((wgid % nig) % gsz); u.pn = (wgid % nig) / gsz; return true;
    }
    __device__ __forceinline__ void a_ready(const Unit&) const {}
    __device__ __forceinline__ void done(const Unit&) const {}
};
__device__ __forceinline__ unsigned cvt_pk_bf16(float lo, float hi) { unsigned r; asm volatile("v_cvt_pk_bf16_f32 %0, %1, %2" : "=v"(r) : "v"(lo), "v"(hi)); return r; }
typedef float f32x2 __attribute__((ext_vector_type(2)));
__device__ __forceinline__ f32x2 gelu_pk(f32x2 v) {
    const f32x2 av = __builtin_elementwise_abs(v), d = av * 0.2316418882f + 1.0f;
    f32x2 t; t.x = __builtin_amdgcn_rcpf(d.x); t.y = __builtin_amdgcn_rcpf(d.y);
    f32x2 q = t * 0.5307027145f + (-0.7265760135f); q = q * t + 0.7107068705f; q = q * t + (-0.142248368f); q = q * t + 0.127414796f; q = q * t;
    const f32x2 s = (v * v) * (-0.72134752044f);
    f32x2 e; e.x = __builtin_amdgcn_exp2f(s.x); e.y = __builtin_amdgcn_exp2f(s.y);
    const f32x2 m = v * (q * e), r = v - m;
    f32x2 o; o.x = v.x < 0.f ? m.x : r.x; o.y = v.y < 0.f ? m.y : r.y; return o;
}

template <int ACT  > struct EpiBf16 {
    static constexpr bool PERM = true, AFTER_DRAIN = false; static constexpr int MIDK = 0; static_assert(ACT == 0 || ACT == 1, "EpiBf16: ACT is 0 (none) or 1 (gelu_pk)");
    bf16_t* O; int ldc; const float* bias; int split_cols; size_t split_stride; float scale0;
    __device__ __forceinline__ void operator()(const f32x4 (&acc)[2][2][4][2], const Unit& u, int wr, int wc, int fr, int fq) const {
        const int row0 = u.pm * BM + wr * 64 + fr; int colt = u.pn * BM; bf16_t* base = O;
        float sc = 1.f; if (split_cols) { const int t = colt / split_cols; base += (size_t)t * split_stride; colt -= t * split_cols; if (t == 0) sc = scale0; }
        const int col0 = colt + wc * 32 + 8 * fq, bcol0 = u.pn * BM + wc * 32 + 8 * fq;
        f32x4 bv[2][2];
#pragma unroll
        for (int bj = 0; bj < 2; ++bj)
#pragma unroll
            for (int n = 0; n < 2; ++n) bv[bj][n] = bias ? *(const f32x4*)(bias + bcol0 + bj * HALF + 4 * n) : (f32x4){0.f, 0.f, 0.f, 0.f};
#pragma unroll
        for (int ai = 0; ai < 2; ++ai)
#pragma unroll
            for (int m = 0; m < 4; ++m) { bf16_t* rowp = base + (size_t)(row0 + ai * HALF + m * 16) * ldc + col0;
#pragma unroll
                for (int bj = 0; bj < 2; ++bj) { f32x4 v0 = acc[ai][bj][m][0] + bv[bj][0], v1 = acc[ai][bj][m][1] + bv[bj][1];
                    if (ACT == 1) { f32x2 a = gelu_pk((f32x2){v0[0], v0[1]}), b = gelu_pk((f32x2){v0[2], v0[3]}), c = gelu_pk((f32x2){v1[0], v1[1]}), d = gelu_pk((f32x2){v1[2], v1[3]});
                        v0 = (f32x4){a.x, a.y, b.x, b.y}; v1 = (f32x4){c.x, c.y, d.x, d.y}; }
                    v0 = v0 * sc; v1 = v1 * sc; u32x4 w; w.x = cvt_pk_bf16(v0[0], v0[1]); w.y = cvt_pk_bf16(v0[2], v0[3]); w.z = cvt_pk_bf16(v1[0], v1[1]); w.w = cvt_pk_bf16(v1[2], v1[3]);
                    *(u32x4*)(rowp + bj * HALF) = w; } }
    }
};

__device__ __forceinline__ float bf_lo(unsigned w) { return __builtin_bit_cast(float, w << 16); }
__device__ __forceinline__ float bf_hi(unsigned w) { return __builtin_bit_cast(float, w & 0xffff0000u); }
__device__ __forceinline__ float fsigmoid(float x) { return __builtin_amdgcn_rcpf(1.0f + __expf(-x)); }
typedef unsigned u32x2 __attribute__((ext_vector_type(2)));

struct EpiF32 {
    static constexpr bool PERM = false, AFTER_DRAIN = false; static constexpr int MIDK = 0;
    float* C; int ldc;
    __device__ __forceinline__ void operator()(const f32x4 (&acc)[2][2][4][2], const Unit& u, int wr, int wc, int fr, int fq) const {
        const int row0 = u.pm * BM + wr * 64 + fr, col0 = u.pn * BM + wc * 32 + 4 * fq;
#pragma unroll
        for (int ai = 0; ai < 2; ++ai)
#pragma unroll
            for (int m = 0; m < 4; ++m) { float* rowp = C + (size_t)(row0 + ai * HALF + m * 16) * ldc + col0;
#pragma unroll
                for (int bj = 0; bj < 2; ++bj)
#pragma unroll
                    for (int n = 0; n < 2; ++n) *(f32x4*)(rowp + bj * HALF + n * 16) = acc[ai][bj][m][n]; }
    }
};
struct EpiRes {
    static constexpr bool PERM = false, AFTER_DRAIN = false; static constexpr int MIDK = 0;
    const float* X; float* C; int ldc;
    __device__ __forceinline__ void operator()(const f32x4 (&acc)[2][2][4][2], const Unit& u, int wr, int wc, int fr, int fq) const {
        const int row0 = u.pm * BM + wr * 64 + fr, col0 = u.pn * BM + wc * 32 + 4 * fq;
#pragma unroll
        for (int ai = 0; ai < 2; ++ai)
#pragma unroll
            for (int m = 0; m < 4; ++m) { const size_t off = (size_t)(row0 + ai * HALF + m * 16) * ldc + col0;
#pragma unroll
                for (int bj = 0; bj < 2; ++bj)
#pragma unroll
                    for (int n = 0; n < 2; ++n) { const f32x4 xv = *(const f32x4*)(X + off + bj * HALF + n * 16); *(f32x4*)(C + off + bj * HALF + n * 16) = acc[ai][bj][m][n] + xv; }
                asm volatile("" ::: "memory"); }
    }
};
struct EpiKV {
    static constexpr bool PERM = false, AFTER_DRAIN = false; static constexpr int MIDK = 0;
    bf16_t* Kb; bf16_t* VT;
    __device__ __forceinline__ void operator()(const f32x4 (&acc)[2][2][4][2], const Unit& u, int wr, int wc, int fr, int fq) const {
        const int row0 = u.pm * BM + wr * 64 + fr, col0 = u.pn * BM + wc * 32 + 4 * fq;
#pragma unroll
        for (int ai = 0; ai < 2; ++ai)
#pragma unroll
            for (int m = 0; m < 4; ++m) { const int r = row0 + ai * HALF + m * 16;
#pragma unroll
                for (int bj = 0; bj < 2; ++bj)
#pragma unroll
                    for (int n = 0; n < 2; ++n) { const f32x4 v = acc[ai][bj][m][n]; const int c = col0 + bj * HALF + n * 16;
                        if (u.pn < 4) { u32x2 w; w.x = cvt_pk_bf16(v[0], v[1]); w.y = cvt_pk_bf16(v[2], v[3]); *(u32x2*)(Kb + (size_t)r * 1024 + c) = w; }
                        else { const int cc = c - 1024, h = cc >> 8, d = cc & 255, b = r >> 8, mm = r & 255;
                            const int idx = (mm >> 5) * 32 + ((mm >> 2) & 3) * 8 + ((mm >> 4) & 1) * 4 + (mm & 3);
                            bf16_t* o = VT + ((size_t)((b * 4 + h) * 256 + d)) * 256 + idx;
                            const unsigned w0 = cvt_pk_bf16(v[0], v[1]), w1 = cvt_pk_bf16(v[2], v[3]);
                            o[0] = (bf16_t)(w0 & 0xffffu); o[256] = (bf16_t)(w0 >> 16); o[512] = (bf16_t)(w1 & 0xffffu); o[768] = (bf16_t)(w1 >> 16); } } }
    }
};
struct EpiBranch {
    static constexpr bool PERM = false, AFTER_DRAIN = false; static constexpr int MIDK = 0;
    const bf16_t* P; int ldp; int gcol0; float* macc; bf16_t* merged;
    __device__ __forceinline__ void operator()(const f32x4 (&acc)[2][2][4][2], const Unit& u, int wr, int wc, int fr, int fq) const {
        const int br = u.pm >> 6, pm = u.pm & 63, pn = u.pn & 7;
        const int row0 = pm * BM + wr * 64 + fr, col0 = pn * BM + wc * 32 + 4 * fq;
#pragma unroll
        for (int ai = 0; ai < 2; ++ai)
#pragma unroll
            for (int m = 0; m < 4; ++m) { const int r = row0 + ai * HALF + m * 16; const bf16_t* prow = P + (size_t)r * ldp + gcol0 + br * 2048;
#pragma unroll
                for (int bj = 0; bj < 2; ++bj)
#pragma unroll
                    for (int n = 0; n < 2; ++n) { const int c = col0 + bj * HALF + n * 16; const u32x2 gw = *(const u32x2*)(prow + c);
                        f32x4 g; g[0] = fsigmoid(bf_lo(gw.x)); g[1] = fsigmoid(bf_hi(gw.x)); g[2] = fsigmoid(bf_lo(gw.y)); g[3] = fsigmoid(bf_hi(gw.y));
                        f32x4 v = acc[ai][bj][m][n] * g; float* mp = macc + (size_t)r * 2048 + c;
                        if (br > 0) v = v + *(const f32x4*)mp;
                        if (br < 2) *(f32x4*)mp = v;
                        else { u32x2 w; w.x = cvt_pk_bf16(v[0], v[1]); w.y = cvt_pk_bf16(v[2], v[3]); *(u32x2*)(merged + (size_t)r * 2048 + c) = w; } }
                asm volatile("" ::: "memory"); }
    }
};
struct EpiSwiglu {
    static constexpr bool PERM = true, AFTER_DRAIN = false; static constexpr int MIDK = 0;
    bf16_t* H; const float* bg; const float* bu;
    __device__ __forceinline__ void operator()(const f32x4 (&acc)[2][2][4][2], const Unit& u, int wr, int wc, int fr, int fq) const {
        const int e = u.pn >> 4, ct = u.pn & 15;
        const int row0 = u.pm * BM + wr * 64 + fr, col0 = ct * 128 + wc * 32 + 8 * fq;
        f32x4 bgv[2], buv[2];
#pragma unroll
        for (int n = 0; n < 2; ++n) { bgv[n] = *(const f32x4*)(bg + (size_t)e * 2048 + col0 + 4 * n); buv[n] = *(const f32x4*)(bu + (size_t)e * 2048 + col0 + 4 * n); }
#pragma unroll
        for (int ai = 0; ai < 2; ++ai)
#pragma unroll
            for (int m = 0; m < 4; ++m) { bf16_t* rowp = H + (size_t)(row0 + ai * HALF + m * 16) * 2048 + col0;
                f32x4 o[2];
#pragma unroll
                for (int n = 0; n < 2; ++n) { const f32x4 g = acc[ai][0][m][n] + bgv[n], up = acc[ai][1][m][n] + buv[n];
#pragma unroll
                    for (int j = 0; j < 4; ++j) { const float hg = fminf(g[j], 7.0f), hu = fminf(fmaxf(up[j], -7.0f), 7.0f); o[n][j] = (hu + 1.0f) * hg * fsigmoid(1.702f * hg); } }
                u32x4 w; w.x = cvt_pk_bf16(o[0][0], o[0][1]); w.y = cvt_pk_bf16(o[0][2], o[0][3]); w.z = cvt_pk_bf16(o[1][0], o[1][1]); w.w = cvt_pk_bf16(o[1][2], o[1][3]);
                *(u32x4*)rowp = w; }
    }
};
struct EpiDown {
    static constexpr bool PERM = true, AFTER_DRAIN = false; static constexpr int MIDK = 0;
    bf16_t* O; const float* bd; const float* rowgate;
    __device__ __forceinline__ void operator()(const f32x4 (&acc)[2][2][4][2], const Unit& u, int wr, int wc, int fr, int fq) const {
        const int e = u.pn >> 3, ct = u.pn & 7;
        const int row0 = u.pm * BM + wr * 64 + fr, col0 = ct * BM + wc * 32 + 8 * fq;
        f32x4 bv[2][2];
#pragma unroll
        for (int bj = 0; bj < 2; ++bj)
#pragma unroll
            for (int n = 0; n < 2; ++n) bv[bj][n] = *(const f32x4*)(bd + (size_t)e * 2048 + col0 + bj * HALF + 4 * n);
#pragma unroll
        for (int ai = 0; ai < 2; ++ai)
#pragma unroll
            for (int m = 0; m < 4; ++m) { const int r = row0 + ai * HALF + m * 16; const float gs = rowgate[r]; bf16_t* rowp = O + (size_t)r * 2048 + col0;
#pragma unroll
                for (int bj = 0; bj < 2; ++bj) { const f32x4 v0 = (acc[ai][bj][m][0] + bv[bj][0]) * gs, v1 = (acc[ai][bj][m][1] + bv[bj][1]) * gs;
                    u32x4 w; w.x = cvt_pk_bf16(v0[0], v0[1]); w.y = cvt_pk_bf16(v0[2], v0[3]); w.z = cvt_pk_bf16(v1[0], v1[1]); w.w = cvt_pk_bf16(v1[2], v1[3]);
                    *(u32x4*)(rowp + bj * HALF) = w; } }
    }
};

struct EpiBranch2 {
    static constexpr bool PERM = false, AFTER_DRAIN = false; static constexpr int MIDK = 16;
    const bf16_t* P; int ldp; int gcol0; bf16_t* merged;
    __device__ __forceinline__ void mid(f32x4 (&acc)[2][2][4][2], const Unit& u, int which, int, int, int, int) const {
        int tz = threadIdx.x; asm volatile("" : "+v"(tz));
        const int wid_ = tz >> 6, lane_ = tz & 63, wr = wid_ >> 2, wc = wid_ & 3, fr = lane_ & 15, fq = lane_ >> 4;
        const int row0 = u.pm * BM + wr * 64 + fr, col0 = u.pn * BM + wc * 32 + 4 * fq;
#pragma unroll
        for (int ai = 0; ai < 2; ++ai)
#pragma unroll
            for (int m = 0; m < 4; ++m) { const bf16_t* prow = P + (size_t)(row0 + ai * HALF + m * 16) * ldp + gcol0 + (which - 1) * 2048;
#pragma unroll
                for (int bj = 0; bj < 2; ++bj)
#pragma unroll
                    for (int n = 0; n < 2; ++n) { const int c = col0 + bj * HALF + n * 16; const u32x2 ga = *(const u32x2*)(prow + c), gb = *(const u32x2*)(prow + 2048 + c);
                        const float a_[4] = {bf_lo(ga.x), bf_hi(ga.x), bf_lo(ga.y), bf_hi(ga.y)}, b_[4] = {bf_lo(gb.x), bf_hi(gb.x), bf_lo(gb.y), bf_hi(gb.y)};
#pragma unroll
                        for (int j = 0; j < 4; ++j) { const float ea = __expf(-fminf(fmaxf(a_[j], -30.f), 30.f)), eb = __expf(-fminf(fmaxf(b_[j], -30.f), 30.f));
                            acc[ai][bj][m][n][j] *= (1.0f + eb) * __builtin_amdgcn_rcpf(1.0f + ea); } }
                asm volatile("" ::: "memory"); }
    }
    __device__ __forceinline__ void operator()(const f32x4 (&acc)[2][2][4][2], const Unit& u, int wr, int wc, int fr, int fq) const {
        const int row0 = u.pm * BM + wr * 64 + fr, col0 = u.pn * BM + wc * 32 + 4 * fq;
#pragma unroll
        for (int ai = 0; ai < 2; ++ai)
#pragma unroll
            for (int m = 0; m < 4; ++m) { const int r = row0 + ai * HALF + m * 16; const bf16_t* prow = P + (size_t)r * ldp + gcol0 + 2 * 2048;
#pragma unroll
                for (int bj = 0; bj < 2; ++bj)
#pragma unroll
                    for (int n = 0; n < 2; ++n) { const int c = col0 + bj * HALF + n * 16; const u32x2 gw = *(const u32x2*)(prow + c);
                        const float g_[4] = {bf_lo(gw.x), bf_hi(gw.x), bf_lo(gw.y), bf_hi(gw.y)}; f32x4 v = acc[ai][bj][m][n];
#pragma unroll
                        for (int j = 0; j < 4; ++j) v[j] *= __builtin_amdgcn_rcpf(1.0f + __expf(-fminf(fmaxf(g_[j], -30.f), 30.f)));
                        u32x2 w; w.x = cvt_pk_bf16(v[0], v[1]); w.y = cvt_pk_bf16(v[2], v[3]); *(u32x2*)(merged + (size_t)r * 2048 + c) = w; }
                asm volatile("" ::: "memory"); }
    }
};
struct BranchOrder {                              static constexpr bool GATHER = false; __device__ __forceinline__ int arow(const Unit&, int) const { return 0; }
    StaticOrder so;
    __device__ void init(int G_, int c_) { so.init(16384, 2048, G_, c_); }
    __device__ bool next(int i, Unit& u) const { const int br = i % 3; Unit t; if (!so.next(i / 3, t)) return false; u.pm = br * 64 + t.pm; u.pn = br * 8 + t.pn; return true; }
    __device__ __forceinline__ void a_ready(const Unit&) const {}
    __device__ __forceinline__ void done(const Unit&) const {}
};
template <bool GATH> struct MoeOrder {
    static constexpr bool GATHER = GATH;
    StaticOrder so; const int* tile_e; const int* tok; int nN;
    __device__ void init(int ntiles, int nN_, int G_, int c_, const int* te, const int* tk) { so.init(ntiles * BM, nN_ * BM, G_, c_); tile_e = te; tok = tk; nN = nN_; }
    __device__ bool next(int i, Unit& u) const { Unit t; if (!so.next(i, t)) return false; u.pm = t.pm; u.pn = tile_e[t.pm] * nN + t.pn; return true; }
    __device__ __forceinline__ int arow(const Unit& u, int r) const { return tok[u.pm * BM + r]; }
    __device__ __forceinline__ void a_ready(const Unit&) const {}
    __device__ __forceinline__ void done(const Unit&) const {}
};
template <class Epi, class Sched, bool ALIGN_EPI = false, bool SP2 = false>
__device__ __forceinline__ void gemm_phase(PG8_LAS unsigned char* lds, const Gemm g, const Sched& S, const Epi& E) {
    const int tid = threadIdx.x, wid = __builtin_amdgcn_readfirstlane(tid >> 6), lane = tid & 63, wr = wid >> 2, wc = wid & 3, fr = lane & 15, fq = lane >> 4;
    const int K = g.K, nt = K / BK;
    unsigned voffA[2], voffB[2];
#pragma unroll
    for (int i = 0; i < 2; ++i) { int R, C; stage_rc(tid * 16 + i * 8192, R, C); const int Rb = Epi::PERM ? ((R & ~31) + perm32(R & 31)) : R;
        voffA[i] = (unsigned)(R * K + C) * 2u; voffB[i] = (unsigned)(Rb * K + C) * 2u; }
    unsigned vc[2][2] = {{0u, 0u}, {0u, 0u}}, vn[2][2] = {{0u, 0u}, {0u, 0u}};
#define PG8_ROWS(dst, un) do { if constexpr (Sched::GATHER) { _Pragma("unroll") for (int _h = 0; _h < 2; ++_h) _Pragma("unroll") for (int _i = 0; _i < 2; ++_i) { int R_, C_; stage_rc(tid * 16 + _i * 8192, R_, C_); \
        dst[_h][_i] = (unsigned)(S.arow(un, _h * HALF + R_) * K + C_) * 2u; } } } while (0)
#define PG8_STAGE_A(bufoff, abase, half, nx) do { if constexpr (Sched::GATHER) { unsigned vo_[2]; vo_[0] = (nx) ? vn[half][0] : vc[half][0]; vo_[1] = (nx) ? vn[half][1] : vc[half][1]; PG8_STAGE(bufoff, abase, vo_); } \
        else { PG8_STAGE(bufoff, (abase) + (half) * hstep, voffA); } } while (0)
    const size_t kstep = (size_t)(BK * 2);
    const size_t hstep = (size_t)HALF * K * 2;
    const size_t tstep = 2 * hstep;
    const unsigned ldsw = (unsigned)wid * 1024u;
    const int aoff = lds_byte(wr * 64 + fr, fq * 8), boff = lds_byte(wc * 32 + fr, fq * 8);
#define PG8_SA(b, h) (((b) * 2 + (h)) * HTB)
#define PG8_SB(b, h) ((4 + (b) * 2 + (h)) * HTB)
#define PG8_STAGE(bufoff, gbase, voff) do { _Pragma("unroll") for (int _i = 0; _i < 2; ++_i) \
        __builtin_amdgcn_global_load_lds((const unsigned*)((const char*)(gbase) + (voff)[_i]), (PG8_LAS unsigned*)(lds + (bufoff) + ldsw + _i * 8192), 16, 0, 0); } while (0)
#define PG8_LDA(dst, b, h) do { _Pragma("unroll") for (int m = 0; m < 4; ++m) _Pragma("unroll") for (int k = 0; k < 2; ++k) dst[m][k] = *(const PG8_LAS bf16x8*)(lds + PG8_SA(b, h) + aoff + m * 2048 + k * 1024); } while (0)
#define PG8_LDB(dst, b, h) do { _Pragma("unroll") for (int n = 0; n < 2; ++n) _Pragma("unroll") for (int k = 0; k < 2; ++k) dst[n][k] = *(const PG8_LAS bf16x8*)(lds + PG8_SB(b, h) + boff + n * 2048 + k * 1024); } while (0)
#define PG8_MMA(ai, bj, At, Bt) do { __builtin_amdgcn_s_setprio(1); _Pragma("unroll") for (int m = 0; m < 4; ++m) _Pragma("unroll") for (int n = 0; n < 2; ++n) _Pragma("unroll") for (int k = 0; k < 2; ++k) \
        acc[ai][bj][m][n] = __builtin_amdgcn_mfma_f32_16x16x32_bf16(Bt[n][k], At[m][k], acc[ai][bj][m][n], 0, 0, 0); __builtin_amdgcn_s_setprio(0); } while (0)
#define PG8_WAIT_V(n) asm volatile("s_waitcnt vmcnt(" #n ")" ::: "memory")
#define PG8_WAIT_L(n) asm volatile("s_waitcnt lgkmcnt(" #n ")" ::: "memory")
#define PG8_BAR __builtin_amdgcn_s_barrier()
#define PG8_SCHED __builtin_amdgcn_sched_barrier(0)
    Unit cur, nxt; int ui = 0;
    if (!S.next(0, cur)) return;
    f32x4 acc[2][2][4][2];
#pragma unroll
    for (int a = 0; a < 2; ++a)
#pragma unroll
        for (int b = 0; b < 2; ++b)
#pragma unroll
            for (int m = 0; m < 4; ++m)
#pragma unroll
                for (int n = 0; n < 2; ++n) acc[a][b][m][n] = (f32x4){0.f, 0.f, 0.f, 0.f};
    bf16x8 At[4][2], B0[2][2], B1[2][2];
    const char* cA = (const char*)g.A + (Sched::GATHER ? (size_t)0 : (size_t)cur.pm * tstep); const char* cB = (const char*)g.Bt + (size_t)cur.pn * tstep;
    PG8_ROWS(vc, cur);
    S.a_ready(cur);
    if constexpr (SP2) {
        PG8_STAGE(PG8_SB(0, 0), cB, voffB); PG8_STAGE(PG8_SB(0, 1), cB + hstep, voffB); PG8_STAGE_A(PG8_SA(0, 0), cA, 0, false); PG8_STAGE_A(PG8_SA(0, 1), cA, 1, false);
        if (wr == 1) PG8_BAR;
        PG8_WAIT_V(2); PG8_BAR;
        PG8_STAGE(PG8_SB(1, 0), cB + kstep, voffB); PG8_STAGE_A(PG8_SA(1, 0), cA + kstep, 0, false); PG8_STAGE(PG8_SB(1, 1), cB + hstep + kstep, voffB);
        PG8_WAIT_V(6); PG8_BAR;
    } else {
        PG8_STAGE(PG8_SB(0, 0), cB, voffB); PG8_STAGE_A(PG8_SA(0, 0), cA, 0, false); PG8_STAGE(PG8_SB(0, 1), cB + hstep, voffB); PG8_STAGE_A(PG8_SA(0, 1), cA, 1, false);
        if (wr == 1) PG8_BAR;
        PG8_WAIT_V(4); PG8_BAR;
        PG8_STAGE(PG8_SB(1, 0), cB + kstep, voffB); PG8_STAGE_A(PG8_SA(1, 0), cA + kstep, 0, false); PG8_STAGE(PG8_SB(1, 1), cB + hstep + kstep, voffB);
        PG8_WAIT_V(6); PG8_BAR;
    }
    for (;;) {
        const bool has_next = S.next(ui + 1, nxt);
        if (has_next) PG8_ROWS(vn, nxt);
        const char* nA = (has_next && !Sched::GATHER) ? (const char*)g.A + (size_t)nxt.pm * tstep : cA; const char* nB = has_next ? (const char*)g.Bt + (size_t)nxt.pn * tstep : cB;
        for (int t = 0; t < nt; t += 2) {
            const bool last = (t == nt - 2);
            const char* a1 = cA + (size_t)(t + 1) * kstep;
            const char* a2 = last ? nA : cA + (size_t)(t + 2) * kstep; const char* b2 = last ? nB : cB + (size_t)(t + 2) * kstep;
            const char* a3 = a2 + kstep; const char* b3 = b2 + kstep;
            if (last && has_next) S.a_ready(nxt);
            if constexpr (Epi::MIDK > 0) { if (t == Epi::MIDK || t == 2 * Epi::MIDK) E.mid(acc, cur, t / Epi::MIDK, wr, wc, fr, fq); }
            if constexpr (SP2) {
            PG8_LDB(B0, 0, 0); PG8_LDB(B1, 0, 1); PG8_SCHED; PG8_LDA(At, 0, 0); PG8_STAGE_A(PG8_SA(1, 1), a1, 1, false);
            PG8_WAIT_V(8); PG8_WAIT_L(0); PG8_BAR; PG8_MMA(0, 0, At, B0); PG8_MMA(0, 1, At, B1); PG8_BAR; PG8_SCHED;
            PG8_LDA(At, 0, 1); PG8_STAGE(PG8_SB(0, 0), b2, voffB); PG8_STAGE(PG8_SB(0, 1), b2 + hstep, voffB); PG8_STAGE_A(PG8_SA(0, 0), a2, 0, last);
            PG8_WAIT_V(8); PG8_WAIT_L(0); PG8_BAR; PG8_MMA(1, 0, At, B0); PG8_MMA(1, 1, At, B1); PG8_BAR; PG8_SCHED;
            PG8_LDB(B0, 1, 0); PG8_LDB(B1, 1, 1); PG8_SCHED; PG8_LDA(At, 1, 0); PG8_STAGE_A(PG8_SA(0, 1), a2, 1, last);
            PG8_WAIT_V(8); PG8_WAIT_L(0); PG8_BAR; PG8_MMA(0, 0, At, B0); PG8_MMA(0, 1, At, B1); PG8_BAR; PG8_SCHED;
            PG8_LDA(At, 1, 1); PG8_STAGE(PG8_SB(1, 0), b3, voffB); PG8_STAGE(PG8_SB(1, 1), b3 + hstep, voffB); PG8_STAGE_A(PG8_SA(1, 0), a3, 0, last);
            PG8_WAIT_V(8); PG8_WAIT_L(0); PG8_BAR; PG8_MMA(1, 0, At, B0); PG8_MMA(1, 1, At, B1); PG8_BAR; PG8_SCHED;
            } else {
            PG8_LDB(B0, 0, 0); PG8_SCHED; PG8_LDA(At, 0, 0); PG8_STAGE_A(PG8_SA(1, 1), a1, 1, false);
            PG8_WAIT_L(8); PG8_BAR; PG8_WAIT_L(0); PG8_MMA(0, 0, At, B0); PG8_BAR; PG8_SCHED;
            PG8_LDB(B1, 0, 1); PG8_STAGE(PG8_SB(0, 0), b2, voffB);
            PG8_BAR; PG8_WAIT_L(0); PG8_MMA(0, 1, At, B1); PG8_BAR;
            PG8_LDA(At, 0, 1); PG8_STAGE_A(PG8_SA(0, 0), a2, 0, last);
            PG8_BAR; PG8_WAIT_L(0); PG8_MMA(1, 0, At, B0); PG8_BAR; PG8_SCHED;
            PG8_STAGE(PG8_SB(0, 1), b2 + hstep, voffB);
            PG8_WAIT_V(6); PG8_BAR; PG8_MMA(1, 1, At, B1); PG8_BAR;
            PG8_LDB(B0, 1, 0); PG8_SCHED; PG8_LDA(At, 1, 0); PG8_STAGE_A(PG8_SA(0, 1), a2, 1, last);
            PG8_WAIT_L(8); PG8_BAR; PG8_WAIT_L(0); PG8_MMA(0, 0, At, B0); PG8_BAR; PG8_SCHED;
            PG8_LDB(B1, 1, 1); PG8_STAGE(PG8_SB(1, 0), b3, voffB);
            PG8_BAR; PG8_WAIT_L(0); PG8_MMA(0, 1, At, B1); PG8_BAR;
            PG8_LDA(At, 1, 1); PG8_STAGE_A(PG8_SA(1, 0), a3, 0, last);
            PG8_BAR; PG8_WAIT_L(0); PG8_MMA(1, 0, At, B0); PG8_BAR; PG8_SCHED;
            PG8_STAGE(PG8_SB(1, 1), b3 + hstep, voffB);
            PG8_WAIT_V(6); PG8_BAR; PG8_MMA(1, 1, At, B1); PG8_BAR;
            }
        }
        if constexpr (ALIGN_EPI) { if (wr == 0) PG8_BAR; }
        if constexpr (!Epi::AFTER_DRAIN) { E(acc, cur, wr, wc, fr, fq); S.done(cur); }
        if (!has_next) break;
#pragma unroll
        for (int a = 0; a < 2; ++a)
#pragma unroll
            for (int b = 0; b < 2; ++b)
#pragma unroll
                for (int m = 0; m < 4; ++m)
#pragma unroll
                    for (int n = 0; n < 2; ++n) acc[a][b][m][n] = (f32x4){0.f, 0.f, 0.f, 0.f};
        cur = nxt; cA = nA; cB = nB; ++ui;
        if constexpr (Sched::GATHER) { vc[0][0] = vn[0][0]; vc[0][1] = vn[0][1]; vc[1][0] = vn[1][0]; vc[1][1] = vn[1][1]; }
        if constexpr (ALIGN_EPI) { if (wr == 1) PG8_BAR; }
    }
    PG8_WAIT_V(0);
    if constexpr (!ALIGN_EPI) { if (wr == 0) PG8_BAR; }
    PG8_BAR;
    if constexpr (Epi::AFTER_DRAIN) { E.fused(acc, cur, wr, wc, fr, fq, lds, wid, lane); S.done(cur); }
#undef PG8_SA
#undef PG8_SB
#undef PG8_STAGE
#undef PG8_STAGE_A
#undef PG8_ROWS
#undef PG8_LDA
#undef PG8_LDB
#undef PG8_MMA
#undef PG8_WAIT_V
#undef PG8_WAIT_L
#undef PG8_BAR
#undef PG8_SCHED
}
}

constexpr int NWAVES = 8;
constexpr int BATCH = 2, SEQ = 8192, T = BATCH * SEQ, D = 2048;
constexpr int RWKV_COLS = 3360, IN_COLS = 12576;
constexpr int NP = 12800;
constexpr int PC_LX = 3584, PC_LY = 4608, PC_Q = 5632, PC_G = 6656;
constexpr int NE = 32, MAXROWS = 65536 + NE * 256;
constexpr int LORA_K = 384;
constexpr float EPS = 1e-6f, GN_EPS = 64e-5f;

constexpr size_t MiB = 1u << 20;
constexpr size_t WS_CTL = 0, CTL_ZERO_BYTES = 1 * MiB;
constexpr size_t WS_WIN = 1 * MiB, WS_WMKV = 51 * MiB, WS_WLORA = 59 * MiB, WS_WBR = 62 * MiB, WS_WO = 74 * MiB, WS_WR = 82 * MiB, WS_LW = 83 * MiB;
constexpr size_t WS_WGU = 84 * MiB, WS_WD = 596 * MiB;
constexpr size_t WS_XN = 852 * MiB;
constexpr size_t WS_P = 916 * MiB;
constexpr size_t WS_LORAOUT = 1316 * MiB;
constexpr size_t WS_SCAN = 1508 * MiB;
constexpr size_t WS_YABC = 1892 * MiB;
constexpr size_t WS_MISC = 1988 * MiB;
constexpr size_t WS_MN = WS_MISC, WS_KMEM = WS_MISC + 2 * MiB, WS_VT = WS_MISC + 3 * MiB, WS_LRUC = WS_MISC + 4 * MiB  , WS_BONUS = WS_MISC + 7 * MiB;
constexpr size_t WS_PICK = WS_MISC + 8 * MiB  , WS_ROWTAB = WS_MISC + 9 * MiB  , WS_SPL = WS_ROWTAB + 512 * 1024  ;
constexpr size_t WS_END = 2000 * MiB;
constexpr size_t WS_MACC = WS_LORAOUT, WS_MERGED = 1444 * MiB, WS_H1 = WS_SCAN, WS_XS = WS_P, WS_OROW = WS_P, WS_HH = 1204 * MiB;
constexpr int CW_BAR = 4096, CW_CNT = 8192, CW_NTILES = 8192 + 64, CW_TILEE = 8192 + 128;

constexpr int LDS_BYTES = 147456;
constexpr int MISC_OFF = 143360;

#define GAS __attribute__((address_space(1)))
#define LAS __attribute__((address_space(3)))
typedef unsigned short bf16;
typedef unsigned v4u __attribute__((ext_vector_type(4)));
typedef unsigned v2u __attribute__((ext_vector_type(2)));
typedef float f32x4 __attribute__((ext_vector_type(4)));
typedef float f32x2 __attribute__((ext_vector_type(2)));
typedef short bf16x8 __attribute__((ext_vector_type(8)));
#define LDS_WAIT() asm volatile("s_waitcnt lgkmcnt(0)" ::: "memory")
#define VM_WAIT() asm volatile("s_waitcnt vmcnt(0)" ::: "memory")
__device__ __forceinline__ unsigned f2bf(float f) { unsigned u = __builtin_bit_cast(unsigned, f); return (u + 0x7fffu + ((u >> 16) & 1u)) >> 16; }
__device__ __forceinline__ unsigned pk2(float lo, float hi) { return f2bf(lo) | (f2bf(hi) << 16); }
__device__ __forceinline__ float bflo(unsigned w) { return __builtin_bit_cast(float, w << 16); }
__device__ __forceinline__ float bfhi(unsigned w) { return __builtin_bit_cast(float, w & 0xffff0000u); }
__device__ __forceinline__ float bf1(bf16 b) { return __builtin_bit_cast(float, (unsigned)b << 16); }
__device__ __forceinline__ float sigm(float x) { return __builtin_amdgcn_rcpf(1.0f + __expf(-x)); }
__device__ __forceinline__ float fast_tanh(float x) { const float e = __expf(2.0f * x); return 1.0f - 2.0f * __builtin_amdgcn_rcpf(e + 1.0f); }
__device__ __forceinline__ float softplusf(float x) { return fmaxf(x, 0.f) + log1pf(__expf(-fabsf(x))); }
__device__ __forceinline__ float wave_sum(float v) {
#pragma unroll
    for (int o = 1; o < 64; o <<= 1) v += __shfl_xor(v, o);
    return v;
}
template <int CTRL> __device__ __forceinline__ float dppf(float x) { return __builtin_bit_cast(float, __builtin_amdgcn_mov_dpp(__builtin_bit_cast(int, x), CTRL, 0xf, 0xf, true)); }
__device__ __forceinline__ float row16_sum(float v) {
    v += dppf<0xB1>(v); v += dppf<0x4E>(v); v += dppf<0x141>(v); v += dppf<0x140>(v); return v;
}
#define XB_TMO      128
#define XB_XCNT(j)  (256  + 64 * (j))
#define XB_XSUB(j)  (1280 + 64 * (j))
#define XB_XGEN(j)  (2304 + 64 * (j))
#define XB_TOP      3328
#define XB_TOPGEN   3392
#define XCD_BAR_WORDS 3456
#define XB_SPIN_CAP (1u << 18)

__device__ __forceinline__ unsigned xb_ld(unsigned* p)              { return __hip_atomic_load(p, __ATOMIC_RELAXED, __HIP_MEMORY_SCOPE_AGENT); }
__device__ __forceinline__ unsigned xb_add(unsigned* p, unsigned v) { return __hip_atomic_fetch_add(p, v, __ATOMIC_RELAXED, __HIP_MEMORY_SCOPE_AGENT); }
__device__ __forceinline__ unsigned xb_xcc_id() { return (unsigned)__builtin_amdgcn_s_getreg((3 << 11) | 20) & 0xFu; }
#define XB_SPIN(cond, bar) do { unsigned _sp = 0; while (cond) { __builtin_amdgcn_s_sleep(1); \
    if ((++_sp & 255u) == 0u) { if (xb_ld(&(bar)[XB_TMO])) break; if (_sp > XB_SPIN_CAP) { atomicAdd(&(bar)[XB_TMO], 1u); break; } } } } while (0)

struct XcdBarrier {
    unsigned* bar; unsigned x;
    volatile LAS unsigned* st;
};

__device__ __forceinline__ XcdBarrier xcd_barrier_post(unsigned* bar, volatile LAS unsigned* st) {
    XcdBarrier b; b.bar = bar; b.x = xb_xcc_id(); b.st = st;
    if (threadIdx.x == 0) (void)xb_add(&bar[XB_XCNT(b.x)], 1u);
    return b;
}
__device__ __forceinline__ void xcd_barrier_complete(unsigned* bar, unsigned x, unsigned& nloc, unsigned& nx) {
    const unsigned G = gridDim.x * gridDim.y * gridDim.z;
    unsigned sum, cnt, mine, sp = 0u;
    for (;;) {
        sum = 0u; cnt = 0u; mine = 0u;
#pragma unroll
        for (unsigned j = 0; j < 16; ++j) { const unsigned c = xb_ld(&bar[XB_XCNT(j)]); sum += c; cnt += (c > 0u) ? 1u : 0u; mine = (j == x) ? c : mine; }
        if (sum == G) break;
        __builtin_amdgcn_s_sleep(1);
        if ((++sp & 255u) == 0u) { if (xb_ld(&bar[XB_TMO])) break; if (sp > XB_SPIN_CAP) { atomicAdd(&bar[XB_TMO], 1u); break; } }
    }
    nloc = mine > 0u ? mine : 1u; nx = cnt > 0u ? cnt : 1u;
}

__device__ __forceinline__ void xcd_barrier(const XcdBarrier& b) {
    asm volatile("s_waitcnt vmcnt(0)" ::: "memory");
    __syncthreads();
    if (threadIdx.x == 0) {
        unsigned* bar = b.bar;
        __builtin_amdgcn_s_waitcnt(0);
        unsigned nloc = b.st[0], nx = b.st[1];
        if (nloc == 0u) { xcd_barrier_complete(bar, b.x, nloc, nx); b.st[0] = nloc; b.st[1] = nx; }
        const unsigned old = xb_add(&bar[XB_XSUB(b.x)], 1u);
        const unsigned gen = old / nloc;
        if (old + 1u == (gen + 1u) * nloc) {
            __builtin_amdgcn_fence(__ATOMIC_RELEASE, "agent");
            asm volatile("s_waitcnt vmcnt(0)" ::: "memory");
            const unsigned og = xb_add(&bar[XB_TOP], 1u);
            const unsigned tg = og / nx;
            if (og + 1u == (tg + 1u) * nx) xb_add(&bar[XB_TOPGEN], 1u);
            else XB_SPIN(xb_ld(&bar[XB_TOPGEN]) == tg, bar);
            __builtin_amdgcn_fence(__ATOMIC_ACQUIRE, "agent");
            xb_add(&bar[XB_XGEN(b.x)], 1u);
            asm volatile("s_waitcnt vmcnt(0)" ::: "memory");
        } else {
            XB_SPIN(xb_ld(&bar[XB_XGEN(b.x)]) == gen, bar);
            __builtin_amdgcn_fence(__ATOMIC_ACQUIRE, "agent");
            asm volatile("s_waitcnt vmcnt(0)" ::: "memory");
        }
    }
    __syncthreads();
}

struct Frame {
    LAS unsigned char* lds;
    volatile LAS unsigned* MISC;
    int tid, lane, wave, vcu, G;
};
struct Args { const float* in[39]; float* out; unsigned char* ws; int ph_lo, ph_hi; };
enum { I_X = 0, I_MEM, I_GMIX, I_WIN, I_MU, I_W0, I_W2, I_A0, I_A2, I_G2, I_KK, I_KA, I_RK, I_LNW, I_LNB, I_WRO, I_CONVW, I_CONVB, I_LWR, I_LBR, I_LWI, I_LBI, I_LAM, I_WLO,
       I_GMEM, I_WMK, I_WMV, I_WXO, I_WOUT, I_GFFN, I_WROUTER, I_BROUTER, I_WGATE, I_BGATE, I_WUP, I_BUP, I_WDOWN, I_BDOWN, I_GFINAL };


__device__ __forceinline__ const float* inp(int k) {
    typedef const volatile unsigned long long __attribute__((address_space(4))) ka_t;
    ka_t* ka = (ka_t*)__builtin_amdgcn_kernarg_segment_ptr();
    return (const float*)ka[k];
}
template <int NB> __device__ __forceinline__ void transpose_item(const float* W, int N, int k0, int n0, bf16* WT, int Kd, int drow0, int lane, int kdo = 0) {
    constexpr int LPR = NB / 4, G = 64 / LPR, KR = 64 / G;
    const int g = lane / LPR, c = lane % LPR;
    const GAS float* src = (const GAS float*)W + (size_t)(k0 + KR * g) * N + n0 + 4 * c;
    f32x4 ld[KR];
#pragma unroll
    for (int i = 0; i < KR; ++i) ld[i] = __builtin_nontemporal_load((const GAS f32x4*)(src + (size_t)i * N));
    GAS bf16* dst = (GAS bf16*)WT + (size_t)(drow0 + 4 * c) * Kd + kdo + k0 + KR * g;
#pragma unroll
    for (int j = 0; j < 4; ++j)
#pragma unroll
        for (int q = 0; q < KR / 8; ++q) { v4u o; o.x = pk2(ld[8 * q + 0][j], ld[8 * q + 1][j]); o.y = pk2(ld[8 * q + 2][j], ld[8 * q + 3][j]); o.z = pk2(ld[8 * q + 4][j], ld[8 * q + 5][j]); o.w = pk2(ld[8 * q + 6][j], ld[8 * q + 7][j]);
            *(GAS v4u*)(dst + (size_t)j * Kd + 8 * q) = o; }
}
__device__ __forceinline__ void rms_row_to_bf16(const float* xrow, const float* gain, bf16* orow, int lane) {
    const GAS f32x4* xr = (const GAS f32x4*)xrow + lane; const GAS f32x4* gr = (const GAS f32x4*)gain + lane;
    f32x4 v[8]; float s = 0.f;
#pragma unroll
    for (int j = 0; j < 8; ++j) { v[j] = xr[64 * j]; s += (v[j].x * v[j].x + v[j].y * v[j].y) + (v[j].z * v[j].z + v[j].w * v[j].w); }
    const float rstd = 1.0f / sqrtf(wave_sum(s) * (1.f / D) + EPS);
    GAS v2u* o8 = (GAS v2u*)orow + lane;
#pragma unroll
    for (int j = 0; j < 8; ++j) { const f32x4 g = gr[64 * j]; v2u w; w.x = pk2(v[j].x * rstd * g.x, v[j].y * rstd * g.y); w.y = pk2(v[j].z * rstd * g.z, v[j].w * rstd * g.w); o8[64 * j] = w; }
}

__device__ __forceinline__ void p0_prologue(const Frame& F, const Args& a) {
    unsigned char* ws = a.ws;
    const int gw = F.vcu * NWAVES + F.wave, NGW = F.G * NWAVES;
    constexpr int I_IN = 32 * (IN_COLS / 32), I_MK = 32 * 32, I_BR = 16 * 64, I_O = 32 * 64;
    constexpr int NITEMS = I_IN + 2 * I_MK + 3 * I_BR + I_O;
    for (int it = gw; it < NITEMS; it += NGW) {
        int r = it;
        if (r < I_IN) { const int nb = IN_COLS / 32, kb = r / nb, n0 = 32 * (r % nb); transpose_item<32>(inp(I_WIN), IN_COLS, 64 * kb, n0, (bf16*)(ws + WS_WIN), D, n0 + (n0 >= RWKV_COLS ? 224 : 0), F.lane); continue; } r -= I_IN;
        if (r < I_MK) { transpose_item<32>(inp(I_WMK), 1024, 64 * (r / 32), 32 * (r % 32), (bf16*)(ws + WS_WMKV), D, 32 * (r % 32), F.lane); continue; } r -= I_MK;
        if (r < I_MK) { transpose_item<32>(inp(I_WMV), 1024, 64 * (r / 32), 32 * (r % 32), (bf16*)(ws + WS_WMKV), D, 1024 + 32 * (r % 32), F.lane); continue; } r -= I_MK;
        if (r < I_BR) { transpose_item<32>(inp(I_WRO), 2048, 64 * (r / 64), 32 * (r % 64), (bf16*)(ws + WS_WBR), 3072, 32 * (r % 64), F.lane, 0); continue; } r -= I_BR;
        if (r < I_BR) { transpose_item<32>(inp(I_WLO), 2048, 64 * (r / 64), 32 * (r % 64), (bf16*)(ws + WS_WBR), 3072, 32 * (r % 64), F.lane, 1024); continue; } r -= I_BR;
        if (r < I_BR) { transpose_item<32>(inp(I_WXO), 2048, 64 * (r / 64), 32 * (r % 64), (bf16*)(ws + WS_WBR), 3072, 32 * (r % 64), F.lane, 2048); continue; } r -= I_BR;
        transpose_item<32>(inp(I_WOUT), 2048, 64 * (r / 64), 32 * (r % 64), (bf16*)(ws + WS_WO), D, 32 * (r % 64), F.lane);
    }
    for (int m = gw; m < T; m += NGW) rms_row_to_bf16(inp(I_X) + (size_t)m * D, inp(I_GMIX), (bf16*)(ws + WS_XN) + (size_t)m * D, F.lane);
    for (int m = gw; m < 512; m += NGW) rms_row_to_bf16(inp(I_MEM) + (size_t)m * D, inp(I_GMEM), (bf16*)(ws + WS_MN) + (size_t)m * D, F.lane);
    const int gt = F.vcu * (NWAVES * 64) + F.tid, NGT = F.G * NWAVES * 64;
    { bf16* wz = (bf16*)(ws + WS_WIN) + (size_t)RWKV_COLS * D; for (int i = gt; i < 224 * D / 2; i += NGT) ((GAS unsigned*)wz)[i] = 0u; }
    { bf16* wl = (bf16*)(ws + WS_WLORA);
      for (int i = gt; i < 3072 * LORA_K; i += NGT) { const int n = i / LORA_K, k = i % LORA_K; float v = 0.f;
          if (n < 1024) { if (k < 64) v = inp(I_W2)[k * 1024 + n]; }
          else if (n < 2048) { if (k >= 64 && k < 128) v = inp(I_A2)[(k - 64) * 1024 + (n - 1024)]; }
          else { if (k >= 128 && k < 288) v = inp(I_G2)[(k - 128) * 1024 + (n - 2048)]; }
          wl[i] = (bf16)f2bf(v); } }
    { const float* lam = inp(I_LAM); float* spl = (float*)(ws + WS_SPL); for (int i = gt; i < 1024; i += NGT) spl[i] = softplusf(-lam[i]); }
    { bf16* wr = (bf16*)(ws + WS_WR);
      for (int i = gt; i < 32 * D; i += NGT) { const int e = i / D, k = i % D; const float w = inp(I_WROUTER)[k * 32 + e]; const unsigned hi = f2bf(w); const float r = w - __builtin_bit_cast(float, hi << 16);
          wr[i] = (bf16)hi; wr[32 * D + i] = (bf16)f2bf(r); } }
    { const float* lwi_p = inp(I_LWI); const float* lwr_p = inp(I_LWR); bf16* lw = (bf16*)(ws + WS_LW);
      for (int i = gt; i < 2 * 16 * 4 * 2 * 64 * 8; i += NGT) { const int j = i & 7, ln = (i >> 3) & 63, ks = (i >> 9) & 1, vbo = (i >> 10) & 3, n = (i >> 12) & 15, mat = i >> 16;
          const int w = 32 * ks + 16 * (j >> 2) + 4 * (ln >> 4) + (j & 3), v = 16 * vbo + (ln & 15);
          lw[i] = (bf16)f2bf((mat ? lwi_p : lwr_p)[(n * 64 + w) * 64 + v]); } }
}

__device__ __forceinline__ void moe_weight_convert(const Frame& F, const Args& a, int gw, int NGW) {
    unsigned char* ws = a.ws;
    const float* wg = inp(I_WGATE); const float* wu = inp(I_WUP); const float* wd = inp(I_WDOWN);
    constexpr int PER = 1024;
    for (int it = gw; it < NE * 3 * PER; it += NGW) {
        const int e = it / (3 * PER), r = it % (3 * PER), which = r / PER, q = r % PER, k0 = 64 * (q / 32), n0 = 64 * (q % 32);
        if (which == 0) transpose_item<64>(wg + (size_t)e * D * D, D, k0, n0, (bf16*)(ws + WS_WGU) + (size_t)e * 4096 * D, D, (n0 >> 7) * 256 + (n0 & 127), F.lane);
        else if (which == 1) transpose_item<64>(wu + (size_t)e * D * D, D, k0, n0, (bf16*)(ws + WS_WGU) + (size_t)e * 4096 * D, D, (n0 >> 7) * 256 + 128 + (n0 & 127), F.lane);
        else transpose_item<64>(wd + (size_t)e * D * D, D, k0, n0, (bf16*)(ws + WS_WD) + (size_t)e * 2048 * D, D, n0, F.lane);
    }
}

__device__ __forceinline__ void r1_lora_in(const Frame& F, const Args& a) {
    const bf16* P = (const bf16*)(a.ws + WS_P); bf16* L = (bf16*)(a.ws + WS_XN);
    const float* mu = inp(I_MU);
    const int gw = F.vcu * NWAVES + F.wave, NGW = F.G * NWAVES;
    for (int m = gw; m < T; m += NGW) {
        const bool first = (m % SEQ) == 0;
#pragma unroll
        for (int j = 0; j < 6; ++j) { const int k = F.lane + 64 * j; float o = 0.f;
            if (k < 288) { const int c = 3072 + k; const float cur = bf1(P[(size_t)m * NP + c]); const float prev = first ? 0.f : bf1(P[(size_t)(m - 1) * NP + c]);
                const float x = cur + (prev - cur) * mu[c]; o = k < 64 ? fast_tanh(x) : (k < 128 ? x : sigm(x)); }
            L[(size_t)m * LORA_K + k] = (bf16)f2bf(o); }
    }
}

constexpr int REC_F = 2816, REC_AT = 0, REC_RT = 512, REC_BKT = 1024, REC_WC = 2048, REC_N = 2112, REC_Q = 2176, REC_V8 = 2240;
__device__ __forceinline__ float wave_sum_fast(float v) { v = row16_sum(v); v += __shfl_xor(v, 16); v += __shfl_xor(v, 32); return v; }
__device__ __forceinline__ void r3_blocks(const Frame& F, const Args& a) {
    const GAS bf16* P = (const GAS bf16*)(a.ws + WS_P); const GAS float* LO = (const GAS float*)(a.ws + WS_LORAOUT);
    GAS float* REC = (GAS float*)(a.ws + WS_SCAN); GAS float* BON = (GAS float*)(a.ws + WS_BONUS);
    const GAS float* mu = (const GAS float*)inp(I_MU); const GAS float* w0 = (const GAS float*)inp(I_W0); const GAS float* a0 = (const GAS float*)inp(I_A0);
    const GAS float* kkp = (const GAS float*)inp(I_KK); const GAS float* kap = (const GAS float*)inp(I_KA); const GAS float* rkp = (const GAS float*)inp(I_RK);
    LAS float* G1 = (LAS float*)(F.lds + F.wave * 16384);
    LAS float* G2 = G1 + 2048;
    const int gw = F.vcu * NWAVES + F.wave, NGW = F.G * NWAVES, lane = F.lane;
#pragma unroll 1
    for (int it = gw; it < 32 * 1024; it += NGW) {
        const int bh = it >> 10, blk = it & 1023, b = bh >> 4, h = bh & 15, c = h * 64 + lane, m0 = b * SEQ + blk * 8;
        const float mur = mu[c], muk = mu[1024 + c], muv = mu[2048 + c], w0c = w0[c], a0c = a0[c], kkw = kkp[c], kaw = kap[c], rkw = rkp[c];
        float w[8], av[8], bv[8], kv[8], rv[8], vv[8], ag[8], kk[8], n2[8], bo[8];
        float pr = 0.f, pk = 0.f, pv = 0.f;
        if (blk > 0) { const GAS bf16* pp = P + (size_t)(m0 - 1) * NP; pr = bf1(pp[c]); pk = bf1(pp[1024 + c]); pv = bf1(pp[2048 + c]); }
#pragma unroll
        for (int t = 0; t < 8; ++t) { const GAS bf16* pc = P + (size_t)(m0 + t) * NP; const float cr = bf1(pc[c]), ck = bf1(pc[1024 + c]), cv = bf1(pc[2048 + c]);
            const float r = cr + (pr - cr) * mur, k = ck + (pk - ck) * muk, v = cv + (pv - cv) * muv; pr = cr; pk = ck; pv = cv;
            const float wpre = w0c + LO[(size_t)(m0 + t) * 3072 + c], apre = a0c + LO[(size_t)(m0 + t) * 3072 + 1024 + c];
            w[t] = __expf(-0.6065306597126334f * __builtin_amdgcn_rcpf(1.0f + __expf(-wpre)));
            ag[t] = __builtin_amdgcn_rcpf(1.0f + __expf(-apre));
            kk[t] = k * kkw; n2[t] = kk[t] * kk[t];
            kv[t] = k * (1.0f + (ag[t] - 1.0f) * kaw); rv[t] = r; vv[t] = v; bo[t] = r * kv[t] * rkw; }
#pragma unroll
        for (int t = 0; t < 8; ++t) { n2[t] = wave_sum_fast(n2[t]); bo[t] = wave_sum_fast(bo[t]); }
#pragma unroll
        for (int t = 0; t < 8; ++t) { const float kkn = kk[t] * (1.0f / sqrtf(fmaxf(n2[t], 1e-24f))); av[t] = -kkn; bv[t] = kkn * ag[t]; if (lane == 0) BON[(m0 + t) * 16 + h] = bo[t]; }
        float Pp[8]; Pp[0] = w[0];
#pragma unroll
        for (int t = 1; t < 8; ++t) Pp[t] = Pp[t - 1] * w[t];
        float bch[8], kch[8], ah[8], rh[8];
#pragma unroll
        for (int t = 0; t < 8; ++t) { const float pin = __builtin_amdgcn_rcpf(Pp[t]); bch[t] = bv[t] * pin; kch[t] = kv[t] * pin; ah[t] = av[t] * (t > 0 ? Pp[t - 1] : 1.0f); rh[t] = rv[t] * Pp[t]; }
        const int pos = (lane & 3) * 16 + (lane >> 2);
#pragma unroll
        for (int t = 0; t < 8; ++t) { G1[t * 64 + pos] = bch[t]; G1[(8 + t) * 64 + pos] = kch[t]; G1[(16 + t) * 64 + pos] = ah[t]; G1[(24 + t) * 64 + pos] = rh[t]; }
        LDS_WAIT(); asm volatile("" ::: "memory");
        f32x4 fa[4], fb[4];
#pragma unroll
        for (int q = 0; q < 4; ++q) { fa[q] = *(const LAS f32x4*)(G1 + (lane & 15) * 64 + (lane >> 4) * 16 + 4 * q); fb[q] = *(const LAS f32x4*)(G1 + (16 + (lane & 15)) * 64 + (lane >> 4) * 16 + 4 * q); }
        f32x4 dacc = {0.f, 0.f, 0.f, 0.f};
#pragma unroll
        for (int s2 = 0; s2 < 16; ++s2) dacc = __builtin_amdgcn_mfma_f32_16x16x4f32(fa[s2 >> 2][s2 & 3], fb[s2 >> 2][s2 & 3], dacc, 0, 0, 0);
        *(LAS f32x4*)(G2 + (lane & 15) * 16 + 4 * (lane >> 4)) = dacc;
        LDS_WAIT(); asm volatile("" ::: "memory");
        float M[8][8];
        { float Lm[8][8];
#pragma unroll
          for (int t = 1; t < 8; ++t) { const f32x4 l0 = *(const LAS f32x4*)(G2 + t * 16), l1 = *(const LAS f32x4*)(G2 + t * 16 + 4);
#pragma unroll
              for (int i = 0; i < 4; ++i) { Lm[t][i] = l0[i]; Lm[t][4 + i] = l1[i]; } }
#pragma unroll
          for (int t = 0; t < 8; ++t) { M[t][t] = 1.0f;
#pragma unroll
              for (int i = t - 1; i >= 0; --i) { float acc = 0.f;
#pragma unroll
                  for (int j = i; j < t; ++j) acc += Lm[t][j] * M[j][i];
                  M[t][i] = acc; } } }
        GAS float* rec = REC + ((size_t)bh * 1024 + blk) * REC_F;
#pragma unroll
        for (int t = 0; t < 8; ++t) { float acc = 0.f;
#pragma unroll
            for (int i = 0; i <= t; ++i) acc += M[t][i] * ah[i];
            rec[REC_AT + t * 64 + lane] = acc; }
        float Nm[8][8];
        { float Km[8][8];
#pragma unroll
          for (int t = 1; t < 8; ++t) { const f32x4 l0 = *(const LAS f32x4*)(G2 + t * 16 + 8), l1 = *(const LAS f32x4*)(G2 + t * 16 + 12);
#pragma unroll
              for (int i = 0; i < 4; ++i) { Km[t][i] = l0[i]; Km[t][4 + i] = l1[i]; } }
#pragma unroll
          for (int t = 0; t < 8; ++t)
#pragma unroll
              for (int i = 0; i < 8; ++i) { float acc = 0.f;
                  if (i < t) {
#pragma unroll
                      for (int j = i + 1; j <= t; ++j) acc += M[t][j] * Km[j][i]; }
                  Nm[t][i] = acc; } }
        float rb[8][8];
#pragma unroll
        for (int t = 0; t < 8; ++t) { const f32x4 l0 = *(const LAS f32x4*)(G2 + (8 + t) * 16), l1 = *(const LAS f32x4*)(G2 + (8 + t) * 16 + 4);
#pragma unroll
            for (int i = 0; i < 4; ++i) { rb[t][i] = l0[i]; rb[t][4 + i] = l1[i]; } }
#pragma unroll
        for (int t = 0; t < 8; ++t) { float acc = rh[t];
#pragma unroll
            for (int i = 0; i <= t; ++i) { float rm = 0.f;
#pragma unroll
                for (int j = i; j <= t; ++j) rm += rb[t][j] * M[j][i];
                acc += rm * ah[i]; }
            rec[REC_RT + t * 64 + lane] = acc; }
        float Qm[8][8];
#pragma unroll
        for (int t = 0; t < 8; ++t) { const f32x4 l0 = *(const LAS f32x4*)(G2 + (8 + t) * 16 + 8), l1 = *(const LAS f32x4*)(G2 + (8 + t) * 16 + 12);
#pragma unroll
            for (int i = 0; i < 8; ++i) { float acc = 0.f;
                if (i <= t) { acc = i < 4 ? l0[i & 3] : l1[i & 3];
#pragma unroll
                    for (int j = i + 1; j <= t; ++j) acc += rb[t][j] * Nm[j][i]; }
                Qm[t][i] = acc; } }
#pragma unroll
        for (int q4 = 0; q4 < 2; ++q4) { *(GAS f32x4*)(rec + REC_BKT + lane * 16 + 4 * q4) = (f32x4){bch[4 * q4] * Pp[7], bch[4 * q4 + 1] * Pp[7], bch[4 * q4 + 2] * Pp[7], bch[4 * q4 + 3] * Pp[7]};
            *(GAS f32x4*)(rec + REC_BKT + lane * 16 + 8 + 4 * q4) = (f32x4){kch[4 * q4] * Pp[7], kch[4 * q4 + 1] * Pp[7], kch[4 * q4 + 2] * Pp[7], kch[4 * q4 + 3] * Pp[7]}; }
        rec[REC_WC + lane] = Pp[7];
        if (lane == 0) {
#pragma unroll
            for (int t = 0; t < 8; ++t) { *(GAS f32x4*)(rec + REC_N + t * 8) = (f32x4){Nm[t][0], Nm[t][1], Nm[t][2], Nm[t][3]}; *(GAS f32x4*)(rec + REC_N + t * 8 + 4) = (f32x4){Nm[t][4], Nm[t][5], Nm[t][6], Nm[t][7]};
                *(GAS f32x4*)(rec + REC_Q + t * 8) = (f32x4){Qm[t][0], Qm[t][1], Qm[t][2], Qm[t][3]}; *(GAS f32x4*)(rec + REC_Q + t * 8 + 4) = (f32x4){Qm[t][4], Qm[t][5], Qm[t][6], Qm[t][7]}; } }
        *(GAS f32x4*)(rec + REC_V8 + lane * 8) = (f32x4){vv[0], vv[1], vv[2], vv[3]}; *(GAS f32x4*)(rec + REC_V8 + lane * 8 + 4) = (f32x4){vv[4], vv[5], vv[6], vv[7]};
        LDS_WAIT(); asm volatile("" ::: "memory");
    }
}

constexpr int SC_NS = 8, SC_RB = REC_F * 4, SC_SYNC = SC_NS * SC_RB;
__device__ __forceinline__ unsigned lds_word(const volatile LAS unsigned* p) { return (unsigned)__builtin_amdgcn_readfirstlane((int)*p); }
__device__ __forceinline__ bool scan_wg(int& bh, int& quarter) { const int bx = blockIdx.x; if (gridDim.x != 256 || ((bx >> 3) & 1)) return false; const int slot = bx >> 4; bh = (bx & 7) * 4 + (slot >> 2); quarter = slot & 3; return true; }
__device__ __forceinline__ void r4_feeder(const Frame& F, const Args& a, int bh) {
    const GAS char* gsrc = (const GAS char*)(a.ws + WS_SCAN) + (size_t)bh * 1024 * SC_RB + F.lane * 16;
    LAS unsigned char* ring = F.lds;
    volatile LAS unsigned* sync = (volatile LAS unsigned*)(F.lds + SC_SYNC);
    bool dead = false;
#pragma unroll 1
    for (int B = 0; B < 1024; ++B) {
        if (B >= SC_NS && !dead) { unsigned spins = 0; for (;;) { const unsigned d0 = lds_word(sync + 16); if ((int)d0 > B - SC_NS) break; if (++spins > (1u << 20)) { dead = true; break; } __builtin_amdgcn_s_sleep(2); } }
        LAS unsigned char* slot = ring + (B & (SC_NS - 1)) * SC_RB;
#pragma unroll
        for (int q = 0; q < 11; ++q) __builtin_amdgcn_global_load_lds((const GAS unsigned*)(gsrc + (size_t)B * SC_RB + q * 1024), (LAS unsigned*)(slot + q * 1024), 16, 0, 0);
        asm volatile("s_waitcnt vmcnt(55)" ::: "memory");
        if (B >= 5 && F.lane == 0) sync[0] = (unsigned)(B - 4);
    }
    asm volatile("s_waitcnt vmcnt(0)" ::: "memory");
    if (F.lane == 0) sync[0] = 1024u;
}
template <int VAR> __device__ __forceinline__ void r4_scan(const Frame& F, const Args& a, int bh, int quarter) {
    float* YT = (float*)(a.ws + WS_XN);
    constexpr int RB = SC_RB;
    __builtin_amdgcn_s_setprio(3);
    const int r = F.lane & 15, q = F.lane >> 4, rowg = quarter * 16 + r;
    LAS unsigned char* ring = F.lds;
    volatile LAS unsigned* sync = (volatile LAS unsigned*)(F.lds + SC_SYNC);
    const LAS unsigned char* pA1 = ring + (REC_AT + r * 64 + 4 * q) * 4;
    const LAS unsigned char* pNQ = ring + (REC_N + r * 8 + 2 * q) * 4;
    const LAS unsigned char* pVb = ring + (REC_V8 + rowg * 8 + 2 * q) * 4;
    const LAS unsigned char* pV4 = ring + (REC_V8 + rowg * 8 + 4 * (q & 1)) * 4;
    const LAS unsigned char* pA2 = ring + (REC_BKT + r * 16 + 4 * q) * 4;
    const LAS unsigned char* pWC = ring + (REC_WC + 4 * q) * 4;
    unsigned have = 0; bool dead = (VAR == 1);
#define SC_NEED(n) do { unsigned spins_ = 0; while (have < (unsigned)(n) && !dead) { have = lds_word(sync); if (have >= (unsigned)(n)) break; if (++spins_ > (1u << 20)) { dead = true; break; } __builtin_amdgcn_s_sleep(1); } } while (0)
    f32x4 S[4];
#pragma unroll
    for (int kb = 0; kb < 4; ++kb) S[kb] = (f32x4){0.f, 0.f, 0.f, 0.f};
    GAS float* yrow = (GAS float*)YT + (size_t)(bh * 64 + rowg) * SEQ + 4 * (q & 1);
#define SC_LD(a1_, nq_, vb_, v4_, a2_, wc_, so_) do { _Pragma("unroll") for (int kb_ = 0; kb_ < 4; ++kb_) a1_[kb_] = *(const LAS f32x4*)(pA1 + (so_) + kb_ * 64); \
        nq_ = *(const LAS f32x2*)(pNQ + (so_)); vb_ = *(const LAS f32x2*)(pVb + (so_)); v4_ = *(const LAS f32x4*)(pV4 + (so_)); \
        _Pragma("unroll") for (int kb_ = 0; kb_ < 4; ++kb_) { a2_[kb_] = *(const LAS f32x4*)(pA2 + (so_) + kb_ * 1024); wc_[kb_] = *(const LAS f32x4*)(pWC + (so_) + kb_ * 64); } } while (0)
    f32x4 a1[4], a2[4], wc[4], v4; f32x2 nq, vb;
    SC_NEED(1); asm volatile("" ::: "memory");
    SC_LD(a1, nq, vb, v4, a2, wc, 0);
#pragma unroll 1
    for (int k0 = 0; k0 < 1024; k0 += SC_NS) {
#pragma unroll
        for (int u = 0; u < SC_NS; ++u) { const int sn = ((u + 1) & (SC_NS - 1)) * RB;
            f32x4 d0 = {0.f, 0.f, 0.f, 0.f}, d1 = {0.f, 0.f, 0.f, 0.f};
#pragma unroll
            for (int kb = 0; kb < 4; ++kb) { d0 = __builtin_amdgcn_mfma_f32_16x16x4f32(a1[kb][0], S[kb][0], d0, 0, 0, 0); d1 = __builtin_amdgcn_mfma_f32_16x16x4f32(a1[kb][1], S[kb][1], d1, 0, 0, 0);
                d0 = __builtin_amdgcn_mfma_f32_16x16x4f32(a1[kb][2], S[kb][2], d0, 0, 0, 0); d1 = __builtin_amdgcn_mfma_f32_16x16x4f32(a1[kb][3], S[kb][3], d1, 0, 0, 0); }
            d0 = __builtin_amdgcn_mfma_f32_16x16x4f32(nq[0], vb[0], d0, 0, 0, 0); d1 = __builtin_amdgcn_mfma_f32_16x16x4f32(nq[1], vb[1], d1, 0, 0, 0);
            f32x4 na1[4], na2[4], nwc[4], nv4; f32x2 nnq, nvb;
            SC_NEED(k0 + u + 2 <= 1024 ? k0 + u + 2 : 1024); asm volatile("" ::: "memory");
            SC_LD(na1, nnq, nvb, nv4, na2, nwc, sn);
            asm volatile("" ::: "memory");
            const f32x4 dd = d0 + d1;
            if (q >= 2) *(GAS f32x4*)(yrow + (k0 + u) * 8) = dd;
            const f32x4 b2 = q >= 2 ? v4 : dd;
            f32x4 n[4];
#pragma unroll
            for (int kb = 0; kb < 4; ++kb) n[kb] = S[kb] * wc[kb];
#pragma unroll
            for (int sp = 0; sp < 4; ++sp)
#pragma unroll
                for (int kb = 0; kb < 4; ++kb) n[kb] = __builtin_amdgcn_mfma_f32_16x16x4f32(a2[kb][sp], b2[sp], n[kb], 0, 0, 0);
#pragma unroll
            for (int kb = 0; kb < 4; ++kb) S[kb] = n[kb];
            asm volatile("" : "+v"(S[0]), "+v"(S[1]), "+v"(S[2]), "+v"(S[3]) :: "memory");
            if (F.lane == 0) sync[16] = (unsigned)(k0 + u + 1);
#pragma unroll
            for (int kb = 0; kb < 4; ++kb) { a1[kb] = na1[kb]; a2[kb] = na2[kb]; wc[kb] = nwc[kb]; }
            nq = nnq; vb = nvb; v4 = nv4;
        }
    }
#undef SC_LD
#undef SC_NEED
    __builtin_amdgcn_s_setprio(0);
}

__device__ __forceinline__ void r5_finish(const Frame& F, const Args& a) {
    const float* YT = (const float*)(a.ws + WS_XN); const float* LO = (const float*)(a.ws + WS_LORAOUT); const bf16* P = (const bf16*)(a.ws + WS_P); const float* BON = (const float*)(a.ws + WS_BONUS);
    bf16* YA = (bf16*)(a.ws + WS_YABC);
    LAS float* scr = (LAS float*)(F.lds + F.wave * 16640);
    const int gw = F.vcu * NWAVES + F.wave, NGW = F.G * NWAVES;
    for (int it = gw; it < 32 * 128; it += NGW) {
        const int bh = it >> 7, tt = it & 127, t0 = tt * 64, b = bh >> 4, h = bh & 15;
        float y[64]; float s = 0.f;
#pragma unroll
        for (int v = 0; v < 64; ++v) { y[v] = YT[(size_t)(bh * 64 + v) * SEQ + t0 + F.lane]; s += y[v]; }
        const float mean = s * (1.f / 64.f); float q = 0.f;
#pragma unroll
        for (int v = 0; v < 64; ++v) { const float d = y[v] - mean; q += d * d; }
        const float rstd = 1.0f / sqrtf(q * (1.f / 64.f) + GN_EPS);
#pragma unroll
        for (int v = 0; v < 64; ++v) scr[F.lane * 65 + v] = (y[v] - mean) * rstd;
        LDS_WAIT(); asm volatile("" ::: "memory");
        const int c = h * 64 + F.lane; const float lw = inp(I_LNW)[c], lb = inp(I_LNB)[c], muv = inp(I_MU)[2048 + c];
        float pv = t0 > 0 ? bf1(P[(size_t)(b * SEQ + t0 - 1) * NP + 2048 + c]) : 0.f;
        for (int ti = 0; ti < 64; ++ti) { const int m = b * SEQ + t0 + ti;
            const float yn = scr[ti * 65 + F.lane];
            const float cv = bf1(P[(size_t)m * NP + 2048 + c]); const float vsh = cv + (pv - cv) * muv; pv = cv;
            const float o = (yn * lw + lb + BON[m * 16 + h] * vsh) * LO[(size_t)m * 3072 + 2048 + c];
            YA[(size_t)m * 3072 + c] = (bf16)f2bf(o); }
        LDS_WAIT(); asm volatile("" ::: "memory");
    }
}

__device__ __forceinline__ float gelu_tanh(float x) { const float u = 0.7978845608028654f * (x + 0.044715f * x * x * x); return 0.5f * x * (1.0f + fast_tanh(u)); }
template <int CTRL> __device__ __forceinline__ float dpp_keep(float old, float x) { return __builtin_bit_cast(float, __builtin_amdgcn_update_dpp(__builtin_bit_cast(int, old), __builtin_bit_cast(int, x), CTRL, 0xf, 0xf, false)); }
template <bool FINAL> __device__ __forceinline__ void lru_pass(const Frame& F, const Args& a, int gw, int NGW) {
    const bf16* P = (const bf16*)(a.ws + WS_P); const bf16* LW = (const bf16*)(a.ws + WS_LW);
    float* CA = (float*)(a.ws + WS_LRUC); float* CB = CA + 256 * 1024; const float* HIN = CB + 256 * 1024;
    bf16* YB = (bf16*)(a.ws + WS_YABC) + 1024;
    const GAS float* lbr_p = (const GAS float*)inp(I_LBR); const GAS float* lbi_p = (const GAS float*)inp(I_LBI); const GAS float* spl_p = (const GAS float*)(a.ws + WS_SPL);
    const GAS float* cvb_p = (const GAS float*)inp(I_CONVB); const GAS float* cvw_p = (const GAS float*)inp(I_CONVW);
    const int tq = F.lane & 15, kq = F.lane >> 4;
    for (int it = gw; it < 256 * 16; it += NGW) {
        const int tt = it >> 4, n = it & 15, m0 = tt * 64, cb = n * 64 + 4 * kq;
        const bool seq0 = (m0 % SEQ) == 0;
        float hcar[4][4];
        float aprod[4][4];
#pragma unroll
        for (int vb = 0; vb < 4; ++vb)
#pragma unroll
            for (int i = 0; i < 4; ++i) { hcar[vb][i] = FINAL ? HIN[tt * 1024 + cb + 16 * vb + i] : 0.f; aprod[vb][i] = 1.f; }
#pragma unroll 1
        for (int tb = 0; tb < 4; ++tb) {
            asm volatile("" ::: "memory");
            const int m = m0 + 16 * tb + tq, tseq = m % SEQ;
            f32x4 xc[4];
#pragma unroll
            for (int vb = 0; vb < 4; ++vb) { const int c = cb + 16 * vb; f32x4 acc = *(const GAS f32x4*)(cvb_p + c);
#pragma unroll
                for (int j = 0; j < 4; ++j) { if (tseq - j >= 0) { const v2u pw = *(const GAS v2u*)((const GAS bf16*)P + (size_t)(m - j) * NP + PC_LX + c); const f32x4 cw = *(const GAS f32x4*)(cvw_p + j * 1024 + c);
                        acc[0] += cw[0] * bflo(pw.x); acc[1] += cw[1] * bfhi(pw.x); acc[2] += cw[2] * bflo(pw.y); acc[3] += cw[3] * bfhi(pw.y); } }
                xc[vb] = acc; }
            bf16x8 bfrag[2];
#pragma unroll
            for (int ks = 0; ks < 2; ++ks) { v4u w; w.x = pk2(xc[2 * ks][0], xc[2 * ks][1]); w.y = pk2(xc[2 * ks][2], xc[2 * ks][3]); w.z = pk2(xc[2 * ks + 1][0], xc[2 * ks + 1][1]); w.w = pk2(xc[2 * ks + 1][2], xc[2 * ks + 1][3]); bfrag[ks] = __builtin_bit_cast(bf16x8, w); }
#pragma unroll
            for (int vb = 0; vb < 4; ++vb) {
                f32x4 gr = {0.f, 0.f, 0.f, 0.f}, gi = {0.f, 0.f, 0.f, 0.f};
#pragma unroll
                for (int ks = 0; ks < 2; ++ks) { const bf16x8 wr_ = *(const bf16x8*)(LW + ((((size_t)(0 * 16 + n) * 4 + vb) * 2 + ks) * 64 + F.lane) * 8); const bf16x8 wi_ = *(const bf16x8*)(LW + ((((size_t)(1 * 16 + n) * 4 + vb) * 2 + ks) * 64 + F.lane) * 8);
                    gr = __builtin_amdgcn_mfma_f32_16x16x32_bf16(wr_, bfrag[ks], gr, 0, 0, 0); gi = __builtin_amdgcn_mfma_f32_16x16x32_bf16(wi_, bfrag[ks], gi, 0, 0, 0); }
                const int c = cb + 16 * vb;
                const f32x4 brv = *(const GAS f32x4*)(lbr_p + c), biv = *(const GAS f32x4*)(lbi_p + c); const f32x4 spl = *(const GAS f32x4*)(spl_p + c);
                v2u pyw; if (FINAL) pyw = *(const v2u*)(P + (size_t)m * NP + PC_LY + c);
                float hout[4];
#pragma unroll
                for (int i = 0; i < 4; ++i) {
                    const float g_r = sigm(gr[i] + brv[i]), g_i = sigm(gi[i] + biv[i]);
                    const float log_a = -8.0f * g_r * spl[i];
                    float av = __expf(log_a); float mult = __builtin_amdgcn_sqrtf(fmaxf(1.0f - av * av, 0.f)); if (tseq == 0) mult = 1.0f;
                    float bv = mult * g_i * xc[vb][i];
                    { float pa = dpp_keep<0x111>(1.0f, av), pb = dpp_keep<0x111>(0.0f, bv); bv = av * pb + bv; av = av * pa; }
                    { float pa = dpp_keep<0x112>(1.0f, av), pb = dpp_keep<0x112>(0.0f, bv); bv = av * pb + bv; av = av * pa; }
                    { float pa = dpp_keep<0x114>(1.0f, av), pb = dpp_keep<0x114>(0.0f, bv); bv = av * pb + bv; av = av * pa; }
                    { float pa = dpp_keep<0x118>(1.0f, av), pb = dpp_keep<0x118>(0.0f, bv); bv = av * pb + bv; av = av * pa; }
                    const float hv = bv + av * hcar[vb][i];
                    const int l15 = (F.lane & 48) | 15;
                    const float hend = __shfl(hv, l15), aend = __shfl(av, l15);
                    hcar[vb][i] = hend; if (!FINAL) aprod[vb][i] *= aend; hout[i] = hv; }
                if (FINAL) { const float y0 = hout[0] * gelu_tanh(bflo(pyw.x)), y1 = hout[1] * gelu_tanh(bfhi(pyw.x)), y2 = hout[2] * gelu_tanh(bflo(pyw.y)), y3 = hout[3] * gelu_tanh(bfhi(pyw.y));
                    v2u w; w.x = pk2(y0, y1); w.y = pk2(y2, y3); *(v2u*)(YB + (size_t)m * 3072 + c) = w; }
            }
        }
        if (!FINAL && tq == 0) {
#pragma unroll
            for (int vb = 0; vb < 4; ++vb) { f32x4 pa, pb;
#pragma unroll
                for (int i = 0; i < 4; ++i) { pa[i] = aprod[vb][i]; pb[i] = hcar[vb][i]; }
                *(f32x4*)(CA + tt * 1024 + cb + 16 * vb) = pa; *(f32x4*)(CB + tt * 1024 + cb + 16 * vb) = pb; }
        }
        (void)seq0;
    }
}
__device__ __forceinline__ void lru_carry(const Frame& F, const Args& a) {
    const float* CA = (const float*)(a.ws + WS_LRUC); const float* CB = CA + 256 * 1024; float* HIN = (float*)CB + 256 * 1024;
    const int gt = F.vcu * (NWAVES * 64) + F.tid;
    if (gt < 2048) { const int b = gt >> 10, c = gt & 1023; float h = 0.f;
        for (int k = 0; k < 128; ++k) { const int tt = b * 128 + k; HIN[tt * 1024 + c] = h; h = CA[tt * 1024 + c] * h + CB[tt * 1024 + c]; } }
}

__device__ __forceinline__ void xattn_phase(const Frame& F, const Args& a, int gw, int NGW) {
    const bf16* P = (const bf16*)(a.ws + WS_P); const bf16* KM = (const bf16*)(a.ws + WS_KMEM); const bf16* VT = (const bf16*)(a.ws + WS_VT);
    bf16* YC = (bf16*)(a.ws + WS_YABC) + 2048;
    const int tq = F.lane & 15, kq = F.lane >> 4;
    for (int it = gw; it < 4 * 512; it += NGW) {
        const int h = it >> 9, tg = it & 511, m0 = tg * 32, b = m0 / SEQ;
        bf16x8 qf[2][8];
#pragma unroll
        for (int g = 0; g < 2; ++g)
#pragma unroll
            for (int ks = 0; ks < 8; ++ks) qf[g][ks] = *(const bf16x8*)(P + (size_t)(m0 + 16 * g + tq) * NP + PC_Q + h * 256 + 32 * ks + 8 * kq);
        f32x4 s[2][16];
#pragma unroll
        for (int mb = 0; mb < 16; ++mb) { f32x4 acc0 = {0.f, 0.f, 0.f, 0.f}, acc1 = {0.f, 0.f, 0.f, 0.f}; const bf16* kp = KM + (size_t)(b * 256 + 16 * mb + tq) * 1024 + h * 256 + 8 * kq;
#pragma unroll
            for (int ks = 0; ks < 8; ++ks) { const bf16x8 kf = *(const bf16x8*)(kp + 32 * ks);
                acc0 = __builtin_amdgcn_mfma_f32_16x16x32_bf16(kf, qf[0][ks], acc0, 0, 0, 0); acc1 = __builtin_amdgcn_mfma_f32_16x16x32_bf16(kf, qf[1][ks], acc1, 0, 0, 0); }
            s[0][mb] = acc0; s[1][mb] = acc1; asm volatile("" ::: "memory"); }
        bf16x8 pf[2][8];
#pragma unroll
        for (int g = 0; g < 2; ++g) {
            float mx = -3.0e38f;
#pragma unroll
            for (int mb = 0; mb < 16; ++mb) { s[g][mb] = s[g][mb] * 0.0625f; mx = fmaxf(mx, fmaxf(fmaxf(s[g][mb][0], s[g][mb][1]), fmaxf(s[g][mb][2], s[g][mb][3]))); }
            mx = fmaxf(mx, __shfl_xor(mx, 16)); mx = fmaxf(mx, __shfl_xor(mx, 32));
            float sum = 0.f;
#pragma unroll
            for (int mb = 0; mb < 16; ++mb) {
#pragma unroll
                for (int i = 0; i < 4; ++i) { s[g][mb][i] = __expf(s[g][mb][i] - mx); sum += s[g][mb][i]; } }
            sum += __shfl_xor(sum, 16); sum += __shfl_xor(sum, 32);
            const float inv = 1.0f / sum;
#pragma unroll
            for (int ks = 0; ks < 8; ++ks) { v4u w; w.x = pk2(s[g][2 * ks][0] * inv, s[g][2 * ks][1] * inv); w.y = pk2(s[g][2 * ks][2] * inv, s[g][2 * ks][3] * inv); w.z = pk2(s[g][2 * ks + 1][0] * inv, s[g][2 * ks + 1][1] * inv); w.w = pk2(s[g][2 * ks + 1][2] * inv, s[g][2 * ks + 1][3] * inv); pf[g][ks] = __builtin_bit_cast(bf16x8, w); } }
#pragma unroll
        for (int db = 0; db < 16; ++db) { f32x4 acc0 = {0.f, 0.f, 0.f, 0.f}, acc1 = {0.f, 0.f, 0.f, 0.f}; const bf16* vp = VT + ((size_t)((b * 4 + h) * 256 + 16 * db + tq)) * 256 + 8 * kq;
#pragma unroll
            for (int ks = 0; ks < 8; ++ks) { const bf16x8 vf = *(const bf16x8*)(vp + 32 * ks);
                acc0 = __builtin_amdgcn_mfma_f32_16x16x32_bf16(vf, pf[0][ks], acc0, 0, 0, 0); acc1 = __builtin_amdgcn_mfma_f32_16x16x32_bf16(vf, pf[1][ks], acc1, 0, 0, 0); }
            v2u w0_, w1_; w0_.x = pk2(acc0[0], acc0[1]); w0_.y = pk2(acc0[2], acc0[3]); w1_.x = pk2(acc1[0], acc1[1]); w1_.y = pk2(acc1[2], acc1[3]);
            *(v2u*)(YC + (size_t)(m0 + tq) * 3072 + h * 256 + 16 * db + 4 * kq) = w0_; *(v2u*)(YC + (size_t)(m0 + 16 + tq) * 3072 + h * 256 + 16 * db + 4 * kq) = w1_; asm volatile("" ::: "memory"); }
    }
}

__device__ __forceinline__ void router_phase(const Frame& F, const Args& a) {
    const float* H1 = (const float*)(a.ws + WS_H1); bf16* XN2 = (bf16*)(a.ws + WS_XN); const bf16* WR = (const bf16*)(a.ws + WS_WR);
    int* pick_e = (int*)(a.ws + WS_PICK); int* pick_rank = pick_e + 65536; float* pick_gate = (float*)(pick_rank + 65536);
    unsigned* gcnt = (unsigned*)(a.ws + WS_CTL) + CW_CNT;
    LAS float* lg = (LAS float*)(F.lds + F.wave * 4096);
    LAS unsigned* lcnt = (LAS unsigned*)(F.lds + 65536);
    const int tq = F.lane & 15, kq = F.lane >> 4;
    for (int g0 = F.vcu * 4; g0 < 1024; g0 += F.G * 4) {
        if (F.tid < 64) lcnt[F.tid] = 0u;
        __syncthreads();
        int me = 0, mrank = 0; float mgate = 0.f; int e4[4]; float g4[4]; int r4[4];
        const int m0 = (g0 + F.wave) * 16;
        if (F.wave < 4) {
            float myr = 0.f;
            for (int j = 0; j < 16; ++j) { const GAS f32x4* xr = (const GAS f32x4*)(H1 + (size_t)(m0 + j) * D) + F.lane; float s = 0.f;
#pragma unroll
                for (int q = 0; q < 8; ++q) { const f32x4 v = xr[64 * q]; s += (v.x * v.x + v.y * v.y) + (v.z * v.z + v.w * v.w); }
                const float rs = 1.0f / sqrtf(wave_sum(s) * (1.f / D) + EPS); if (tq == j) myr = rs; }
            f32x4 acc[2] = {{0.f, 0.f, 0.f, 0.f}, {0.f, 0.f, 0.f, 0.f}};
            const float* hrow = H1 + (size_t)(m0 + tq) * D + 8 * kq; const float* grow = inp(I_GFFN) + 8 * kq; bf16* xrow = XN2 + (size_t)(m0 + tq) * D + 8 * kq;
            for (int ks = 0; ks < 64; ++ks) {
                const f32x4 x0 = *(const f32x4*)(hrow + 32 * ks), x1 = *(const f32x4*)(hrow + 32 * ks + 4), g0v = *(const f32x4*)(grow + 32 * ks), g1v = *(const f32x4*)(grow + 32 * ks + 4);
                v4u w; w.x = pk2(x0[0] * myr * g0v[0], x0[1] * myr * g0v[1]); w.y = pk2(x0[2] * myr * g0v[2], x0[3] * myr * g0v[3]); w.z = pk2(x1[0] * myr * g1v[0], x1[1] * myr * g1v[1]); w.w = pk2(x1[2] * myr * g1v[2], x1[3] * myr * g1v[3]);
                *(v4u*)(xrow + 32 * ks) = w; const bf16x8 af = __builtin_bit_cast(bf16x8, w);
#pragma unroll
                for (int eh = 0; eh < 2; ++eh) { const bf16* wp = WR + (size_t)(16 * eh + tq) * D + 32 * ks + 8 * kq;
                    acc[eh] = __builtin_amdgcn_mfma_f32_16x16x32_bf16(af, *(const bf16x8*)wp, acc[eh], 0, 0, 0);
                    acc[eh] = __builtin_amdgcn_mfma_f32_16x16x32_bf16(af, *(const bf16x8*)(wp + 32 * D), acc[eh], 0, 0, 0); } }
#pragma unroll
            for (int eh = 0; eh < 2; ++eh)
#pragma unroll
                for (int i = 0; i < 4; ++i) lg[(4 * kq + i) * 33 + 16 * eh + tq] = acc[eh][i] + inp(I_BROUTER)[16 * eh + tq];
            LDS_WAIT(); asm volatile("" ::: "memory");
            if (F.lane < 16) { float v[32];
#pragma unroll
                for (int e = 0; e < 32; ++e) v[e] = lg[F.lane * 33 + e];
                float tv[4];
#pragma unroll
                for (int k = 0; k < 4; ++k) { float best = -3.0e38f; int bi = 0;
#pragma unroll
                    for (int e = 0; e < 32; ++e) { if (v[e] > best) { best = v[e]; bi = e; } }
                    tv[k] = best; e4[k] = bi;
#pragma unroll
                    for (int e = 0; e < 32; ++e) { if (e == bi) v[e] = -3.0e38f; } }
                float den = 0.f;
#pragma unroll
                for (int k = 0; k < 4; ++k) { g4[k] = __expf(tv[k] - tv[0]); den += g4[k]; }
#pragma unroll
                for (int k = 0; k < 4; ++k) { g4[k] = g4[k] / den; r4[k] = (int)atomicAdd((unsigned*)&lcnt[e4[k]], 1u); } }
        }
        __syncthreads();
        if (F.tid < 32) lcnt[32 + F.tid] = atomicAdd(&gcnt[F.tid], lcnt[F.tid]);
        __syncthreads();
        if (F.wave < 4 && F.lane < 16) {
#pragma unroll
            for (int k = 0; k < 4; ++k) { const int pi = (m0 + F.lane) * 4 + k; pick_e[pi] = e4[k]; pick_rank[pi] = (int)lcnt[32 + e4[k]] + r4[k]; pick_gate[pi] = g4[k]; } }
        __syncthreads();
        (void)me; (void)mrank; (void)mgate;
    }
}

__device__ __forceinline__ void scatter_phase(const Frame& F, const Args& a) {
    const int* pick_e = (const int*)(a.ws + WS_PICK); const int* pick_rank = pick_e + 65536; const float* pick_gate = (const float*)(pick_rank + 65536); int* pos = (int*)(pick_gate + 65536);
    float* gate_of_row = (float*)(a.ws + WS_ROWTAB); int* tok_of_row = (int*)(a.ws + WS_ROWTAB + 512 * 1024 + 8192);
    unsigned* ctl = (unsigned*)(a.ws + WS_CTL);
    LAS int* pst = (LAS int*)(F.lds);
    if (F.tid == 0) { int acc = 0; for (int e = 0; e < NE; ++e) { pst[e] = acc; const int c = (int)ctl[CW_CNT + e]; pst[32 + e] = c; const int nt = (c + 255) >> 8;
            if (blockIdx.x == 0) for (int k = 0; k < nt; ++k) ctl[CW_TILEE + (acc >> 8) + k] = (unsigned)e;
            acc += nt << 8; }
        if (blockIdx.x == 0) ctl[CW_NTILES] = (unsigned)(acc >> 8); }
    __syncthreads();
    const int gt = F.vcu * (NWAVES * 64) + F.tid, NGT = F.G * NWAVES * 64;
    for (int pi = gt; pi < 65536; pi += NGT) { const int e = pick_e[pi], row = pst[e] + pick_rank[pi]; pos[pi] = row; gate_of_row[row] = pick_gate[pi]; tok_of_row[row] = pi >> 2; }
    if (blockIdx.x == 0) for (int e = 0; e < NE; ++e) { const int r0 = pst[e] + pst[32 + e], r1 = pst[e] + (((pst[32 + e] + 255) >> 8) << 8);
        for (int r = r0 + F.tid; r < r1; r += NWAVES * 64) { tok_of_row[r] = 0; gate_of_row[r] = 0.f; } }
}

__device__ __forceinline__ void final_phase(const Frame& F, const Args& a) {
    const float* H1 = (const float*)(a.ws + WS_H1); const bf16* OR = (const bf16*)(a.ws + WS_OROW);
    const int* pos = (const int*)(a.ws + WS_PICK) + 3 * 65536;
    const int gw = F.vcu * NWAVES + F.wave, NGW = F.G * NWAVES;
    for (int m = gw; m < T; m += NGW) {
        const GAS f32x4* xr = (const GAS f32x4*)(H1 + (size_t)m * D) + F.lane; const GAS f32x4* gr = (const GAS f32x4*)inp(I_GFINAL) + F.lane;
        f32x4 v[8];
#pragma unroll
        for (int j = 0; j < 8; ++j) v[j] = xr[64 * j];
#pragma unroll
        for (int k = 0; k < 4; ++k) { const int row = pos[m * 4 + k]; const GAS v2u* orp = (const GAS v2u*)(OR + (size_t)row * D) + F.lane;
#pragma unroll
            for (int j = 0; j < 8; ++j) { const v2u w = orp[64 * j]; v[j].x += bflo(w.x); v[j].y += bfhi(w.x); v[j].z += bflo(w.y); v[j].w += bfhi(w.y); } }
        float s = 0.f;
#pragma unroll
        for (int j = 0; j < 8; ++j) s += (v[j].x * v[j].x + v[j].y * v[j].y) + (v[j].z * v[j].z + v[j].w * v[j].w);
        const float rstd = 1.0f / sqrtf(wave_sum(s) * (1.f / D) + EPS);
        GAS f32x4* o = (GAS f32x4*)(a.out + (size_t)m * D) + F.lane;
#pragma unroll
        for (int j = 0; j < 8; ++j) { const f32x4 g = gr[64 * j]; o[64 * j] = (f32x4){v[j].x * rstd * g.x, v[j].y * rstd * g.y, v[j].z * rstd * g.z, v[j].w * rstd * g.w}; }
    }
}

#ifndef MK_N_LAUNCHES
#define MK_N_LAUNCHES 1
#endif
constexpr int NPH = 14;
__global__ void __launch_bounds__(NWAVES * 64, 2) fwd(Args args) {
    extern __shared__ __attribute__((aligned(16))) unsigned char lds[];
#define NEWFRAME() Frame F; { int tz = threadIdx.x; asm volatile("" : "+v"(tz)); F.lds = (LAS unsigned char*)lds; F.MISC = (volatile LAS unsigned*)(F.lds + MISC_OFF); F.tid = tz; F.lane = tz & 63; F.wave = __builtin_amdgcn_readfirstlane(tz >> 6); \
        F.G = gridDim.x; const int bx = blockIdx.x; F.vcu = (F.G % 8 == 0) ? (bx % 8) * (F.G / 8) + bx / 8 : bx; }
    unsigned char* ws = args.ws;
    unsigned* ctl = (unsigned*)(ws + WS_CTL);
    for (int u = threadIdx.x; u < (LDS_BYTES - MISC_OFF) / 4; u += NWAVES * 64) ((LAS unsigned*)((LAS unsigned char*)lds + MISC_OFF))[u] = 0u;
    __syncthreads();
    const int lo = args.ph_lo, hi = args.ph_hi;
    XcdBarrier bar; bar.bar = ctl + CW_BAR; bar.x = 0; bar.st = nullptr;
    if (hi - lo > 1) bar = xcd_barrier_post(ctl + CW_BAR, (volatile LAS unsigned*)((LAS unsigned char*)lds + MISC_OFF) + 8);
#ifndef PHMASK
#define PHMASK 0xFFFF
#endif
#define IN(k) (((PHMASK >> (k)) & 1) && lo <= (k) && (k) < hi)
#define SEAM(k) do { if (IN(k) && IN((k) + 1)) xcd_barrier(bar); } while (0)

    if (IN(0)) { NEWFRAME(); p0_prologue(F, args); } SEAM(0);
    if (IN(1)) { NEWFRAME();
        { pg8::Gemm g{(const bf16*)(ws + WS_XN), (const bf16*)(ws + WS_WIN), T, NP, D}; pg8::StaticOrder S; S.init(T, NP, F.G, (int)blockIdx.x);
          pg8::EpiBf16<0> E{(bf16*)(ws + WS_P), NP, nullptr, 0, 0, 1.f};
          pg8::gemm_phase<pg8::EpiBf16<0>, pg8::StaticOrder, true, true>(F.lds, g, S, E); }
        __syncthreads();
        { pg8::Gemm g{(const bf16*)(ws + WS_MN), (const bf16*)(ws + WS_WMKV), 512, 2048, D}; pg8::StaticOrder S; S.init(512, 2048, F.G, (int)((blockIdx.x + F.G / 2) % F.G));
          pg8::EpiKV E{(bf16*)(ws + WS_KMEM), (bf16*)(ws + WS_VT)};
          pg8::gemm_phase<pg8::EpiKV, pg8::StaticOrder, true, true>(F.lds, g, S, E); }
    } SEAM(1);
    if (IN(2)) { NEWFRAME();
#ifndef NO_R1
 r1_lora_in(F, args);
#endif
#ifndef NO_LRU
 lru_pass<false>(F, args, F.vcu * NWAVES + F.wave, F.G * NWAVES);
#endif
 } SEAM(2);
    if (IN(3)) { NEWFRAME();
        lru_carry(F, args);
        { pg8::Gemm g{(const bf16*)(ws + WS_XN), (const bf16*)(ws + WS_WLORA), T, 3072, LORA_K}; pg8::StaticOrder S; S.init(T, 3072, F.G, (int)blockIdx.x);
          pg8::EpiF32 E{(float*)(ws + WS_LORAOUT), 3072};
          pg8::gemm_phase<pg8::EpiF32, pg8::StaticOrder, true, true>(F.lds, g, S, E); }
    } SEAM(3);
    if (IN(4)) { NEWFRAME(); r3_blocks(F, args); } SEAM(4);
    if (IN(5)) { NEWFRAME();
        if (F.tid < 64) ((LAS unsigned*)(F.lds + SC_SYNC))[F.tid] = 0u; __syncthreads();
        int bh = 0, quarter = 0; const bool sw = scan_wg(bh, quarter);
        int gw2, NGW2; { const int bx = blockIdx.x, G = F.G; if (G == 256) { NGW2 = 1792; gw2 = sw ? ((bx >> 4) * 8 + (bx & 7)) * 6 + (F.wave - 2) : 768 + ((bx >> 4) * 8 + (bx & 7)) * 8 + F.wave; } else { NGW2 = G * 8; gw2 = F.vcu * 8 + F.wave; } }
        if (sw && F.wave == 0) r4_scan<0>(F, args, bh, quarter);
        else if (sw && F.wave == 1) r4_feeder(F, args, bh);
        else {
            const int rot = F.wave % 3;
            if (rot == 0) { moe_weight_convert(F, args, gw2, NGW2); xattn_phase(F, args, gw2, NGW2); lru_pass<true>(F, args, gw2, NGW2); }
            else if (rot == 1) { xattn_phase(F, args, gw2, NGW2); lru_pass<true>(F, args, gw2, NGW2); moe_weight_convert(F, args, gw2, NGW2); }
            else { lru_pass<true>(F, args, gw2, NGW2); moe_weight_convert(F, args, gw2, NGW2); xattn_phase(F, args, gw2, NGW2); } }
    } SEAM(5);
    if (IN(6)) { NEWFRAME(); r5_finish(F, args); } SEAM(6);
    if (IN(7)) { NEWFRAME();
        pg8::Gemm g{(const bf16*)(ws + WS_YABC), (const bf16*)(ws + WS_WBR), T, 2048, 3072}; pg8::StaticOrder S; S.init(T, 2048, F.G, (int)blockIdx.x);
        pg8::EpiBranch2 E{(const bf16*)(ws + WS_P), NP, PC_G, (bf16*)(ws + WS_MERGED)};
        pg8::gemm_phase<pg8::EpiBranch2, pg8::StaticOrder, true, true>(F.lds, g, S, E);
    } SEAM(7);
    if (IN(8)) { NEWFRAME();
        pg8::Gemm g{(const bf16*)(ws + WS_MERGED), (const bf16*)(ws + WS_WO), T, D, D}; pg8::StaticOrder S; S.init(T, D, F.G, (int)blockIdx.x);
        pg8::EpiRes E{inp(I_X), (float*)(ws + WS_H1), D};
        pg8::gemm_phase<pg8::EpiRes, pg8::StaticOrder, true, true>(F.lds, g, S, E);
    } SEAM(8);
    if (IN(9)) { NEWFRAME(); router_phase(F, args); } SEAM(9);
    if (IN(10)) { NEWFRAME(); scatter_phase(F, args); } SEAM(10);
    if (IN(11)) { NEWFRAME();
        const int ntiles = (int)__hip_atomic_load(ctl + CW_NTILES, __ATOMIC_RELAXED, __HIP_MEMORY_SCOPE_AGENT);
        pg8::Gemm g{(const bf16*)(ws + WS_XN), (const bf16*)(ws + WS_WGU), ntiles * 256, NE * 4096, D}; pg8::MoeOrder<true> S; S.init(ntiles, 16, F.G, (int)blockIdx.x, (const int*)(ctl + CW_TILEE), (const int*)(ws + WS_ROWTAB + 512 * 1024 + 8192));
        pg8::EpiSwiglu E{(bf16*)(ws + WS_HH), inp(I_BGATE), inp(I_BUP)};
        pg8::gemm_phase<pg8::EpiSwiglu, pg8::MoeOrder<true>, true, true>(F.lds, g, S, E);
    } SEAM(11);
    if (IN(12)) { NEWFRAME();
        const int ntiles = (int)__hip_atomic_load(ctl + CW_NTILES, __ATOMIC_RELAXED, __HIP_MEMORY_SCOPE_AGENT);
        pg8::Gemm g{(const bf16*)(ws + WS_HH), (const bf16*)(ws + WS_WD), ntiles * 256, NE * 2048, D}; pg8::MoeOrder<false> S; S.init(ntiles, 8, F.G, (int)blockIdx.x, (const int*)(ctl + CW_TILEE), nullptr);
        pg8::EpiDown E{(bf16*)(ws + WS_OROW), inp(I_BDOWN), (const float*)(ws + WS_ROWTAB)};
        pg8::gemm_phase<pg8::EpiDown, pg8::MoeOrder<false>, true, true>(F.lds, g, S, E);
    } SEAM(12);
    if (IN(13)) { NEWFRAME(); final_phase(F, args); }
#ifdef PROBE_EXTRA_PHASE
    if (lo == 14) { NEWFRAME(); if (F.tid < 64) ((LAS unsigned*)(F.lds + SC_SYNC))[F.tid] = 0u; __syncthreads(); int bh = 0, quarter = 0; const bool sw = scan_wg(bh, quarter); if (sw && F.wave == 0) r4_scan<0>(F, args, bh, quarter); else if (sw && F.wave == 1) r4_feeder(F, args, bh); }
    if (lo == 17) { NEWFRAME(); int bh = 0, quarter = 0; const bool sw = scan_wg(bh, quarter); if (sw && F.wave == 0) r4_scan<1>(F, args, bh, quarter); }
    if (lo == 15) { NEWFRAME(); moe_weight_convert(F, args, F.vcu * 8 + F.wave, F.G * 8); }
#endif
#undef IN
#undef SEAM
}

extern "C" void kernel_launch(void* const* d_in, const int* in_sizes, int n_in, void* d_out, int out_size, void* d_ws, size_t ws_size, hipStream_t stream) {
    static int grid = 0;
    if (grid == 0) {
        if (n_in != 39 || out_size != T * D || ws_size < WS_END) { fprintf(stderr, "kernel_launch: built for 39 inputs, out of %d floats, >= %zu bytes of workspace; got n_in %d, out %d, ws %zu; nothing launched\n", T * D, (size_t)WS_END, n_in, out_size, ws_size); grid = -1; return; }
        int dev = 0, cus = 0, per_cu = 0;
        if (hipGetDevice(&dev) != hipSuccess || hipDeviceGetAttribute(&cus, hipDeviceAttributeMultiprocessorCount, dev) != hipSuccess) { fprintf(stderr, "kernel_launch: device query failed\n"); grid = -1; return; }
        if (hipFuncSetAttribute((const void*)fwd, hipFuncAttributeMaxDynamicSharedMemorySize, LDS_BYTES) != hipSuccess) { fprintf(stderr, "kernel_launch: hipFuncSetAttribute failed\n"); grid = -1; return; }
        if (hipOccupancyMaxActiveBlocksPerMultiprocessor(&per_cu, (const void*)fwd, NWAVES * 64, LDS_BYTES) != hipSuccess || per_cu < 1)
            fprintf(stderr, "kernel_launch: note: occupancy query reports %d workgroups per CU\n", per_cu);
        (void)hipGetLastError();
        grid = cus;
    }
    if (grid < 0) return;
    (void)in_sizes;
    if (hipMemsetAsync((char*)d_ws + WS_CTL, 0, CTL_ZERO_BYTES, stream) != hipSuccess) { fprintf(stderr, "kernel_launch: hipMemsetAsync failed\n"); return; }
    Args a{};
    for (int i = 0; i < 39; ++i) a.in[i] = (const float*)d_in[i];
    a.out = (float*)d_out; a.ws = (unsigned char*)d_ws;
#if MK_N_LAUNCHES == 1
    a.ph_lo = 0; a.ph_hi = NPH;
    hipLaunchKernelGGL(fwd, dim3(grid), dim3(NWAVES * 64), LDS_BYTES, stream, a);
#else
    for (int k = 0; k < NPH; ++k) { a.ph_lo = k; a.ph_hi = k + 1; int reps = 1;
#ifdef PROBE_REP_PHASE
        if (k == PROBE_REP_PHASE) reps = 1 + PROBE_REP_N;
#endif
        for (int r = 0; r < reps; ++r) hipLaunchKernelGGL(fwd, dim3(grid), dim3(NWAVES * 64), LDS_BYTES, stream, a); }
#ifdef PROBE_EXTRA_PHASE
    for (int r = 0; r < PROBE_REP_N; ++r) { a.ph_lo = PROBE_EXTRA_PHASE; a.ph_hi = PROBE_EXTRA_PHASE + 1; hipLaunchKernelGGL(fwd, dim3(grid), dim3(NWAVES * 64), LDS_BYTES, stream, a); }
#endif
#endif
    const hipError_t le = hipPeekAtLastError();
    if (le != hipSuccess) fprintf(stderr, "kernel_launch: launch failed: %s\n", hipGetErrorName(le));
}
```

```cpp
#include <hip/hip_runtime.h>
#include <cstdio>
#include <cstdint>
namespace pg8 {
#define PG8_LAS __attribute__((address_space(3)))
typedef unsigned short bf16_t;
typedef short bf16x8 __attribute__((ext_vector_type(8)));
typedef float f32x4 __attribute__((ext_vector_type(4)));
typedef unsigned u32x4 __attribute__((ext_vector_type(4)));
constexpr int BM = 256, BK = 64, HALF = 128, HTB = HALF * BK * 2  , STAGE_BYTES = 8 * HTB, NXCD = 8, WGM = 8;

__host__ __device__ __forceinline__ int lds_byte(int r, int c) { const int st = (r >> 4) * 2 + (c >> 5), rr = r & 15, cc = c & 31, ob = rr * 64 + cc * 2; return st * 1024 + (ob ^ (((ob >> 9) & 1) << 5)); }
__host__ __device__ __forceinline__ void stage_rc(int b, int& R, int& C) { const int st = b / 1024, sb = b % 1024, swz = sb ^ (((sb >> 9) & 1) << 5); R = (st >> 1) * 16 + swz / 64; C = (st & 1) * 32 + (swz % 64) / 2; }
__host__ __device__ __forceinline__ int perm32(int rho) { const int n = rho >> 4, i = rho & 15; return 8 * (i >> 2) + 4 * n + (i & 3); }

struct Unit { int pm, pn; };
struct Gemm { const bf16_t* A; const bf16_t* Bt; int M, N, K; };

struct StaticOrder {
    static constexpr bool GATHER = false; __device__ __forceinline__ int arow(const Unit&, int) const { return 0; }
    int nM, nN, nwg, G, c;
    __host__ __device__ void init(int M, int N, int G_, int c_) { nM = M / BM; nN = N / BM; nwg = nM * nN; G = G_; c = c_; }
    __host__ __device__ bool next(int i, Unit& u) const {
        const long L = (long)i * G + c; if (L >= nwg) return false;
        int wgid = (int)L; { const int q = nwg / NXCD, r = nwg % NXCD, xcd = wgid % NXCD, off = wgid / NXCD; wgid = (xcd < r ? xcd * (q + 1) : r * (q + 1) + (xcd - r) * q) + off; }
        const int nig = WGM * nN, gid = wgid / nig, fm = gid * WGM, gsz = (nM - fm) < WGM ? (nM - fm) : WGM;
        u.pm = fm + ((wgid % nig) % gsz); u.pn = (wgid % nig) / gsz; return true;
    }
    __device__ __forceinline__ void a_ready(const Unit&) const {}
    __device__ __forceinline__ void done(const Unit&) const {}
};
__device__ __forceinline__ unsigned cvt_pk_bf16(float lo, float hi) { unsigned r; asm volatile("v_cvt_pk_bf16_f32 %0, %1, %2" : "=v"(r) : "v"(lo), "v"(hi)); return r; }
typedef float f32x2 __attribute__((ext_vector_type(2)));
__device__ __forceinline__ f32x2 gelu_pk(f32x2 v) {
    const f32x2 av = __builtin_elementwise_abs(v), d = av * 0.2316418882f + 1.0f;
    f32x2 t; t.x = __builtin_amdgcn_rcpf(d.x); t.y = __builtin_amdgcn_rcpf(d.y);
    f32x2 q = t * 0.5307027145f + (-0.7265760135f); q = q * t + 0.7107068705f; q = q * t + (-0.142248368f); q = q * t + 0.127414796f; q = q * t;
    const f32x2 s = (v * v) * (-0.72134752044f);
    f32x2 e; e.x = __builtin_amdgcn_exp2f(s.x); e.y = __builtin_amdgcn_exp2f(s.y);
    const f32x2 m = v * (q * e), r = v - m;
    f32x2 o; o.x = v.x < 0.f ? m.x : r.x; o.y = v.y < 0.f ? m.y : r.y; return o;
}

template <int ACT  > struct EpiBf16 {
    static constexpr bool PERM = true, AFTER_DRAIN = false; static constexpr int MIDK = 0; static_assert(ACT == 0 || ACT == 1, "EpiBf16: ACT is 0 (none) or 1 (gelu_pk)");
    bf16_t* O; int ldc; const float* bias; int split_cols; size_t split_stride; float scale0;
    __device__ __forceinline__ void operator()(const f32x4 (&acc)[2][2][4][2], const Unit& u, int wr, int wc, int fr, int fq) const {
        const int row0 = u.pm * BM + wr * 64 + fr; int colt = u.pn * BM; bf16_t* base = O;
        float sc = 1.f; if (split_cols) { const int t = colt / split_cols; base += (size_t)t * split_stride; colt -= t * split_cols; if (t == 0) sc = scale0; }
        const int col0 = colt + wc * 32 + 8 * fq, bcol0 = u.pn * BM + wc * 32 + 8 * fq;
        f32x4 bv[2][2];
#pragma unroll
        for (int bj = 0; bj < 2; ++bj)
#pragma unroll
            for (int n = 0; n < 2; ++n) bv[bj][n] = bias ? *(const f32x4*)(bias + bcol0 + bj * HALF + 4 * n) : (f32x4){0.f, 0.f, 0.f, 0.f};
#pragma unroll
        for (int ai = 0; ai < 2; ++ai)
#pragma unroll
            for (int m = 0; m < 4; ++m) { bf16_t* rowp = base + (size_t)(row0 + ai * HALF + m * 16) * ldc + col0;
#pragma unroll
                for (int bj = 0; bj < 2; ++bj) { f32x4 v0 = acc[ai][bj][m][0] + bv[bj][0], v1 = acc[ai][bj][m][1] + bv[bj][1];
                    if (ACT == 1) { f32x2 a = gelu_pk((f32x2){v0[0], v0[1]}), b = gelu_pk((f32x2){v0[2], v0[3]}), c = gelu_pk((f32x2){v1[0], v1[1]}), d = gelu_pk((f32x2){v1[2], v1[3]});
                        v0 = (f32x4){a.x, a.y, b.x, b.y}; v1 = (f32x4){c.x, c.y, d.x, d.y}; }
                    v0 = v0 * sc; v1 = v1 * sc; u32x4 w; w.x = cvt_pk_bf16(v0[0], v0[1]); w.y = cvt_pk_bf16(v0[2], v0[3]); w.z = cvt_pk_bf16(v1[0], v1[1]); w.w = cvt_pk_bf16(v1[2], v1[3]);
                    *(u32x4*)(rowp + bj * HALF) = w; } }
    }
};

__device__ __forceinline__ float bf_lo(unsigned w) { return __builtin_bit_cast(float, w << 16); }
__device__ __forceinline__ float bf_hi(unsigned w) { return __builtin_bit_cast(float, w & 0xffff0000u); }
__device__ __forceinline__ float fsigmoid(float x) { return __builtin_amdgcn_rcpf(1.0f + __expf(-x)); }
typedef unsigned u32x2 __attribute__((ext_vector_type(2)));

struct EpiF32 {
    static constexpr bool PERM = false, AFTER_DRAIN = false; static constexpr int MIDK = 0;
    float* C; int ldc;
    __device__ __forceinline__ void operator()(const f32x4 (&acc)[2][2][4][2], const Unit& u, int wr, int wc, int fr, int fq) const {
        const int row0 = u.pm * BM + wr * 64 + fr, col0 = u.pn * BM + wc * 32 + 4 * fq;
#pragma unroll
        for (int ai = 0; ai < 2; ++ai)
#pragma unroll
            for (int m = 0; m < 4; ++m) { float* rowp = C + (size_t)(row0 + ai * HALF + m * 16) * ldc + col0;
#pragma unroll
                for (int bj = 0; bj < 2; ++bj)
#pragma unroll
                    for (int n = 0; n < 2; ++n) *(f32x4*)(rowp + bj * HALF + n * 16) = acc[ai][bj][m][n]; }
    }
};
struct EpiRes {
    static constexpr bool PERM = false, AFTER_DRAIN = false; static constexpr int MIDK = 0;
    const float* X; float* C; int ldc;
    __device__ __forceinline__ void operator()(const f32x4 (&acc)[2][2][4][2], const Unit& u, int wr, int wc, int fr, int fq) const {
        const int row0 = u.pm * BM + wr * 64 + fr, col0 = u.pn * BM + wc * 32 + 4 * fq;
#pragma unroll
        for (int ai = 0; ai < 2; ++ai)
#pragma unroll
            for (int m = 0; m < 4; ++m) { const size_t off = (size_t)(row0 + ai * HALF + m * 16) * ldc + col0;
#pragma unroll
                for (int bj = 0; bj < 2; ++bj)
#pragma unroll
                    for (int n = 0; n < 2; ++n) { const f32x4 xv = *(const f32x4*)(X + off + bj * HALF + n * 16); *(f32x4*)(C + off + bj * HALF + n * 16) = acc[ai][bj][m][n] + xv; }
                asm volatile("" ::: "memory"); }
    }
};
struct EpiKV {
    static constexpr bool PERM = false, AFTER_DRAIN = false; static constexpr int MIDK = 0;
    bf16_t* Kb; bf16_t* VT;
    __device__ __forceinline__ void operator()(const f32x4 (&acc)[2][2][4][2], const Unit& u, int wr, int wc, int fr, int fq) const {
        const int row0 = u.pm * BM + wr * 64 + fr, col0 = u.pn * BM + wc * 32 + 4 * fq;
#pragma unroll
        for (int ai = 0; ai < 2; ++ai)
#pragma unroll
            for (int m = 0; m < 4; ++m) { const int r = row0 + ai * HALF + m * 16;
#pragma unroll
                for (int bj = 0; bj < 2; ++bj)
#pragma unroll
                    for (int n = 0; n < 2; ++n) { const f32x4 v = acc[ai][bj][m][n]; const int c = col0 + bj * HALF + n * 16;
                        if (u.pn < 4) { u32x2 w; w.x = cvt_pk_bf16(v[0], v[1]); w.y = cvt_pk_bf16(v[2], v[3]); *(u32x2*)(Kb + (size_t)r * 1024 + c) = w; }
                        else { const int cc = c - 1024, h = cc >> 8, d = cc & 255, b = r >> 8, mm = r & 255;
                            const int idx = (mm >> 5) * 32 + ((mm >> 2) & 3) * 8 + ((mm >> 4) & 1) * 4 + (mm & 3);
                            bf16_t* o = VT + ((size_t)((b * 4 + h) * 256 + d)) * 256 + idx;
                            const unsigned w0 = cvt_pk_bf16(v[0], v[1]), w1 = cvt_pk_bf16(v[2], v[3]);
                            o[0] = (bf16_t)(w0 & 0xffffu); o[256] = (bf16_t)(w0 >> 16); o[512] = (bf16_t)(w1 & 0xffffu); o[768] = (bf16_t)(w1 >> 16); } } }
    }
};
struct EpiBranch {
    static constexpr bool PERM = false, AFTER_DRAIN = false; static constexpr int MIDK = 0;
    const bf16_t* P; int ldp; int gcol0; float* macc; bf16_t* merged;
    __device__ __forceinline__ void operator()(const f32x4 (&acc)[2][2][4][2], const Unit& u, int wr, int wc, int fr, int fq) const {
        const int br = u.pm >> 6, pm = u.pm & 63, pn = u.pn & 7;
        const int row0 = pm * BM + wr * 64 + fr, col0 = pn * BM + wc * 32 + 4 * fq;
#pragma unroll
        for (int ai = 0; ai < 2; ++ai)
#pragma unroll
            for (int m = 0; m < 4; ++m) { const int r = row0 + ai * HALF + m * 16; const bf16_t* prow = P + (size_t)r * ldp + gcol0 + br * 2048;
#pragma unroll
                for (int bj = 0; bj < 2; ++bj)
#pragma unroll
                    for (int n = 0; n < 2; ++n) { const int c = col0 + bj * HALF + n * 16; const u32x2 gw = *(const u32x2*)(prow + c);
                        f32x4 g; g[0] = fsigmoid(bf_lo(gw.x)); g[1] = fsigmoid(bf_hi(gw.x)); g[2] = fsigmoid(bf_lo(gw.y)); g[3] = fsigmoid(bf_hi(gw.y));
                        f32x4 v = acc[ai][bj][m][n] * g; float* mp = macc + (size_t)r * 2048 + c;
                        if (br > 0) v = v + *(const f32x4*)mp;
                        if (br < 2) *(f32x4*)mp = v;
                        else { u32x2 w; w.x = cvt_pk_bf16(v[0], v[1]); w.y = cvt_pk_bf16(v[2], v[3]); *(u32x2*)(merged + (size_t)r * 2048 + c) = w; } }
                asm volatile("" ::: "memory"); }
    }
};
struct EpiSwiglu {
    static constexpr bool PERM = true, AFTER_DRAIN = false; static constexpr int MIDK = 0;
    bf16_t* H; const float* bg; const float* bu;
    __device__ __forceinline__ void operator()(const f32x4 (&acc)[2][2][4][2], const Unit& u, int wr, int wc, int fr, int fq) const {
        const int e = u.pn >> 4, ct = u.pn & 15;
        const int row0 = u.pm * BM + wr * 64 + fr, col0 = ct * 128 + wc * 32 + 8 * fq;
        f32x4 bgv[2], buv[2];
#pragma unroll
        for (int n = 0; n < 2; ++n) { bgv[n] = *(const f32x4*)(bg + (size_t)e * 2048 + col0 + 4 * n); buv[n] = *(const f32x4*)(bu + (size_t)e * 2048 + col0 + 4 * n); }
#pragma unroll
        for (int ai = 0; ai < 2; ++ai)
#pragma unroll
            for (int m = 0; m < 4; ++m) { bf16_t* rowp = H + (size_t)(row0 + ai * HALF + m * 16) * 2048 + col0;
                f32x4 o[2];
#pragma unroll
                for (int n = 0; n < 2; ++n) { const f32x4 g = acc[ai][0][m][n] + bgv[n], up = acc[ai][1][m][n] + buv[n];
#pragma unroll
                    for (int j = 0; j < 4; ++j) { const float hg = fminf(g[j], 7.0f), hu = fminf(fmaxf(up[j], -7.0f), 7.0f); o[n][j] = (hu + 1.0f) * hg * fsigmoid(1.702f * hg); } }
                u32x4 w; w.x = cvt_pk_bf16(o[0][0], o[0][1]); w.y = cvt_pk_bf16(o[0][2], o[0][3]); w.z = cvt_pk_bf16(o[1][0], o[1][1]); w.w = cvt_pk_bf16(o[1][2], o[1][3]);
                *(u32x4*)rowp = w; }
    }
};
struct EpiDown {
    static constexpr bool PERM = true, AFTER_DRAIN = false; static constexpr int MIDK = 0;
    bf16_t* O; const float* bd; const float* rowgate;
    __device__ __forceinline__ void operator()(const f32x4 (&acc)[2][2][4][2], const Unit& u, int wr, int wc, int fr, int fq) const {
        const int e = u.pn >> 3, ct = u.pn & 7;
        const int row0 = u.pm * BM + wr * 64 + fr, col0 = ct * BM + wc * 32 + 8 * fq;
        f32x4 bv[2][2];
#pragma unroll
        for (int bj = 0; bj < 2; ++bj)
#pragma unroll
            for (int n = 0; n < 2; ++n) bv[bj][n] = *(const f32x4*)(bd + (size_t)e * 2048 + col0 + bj * HALF + 4 * n);
#pragma unroll
        for (int ai = 0; ai < 2; ++ai)
#pragma unroll
            for (int m = 0; m < 4; ++m) { const int r = row0 + ai * HALF + m * 16; const float gs = rowgate[r]; bf16_t* rowp = O + (size_t)r * 2048 + col0;
#pragma unroll
                for (int bj = 0; bj < 2; ++bj) { const f32x4 v0 = (acc[ai][bj][m][0] + bv[bj][0]) * gs, v1 = (acc[ai][bj][m][1] + bv[bj][1]) * gs;
                    u32x4 w; w.x = cvt_pk_bf16(v0[0], v0[1]); w.y = cvt_pk_bf16(v0[2], v0[3]); w.z = cvt_pk_bf16(v1[0], v1[1]); w.w = cvt_pk_bf16(v1[2], v1[3]);
                    *(u32x4*)(rowp + bj * HALF) = w; } }
    }
};

struct EpiBranch2 {
    static constexpr bool PERM = false, AFTER_DRAIN = false; static constexpr int MIDK = 16;
    const bf16_t* P; int ldp; int gcol0; bf16_t* merged;
    __device__ __forceinline__ void mid(f32x4 (&acc)[2][2][4][2], const Unit& u, int which, int, int, int, int) const {
        int tz = threadIdx.x; asm volatile("" : "+v"(tz));
        const int wid_ = tz >> 6, lane_ = tz & 63, wr = wid_ >> 2, wc = wid_ & 3, fr = lane_ & 15, fq = lane_ >> 4;
        const int row0 = u.pm * BM + wr * 64 + fr, col0 = u.pn * BM + wc * 32 + 4 * fq;
#pragma unroll
        for (int ai = 0; ai < 2; ++ai)
#pragma unroll
            for (int m = 0; m < 4; ++m) { const bf16_t* prow = P + (size_t)(row0 + ai * HALF + m * 16) * ldp + gcol0 + (which - 1) * 2048;
#pragma unroll
                for (int bj = 0; bj < 2; ++bj)
#pragma unroll
                    for (int n = 0; n < 2; ++n) { const int c = col0 + bj * HALF + n * 16; const u32x2 ga = *(const u32x2*)(prow + c), gb = *(const u32x2*)(prow + 2048 + c);
                        const float a_[4] = {bf_lo(ga.x), bf_hi(ga.x), bf_lo(ga.y), bf_hi(ga.y)}, b_[4] = {bf_lo(gb.x), bf_hi(gb.x), bf_lo(gb.y), bf_hi(gb.y)};
#pragma unroll
                        for (int j = 0; j < 4; ++j) { const float ea = __expf(-fminf(fmaxf(a_[j], -30.f), 30.f)), eb = __expf(-fminf(fmaxf(b_[j], -30.f), 30.f));
                            acc[ai][bj][m][n][j] *= (1.0f + eb) * __builtin_amdgcn_rcpf(1.0f + ea); } }
                asm volatile("" ::: "memory"); }
    }
    __device__ __forceinline__ void operator()(const f32x4 (&acc)[2][2][4][2], const Unit& u, int wr, int wc, int fr, int fq) const {
        const int row0 = u.pm * BM + wr * 64 + fr, col0 = u.pn * BM + wc * 32 + 4 * fq;
#pragma unroll
        for (int ai = 0; ai < 2; ++ai)
#pragma unroll
            for (int m = 0; m < 4; ++m) { const int r = row0 + ai * HALF + m * 16; const bf16_t* prow = P + (size_t)r * ldp + gcol0 + 2 * 2048;
#pragma unroll
                for (int bj = 0; bj < 2; ++bj)
#pragma unroll
                    for (int n = 0; n < 2; ++n) { const int c = col0 + bj * HALF + n * 16; const u32x2 gw = *(const u32x2*)(prow + c);
                        const float g_[4] = {bf_lo(gw.x), bf_hi(gw.x), bf_lo(gw.y), bf_hi(gw.y)}; f32x4 v = acc[ai][bj][m][n];
#pragma unroll
                        for (int j = 0; j < 4; ++j) v[j] *= __builtin_amdgcn_rcpf(1.0f + __expf(-fminf(fmaxf(g_[j], -30.f), 30.f)));
                        u32x2 w; w.x = cvt_pk_bf16(v[0], v[1]); w.y = cvt_pk_bf16(v[2], v[3]); *(u32x2*)(merged + (size_t)r * 2048 + c) = w; }
                asm volatile("" ::: "memory"); }
    }
};
struct BranchOrder {                              static constexpr bool GATHER = false; __device__ __forceinline__ int arow(const Unit&, int) const { return 0; }
    StaticOrder so;
    __device__ void init(int G_, int c_) { so.init(16384, 2048, G_, c_); }
    __device__ bool next(int i, Unit& u) const { const int br = i % 3; Unit t; if (!so.next(i / 3, t)) return false; u.pm = br * 64 + t.pm; u.pn = br * 8 + t.pn; return true; }
    __device__ __forceinline__ void a_ready(const Unit&) const {}
    __device__ __forceinline__ void done(const Unit&) const {}
};
template <bool GATH> struct MoeOrder {
    static constexpr bool GATHER = GATH;
    StaticOrder so; const int* tile_e; const int* tok; int nN;
    __device__ void init(int ntiles, int nN_, int G_, int c_, const int* te, const int* tk) { so.init(ntiles * BM, nN_ * BM, G_, c_); tile_e = te; tok = tk; nN = nN_; }
    __device__ bool next(int i, Unit& u) const { Unit t; if (!so.next(i, t)) return false; u.pm = t.pm; u.pn = tile_e[t.pm] * nN + t.pn; return true; }
    __device__ __forceinline__ int arow(const Unit& u, int r) const { return tok[u.pm * BM + r]; }
    __device__ __forceinline__ void a_ready(const Unit&) const {}
    __device__ __forceinline__ void done(const Unit&) const {}
};
template <class Epi, class Sched, bool ALIGN_EPI = false, bool SP2 = false>
__device__ __forceinline__ void gemm_phase(PG8_LAS unsigned char* lds, const Gemm g, const Sched& S, const Epi& E) {
    const int tid = threadIdx.x, wid = __builtin_amdgcn_readfirstlane(tid >> 6), lane = tid & 63, wr = wid >> 2, wc = wid & 3, fr = lane & 15, fq = lane >> 4;
    const int K = g.K, nt = K / BK;
    unsigned voffA[2], voffB[2];
#pragma unroll
    for (int i = 0; i < 2; ++i) { int R, C; stage_rc(tid * 16 + i * 8192, R, C); const int Rb = Epi::PERM ? ((R & ~31) + perm32(R & 31)) : R;
        voffA[i] = (unsigned)(R * K + C) * 2u; voffB[i] = (unsigned)(Rb * K + C) * 2u; }
    unsigned vc[2][2] = {{0u, 0u}, {0u, 0u}}, vn[2][2] = {{0u, 0u}, {0u, 0u}};
#define PG8_ROWS(dst, un) do { if constexpr (Sched::GATHER) { _Pragma("unroll") for (int _h = 0; _h < 2; ++_h) _Pragma("unroll") for (int _i = 0; _i < 2; ++_i) { int R_, C_; stage_rc(tid * 16 + _i * 8192, R_, C_); \
        dst[_h][_i] = (unsigned)(S.arow(un, _h * HALF + R_) * K + C_) * 2u; } } } while (0)
#define PG8_STAGE_A(bufoff, abase, half, nx) do { if constexpr (Sched::GATHER) { unsigned vo_[2]; vo_[0] = (nx) ? vn[half][0] : vc[half][0]; vo_[1] = (nx) ? vn[half][1] : vc[half][1]; PG8_STAGE(bufoff, abase, vo_); } \
        else { PG8_STAGE(bufoff, (abase) + (half) * hstep, voffA); } } while (0)
    const size_t kstep = (size_t)(BK * 2);
    const size_t hstep = (size_t)HALF * K * 2;
    const size_t tstep = 2 * hstep;
    const unsigned ldsw = (unsigned)wid * 1024u;
    const int aoff = lds_byte(wr * 64 + fr, fq * 8), boff = lds_byte(wc * 32 + fr, fq * 8);
#define PG8_SA(b, h) (((b) * 2 + (h)) * HTB)
#define PG8_SB(b, h) ((4 + (b) * 2 + (h)) * HTB)
#define PG8_STAGE(bufoff, gbase, voff) do { _Pragma("unroll") for (int _i = 0; _i < 2; ++_i) \
        __builtin_amdgcn_global_load_lds((const unsigned*)((const char*)(gbase) + (voff)[_i]), (PG8_LAS unsigned*)(lds + (bufoff) + ldsw + _i * 8192), 16, 0, 0); } while (0)
#define PG8_LDA(dst, b, h) do { _Pragma("unroll") for (int m = 0; m < 4; ++m) _Pragma("unroll") for (int k = 0; k < 2; ++k) dst[m][k] = *(const PG8_LAS bf16x8*)(lds + PG8_SA(b, h) + aoff + m * 2048 + k * 1024); } while (0)
#define PG8_LDB(dst, b, h) do { _Pragma("unroll") for (int n = 0; n < 2; ++n) _Pragma("unroll") for (int k = 0; k < 2; ++k) dst[n][k] = *(const PG8_LAS bf16x8*)(lds + PG8_SB(b, h) + boff + n * 2048 + k * 1024); } while (0)
#define PG8_MMA(ai, bj, At, Bt) do { __builtin_amdgcn_s_setprio(1); _Pragma("unroll") for (int m = 0; m < 4; ++m) _Pragma("unroll") for (int n = 0; n < 2; ++n) _Pragma("unroll") for (int k = 0; k < 2; ++k) \
        acc[ai][bj][m][n] = __builtin_amdgcn_mfma_f32_16x16x32_bf16(Bt[n][k], At[m][k], acc[ai][bj][m][n], 0, 0, 0); __builtin_amdgcn_s_setprio(0); } while (0)
#define PG8_WAIT_V(n) asm volatile("s_waitcnt vmcnt(" #n ")" ::: "memory")
#define PG8_WAIT_L(n) asm volatile("s_waitcnt lgkmcnt(" #n ")" ::: "memory")
#define PG8_BAR __builtin_amdgcn_s_barrier()
#define PG8_SCHED __builtin_amdgcn_sched_barrier(0)
    Unit cur, nxt; int ui = 0;
    if (!S.next(0, cur)) return;
    f32x4 acc[2][2][4][2];
#pragma unroll
    for (int a = 0; a < 2; ++a)
#pragma unroll
        for (int b = 0; b < 2; ++b)
#pragma unroll
            for (int m = 0; m < 4; ++m)
#pragma unroll
                for (int n = 0; n < 2; ++n) acc[a][b][m][n] = (f32x4){0.f, 0.f, 0.f, 0.f};
    bf16x8 At[4][2], B0[2][2], B1[2][2];
    const char* cA = (const char*)g.A + (Sched::GATHER ? (size_t)0 : (size_t)cur.pm * tstep); const char* cB = (const char*)g.Bt + (size_t)cur.pn * tstep;
    PG8_ROWS(vc, cur);
    S.a_ready(cur);
    if constexpr (SP2) {
        PG8_STAGE(PG8_SB(0, 0), cB, voffB); PG8_STAGE(PG8_SB(0, 1), cB + hstep, voffB); PG8_STAGE_A(PG8_SA(0, 0), cA, 0, false); PG8_STAGE_A(PG8_SA(0, 1), cA, 1, false);
        if (wr == 1) PG8_BAR;
        PG8_WAIT_V(2); PG8_BAR;
        PG8_STAGE(PG8_SB(1, 0), cB + kstep, voffB); PG8_STAGE_A(PG8_SA(1, 0), cA + kstep, 0, false); PG8_STAGE(PG8_SB(1, 1), cB + hstep + kstep, voffB);
        PG8_WAIT_V(6); PG8_BAR;
    } else {
        PG8_STAGE(PG8_SB(0, 0), cB, voffB); PG8_STAGE_A(PG8_SA(0, 0), cA, 0, false); PG8_STAGE(PG8_SB(0, 1), cB + hstep, voffB); PG8_STAGE_A(PG8_SA(0, 1), cA, 1, false);
        if (wr == 1) PG8_BAR;
        PG8_WAIT_V(4); PG8_BAR;
        PG8_STAGE(PG8_SB(1, 0), cB + kstep, voffB); PG8_STAGE_A(PG8_SA(1, 0), cA + kstep, 0, false); PG8_STAGE(PG8_SB(1, 1), cB + hstep + kstep, voffB);
        PG8_WAIT_V(6); PG8_BAR;
    }
    for (;;) {
        const bool has_next = S.next(ui + 1, nxt);
        if (has_next) PG8_ROWS(vn, nxt);
        const char* nA = (has_next && !Sched::GATHER) ? (const char*)g.A + (size_t)nxt.pm * tstep : cA; const char* nB = has_next ? (const char*)g.Bt + (size_t)nxt.pn * tstep : cB;
        for (int t = 0; t < nt; t += 2) {
            const bool last = (t == nt - 2);
            const char* a1 = cA + (size_t)(t + 1) * kstep;
            const char* a2 = last ? nA : cA + (size_t)(t + 2) * kstep; const char* b2 = last ? nB : cB + (size_t)(t + 2) * kstep;
            const char* a3 = a2 + kstep; const char* b3 = b2 + kstep;
            if (last && has_next) S.a_ready(nxt);
            if constexpr (Epi::MIDK > 0) { if (t == Epi::MIDK || t == 2 * Epi::MIDK) E.mid(acc, cur, t / Epi::MIDK, wr, wc, fr, fq); }
            if constexpr (SP2) {
            PG8_LDB(B0, 0, 0); PG8_LDB(B1, 0, 1); PG8_SCHED; PG8_LDA(At, 0, 0); PG8_STAGE_A(PG8_SA(1, 1), a1, 1, false);
            PG8_WAIT_V(8); PG8_WAIT_L(0); PG8_BAR; PG8_MMA(0, 0, At, B0); PG8_MMA(0, 1, At, B1); PG8_BAR; PG8_SCHED;
            PG8_LDA(At, 0, 1); PG8_STAGE(PG8_SB(0, 0), b2, voffB); PG8_STAGE(PG8_SB(0, 1), b2 + hstep, voffB); PG8_STAGE_A(PG8_SA(0, 0), a2, 0, last);
            PG8_WAIT_V(8); PG8_WAIT_L(0); PG8_BAR; PG8_MMA(1, 0, At, B0); PG8_MMA(1, 1, At, B1); PG8_BAR; PG8_SCHED;
            PG8_LDB(B0, 1, 0); PG8_LDB(B1, 1, 1); PG8_SCHED; PG8_LDA(At, 1, 0); PG8_STAGE_A(PG8_SA(0, 1), a2, 1, last);
            PG8_WAIT_V(8); PG8_WAIT_L(0); PG8_BAR; PG8_MMA(0, 0, At, B0); PG8_MMA(0, 1, At, B1); PG8_BAR; PG8_SCHED;
            PG8_LDA(At, 1, 1); PG8_STAGE(PG8_SB(1, 0), b3, voffB); PG8_STAGE(PG8_SB(1, 1), b3 + hstep, voffB); PG8_STAGE_A(PG8_SA(1, 0), a3, 0, last);
            PG8_WAIT_V(8); PG8_WAIT_L(0); PG8_BAR; PG8_MMA(1, 0, At, B0); PG8_MMA(1, 1, At, B1); PG8_BAR; PG8_SCHED;
            } else {
            PG8_LDB(B0, 0, 0); PG8_SCHED; PG8_LDA(At, 0, 0); PG8_STAGE_A(PG8_SA(1, 1), a1, 1, false);
            PG8_WAIT_L(8); PG8_BAR; PG8_WAIT_L(0); PG8_MMA(0, 0, At, B0); PG8_BAR; PG8_SCHED;
            PG8_LDB(B1, 0, 1); PG8_STAGE(PG8_SB(0, 0), b2, voffB);
            PG8_BAR; PG8_WAIT_L(0); PG8_MMA(0, 1, At, B1); PG8_BAR;
            PG8_LDA(At, 0, 1); PG8_STAGE_A(PG8_SA(0, 0), a2, 0, last);
            PG8_BAR; PG8_WAIT_L(0); PG8_MMA(1, 0, At, B0); PG8_BAR; PG8_SCHED;
            PG8_STAGE(PG8_SB(0, 1), b2 + hstep, voffB);
            PG8_WAIT_V(6); PG8_BAR; PG8_MMA(1, 1, At, B1); PG8_BAR;
            PG8_LDB(B0, 1, 0); PG8_SCHED; PG8_LDA(At, 1, 0); PG8_STAGE_A(PG8_SA(0, 1), a2, 1, last);
            PG8_WAIT_L(8); PG8_BAR; PG8_WAIT_L(0); PG8_MMA(0, 0, At, B0); PG8_BAR; PG8_SCHED;
            PG8_LDB(B1, 1, 1); PG8_STAGE(PG8_SB(1, 0), b3, voffB);
            PG8_BAR; PG8_WAIT_L(0); PG8_MMA(0, 1, At, B1); PG8_BAR;
            PG8_LDA(At, 1, 1); PG8_STAGE_A(PG8_SA(1, 0), a3, 0, last);
            PG8_BAR; PG8_WAIT_L(0); PG8_MMA(1, 0, At, B0); PG8_BAR; PG8_SCHED;
            PG8_STAGE(PG8_SB(1, 1), b3 + hstep, voffB);
            PG8_WAIT_V(6); PG8_BAR; PG8_MMA(1, 1, At, B1); PG8_BAR;
            }
        }
        if constexpr (ALIGN_EPI) { if (wr == 0) PG8_BAR; }
        if constexpr (!Epi::AFTER_DRAIN) { E(acc, cur, wr, wc, fr, fq); S.done(cur); }
        if (!has_next) break;
#pragma unroll
        for (int a = 0; a < 2; ++a)
#pragma unroll
            for (int b = 0; b < 2; ++b)
#pragma unroll
                for (int m = 0; m < 4; ++m)
#pragma unroll
                    for (int n = 0; n < 2; ++n) acc[a][b][m][n] = (f32x4){0.f, 0.f, 0.f, 0.f};
        cur = nxt; cA = nA; cB = nB; ++ui;
        if constexpr (Sched::GATHER) { vc[0][0] = vn[0][0]; vc[0][1] = vn[0][1]; vc[1][0] = vn[1][0]; vc[1][1] = vn[1][1]; }
        if constexpr (ALIGN_EPI) { if (wr == 1) PG8_BAR; }
    }
    PG8_WAIT_V(0);
    if constexpr (!ALIGN_EPI) { if (wr == 0) PG8_BAR; }
    PG8_BAR;
    if constexpr (Epi::AFTER_DRAIN) { E.fused(acc, cur, wr, wc, fr, fq, lds, wid, lane); S.done(cur); }
#undef PG8_SA
#undef PG8_SB
#undef PG8_STAGE
#undef PG8_STAGE_A
#undef PG8_ROWS
#undef PG8_LDA
#undef PG8_LDB
#undef PG8_MMA
#undef PG8_WAIT_V
#undef PG8_WAIT_L
#undef PG8_BAR
#undef PG8_SCHED
}
}

constexpr int NWAVES = 8;
constexpr int BATCH = 2, SEQ = 8192, T = BATCH * SEQ, D = 2048;
constexpr int RWKV_COLS = 3360, IN_COLS = 12576;
constexpr int NP = 12800;
constexpr int PC_LX = 3584, PC_LY = 4608, PC_Q = 5632, PC_G = 6656;
constexpr int NE = 32, MAXROWS = 65536 + NE * 256;
constexpr int LORA_K = 384;
constexpr float EPS = 1e-6f, GN_EPS = 64e-5f;

constexpr size_t MiB = 1u << 20;
constexpr size_t WS_CTL = 0, CTL_ZERO_BYTES = 1 * MiB;
constexpr size_t WS_WIN = 1 * MiB, WS_WMKV = 51 * MiB, WS_WLORA = 59 * MiB, WS_WBR = 62 * MiB, WS_WO = 74 * MiB, WS_WR = 82 * MiB, WS_LW = 83 * MiB;
constexpr size_t WS_WGU = 84 * MiB, WS_WD = 596 * MiB;
constexpr size_t WS_XN = 852 * MiB;
constexpr size_t WS_P = 916 * MiB;
constexpr size_t WS_LORAOUT = 1316 * MiB;
constexpr size_t WS_SCAN = 1508 * MiB;
constexpr size_t WS_YABC = 1892 * MiB;
constexpr size_t WS_MISC = 1988 * MiB;
constexpr size_t WS_MN = WS_MISC, WS_KMEM = WS_MISC + 2 * MiB, WS_VT = WS_MISC + 3 * MiB, WS_LRUC = WS_MISC + 4 * MiB  , WS_BONUS = WS_MISC + 7 * MiB;
constexpr size_t WS_PICK = WS_MISC + 8 * MiB  , WS_ROWTAB = WS_MISC + 9 * MiB  , WS_SPL = WS_ROWTAB + 512 * 1024  ;
constexpr size_t WS_END = 2000 * MiB;
constexpr size_t WS_MACC = WS_LORAOUT, WS_MERGED = 1444 * MiB, WS_H1 = WS_SCAN, WS_XS = WS_P, WS_OROW = WS_P, WS_HH = 1204 * MiB;
constexpr int CW_BAR = 4096, CW_CNT = 8192, CW_NTILES = 8192 + 64, CW_TILEE = 8192 + 128;

constexpr int LDS_BYTES = 147456;
constexpr int MISC_OFF = 143360;

#define GAS __attribute__((address_space(1)))
#define LAS __attribute__((address_space(3)))
typedef unsigned short bf16;
typedef unsigned v4u __attribute__((ext_vector_type(4)));
typedef unsigned v2u __attribute__((ext_vector_type(2)));
typedef float f32x4 __attribute__((ext_vector_type(4)));
typedef float f32x2 __attribute__((ext_vector_type(2)));
typedef short bf16x8 __attribute__((ext_vector_type(8)));
#define LDS_WAIT() asm volatile("s_waitcnt lgkmcnt(0)" ::: "memory")
#define VM_WAIT() asm volatile("s_waitcnt vmcnt(0)" ::: "memory")
__device__ __forceinline__ unsigned f2bf(float f) { unsigned u = __builtin_bit_cast(unsigned, f); return (u + 0x7fffu + ((u >> 16) & 1u)) >> 16; }
__device__ __forceinline__ unsigned pk2(float lo, float hi) { return f2bf(lo) | (f2bf(hi) << 16); }
__device__ __forceinline__ float bflo(unsigned w) { return __builtin_bit_cast(float, w << 16); }
__device__ __forceinline__ float bfhi(unsigned w) { return __builtin_bit_cast(float, w & 0xffff0000u); }
__device__ __forceinline__ float bf1(bf16 b) { return __builtin_bit_cast(float, (unsigned)b << 16); }
__device__ __forceinline__ float sigm(float x) { return __builtin_amdgcn_rcpf(1.0f + __expf(-x)); }
__device__ __forceinline__ float fast_tanh(float x) { const float e = __expf(2.0f * x); return 1.0f - 2.0f * __builtin_amdgcn_rcpf(e + 1.0f); }
__device__ __forceinline__ float softplusf(float x) { return fmaxf(x, 0.f) + log1pf(__expf(-fabsf(x))); }
__device__ __forceinline__ float wave_sum(float v) {
#pragma unroll
    for (int o = 1; o < 64; o <<= 1) v += __shfl_xor(v, o);
    return v;
}
template <int CTRL> __device__ __forceinline__ float dppf(float x) { return __builtin_bit_cast(float, __builtin_amdgcn_mov_dpp(__builtin_bit_cast(int, x), CTRL, 0xf, 0xf, true)); }
__device__ __forceinline__ float row16_sum(float v) {
    v += dppf<0xB1>(v); v += dppf<0x4E>(v); v += dppf<0x141>(v); v += dppf<0x140>(v); return v;
}
#define XB_TMO      128
#define XB_XCNT(j)  (256  + 64 * (j))
#define XB_XSUB(j)  (1280 + 64 * (j))
#define XB_XGEN(j)  (2304 + 64 * (j))
#define XB_TOP      3328
#define XB_TOPGEN   3392
#define XCD_BAR_WORDS 3456
#define XB_SPIN_CAP (1u << 18)

__device__ __forceinline__ unsigned xb_ld(unsigned* p)              { return __hip_atomic_load(p, __ATOMIC_RELAXED, __HIP_MEMORY_SCOPE_AGENT); }
__device__ __forceinline__ unsigned xb_add(unsigned* p, unsigned v) { return __hip_atomic_fetch_add(p, v, __ATOMIC_RELAXED, __HIP_MEMORY_SCOPE_AGENT); }
__device__ __forceinline__ unsigned xb_xcc_id() { return (unsigned)__builtin_amdgcn_s_getreg((3 << 11) | 20) & 0xFu; }
#define XB_SPIN(cond, bar) do { unsigned _sp = 0; while (cond) { __builtin_amdgcn_s_sleep(1); \
    if ((++_sp & 255u) == 0u) { if (xb_ld(&(bar)[XB_TMO])) break; if (_sp > XB_SPIN_CAP) { atomicAdd(&(bar)[XB_TMO], 1u); break; } } } } while (0)

struct XcdBarrier {
    unsigned* bar; unsigned x;
    volatile LAS unsigned* st;
};

__device__ __forceinline__ XcdBarrier xcd_barrier_post(unsigned* bar, volatile LAS unsigned* st) {
    XcdBarrier b; b.bar = bar; b.x = xb_xcc_id(); b.st = st;
    if (threadIdx.x == 0) (void)xb_add(&bar[XB_XCNT(b.x)], 1u);
    return b;
}
__device__ __forceinline__ void xcd_barrier_complete(unsigned* bar, unsigned x, unsigned& nloc, unsigned& nx) {
    const unsigned G = gridDim.x * gridDim.y * gridDim.z;
    unsigned sum, cnt, mine, sp = 0u;
    for (;;) {
        sum = 0u; cnt = 0u; mine = 0u;
#pragma unroll
        for (unsigned j = 0; j < 16; ++j) { const unsigned c = xb_ld(&bar[XB_XCNT(j)]); sum += c; cnt += (c > 0u) ? 1u : 0u; mine = (j == x) ? c : mine; }
        if (sum == G) break;
        __builtin_amdgcn_s_sleep(1);
        if ((++sp & 255u) == 0u) { if (xb_ld(&bar[XB_TMO])) break; if (sp > XB_SPIN_CAP) { atomicAdd(&bar[XB_TMO], 1u); break; } }
    }
    nloc = mine > 0u ? mine : 1u; nx = cnt > 0u ? cnt : 1u;
}

__device__ __forceinline__ void xcd_barrier(const XcdBarrier& b) {
    asm volatile("s_waitcnt vmcnt(0)" ::: "memory");
    __syncthreads();
    if (threadIdx.x == 0) {
        unsigned* bar = b.bar;
        __builtin_amdgcn_s_waitcnt(0);
        unsigned nloc = b.st[0], nx = b.st[1];
        if (nloc == 0u) { xcd_barrier_complete(bar, b.x, nloc, nx); b.st[0] = nloc; b.st[1] = nx; }
        const unsigned old = xb_add(&bar[XB_XSUB(b.x)], 1u);
        const unsigned gen = old / nloc;
        if (old + 1u == (gen + 1u) * nloc) {
            __builtin_amdgcn_fence(__ATOMIC_RELEASE, "agent");
            asm volatile("s_waitcnt vmcnt(0)" ::: "memory");
            const unsigned og = xb_add(&bar[XB_TOP], 1u);
            const unsigned tg = og / nx;
            if (og + 1u == (tg + 1u) * nx) xb_add(&bar[XB_TOPGEN], 1u);
            else XB_SPIN(xb_ld(&bar[XB_TOPGEN]) == tg, bar);
            __builtin_amdgcn_fence(__ATOMIC_ACQUIRE, "agent");
            xb_add(&bar[XB_XGEN(b.x)], 1u);
            asm volatile("s_waitcnt vmcnt(0)" ::: "memory");
        } else {
            XB_SPIN(xb_ld(&bar[XB_XGEN(b.x)]) == gen, bar);
            __builtin_amdgcn_fence(__ATOMIC_ACQUIRE, "agent");
            asm volatile("s_waitcnt vmcnt(0)" ::: "memory");
        }
    }
    __syncthreads();
}

struct Frame {
    LAS unsigned char* lds;
    volatile LAS unsigned* MISC;
    int tid, lane, wave, vcu, G;
};
struct Args { const float* in[39]; float* out; unsigned char* ws; int ph_lo, ph_hi; };
enum { I_X = 0, I_MEM, I_GMIX, I_WIN, I_MU, I_W0, I_W2, I_A0, I_A2, I_G2, I_KK, I_KA, I_RK, I_LNW, I_LNB, I_WRO, I_CONVW, I_CONVB, I_LWR, I_LBR, I_LWI, I_LBI, I_LAM, I_WLO,
       I_GMEM, I_WMK, I_WMV, I_WXO, I_WOUT, I_GFFN, I_WROUTER, I_BROUTER, I_WGATE, I_BGATE, I_WUP, I_BUP, I_WDOWN, I_BDOWN, I_GFINAL };


__device__ __forceinline__ const float* inp(int k) {
    typedef const volatile unsigned long long __attribute__((address_space(4))) ka_t;
    ka_t* ka = (ka_t*)__builtin_amdgcn_kernarg_segment_ptr();
    return (const float*)ka[k];
}
template <int NB> __device__ __forceinline__ void transpose_item(const float* W, int N, int k0, int n0, bf16* WT, int Kd, int drow0, int lane, int kdo = 0) {
    constexpr int LPR = NB / 4, G = 64 / LPR, KR = 64 / G;
    const int g = lane / LPR, c = lane % LPR;
    const GAS float* src = (const GAS float*)W + (size_t)(k0 + KR * g) * N + n0 + 4 * c;
    f32x4 ld[KR];
#pragma unroll
    for (int i = 0; i < KR; ++i) ld[i] = __builtin_nontemporal_load((const GAS f32x4*)(src + (size_t)i * N));
    GAS bf16* dst = (GAS bf16*)WT + (size_t)(drow0 + 4 * c) * Kd + kdo + k0 + KR * g;
#pragma unroll
    for (int j = 0; j < 4; ++j)
#pragma unroll
        for (int q = 0; q < KR / 8; ++q) { v4u o; o.x = pk2(ld[8 * q + 0][j], ld[8 * q + 1][j]); o.y = pk2(ld[8 * q + 2][j], ld[8 * q + 3][j]); o.z = pk2(ld[8 * q + 4][j], ld[8 * q + 5][j]); o.w = pk2(ld[8 * q + 6][j], ld[8 * q + 7][j]);
            *(GAS v4u*)(dst + (size_t)j * Kd + 8 * q) = o; }
}
__device__ __forceinline__ void rms_row_to_bf16(const float* xrow, const float* gain, bf16* orow, int lane) {
    const GAS f32x4* xr = (const GAS f32x4*)xrow + lane; const GAS f32x4* gr = (const GAS f32x4*)gain + lane;
    f32x4 v[8]; float s = 0.f;
#pragma unroll
    for (int j = 0; j < 8; ++j) { v[j] = xr[64 * j]; s += (v[j].x * v[j].x + v[j].y * v[j].y) + (v[j].z * v[j].z + v[j].w * v[j].w); }
    const float rstd = 1.0f / sqrtf(wave_sum(s) * (1.f / D) + EPS);
    GAS v2u* o8 = (GAS v2u*)orow + lane;
#pragma unroll
    for (int j = 0; j < 8; ++j) { const f32x4 g = gr[64 * j]; v2u w; w.x = pk2(v[j].x * rstd * g.x, v[j].y * rstd * g.y); w.y = pk2(v[j].z * rstd * g.z, v[j].w * rstd * g.w); o8[64 * j] = w; }
}

__device__ __forceinline__ void p0_prologue(const Frame& F, const Args& a) {
    unsigned char* ws = a.ws;
    const int gw = F.vcu * NWAVES + F.wave, NGW = F.G * NWAVES;
    constexpr int I_IN = 32 * (IN_COLS / 32), I_MK = 32 * 32, I_BR = 16 * 64, I_O = 32 * 64;
    constexpr int NITEMS = I_IN + 2 * I_MK + 3 * I_BR + I_O;
    for (int it = gw; it < NITEMS; it += NGW) {
        int r = it;
        if (r < I_IN) { const int nb = IN_COLS / 32, kb = r / nb, n0 = 32 * (r % nb); transpose_item<32>(inp(I_WIN), IN_COLS, 64 * kb, n0, (bf16*)(ws + WS_WIN), D, n0 + (n0 >= RWKV_COLS ? 224 : 0), F.lane); continue; } r -= I_IN;
        if (r < I_MK) { transpose_item<32>(inp(I_WMK), 1024, 64 * (r / 32), 32 * (r % 32), (bf16*)(ws + WS_WMKV), D, 32 * (r % 32), F.lane); continue; } r -= I_MK;
        if (r < I_MK) { transpose_item<32>(inp(I_WMV), 1024, 64 * (r / 32), 32 * (r % 32), (bf16*)(ws + WS_WMKV), D, 1024 + 32 * (r % 32), F.lane); continue; } r -= I_MK;
        if (r < I_BR) { transpose_item<32>(inp(I_WRO), 2048, 64 * (r / 64), 32 * (r % 64), (bf16*)(ws + WS_WBR), 3072, 32 * (r % 64), F.lane, 0); continue; } r -= I_BR;
        if (r < I_BR) { transpose_item<32>(inp(I_WLO), 2048, 64 * (r / 64), 32 * (r % 64), (bf16*)(ws + WS_WBR), 3072, 32 * (r % 64), F.lane, 1024); continue; } r -= I_BR;
        if (r < I_BR) { transpose_item<32>(inp(I_WXO), 2048, 64 * (r / 64), 32 * (r % 64), (bf16*)(ws + WS_WBR), 3072, 32 * (r % 64), F.lane, 2048); continue; } r -= I_BR;
        transpose_item<32>(inp(I_WOUT), 2048, 64 * (r / 64), 32 * (r % 64), (bf16*)(ws + WS_WO), D, 32 * (r % 64), F.lane);
    }
    for (int m = gw; m < T; m += NGW) rms_row_to_bf16(inp(I_X) + (size_t)m * D, inp(I_GMIX), (bf16*)(ws + WS_XN) + (size_t)m * D, F.lane);
    for (int m = gw; m < 512; m += NGW) rms_row_to_bf16(inp(I_MEM) + (size_t)m * D, inp(I_GMEM), (bf16*)(ws + WS_MN) + (size_t)m * D, F.lane);
    const int gt = F.vcu * (NWAVES * 64) + F.tid, NGT = F.G * NWAVES * 64;
    { bf16* wz = (bf16*)(ws + WS_WIN) + (size_t)RWKV_COLS * D; for (int i = gt; i < 224 * D / 2; i += NGT) ((GAS unsigned*)wz)[i] = 0u; }
    { bf16* wl = (bf16*)(ws + WS_WLORA);
      for (int i = gt; i < 3072 * LORA_K; i += NGT) { const int n = i / LORA_K, k = i % LORA_K; float v = 0.f;
          if (n < 1024) { if (k < 64) v = inp(I_W2)[k * 1024 + n]; }
          else if (n < 2048) { if (k >= 64 && k < 128) v = inp(I_A2)[(k - 64) * 1024 + (n - 1024)]; }
          else { if (k >= 128 && k < 288) v = inp(I_G2)[(k - 128) * 1024 + (n - 2048)]; }
          wl[i] = (bf16)f2bf(v); } }
    { const float* lam = inp(I_LAM); float* spl = (float*)(ws + WS_SPL); for (int i = gt; i < 1024; i += NGT) spl[i] = softplusf(-lam[i]); }
    { bf16* wr = (bf16*)(ws + WS_WR);
      for (int i = gt; i < 32 * D; i += NGT) { const int e = i / D, k = i % D; const float w = inp(I_WROUTER)[k * 32 + e]; const unsigned hi = f2bf(w); const float r = w - __builtin_bit_cast(float, hi << 16);
          wr[i] = (bf16)hi; wr[32 * D + i] = (bf16)f2bf(r); } }
    { const float* lwi_p = inp(I_LWI); const float* lwr_p = inp(I_LWR); bf16* lw = (bf16*)(ws + WS_LW);
      for (int i = gt; i < 2 * 16 * 4 * 2 * 64 * 8; i += NGT) { const int j = i & 7, ln = (i >> 3) & 63, ks = (i >> 9) & 1, vbo = (i >> 10) & 3, n = (i >> 12) & 15, mat = i >> 16;
          const int w = 32 * ks + 16 * (j >> 2) + 4 * (ln >> 4) + (j & 3), v = 16 * vbo + (ln & 15);
          lw[i] = (bf16)f2bf((mat ? lwi_p : lwr_p)[(n * 64 + w) * 64 + v]); } }
}

__device__ __forceinline__ void moe_weight_convert(const Frame& F, const Args& a, int gw, int NGW) {
    unsigned char* ws = a.ws;
    const float* wg = inp(I_WGATE); const float* wu = inp(I_WUP); const float* wd = inp(I_WDOWN);
    constexpr int PER = 1024;
    for (int it = gw; it < NE * 3 * PER; it += NGW) {
        const int e = it / (3 * PER), r = it % (3 * PER), which = r / PER, q = r % PER, k0 = 64 * (q / 32), n0 = 64 * (q % 32);
        if (which == 0) transpose_item<64>(wg + (size_t)e * D * D, D, k0, n0, (bf16*)(ws + WS_WGU) + (size_t)e * 4096 * D, D, (n0 >> 7) * 256 + (n0 & 127), F.lane);
        else if (which == 1) transpose_item<64>(wu + (size_t)e * D * D, D, k0, n0, (bf16*)(ws + WS_WGU) + (size_t)e * 4096 * D, D, (n0 >> 7) * 256 + 128 + (n0 & 127), F.lane);
        else transpose_item<64>(wd + (size_t)e * D * D, D, k0, n0, (bf16*)(ws + WS_WD) + (size_t)e * 2048 * D, D, n0, F.lane);
    }
}

__device__ __forceinline__ void r1_lora_in(const Frame& F, const Args& a) {
    const bf16* P = (const bf16*)(a.ws + WS_P); bf16* L = (bf16*)(a.ws + WS_XN);
    const float* mu = inp(I_MU);
    const int gw = F.vcu * NWAVES + F.wave, NGW = F.G * NWAVES;
    for (int m = gw; m < T; m += NGW) {
        const bool first = (m % SEQ) == 0;
#pragma unroll
        for (int j = 0; j < 6; ++j) { const int k = F.lane + 64 * j; float o = 0.f;
            if (k < 288) { const int c = 3072 + k; const float cur = bf1(P[(size_t)m * NP + c]); const float prev = first ? 0.f : bf1(P[(size_t)(m - 1) * NP + c]);
                const float x = cur + (prev - cur) * mu[c]; o = k < 64 ? fast_tanh(x) : (k < 128 ? x : sigm(x)); }
            L[(size_t)m * LORA_K + k] = (bf16)f2bf(o); }
    }
}

constexpr int REC_F = 2816, REC_AT = 0, REC_RT = 512, REC_BKT = 1024, REC_WC = 2048, REC_N = 2112, REC_Q = 2176, REC_V8 = 2240;
__device__ __forceinline__ float wave_sum_fast(float v) { v = row16_sum(v); v += __shfl_xor(v, 16); v += __shfl_xor(v, 32); return v; }
__device__ __forceinline__ void r3_blocks(const Frame& F, const Args& a) {
    const GAS bf16* P = (const GAS bf16*)(a.ws + WS_P); const GAS float* LO = (const GAS float*)(a.ws + WS_LORAOUT);
    GAS float* REC = (GAS float*)(a.ws + WS_SCAN); GAS float* BON = (GAS float*)(a.ws + WS_BONUS);
    const GAS float* mu = (const GAS float*)inp(I_MU); const GAS float* w0 = (const GAS float*)inp(I_W0); const GAS float* a0 = (const GAS float*)inp(I_A0);
    const GAS float* kkp = (const GAS float*)inp(I_KK); const GAS float* kap = (const GAS float*)inp(I_KA); const GAS float* rkp = (const GAS float*)inp(I_RK);
    LAS float* G1 = (LAS float*)(F.lds + F.wave * 16384);
    LAS float* G2 = G1 + 2048;
    const int gw = F.vcu * NWAVES + F.wave, NGW = F.G * NWAVES, lane = F.lane;
#pragma unroll 1
    for (int it = gw; it < 32 * 1024; it += NGW) {
        const int bh = it >> 10, blk = it & 1023, b = bh >> 4, h = bh & 15, c = h * 64 + lane, m0 = b * SEQ + blk * 8;
        const float mur = mu[c], muk = mu[1024 + c], muv = mu[2048 + c], w0c = w0[c], a0c = a0[c], kkw = kkp[c], kaw = kap[c], rkw = rkp[c];
        float w[8], av[8], bv[8], kv[8], rv[8], vv[8], ag[8], kk[8], n2[8], bo[8];
        float pr = 0.f, pk = 0.f, pv = 0.f;
        if (blk > 0) { const GAS bf16* pp = P + (size_t)(m0 - 1) * NP; pr = bf1(pp[c]); pk = bf1(pp[1024 + c]); pv = bf1(pp[2048 + c]); }
#pragma unroll
        for (int t = 0; t < 8; ++t) { const GAS bf16* pc = P + (size_t)(m0 + t) * NP; const float cr = bf1(pc[c]), ck = bf1(pc[1024 + c]), cv = bf1(pc[2048 + c]);
            const float r = cr + (pr - cr) * mur, k = ck + (pk - ck) * muk, v = cv + (pv - cv) * muv; pr = cr; pk = ck; pv = cv;
            const float wpre = w0c + LO[(size_t)(m0 + t) * 3072 + c], apre = a0c + LO[(size_t)(m0 + t) * 3072 + 1024 + c];
            w[t] = __expf(-0.6065306597126334f * __builtin_amdgcn_rcpf(1.0f + __expf(-wpre)));
            ag[t] = __builtin_amdgcn_rcpf(1.0f + __expf(-apre));
            kk[t] = k * kkw; n2[t] = kk[t] * kk[t];
            kv[t] = k * (1.0f + (ag[t] - 1.0f) * kaw); rv[t] = r; vv[t] = v; bo[t] = r * kv[t] * rkw; }
#pragma unroll
        for (int t = 0; t < 8; ++t) { n2[t] = wave_sum_fast(n2[t]); bo[t] = wave_sum_fast(bo[t]); }
#pragma unroll
        for (int t = 0; t < 8; ++t) { const float kkn = kk[t] * (1.0f / sqrtf(fmaxf(n2[t], 1e-24f))); av[t] = -kkn; bv[t] = kkn * ag[t]; if (lane == 0) BON[(m0 + t) * 16 + h] = bo[t]; }
        float Pp[8]; Pp[0] = w[0];
#pragma unroll
        for (int t = 1; t < 8; ++t) Pp[t] = Pp[t - 1] * w[t];
        float bch[8], kch[8], ah[8], rh[8];
#pragma unroll
        for (int t = 0; t < 8; ++t) { const float pin = __builtin_amdgcn_rcpf(Pp[t]); bch[t] = bv[t] * pin; kch[t] = kv[t] * pin; ah[t] = av[t] * (t > 0 ? Pp[t - 1] : 1.0f); rh[t] = rv[t] * Pp[t]; }
        const int pos = (lane & 3) * 16 + (lane >> 2);
#pragma unroll
        for (int t = 0; t < 8; ++t) { G1[t * 64 + pos] = bch[t]; G1[(8 + t) * 64 + pos] = kch[t]; G1[(16 + t) * 64 + pos] = ah[t]; G1[(24 + t) * 64 + pos] = rh[t]; }
        LDS_WAIT(); asm volatile("" ::: "memory");
        f32x4 fa[4], fb[4];
#pragma unroll
        for (int q = 0; q < 4; ++q) { fa[q] = *(const LAS f32x4*)(G1 + (lane & 15) * 64 + (lane >> 4) * 16 + 4 * q); fb[q] = *(const LAS f32x4*)(G1 + (16 + (lane & 15)) * 64 + (lane >> 4) * 16 + 4 * q); }
        f32x4 dacc = {0.f, 0.f, 0.f, 0.f};
#pragma unroll
        for (int s2 = 0; s2 < 16; ++s2) dacc = __builtin_amdgcn_mfma_f32_16x16x4f32(fa[s2 >> 2][s2 & 3], fb[s2 >> 2][s2 & 3], dacc, 0, 0, 0);
        *(LAS f32x4*)(G2 + (lane & 15) * 16 + 4 * (lane >> 4)) = dacc;
        LDS_WAIT(); asm volatile("" ::: "memory");
        float M[8][8];
        { float Lm[8][8];
#pragma unroll
          for (int t = 1; t < 8; ++t) { const f32x4 l0 = *(const LAS f32x4*)(G2 + t * 16), l1 = *(const LAS f32x4*)(G2 + t * 16 + 4);
#pragma unroll
              for (int i = 0; i < 4; ++i) { Lm[t][i] = l0[i]; Lm[t][4 + i] = l1[i]; } }
#pragma unroll
          for (int t = 0; t < 8; ++t) { M[t][t] = 1.0f;
#pragma unroll
              for (int i = t - 1; i >= 0; --i) { float acc = 0.f;
#pragma unroll
                  for (int j = i; j < t; ++j) acc += Lm[t][j] * M[j][i];
                  M[t][i] = acc; } } }
        GAS float* rec = REC + ((size_t)bh * 1024 + blk) * REC_F;
#pragma unroll
        for (int t = 0; t < 8; ++t) { float acc = 0.f;
#pragma unroll
            for (int i = 0; i <= t; ++i) acc += M[t][i] * ah[i];
            rec[REC_AT + t * 64 + lane] = acc; }
        float Nm[8][8];
        { float Km[8][8];
#pragma unroll
          for (int t = 1; t < 8; ++t) { const f32x4 l0 = *(const LAS f32x4*)(G2 + t * 16 + 8), l1 = *(const LAS f32x4*)(G2 + t * 16 + 12);
#pragma unroll
              for (int i = 0; i < 4; ++i) { Km[t][i] = l0[i]; Km[t][4 + i] = l1[i]; } }
#pragma unroll
          for (int t = 0; t < 8; ++t)
#pragma unroll
              for (int i = 0; i < 8; ++i) { float acc = 0.f;
                  if (i < t) {
#pragma unroll
                      for (int j = i + 1; j <= t; ++j) acc += M[t][j] * Km[j][i]; }
                  Nm[t][i] = acc; } }
        float rb[8][8];
#pragma unroll
        for (int t = 0; t < 8; ++t) { const f32x4 l0 = *(const LAS f32x4*)(G2 + (8 + t) * 16), l1 = *(const LAS f32x4*)(G2 + (8 + t) * 16 + 4);
#pragma unroll
            for (int i = 0; i < 4; ++i) { rb[t][i] = l0[i]; rb[t][4 + i] = l1[i]; } }
#pragma unroll
        for (int t = 0; t < 8; ++t) { float acc = rh[t];
#pragma unroll
            for (int i = 0; i <= t; ++i) { float rm = 0.f;
#pragma unroll
                for (int j = i; j <= t; ++j) rm += rb[t][j] * M[j][i];
                acc += rm * ah[i]; }
            rec[REC_RT + t * 64 + lane] = acc; }
        float Qm[8][8];
#pragma unroll
        for (int t = 0; t < 8; ++t) { const f32x4 l0 = *(const LAS f32x4*)(G2 + (8 + t) * 16 + 8), l1 = *(const LAS f32x4*)(G2 + (8 + t) * 16 + 12);
#pragma unroll
            for (int i = 0; i < 8; ++i) { float acc = 0.f;
                if (i <= t) { acc = i < 4 ? l0[i & 3] : l1[i & 3];
#pragma unroll
                    for (int j = i + 1; j <= t; ++j) acc += rb[t][j] * Nm[j][i]; }
                Qm[t][i] = acc; } }
#pragma unroll
        for (int q4 = 0; q4 < 2; ++q4) { *(GAS f32x4*)(rec + REC_BKT + lane * 16 + 4 * q4) = (f32x4){bch[4 * q4] * Pp[7], bch[4 * q4 + 1] * Pp[7], bch[4 * q4 + 2] * Pp[7], bch[4 * q4 + 3] * Pp[7]};
            *(GAS f32x4*)(rec + REC_BKT + lane * 16 + 8 + 4 * q4) = (f32x4){kch[4 * q4] * Pp[7], kch[4 * q4 + 1] * Pp[7], kch[4 * q4 + 2] * Pp[7], kch[4 * q4 + 3] * Pp[7]}; }
        rec[REC_WC + lane] = Pp[7];
        if (lane == 0) {
#pragma unroll
            for (int t = 0; t < 8; ++t) { *(GAS f32x4*)(rec + REC_N + t * 8) = (f32x4){Nm[t][0], Nm[t][1], Nm[t][2], Nm[t][3]}; *(GAS f32x4*)(rec + REC_N + t * 8 + 4) = (f32x4){Nm[t][4], Nm[t][5], Nm[t][6], Nm[t][7]};
                *(GAS f32x4*)(rec + REC_Q + t * 8) = (f32x4){Qm[t][0], Qm[t][1], Qm[t][2], Qm[t][3]}; *(GAS f32x4*)(rec + REC_Q + t * 8 + 4) = (f32x4){Qm[t][4], Qm[t][5], Qm[t][6], Qm[t][7]}; } }
        *(GAS f32x4*)(rec + REC_V8 + lane * 8) = (f32x4){vv[0], vv[1], vv[2], vv[3]}; *(GAS f32x4*)(rec + REC_V8 + lane * 8 + 4) = (f32x4){vv[4], vv[5], vv[6], vv[7]};
        LDS_WAIT(); asm volatile("" ::: "memory");
    }
}

constexpr int SC_NS = 12, SC_RB = REC_F * 4, SC_SYNC = SC_NS * SC_RB;
__device__ __forceinline__ unsigned lds_word(const volatile LAS unsigned* p) { return (unsigned)__builtin_amdgcn_readfirstlane((int)*p); }
__device__ __forceinline__ bool scan_wg(int& bh, int& quarter) { const int bx = blockIdx.x; if (gridDim.x != 256 || ((bx >> 3) & 1)) return false; const int slot = bx >> 4; bh = (bx & 7) * 4 + (slot >> 2); quarter = slot & 3; return true; }
__device__ __forceinline__ void r4_feeder(const Frame& F, const Args& a, int bh) {
    const GAS char* gsrc = (const GAS char*)(a.ws + WS_SCAN) + (size_t)bh * 1024 * SC_RB + F.lane * 16;
    LAS unsigned char* ring = F.lds;
    volatile LAS unsigned* sync = (volatile LAS unsigned*)(F.lds + SC_SYNC);
    bool dead = false;
#pragma unroll 1
    for (int B = 0; B < 1024; ++B) {
        if (B >= SC_NS && !dead) { unsigned spins = 0; for (;;) { const unsigned d0 = lds_word(sync + 16); if ((int)d0 > B - SC_NS) break; if (++spins > (1u << 20)) { dead = true; break; } __builtin_amdgcn_s_sleep(2); } }
        LAS unsigned char* slot = ring + (B % SC_NS) * SC_RB;
#pragma unroll
        for (int q = 0; q < 11; ++q) __builtin_amdgcn_global_load_lds((const GAS unsigned*)(gsrc + (size_t)B * SC_RB + q * 1024), (LAS unsigned*)(slot + q * 1024), 16, 0, 0);
        asm volatile("s_waitcnt vmcnt(55)" ::: "memory");
        if (B >= 5 && F.lane == 0) sync[0] = (unsigned)(B - 4);
    }
    asm volatile("s_waitcnt vmcnt(0)" ::: "memory");
    if (F.lane == 0) sync[0] = 1024u;
}
template <int VAR> __device__ __forceinline__ void r4_scan(const Frame& F, const Args& a, int bh, int quarter) {
    float* YT = (float*)(a.ws + WS_XN);
    constexpr int RB = SC_RB;
    __builtin_amdgcn_s_setprio(3);
    const int r = F.lane & 15, q = F.lane >> 4, rowg = quarter * 16 + r;
    LAS unsigned char* ring = F.lds;
    volatile LAS unsigned* sync = (volatile LAS unsigned*)(F.lds + SC_SYNC);
    const LAS unsigned char* pA1 = ring + (REC_AT + r * 64 + 4 * q) * 4;
    const LAS unsigned char* pNQ = ring + (REC_N + r * 8 + 2 * q) * 4;
    const LAS unsigned char* pVb = ring + (REC_V8 + rowg * 8 + 2 * q) * 4;
    const LAS unsigned char* pV4 = ring + (REC_V8 + rowg * 8 + 4 * (q & 1)) * 4;
    const LAS unsigned char* pA2 = ring + (REC_BKT + r * 16 + 4 * q) * 4;
    const LAS unsigned char* pWC = ring + (REC_WC + 4 * q) * 4;
    unsigned have = 0; bool dead = (VAR == 1);
#define SC_NEED(n) do { unsigned spins_ = 0; while (have < (unsigned)(n) && !dead) { have = lds_word(sync); if (have >= (unsigned)(n)) break; if (++spins_ > (1u << 20)) { dead = true; break; } __builtin_amdgcn_s_sleep(1); } } while (0)
    f32x4 S[4];
#pragma unroll
    for (int kb = 0; kb < 4; ++kb) S[kb] = (f32x4){0.f, 0.f, 0.f, 0.f};
    GAS float* yrow = (GAS float*)YT + (size_t)(bh * 64 + rowg) * SEQ + 4 * (q & 1);
#define SC_LD(a1_, nq_, vb_, v4_, a2_, wc_, so_) do { _Pragma("unroll") for (int kb_ = 0; kb_ < 4; ++kb_) a1_[kb_] = *(const LAS f32x4*)(pA1 + (so_) + kb_ * 64); \
        nq_ = *(const LAS f32x2*)(pNQ + (so_)); vb_ = *(const LAS f32x2*)(pVb + (so_)); v4_ = *(const LAS f32x4*)(pV4 + (so_)); \
        _Pragma("unroll") for (int kb_ = 0; kb_ < 4; ++kb_) { a2_[kb_] = *(const LAS f32x4*)(pA2 + (so_) + kb_ * 1024); wc_[kb_] = *(const LAS f32x4*)(pWC + (so_) + kb_ * 64); } } while (0)
    f32x4 a1[4], a2[4], wc[4], v4; f32x2 nq, vb;
    SC_NEED(1); asm volatile("" ::: "memory");
    SC_LD(a1, nq, vb, v4, a2, wc, 0);
#pragma unroll 1
    for (int k0 = 0; k0 < 1024; k0 += SC_NS) {
#pragma unroll
        for (int u = 0; u < SC_NS; ++u) { if (k0 + u >= 1024) break; const int sn = ((u + 1) % SC_NS) * RB;
            f32x4 d0 = {0.f, 0.f, 0.f, 0.f}, d1 = {0.f, 0.f, 0.f, 0.f};
#pragma unroll
            for (int kb = 0; kb < 4; ++kb) { d0 = __builtin_amdgcn_mfma_f32_16x16x4f32(a1[kb][0], S[kb][0], d0, 0, 0, 0); d1 = __builtin_amdgcn_mfma_f32_16x16x4f32(a1[kb][1], S[kb][1], d1, 0, 0, 0);
                d0 = __builtin_amdgcn_mfma_f32_16x16x4f32(a1[kb][2], S[kb][2], d0, 0, 0, 0); d1 = __builtin_amdgcn_mfma_f32_16x16x4f32(a1[kb][3], S[kb][3], d1, 0, 0, 0); }
            d0 = __builtin_amdgcn_mfma_f32_16x16x4f32(nq[0], vb[0], d0, 0, 0, 0); d1 = __builtin_amdgcn_mfma_f32_16x16x4f32(nq[1], vb[1], d1, 0, 0, 0);
            f32x4 na1[4], na2[4], nwc[4], nv4; f32x2 nnq, nvb;
            SC_NEED(k0 + u + 2 <= 1024 ? k0 + u + 2 : 1024); asm volatile("" ::: "memory");
            SC_LD(na1, nnq, nvb, nv4, na2, nwc, sn);
            asm volatile("" ::: "memory");
            const f32x4 dd = d0 + d1;
            if (q >= 2) *(GAS f32x4*)(yrow + (k0 + u) * 8) = dd;
            const f32x4 b2 = q >= 2 ? v4 : dd;
            f32x4 n[4];
#pragma unroll
            for (int kb = 0; kb < 4; ++kb) n[kb] = S[kb] * wc[kb];
#pragma unroll
            for (int sp = 0; sp < 4; ++sp)
#pragma unroll
                for (int kb = 0; kb < 4; ++kb) n[kb] = __builtin_amdgcn_mfma_f32_16x16x4f32(a2[kb][sp], b2[sp], n[kb], 0, 0, 0);
#pragma unroll
            for (int kb = 0; kb < 4; ++kb) S[kb] = n[kb];
            asm volatile("" : "+v"(S[0]), "+v"(S[1]), "+v"(S[2]), "+v"(S[3]) :: "memory");
            if (F.lane == 0) sync[16] = (unsigned)(k0 + u + 1);
#pragma unroll
            for (int kb = 0; kb < 4; ++kb) { a1[kb] = na1[kb]; a2[kb] = na2[kb]; wc[kb] = nwc[kb]; }
            nq = nnq; vb = nvb; v4 = nv4;
        }
    }
#undef SC_LD
#undef SC_NEED
    __builtin_amdgcn_s_setprio(0);
}

__device__ __forceinline__ void r5_finish(const Frame& F, const Args& a) {
    const float* YT = (const float*)(a.ws + WS_XN); const float* LO = (const float*)(a.ws + WS_LORAOUT); const bf16* P = (const bf16*)(a.ws + WS_P); const float* BON = (const float*)(a.ws + WS_BONUS);
    bf16* YA = (bf16*)(a.ws + WS_YABC);
    LAS float* scr = (LAS float*)(F.lds + F.wave * 16640);
    const int gw = F.vcu * NWAVES + F.wave, NGW = F.G * NWAVES;
    for (int it = gw; it < 32 * 128; it += NGW) {
        const int bh = it >> 7, tt = it & 127, t0 = tt * 64, b = bh >> 4, h = bh & 15;
        float y[64]; float s = 0.f;
#pragma unroll
        for (int v = 0; v < 64; ++v) { y[v] = YT[(size_t)(bh * 64 + v) * SEQ + t0 + F.lane]; s += y[v]; }
        const float mean = s * (1.f / 64.f); float q = 0.f;
#pragma unroll
        for (int v = 0; v < 64; ++v) { const float d = y[v] - mean; q += d * d; }
        const float rstd = 1.0f / sqrtf(q * (1.f / 64.f) + GN_EPS);
#pragma unroll
        for (int v = 0; v < 64; ++v) scr[F.lane * 65 + v] = (y[v] - mean) * rstd;
        LDS_WAIT(); asm volatile("" ::: "memory");
        { const int ts = F.lane >> 4, cq = F.lane & 15, c = h * 64 + 4 * cq;
          const f32x4 lw = *(const GAS f32x4*)((const GAS float*)inp(I_LNW) + c), lb = *(const GAS f32x4*)((const GAS float*)inp(I_LNB) + c), muv = *(const GAS f32x4*)((const GAS float*)inp(I_MU) + 2048 + c);
#pragma unroll 4
          for (int tg = 0; tg < 16; ++tg) { const int ti = 4 * tg + ts, m = b * SEQ + t0 + ti;
              f32x4 yn; yn[0] = scr[ti * 65 + 4 * cq]; yn[1] = scr[ti * 65 + 4 * cq + 1]; yn[2] = scr[ti * 65 + 4 * cq + 2]; yn[3] = scr[ti * 65 + 4 * cq + 3];
              const v2u cw = *(const GAS v2u*)((const GAS bf16*)P + (size_t)m * NP + 2048 + c); v2u pw = cw; if (m % SEQ != 0) pw = *(const GAS v2u*)((const GAS bf16*)P + (size_t)(m - 1) * NP + 2048 + c);
              const f32x4 cv = {bflo(cw.x), bfhi(cw.x), bflo(cw.y), bfhi(cw.y)}; f32x4 pv = {bflo(pw.x), bfhi(pw.x), bflo(pw.y), bfhi(pw.y)}; if (m % SEQ == 0) pv = (f32x4){0.f, 0.f, 0.f, 0.f};
              const f32x4 vsh = cv + (pv - cv) * muv;
              const f32x4 g = *(const GAS f32x4*)((const GAS float*)LO + (size_t)m * 3072 + 2048 + c); const float bon = BON[m * 16 + h];
              const f32x4 o = (yn * lw + lb + vsh * bon) * g;
              v2u w; w.x = pk2(o[0], o[1]); w.y = pk2(o[2], o[3]); *(GAS v2u*)((GAS bf16*)YA + (size_t)m * 3072 + c) = w; } }
        LDS_WAIT(); asm volatile("" ::: "memory");
    }
}

__device__ __forceinline__ float gelu_tanh(float x) { const float u = 0.7978845608028654f * (x + 0.044715f * x * x * x); return 0.5f * x * (1.0f + fast_tanh(u)); }
template <int CTRL> __device__ __forceinline__ float dpp_keep(float old, float x) { return __builtin_bit_cast(float, __builtin_amdgcn_update_dpp(__builtin_bit_cast(int, old), __builtin_bit_cast(int, x), CTRL, 0xf, 0xf, false)); }
template <bool FINAL> __device__ __forceinline__ void lru_pass(const Frame& F, const Args& a, int gw, int NGW) {
    const bf16* P = (const bf16*)(a.ws + WS_P); const bf16* LW = (const bf16*)(a.ws + WS_LW);
    float* CA = (float*)(a.ws + WS_LRUC); float* CB = CA + 256 * 1024; const float* HIN = CB + 256 * 1024;
    bf16* YB = (bf16*)(a.ws + WS_YABC) + 1024;
    const GAS float* lbr_p = (const GAS float*)inp(I_LBR); const GAS float* lbi_p = (const GAS float*)inp(I_LBI); const GAS float* spl_p = (const GAS float*)(a.ws + WS_SPL);
    const GAS float* cvb_p = (const GAS float*)inp(I_CONVB); const GAS float* cvw_p = (const GAS float*)inp(I_CONVW);
    const int tq = F.lane & 15, kq = F.lane >> 4;
    for (int it = gw; it < 256 * 16; it += NGW) {
        const int tt = it >> 4, n = it & 15, m0 = tt * 64, cb = n * 64 + 4 * kq;
        const bool seq0 = (m0 % SEQ) == 0;
        float hcar[4][4];
        float aprod[4][4];
#pragma unroll
        for (int vb = 0; vb < 4; ++vb)
#pragma unroll
            for (int i = 0; i < 4; ++i) { hcar[vb][i] = FINAL ? HIN[tt * 1024 + cb + 16 * vb + i] : 0.f; aprod[vb][i] = 1.f; }
#pragma unroll 1
        for (int tb = 0; tb < 4; ++tb) {
            asm volatile("" ::: "memory");
            const int m = m0 + 16 * tb + tq, tseq = m % SEQ;
            f32x4 xc[4];
#pragma unroll
            for (int vb = 0; vb < 4; ++vb) { const int c = cb + 16 * vb; f32x4 acc = *(const GAS f32x4*)(cvb_p + c);
#pragma unroll
                for (int j = 0; j < 4; ++j) { if (tseq - j >= 0) { const v2u pw = *(const GAS v2u*)((const GAS bf16*)P + (size_t)(m - j) * NP + PC_LX + c); const f32x4 cw = *(const GAS f32x4*)(cvw_p + j * 1024 + c);
                        acc[0] += cw[0] * bflo(pw.x); acc[1] += cw[1] * bfhi(pw.x); acc[2] += cw[2] * bflo(pw.y); acc[3] += cw[3] * bfhi(pw.y); } }
                xc[vb] = acc; }
            bf16x8 bfrag[2];
#pragma unroll
            for (int ks = 0; ks < 2; ++ks) { v4u w; w.x = pk2(xc[2 * ks][0], xc[2 * ks][1]); w.y = pk2(xc[2 * ks][2], xc[2 * ks][3]); w.z = pk2(xc[2 * ks + 1][0], xc[2 * ks + 1][1]); w.w = pk2(xc[2 * ks + 1][2], xc[2 * ks + 1][3]); bfrag[ks] = __builtin_bit_cast(bf16x8, w); }
#pragma unroll
            for (int vb = 0; vb < 4; ++vb) {
                f32x4 gr = {0.f, 0.f, 0.f, 0.f}, gi = {0.f, 0.f, 0.f, 0.f};
#pragma unroll
                for (int ks = 0; ks < 2; ++ks) { const bf16x8 wr_ = *(const bf16x8*)(LW + ((((size_t)(0 * 16 + n) * 4 + vb) * 2 + ks) * 64 + F.lane) * 8); const bf16x8 wi_ = *(const bf16x8*)(LW + ((((size_t)(1 * 16 + n) * 4 + vb) * 2 + ks) * 64 + F.lane) * 8);
                    gr = __builtin_amdgcn_mfma_f32_16x16x32_bf16(wr_, bfrag[ks], gr, 0, 0, 0); gi = __builtin_amdgcn_mfma_f32_16x16x32_bf16(wi_, bfrag[ks], gi, 0, 0, 0); }
                const int c = cb + 16 * vb;
                const f32x4 brv = *(const GAS f32x4*)(lbr_p + c), biv = *(const GAS f32x4*)(lbi_p + c); const f32x4 spl = *(const GAS f32x4*)(spl_p + c);
                v2u pyw; if (FINAL) pyw = *(const v2u*)(P + (size_t)m * NP + PC_LY + c);
                float hout[4];
#pragma unroll
                for (int i = 0; i < 4; ++i) {
                    const float g_r = sigm(gr[i] + brv[i]), g_i = sigm(gi[i] + biv[i]);
                    const float log_a = -8.0f * g_r * spl[i];
                    float av = __expf(log_a); float mult = __builtin_amdgcn_sqrtf(fmaxf(1.0f - av * av, 0.f)); if (tseq == 0) mult = 1.0f;
                    float bv = mult * g_i * xc[vb][i];
                    { float pa = dpp_keep<0x111>(1.0f, av), pb = dpp_keep<0x111>(0.0f, bv); bv = av * pb + bv; av = av * pa; }
                    { float pa = dpp_keep<0x112>(1.0f, av), pb = dpp_keep<0x112>(0.0f, bv); bv = av * pb + bv; av = av * pa; }
                    { float pa = dpp_keep<0x114>(1.0f, av), pb = dpp_keep<0x114>(0.0f, bv); bv = av * pb + bv; av = av * pa; }
                    { float pa = dpp_keep<0x118>(1.0f, av), pb = dpp_keep<0x118>(0.0f, bv); bv = av * pb + bv; av = av * pa; }
                    const float hv = bv + av * hcar[vb][i];
                    const int l15 = (F.lane & 48) | 15;
                    const float hend = __shfl(hv, l15), aend = __shfl(av, l15);
                    hcar[vb][i] = hend; if (!FINAL) aprod[vb][i] *= aend; hout[i] = hv; }
                if (FINAL) { const float y0 = hout[0] * gelu_tanh(bflo(pyw.x)), y1 = hout[1] * gelu_tanh(bfhi(pyw.x)), y2 = hout[2] * gelu_tanh(bflo(pyw.y)), y3 = hout[3] * gelu_tanh(bfhi(pyw.y));
                    v2u w; w.x = pk2(y0, y1); w.y = pk2(y2, y3); *(v2u*)(YB + (size_t)m * 3072 + c) = w; }
            }
        }
        if (!FINAL && tq == 0) {
#pragma unroll
            for (int vb = 0; vb < 4; ++vb) { f32x4 pa, pb;
#pragma unroll
                for (int i = 0; i < 4; ++i) { pa[i] = aprod[vb][i]; pb[i] = hcar[vb][i]; }
                *(f32x4*)(CA + tt * 1024 + cb + 16 * vb) = pa; *(f32x4*)(CB + tt * 1024 + cb + 16 * vb) = pb; }
        }
        (void)seq0;
    }
}
__device__ __forceinline__ void lru_carry(const Frame& F, const Args& a) {
    const float* CA = (const float*)(a.ws + WS_LRUC); const float* CB = CA + 256 * 1024; float* HIN = (float*)CB + 256 * 1024;
    const int gt = F.vcu * (NWAVES * 64) + F.tid;
    if (gt < 2048) { const int b = gt >> 10, c = gt & 1023; float h = 0.f;
#pragma unroll 1
        for (int k0 = 0; k0 < 128; k0 += 32) { float ca[32], cb[32];
#pragma unroll
            for (int j = 0; j < 32; ++j) { const int tt = b * 128 + k0 + j; ca[j] = CA[tt * 1024 + c]; cb[j] = CB[tt * 1024 + c]; }
#pragma unroll
            for (int j = 0; j < 32; ++j) { const int tt = b * 128 + k0 + j; HIN[tt * 1024 + c] = h; h = ca[j] * h + cb[j]; } } }
}

__device__ __forceinline__ void xattn_phase(const Frame& F, const Args& a, int gw, int NGW) {
    const bf16* P = (const bf16*)(a.ws + WS_P); const bf16* KM = (const bf16*)(a.ws + WS_KMEM); const bf16* VT = (const bf16*)(a.ws + WS_VT);
    bf16* YC = (bf16*)(a.ws + WS_YABC) + 2048;
    const int tq = F.lane & 15, kq = F.lane >> 4;
    for (int it = gw; it < 4 * 512; it += NGW) {
        const int h = it >> 9, tg = it & 511, m0 = tg * 32, b = m0 / SEQ;
        bf16x8 qf[2][8];
#pragma unroll
        for (int g = 0; g < 2; ++g)
#pragma unroll
            for (int ks = 0; ks < 8; ++ks) qf[g][ks] = *(const bf16x8*)(P + (size_t)(m0 + 16 * g + tq) * NP + PC_Q + h * 256 + 32 * ks + 8 * kq);
        f32x4 s[2][16];
#pragma unroll
        for (int mb = 0; mb < 16; ++mb) { f32x4 acc0 = {0.f, 0.f, 0.f, 0.f}, acc1 = {0.f, 0.f, 0.f, 0.f}; const bf16* kp = KM + (size_t)(b * 256 + 16 * mb + tq) * 1024 + h * 256 + 8 * kq;
#pragma unroll
            for (int ks = 0; ks < 8; ++ks) { const bf16x8 kf = *(const bf16x8*)(kp + 32 * ks);
                acc0 = __builtin_amdgcn_mfma_f32_16x16x32_bf16(kf, qf[0][ks], acc0, 0, 0, 0); acc1 = __builtin_amdgcn_mfma_f32_16x16x32_bf16(kf, qf[1][ks], acc1, 0, 0, 0); }
            s[0][mb] = acc0; s[1][mb] = acc1; asm volatile("" ::: "memory"); }
        bf16x8 pf[2][8];
#pragma unroll
        for (int g = 0; g < 2; ++g) {
            float mx = -3.0e38f;
#pragma unroll
            for (int mb = 0; mb < 16; ++mb) { s[g][mb] = s[g][mb] * 0.0625f; mx = fmaxf(mx, fmaxf(fmaxf(s[g][mb][0], s[g][mb][1]), fmaxf(s[g][mb][2], s[g][mb][3]))); }
            mx = fmaxf(mx, __shfl_xor(mx, 16)); mx = fmaxf(mx, __shfl_xor(mx, 32));
            float sum = 0.f;
#pragma unroll
            for (int mb = 0; mb < 16; ++mb) {
#pragma unroll
                for (int i = 0; i < 4; ++i) { s[g][mb][i] = __expf(s[g][mb][i] - mx); sum += s[g][mb][i]; } }
            sum += __shfl_xor(sum, 16); sum += __shfl_xor(sum, 32);
            const float inv = 1.0f / sum;
#pragma unroll
            for (int ks = 0; ks < 8; ++ks) { v4u w; w.x = pk2(s[g][2 * ks][0] * inv, s[g][2 * ks][1] * inv); w.y = pk2(s[g][2 * ks][2] * inv, s[g][2 * ks][3] * inv); w.z = pk2(s[g][2 * ks + 1][0] * inv, s[g][2 * ks + 1][1] * inv); w.w = pk2(s[g][2 * ks + 1][2] * inv, s[g][2 * ks + 1][3] * inv); pf[g][ks] = __builtin_bit_cast(bf16x8, w); } }
#pragma unroll
        for (int db = 0; db < 16; ++db) { f32x4 acc0 = {0.f, 0.f, 0.f, 0.f}, acc1 = {0.f, 0.f, 0.f, 0.f}; const bf16* vp = VT + ((size_t)((b * 4 + h) * 256 + 16 * db + tq)) * 256 + 8 * kq;
#pragma unroll
            for (int ks = 0; ks < 8; ++ks) { const bf16x8 vf = *(const bf16x8*)(vp + 32 * ks);
                acc0 = __builtin_amdgcn_mfma_f32_16x16x32_bf16(vf, pf[0][ks], acc0, 0, 0, 0); acc1 = __builtin_amdgcn_mfma_f32_16x16x32_bf16(vf, pf[1][ks], acc1, 0, 0, 0); }
            v2u w0_, w1_; w0_.x = pk2(acc0[0], acc0[1]); w0_.y = pk2(acc0[2], acc0[3]); w1_.x = pk2(acc1[0], acc1[1]); w1_.y = pk2(acc1[2], acc1[3]);
            *(v2u*)(YC + (size_t)(m0 + tq) * 3072 + h * 256 + 16 * db + 4 * kq) = w0_; *(v2u*)(YC + (size_t)(m0 + 16 + tq) * 3072 + h * 256 + 16 * db + 4 * kq) = w1_; asm volatile("" ::: "memory"); }
    }
}

__device__ __forceinline__ void router_phase(const Frame& F, const Args& a) {
    const float* H1 = (const float*)(a.ws + WS_H1); bf16* XN2 = (bf16*)(a.ws + WS_XN); const bf16* WR = (const bf16*)(a.ws + WS_WR);
    int* pick_e = (int*)(a.ws + WS_PICK); int* pick_rank = pick_e + 65536; float* pick_gate = (float*)(pick_rank + 65536);
    unsigned* gcnt = (unsigned*)(a.ws + WS_CTL) + CW_CNT;
    LAS float* lg = (LAS float*)(F.lds + F.wave * 4096);
    LAS unsigned* lcnt = (LAS unsigned*)(F.lds + 65536);
    const int tq = F.lane & 15, kq = F.lane >> 4;
    for (int g0 = F.vcu * 4; g0 < 1024; g0 += F.G * 4) {
        if (F.tid < 64) lcnt[F.tid] = 0u;
        __syncthreads();
        int me = 0, mrank = 0; float mgate = 0.f; int e4[4]; float g4[4]; int r4[4];
        const int m0 = (g0 + F.wave) * 16;
        if (F.wave < 4) {
            float myr = 0.f;
            for (int j = 0; j < 16; ++j) { const GAS f32x4* xr = (const GAS f32x4*)(H1 + (size_t)(m0 + j) * D) + F.lane; float s = 0.f;
#pragma unroll
                for (int q = 0; q < 8; ++q) { const f32x4 v = xr[64 * q]; s += (v.x * v.x + v.y * v.y) + (v.z * v.z + v.w * v.w); }
                const float rs = 1.0f / sqrtf(wave_sum(s) * (1.f / D) + EPS); if (tq == j) myr = rs; }
            f32x4 acc[2] = {{0.f, 0.f, 0.f, 0.f}, {0.f, 0.f, 0.f, 0.f}};
            const float* hrow = H1 + (size_t)(m0 + tq) * D + 8 * kq; const float* grow = inp(I_GFFN) + 8 * kq; bf16* xrow = XN2 + (size_t)(m0 + tq) * D + 8 * kq;
            for (int ks = 0; ks < 64; ++ks) {
                const f32x4 x0 = *(const f32x4*)(hrow + 32 * ks), x1 = *(const f32x4*)(hrow + 32 * ks + 4), g0v = *(const f32x4*)(grow + 32 * ks), g1v = *(const f32x4*)(grow + 32 * ks + 4);
                v4u w; w.x = pk2(x0[0] * myr * g0v[0], x0[1] * myr * g0v[1]); w.y = pk2(x0[2] * myr * g0v[2], x0[3] * myr * g0v[3]); w.z = pk2(x1[0] * myr * g1v[0], x1[1] * myr * g1v[1]); w.w = pk2(x1[2] * myr * g1v[2], x1[3] * myr * g1v[3]);
                *(v4u*)(xrow + 32 * ks) = w; const bf16x8 af = __builtin_bit_cast(bf16x8, w);
#pragma unroll
                for (int eh = 0; eh < 2; ++eh) { const bf16* wp = WR + (size_t)(16 * eh + tq) * D + 32 * ks + 8 * kq;
                    acc[eh] = __builtin_amdgcn_mfma_f32_16x16x32_bf16(af, *(const bf16x8*)wp, acc[eh], 0, 0, 0);
                    acc[eh] = __builtin_amdgcn_mfma_f32_16x16x32_bf16(af, *(const bf16x8*)(wp + 32 * D), acc[eh], 0, 0, 0); } }
#pragma unroll
            for (int eh = 0; eh < 2; ++eh)
#pragma unroll
                for (int i = 0; i < 4; ++i) lg[(4 * kq + i) * 33 + 16 * eh + tq] = acc[eh][i] + inp(I_BROUTER)[16 * eh + tq];
            LDS_WAIT(); asm volatile("" ::: "memory");
            if (F.lane < 16) { float v[32];
#pragma unroll
                for (int e = 0; e < 32; ++e) v[e] = lg[F.lane * 33 + e];
                float tv[4];
#pragma unroll
                for (int k = 0; k < 4; ++k) { float best = -3.0e38f; int bi = 0;
#pragma unroll
                    for (int e = 0; e < 32; ++e) { if (v[e] > best) { best = v[e]; bi = e; } }
                    tv[k] = best; e4[k] = bi;
#pragma unroll
                    for (int e = 0; e < 32; ++e) { if (e == bi) v[e] = -3.0e38f; } }
                float den = 0.f;
#pragma unroll
                for (int k = 0; k < 4; ++k) { g4[k] = __expf(tv[k] - tv[0]); den += g4[k]; }
#pragma unroll
                for (int k = 0; k < 4; ++k) { g4[k] = g4[k] / den; r4[k] = (int)atomicAdd((unsigned*)&lcnt[e4[k]], 1u); } }
        }
        __syncthreads();
        if (F.tid < 32) lcnt[32 + F.tid] = atomicAdd(&gcnt[F.tid], lcnt[F.tid]);
        __syncthreads();
        if (F.wave < 4 && F.lane < 16) {
#pragma unroll
            for (int k = 0; k < 4; ++k) { const int pi = (m0 + F.lane) * 4 + k; pick_e[pi] = e4[k]; pick_rank[pi] = (int)lcnt[32 + e4[k]] + r4[k]; pick_gate[pi] = g4[k]; } }
        __syncthreads();
        (void)me; (void)mrank; (void)mgate;
    }
}

__device__ __forceinline__ void scatter_phase(const Frame& F, const Args& a) {
    const int* pick_e = (const int*)(a.ws + WS_PICK); const int* pick_rank = pick_e + 65536; const float* pick_gate = (const float*)(pick_rank + 65536); int* pos = (int*)(pick_gate + 65536);
    float* gate_of_row = (float*)(a.ws + WS_ROWTAB); int* tok_of_row = (int*)(a.ws + WS_ROWTAB + 512 * 1024 + 8192);
    unsigned* ctl = (unsigned*)(a.ws + WS_CTL);
    LAS int* pst = (LAS int*)(F.lds);
    if (F.tid == 0) { int acc = 0; for (int e = 0; e < NE; ++e) { pst[e] = acc; const int c = (int)ctl[CW_CNT + e]; pst[32 + e] = c; const int nt = (c + 255) >> 8;
            if (blockIdx.x == 0) for (int k = 0; k < nt; ++k) ctl[CW_TILEE + (acc >> 8) + k] = (unsigned)e;
            acc += nt << 8; }
        if (blockIdx.x == 0) ctl[CW_NTILES] = (unsigned)(acc >> 8); }
    __syncthreads();
    const int gt = F.vcu * (NWAVES * 64) + F.tid, NGT = F.G * NWAVES * 64;
    for (int pi = gt; pi < 65536; pi += NGT) { const int e = pick_e[pi], row = pst[e] + pick_rank[pi]; pos[pi] = row; gate_of_row[row] = pick_gate[pi]; tok_of_row[row] = pi >> 2; }
    if (blockIdx.x == 0) for (int e = 0; e < NE; ++e) { const int r0 = pst[e] + pst[32 + e], r1 = pst[e] + (((pst[32 + e] + 255) >> 8) << 8);
        for (int r = r0 + F.tid; r < r1; r += NWAVES * 64) { tok_of_row[r] = 0; gate_of_row[r] = 0.f; } }
}

__device__ __forceinline__ void final_phase(const Frame& F, const Args& a) {
    const float* H1 = (const float*)(a.ws + WS_H1); const bf16* OR = (const bf16*)(a.ws + WS_OROW);
    const int* pos = (const int*)(a.ws + WS_PICK) + 3 * 65536;
    const int gw = F.vcu * NWAVES + F.wave, NGW = F.G * NWAVES;
    for (int m = gw; m < T; m += NGW) {
        const GAS f32x4* xr = (const GAS f32x4*)(H1 + (size_t)m * D) + F.lane; const GAS f32x4* gr = (const GAS f32x4*)inp(I_GFINAL) + F.lane;
        f32x4 v[8];
#pragma unroll
        for (int j = 0; j < 8; ++j) v[j] = xr[64 * j];
#pragma unroll
        for (int k = 0; k < 4; ++k) { const int row = pos[m * 4 + k]; const GAS v2u* orp = (const GAS v2u*)(OR + (size_t)row * D) + F.lane;
#pragma unroll
            for (int j = 0; j < 8; ++j) { const v2u w = orp[64 * j]; v[j].x += bflo(w.x); v[j].y += bfhi(w.x); v[j].z += bflo(w.y); v[j].w += bfhi(w.y); } }
        float s = 0.f;
#pragma unroll
        for (int j = 0; j < 8; ++j) s += (v[j].x * v[j].x + v[j].y * v[j].y) + (v[j].z * v[j].z + v[j].w * v[j].w);
        const float rstd = 1.0f / sqrtf(wave_sum(s) * (1.f / D) + EPS);
        GAS f32x4* o = (GAS f32x4*)(a.out + (size_t)m * D) + F.lane;
#pragma unroll
        for (int j = 0; j < 8; ++j) { const f32x4 g = gr[64 * j]; o[64 * j] = (f32x4){v[j].x * rstd * g.x, v[j].y * rstd * g.y, v[j].z * rstd * g.z, v[j].w * rstd * g.w}; }
    }
}

#ifndef MK_N_LAUNCHES
#define MK_N_LAUNCHES 1
#endif
constexpr int NPH = 14;
__global__ void __launch_bounds__(NWAVES * 64, 2) fwd(Args args) {
    extern __shared__ __attribute__((aligned(16))) unsigned char lds[];
#define NEWFRAME() Frame F; { int tz = threadIdx.x; asm volatile("" : "+v"(tz)); F.lds = (LAS unsigned char*)lds; F.MISC = (volatile LAS unsigned*)(F.lds + MISC_OFF); F.tid = tz; F.lane = tz & 63; F.wave = __builtin_amdgcn_readfirstlane(tz >> 6); \
        F.G = gridDim.x; const int bx = blockIdx.x; F.vcu = (F.G % 8 == 0) ? (bx % 8) * (F.G / 8) + bx / 8 : bx; }
    unsigned char* ws = args.ws;
    unsigned* ctl = (unsigned*)(ws + WS_CTL);
    for (int u = threadIdx.x; u < (LDS_BYTES - MISC_OFF) / 4; u += NWAVES * 64) ((LAS unsigned*)((LAS unsigned char*)lds + MISC_OFF))[u] = 0u;
    __syncthreads();
    const int lo = args.ph_lo, hi = args.ph_hi;
    XcdBarrier bar; bar.bar = ctl + CW_BAR; bar.x = 0; bar.st = nullptr;
    if (hi - lo > 1) bar = xcd_barrier_post(ctl + CW_BAR, (volatile LAS unsigned*)((LAS unsigned char*)lds + MISC_OFF) + 8);
#ifndef PHMASK
#define PHMASK 0xFFFF
#endif
#define IN(k) (((PHMASK >> (k)) & 1) && lo <= (k) && (k) < hi)
#define SEAM(k) do { if (IN(k) && IN((k) + 1)) xcd_barrier(bar); } while (0)

    if (IN(0)) { NEWFRAME(); p0_prologue(F, args); } SEAM(0);
    if (IN(1)) { NEWFRAME();
        { pg8::Gemm g{(const bf16*)(ws + WS_XN), (const bf16*)(ws + WS_WIN), T, NP, D}; pg8::StaticOrder S; S.init(T, NP, F.G, (int)blockIdx.x);
          pg8::EpiBf16<0> E{(bf16*)(ws + WS_P), NP, nullptr, 0, 0, 1.f};
          pg8::gemm_phase<pg8::EpiBf16<0>, pg8::StaticOrder, true, true>(F.lds, g, S, E); }
        __syncthreads();
        { pg8::Gemm g{(const bf16*)(ws + WS_MN), (const bf16*)(ws + WS_WMKV), 512, 2048, D}; pg8::StaticOrder S; S.init(512, 2048, F.G, (int)((blockIdx.x + F.G / 2) % F.G));
          pg8::EpiKV E{(bf16*)(ws + WS_KMEM), (bf16*)(ws + WS_VT)};
          pg8::gemm_phase<pg8::EpiKV, pg8::StaticOrder, true, true>(F.lds, g, S, E); }
    } SEAM(1);
    if (IN(2)) { NEWFRAME();
#ifndef NO_R1
 r1_lora_in(F, args);
#endif
#ifndef NO_LRU
 lru_pass<false>(F, args, F.vcu * NWAVES + F.wave, F.G * NWAVES);
#endif
 } SEAM(2);
    if (IN(3)) { NEWFRAME();
        lru_carry(F, args);
        { pg8::Gemm g{(const bf16*)(ws + WS_XN), (const bf16*)(ws + WS_WLORA), T, 3072, LORA_K}; pg8::StaticOrder S; S.init(T, 3072, F.G, (int)blockIdx.x);
          pg8::EpiF32 E{(float*)(ws + WS_LORAOUT), 3072};
          pg8::gemm_phase<pg8::EpiF32, pg8::StaticOrder, true, true>(F.lds, g, S, E); }
    } SEAM(3);
    if (IN(4)) { NEWFRAME(); r3_blocks(F, args); } SEAM(4);
    if (IN(5)) { NEWFRAME();
        if (F.tid < 64) ((LAS unsigned*)(F.lds + SC_SYNC))[F.tid] = 0u; __syncthreads();
        int bh = 0, quarter = 0; const bool sw = scan_wg(bh, quarter);
        int gw2, NGW2; { const int bx = blockIdx.x, G = F.G; if (G == 256) { NGW2 = 1792; gw2 = sw ? ((bx >> 4) * 8 + (bx & 7)) * 6 + (F.wave - 2) : 768 + ((bx >> 4) * 8 + (bx & 7)) * 8 + F.wave; } else { NGW2 = G * 8; gw2 = F.vcu * 8 + F.wave; } }
        if (sw && F.wave == 0) r4_scan<0>(F, args, bh, quarter);
        else if (sw && F.wave == 1) r4_feeder(F, args, bh);
        else {
            const int rot = F.wave % 3;
            if (rot == 0) { moe_weight_convert(F, args, gw2, NGW2); xattn_phase(F, args, gw2, NGW2); lru_pass<true>(F, args, gw2, NGW2); }
            else if (rot == 1) { xattn_phase(F, args, gw2, NGW2); lru_pass<true>(F, args, gw2, NGW2); moe_weight_convert(F, args, gw2, NGW2); }
            else { lru_pass<true>(F, args, gw2, NGW2); moe_weight_convert(F, args, gw2, NGW2); xattn_phase(F, args, gw2, NGW2); } }
    } SEAM(5);
    if (IN(6)) { NEWFRAME(); r5_finish(F, args); } SEAM(6);
    if (IN(7)) { NEWFRAME();
        pg8::Gemm g{(const bf16*)(ws + WS_YABC), (const bf16*)(ws + WS_WBR), T, 2048, 3072}; pg8::StaticOrder S; S.init(T, 2048, F.G, (int)blockIdx.x);
        pg8::EpiBranch2 E{(const bf16*)(ws + WS_P), NP, PC_G, (bf16*)(ws + WS_MERGED)};
        pg8::gemm_phase<pg8::EpiBranch2, pg8::StaticOrder, true, true>(F.lds, g, S, E);
    } SEAM(7);
    if (IN(8)) { NEWFRAME();
        pg8::Gemm g{(const bf16*)(ws + WS_MERGED), (const bf16*)(ws + WS_WO), T, D, D}; pg8::StaticOrder S; S.init(T, D, F.G, (int)blockIdx.x);
        pg8::EpiRes E{inp(I_X), (float*)(ws + WS_H1), D};
        pg8::gemm_phase<pg8::EpiRes, pg8::StaticOrder, true, true>(F.lds, g, S, E);
    } SEAM(8);
    if (IN(9)) { NEWFRAME(); router_phase(F, args); } SEAM(9);
    if (IN(10)) { NEWFRAME(); scatter_phase(F, args); } SEAM(10);
    if (IN(11)) { NEWFRAME();
        const int ntiles = (int)__hip_atomic_load(ctl + CW_NTILES, __ATOMIC_RELAXED, __HIP_MEMORY_SCOPE_AGENT);
        pg8::Gemm g{(const bf16*)(ws + WS_XN), (const bf16*)(ws + WS_WGU), ntiles * 256, NE * 4096, D}; pg8::MoeOrder<true> S; S.init(ntiles, 16, F.G, (int)blockIdx.x, (const int*)(ctl + CW_TILEE), (const int*)(ws + WS_ROWTAB + 512 * 1024 + 8192));
        pg8::EpiSwiglu E{(bf16*)(ws + WS_HH), inp(I_BGATE), inp(I_BUP)};
        pg8::gemm_phase<pg8::EpiSwiglu, pg8::MoeOrder<true>, true, true>(F.lds, g, S, E);
    } SEAM(11);
    if (IN(12)) { NEWFRAME();
        const int ntiles = (int)__hip_atomic_load(ctl + CW_NTILES, __ATOMIC_RELAXED, __HIP_MEMORY_SCOPE_AGENT);
        pg8::Gemm g{(const bf16*)(ws + WS_HH), (const bf16*)(ws + WS_WD), ntiles * 256, NE * 2048, D}; pg8::MoeOrder<false> S; S.init(ntiles, 8, F.G, (int)blockIdx.x, (const int*)(ctl + CW_TILEE), nullptr);
        pg8::EpiDown E{(bf16*)(ws + WS_OROW), inp(I_BDOWN), (const float*)(ws + WS_ROWTAB)};
        pg8::gemm_phase<pg8::EpiDown, pg8::MoeOrder<false>, true, true>(F.lds, g, S, E);
    } SEAM(12);
    if (IN(13)) { NEWFRAME(); final_phase(F, args); }
#ifdef PROBE_EXTRA_PHASE
    if (lo == 14) { NEWFRAME(); if (F.tid < 64) ((LAS unsigned*)(F.lds + SC_SYNC))[F.tid] = 0u; __syncthreads(); int bh = 0, quarter = 0; const bool sw = scan_wg(bh, quarter); if (sw && F.wave == 0) r4_scan<0>(F, args, bh, quarter); else if (sw && F.wave == 1) r4_feeder(F, args, bh); }
    if (lo == 17) { NEWFRAME(); int bh = 0, quarter = 0; const bool sw = scan_wg(bh, quarter); if (sw && F.wave == 0) r4_scan<1>(F, args, bh, quarter); }
    if (lo == 15) { NEWFRAME(); moe_weight_convert(F, args, F.vcu * 8 + F.wave, F.G * 8); }
#endif
#undef IN
#undef SEAM
}

extern "C" void kernel_launch(void* const* d_in, const int* in_sizes, int n_in, void* d_out, int out_size, void* d_ws, size_t ws_size, hipStream_t stream) {
    static int grid = 0;
    if (grid == 0) {
        if (n_in != 39 || out_size != T * D || ws_size < WS_END) { fprintf(stderr, "kernel_launch: built for 39 inputs, out of %d floats, >= %zu bytes of workspace; got n_in %d, out %d, ws %zu; nothing launched\n", T * D, (size_t)WS_END, n_in, out_size, ws_size); grid = -1; return; }
        int dev = 0, cus = 0, per_cu = 0;
        if (hipGetDevice(&dev) != hipSuccess || hipDeviceGetAttribute(&cus, hipDeviceAttributeMultiprocessorCount, dev) != hipSuccess) { fprintf(stderr, "kernel_launch: device query failed\n"); grid = -1; return; }
        if (hipFuncSetAttribute((const void*)fwd, hipFuncAttributeMaxDynamicSharedMemorySize, LDS_BYTES) != hipSuccess) { fprintf(stderr, "kernel_launch: hipFuncSetAttribute failed\n"); grid = -1; return; }
        if (hipOccupancyMaxActiveBlocksPerMultiprocessor(&per_cu, (const void*)fwd, NWAVES * 64, LDS_BYTES) != hipSuccess || per_cu < 1)
            fprintf(stderr, "kernel_launch: note: occupancy query reports %d workgroups per CU\n", per_cu);
        (void)hipGetLastError();
        grid = cus;
    }
    if (grid < 0) return;
    (void)in_sizes;
    if (hipMemsetAsync((char*)d_ws + WS_CTL, 0, CTL_ZERO_BYTES, stream) != hipSuccess) { fprintf(stderr, "kernel_launch: hipMemsetAsync failed\n"); return; }
    Args a{};
    for (int i = 0; i < 39; ++i) a.in[i] = (const float*)d_in[i];
    a.out = (float*)d_out; a.ws = (unsigned char*)d_ws;
#if MK_N_LAUNCHES == 1
    a.ph_lo = 0; a.ph_hi = NPH;
    hipLaunchKernelGGL(fwd, dim3(grid), dim3(NWAVES * 64), LDS_BYTES, stream, a);
#else
    for (int k = 0; k < NPH; ++k) { a.ph_lo = k; a.ph_hi = k + 1; int reps = 1;
#ifdef PROBE_REP_PHASE
        if (k == PROBE_REP_PHASE) reps = 1 + PROBE_REP_N;
#endif
        for (int r = 0; r < reps; ++r) hipLaunchKernelGGL(fwd, dim3(grid), dim3(NWAVES * 64), LDS_BYTES, stream, a); }
#ifdef PROBE_EXTRA_PHASE
    for (int r = 0; r < PROBE_REP_N; ++r) { a.ph_lo = PROBE_EXTRA_PHASE; a.ph_hi = PROBE_EXTRA_PHASE + 1; hipLaunchKernelGGL(fwd, dim3(grid), dim3(NWAVES * 64), LDS_BYTES, stream, a); }
#endif
#endif
    const hipError_t le = hipPeekAtLastError();
    if (le != hipSuccess) fprintf(stderr, "kernel_launch: launch failed: %s\n", hipGetErrorName(le));
}
```

```cpp
#include <hip/hip_runtime.h>
#include <cstdio>
#include <cstdint>
namespace pg8 {
#define PG8_LAS __attribute__((address_space(3)))
typedef unsigned short bf16_t;
typedef short bf16x8 __attribute__((ext_vector_type(8)));
typedef float f32x4 __attribute__((ext_vector_type(4)));
typedef unsigned u32x4 __attribute__((ext_vector_type(4)));
constexpr int BM = 256, BK = 64, HALF = 128, HTB = HALF * BK * 2  , STAGE_BYTES = 8 * HTB, NXCD = 8, WGM = 8;

__host__ __device__ __forceinline__ int lds_byte(int r, int c) { const int st = (r >> 4) * 2 + (c >> 5), rr = r & 15, cc = c & 31, ob = rr * 64 + cc * 2; return st * 1024 + (ob ^ (((ob >> 9) & 1) << 5)); }
__host__ __device__ __forceinline__ void stage_rc(int b, int& R, int& C) { const int st = b / 1024, sb = b % 1024, swz = sb ^ (((sb >> 9) & 1) << 5); R = (st >> 1) * 16 + swz / 64; C = (st & 1) * 32 + (swz % 64) / 2; }
__host__ __device__ __forceinline__ int perm32(int rho) { const int n = rho >> 4, i = rho & 15; return 8 * (i >> 2) + 4 * n + (i & 3); }

struct Unit { int pm, pn; };
struct Gemm { const bf16_t* A; const bf16_t* Bt; int M, N, K; };

struct StaticOrder {
    static constexpr bool GATHER = false; __device__ __forceinline__ int arow(const Unit&, int) const { return 0; }
    int nM, nN, nwg, G, c;
    __host__ __device__ void init(int M, int N, int G_, int c_) { nM = M / BM; nN = N / BM; nwg = nM * nN; G = G_; c = c_; }
    __host__ __device__ bool next(int i, Unit& u) const {
        const int L = i * G + c; if (L >= nwg) return false;
        int wgid = (int)L; { const int q = nwg / NXCD, r = nwg % NXCD, xcd = wgid % NXCD, off = wgid / NXCD; wgid = (xcd < r ? xcd * (q + 1) : r * (q + 1) + (xcd - r) * q) + off; }
        const int nig = WGM * nN, gid = wgid / nig, fm = gid * WGM, gsz = (nM - fm) < WGM ? (nM - fm) : WGM;
        u.pm = fm + ((wgid % nig) % gsz); u.pn = (wgid % nig) / gsz; return true;
    }
    __device__ __forceinline__ void a_ready(const Unit&) const {}
    __device__ __forceinline__ void done(const Unit&) const {}
};
__device__ __forceinline__ unsigned cvt_pk_bf16(float lo, float hi) { unsigned r; asm volatile("v_cvt_pk_bf16_f32 %0, %1, %2" : "=v"(r) : "v"(lo), "v"(hi)); return r; }
typedef float f32x2 __attribute__((ext_vector_type(2)));
__device__ __forceinline__ f32x2 gelu_pk(f32x2 v) {
    const f32x2 av = __builtin_elementwise_abs(v), d = av * 0.2316418882f + 1.0f;
    f32x2 t; t.x = __builtin_amdgcn_rcpf(d.x); t.y = __builtin_amdgcn_rcpf(d.y);
    f32x2 q = t * 0.5307027145f + (-0.7265760135f); q = q * t + 0.7107068705f; q = q * t + (-0.142248368f); q = q * t + 0.127414796f; q = q * t;
    const f32x2 s = (v * v) * (-0.72134752044f);
    f32x2 e; e.x = __builtin_amdgcn_exp2f(s.x); e.y = __builtin_amdgcn_exp2f(s.y);
    const f32x2 m = v * (q * e), r = v - m;
    f32x2 o; o.x = v.x < 0.f ? m.x : r.x; o.y = v.y < 0.f ? m.y : r.y; return o;
}

template <int ACT  > struct EpiBf16 {
    static constexpr bool PERM = true, AFTER_DRAIN = false; static constexpr int MIDK = 0; static constexpr int WSCALE = 0x7f7f7f7f; static_assert(ACT == 0 || ACT == 1, "EpiBf16: ACT is 0 (none) or 1 (gelu_pk)");
    bf16_t* O; int ldc; const float* bias; int split_cols; size_t split_stride; float scale0;
    __device__ __forceinline__ void operator()(const f32x4 (&acc)[2][2][4][2], const Unit& u, int wr, int wc, int fr, int fq) const {
        const int row0 = u.pm * BM + wr * 64 + fr; int colt = u.pn * BM; bf16_t* base = O;
        float sc = 1.f; if (split_cols) { const int t = colt / split_cols; base += (size_t)t * split_stride; colt -= t * split_cols; if (t == 0) sc = scale0; }
        const int col0 = colt + wc * 32 + 8 * fq, bcol0 = u.pn * BM + wc * 32 + 8 * fq;
        f32x4 bv[2][2];
#pragma unroll
        for (int bj = 0; bj < 2; ++bj)
#pragma unroll
            for (int n = 0; n < 2; ++n) bv[bj][n] = bias ? *(const f32x4*)(bias + bcol0 + bj * HALF + 4 * n) : (f32x4){0.f, 0.f, 0.f, 0.f};
#pragma unroll
        for (int ai = 0; ai < 2; ++ai)
#pragma unroll
            for (int m = 0; m < 4; ++m) { bf16_t* rowp = base + (size_t)(row0 + ai * HALF + m * 16) * ldc + col0;
#pragma unroll
                for (int bj = 0; bj < 2; ++bj) { f32x4 v0 = acc[ai][bj][m][0] + bv[bj][0], v1 = acc[ai][bj][m][1] + bv[bj][1];
                    if (ACT == 1) { f32x2 a = gelu_pk((f32x2){v0[0], v0[1]}), b = gelu_pk((f32x2){v0[2], v0[3]}), c = gelu_pk((f32x2){v1[0], v1[1]}), d = gelu_pk((f32x2){v1[2], v1[3]});
                        v0 = (f32x4){a.x, a.y, b.x, b.y}; v1 = (f32x4){c.x, c.y, d.x, d.y}; }
                    v0 = v0 * sc; v1 = v1 * sc; u32x4 w; w.x = cvt_pk_bf16(v0[0], v0[1]); w.y = cvt_pk_bf16(v0[2], v0[3]); w.z = cvt_pk_bf16(v1[0], v1[1]); w.w = cvt_pk_bf16(v1[2], v1[3]);
                    *(u32x4*)(rowp + bj * HALF) = w; } }
    }
};

__device__ __forceinline__ float bf_lo(unsigned w) { return __builtin_bit_cast(float, w << 16); }
__device__ __forceinline__ float bf_hi(unsigned w) { return __builtin_bit_cast(float, w & 0xffff0000u); }
__device__ __forceinline__ float fsigmoid(float x) { return __builtin_amdgcn_rcpf(1.0f + __expf(-x)); }
typedef unsigned u32x2 __attribute__((ext_vector_type(2)));

struct EpiF32 {
    static constexpr bool PERM = false, AFTER_DRAIN = false; static constexpr int MIDK = 0; static constexpr int WSCALE = 0x7f7f7f7f;
    float* C; int ldc;
    __device__ __forceinline__ void operator()(const f32x4 (&acc)[2][2][4][2], const Unit& u, int wr, int wc, int fr, int fq) const {
        const int row0 = u.pm * BM + wr * 64 + fr, col0 = u.pn * BM + wc * 32 + 4 * fq;
#pragma unroll
        for (int ai = 0; ai < 2; ++ai)
#pragma unroll
            for (int m = 0; m < 4; ++m) { float* rowp = C + (size_t)(row0 + ai * HALF + m * 16) * ldc + col0;
#pragma unroll
                for (int bj = 0; bj < 2; ++bj)
#pragma unroll
                    for (int n = 0; n < 2; ++n) *(f32x4*)(rowp + bj * HALF + n * 16) = acc[ai][bj][m][n]; }
    }
};
struct EpiRes {
    static constexpr bool PERM = false, AFTER_DRAIN = false; static constexpr int MIDK = 0; static constexpr int WSCALE = 0x7f7f7f7f;
    const float* X; float* C; int ldc;
    __device__ __forceinline__ void operator()(const f32x4 (&acc)[2][2][4][2], const Unit& u, int wr, int wc, int fr, int fq) const {
        const int row0 = u.pm * BM + wr * 64 + fr, col0 = u.pn * BM + wc * 32 + 4 * fq;
#pragma unroll
        for (int ai = 0; ai < 2; ++ai)
#pragma unroll
            for (int m = 0; m < 4; ++m) { const size_t off = (size_t)(row0 + ai * HALF + m * 16) * ldc + col0;
#pragma unroll
                for (int bj = 0; bj < 2; ++bj)
#pragma unroll
                    for (int n = 0; n < 2; ++n) { const f32x4 xv = *(const f32x4*)(X + off + bj * HALF + n * 16); *(f32x4*)(C + off + bj * HALF + n * 16) = acc[ai][bj][m][n] + xv; }
                asm volatile("" ::: "memory"); }
    }
};
struct EpiKV {
    static constexpr bool PERM = false, AFTER_DRAIN = false; static constexpr int MIDK = 0; static constexpr int WSCALE = 0x7f7f7f7f;
    bf16_t* Kb; bf16_t* VT;
    __device__ __forceinline__ void operator()(const f32x4 (&acc)[2][2][4][2], const Unit& u, int wr, int wc, int fr, int fq) const {
        const int row0 = u.pm * BM + wr * 64 + fr, col0 = u.pn * BM + wc * 32 + 4 * fq;
#pragma unroll
        for (int ai = 0; ai < 2; ++ai)
#pragma unroll
            for (int m = 0; m < 4; ++m) { const int r = row0 + ai * HALF + m * 16;
#pragma unroll
                for (int bj = 0; bj < 2; ++bj)
#pragma unroll
                    for (int n = 0; n < 2; ++n) { const f32x4 v = acc[ai][bj][m][n]; const int c = col0 + bj * HALF + n * 16;
                        if (u.pn < 4) { u32x2 w; w.x = cvt_pk_bf16(v[0], v[1]); w.y = cvt_pk_bf16(v[2], v[3]); *(u32x2*)(Kb + (size_t)r * 1024 + c) = w; }
                        else { const int cc = c - 1024, h = cc >> 8, d = cc & 255, b = r >> 8, mm = r & 255;
                            const int idx = (mm >> 5) * 32 + ((mm >> 2) & 3) * 8 + ((mm >> 4) & 1) * 4 + (mm & 3);
                            bf16_t* o = VT + ((size_t)((b * 4 + h) * 256 + d)) * 256 + idx;
                            const unsigned w0 = cvt_pk_bf16(v[0], v[1]), w1 = cvt_pk_bf16(v[2], v[3]);
                            o[0] = (bf16_t)(w0 & 0xffffu); o[256] = (bf16_t)(w0 >> 16); o[512] = (bf16_t)(w1 & 0xffffu); o[768] = (bf16_t)(w1 >> 16); } } }
    }
};
struct EpiBranch {
    static constexpr bool PERM = false, AFTER_DRAIN = false; static constexpr int MIDK = 0; static constexpr int WSCALE = 0x7f7f7f7f;
    const bf16_t* P; int ldp; int gcol0; float* macc; bf16_t* merged;
    __device__ __forceinline__ void operator()(const f32x4 (&acc)[2][2][4][2], const Unit& u, int wr, int wc, int fr, int fq) const {
        const int br = u.pm >> 6, pm = u.pm & 63, pn = u.pn & 7;
        const int row0 = pm * BM + wr * 64 + fr, col0 = pn * BM + wc * 32 + 4 * fq;
#pragma unroll
        for (int ai = 0; ai < 2; ++ai)
#pragma unroll
            for (int m = 0; m < 4; ++m) { const int r = row0 + ai * HALF + m * 16; const bf16_t* prow = P + (size_t)r * ldp + gcol0 + br * 2048;
#pragma unroll
                for (int bj = 0; bj < 2; ++bj)
#pragma unroll
                    for (int n = 0; n < 2; ++n) { const int c = col0 + bj * HALF + n * 16; const u32x2 gw = *(const u32x2*)(prow + c);
                        f32x4 g; g[0] = fsigmoid(bf_lo(gw.x)); g[1] = fsigmoid(bf_hi(gw.x)); g[2] = fsigmoid(bf_lo(gw.y)); g[3] = fsigmoid(bf_hi(gw.y));
                        f32x4 v = acc[ai][bj][m][n] * g; float* mp = macc + (size_t)r * 2048 + c;
                        if (br > 0) v = v + *(const f32x4*)mp;
                        if (br < 2) *(f32x4*)mp = v;
                        else { u32x2 w; w.x = cvt_pk_bf16(v[0], v[1]); w.y = cvt_pk_bf16(v[2], v[3]); *(u32x2*)(merged + (size_t)r * 2048 + c) = w; } }
                asm volatile("" ::: "memory"); }
    }
};
struct EpiSwiglu {
    static constexpr bool PERM = true, AFTER_DRAIN = false; static constexpr int MIDK = 0; static constexpr int WSCALE = 0x79797979;
    unsigned char* H; const float* bg; const float* bu;
    __device__ __forceinline__ void operator()(const f32x4 (&acc)[2][2][4][2], const Unit& u, int wr, int wc, int fr, int fq) const {
        int tz_ = threadIdx.x; asm volatile("" : "+v"(tz_)); { const int wid_ = tz_ >> 6, lane_ = tz_ & 63; wr = wid_ >> 2; wc = wid_ & 3; fr = lane_ & 15; fq = lane_ >> 4; }
        const int e = u.pn >> 4, ct = u.pn & 15;
        const int row0 = u.pm * BM + wr * 64 + fr, col0 = ct * 128 + wc * 32 + 8 * fq;
        f32x4 bgv[2], buv[2];
#pragma unroll
        for (int n = 0; n < 2; ++n) { bgv[n] = *(const f32x4*)(bg + (size_t)e * 2048 + col0 + 4 * n); buv[n] = *(const f32x4*)(bu + (size_t)e * 2048 + col0 + 4 * n); }
#pragma unroll
        for (int ai = 0; ai < 2; ++ai)
#pragma unroll
            for (int m = 0; m < 4; ++m) { unsigned char* rowp = H + (size_t)(row0 + ai * HALF + m * 16) * 2048 + col0;
                f32x4 o[2];
#pragma unroll
                for (int n = 0; n < 2; ++n) { const f32x4 g = acc[ai][0][m][n] + bgv[n], up = acc[ai][1][m][n] + buv[n];
#pragma unroll
                    for (int j = 0; j < 4; ++j) { const float hg = fminf(g[j], 7.0f), hu = fminf(fmaxf(up[j], -7.0f), 7.0f); o[n][j] = (hu + 1.0f) * hg * fsigmoid(1.702f * hg); } }
                u32x2 w; { int t0 = __builtin_amdgcn_cvt_pk_fp8_f32(o[0][0], o[0][1], 0, false); t0 = __builtin_amdgcn_cvt_pk_fp8_f32(o[0][2], o[0][3], t0, true); int t1 = __builtin_amdgcn_cvt_pk_fp8_f32(o[1][0], o[1][1], 0, false); t1 = __builtin_amdgcn_cvt_pk_fp8_f32(o[1][2], o[1][3], t1, true); w.x = (unsigned)t0; w.y = (unsigned)t1; }
                *(u32x2*)rowp = w; }
    }
};
struct EpiDown {
    static constexpr bool PERM = true, AFTER_DRAIN = false; static constexpr int MIDK = 0; static constexpr int WSCALE = 0x79797979;
    bf16_t* O; const float* bd; const float* rowgate;
    __device__ __forceinline__ void operator()(const f32x4 (&acc)[2][2][4][2], const Unit& u, int wr, int wc, int fr, int fq) const {
        int tz_ = threadIdx.x; asm volatile("" : "+v"(tz_)); { const int wid_ = tz_ >> 6, lane_ = tz_ & 63; wr = wid_ >> 2; wc = wid_ & 3; fr = lane_ & 15; fq = lane_ >> 4; }
        const int e = u.pn >> 3, ct = u.pn & 7;
        const int row0 = u.pm * BM + wr * 64 + fr, col0 = ct * BM + wc * 32 + 8 * fq;
        f32x4 bv[2][2];
#pragma unroll
        for (int bj = 0; bj < 2; ++bj)
#pragma unroll
            for (int n = 0; n < 2; ++n) bv[bj][n] = *(const f32x4*)(bd + (size_t)e * 2048 + col0 + bj * HALF + 4 * n);
#pragma unroll
        for (int ai = 0; ai < 2; ++ai)
#pragma unroll
            for (int m = 0; m < 4; ++m) { const int r = row0 + ai * HALF + m * 16; const float gs = rowgate[r]; bf16_t* rowp = O + (size_t)r * 2048 + col0;
#pragma unroll
                for (int bj = 0; bj < 2; ++bj) { const f32x4 v0 = (acc[ai][bj][m][0] + bv[bj][0]) * gs, v1 = (acc[ai][bj][m][1] + bv[bj][1]) * gs;
                    u32x4 w; w.x = cvt_pk_bf16(v0[0], v0[1]); w.y = cvt_pk_bf16(v0[2], v0[3]); w.z = cvt_pk_bf16(v1[0], v1[1]); w.w = cvt_pk_bf16(v1[2], v1[3]);
                    *(u32x4*)(rowp + bj * HALF) = w; } }
    }
};

struct EpiBranch2 {
    static constexpr bool PERM = false, AFTER_DRAIN = false; static constexpr int MIDK = 16; static constexpr int WSCALE = 0x7f7f7f7f;
    const bf16_t* P; int ldp; int gcol0; bf16_t* merged;
    __device__ __forceinline__ void mid(f32x4 (&acc)[2][2][4][2], const Unit& u, int which, int, int, int, int) const {
        int tz = threadIdx.x; asm volatile("" : "+v"(tz));
        const int wid_ = tz >> 6, lane_ = tz & 63, wr = wid_ >> 2, wc = wid_ & 3, fr = lane_ & 15, fq = lane_ >> 4;
        const int row0 = u.pm * BM + wr * 64 + fr, col0 = u.pn * BM + wc * 32 + 4 * fq;
#pragma unroll
        for (int ai = 0; ai < 2; ++ai)
#pragma unroll
            for (int m = 0; m < 4; ++m) { const bf16_t* prow = P + (size_t)(row0 + ai * HALF + m * 16) * ldp + gcol0 + (which - 1) * 2048;
#pragma unroll
                for (int bj = 0; bj < 2; ++bj)
#pragma unroll
                    for (int n = 0; n < 2; ++n) { const int c = col0 + bj * HALF + n * 16; const u32x2 ga = *(const u32x2*)(prow + c), gb = *(const u32x2*)(prow + 2048 + c);
                        const float a_[4] = {bf_lo(ga.x), bf_hi(ga.x), bf_lo(ga.y), bf_hi(ga.y)}, b_[4] = {bf_lo(gb.x), bf_hi(gb.x), bf_lo(gb.y), bf_hi(gb.y)};
#pragma unroll
                        for (int j = 0; j < 4; ++j) { const float ea = __expf(-fminf(fmaxf(a_[j], -30.f), 30.f)), eb = __expf(-fminf(fmaxf(b_[j], -30.f), 30.f));
                            acc[ai][bj][m][n][j] *= (1.0f + eb) * __builtin_amdgcn_rcpf(1.0f + ea); } }
                asm volatile("" ::: "memory"); }
    }
    __device__ __forceinline__ void operator()(const f32x4 (&acc)[2][2][4][2], const Unit& u, int wr, int wc, int fr, int fq) const {
        const int row0 = u.pm * BM + wr * 64 + fr, col0 = u.pn * BM + wc * 32 + 4 * fq;
#pragma unroll
        for (int ai = 0; ai < 2; ++ai)
#pragma unroll
            for (int m = 0; m < 4; ++m) { const int r = row0 + ai * HALF + m * 16; const bf16_t* prow = P + (size_t)r * ldp + gcol0 + 2 * 2048;
#pragma unroll
                for (int bj = 0; bj < 2; ++bj)
#pragma unroll
                    for (int n = 0; n < 2; ++n) { const int c = col0 + bj * HALF + n * 16; const u32x2 gw = *(const u32x2*)(prow + c);
                        const float g_[4] = {bf_lo(gw.x), bf_hi(gw.x), bf_lo(gw.y), bf_hi(gw.y)}; f32x4 v = acc[ai][bj][m][n];
#pragma unroll
                        for (int j = 0; j < 4; ++j) v[j] *= __builtin_amdgcn_rcpf(1.0f + __expf(-fminf(fmaxf(g_[j], -30.f), 30.f)));
                        u32x2 w; w.x = cvt_pk_bf16(v[0], v[1]); w.y = cvt_pk_bf16(v[2], v[3]); *(u32x2*)(merged + (size_t)r * 2048 + c) = w; }
                asm volatile("" ::: "memory"); }
    }
};
struct BranchOrder {                              static constexpr bool GATHER = false; __device__ __forceinline__ int arow(const Unit&, int) const { return 0; }
    StaticOrder so;
    __device__ void init(int G_, int c_) { so.init(16384, 2048, G_, c_); }
    __device__ bool next(int i, Unit& u) const { const int br = i % 3; Unit t; if (!so.next(i / 3, t)) return false; u.pm = br * 64 + t.pm; u.pn = br * 8 + t.pn; return true; }
    __device__ __forceinline__ void a_ready(const Unit&) const {}
    __device__ __forceinline__ void done(const Unit&) const {}
};
template <bool GATH> struct MoeOrder {
    static constexpr bool GATHER = GATH;
    StaticOrder so; const int* tile_e; const int* tok; int nN;
    __device__ void init(int ntiles, int nN_, int G_, int c_, const int* te, const int* tk) { so.init(ntiles * BM, nN_ * BM, G_, c_); tile_e = te; tok = tk; nN = nN_; }
    __device__ bool next(int i, Unit& u) const { Unit t; if (!so.next(i, t)) return false; u.pm = t.pm; u.pn = tile_e[t.pm] * nN + t.pn; return true; }
    __device__ __forceinline__ int arow(const Unit& u, int r) const { return tok[u.pm * BM + r]; }
    __device__ __forceinline__ void a_ready(const Unit&) const {}
    __device__ __forceinline__ void done(const Unit&) const {}
};
typedef int i32x4 __attribute__((ext_vector_type(4)));
typedef int i32x8 __attribute__((ext_vector_type(8)));
__device__ __forceinline__ i32x8 frag8(bf16x8 lo, bf16x8 hi) { return __builtin_shufflevector(__builtin_bit_cast(i32x4, lo), __builtin_bit_cast(i32x4, hi), 0, 1, 2, 3, 4, 5, 6, 7); }
template <class Epi, class Sched, bool ALIGN_EPI = false, bool SP2 = false, int ESZ = 2>
__device__ __forceinline__ void gemm_phase(PG8_LAS unsigned char* lds, const Gemm g, const Sched& S, const Epi& E) {
    const int tid = threadIdx.x, wid = __builtin_amdgcn_readfirstlane(tid >> 6), lane = tid & 63, wr = wid >> 2, wc = wid & 3, fr = lane & 15, fq = lane >> 4;
    const int K = g.K, nt = K / (BK * 2 / ESZ);
    const __amdgpu_buffer_rsrc_t rsA = __builtin_amdgcn_make_buffer_rsrc((void*)g.A, 0, 0x7fffffff, 0x00020000), rsB = __builtin_amdgcn_make_buffer_rsrc((void*)g.Bt, 0, 0x7fffffff, 0x00020000);
    unsigned voffA[2], voffB[2];
#pragma unroll
    for (int i = 0; i < 2; ++i) { int R, C; stage_rc(tid * 16 + i * 8192, R, C); const int Rb = Epi::PERM ? ((R & ~31) + perm32(R & 31)) : R;
        voffA[i] = (unsigned)(R * K) * (unsigned)ESZ + (unsigned)C * 2u; voffB[i] = (unsigned)(Rb * K) * (unsigned)ESZ + (unsigned)C * 2u; }
    unsigned vc[2][2] = {{0u, 0u}, {0u, 0u}}, vn[2][2] = {{0u, 0u}, {0u, 0u}};
#define PG8_ROWS(dst, un) do { if constexpr (Sched::GATHER) { _Pragma("unroll") for (int _h = 0; _h < 2; ++_h) _Pragma("unroll") for (int _i = 0; _i < 2; ++_i) { int R_, C_; stage_rc(tid * 16 + _i * 8192, R_, C_); \
        dst[_h][_i] = (unsigned)(S.arow(un, _h * HALF + R_) * K) * (unsigned)ESZ + (unsigned)C_ * 2u; } } } while (0)
#define PG8_STAGE_A(bufoff, abase, half, nx) do { if constexpr (Sched::GATHER) { unsigned vo_[2]; vo_[0] = (nx) ? vn[half][0] : vc[half][0]; vo_[1] = (nx) ? vn[half][1] : vc[half][1]; PG8_STAGE_R(bufoff, rsA, g.A, abase, vo_); } \
        else { PG8_STAGE_R(bufoff, rsA, g.A, (abase) + (half) * hstep, voffA); } } while (0)
    const size_t kstep = (size_t)(BK * 2);
    const size_t hstep = (size_t)HALF * K * ESZ;
    const size_t tstep = 2 * hstep;
    const unsigned ldsw = (unsigned)wid * 1024u;
    const int aoff = lds_byte(wr * 64 + fr, fq * 8), boff = lds_byte(wc * 32 + fr, fq * 8);
    const int aoffE = lds_byte(wr * 64 + fr, fq * 16), boffE = lds_byte(wc * 32 + fr, fq * 16);
#define PG8_SA(b, h) (((b) * 2 + (h)) * HTB)
#define PG8_SB(b, h) ((4 + (b) * 2 + (h)) * HTB)
#define PG8_STAGE_R(bufoff, rs, b0, gbase, voff) do { const int so_ = (int)((const char*)(gbase) - (const char*)(b0)); _Pragma("unroll") for (int _i = 0; _i < 2; ++_i) \
        __builtin_amdgcn_raw_ptr_buffer_load_lds(rs, (PG8_LAS void*)(lds + (bufoff) + ldsw + _i * 8192), 16, (int)(voff)[_i], so_, 0, 0); } while (0)
#define PG8_STAGE(bufoff, gbase, voff) PG8_STAGE_R(bufoff, rsB, g.Bt, gbase, voff)
#define PG8_LDA(dst, b, h) do { if constexpr (ESZ == 2) { _Pragma("unroll") for (int m = 0; m < 4; ++m) _Pragma("unroll") for (int k = 0; k < 2; ++k) dst[m][k] = *(const PG8_LAS bf16x8*)(lds + PG8_SA(b, h) + aoff + m * 2048 + k * 1024); } \
        else { _Pragma("unroll") for (int m = 0; m < 4; ++m) { dst##8[m].lo = *(const PG8_LAS i32x4*)(lds + PG8_SA(b, h) + aoffE + m * 2048); dst##8[m].hi = *(const PG8_LAS i32x4*)(lds + PG8_SA(b, h) + aoffE + 16 + m * 2048); } } } while (0)
#define PG8_LDB(dst, b, h) do { if constexpr (ESZ == 2) { _Pragma("unroll") for (int n = 0; n < 2; ++n) _Pragma("unroll") for (int k = 0; k < 2; ++k) dst[n][k] = *(const PG8_LAS bf16x8*)(lds + PG8_SB(b, h) + boff + n * 2048 + k * 1024); } \
        else { _Pragma("unroll") for (int n = 0; n < 2; ++n) { dst##8[n].lo = *(const PG8_LAS i32x4*)(lds + PG8_SB(b, h) + boffE + n * 2048); dst##8[n].hi = *(const PG8_LAS i32x4*)(lds + PG8_SB(b, h) + boffE + 16 + n * 2048); } } } while (0)
#define PG8_MMA(ai, bj, At, Bt) do { __builtin_amdgcn_s_setprio(1); _Pragma("unroll") for (int m = 0; m < 4; ++m) _Pragma("unroll") for (int n = 0; n < 2; ++n) { if constexpr (ESZ == 2) { _Pragma("unroll") for (int k = 0; k < 2; ++k) \
        acc[ai][bj][m][n] = __builtin_amdgcn_mfma_f32_16x16x32_bf16(Bt[n][k], At[m][k], acc[ai][bj][m][n], 0, 0, 0); } else { \
        acc[ai][bj][m][n] = __builtin_amdgcn_mfma_scale_f32_16x16x128_f8f6f4(Bt##8[n], At##8[m], acc[ai][bj][m][n], 0, 0, 0, Epi::WSCALE, 0, 0x7f7f7f7f); } } __builtin_amdgcn_s_setprio(0); } while (0)
#define PG8_WAIT_V(n) asm volatile("s_waitcnt vmcnt(" #n ")" ::: "memory")
#define PG8_WAIT_L(n) asm volatile("s_waitcnt lgkmcnt(" #n ")" ::: "memory")
#define PG8_BAR __builtin_amdgcn_s_barrier()
#define PG8_SCHED __builtin_amdgcn_sched_barrier(0)
    Unit cur, nxt; int ui = 0;
    if (!S.next(0, cur)) return;
    f32x4 acc[2][2][4][2];
#pragma unroll
    for (int a = 0; a < 2; ++a)
#pragma unroll
        for (int b = 0; b < 2; ++b)
#pragma unroll
            for (int m = 0; m < 4; ++m)
#pragma unroll
                for (int n = 0; n < 2; ++n) acc[a][b][m][n] = (f32x4){0.f, 0.f, 0.f, 0.f};
    bf16x8 At[4][2], B0[2][2], B1[2][2];
    i32x8 At8[4], B08[2], B18[2];
    const char* cA = (const char*)g.A + (Sched::GATHER ? (size_t)0 : (size_t)cur.pm * tstep); const char* cB = (const char*)g.Bt + (size_t)cur.pn * tstep;
    PG8_ROWS(vc, cur);
    S.a_ready(cur);
    if constexpr (SP2) {
        PG8_STAGE(PG8_SB(0, 0), cB, voffB); PG8_STAGE(PG8_SB(0, 1), cB + hstep, voffB); PG8_STAGE_A(PG8_SA(0, 0), cA, 0, false); PG8_STAGE_A(PG8_SA(0, 1), cA, 1, false);
        if (wr == 1) PG8_BAR;
        PG8_WAIT_V(2); PG8_BAR;
        PG8_STAGE(PG8_SB(1, 0), cB + kstep, voffB); PG8_STAGE_A(PG8_SA(1, 0), cA + kstep, 0, false); PG8_STAGE(PG8_SB(1, 1), cB + hstep + kstep, voffB);
        PG8_WAIT_V(6); PG8_BAR;
    } else {
        PG8_STAGE(PG8_SB(0, 0), cB, voffB); PG8_STAGE_A(PG8_SA(0, 0), cA, 0, false); PG8_STAGE(PG8_SB(0, 1), cB + hstep, voffB); PG8_STAGE_A(PG8_SA(0, 1), cA, 1, false);
        if (wr == 1) PG8_BAR;
        PG8_WAIT_V(4); PG8_BAR;
        PG8_STAGE(PG8_SB(1, 0), cB + kstep, voffB); PG8_STAGE_A(PG8_SA(1, 0), cA + kstep, 0, false); PG8_STAGE(PG8_SB(1, 1), cB + hstep + kstep, voffB);
        PG8_WAIT_V(6); PG8_BAR;
    }
    for (;;) {
        const bool has_next = S.next(ui + 1, nxt);
        if (has_next) PG8_ROWS(vn, nxt);
        const char* nA = (has_next && !Sched::GATHER) ? (const char*)g.A + (size_t)nxt.pm * tstep : cA; const char* nB = has_next ? (const char*)g.Bt + (size_t)nxt.pn * tstep : cB;
        for (int t = 0; t < nt; t += 2) {
            const bool last = (t == nt - 2);
            const char* a1 = cA + (size_t)(t + 1) * kstep;
            const char* a2 = last ? nA : cA + (size_t)(t + 2) * kstep; const char* b2 = last ? nB : cB + (size_t)(t + 2) * kstep;
            const char* a3 = a2 + kstep; const char* b3 = b2 + kstep;
            if (last && has_next) S.a_ready(nxt);
            if constexpr (Epi::MIDK > 0) { if (t == Epi::MIDK || t == 2 * Epi::MIDK) E.mid(acc, cur, t / Epi::MIDK, wr, wc, fr, fq); }
            if constexpr (SP2) {
            PG8_LDB(B0, 0, 0); PG8_LDB(B1, 0, 1); PG8_SCHED; PG8_LDA(At, 0, 0); PG8_STAGE_A(PG8_SA(1, 1), a1, 1, false);
            PG8_WAIT_V(8); PG8_WAIT_L(0); PG8_BAR; PG8_MMA(0, 0, At, B0); PG8_MMA(0, 1, At, B1); PG8_BAR; PG8_SCHED;
            PG8_LDA(At, 0, 1); PG8_STAGE(PG8_SB(0, 0), b2, voffB); PG8_STAGE(PG8_SB(0, 1), b2 + hstep, voffB); PG8_STAGE_A(PG8_SA(0, 0), a2, 0, last);
            PG8_WAIT_V(8); PG8_WAIT_L(0); PG8_BAR; PG8_MMA(1, 0, At, B0); PG8_MMA(1, 1, At, B1); PG8_BAR; PG8_SCHED;
            PG8_LDB(B0, 1, 0); PG8_LDB(B1, 1, 1); PG8_SCHED; PG8_LDA(At, 1, 0); PG8_STAGE_A(PG8_SA(0, 1), a2, 1, last);
            PG8_WAIT_V(8); PG8_WAIT_L(0); PG8_BAR; PG8_MMA(0, 0, At, B0); PG8_MMA(0, 1, At, B1); PG8_BAR; PG8_SCHED;
            PG8_LDA(At, 1, 1); PG8_STAGE(PG8_SB(1, 0), b3, voffB); PG8_STAGE(PG8_SB(1, 1), b3 + hstep, voffB); PG8_STAGE_A(PG8_SA(1, 0), a3, 0, last);
            PG8_WAIT_V(8); PG8_WAIT_L(0); PG8_BAR; PG8_MMA(1, 0, At, B0); PG8_MMA(1, 1, At, B1); PG8_BAR; PG8_SCHED;
            } else {
            PG8_LDB(B0, 0, 0); PG8_SCHED; PG8_LDA(At, 0, 0); PG8_STAGE_A(PG8_SA(1, 1), a1, 1, false);
            PG8_WAIT_L(8); PG8_BAR; PG8_WAIT_L(0); PG8_MMA(0, 0, At, B0); PG8_BAR; PG8_SCHED;
            PG8_LDB(B1, 0, 1); PG8_STAGE(PG8_SB(0, 0), b2, voffB);
            PG8_BAR; PG8_WAIT_L(0); PG8_MMA(0, 1, At, B1); PG8_BAR;
            PG8_LDA(At, 0, 1); PG8_STAGE_A(PG8_SA(0, 0), a2, 0, last);
            PG8_BAR; PG8_WAIT_L(0); PG8_MMA(1, 0, At, B0); PG8_BAR; PG8_SCHED;
            PG8_STAGE(PG8_SB(0, 1), b2 + hstep, voffB);
            PG8_WAIT_V(6); PG8_BAR; PG8_MMA(1, 1, At, B1); PG8_BAR;
            PG8_LDB(B0, 1, 0); PG8_SCHED; PG8_LDA(At, 1, 0); PG8_STAGE_A(PG8_SA(0, 1), a2, 1, last);
            PG8_WAIT_L(8); PG8_BAR; PG8_WAIT_L(0); PG8_MMA(0, 0, At, B0); PG8_BAR; PG8_SCHED;
            PG8_LDB(B1, 1, 1); PG8_STAGE(PG8_SB(1, 0), b3, voffB);
            PG8_BAR; PG8_WAIT_L(0); PG8_MMA(0, 1, At, B1); PG8_BAR;
            PG8_LDA(At, 1, 1); PG8_STAGE_A(PG8_SA(1, 0), a3, 0, last);
            PG8_BAR; PG8_WAIT_L(0); PG8_MMA(1, 0, At, B0); PG8_BAR; PG8_SCHED;
            PG8_STAGE(PG8_SB(1, 1), b3 + hstep, voffB);
            PG8_WAIT_V(6); PG8_BAR; PG8_MMA(1, 1, At, B1); PG8_BAR;
            }
        }
        if constexpr (ALIGN_EPI) { if (wr == 0) PG8_BAR; }
        if constexpr (!Epi::AFTER_DRAIN) { E(acc, cur, wr, wc, fr, fq); S.done(cur); }
        if (!has_next) break;
#pragma unroll
        for (int a = 0; a < 2; ++a)
#pragma unroll
            for (int b = 0; b < 2; ++b)
#pragma unroll
                for (int m = 0; m < 4; ++m)
#pragma unroll
                    for (int n = 0; n < 2; ++n) acc[a][b][m][n] = (f32x4){0.f, 0.f, 0.f, 0.f};
        cur = nxt; cA = nA; cB = nB; ++ui;
        if constexpr (Sched::GATHER) { vc[0][0] = vn[0][0]; vc[0][1] = vn[0][1]; vc[1][0] = vn[1][0]; vc[1][1] = vn[1][1]; }
        if constexpr (ALIGN_EPI) { if (wr == 1) PG8_BAR; }
    }
    PG8_WAIT_V(0);
    if constexpr (!ALIGN_EPI) { if (wr == 0) PG8_BAR; }
    PG8_BAR;
    if constexpr (Epi::AFTER_DRAIN) { E.fused(acc, cur, wr, wc, fr, fq, lds, wid, lane); S.done(cur); }
#undef PG8_SA
#undef PG8_SB
#undef PG8_STAGE
#undef PG8_STAGE_R
#undef PG8_STAGE_A
#undef PG8_ROWS
#undef PG8_LDA
#undef PG8_LDB
#undef PG8_MMA
#undef PG8_WAIT_V
#undef PG8_WAIT_L
#undef PG8_BAR
#undef PG8_SCHED
}
}

constexpr int NWAVES = 8;
constexpr int BATCH = 2, SEQ = 8192, T = BATCH * SEQ, D = 2048;
constexpr int RWKV_COLS = 3360, IN_COLS = 12576;
constexpr int NP = 12800;
constexpr int PC_LX = 3584, PC_LY = 4608, PC_Q = 5632, PC_G = 6656;
constexpr int NE = 32, MAXROWS = 65536 + NE * 256;
constexpr int LORA_K = 384;
constexpr float EPS = 1e-6f, GN_EPS = 64e-5f;

constexpr size_t MiB = 1u << 20;
constexpr size_t WS_CTL = 0, CTL_ZERO_BYTES = 1 * MiB;
constexpr size_t WS_WIN = 1 * MiB, WS_WMKV = 51 * MiB, WS_WLORA = 59 * MiB, WS_WBR = 62 * MiB, WS_WO = 74 * MiB, WS_WR = 82 * MiB, WS_LW = 83 * MiB;
constexpr size_t WS_WGU = 84 * MiB, WS_WD = 596 * MiB;
constexpr size_t WS_XN = 852 * MiB;
constexpr size_t WS_P = 916 * MiB;
constexpr size_t WS_LORAOUT = 1316 * MiB;
constexpr size_t WS_SCAN = 1508 * MiB;
constexpr size_t WS_YABC = 1892 * MiB;
constexpr size_t WS_MISC = 1988 * MiB;
constexpr size_t WS_MN = WS_MISC, WS_KMEM = WS_MISC + 2 * MiB, WS_VT = WS_MISC + 3 * MiB, WS_LRUC = WS_MISC + 4 * MiB  , WS_BONUS = WS_MISC + 7 * MiB;
constexpr size_t WS_PICK = WS_MISC + 8 * MiB  , WS_ROWTAB = WS_MISC + 9 * MiB  , WS_SPL = WS_ROWTAB + 512 * 1024  ;
constexpr size_t WS_END = 2000 * MiB;
constexpr size_t WS_MACC = WS_LORAOUT, WS_MERGED = 1444 * MiB, WS_H1 = WS_SCAN, WS_XS = WS_P, WS_OROW = WS_P, WS_HH = 1204 * MiB;
constexpr int CW_BAR = 4096, CW_CNT = 8192, CW_NTILES = 8192 + 64, CW_TILEE = 8192 + 128;

constexpr int LDS_BYTES = 147456;
constexpr int MISC_OFF = 143360;

#define GAS __attribute__((address_space(1)))
#define LAS __attribute__((address_space(3)))
typedef unsigned short bf16;
typedef unsigned v4u __attribute__((ext_vector_type(4)));
typedef unsigned v2u __attribute__((ext_vector_type(2)));
typedef float f32x4 __attribute__((ext_vector_type(4)));
typedef float f32x2 __attribute__((ext_vector_type(2)));
typedef short bf16x8 __attribute__((ext_vector_type(8)));
#define LDS_WAIT() asm volatile("s_waitcnt lgkmcnt(0)" ::: "memory")
#define VM_WAIT() asm volatile("s_waitcnt vmcnt(0)" ::: "memory")
__device__ __forceinline__ unsigned f2bf(float f) { unsigned u = __builtin_bit_cast(unsigned, f); return (u + 0x7fffu + ((u >> 16) & 1u)) >> 16; }
__device__ __forceinline__ unsigned pk2(float lo, float hi) { return f2bf(lo) | (f2bf(hi) << 16); }
__device__ __forceinline__ float bflo(unsigned w) { return __builtin_bit_cast(float, w << 16); }
__device__ __forceinline__ float bfhi(unsigned w) { return __builtin_bit_cast(float, w & 0xffff0000u); }
__device__ __forceinline__ float bf1(bf16 b) { return __builtin_bit_cast(float, (unsigned)b << 16); }
__device__ __forceinline__ float sigm(float x) { return __builtin_amdgcn_rcpf(1.0f + __expf(-x)); }
__device__ __forceinline__ float fast_tanh(float x) { const float e = __expf(2.0f * x); return 1.0f - 2.0f * __builtin_amdgcn_rcpf(e + 1.0f); }
__device__ __forceinline__ float softplusf(float x) { return fmaxf(x, 0.f) + log1pf(__expf(-fabsf(x))); }
__device__ __forceinline__ float wave_sum(float v) {
#pragma unroll
    for (int o = 1; o < 64; o <<= 1) v += __shfl_xor(v, o);
    return v;
}
template <int CTRL> __device__ __forceinline__ float dppf(float x) { return __builtin_bit_cast(float, __builtin_amdgcn_mov_dpp(__builtin_bit_cast(int, x), CTRL, 0xf, 0xf, true)); }
__device__ __forceinline__ float row16_sum(float v) {
    v += dppf<0xB1>(v); v += dppf<0x4E>(v); v += dppf<0x141>(v); v += dppf<0x140>(v); return v;
}
#define XB_TMO      128
#define XB_XCNT(j)  (256  + 64 * (j))
#define XB_XSUB(j)  (1280 + 64 * (j))
#define XB_XGEN(j)  (2304 + 64 * (j))
#define XB_TOP      3328
#define XB_TOPGEN   3392
#define XCD_BAR_WORDS 3456
#define XB_SPIN_CAP (1u << 18)

__device__ __forceinline__ unsigned xb_ld(unsigned* p)              { return __hip_atomic_load(p, __ATOMIC_RELAXED, __HIP_MEMORY_SCOPE_AGENT); }
__device__ __forceinline__ unsigned xb_add(unsigned* p, unsigned v) { return __hip_atomic_fetch_add(p, v, __ATOMIC_RELAXED, __HIP_MEMORY_SCOPE_AGENT); }
__device__ __forceinline__ unsigned xb_xcc_id() { return (unsigned)__builtin_amdgcn_s_getreg((3 << 11) | 20) & 0xFu; }
#define XB_SPIN(cond, bar) do { unsigned _sp = 0; while (cond) { __builtin_amdgcn_s_sleep(1); \
    if ((++_sp & 255u) == 0u) { if (xb_ld(&(bar)[XB_TMO])) break; if (_sp > XB_SPIN_CAP) { atomicAdd(&(bar)[XB_TMO], 1u); break; } } } } while (0)

struct XcdBarrier {
    unsigned* bar; unsigned x;
    volatile LAS unsigned* st;
};

__device__ __forceinline__ XcdBarrier xcd_barrier_post(unsigned* bar, volatile LAS unsigned* st) {
    XcdBarrier b; b.bar = bar; b.x = xb_xcc_id(); b.st = st;
    if (threadIdx.x == 0) (void)xb_add(&bar[XB_XCNT(b.x)], 1u);
    return b;
}
__device__ __forceinline__ void xcd_barrier_complete(unsigned* bar, unsigned x, unsigned& nloc, unsigned& nx) {
    const unsigned G = gridDim.x * gridDim.y * gridDim.z;
    unsigned sum, cnt, mine, sp = 0u;
    for (;;) {
        sum = 0u; cnt = 0u; mine = 0u;
#pragma unroll
        for (unsigned j = 0; j < 16; ++j) { const unsigned c = xb_ld(&bar[XB_XCNT(j)]); sum += c; cnt += (c > 0u) ? 1u : 0u; mine = (j == x) ? c : mine; }
        if (sum == G) break;
        __builtin_amdgcn_s_sleep(1);
        if ((++sp & 255u) == 0u) { if (xb_ld(&bar[XB_TMO])) break; if (sp > XB_SPIN_CAP) { atomicAdd(&bar[XB_TMO], 1u); break; } }
    }
    nloc = mine > 0u ? mine : 1u; nx = cnt > 0u ? cnt : 1u;
}

__device__ __forceinline__ void xcd_barrier(const XcdBarrier& b) {
    asm volatile("s_waitcnt vmcnt(0)" ::: "memory");
    __syncthreads();
    if (threadIdx.x == 0) {
        unsigned* bar = b.bar;
        __builtin_amdgcn_s_waitcnt(0);
        unsigned nloc = b.st[0], nx = b.st[1];
        if (nloc == 0u) { xcd_barrier_complete(bar, b.x, nloc, nx); b.st[0] = nloc; b.st[1] = nx; }
        const unsigned old = xb_add(&bar[XB_XSUB(b.x)], 1u);
        const unsigned gen = old / nloc;
        if (old + 1u == (gen + 1u) * nloc) {
            __builtin_amdgcn_fence(__ATOMIC_RELEASE, "agent");
            asm volatile("s_waitcnt vmcnt(0)" ::: "memory");
            const unsigned og = xb_add(&bar[XB_TOP], 1u);
            const unsigned tg = og / nx;
            if (og + 1u == (tg + 1u) * nx) xb_add(&bar[XB_TOPGEN], 1u);
            else XB_SPIN(xb_ld(&bar[XB_TOPGEN]) == tg, bar);
            __builtin_amdgcn_fence(__ATOMIC_ACQUIRE, "agent");
            xb_add(&bar[XB_XGEN(b.x)], 1u);
            asm volatile("s_waitcnt vmcnt(0)" ::: "memory");
        } else {
            XB_SPIN(xb_ld(&bar[XB_XGEN(b.x)]) == gen, bar);
            __builtin_amdgcn_fence(__ATOMIC_ACQUIRE, "agent");
            asm volatile("s_waitcnt vmcnt(0)" ::: "memory");
        }
    }
    __syncthreads();
}

struct Frame {
    LAS unsigned char* lds;
    volatile LAS unsigned* MISC;
    int tid, lane, wave, vcu, G;
};
struct Args { const float* in[39]; float* out; unsigned char* ws; int ph_lo, ph_hi; };
enum { I_X = 0, I_MEM, I_GMIX, I_WIN, I_MU, I_W0, I_W2, I_A0, I_A2, I_G2, I_KK, I_KA, I_RK, I_LNW, I_LNB, I_WRO, I_CONVW, I_CONVB, I_LWR, I_LBR, I_LWI, I_LBI, I_LAM, I_WLO,
       I_GMEM, I_WMK, I_WMV, I_WXO, I_WOUT, I_GFFN, I_WROUTER, I_BROUTER, I_WGATE, I_BGATE, I_WUP, I_BUP, I_WDOWN, I_BDOWN, I_GFINAL };


__device__ __forceinline__ const float* inp(int k) {
    typedef const volatile unsigned long long __attribute__((address_space(4))) ka_t;
    ka_t* ka = (ka_t*)__builtin_amdgcn_kernarg_segment_ptr();
    return (const float*)ka[k];
}
template <int NB> __device__ __forceinline__ void transpose_item(const float* W, int N, int k0, int n0, bf16* WT, int Kd, int drow0, int lane, int kdo = 0) {
    constexpr int LPR = NB / 4, G = 64 / LPR, KR = 64 / G;
    const int g = lane / LPR, c = lane % LPR;
    const GAS float* src = (const GAS float*)W + (size_t)(k0 + KR * g) * N + n0 + 4 * c;
    f32x4 ld[KR];
#pragma unroll
    for (int i = 0; i < KR; ++i) ld[i] = __builtin_nontemporal_load((const GAS f32x4*)(src + (size_t)i * N));
    GAS bf16* dst = (GAS bf16*)WT + (size_t)(drow0 + 4 * c) * Kd + kdo + k0 + KR * g;
#pragma unroll
    for (int j = 0; j < 4; ++j)
#pragma unroll
        for (int q = 0; q < KR / 8; ++q) { v4u o; o.x = pk2(ld[8 * q + 0][j], ld[8 * q + 1][j]); o.y = pk2(ld[8 * q + 2][j], ld[8 * q + 3][j]); o.z = pk2(ld[8 * q + 4][j], ld[8 * q + 5][j]); o.w = pk2(ld[8 * q + 6][j], ld[8 * q + 7][j]);
            *(GAS v4u*)(dst + (size_t)j * Kd + 8 * q) = o; }
}
__device__ __forceinline__ unsigned pk4_fp8(float a, float b, float c, float d) { int w = __builtin_amdgcn_cvt_pk_fp8_f32(a, b, 0, false); w = __builtin_amdgcn_cvt_pk_fp8_f32(c, d, w, true); return (unsigned)w; }
__device__ __forceinline__ void transpose_item_fp8(const float* W, int N, int k0, int n0, unsigned char* WT, int Kd, int drow0, int lane, float scale) {
    const int g = lane >> 4, c = lane & 15;
    const GAS float* src = (const GAS float*)W + (size_t)(k0 + 16 * g) * N + n0 + 4 * c;
    f32x4 ld[16];
#pragma unroll
    for (int i = 0; i < 16; ++i) ld[i] = __builtin_nontemporal_load((const GAS f32x4*)(src + (size_t)i * N)) * scale;
    GAS unsigned char* dst = (GAS unsigned char*)WT + (size_t)(drow0 + 4 * c) * Kd + k0 + 16 * g;
#pragma unroll
    for (int j = 0; j < 4; ++j) { v4u o; o.x = pk4_fp8(ld[0][j], ld[1][j], ld[2][j], ld[3][j]); o.y = pk4_fp8(ld[4][j], ld[5][j], ld[6][j], ld[7][j]); o.z = pk4_fp8(ld[8][j], ld[9][j], ld[10][j], ld[11][j]); o.w = pk4_fp8(ld[12][j], ld[13][j], ld[14][j], ld[15][j]);
        *(GAS v4u*)(dst + (size_t)j * Kd) = o; }
}
__device__ __forceinline__ void rms_row_to_bf16(const float* xrow, const float* gain, bf16* orow, int lane) {
    const GAS f32x4* xr = (const GAS f32x4*)xrow + lane; const GAS f32x4* gr = (const GAS f32x4*)gain + lane;
    f32x4 v[8]; float s = 0.f;
#pragma unroll
    for (int j = 0; j < 8; ++j) { v[j] = xr[64 * j]; s += (v[j].x * v[j].x + v[j].y * v[j].y) + (v[j].z * v[j].z + v[j].w * v[j].w); }
    const float rstd = 1.0f / sqrtf(wave_sum(s) * (1.f / D) + EPS);
    GAS v2u* o8 = (GAS v2u*)orow + lane;
#pragma unroll
    for (int j = 0; j < 8; ++j) { const f32x4 g = gr[64 * j]; v2u w; w.x = pk2(v[j].x * rstd * g.x, v[j].y * rstd * g.y); w.y = pk2(v[j].z * rstd * g.z, v[j].w * rstd * g.w); o8[64 * j] = w; }
}

__device__ __forceinline__ void p0_prologue(const Frame& F, const Args& a) {
    unsigned char* ws = a.ws;
    const int gw = F.vcu * NWAVES + F.wave, NGW = F.G * NWAVES;
    constexpr int I_IN = 32 * (IN_COLS / 32), I_MK = 32 * 32, I_BR = 16 * 64, I_O = 32 * 64;
    constexpr int NITEMS = I_IN + 2 * I_MK + 3 * I_BR + I_O;
    for (int it = gw; it < NITEMS; it += NGW) {
        int r = it;
        if (r < I_IN) { const int nb = IN_COLS / 32, kb = r / nb, n0 = 32 * (r % nb); transpose_item<32>(inp(I_WIN), IN_COLS, 64 * kb, n0, (bf16*)(ws + WS_WIN), D, n0 + (n0 >= RWKV_COLS ? 224 : 0), F.lane); continue; } r -= I_IN;
        if (r < I_MK) { transpose_item<32>(inp(I_WMK), 1024, 64 * (r / 32), 32 * (r % 32), (bf16*)(ws + WS_WMKV), D, 32 * (r % 32), F.lane); continue; } r -= I_MK;
        if (r < I_MK) { transpose_item<32>(inp(I_WMV), 1024, 64 * (r / 32), 32 * (r % 32), (bf16*)(ws + WS_WMKV), D, 1024 + 32 * (r % 32), F.lane); continue; } r -= I_MK;
        if (r < I_BR) { transpose_item<32>(inp(I_WRO), 2048, 64 * (r / 64), 32 * (r % 64), (bf16*)(ws + WS_WBR), 3072, 32 * (r % 64), F.lane, 0); continue; } r -= I_BR;
        if (r < I_BR) { transpose_item<32>(inp(I_WLO), 2048, 64 * (r / 64), 32 * (r % 64), (bf16*)(ws + WS_WBR), 3072, 32 * (r % 64), F.lane, 1024); continue; } r -= I_BR;
        if (r < I_BR) { transpose_item<32>(inp(I_WXO), 2048, 64 * (r / 64), 32 * (r % 64), (bf16*)(ws + WS_WBR), 3072, 32 * (r % 64), F.lane, 2048); continue; } r -= I_BR;
        transpose_item<32>(inp(I_WOUT), 2048, 64 * (r / 64), 32 * (r % 64), (bf16*)(ws + WS_WO), D, 32 * (r % 64), F.lane);
    }
    for (int m = gw; m < T; m += NGW) rms_row_to_bf16(inp(I_X) + (size_t)m * D, inp(I_GMIX), (bf16*)(ws + WS_XN) + (size_t)m * D, F.lane);
    for (int m = gw; m < 512; m += NGW) rms_row_to_bf16(inp(I_MEM) + (size_t)m * D, inp(I_GMEM), (bf16*)(ws + WS_MN) + (size_t)m * D, F.lane);
    const int gt = F.vcu * (NWAVES * 64) + F.tid, NGT = F.G * NWAVES * 64;
    { bf16* wz = (bf16*)(ws + WS_WIN) + (size_t)RWKV_COLS * D; for (int i = gt; i < 224 * D / 2; i += NGT) ((GAS unsigned*)wz)[i] = 0u; }
    { bf16* wl = (bf16*)(ws + WS_WLORA);
      for (int i = gt; i < 3072 * LORA_K; i += NGT) { const int n = i / LORA_K, k = i % LORA_K; float v = 0.f;
          if (n < 1024) { if (k < 64) v = inp(I_W2)[k * 1024 + n]; }
          else if (n < 2048) { if (k >= 64 && k < 128) v = inp(I_A2)[(k - 64) * 1024 + (n - 1024)]; }
          else { if (k >= 128 && k < 288) v = inp(I_G2)[(k - 128) * 1024 + (n - 2048)]; }
          wl[i] = (bf16)f2bf(v); } }
    { const float* lam = inp(I_LAM); float* spl = (float*)(ws + WS_SPL); for (int i = gt; i < 1024; i += NGT) spl[i] = softplusf(-lam[i]); }
    { bf16* wr = (bf16*)(ws + WS_WR);
      for (int i = gt; i < 32 * D; i += NGT) { const int e = i / D, k = i % D; const float w = inp(I_WROUTER)[k * 32 + e]; const unsigned hi = f2bf(w); const float r = w - __builtin_bit_cast(float, hi << 16);
          wr[i] = (bf16)hi; wr[32 * D + i] = (bf16)f2bf(r); } }
    { const float* lwi_p = inp(I_LWI); const float* lwr_p = inp(I_LWR); bf16* lw = (bf16*)(ws + WS_LW);
      for (int i = gt; i < 2 * 16 * 4 * 2 * 64 * 8; i += NGT) { const int j = i & 7, ln = (i >> 3) & 63, ks = (i >> 9) & 1, vbo = (i >> 10) & 3, n = (i >> 12) & 15, mat = i >> 16;
          const int w = 32 * ks + 16 * (j >> 2) + 4 * (ln >> 4) + (j & 3), v = 16 * vbo + (ln & 15);
          lw[i] = (bf16)f2bf((mat ? lwi_p : lwr_p)[(n * 64 + w) * 64 + v]); } }
}

__device__ __forceinline__ void moe_weight_convert(const Frame& F, const Args& a, int gw, int NGW) {
    unsigned char* ws = a.ws;
    const float* wg = inp(I_WGATE); const float* wu = inp(I_WUP); const float* wd = inp(I_WDOWN);
    constexpr int PER = 1024;
    for (int it = gw; it < NE * 3 * PER; it += NGW) {
        const int e = it / (3 * PER), r = it % (3 * PER), which = r / PER, q = r % PER, k0 = 64 * (q / 32), n0 = 64 * (q % 32);
        if (which == 0) transpose_item_fp8(wg + (size_t)e * D * D, D, k0, n0, ws + WS_WGU + (size_t)e * 4096 * D, D, (n0 >> 7) * 256 + (n0 & 127), F.lane, 64.0f);
        else if (which == 1) transpose_item_fp8(wu + (size_t)e * D * D, D, k0, n0, ws + WS_WGU + (size_t)e * 4096 * D, D, (n0 >> 7) * 256 + 128 + (n0 & 127), F.lane, 64.0f);
        else transpose_item_fp8(wd + (size_t)e * D * D, D, k0, n0, ws + WS_WD + (size_t)e * 2048 * D, D, n0, F.lane, 64.0f);
    }
}

__device__ __forceinline__ void r1_lora_in(const Frame& F, const Args& a) {
    const bf16* P = (const bf16*)(a.ws + WS_P); bf16* L = (bf16*)(a.ws + WS_XN);
    const float* mu = inp(I_MU);
    const int gw = F.vcu * NWAVES + F.wave, NGW = F.G * NWAVES;
    for (int m = gw; m < T; m += NGW) {
        const bool first = (m % SEQ) == 0;
#pragma unroll
        for (int j = 0; j < 6; ++j) { const int k = F.lane + 64 * j; float o = 0.f;
            if (k < 288) { const int c = 3072 + k; const float cur = bf1(P[(size_t)m * NP + c]); const float prev = first ? 0.f : bf1(P[(size_t)(m - 1) * NP + c]);
                const float x = cur + (prev - cur) * mu[c]; o = k < 64 ? fast_tanh(x) : (k < 128 ? x : sigm(x)); }
            L[(size_t)m * LORA_K + k] = (bf16)f2bf(o); }
    }
}

constexpr int REC_F = 2816, REC_AT = 0, REC_RT = 512, REC_BKT = 1024, REC_WC = 2048, REC_N = 2112, REC_Q = 2176, REC_V8 = 2240;
__device__ __forceinline__ float wave_sum_fast(float v) { v = row16_sum(v); v += __shfl_xor(v, 16); v += __shfl_xor(v, 32); return v; }
__device__ __forceinline__ void r3_blocks(const Frame& F, const Args& a) {
    const GAS bf16* P = (const GAS bf16*)(a.ws + WS_P); const GAS float* LO = (const GAS float*)(a.ws + WS_LORAOUT);
    GAS float* REC = (GAS float*)(a.ws + WS_SCAN); GAS float* BON = (GAS float*)(a.ws + WS_BONUS);
    const GAS float* mu = (const GAS float*)inp(I_MU); const GAS float* w0 = (const GAS float*)inp(I_W0); const GAS float* a0 = (const GAS float*)inp(I_A0);
    const GAS float* kkp = (const GAS float*)inp(I_KK); const GAS float* kap = (const GAS float*)inp(I_KA); const GAS float* rkp = (const GAS float*)inp(I_RK);
    LAS float* G1 = (LAS float*)(F.lds + F.wave * 16384);
    LAS float* G2 = G1 + 2048;
    const int gw = F.vcu * NWAVES + F.wave, NGW = F.G * NWAVES, lane = F.lane;
#pragma unroll 1
    for (int it = gw; it < 32 * 1024; it += NGW) {
        const int bh = it >> 10, blk = it & 1023, b = bh >> 4, h = bh & 15, c = h * 64 + lane, m0 = b * SEQ + blk * 8;
        const float mur = mu[c], muk = mu[1024 + c], muv = mu[2048 + c], w0c = w0[c], a0c = a0[c], kkw = kkp[c], kaw = kap[c], rkw = rkp[c];
        float w[8], av[8], bv[8], kv[8], rv[8], vv[8], ag[8], kk[8], n2[8], bo[8];
        float pr = 0.f, pk = 0.f, pv = 0.f;
        if (blk > 0) { const GAS bf16* pp = P + (size_t)(m0 - 1) * NP; pr = bf1(pp[c]); pk = bf1(pp[1024 + c]); pv = bf1(pp[2048 + c]); }
#pragma unroll
        for (int t = 0; t < 8; ++t) { const GAS bf16* pc = P + (size_t)(m0 + t) * NP; const float cr = bf1(pc[c]), ck = bf1(pc[1024 + c]), cv = bf1(pc[2048 + c]);
            const float r = cr + (pr - cr) * mur, k = ck + (pk - ck) * muk, v = cv + (pv - cv) * muv; pr = cr; pk = ck; pv = cv;
            const float wpre = w0c + LO[(size_t)(m0 + t) * 3072 + c], apre = a0c + LO[(size_t)(m0 + t) * 3072 + 1024 + c];
            w[t] = __expf(-0.6065306597126334f * __builtin_amdgcn_rcpf(1.0f + __expf(-wpre)));
            ag[t] = __builtin_amdgcn_rcpf(1.0f + __expf(-apre));
            kk[t] = k * kkw; n2[t] = kk[t] * kk[t];
            kv[t] = k * (1.0f + (ag[t] - 1.0f) * kaw); rv[t] = r; vv[t] = v; bo[t] = r * kv[t] * rkw; }
#pragma unroll
        for (int t = 0; t < 8; ++t) { n2[t] = wave_sum_fast(n2[t]); bo[t] = wave_sum_fast(bo[t]); }
#pragma unroll
        for (int t = 0; t < 8; ++t) { const float kkn = kk[t] * (1.0f / sqrtf(fmaxf(n2[t], 1e-24f))); av[t] = -kkn; bv[t] = kkn * ag[t]; if (lane == 0) BON[(m0 + t) * 16 + h] = bo[t]; }
        float Pp[8]; Pp[0] = w[0];
#pragma unroll
        for (int t = 1; t < 8; ++t) Pp[t] = Pp[t - 1] * w[t];
        float bch[8], kch[8], ah[8], rh[8];
#pragma unroll
        for (int t = 0; t < 8; ++t) { const float pin = __builtin_amdgcn_rcpf(Pp[t]); bch[t] = bv[t] * pin; kch[t] = kv[t] * pin; ah[t] = av[t] * (t > 0 ? Pp[t - 1] : 1.0f); rh[t] = rv[t] * Pp[t]; }
        const int pos = (lane & 3) * 16 + (lane >> 2);
#pragma unroll
        for (int t = 0; t < 8; ++t) { G1[t * 64 + pos] = bch[t]; G1[(8 + t) * 64 + pos] = kch[t]; G1[(16 + t) * 64 + pos] = ah[t]; G1[(24 + t) * 64 + pos] = rh[t]; }
        LDS_WAIT(); asm volatile("" ::: "memory");
        f32x4 fa[4], fb[4];
#pragma unroll
        for (int q = 0; q < 4; ++q) { fa[q] = *(const LAS f32x4*)(G1 + (lane & 15) * 64 + (lane >> 4) * 16 + 4 * q); fb[q] = *(const LAS f32x4*)(G1 + (16 + (lane & 15)) * 64 + (lane >> 4) * 16 + 4 * q); }
        f32x4 dacc = {0.f, 0.f, 0.f, 0.f};
#pragma unroll
        for (int s2 = 0; s2 < 16; ++s2) dacc = __builtin_amdgcn_mfma_f32_16x16x4f32(fa[s2 >> 2][s2 & 3], fb[s2 >> 2][s2 & 3], dacc, 0, 0, 0);
        *(LAS f32x4*)(G2 + (lane & 15) * 16 + 4 * (lane >> 4)) = dacc;
        LDS_WAIT(); asm volatile("" ::: "memory");
        float M[8][8];
        { float Lm[8][8];
#pragma unroll
          for (int t = 1; t < 8; ++t) { const f32x4 l0 = *(const LAS f32x4*)(G2 + t * 16), l1 = *(const LAS f32x4*)(G2 + t * 16 + 4);
#pragma unroll
              for (int i = 0; i < 4; ++i) { Lm[t][i] = l0[i]; Lm[t][4 + i] = l1[i]; } }
#pragma unroll
          for (int t = 0; t < 8; ++t) { M[t][t] = 1.0f;
#pragma unroll
              for (int i = t - 1; i >= 0; --i) { float acc = 0.f;
#pragma unroll
                  for (int j = i; j < t; ++j) acc += Lm[t][j] * M[j][i];
                  M[t][i] = acc; } } }
        GAS float* rec = REC + ((size_t)bh * 1024 + blk) * REC_F;
#pragma unroll
        for (int t = 0; t < 8; ++t) { float acc = 0.f;
#pragma unroll
            for (int i = 0; i <= t; ++i) acc += M[t][i] * ah[i];
            rec[REC_AT + t * 64 + lane] = acc; }
        float Nm[8][8];
        { float Km[8][8];
#pragma unroll
          for (int t = 1; t < 8; ++t) { const f32x4 l0 = *(const LAS f32x4*)(G2 + t * 16 + 8), l1 = *(const LAS f32x4*)(G2 + t * 16 + 12);
#pragma unroll
              for (int i = 0; i < 4; ++i) { Km[t][i] = l0[i]; Km[t][4 + i] = l1[i]; } }
#pragma unroll
          for (int t = 0; t < 8; ++t)
#pragma unroll
              for (int i = 0; i < 8; ++i) { float acc = 0.f;
                  if (i < t) {
#pragma unroll
                      for (int j = i + 1; j <= t; ++j) acc += M[t][j] * Km[j][i]; }
                  Nm[t][i] = acc; } }
        float rb[8][8];
#pragma unroll
        for (int t = 0; t < 8; ++t) { const f32x4 l0 = *(const LAS f32x4*)(G2 + (8 + t) * 16), l1 = *(const LAS f32x4*)(G2 + (8 + t) * 16 + 4);
#pragma unroll
            for (int i = 0; i < 4; ++i) { rb[t][i] = l0[i]; rb[t][4 + i] = l1[i]; } }
#pragma unroll
        for (int t = 0; t < 8; ++t) { float acc = rh[t];
#pragma unroll
            for (int i = 0; i <= t; ++i) { float rm = 0.f;
#pragma unroll
                for (int j = i; j <= t; ++j) rm += rb[t][j] * M[j][i];
                acc += rm * ah[i]; }
            rec[REC_RT + t * 64 + lane] = acc; }
        float Qm[8][8];
#pragma unroll
        for (int t = 0; t < 8; ++t) { const f32x4 l0 = *(const LAS f32x4*)(G2 + (8 + t) * 16 + 8), l1 = *(const LAS f32x4*)(G2 + (8 + t) * 16 + 12);
#pragma unroll
            for (int i = 0; i < 8; ++i) { float acc = 0.f;
                if (i <= t) { acc = i < 4 ? l0[i & 3] : l1[i & 3];
#pragma unroll
                    for (int j = i + 1; j <= t; ++j) acc += rb[t][j] * Nm[j][i]; }
                Qm[t][i] = acc; } }
#pragma unroll
        for (int q4 = 0; q4 < 2; ++q4) { *(GAS f32x4*)(rec + REC_BKT + lane * 16 + 4 * q4) = (f32x4){bch[4 * q4] * Pp[7], bch[4 * q4 + 1] * Pp[7], bch[4 * q4 + 2] * Pp[7], bch[4 * q4 + 3] * Pp[7]};
            *(GAS f32x4*)(rec + REC_BKT + lane * 16 + 8 + 4 * q4) = (f32x4){kch[4 * q4] * Pp[7], kch[4 * q4 + 1] * Pp[7], kch[4 * q4 + 2] * Pp[7], kch[4 * q4 + 3] * Pp[7]}; }
        rec[REC_WC + lane] = Pp[7];
        if (lane == 0) {
#pragma unroll
            for (int t = 0; t < 8; ++t) { *(GAS f32x4*)(rec + REC_N + t * 8) = (f32x4){Nm[t][0], Nm[t][1], Nm[t][2], Nm[t][3]}; *(GAS f32x4*)(rec + REC_N + t * 8 + 4) = (f32x4){Nm[t][4], Nm[t][5], Nm[t][6], Nm[t][7]};
                *(GAS f32x4*)(rec + REC_Q + t * 8) = (f32x4){Qm[t][0], Qm[t][1], Qm[t][2], Qm[t][3]}; *(GAS f32x4*)(rec + REC_Q + t * 8 + 4) = (f32x4){Qm[t][4], Qm[t][5], Qm[t][6], Qm[t][7]}; } }
        *(GAS f32x4*)(rec + REC_V8 + lane * 8) = (f32x4){vv[0], vv[1], vv[2], vv[3]}; *(GAS f32x4*)(rec + REC_V8 + lane * 8 + 4) = (f32x4){vv[4], vv[5], vv[6], vv[7]};
        LDS_WAIT(); asm volatile("" ::: "memory");
    }
}

constexpr int SC_NS = 12, SC_RB = REC_F * 4, SC_SYNC = SC_NS * SC_RB;
__device__ __forceinline__ unsigned lds_word(const volatile LAS unsigned* p) { return (unsigned)__builtin_amdgcn_readfirstlane((int)*p); }
__device__ __forceinline__ bool scan_wg(int& bh, int& quarter) { const int bx = blockIdx.x; if (gridDim.x != 256 || ((bx >> 3) & 1)) return false; const int slot = bx >> 4; bh = (bx & 7) * 4 + (slot >> 2); quarter = slot & 3; return true; }
__device__ __forceinline__ void r4_feeder(const Frame& F, const Args& a, int bh) {
    const GAS char* gsrc = (const GAS char*)(a.ws + WS_SCAN) + (size_t)bh * 1024 * SC_RB + F.lane * 16;
    LAS unsigned char* ring = F.lds;
    volatile LAS unsigned* sync = (volatile LAS unsigned*)(F.lds + SC_SYNC);
    bool dead = false;
#pragma unroll 1
    for (int B = 0; B < 1024; ++B) {
        if (B >= SC_NS && !dead) { unsigned spins = 0; for (;;) { const unsigned d0 = lds_word(sync + 16); if ((int)d0 > B - SC_NS) break; if (++spins > (1u << 20)) { dead = true; break; } __builtin_amdgcn_s_sleep(2); } }
        LAS unsigned char* slot = ring + (B % SC_NS) * SC_RB;
#pragma unroll
        for (int q = 0; q < 11; ++q) __builtin_amdgcn_global_load_lds((const GAS unsigned*)(gsrc + (size_t)B * SC_RB + q * 1024), (LAS unsigned*)(slot + q * 1024), 16, 0, 0);
        asm volatile("s_waitcnt vmcnt(55)" ::: "memory");
        if (B >= 5 && F.lane == 0) sync[0] = (unsigned)(B - 4);
    }
    asm volatile("s_waitcnt vmcnt(0)" ::: "memory");
    if (F.lane == 0) sync[0] = 1024u;
}
template <int VAR> __device__ __forceinline__ void r4_scan(const Frame& F, const Args& a, int bh, int quarter) {
    float* YT = (float*)(a.ws + WS_XN);
    constexpr int RB = SC_RB;
    __builtin_amdgcn_s_setprio(3);
    const int r = F.lane & 15, q = F.lane >> 4, rowg = quarter * 16 + r;
    LAS unsigned char* ring = F.lds;
    volatile LAS unsigned* sync = (volatile LAS unsigned*)(F.lds + SC_SYNC);
    const LAS unsigned char* pA1 = ring + (REC_AT + r * 64 + 4 * q) * 4;
    const LAS unsigned char* pNQ = ring + (REC_N + r * 8 + 2 * q) * 4;
    const LAS unsigned char* pVb = ring + (REC_V8 + rowg * 8 + 2 * q) * 4;
    const LAS unsigned char* pV4 = ring + (REC_V8 + rowg * 8 + 4 * (q & 1)) * 4;
    const LAS unsigned char* pA2 = ring + (REC_BKT + r * 16 + 4 * q) * 4;
    const LAS unsigned char* pWC = ring + (REC_WC + 4 * q) * 4;
    unsigned have = 0; bool dead = (VAR == 1);
#define SC_NEED(n) do { unsigned spins_ = 0; while (have < (unsigned)(n) && !dead) { have = lds_word(sync); if (have >= (unsigned)(n)) break; if (++spins_ > (1u << 20)) { dead = true; break; } __builtin_amdgcn_s_sleep(1); } } while (0)
    f32x4 S[4];
#pragma unroll
    for (int kb = 0; kb < 4; ++kb) S[kb] = (f32x4){0.f, 0.f, 0.f, 0.f};
    GAS float* yrow = (GAS float*)YT + (size_t)(bh * 64 + rowg) * SEQ + 4 * (q & 1);
#define SC_LD(a1_, nq_, vb_, v4_, a2_, wc_, so_) do { _Pragma("unroll") for (int kb_ = 0; kb_ < 4; ++kb_) a1_[kb_] = *(const LAS f32x4*)(pA1 + (so_) + kb_ * 64); \
        nq_ = *(const LAS f32x2*)(pNQ + (so_)); vb_ = *(const LAS f32x2*)(pVb + (so_)); v4_ = *(const LAS f32x4*)(pV4 + (so_)); \
        _Pragma("unroll") for (int kb_ = 0; kb_ < 4; ++kb_) { a2_[kb_] = *(const LAS f32x4*)(pA2 + (so_) + kb_ * 1024); wc_[kb_] = *(const LAS f32x4*)(pWC + (so_) + kb_ * 64); } } while (0)
    f32x4 a1[4], a2[4], wc[4], v4; f32x2 nq, vb;
    SC_NEED(1); asm volatile("" ::: "memory");
    SC_LD(a1, nq, vb, v4, a2, wc, 0);
#pragma unroll 1
    for (int k0 = 0; k0 < 1024; k0 += SC_NS) {
#pragma unroll
        for (int u = 0; u < SC_NS; ++u) { if (k0 + u >= 1024) break; const int sn = ((u + 1) % SC_NS) * RB;
            f32x4 d0 = {0.f, 0.f, 0.f, 0.f}, d1 = {0.f, 0.f, 0.f, 0.f};
#pragma unroll
            for (int kb = 0; kb < 4; ++kb) { d0 = __builtin_amdgcn_mfma_f32_16x16x4f32(a1[kb][0], S[kb][0], d0, 0, 0, 0); d1 = __builtin_amdgcn_mfma_f32_16x16x4f32(a1[kb][1], S[kb][1], d1, 0, 0, 0);
                d0 = __builtin_amdgcn_mfma_f32_16x16x4f32(a1[kb][2], S[kb][2], d0, 0, 0, 0); d1 = __builtin_amdgcn_mfma_f32_16x16x4f32(a1[kb][3], S[kb][3], d1, 0, 0, 0); }
            d0 = __builtin_amdgcn_mfma_f32_16x16x4f32(nq[0], vb[0], d0, 0, 0, 0); d1 = __builtin_amdgcn_mfma_f32_16x16x4f32(nq[1], vb[1], d1, 0, 0, 0);
            f32x4 na1[4], na2[4], nwc[4], nv4; f32x2 nnq, nvb;
            SC_NEED(k0 + u + 2 <= 1024 ? k0 + u + 2 : 1024); asm volatile("" ::: "memory");
            SC_LD(na1, nnq, nvb, nv4, na2, nwc, sn);
            asm volatile("" ::: "memory");
            const f32x4 dd = d0 + d1;
            if (q >= 2) *(GAS f32x4*)(yrow + (k0 + u) * 8) = dd;
            const f32x4 b2 = q >= 2 ? v4 : dd;
            f32x4 n[4];
#pragma unroll
            for (int kb = 0; kb < 4; ++kb) n[kb] = S[kb] * wc[kb];
#pragma unroll
            for (int sp = 0; sp < 4; ++sp)
#pragma unroll
                for (int kb = 0; kb < 4; ++kb) n[kb] = __builtin_amdgcn_mfma_f32_16x16x4f32(a2[kb][sp], b2[sp], n[kb], 0, 0, 0);
#pragma unroll
            for (int kb = 0; kb < 4; ++kb) S[kb] = n[kb];
            asm volatile("" : "+v"(S[0]), "+v"(S[1]), "+v"(S[2]), "+v"(S[3]) :: "memory");
            if (F.lane == 0) sync[16] = (unsigned)(k0 + u + 1);
#pragma unroll
            for (int kb = 0; kb < 4; ++kb) { a1[kb] = na1[kb]; a2[kb] = na2[kb]; wc[kb] = nwc[kb]; }
            nq = nnq; vb = nvb; v4 = nv4;
        }
    }
#undef SC_LD
#undef SC_NEED
    __builtin_amdgcn_s_setprio(0);
}

__device__ __forceinline__ void r5_finish(const Frame& F, const Args& a) {
    const float* YT = (const float*)(a.ws + WS_XN); const float* LO = (const float*)(a.ws + WS_LORAOUT); const bf16* P = (const bf16*)(a.ws + WS_P); const float* BON = (const float*)(a.ws + WS_BONUS);
    bf16* YA = (bf16*)(a.ws + WS_YABC);
    LAS float* scr = (LAS float*)(F.lds + F.wave * 16640);
    const int gw = F.vcu * NWAVES + F.wave, NGW = F.G * NWAVES;
    for (int it = gw; it < 32 * 128; it += NGW) {
        const int bh = it >> 7, tt = it & 127, t0 = tt * 64, b = bh >> 4, h = bh & 15;
        float y[64]; float s = 0.f;
#pragma unroll
        for (int v = 0; v < 64; ++v) { y[v] = YT[(size_t)(bh * 64 + v) * SEQ + t0 + F.lane]; s += y[v]; }
        const float mean = s * (1.f / 64.f); float q = 0.f;
#pragma unroll
        for (int v = 0; v < 64; ++v) { const float d = y[v] - mean; q += d * d; }
        const float rstd = 1.0f / sqrtf(q * (1.f / 64.f) + GN_EPS);
#pragma unroll
        for (int v = 0; v < 64; ++v) scr[F.lane * 65 + v] = (y[v] - mean) * rstd;
        LDS_WAIT(); asm volatile("" ::: "memory");
        { const int ts = F.lane >> 4, cq = F.lane & 15, c = h * 64 + 4 * cq;
          const f32x4 lw = *(const GAS f32x4*)((const GAS float*)inp(I_LNW) + c), lb = *(const GAS f32x4*)((const GAS float*)inp(I_LNB) + c), muv = *(const GAS f32x4*)((const GAS float*)inp(I_MU) + 2048 + c);
#pragma unroll 4
          for (int tg = 0; tg < 16; ++tg) { const int ti = 4 * tg + ts, m = b * SEQ + t0 + ti;
              f32x4 yn; yn[0] = scr[ti * 65 + 4 * cq]; yn[1] = scr[ti * 65 + 4 * cq + 1]; yn[2] = scr[ti * 65 + 4 * cq + 2]; yn[3] = scr[ti * 65 + 4 * cq + 3];
              const v2u cw = *(const GAS v2u*)((const GAS bf16*)P + (size_t)m * NP + 2048 + c); v2u pw = cw; if (m % SEQ != 0) pw = *(const GAS v2u*)((const GAS bf16*)P + (size_t)(m - 1) * NP + 2048 + c);
              const f32x4 cv = {bflo(cw.x), bfhi(cw.x), bflo(cw.y), bfhi(cw.y)}; f32x4 pv = {bflo(pw.x), bfhi(pw.x), bflo(pw.y), bfhi(pw.y)}; if (m % SEQ == 0) pv = (f32x4){0.f, 0.f, 0.f, 0.f};
              const f32x4 vsh = cv + (pv - cv) * muv;
              const f32x4 g = *(const GAS f32x4*)((const GAS float*)LO + (size_t)m * 3072 + 2048 + c); const float bon = BON[m * 16 + h];
              const f32x4 o = (yn * lw + lb + vsh * bon) * g;
              v2u w; w.x = pk2(o[0], o[1]); w.y = pk2(o[2], o[3]); *(GAS v2u*)((GAS bf16*)YA + (size_t)m * 3072 + c) = w; } }
        LDS_WAIT(); asm volatile("" ::: "memory");
    }
}

__device__ __forceinline__ float gelu_tanh(float x) { const float u = 0.7978845608028654f * (x + 0.044715f * x * x * x); return 0.5f * x * (1.0f + fast_tanh(u)); }
template <int CTRL> __device__ __forceinline__ float dpp_keep(float old, float x) { return __builtin_bit_cast(float, __builtin_amdgcn_update_dpp(__builtin_bit_cast(int, old), __builtin_bit_cast(int, x), CTRL, 0xf, 0xf, false)); }
template <bool FINAL> __device__ __forceinline__ void lru_pass(const Frame& F, const Args& a, int gw, int NGW) {
    const bf16* P = (const bf16*)(a.ws + WS_P); const bf16* LW = (const bf16*)(a.ws + WS_LW);
    float* CA = (float*)(a.ws + WS_LRUC); float* CB = CA + 256 * 1024; const float* HIN = CB + 256 * 1024;
    bf16* YB = (bf16*)(a.ws + WS_YABC) + 1024;
    const GAS float* lbr_p = (const GAS float*)inp(I_LBR); const GAS float* lbi_p = (const GAS float*)inp(I_LBI); const GAS float* spl_p = (const GAS float*)(a.ws + WS_SPL);
    const GAS float* cvb_p = (const GAS float*)inp(I_CONVB); const GAS float* cvw_p = (const GAS float*)inp(I_CONVW);
    const int tq = F.lane & 15, kq = F.lane >> 4;
    for (int it = gw; it < 256 * 16; it += NGW) {
        const int tt = it >> 4, n = it & 15, m0 = tt * 64, cb = n * 64 + 4 * kq;
        const bool seq0 = (m0 % SEQ) == 0;
        float hcar[4][4];
        float aprod[4][4];
#pragma unroll
        for (int vb = 0; vb < 4; ++vb)
#pragma unroll
            for (int i = 0; i < 4; ++i) { hcar[vb][i] = FINAL ? HIN[tt * 1024 + cb + 16 * vb + i] : 0.f; aprod[vb][i] = 1.f; }
#pragma unroll 1
        for (int tb = 0; tb < 4; ++tb) {
            asm volatile("" ::: "memory");
            const int m = m0 + 16 * tb + tq, tseq = m % SEQ;
            f32x4 xc[4];
#pragma unroll
            for (int vb = 0; vb < 4; ++vb) { const int c = cb + 16 * vb; f32x4 acc = *(const GAS f32x4*)(cvb_p + c);
#pragma unroll
                for (int j = 0; j < 4; ++j) { if (tseq - j >= 0) { const v2u pw = *(const GAS v2u*)((const GAS bf16*)P + (size_t)(m - j) * NP + PC_LX + c); const f32x4 cw = *(const GAS f32x4*)(cvw_p + j * 1024 + c);
                        acc[0] += cw[0] * bflo(pw.x); acc[1] += cw[1] * bfhi(pw.x); acc[2] += cw[2] * bflo(pw.y); acc[3] += cw[3] * bfhi(pw.y); } }
                xc[vb] = acc; }
            bf16x8 bfrag[2];
#pragma unroll
            for (int ks = 0; ks < 2; ++ks) { v4u w; w.x = pk2(xc[2 * ks][0], xc[2 * ks][1]); w.y = pk2(xc[2 * ks][2], xc[2 * ks][3]); w.z = pk2(xc[2 * ks + 1][0], xc[2 * ks + 1][1]); w.w = pk2(xc[2 * ks + 1][2], xc[2 * ks + 1][3]); bfrag[ks] = __builtin_bit_cast(bf16x8, w); }
#pragma unroll
            for (int vb = 0; vb < 4; ++vb) {
                f32x4 gr = {0.f, 0.f, 0.f, 0.f}, gi = {0.f, 0.f, 0.f, 0.f};
#pragma unroll
                for (int ks = 0; ks < 2; ++ks) { const bf16x8 wr_ = *(const bf16x8*)(LW + ((((size_t)(0 * 16 + n) * 4 + vb) * 2 + ks) * 64 + F.lane) * 8); const bf16x8 wi_ = *(const bf16x8*)(LW + ((((size_t)(1 * 16 + n) * 4 + vb) * 2 + ks) * 64 + F.lane) * 8);
                    gr = __builtin_amdgcn_mfma_f32_16x16x32_bf16(wr_, bfrag[ks], gr, 0, 0, 0); gi = __builtin_amdgcn_mfma_f32_16x16x32_bf16(wi_, bfrag[ks], gi, 0, 0, 0); }
                const int c = cb + 16 * vb;
                const f32x4 brv = *(const GAS f32x4*)(lbr_p + c), biv = *(const GAS f32x4*)(lbi_p + c); const f32x4 spl = *(const GAS f32x4*)(spl_p + c);
                v2u pyw; if (FINAL) pyw = *(const v2u*)(P + (size_t)m * NP + PC_LY + c);
                float hout[4];
#pragma unroll
                for (int i = 0; i < 4; ++i) {
                    const float g_r = sigm(gr[i] + brv[i]), g_i = sigm(gi[i] + biv[i]);
                    const float log_a = -8.0f * g_r * spl[i];
                    float av = __expf(log_a); float mult = __builtin_amdgcn_sqrtf(fmaxf(1.0f - av * av, 0.f)); if (tseq == 0) mult = 1.0f;
                    float bv = mult * g_i * xc[vb][i];
                    { float pa = dpp_keep<0x111>(1.0f, av), pb = dpp_keep<0x111>(0.0f, bv); bv = av * pb + bv; av = av * pa; }
                    { float pa = dpp_keep<0x112>(1.0f, av), pb = dpp_keep<0x112>(0.0f, bv); bv = av * pb + bv; av = av * pa; }
                    { float pa = dpp_keep<0x114>(1.0f, av), pb = dpp_keep<0x114>(0.0f, bv); bv = av * pb + bv; av = av * pa; }
                    { float pa = dpp_keep<0x118>(1.0f, av), pb = dpp_keep<0x118>(0.0f, bv); bv = av * pb + bv; av = av * pa; }
                    const float hv = bv + av * hcar[vb][i];
                    const int l15 = (F.lane & 48) | 15;
                    const float hend = __shfl(hv, l15), aend = __shfl(av, l15);
                    hcar[vb][i] = hend; if (!FINAL) aprod[vb][i] *= aend; hout[i] = hv; }
                if (FINAL) { const float y0 = hout[0] * gelu_tanh(bflo(pyw.x)), y1 = hout[1] * gelu_tanh(bfhi(pyw.x)), y2 = hout[2] * gelu_tanh(bflo(pyw.y)), y3 = hout[3] * gelu_tanh(bfhi(pyw.y));
                    v2u w; w.x = pk2(y0, y1); w.y = pk2(y2, y3); *(v2u*)(YB + (size_t)m * 3072 + c) = w; }
            }
        }
        if (!FINAL && tq == 0) {
#pragma unroll
            for (int vb = 0; vb < 4; ++vb) { f32x4 pa, pb;
#pragma unroll
                for (int i = 0; i < 4; ++i) { pa[i] = aprod[vb][i]; pb[i] = hcar[vb][i]; }
                *(f32x4*)(CA + tt * 1024 + cb + 16 * vb) = pa; *(f32x4*)(CB + tt * 1024 + cb + 16 * vb) = pb; }
        }
        (void)seq0;
    }
}
__device__ __forceinline__ void lru_carry(const Frame& F, const Args& a) {
    const float* CA = (const float*)(a.ws + WS_LRUC); const float* CB = CA + 256 * 1024; float* HIN = (float*)CB + 256 * 1024;
    const int gt = F.vcu * (NWAVES * 64) + F.tid;
    if (gt < 2048) { const int b = gt >> 10, c = gt & 1023; float h = 0.f;
#pragma unroll 1
        for (int k0 = 0; k0 < 128; k0 += 32) { float ca[32], cb[32];
#pragma unroll
            for (int j = 0; j < 32; ++j) { const int tt = b * 128 + k0 + j; ca[j] = CA[tt * 1024 + c]; cb[j] = CB[tt * 1024 + c]; }
#pragma unroll
            for (int j = 0; j < 32; ++j) { const int tt = b * 128 + k0 + j; HIN[tt * 1024 + c] = h; h = ca[j] * h + cb[j]; } } }
}

__device__ __forceinline__ void xattn_phase(const Frame& F, const Args& a, int gw, int NGW) {
    const bf16* P = (const bf16*)(a.ws + WS_P); const bf16* KM = (const bf16*)(a.ws + WS_KMEM); const bf16* VT = (const bf16*)(a.ws + WS_VT);
    bf16* YC = (bf16*)(a.ws + WS_YABC) + 2048;
    const int tq = F.lane & 15, kq = F.lane >> 4;
    for (int it = gw; it < 4 * 512; it += NGW) {
        const int h = it >> 9, tg = it & 511, m0 = tg * 32, b = m0 / SEQ;
        bf16x8 qf[2][8];
#pragma unroll
        for (int g = 0; g < 2; ++g)
#pragma unroll
            for (int ks = 0; ks < 8; ++ks) qf[g][ks] = *(const bf16x8*)(P + (size_t)(m0 + 16 * g + tq) * NP + PC_Q + h * 256 + 32 * ks + 8 * kq);
        f32x4 s[2][16];
#pragma unroll
        for (int mb = 0; mb < 16; ++mb) { f32x4 acc0 = {0.f, 0.f, 0.f, 0.f}, acc1 = {0.f, 0.f, 0.f, 0.f}; const bf16* kp = KM + (size_t)(b * 256 + 16 * mb + tq) * 1024 + h * 256 + 8 * kq;
#pragma unroll
            for (int ks = 0; ks < 8; ++ks) { const bf16x8 kf = *(const bf16x8*)(kp + 32 * ks);
                acc0 = __builtin_amdgcn_mfma_f32_16x16x32_bf16(kf, qf[0][ks], acc0, 0, 0, 0); acc1 = __builtin_amdgcn_mfma_f32_16x16x32_bf16(kf, qf[1][ks], acc1, 0, 0, 0); }
            s[0][mb] = acc0; s[1][mb] = acc1; asm volatile("" ::: "memory"); }
        bf16x8 pf[2][8];
#pragma unroll
        for (int g = 0; g < 2; ++g) {
            float mx = -3.0e38f;
#pragma unroll
            for (int mb = 0; mb < 16; ++mb) { s[g][mb] = s[g][mb] * 0.0625f; mx = fmaxf(mx, fmaxf(fmaxf(s[g][mb][0], s[g][mb][1]), fmaxf(s[g][mb][2], s[g][mb][3]))); }
            mx = fmaxf(mx, __shfl_xor(mx, 16)); mx = fmaxf(mx, __shfl_xor(mx, 32));
            float sum = 0.f;
#pragma unroll
            for (int mb = 0; mb < 16; ++mb) {
#pragma unroll
                for (int i = 0; i < 4; ++i) { s[g][mb][i] = __expf(s[g][mb][i] - mx); sum += s[g][mb][i]; } }
            sum += __shfl_xor(sum, 16); sum += __shfl_xor(sum, 32);
            const float inv = 1.0f / sum;
#pragma unroll
            for (int ks = 0; ks < 8; ++ks) { v4u w; w.x = pk2(s[g][2 * ks][0] * inv, s[g][2 * ks][1] * inv); w.y = pk2(s[g][2 * ks][2] * inv, s[g][2 * ks][3] * inv); w.z = pk2(s[g][2 * ks + 1][0] * inv, s[g][2 * ks + 1][1] * inv); w.w = pk2(s[g][2 * ks + 1][2] * inv, s[g][2 * ks + 1][3] * inv); pf[g][ks] = __builtin_bit_cast(bf16x8, w); } }
#pragma unroll
        for (int db = 0; db < 16; ++db) { f32x4 acc0 = {0.f, 0.f, 0.f, 0.f}, acc1 = {0.f, 0.f, 0.f, 0.f}; const bf16* vp = VT + ((size_t)((b * 4 + h) * 256 + 16 * db + tq)) * 256 + 8 * kq;
#pragma unroll
            for (int ks = 0; ks < 8; ++ks) { const bf16x8 vf = *(const bf16x8*)(vp + 32 * ks);
                acc0 = __builtin_amdgcn_mfma_f32_16x16x32_bf16(vf, pf[0][ks], acc0, 0, 0, 0); acc1 = __builtin_amdgcn_mfma_f32_16x16x32_bf16(vf, pf[1][ks], acc1, 0, 0, 0); }
            v2u w0_, w1_; w0_.x = pk2(acc0[0], acc0[1]); w0_.y = pk2(acc0[2], acc0[3]); w1_.x = pk2(acc1[0], acc1[1]); w1_.y = pk2(acc1[2], acc1[3]);
            *(v2u*)(YC + (size_t)(m0 + tq) * 3072 + h * 256 + 16 * db + 4 * kq) = w0_; *(v2u*)(YC + (size_t)(m0 + 16 + tq) * 3072 + h * 256 + 16 * db + 4 * kq) = w1_; asm volatile("" ::: "memory"); }
    }
}

__device__ __forceinline__ void router_phase(const Frame& F, const Args& a) {
    const float* H1 = (const float*)(a.ws + WS_H1); bf16* XN2 = (bf16*)(a.ws + WS_XN); const bf16* WR = (const bf16*)(a.ws + WS_WR);
    int* pick_e = (int*)(a.ws + WS_PICK); int* pick_rank = pick_e + 65536; float* pick_gate = (float*)(pick_rank + 65536);
    unsigned* gcnt = (unsigned*)(a.ws + WS_CTL) + CW_CNT;
    LAS float* lg = (LAS float*)(F.lds + F.wave * 4096);
    LAS unsigned* lcnt = (LAS unsigned*)(F.lds + 65536);
    const int tq = F.lane & 15, kq = F.lane >> 4;
    for (int g0 = F.vcu * 4; g0 < 1024; g0 += F.G * 4) {
        if (F.tid < 64) lcnt[F.tid] = 0u;
        __syncthreads();
        int me = 0, mrank = 0; float mgate = 0.f; int e4[4]; float g4[4]; int r4[4];
        const int m0 = (g0 + F.wave) * 16;
        if (F.wave < 4) {
            float myr = 0.f;
            for (int j = 0; j < 16; ++j) { const GAS f32x4* xr = (const GAS f32x4*)(H1 + (size_t)(m0 + j) * D) + F.lane; float s = 0.f;
#pragma unroll
                for (int q = 0; q < 8; ++q) { const f32x4 v = xr[64 * q]; s += (v.x * v.x + v.y * v.y) + (v.z * v.z + v.w * v.w); }
                const float rs = 1.0f / sqrtf(wave_sum(s) * (1.f / D) + EPS); if (tq == j) myr = rs; }
            f32x4 acc[2] = {{0.f, 0.f, 0.f, 0.f}, {0.f, 0.f, 0.f, 0.f}};
            const float* hrow = H1 + (size_t)(m0 + tq) * D + 8 * kq; const float* grow = inp(I_GFFN) + 8 * kq; unsigned char* xrow = (unsigned char*)XN2 + (size_t)(m0 + tq) * D + 8 * kq;
            for (int ks = 0; ks < 64; ++ks) {
                const f32x4 x0 = *(const f32x4*)(hrow + 32 * ks), x1 = *(const f32x4*)(hrow + 32 * ks + 4), g0v = *(const f32x4*)(grow + 32 * ks), g1v = *(const f32x4*)(grow + 32 * ks + 4);
                v4u w; w.x = pk2(x0[0] * myr * g0v[0], x0[1] * myr * g0v[1]); w.y = pk2(x0[2] * myr * g0v[2], x0[3] * myr * g0v[3]); w.z = pk2(x1[0] * myr * g1v[0], x1[1] * myr * g1v[1]); w.w = pk2(x1[2] * myr * g1v[2], x1[3] * myr * g1v[3]);
                { v2u q8; q8.x = pk4_fp8(x0[0] * myr * g0v[0], x0[1] * myr * g0v[1], x0[2] * myr * g0v[2], x0[3] * myr * g0v[3]); q8.y = pk4_fp8(x1[0] * myr * g1v[0], x1[1] * myr * g1v[1], x1[2] * myr * g1v[2], x1[3] * myr * g1v[3]); *(v2u*)(xrow + 32 * ks) = q8; }
                const bf16x8 af = __builtin_bit_cast(bf16x8, w);
#pragma unroll
                for (int eh = 0; eh < 2; ++eh) { const bf16* wp = WR + (size_t)(16 * eh + tq) * D + 32 * ks + 8 * kq;
                    acc[eh] = __builtin_amdgcn_mfma_f32_16x16x32_bf16(af, *(const bf16x8*)wp, acc[eh], 0, 0, 0);
                    acc[eh] = __builtin_amdgcn_mfma_f32_16x16x32_bf16(af, *(const bf16x8*)(wp + 32 * D), acc[eh], 0, 0, 0); } }
#pragma unroll
            for (int eh = 0; eh < 2; ++eh)
#pragma unroll
                for (int i = 0; i < 4; ++i) lg[(4 * kq + i) * 33 + 16 * eh + tq] = acc[eh][i] + inp(I_BROUTER)[16 * eh + tq];
            LDS_WAIT(); asm volatile("" ::: "memory");
            if (F.lane < 16) { float v[32];
#pragma unroll
                for (int e = 0; e < 32; ++e) v[e] = lg[F.lane * 33 + e];
                float tv[4];
#pragma unroll
                for (int k = 0; k < 4; ++k) { float best = -3.0e38f; int bi = 0;
#pragma unroll
                    for (int e = 0; e < 32; ++e) { if (v[e] > best) { best = v[e]; bi = e; } }
                    tv[k] = best; e4[k] = bi;
#pragma unroll
                    for (int e = 0; e < 32; ++e) { if (e == bi) v[e] = -3.0e38f; } }
                float den = 0.f;
#pragma unroll
                for (int k = 0; k < 4; ++k) { g4[k] = __expf(tv[k] - tv[0]); den += g4[k]; }
#pragma unroll
                for (int k = 0; k < 4; ++k) { g4[k] = g4[k] / den; r4[k] = (int)atomicAdd((unsigned*)&lcnt[e4[k]], 1u); } }
        }
        __syncthreads();
        if (F.tid < 32) lcnt[32 + F.tid] = atomicAdd(&gcnt[F.tid], lcnt[F.tid]);
        __syncthreads();
        if (F.wave < 4 && F.lane < 16) {
#pragma unroll
            for (int k = 0; k < 4; ++k) { const int pi = (m0 + F.lane) * 4 + k; pick_e[pi] = e4[k]; pick_rank[pi] = (int)lcnt[32 + e4[k]] + r4[k]; pick_gate[pi] = g4[k]; } }
        __syncthreads();
        (void)me; (void)mrank; (void)mgate;
    }
}

__device__ __forceinline__ void scatter_phase(const Frame& F, const Args& a) {
    const int* pick_e = (const int*)(a.ws + WS_PICK); const int* pick_rank = pick_e + 65536; const float* pick_gate = (const float*)(pick_rank + 65536); int* pos = (int*)(pick_gate + 65536);
    float* gate_of_row = (float*)(a.ws + WS_ROWTAB); int* tok_of_row = (int*)(a.ws + WS_ROWTAB + 512 * 1024 + 8192);
    unsigned* ctl = (unsigned*)(a.ws + WS_CTL);
    LAS int* pst = (LAS int*)(F.lds);
    if (F.tid == 0) { int acc = 0; for (int e = 0; e < NE; ++e) { pst[e] = acc; const int c = (int)ctl[CW_CNT + e]; pst[32 + e] = c; const int nt = (c + 255) >> 8;
            if (blockIdx.x == 0) for (int k = 0; k < nt; ++k) ctl[CW_TILEE + (acc >> 8) + k] = (unsigned)e;
            acc += nt << 8; }
        if (blockIdx.x == 0) ctl[CW_NTILES] = (unsigned)(acc >> 8); }
    __syncthreads();
    { const int gw = F.vcu * NWAVES + F.wave, NGW = F.G * NWAVES; const unsigned char* X8 = a.ws + WS_XN; unsigned char* XS8 = a.ws + WS_XS;
      for (int pi = gw; pi < 65536; pi += NGW) {
        const int e = pick_e[pi], row = pst[e] + pick_rank[pi], tok = pi >> 2;
        if (F.lane == 0) { pos[pi] = row; gate_of_row[row] = pick_gate[pi]; tok_of_row[row] = tok; }
        const GAS v4u* src = (const GAS v4u*)(X8 + (size_t)tok * D) + F.lane; GAS v4u* dst = (GAS v4u*)(XS8 + (size_t)row * D) + F.lane;
        dst[0] = src[0]; dst[64] = src[64]; } }
    if (blockIdx.x == 0) for (int e = 0; e < NE; ++e) { const int r0 = pst[e] + pst[32 + e], r1 = pst[e] + (((pst[32 + e] + 255) >> 8) << 8);
        for (int r = r0 + F.tid; r < r1; r += NWAVES * 64) { tok_of_row[r] = 0; gate_of_row[r] = 0.f; } }
}

__device__ __forceinline__ void final_phase(const Frame& F, const Args& a) {
    const float* H1 = (const float*)(a.ws + WS_H1); const bf16* OR = (const bf16*)(a.ws + WS_OROW);
    const int* pos = (const int*)(a.ws + WS_PICK) + 3 * 65536;
    const int gw = F.vcu * NWAVES + F.wave, NGW = F.G * NWAVES;
    for (int m = gw; m < T; m += NGW) {
        const GAS f32x4* xr = (const GAS f32x4*)(H1 + (size_t)m * D) + F.lane; const GAS f32x4* gr = (const GAS f32x4*)inp(I_GFINAL) + F.lane;
        f32x4 v[8];
#pragma unroll
        for (int j = 0; j < 8; ++j) v[j] = xr[64 * j];
#pragma unroll
        for (int k = 0; k < 4; ++k) { const int row = pos[m * 4 + k]; const GAS v2u* orp = (const GAS v2u*)(OR + (size_t)row * D) + F.lane;
#pragma unroll
            for (int j = 0; j < 8; ++j) { const v2u w = orp[64 * j]; v[j].x += bflo(w.x); v[j].y += bfhi(w.x); v[j].z += bflo(w.y); v[j].w += bfhi(w.y); } }
        float s = 0.f;
#pragma unroll
        for (int j = 0; j < 8; ++j) s += (v[j].x * v[j].x + v[j].y * v[j].y) + (v[j].z * v[j].z + v[j].w * v[j].w);
        const float rstd = 1.0f / sqrtf(wave_sum(s) * (1.f / D) + EPS);
        GAS f32x4* o = (GAS f32x4*)(a.out + (size_t)m * D) + F.lane;
#pragma unroll
        for (int j = 0; j < 8; ++j) { const f32x4 g = gr[64 * j]; o[64 * j] = (f32x4){v[j].x * rstd * g.x, v[j].y * rstd * g.y, v[j].z * rstd * g.z, v[j].w * rstd * g.w}; }
    }
}

#ifndef MK_N_LAUNCHES
#define MK_N_LAUNCHES 1
#endif
constexpr int NPH = 14;
__global__ void __launch_bounds__(NWAVES * 64, 2) fwd(Args args) {
    extern __shared__ __attribute__((aligned(16))) unsigned char lds[];
#define NEWFRAME() Frame F; { int tz = threadIdx.x; asm volatile("" : "+v"(tz)); F.lds = (LAS unsigned char*)lds; F.MISC = (volatile LAS unsigned*)(F.lds + MISC_OFF); F.tid = tz; F.lane = tz & 63; F.wave = __builtin_amdgcn_readfirstlane(tz >> 6); \
        F.G = gridDim.x; const int bx = blockIdx.x; F.vcu = (F.G % 8 == 0) ? (bx % 8) * (F.G / 8) + bx / 8 : bx; }
    unsigned char* ws = args.ws;
    unsigned* ctl = (unsigned*)(ws + WS_CTL);
    for (int u = threadIdx.x; u < (LDS_BYTES - MISC_OFF) / 4; u += NWAVES * 64) ((LAS unsigned*)((LAS unsigned char*)lds + MISC_OFF))[u] = 0u;
    __syncthreads();
    const int lo = args.ph_lo, hi = args.ph_hi;
    XcdBarrier bar; bar.bar = ctl + CW_BAR; bar.x = 0; bar.st = nullptr;
    if (hi - lo > 1) bar = xcd_barrier_post(ctl + CW_BAR, (volatile LAS unsigned*)((LAS unsigned char*)lds + MISC_OFF) + 8);
#ifndef PHMASK
#define PHMASK 0xFFFF
#endif
#define IN(k) (((PHMASK >> (k)) & 1) && lo <= (k) && (k) < hi)
#define SEAM(k) do { if (IN(k) && IN((k) + 1)) xcd_barrier(bar); } while (0)

    if (IN(0)) { NEWFRAME(); p0_prologue(F, args); } SEAM(0);
    if (IN(1)) { NEWFRAME();
        { pg8::Gemm g{(const bf16*)(ws + WS_XN), (const bf16*)(ws + WS_WIN), T, NP, D}; pg8::StaticOrder S; S.init(T, NP, F.G, (int)blockIdx.x);
          pg8::EpiBf16<0> E{(bf16*)(ws + WS_P), NP, nullptr, 0, 0, 1.f};
          pg8::gemm_phase<pg8::EpiBf16<0>, pg8::StaticOrder, true, true>(F.lds, g, S, E); }
        __syncthreads();
        { pg8::Gemm g{(const bf16*)(ws + WS_MN), (const bf16*)(ws + WS_WMKV), 512, 2048, D}; pg8::StaticOrder S; S.init(512, 2048, F.G, (int)((blockIdx.x + F.G / 2) % F.G));
          pg8::EpiKV E{(bf16*)(ws + WS_KMEM), (bf16*)(ws + WS_VT)};
          pg8::gemm_phase<pg8::EpiKV, pg8::StaticOrder, true, true>(F.lds, g, S, E); }
    } SEAM(1);
    if (IN(2)) { NEWFRAME();
#ifndef NO_R1
 r1_lora_in(F, args);
#endif
#ifndef NO_LRU
 lru_pass<false>(F, args, F.vcu * NWAVES + F.wave, F.G * NWAVES);
#endif
 } SEAM(2);
    if (IN(3)) { NEWFRAME();
        lru_carry(F, args);
        { pg8::Gemm g{(const bf16*)(ws + WS_XN), (const bf16*)(ws + WS_WLORA), T, 3072, LORA_K}; pg8::StaticOrder S; S.init(T, 3072, F.G, (int)blockIdx.x);
          pg8::EpiF32 E{(float*)(ws + WS_LORAOUT), 3072};
          pg8::gemm_phase<pg8::EpiF32, pg8::StaticOrder, true, true>(F.lds, g, S, E); }
    } SEAM(3);
    if (IN(4)) { NEWFRAME(); r3_blocks(F, args); } SEAM(4);
    if (IN(5)) { NEWFRAME();
        if (F.tid < 64) ((LAS unsigned*)(F.lds + SC_SYNC))[F.tid] = 0u; __syncthreads();
        int bh = 0, quarter = 0; const bool sw = scan_wg(bh, quarter);
        int gw2, NGW2; { const int bx = blockIdx.x, G = F.G; if (G == 256) { NGW2 = 1792; gw2 = sw ? ((bx >> 4) * 8 + (bx & 7)) * 6 + (F.wave - 2) : 768 + ((bx >> 4) * 8 + (bx & 7)) * 8 + F.wave; } else { NGW2 = G * 8; gw2 = F.vcu * 8 + F.wave; } }
        if (sw && F.wave == 0) r4_scan<0>(F, args, bh, quarter);
        else if (sw && F.wave == 1) r4_feeder(F, args, bh);
        else {
            const int rot = F.wave % 3;
            if (rot == 0) { moe_weight_convert(F, args, gw2, NGW2); xattn_phase(F, args, gw2, NGW2); lru_pass<true>(F, args, gw2, NGW2); }
            else if (rot == 1) { xattn_phase(F, args, gw2, NGW2); lru_pass<true>(F, args, gw2, NGW2); moe_weight_convert(F, args, gw2, NGW2); }
            else { lru_pass<true>(F, args, gw2, NGW2); moe_weight_convert(F, args, gw2, NGW2); xattn_phase(F, args, gw2, NGW2); } }
    } SEAM(5);
    if (IN(6)) { NEWFRAME(); r5_finish(F, args); } SEAM(6);
    if (IN(7)) { NEWFRAME();
        pg8::Gemm g{(const bf16*)(ws + WS_YABC), (const bf16*)(ws + WS_WBR), T, 2048, 3072}; pg8::StaticOrder S; S.init(T, 2048, F.G, (int)blockIdx.x);
        pg8::EpiBranch2 E{(const bf16*)(ws + WS_P), NP, PC_G, (bf16*)(ws + WS_MERGED)};
        pg8::gemm_phase<pg8::EpiBranch2, pg8::StaticOrder, true, true>(F.lds, g, S, E);
    } SEAM(7);
    if (IN(8)) { NEWFRAME();
        pg8::Gemm g{(const bf16*)(ws + WS_MERGED), (const bf16*)(ws + WS_WO), T, D, D}; pg8::StaticOrder S; S.init(T, D, F.G, (int)blockIdx.x);
        pg8::EpiRes E{inp(I_X), (float*)(ws + WS_H1), D};
        pg8::gemm_phase<pg8::EpiRes, pg8::StaticOrder, true, true>(F.lds, g, S, E);
    } SEAM(8);
    if (IN(9)) { NEWFRAME(); router_phase(F, args); } SEAM(9);
    if (IN(10)) { NEWFRAME(); scatter_phase(F, args); } SEAM(10);
    if (IN(11)) { NEWFRAME();
        const int ntiles = __builtin_amdgcn_readfirstlane((int)__hip_atomic_load(ctl + CW_NTILES, __ATOMIC_RELAXED, __HIP_MEMORY_SCOPE_AGENT));
        pg8::Gemm g{(const bf16*)(ws + WS_XS), (const bf16*)(ws + WS_WGU), ntiles * 256, NE * 4096, D}; pg8::MoeOrder<false> S; S.init(ntiles, 16, F.G, (int)blockIdx.x, (const int*)(ctl + CW_TILEE), nullptr);
        pg8::EpiSwiglu E{ws + WS_HH, inp(I_BGATE), inp(I_BUP)};
        pg8::gemm_phase<pg8::EpiSwiglu, pg8::MoeOrder<false>, true, true, 1>(F.lds, g, S, E);
    } SEAM(11);
    if (IN(12)) { NEWFRAME();
        const int ntiles = __builtin_amdgcn_readfirstlane((int)__hip_atomic_load(ctl + CW_NTILES, __ATOMIC_RELAXED, __HIP_MEMORY_SCOPE_AGENT));
        pg8::Gemm g{(const bf16*)(ws + WS_HH), (const bf16*)(ws + WS_WD), ntiles * 256, NE * 2048, D}; pg8::MoeOrder<false> S; S.init(ntiles, 8, F.G, (int)blockIdx.x, (const int*)(ctl + CW_TILEE), nullptr);
        pg8::EpiDown E{(bf16*)(ws + WS_OROW), inp(I_BDOWN), (const float*)(ws + WS_ROWTAB)};
        pg8::gemm_phase<pg8::EpiDown, pg8::MoeOrder<false>, true, true, 1>(F.lds, g, S, E);
    } SEAM(12);
    if (IN(13)) { NEWFRAME(); final_phase(F, args); }
#ifdef PROBE_EXTRA_PHASE
    if (lo == 14) { NEWFRAME(); if (F.tid < 64) ((LAS unsigned*)(F.lds + SC_SYNC))[F.tid] = 0u; __syncthreads(); int bh = 0, quarter = 0; const bool sw = scan_wg(bh, quarter); if (sw && F.wave == 0) r4_scan<0>(F, args, bh, quarter); else if (sw && F.wave == 1) r4_feeder(F, args, bh); }
    if (lo == 17) { NEWFRAME(); int bh = 0, quarter = 0; const bool sw = scan_wg(bh, quarter); if (sw && F.wave == 0) r4_scan<1>(F, args, bh, quarter); }
    if (lo == 15) { NEWFRAME(); moe_weight_convert(F, args, F.vcu * 8 + F.wave, F.G * 8); }
#endif
#undef IN
#undef SEAM
}

extern "C" void kernel_launch(void* const* d_in, const int* in_sizes, int n_in, void* d_out, int out_size, void* d_ws, size_t ws_size, hipStream_t stream) {
    static int grid = 0;
    if (grid == 0) {
        if (n_in != 39 || out_size != T * D || ws_size < WS_END) { fprintf(stderr, "kernel_launch: built for 39 inputs, out of %d floats, >= %zu bytes of workspace; got n_in %d, out %d, ws %zu; nothing launched\n", T * D, (size_t)WS_END, n_in, out_size, ws_size); grid = -1; return; }
        int dev = 0, cus = 0, per_cu = 0;
        if (hipGetDevice(&dev) != hipSuccess || hipDeviceGetAttribute(&cus, hipDeviceAttributeMultiprocessorCount, dev) != hipSuccess) { fprintf(stderr, "kernel_launch: device query failed\n"); grid = -1; return; }
        if (hipFuncSetAttribute((const void*)fwd, hipFuncAttributeMaxDynamicSharedMemorySize, LDS_BYTES) != hipSuccess) { fprintf(stderr, "kernel_launch: hipFuncSetAttribute failed\n"); grid = -1; return; }
        if (hipOccupancyMaxActiveBlocksPerMultiprocessor(&per_cu, (const void*)fwd, NWAVES * 64, LDS_BYTES) != hipSuccess || per_cu < 1)
            fprintf(stderr, "kernel_launch: note: occupancy query reports %d workgroups per CU\n", per_cu);
        (void)hipGetLastError();
        grid = cus;
    }
    if (grid < 0) return;
    (void)in_sizes;
    if (hipMemsetAsync((char*)d_ws + WS_CTL, 0, CTL_ZERO_BYTES, stream) != hipSuccess) { fprintf(stderr, "kernel_launch: hipMemsetAsync failed\n"); return; }
    Args a{};
    for (int i = 0; i < 39; ++i) a.in[i] = (const float*)d_in[i];
    a.out = (float*)d_out; a.ws = (unsigned char*)d_ws;
#if MK_N_LAUNCHES == 1
    a.ph_lo = 0; a.ph_hi = NPH;
    hipLaunchKernelGGL(fwd, dim3(grid), dim3(NWAVES * 64), LDS_BYTES, stream, a);
#else
    for (int k = 0; k < NPH; ++k) { a.ph_lo = k; a.ph_hi = k + 1; int reps = 1;
#ifdef PROBE_REP_PHASE
        if (k == PROBE_REP_PHASE) reps = 1 + PROBE_REP_N;
#endif
        for (int r = 0; r < reps; ++r) hipLaunchKernelGGL(fwd, dim3(grid), dim3(NWAVES * 64), LDS_BYTES, stream, a); }
#ifdef PROBE_EXTRA_PHASE
    for (int r = 0; r < PROBE_REP_N; ++r) { a.ph_lo = PROBE_EXTRA_PHASE; a.ph_hi = PROBE_EXTRA_PHASE + 1; hipLaunchKernelGGL(fwd, dim3(grid), dim3(NWAVES * 64), LDS_BYTES, stream, a); }
#endif
#endif
    const hipError_t le = hipPeekAtLastError();
    if (le != hipSuccess) fprintf(stderr, "kernel_launch: launch failed: %s\n", hipGetErrorName(le));
}
```

```cpp
#include <hip/hip_runtime.h>
#include <cstdio>
#include <cstdint>
namespace pg8 {
#define PG8_LAS __attribute__((address_space(3)))
typedef unsigned short bf16_t;
typedef short bf16x8 __attribute__((ext_vector_type(8)));
typedef float f32x4 __attribute__((ext_vector_type(4)));
typedef unsigned u32x4 __attribute__((ext_vector_type(4)));
constexpr int BM = 256, BK = 64, HALF = 128, HTB = HALF * BK * 2  , STAGE_BYTES = 8 * HTB, NXCD = 8, WGM = 8;

__host__ __device__ __forceinline__ int lds_byte(int r, int c) { const int st = (r >> 4) * 2 + (c >> 5), rr = r & 15, cc = c & 31, ob = rr * 64 + cc * 2; return st * 1024 + (ob ^ (((ob >> 9) & 1) << 5)); }
__host__ __device__ __forceinline__ void stage_rc(int b, int& R, int& C) { const int st = b / 1024, sb = b % 1024, swz = sb ^ (((sb >> 9) & 1) << 5); R = (st >> 1) * 16 + swz / 64; C = (st & 1) * 32 + (swz % 64) / 2; }
__host__ __device__ __forceinline__ int perm32(int rho) { const int n = rho >> 4, i = rho & 15; return 8 * (i >> 2) + 4 * n + (i & 3); }

struct Unit { int pm, pn; };
struct Gemm { const bf16_t* A; const bf16_t* Bt; int M, N, K; };

struct StaticOrder {
    static constexpr bool GATHER = false; __device__ __forceinline__ int arow(const Unit&, int) const { return 0; }
    int nM, nN, nwg, G, c;
    __host__ __device__ void init(int M, int N, int G_, int c_) { nM = M / BM; nN = N / BM; nwg = nM * nN; G = G_; c = c_; }
    __host__ __device__ bool next(int i, Unit& u) const {
        const int L = i * G + c; if (L >= nwg) return false;
        int wgid = (int)L; { const int q = nwg / NXCD, r = nwg % NXCD, xcd = wgid % NXCD, off = wgid / NXCD; wgid = (xcd < r ? xcd * (q + 1) : r * (q + 1) + (xcd - r) * q) + off; }
        const int nig = WGM * nN, gid = wgid / nig, fm = gid * WGM, gsz = (nM - fm) < WGM ? (nM - fm) : WGM;
        u.pm = fm + ((wgid % nig) % gsz); u.pn = (wgid % nig) / gsz; return true;
    }
    __device__ __forceinline__ void a_ready(const Unit&) const {}
    __device__ __forceinline__ void done(const Unit&) const {}
};
struct RangeOrder {
    static constexpr bool GATHER = false; __device__ __forceinline__ int arow(const Unit&, int) const { return 0; }
    StaticOrder so; int start, cnt;
    __device__ void init(int M, int N, int start_, int cnt_) { so.init(M, N, 1, 0); start = start_; cnt = cnt_; }
    __device__ bool next(int i, Unit& u) const { if (i >= cnt) return false; return so.next(start + i, u); }
    __device__ __forceinline__ void a_ready(const Unit&) const {}
    __device__ __forceinline__ void done(const Unit&) const {}
};
__device__ __forceinline__ unsigned cvt_pk_bf16(float lo, float hi) { unsigned r; asm volatile("v_cvt_pk_bf16_f32 %0, %1, %2" : "=v"(r) : "v"(lo), "v"(hi)); return r; }
typedef float f32x2 __attribute__((ext_vector_type(2)));
__device__ __forceinline__ f32x2 gelu_pk(f32x2 v) {
    const f32x2 av = __builtin_elementwise_abs(v), d = av * 0.2316418882f + 1.0f;
    f32x2 t; t.x = __builtin_amdgcn_rcpf(d.x); t.y = __builtin_amdgcn_rcpf(d.y);
    f32x2 q = t * 0.5307027145f + (-0.7265760135f); q = q * t + 0.7107068705f; q = q * t + (-0.142248368f); q = q * t + 0.127414796f; q = q * t;
    const f32x2 s = (v * v) * (-0.72134752044f);
    f32x2 e; e.x = __builtin_amdgcn_exp2f(s.x); e.y = __builtin_amdgcn_exp2f(s.y);
    const f32x2 m = v * (q * e), r = v - m;
    f32x2 o; o.x = v.x < 0.f ? m.x : r.x; o.y = v.y < 0.f ? m.y : r.y; return o;
}

template <int ACT  > struct EpiBf16 {
    static constexpr bool PERM = true, AFTER_DRAIN = false; static constexpr int MIDK = 0; static constexpr int WSCALE = 0x79797979  ; static_assert(ACT == 0 || ACT == 1, "EpiBf16: ACT is 0 (none) or 1 (gelu_pk)");
    bf16_t* O; int ldc; const float* bias; int split_cols; size_t split_stride; float scale0;
    __device__ __forceinline__ void operator()(const f32x4 (&acc)[2][2][4][2], const Unit& u, int wr, int wc, int fr, int fq) const {
        int tz_ = threadIdx.x; asm volatile("" : "+v"(tz_)); { const int wid_ = tz_ >> 6, lane_ = tz_ & 63; wr = wid_ >> 2; wc = wid_ & 3; fr = lane_ & 15; fq = lane_ >> 4; }
        const int row0 = u.pm * BM + wr * 64 + fr; int colt = u.pn * BM; bf16_t* base = O;
        float sc = 1.f; if (split_cols) { const int t = colt / split_cols; base += (size_t)t * split_stride; colt -= t * split_cols; if (t == 0) sc = scale0; }
        const int col0 = colt + wc * 32 + 8 * fq, bcol0 = u.pn * BM + wc * 32 + 8 * fq;
        f32x4 bv[2][2];
#pragma unroll
        for (int bj = 0; bj < 2; ++bj)
#pragma unroll
            for (int n = 0; n < 2; ++n) bv[bj][n] = bias ? *(const f32x4*)(bias + bcol0 + bj * HALF + 4 * n) : (f32x4){0.f, 0.f, 0.f, 0.f};
#pragma unroll
        for (int ai = 0; ai < 2; ++ai)
#pragma unroll
            for (int m = 0; m < 4; ++m) { bf16_t* rowp = base + (size_t)(row0 + ai * HALF + m * 16) * ldc + col0;
#pragma unroll
                for (int bj = 0; bj < 2; ++bj) { f32x4 v0 = acc[ai][bj][m][0] + bv[bj][0], v1 = acc[ai][bj][m][1] + bv[bj][1];
                    if (ACT == 1) { f32x2 a = gelu_pk((f32x2){v0[0], v0[1]}), b = gelu_pk((f32x2){v0[2], v0[3]}), c = gelu_pk((f32x2){v1[0], v1[1]}), d = gelu_pk((f32x2){v1[2], v1[3]});
                        v0 = (f32x4){a.x, a.y, b.x, b.y}; v1 = (f32x4){c.x, c.y, d.x, d.y}; }
                    v0 = v0 * sc; v1 = v1 * sc; u32x4 w; w.x = cvt_pk_bf16(v0[0], v0[1]); w.y = cvt_pk_bf16(v0[2], v0[3]); w.z = cvt_pk_bf16(v1[0], v1[1]); w.w = cvt_pk_bf16(v1[2], v1[3]);
                    *(u32x4*)(rowp + bj * HALF) = w; } }
    }
};

__device__ __forceinline__ float bf_lo(unsigned w) { return __builtin_bit_cast(float, w << 16); }
__device__ __forceinline__ float bf_hi(unsigned w) { return __builtin_bit_cast(float, w & 0xffff0000u); }
__device__ __forceinline__ float fsigmoid(float x) { return __builtin_amdgcn_rcpf(1.0f + __expf(-x)); }
typedef unsigned u32x2 __attribute__((ext_vector_type(2)));

struct EpiF32 {
    static constexpr bool PERM = false, AFTER_DRAIN = false; static constexpr int MIDK = 0; static constexpr int WSCALE = 0x7f7f7f7f;
    float* C; int ldc;
    __device__ __forceinline__ void operator()(const f32x4 (&acc)[2][2][4][2], const Unit& u, int wr, int wc, int fr, int fq) const {
        const int row0 = u.pm * BM + wr * 64 + fr, col0 = u.pn * BM + wc * 32 + 4 * fq;
#pragma unroll
        for (int ai = 0; ai < 2; ++ai)
#pragma unroll
            for (int m = 0; m < 4; ++m) { float* rowp = C + (size_t)(row0 + ai * HALF + m * 16) * ldc + col0;
#pragma unroll
                for (int bj = 0; bj < 2; ++bj)
#pragma unroll
                    for (int n = 0; n < 2; ++n) *(f32x4*)(rowp + bj * HALF + n * 16) = acc[ai][bj][m][n]; }
    }
};
struct EpiRes {
    static constexpr bool PERM = false, AFTER_DRAIN = false; static constexpr int MIDK = 0; static constexpr int WSCALE = 0x7f7f7f7f;
    const float* X; float* C; int ldc;
    __device__ __forceinline__ void operator()(const f32x4 (&acc)[2][2][4][2], const Unit& u, int wr, int wc, int fr, int fq) const {
        const int row0 = u.pm * BM + wr * 64 + fr, col0 = u.pn * BM + wc * 32 + 4 * fq;
#pragma unroll
        for (int ai = 0; ai < 2; ++ai)
#pragma unroll
            for (int m = 0; m < 4; ++m) { const size_t off = (size_t)(row0 + ai * HALF + m * 16) * ldc + col0;
#pragma unroll
                for (int bj = 0; bj < 2; ++bj)
#pragma unroll
                    for (int n = 0; n < 2; ++n) { const f32x4 xv = *(const f32x4*)(X + off + bj * HALF + n * 16); *(f32x4*)(C + off + bj * HALF + n * 16) = acc[ai][bj][m][n] + xv; }
                asm volatile("" ::: "memory"); }
    }
};
struct EpiKV {
    static constexpr bool PERM = false, AFTER_DRAIN = false; static constexpr int MIDK = 0; static constexpr int WSCALE = 0x7f7f7f7f;
    bf16_t* Kb; bf16_t* VT;
    __device__ __forceinline__ void operator()(const f32x4 (&acc)[2][2][4][2], const Unit& u, int wr, int wc, int fr, int fq) const {
        const int row0 = u.pm * BM + wr * 64 + fr, col0 = u.pn * BM + wc * 32 + 4 * fq;
#pragma unroll
        for (int ai = 0; ai < 2; ++ai)
#pragma unroll
            for (int m = 0; m < 4; ++m) { const int r = row0 + ai * HALF + m * 16;
#pragma unroll
                for (int bj = 0; bj < 2; ++bj)
#pragma unroll
                    for (int n = 0; n < 2; ++n) { const f32x4 v = acc[ai][bj][m][n]; const int c = col0 + bj * HALF + n * 16;
                        if (u.pn < 4) { u32x2 w; w.x = cvt_pk_bf16(v[0], v[1]); w.y = cvt_pk_bf16(v[2], v[3]); *(u32x2*)(Kb + (size_t)r * 1024 + c) = w; }
                        else { const int cc = c - 1024, h = cc >> 8, d = cc & 255, b = r >> 8, mm = r & 255;
                            const int idx = (mm >> 5) * 32 + ((mm >> 2) & 3) * 8 + ((mm >> 4) & 1) * 4 + (mm & 3);
                            bf16_t* o = VT + ((size_t)((b * 4 + h) * 256 + d)) * 256 + idx;
                            const unsigned w0 = cvt_pk_bf16(v[0], v[1]), w1 = cvt_pk_bf16(v[2], v[3]);
                            o[0] = (bf16_t)(w0 & 0xffffu); o[256] = (bf16_t)(w0 >> 16); o[512] = (bf16_t)(w1 & 0xffffu); o[768] = (bf16_t)(w1 >> 16); } } }
    }
};
struct EpiBranch {
    static constexpr bool PERM = false, AFTER_DRAIN = false; static constexpr int MIDK = 0; static constexpr int WSCALE = 0x7f7f7f7f;
    const bf16_t* P; int ldp; int gcol0; float* macc; bf16_t* merged;
    __device__ __forceinline__ void operator()(const f32x4 (&acc)[2][2][4][2], const Unit& u, int wr, int wc, int fr, int fq) const {
        const int br = u.pm >> 6, pm = u.pm & 63, pn = u.pn & 7;
        const int row0 = pm * BM + wr * 64 + fr, col0 = pn * BM + wc * 32 + 4 * fq;
#pragma unroll
        for (int ai = 0; ai < 2; ++ai)
#pragma unroll
            for (int m = 0; m < 4; ++m) { const int r = row0 + ai * HALF + m * 16; const bf16_t* prow = P + (size_t)r * ldp + gcol0 + br * 2048;
#pragma unroll
                for (int bj = 0; bj < 2; ++bj)
#pragma unroll
                    for (int n = 0; n < 2; ++n) { const int c = col0 + bj * HALF + n * 16; const u32x2 gw = *(const u32x2*)(prow + c);
                        f32x4 g; g[0] = fsigmoid(bf_lo(gw.x)); g[1] = fsigmoid(bf_hi(gw.x)); g[2] = fsigmoid(bf_lo(gw.y)); g[3] = fsigmoid(bf_hi(gw.y));
                        f32x4 v = acc[ai][bj][m][n] * g; float* mp = macc + (size_t)r * 2048 + c;
                        if (br > 0) v = v + *(const f32x4*)mp;
                        if (br < 2) *(f32x4*)mp = v;
                        else { u32x2 w; w.x = cvt_pk_bf16(v[0], v[1]); w.y = cvt_pk_bf16(v[2], v[3]); *(u32x2*)(merged + (size_t)r * 2048 + c) = w; } }
                asm volatile("" ::: "memory"); }
    }
};
struct EpiSwiglu {
    static constexpr bool PERM = true, AFTER_DRAIN = false; static constexpr int MIDK = 0; static constexpr int WSCALE = 0x79797979;
    unsigned char* H; const float* bg; const float* bu;
    __device__ __forceinline__ void operator()(const f32x4 (&acc)[2][2][4][2], const Unit& u, int wr, int wc, int fr, int fq) const {
        int tz_ = threadIdx.x; asm volatile("" : "+v"(tz_)); { const int wid_ = tz_ >> 6, lane_ = tz_ & 63; wr = wid_ >> 2; wc = wid_ & 3; fr = lane_ & 15; fq = lane_ >> 4; }
        const int e = u.pn >> 4, ct = u.pn & 15;
        const int row0 = u.pm * BM + wr * 64 + fr, col0 = ct * 128 + wc * 32 + 8 * fq;
        f32x4 bgv[2], buv[2];
#pragma unroll
        for (int n = 0; n < 2; ++n) { bgv[n] = *(const f32x4*)(bg + (size_t)e * 2048 + col0 + 4 * n); buv[n] = *(const f32x4*)(bu + (size_t)e * 2048 + col0 + 4 * n); }
#pragma unroll
        for (int ai = 0; ai < 2; ++ai)
#pragma unroll
            for (int m = 0; m < 4; ++m) { unsigned char* rowp = H + (size_t)(row0 + ai * HALF + m * 16) * 2048 + col0;
                f32x4 o[2];
#pragma unroll
                for (int n = 0; n < 2; ++n) { const f32x4 g = acc[ai][0][m][n] + bgv[n], up = acc[ai][1][m][n] + buv[n];
#pragma unroll
                    for (int j = 0; j < 4; ++j) { const float hg = fminf(g[j], 7.0f), hu = fminf(fmaxf(up[j], -7.0f), 7.0f); o[n][j] = (hu + 1.0f) * hg * fsigmoid(1.702f * hg); } }
                u32x2 w; { int t0 = __builtin_amdgcn_cvt_pk_fp8_f32(o[0][0], o[0][1], 0, false); t0 = __builtin_amdgcn_cvt_pk_fp8_f32(o[0][2], o[0][3], t0, true); int t1 = __builtin_amdgcn_cvt_pk_fp8_f32(o[1][0], o[1][1], 0, false); t1 = __builtin_amdgcn_cvt_pk_fp8_f32(o[1][2], o[1][3], t1, true); w.x = (unsigned)t0; w.y = (unsigned)t1; }
                *(u32x2*)rowp = w; }
    }
};
struct EpiDown {
    static constexpr bool PERM = true, AFTER_DRAIN = false; static constexpr int MIDK = 0; static constexpr int WSCALE = 0x79797979;
    bf16_t* O; const float* bd; const float* rowgate;
    __device__ __forceinline__ void operator()(const f32x4 (&acc)[2][2][4][2], const Unit& u, int wr, int wc, int fr, int fq) const {
        int tz_ = threadIdx.x; asm volatile("" : "+v"(tz_)); { const int wid_ = tz_ >> 6, lane_ = tz_ & 63; wr = wid_ >> 2; wc = wid_ & 3; fr = lane_ & 15; fq = lane_ >> 4; }
        const int e = u.pn >> 3, ct = u.pn & 7;
        const int row0 = u.pm * BM + wr * 64 + fr, col0 = ct * BM + wc * 32 + 8 * fq;
        f32x4 bv[2][2];
#pragma unroll
        for (int bj = 0; bj < 2; ++bj)
#pragma unroll
            for (int n = 0; n < 2; ++n) bv[bj][n] = *(const f32x4*)(bd + (size_t)e * 2048 + col0 + bj * HALF + 4 * n);
#pragma unroll
        for (int ai = 0; ai < 2; ++ai)
#pragma unroll
            for (int m = 0; m < 4; ++m) { const int r = row0 + ai * HALF + m * 16; const float gs = rowgate[r]; bf16_t* rowp = O + (size_t)r * 2048 + col0;
#pragma unroll
                for (int bj = 0; bj < 2; ++bj) { const f32x4 v0 = (acc[ai][bj][m][0] + bv[bj][0]) * gs, v1 = (acc[ai][bj][m][1] + bv[bj][1]) * gs;
                    u32x4 w; w.x = cvt_pk_bf16(v0[0], v0[1]); w.y = cvt_pk_bf16(v0[2], v0[3]); w.z = cvt_pk_bf16(v1[0], v1[1]); w.w = cvt_pk_bf16(v1[2], v1[3]);
                    *(u32x4*)(rowp + bj * HALF) = w; } }
    }
};

struct EpiBranch2 {
    static constexpr bool PERM = false, AFTER_DRAIN = false; static constexpr int MIDK = 16; static constexpr int WSCALE = 0x7f7f7f7f;
    const bf16_t* P; int ldp; int gcol0; bf16_t* merged;
    __device__ __forceinline__ void mid(f32x4 (&acc)[2][2][4][2], const Unit& u, int which, int, int, int, int) const {
        int tz = threadIdx.x; asm volatile("" : "+v"(tz));
        const int wid_ = tz >> 6, lane_ = tz & 63, wr = wid_ >> 2, wc = wid_ & 3, fr = lane_ & 15, fq = lane_ >> 4;
        const int row0 = u.pm * BM + wr * 64 + fr, col0 = u.pn * BM + wc * 32 + 4 * fq;
#pragma unroll
        for (int ai = 0; ai < 2; ++ai)
#pragma unroll
            for (int m = 0; m < 4; ++m) { const bf16_t* prow = P + (size_t)(row0 + ai * HALF + m * 16) * ldp + gcol0 + (which - 1) * 2048;
#pragma unroll
                for (int bj = 0; bj < 2; ++bj)
#pragma unroll
                    for (int n = 0; n < 2; ++n) { const int c = col0 + bj * HALF + n * 16; const u32x2 ga = *(const u32x2*)(prow + c), gb = *(const u32x2*)(prow + 2048 + c);
                        const float a_[4] = {bf_lo(ga.x), bf_hi(ga.x), bf_lo(ga.y), bf_hi(ga.y)}, b_[4] = {bf_lo(gb.x), bf_hi(gb.x), bf_lo(gb.y), bf_hi(gb.y)};
#pragma unroll
                        for (int j = 0; j < 4; ++j) { const float ea = __expf(-fminf(fmaxf(a_[j], -30.f), 30.f)), eb = __expf(-fminf(fmaxf(b_[j], -30.f), 30.f));
                            acc[ai][bj][m][n][j] *= (1.0f + eb) * __builtin_amdgcn_rcpf(1.0f + ea); } }
                asm volatile("" ::: "memory"); }
    }
    __device__ __forceinline__ void operator()(const f32x4 (&acc)[2][2][4][2], const Unit& u, int wr, int wc, int fr, int fq) const {
        const int row0 = u.pm * BM + wr * 64 + fr, col0 = u.pn * BM + wc * 32 + 4 * fq;
#pragma unroll
        for (int ai = 0; ai < 2; ++ai)
#pragma unroll
            for (int m = 0; m < 4; ++m) { const int r = row0 + ai * HALF + m * 16; const bf16_t* prow = P + (size_t)r * ldp + gcol0 + 2 * 2048;
#pragma unroll
                for (int bj = 0; bj < 2; ++bj)
#pragma unroll
                    for (int n = 0; n < 2; ++n) { const int c = col0 + bj * HALF + n * 16; const u32x2 gw = *(const u32x2*)(prow + c);
                        const float g_[4] = {bf_lo(gw.x), bf_hi(gw.x), bf_lo(gw.y), bf_hi(gw.y)}; f32x4 v = acc[ai][bj][m][n];
#pragma unroll
                        for (int j = 0; j < 4; ++j) v[j] *= __builtin_amdgcn_rcpf(1.0f + __expf(-fminf(fmaxf(g_[j], -30.f), 30.f)));
                        u32x2 w; w.x = cvt_pk_bf16(v[0], v[1]); w.y = cvt_pk_bf16(v[2], v[3]); *(u32x2*)(merged + (size_t)r * 2048 + c) = w; }
                asm volatile("" ::: "memory"); }
    }
};
struct BranchOrder {                              static constexpr bool GATHER = false; __device__ __forceinline__ int arow(const Unit&, int) const { return 0; }
    StaticOrder so;
    __device__ void init(int G_, int c_) { so.init(16384, 2048, G_, c_); }
    __device__ bool next(int i, Unit& u) const { const int br = i % 3; Unit t; if (!so.next(i / 3, t)) return false; u.pm = br * 64 + t.pm; u.pn = br * 8 + t.pn; return true; }
    __device__ __forceinline__ void a_ready(const Unit&) const {}
    __device__ __forceinline__ void done(const Unit&) const {}
};
template <bool GATH> struct MoeOrder {
    static constexpr bool GATHER = GATH;
    StaticOrder so; const int* tile_e; const int* tok; int nN;
    __device__ void init(int ntiles, int nN_, int G_, int c_, const int* te, const int* tk) { so.init(ntiles * BM, nN_ * BM, G_, c_); tile_e = te; tok = tk; nN = nN_; }
    __device__ bool next(int i, Unit& u) const { Unit t; if (!so.next(i, t)) return false; u.pm = t.pm; u.pn = tile_e[t.pm] * nN + t.pn; return true; }
    __device__ __forceinline__ int arow(const Unit& u, int r) const { return tok[u.pm * BM + r]; }
    __device__ __forceinline__ void a_ready(const Unit&) const {}
    __device__ __forceinline__ void done(const Unit&) const {}
};
typedef int i32x4 __attribute__((ext_vector_type(4)));
typedef int i32x8 __attribute__((ext_vector_type(8)));
__device__ __forceinline__ i32x8 frag8(bf16x8 lo, bf16x8 hi) { return __builtin_shufflevector(__builtin_bit_cast(i32x4, lo), __builtin_bit_cast(i32x4, hi), 0, 1, 2, 3, 4, 5, 6, 7); }
template <class Epi, class Sched, bool ALIGN_EPI = false, bool SP2 = false, int ESZ = 2>
__device__ __forceinline__ void gemm_phase(PG8_LAS unsigned char* lds, const Gemm g, const Sched& S, const Epi& E) {
    int tid_ = threadIdx.x; asm volatile("" : "+v"(tid_));
    const int tid = tid_, wid = __builtin_amdgcn_readfirstlane(tid >> 6), lane = tid & 63, wr = wid >> 2, wc = wid & 3, fr = lane & 15, fq = lane >> 4;
    const int K = g.K, nt = K / (BK * 2 / ESZ);
    const __amdgpu_buffer_rsrc_t rsA = __builtin_amdgcn_make_buffer_rsrc((void*)g.A, 0, 0x7fffffff, 0x00020000), rsB = __builtin_amdgcn_make_buffer_rsrc((void*)g.Bt, 0, 0x7fffffff, 0x00020000);
    unsigned voffA[2], voffB[2];
#pragma unroll
    for (int i = 0; i < 2; ++i) { int R, C; stage_rc(tid * 16 + i * 8192, R, C); const int Rb = Epi::PERM ? ((R & ~31) + perm32(R & 31)) : R;
        voffA[i] = (unsigned)(R * K) * (unsigned)ESZ + (unsigned)C * 2u; voffB[i] = (unsigned)(Rb * K) * (unsigned)ESZ + (unsigned)C * 2u; }
    unsigned vc[2][2] = {{0u, 0u}, {0u, 0u}}, vn[2][2] = {{0u, 0u}, {0u, 0u}};
#define PG8_ROWS(dst, un) do { if constexpr (Sched::GATHER) { _Pragma("unroll") for (int _h = 0; _h < 2; ++_h) _Pragma("unroll") for (int _i = 0; _i < 2; ++_i) { int R_, C_; stage_rc(tid * 16 + _i * 8192, R_, C_); \
        dst[_h][_i] = (unsigned)(S.arow(un, _h * HALF + R_) * K) * (unsigned)ESZ + (unsigned)C_ * 2u; } } } while (0)
#define PG8_STAGE_A(bufoff, abase, half, nx) do { if constexpr (Sched::GATHER) { unsigned vo_[2]; vo_[0] = (nx) ? vn[half][0] : vc[half][0]; vo_[1] = (nx) ? vn[half][1] : vc[half][1]; PG8_STAGE_R(bufoff, rsA, g.A, abase, vo_); } \
        else { PG8_STAGE_R(bufoff, rsA, g.A, (abase) + (half) * hstep, voffA); } } while (0)
    const size_t kstep = (size_t)(BK * 2);
    const size_t hstep = (size_t)HALF * K * ESZ;
    const size_t tstep = 2 * hstep;
    const unsigned ldsw = (unsigned)wid * 1024u;
    const int aoff = lds_byte(wr * 64 + fr, fq * 8), boff = lds_byte(wc * 32 + fr, fq * 8);
    const int aoffE = lds_byte(wr * 64 + fr, fq * 16), boffE = lds_byte(wc * 32 + fr, fq * 16);
#define PG8_SA(b, h) (((b) * 2 + (h)) * HTB)
#define PG8_SB(b, h) ((4 + (b) * 2 + (h)) * HTB)
#define PG8_STAGE_R(bufoff, rs, b0, gbase, voff) do { const int so_ = (int)((const char*)(gbase) - (const char*)(b0)); _Pragma("unroll") for (int _i = 0; _i < 2; ++_i) \
        __builtin_amdgcn_raw_ptr_buffer_load_lds(rs, (PG8_LAS void*)(lds + (bufoff) + ldsw + _i * 8192), 16, (int)(voff)[_i], so_, 0, 0); } while (0)
#define PG8_STAGE(bufoff, gbase, voff) PG8_STAGE_R(bufoff, rsB, g.Bt, gbase, voff)
#define PG8_LDA(dst, b, h) do { if constexpr (ESZ == 2) { _Pragma("unroll") for (int m = 0; m < 4; ++m) _Pragma("unroll") for (int k = 0; k < 2; ++k) dst[m][k] = *(const PG8_LAS bf16x8*)(lds + PG8_SA(b, h) + aoff + m * 2048 + k * 1024); } \
        else { _Pragma("unroll") for (int m = 0; m < 4; ++m) { dst##8[m].lo = *(const PG8_LAS i32x4*)(lds + PG8_SA(b, h) + aoffE + m * 2048); dst##8[m].hi = *(const PG8_LAS i32x4*)(lds + PG8_SA(b, h) + aoffE + 16 + m * 2048); } } } while (0)
#define PG8_LDB(dst, b, h) do { if constexpr (ESZ == 2) { _Pragma("unroll") for (int n = 0; n < 2; ++n) _Pragma("unroll") for (int k = 0; k < 2; ++k) dst[n][k] = *(const PG8_LAS bf16x8*)(lds + PG8_SB(b, h) + boff + n * 2048 + k * 1024); } \
        else { _Pragma("unroll") for (int n = 0; n < 2; ++n) { dst##8[n].lo = *(const PG8_LAS i32x4*)(lds + PG8_SB(b, h) + boffE + n * 2048); dst##8[n].hi = *(const PG8_LAS i32x4*)(lds + PG8_SB(b, h) + boffE + 16 + n * 2048); } } } while (0)
#define PG8_MMA(ai, bj, At, Bt) do { __builtin_amdgcn_s_setprio(1); _Pragma("unroll") for (int m = 0; m < 4; ++m) _Pragma("unroll") for (int n = 0; n < 2; ++n) { if constexpr (ESZ == 2) { _Pragma("unroll") for (int k = 0; k < 2; ++k) \
        acc[ai][bj][m][n] = __builtin_amdgcn_mfma_f32_16x16x32_bf16(Bt[n][k], At[m][k], acc[ai][bj][m][n], 0, 0, 0); } else { \
        acc[ai][bj][m][n] = __builtin_amdgcn_mfma_scale_f32_16x16x128_f8f6f4(Bt##8[n], At##8[m], acc[ai][bj][m][n], 0, 0, 0, Epi::WSCALE, 0, 0x7f7f7f7f); } } __builtin_amdgcn_s_setprio(0); } while (0)
#define PG8_WAIT_V(n) asm volatile("s_waitcnt vmcnt(" #n ")" ::: "memory")
#define PG8_WAIT_L(n) asm volatile("s_waitcnt lgkmcnt(" #n ")" ::: "memory")
#define PG8_BAR __builtin_amdgcn_s_barrier()
#define PG8_SCHED __builtin_amdgcn_sched_barrier(0)
    Unit cur, nxt; int ui = 0;
    if (!S.next(0, cur)) return;
    f32x4 acc[2][2][4][2];
#pragma unroll
    for (int a = 0; a < 2; ++a)
#pragma unroll
        for (int b = 0; b < 2; ++b)
#pragma unroll
            for (int m = 0; m < 4; ++m)
#pragma unroll
                for (int n = 0; n < 2; ++n) acc[a][b][m][n] = (f32x4){0.f, 0.f, 0.f, 0.f};
    bf16x8 At[4][2], B0[2][2], B1[2][2];
    i32x8 At8[4], B08[2], B18[2];
    const char* cA = (const char*)g.A + (Sched::GATHER ? (size_t)0 : (size_t)cur.pm * tstep); const char* cB = (const char*)g.Bt + (size_t)cur.pn * tstep;
    PG8_ROWS(vc, cur);
    S.a_ready(cur);
    if constexpr (SP2) {
        PG8_STAGE(PG8_SB(0, 0), cB, voffB); PG8_STAGE(PG8_SB(0, 1), cB + hstep, voffB); PG8_STAGE_A(PG8_SA(0, 0), cA, 0, false); PG8_STAGE_A(PG8_SA(0, 1), cA, 1, false);
        if (wr == 1) PG8_BAR;
        PG8_WAIT_V(2); PG8_BAR;
        PG8_STAGE(PG8_SB(1, 0), cB + kstep, voffB); PG8_STAGE_A(PG8_SA(1, 0), cA + kstep, 0, false); PG8_STAGE(PG8_SB(1, 1), cB + hstep + kstep, voffB);
        PG8_WAIT_V(6); PG8_BAR;
    } else {
        PG8_STAGE(PG8_SB(0, 0), cB, voffB); PG8_STAGE_A(PG8_SA(0, 0), cA, 0, false); PG8_STAGE(PG8_SB(0, 1), cB + hstep, voffB); PG8_STAGE_A(PG8_SA(0, 1), cA, 1, false);
        if (wr == 1) PG8_BAR;
        PG8_WAIT_V(4); PG8_BAR;
        PG8_STAGE(PG8_SB(1, 0), cB + kstep, voffB); PG8_STAGE_A(PG8_SA(1, 0), cA + kstep, 0, false); PG8_STAGE(PG8_SB(1, 1), cB + hstep + kstep, voffB);
        PG8_WAIT_V(6); PG8_BAR;
    }
    for (;;) {
        const bool has_next = S.next(ui + 1, nxt);
        if (has_next) PG8_ROWS(vn, nxt);
        const char* nA = (has_next && !Sched::GATHER) ? (const char*)g.A + (size_t)nxt.pm * tstep : cA; const char* nB = has_next ? (const char*)g.Bt + (size_t)nxt.pn * tstep : cB;
        for (int t = 0; t < nt; t += 2) {
            const bool last = (t == nt - 2);
            const char* a1 = cA + (size_t)(t + 1) * kstep;
            const char* a2 = last ? nA : cA + (size_t)(t + 2) * kstep; const char* b2 = last ? nB : cB + (size_t)(t + 2) * kstep;
            const char* a3 = a2 + kstep; const char* b3 = b2 + kstep;
            if (last && has_next) S.a_ready(nxt);
            if constexpr (Epi::MIDK > 0) { if (t == Epi::MIDK || t == 2 * Epi::MIDK) E.mid(acc, cur, t / Epi::MIDK, wr, wc, fr, fq); }
            if constexpr (SP2) {
            PG8_LDB(B0, 0, 0); PG8_LDB(B1, 0, 1); PG8_SCHED; PG8_LDA(At, 0, 0); PG8_STAGE_A(PG8_SA(1, 1), a1, 1, false);
            PG8_WAIT_V(8); PG8_WAIT_L(0); PG8_BAR; PG8_MMA(0, 0, At, B0); PG8_MMA(0, 1, At, B1); PG8_BAR; PG8_SCHED;
            PG8_LDA(At, 0, 1); PG8_STAGE(PG8_SB(0, 0), b2, voffB); PG8_STAGE(PG8_SB(0, 1), b2 + hstep, voffB); PG8_STAGE_A(PG8_SA(0, 0), a2, 0, last);
            PG8_WAIT_V(8); PG8_WAIT_L(0); PG8_BAR; PG8_MMA(1, 0, At, B0); PG8_MMA(1, 1, At, B1); PG8_BAR; PG8_SCHED;
            PG8_LDB(B0, 1, 0); PG8_LDB(B1, 1, 1); PG8_SCHED; PG8_LDA(At, 1, 0); PG8_STAGE_A(PG8_SA(0, 1), a2, 1, last);
            PG8_WAIT_V(8); PG8_WAIT_L(0); PG8_BAR; PG8_MMA(0, 0, At, B0); PG8_MMA(0, 1, At, B1); PG8_BAR; PG8_SCHED;
            PG8_LDA(At, 1, 1); PG8_STAGE(PG8_SB(1, 0), b3, voffB); PG8_STAGE(PG8_SB(1, 1), b3 + hstep, voffB); PG8_STAGE_A(PG8_SA(1, 0), a3, 0, last);
            PG8_WAIT_V(8); PG8_WAIT_L(0); PG8_BAR; PG8_MMA(1, 0, At, B0); PG8_MMA(1, 1, At, B1); PG8_BAR; PG8_SCHED;
            } else {
            PG8_LDB(B0, 0, 0); PG8_SCHED; PG8_LDA(At, 0, 0); PG8_STAGE_A(PG8_SA(1, 1), a1, 1, false);
            PG8_WAIT_L(8); PG8_BAR; PG8_WAIT_L(0); PG8_MMA(0, 0, At, B0); PG8_BAR; PG8_SCHED;
            PG8_LDB(B1, 0, 1); PG8_STAGE(PG8_SB(0, 0), b2, voffB);
            PG8_BAR; PG8_WAIT_L(0); PG8_MMA(0, 1, At, B1); PG8_BAR;
            PG8_LDA(At, 0, 1); PG8_STAGE_A(PG8_SA(0, 0), a2, 0, last);
            PG8_BAR; PG8_WAIT_L(0); PG8_MMA(1, 0, At, B0); PG8_BAR; PG8_SCHED;
            PG8_STAGE(PG8_SB(0, 1), b2 + hstep, voffB);
            PG8_WAIT_V(6); PG8_BAR; PG8_MMA(1, 1, At, B1); PG8_BAR;
            PG8_LDB(B0, 1, 0); PG8_SCHED; PG8_LDA(At, 1, 0); PG8_STAGE_A(PG8_SA(0, 1), a2, 1, last);
            PG8_WAIT_L(8); PG8_BAR; PG8_WAIT_L(0); PG8_MMA(0, 0, At, B0); PG8_BAR; PG8_SCHED;
            PG8_LDB(B1, 1, 1); PG8_STAGE(PG8_SB(1, 0), b3, voffB);
            PG8_BAR; PG8_WAIT_L(0); PG8_MMA(0, 1, At, B1); PG8_BAR;
            PG8_LDA(At, 1, 1); PG8_STAGE_A(PG8_SA(1, 0), a3, 0, last);
            PG8_BAR; PG8_WAIT_L(0); PG8_MMA(1, 0, At, B0); PG8_BAR; PG8_SCHED;
            PG8_STAGE(PG8_SB(1, 1), b3 + hstep, voffB);
            PG8_WAIT_V(6); PG8_BAR; PG8_MMA(1, 1, At, B1); PG8_BAR;
            }
        }
        if constexpr (ALIGN_EPI) { if (wr == 0) PG8_BAR; }
        if constexpr (!Epi::AFTER_DRAIN) { E(acc, cur, wr, wc, fr, fq); S.done(cur); }
        if (!has_next) break;
#pragma unroll
        for (int a = 0; a < 2; ++a)
#pragma unroll
            for (int b = 0; b < 2; ++b)
#pragma unroll
                for (int m = 0; m < 4; ++m)
#pragma unroll
                    for (int n = 0; n < 2; ++n) acc[a][b][m][n] = (f32x4){0.f, 0.f, 0.f, 0.f};
        cur = nxt; cA = nA; cB = nB; ++ui;
        if constexpr (Sched::GATHER) { vc[0][0] = vn[0][0]; vc[0][1] = vn[0][1]; vc[1][0] = vn[1][0]; vc[1][1] = vn[1][1]; }
        if constexpr (ALIGN_EPI) { if (wr == 1) PG8_BAR; }
    }
    PG8_WAIT_V(0);
    if constexpr (!ALIGN_EPI) { if (wr == 0) PG8_BAR; }
    PG8_BAR;
    if constexpr (Epi::AFTER_DRAIN) { E.fused(acc, cur, wr, wc, fr, fq, lds, wid, lane); S.done(cur); }
#undef PG8_SA
#undef PG8_SB
#undef PG8_STAGE
#undef PG8_STAGE_R
#undef PG8_STAGE_A
#undef PG8_ROWS
#undef PG8_LDA
#undef PG8_LDB
#undef PG8_MMA
#undef PG8_WAIT_V
#undef PG8_WAIT_L
#undef PG8_BAR
#undef PG8_SCHED
}
}

constexpr int NWAVES = 8;
constexpr int BATCH = 2, SEQ = 8192, T = BATCH * SEQ, D = 2048;
constexpr int RWKV_COLS = 3360, IN_COLS = 12576;
constexpr int NP = 12800;
constexpr int PC_LX = 3584, PC_LY = 4608, PC_Q = 5632, PC_G = 6656;
constexpr int NE = 32, MAXROWS = 65536 + NE * 256;
constexpr int LORA_K = 384;
constexpr float EPS = 1e-6f, GN_EPS = 64e-5f;

constexpr size_t MiB = 1u << 20;
constexpr size_t WS_CTL = 0, CTL_ZERO_BYTES = 1 * MiB;
constexpr size_t WS_WIN = 1 * MiB, WS_WMKV = 51 * MiB, WS_WLORA = 59 * MiB, WS_WBR = 62 * MiB, WS_WO = 74 * MiB, WS_WR = 82 * MiB, WS_LW = 83 * MiB;
constexpr size_t WS_WGU = 84 * MiB, WS_WD = 596 * MiB;
constexpr size_t WS_WIN8 = WS_WIN + 27 * MiB;
constexpr size_t WS_XN8 = 1508 * MiB;
constexpr size_t WS_XN = 852 * MiB;
constexpr size_t WS_P = 916 * MiB;
constexpr size_t WS_LORAOUT = 1316 * MiB;
constexpr size_t WS_SCAN = 1508 * MiB;
constexpr size_t WS_YABC = 1892 * MiB;
constexpr size_t WS_MISC = 1988 * MiB;
constexpr size_t WS_MN = WS_MISC, WS_KMEM = WS_MISC + 2 * MiB, WS_VT = WS_MISC + 3 * MiB, WS_LRUC = WS_MISC + 4 * MiB  , WS_BONUS = WS_MISC + 7 * MiB;
constexpr size_t WS_PICK = WS_MISC + 8 * MiB  , WS_ROWTAB = WS_MISC + 9 * MiB  , WS_SPL = WS_ROWTAB + 512 * 1024  ;
constexpr size_t WS_END = 2000 * MiB;
constexpr size_t WS_MACC = WS_LORAOUT, WS_MERGED = 1444 * MiB, WS_H1 = WS_SCAN, WS_XS = WS_P, WS_OROW = WS_P, WS_HH = 1204 * MiB;
constexpr int CW_BAR = 4096, CW_CNT = 8192, CW_NTILES = 8192 + 64, CW_TILEE = 8192 + 128;

constexpr int LDS_BYTES = 147456;
constexpr int MISC_OFF = 143360;

#define GAS __attribute__((address_space(1)))
#define LAS __attribute__((address_space(3)))
typedef unsigned short bf16;
typedef unsigned v4u __attribute__((ext_vector_type(4)));
typedef unsigned v2u __attribute__((ext_vector_type(2)));
typedef float f32x4 __attribute__((ext_vector_type(4)));
typedef float f32x2 __attribute__((ext_vector_type(2)));
typedef short bf16x8 __attribute__((ext_vector_type(8)));
#define LDS_WAIT() asm volatile("s_waitcnt lgkmcnt(0)" ::: "memory")
#define VM_WAIT() asm volatile("s_waitcnt vmcnt(0)" ::: "memory")
__device__ __forceinline__ unsigned f2bf(float f) { unsigned u = __builtin_bit_cast(unsigned, f); return (u + 0x7fffu + ((u >> 16) & 1u)) >> 16; }
__device__ __forceinline__ unsigned pk2(float lo, float hi) { return f2bf(lo) | (f2bf(hi) << 16); }
__device__ __forceinline__ float bflo(unsigned w) { return __builtin_bit_cast(float, w << 16); }
__device__ __forceinline__ float bfhi(unsigned w) { return __builtin_bit_cast(float, w & 0xffff0000u); }
__device__ __forceinline__ float bf1(bf16 b) { return __builtin_bit_cast(float, (unsigned)b << 16); }
__device__ __forceinline__ float sigm(float x) { return __builtin_amdgcn_rcpf(1.0f + __expf(-x)); }
__device__ __forceinline__ float fast_tanh(float x) { const float e = __expf(2.0f * x); return 1.0f - 2.0f * __builtin_amdgcn_rcpf(e + 1.0f); }
__device__ __forceinline__ float softplusf(float x) { return fmaxf(x, 0.f) + log1pf(__expf(-fabsf(x))); }
__device__ __forceinline__ float wave_sum(float v) {
#pragma unroll
    for (int o = 1; o < 64; o <<= 1) v += __shfl_xor(v, o);
    return v;
}
template <int CTRL> __device__ __forceinline__ float dppf(float x) { return __builtin_bit_cast(float, __builtin_amdgcn_mov_dpp(__builtin_bit_cast(int, x), CTRL, 0xf, 0xf, true)); }
__device__ __forceinline__ float row16_sum(float v) {
    v += dppf<0xB1>(v); v += dppf<0x4E>(v); v += dppf<0x141>(v); v += dppf<0x140>(v); return v;
}
#define XB_TMO      128
#define XB_XCNT(j)  (256  + 64 * (j))
#define XB_XSUB(j)  (1280 + 64 * (j))
#define XB_XGEN(j)  (2304 + 64 * (j))
#define XB_TOP      3328
#define XB_TOPGEN   3392
#define XCD_BAR_WORDS 3456
#define XB_SPIN_CAP (1u << 18)

__device__ __forceinline__ unsigned xb_ld(unsigned* p)              { return __hip_atomic_load(p, __ATOMIC_RELAXED, __HIP_MEMORY_SCOPE_AGENT); }
__device__ __forceinline__ unsigned xb_add(unsigned* p, unsigned v) { return __hip_atomic_fetch_add(p, v, __ATOMIC_RELAXED, __HIP_MEMORY_SCOPE_AGENT); }
__device__ __forceinline__ unsigned xb_xcc_id() { return (unsigned)__builtin_amdgcn_s_getreg((3 << 11) | 20) & 0xFu; }
#define XB_SPIN(cond, bar) do { unsigned _sp = 0; while (cond) { __builtin_amdgcn_s_sleep(1); \
    if ((++_sp & 255u) == 0u) { if (xb_ld(&(bar)[XB_TMO])) break; if (_sp > XB_SPIN_CAP) { atomicAdd(&(bar)[XB_TMO], 1u); break; } } } } while (0)

struct XcdBarrier {
    unsigned* bar; unsigned x;
    volatile LAS unsigned* st;
};

__device__ __forceinline__ XcdBarrier xcd_barrier_post(unsigned* bar, volatile LAS unsigned* st) {
    XcdBarrier b; b.bar = bar; b.x = xb_xcc_id(); b.st = st;
    if (threadIdx.x == 0) (void)xb_add(&bar[XB_XCNT(b.x)], 1u);
    return b;
}
__device__ __forceinline__ void xcd_barrier_complete(unsigned* bar, unsigned x, unsigned& nloc, unsigned& nx) {
    const unsigned G = gridDim.x * gridDim.y * gridDim.z;
    unsigned sum, cnt, mine, sp = 0u;
    for (;;) {
        sum = 0u; cnt = 0u; mine = 0u;
#pragma unroll
        for (unsigned j = 0; j < 16; ++j) { const unsigned c = xb_ld(&bar[XB_XCNT(j)]); sum += c; cnt += (c > 0u) ? 1u : 0u; mine = (j == x) ? c : mine; }
        if (sum == G) break;
        __builtin_amdgcn_s_sleep(1);
        if ((++sp & 255u) == 0u) { if (xb_ld(&bar[XB_TMO])) break; if (sp > XB_SPIN_CAP) { atomicAdd(&bar[XB_TMO], 1u); break; } }
    }
    nloc = mine > 0u ? mine : 1u; nx = cnt > 0u ? cnt : 1u;
}

__device__ __forceinline__ void xcd_barrier(const XcdBarrier& b) {
    asm volatile("s_waitcnt vmcnt(0)" ::: "memory");
    __syncthreads();
    if (threadIdx.x == 0) {
        unsigned* bar = b.bar;
        __builtin_amdgcn_s_waitcnt(0);
        unsigned nloc = b.st[0], nx = b.st[1];
        if (nloc == 0u) { xcd_barrier_complete(bar, b.x, nloc, nx); b.st[0] = nloc; b.st[1] = nx; }
        const unsigned old = xb_add(&bar[XB_XSUB(b.x)], 1u);
        const unsigned gen = old / nloc;
        if (old + 1u == (gen + 1u) * nloc) {
            __builtin_amdgcn_fence(__ATOMIC_RELEASE, "agent");
            asm volatile("s_waitcnt vmcnt(0)" ::: "memory");
            const unsigned og = xb_add(&bar[XB_TOP], 1u);
            const unsigned tg = og / nx;
            if (og + 1u == (tg + 1u) * nx) xb_add(&bar[XB_TOPGEN], 1u);
            else XB_SPIN(xb_ld(&bar[XB_TOPGEN]) == tg, bar);
            __builtin_amdgcn_fence(__ATOMIC_ACQUIRE, "agent");
            xb_add(&bar[XB_XGEN(b.x)], 1u);
            asm volatile("s_waitcnt vmcnt(0)" ::: "memory");
        } else {
            XB_SPIN(xb_ld(&bar[XB_XGEN(b.x)]) == gen, bar);
            __builtin_amdgcn_fence(__ATOMIC_ACQUIRE, "agent");
            asm volatile("s_waitcnt vmcnt(0)" ::: "memory");
        }
    }
    __syncthreads();
}

struct Frame {
    LAS unsigned char* lds;
    volatile LAS unsigned* MISC;
    int tid, lane, wave, vcu, G;
};
struct Args { const float* in[39]; float* out; unsigned char* ws; int ph_lo, ph_hi; };
enum { I_X = 0, I_MEM, I_GMIX, I_WIN, I_MU, I_W0, I_W2, I_A0, I_A2, I_G2, I_KK, I_KA, I_RK, I_LNW, I_LNB, I_WRO, I_CONVW, I_CONVB, I_LWR, I_LBR, I_LWI, I_LBI, I_LAM, I_WLO,
       I_GMEM, I_WMK, I_WMV, I_WXO, I_WOUT, I_GFFN, I_WROUTER, I_BROUTER, I_WGATE, I_BGATE, I_WUP, I_BUP, I_WDOWN, I_BDOWN, I_GFINAL };


__device__ __forceinline__ const float* inp(int k) {
    typedef const volatile unsigned long long __attribute__((address_space(4))) ka_t;
    ka_t* ka = (ka_t*)__builtin_amdgcn_kernarg_segment_ptr();
    return (const float*)ka[k];
}
template <int NB> __device__ __forceinline__ void transpose_item(const float* W, int N, int k0, int n0, bf16* WT, int Kd, int drow0, int lane, int kdo = 0) {
    constexpr int LPR = NB / 4, G = 64 / LPR, KR = 64 / G;
    const int g = lane / LPR, c = lane % LPR;
    const GAS float* src = (const GAS float*)W + (size_t)(k0 + KR * g) * N + n0 + 4 * c;
    f32x4 ld[KR];
#pragma unroll
    for (int i = 0; i < KR; ++i) ld[i] = __builtin_nontemporal_load((const GAS f32x4*)(src + (size_t)i * N));
    GAS bf16* dst = (GAS bf16*)WT + (size_t)(drow0 + 4 * c) * Kd + kdo + k0 + KR * g;
#pragma unroll
    for (int j = 0; j < 4; ++j)
#pragma unroll
        for (int q = 0; q < KR / 8; ++q) { v4u o; o.x = pk2(ld[8 * q + 0][j], ld[8 * q + 1][j]); o.y = pk2(ld[8 * q + 2][j], ld[8 * q + 3][j]); o.z = pk2(ld[8 * q + 4][j], ld[8 * q + 5][j]); o.w = pk2(ld[8 * q + 6][j], ld[8 * q + 7][j]);
            *(GAS v4u*)(dst + (size_t)j * Kd + 8 * q) = o; }
}
__device__ __forceinline__ unsigned pk4_fp8(float a, float b, float c, float d) { int w = __builtin_amdgcn_cvt_pk_fp8_f32(a, b, 0, false); w = __builtin_amdgcn_cvt_pk_fp8_f32(c, d, w, true); return (unsigned)w; }
__device__ __forceinline__ void transpose_item_fp8(const float* W, int N, int k0, int n0, unsigned char* WT, int Kd, int drow0, int lane, float scale) {
    const int g = lane >> 4, c = lane & 15;
    const GAS float* src = (const GAS float*)W + (size_t)(k0 + 16 * g) * N + n0 + 4 * c;
    f32x4 ld[16];
#pragma unroll
    for (int i = 0; i < 16; ++i) ld[i] = __builtin_nontemporal_load((const GAS f32x4*)(src + (size_t)i * N)) * scale;
    GAS unsigned char* dst = (GAS unsigned char*)WT + (size_t)(drow0 + 4 * c) * Kd + k0 + 16 * g;
#pragma unroll
    for (int j = 0; j < 4; ++j) { v4u o; o.x = pk4_fp8(ld[0][j], ld[1][j], ld[2][j], ld[3][j]); o.y = pk4_fp8(ld[4][j], ld[5][j], ld[6][j], ld[7][j]); o.z = pk4_fp8(ld[8][j], ld[9][j], ld[10][j], ld[11][j]); o.w = pk4_fp8(ld[12][j], ld[13][j], ld[14][j], ld[15][j]);
        *(GAS v4u*)(dst + (size_t)j * Kd) = o; }
}
__device__ __forceinline__ void transpose_item_fp8_32(const float* W, int N, int k0, int n0, unsigned char* WT, int Kd, int drow0, int lane, float scale) {
    const int g = lane >> 3, c = lane & 7;
    const GAS float* src = (const GAS float*)W + (size_t)(k0 + 8 * g) * N + n0 + 4 * c;
    f32x4 ld[8];
#pragma unroll
    for (int i = 0; i < 8; ++i) ld[i] = __builtin_nontemporal_load((const GAS f32x4*)(src + (size_t)i * N)) * scale;
    GAS unsigned char* dst = (GAS unsigned char*)WT + (size_t)(drow0 + 4 * c) * Kd + k0 + 8 * g;
#pragma unroll
    for (int j = 0; j < 4; ++j) { v2u o; o.x = pk4_fp8(ld[0][j], ld[1][j], ld[2][j], ld[3][j]); o.y = pk4_fp8(ld[4][j], ld[5][j], ld[6][j], ld[7][j]); *(GAS v2u*)(dst + (size_t)j * Kd) = o; }
}
__device__ __forceinline__ void rms_row_to_bf16(const float* xrow, const float* gain, bf16* orow, int lane, unsigned char* orow8 = nullptr) {
    const GAS f32x4* xr = (const GAS f32x4*)xrow + lane; const GAS f32x4* gr = (const GAS f32x4*)gain + lane;
    f32x4 v[8]; float s = 0.f;
#pragma unroll
    for (int j = 0; j < 8; ++j) { v[j] = xr[64 * j]; s += (v[j].x * v[j].x + v[j].y * v[j].y) + (v[j].z * v[j].z + v[j].w * v[j].w); }
    const float rstd = 1.0f / sqrtf(wave_sum(s) * (1.f / D) + EPS);
    GAS v2u* o8 = (GAS v2u*)orow + lane;
#pragma unroll
    for (int j = 0; j < 8; ++j) { const f32x4 g = gr[64 * j]; v2u w; w.x = pk2(v[j].x * rstd * g.x, v[j].y * rstd * g.y); w.y = pk2(v[j].z * rstd * g.z, v[j].w * rstd * g.w); o8[64 * j] = w;
        if (orow8) ((GAS unsigned*)orow8)[lane + 64 * j] = pk4_fp8(v[j].x * rstd * g.x, v[j].y * rstd * g.y, v[j].z * rstd * g.z, v[j].w * rstd * g.w); }
}

__device__ __forceinline__ void p0_prologue(const Frame& F, const Args& a) {
    unsigned char* ws = a.ws;
    const int gw = F.vcu * NWAVES + F.wave, NGW = F.G * NWAVES;
    constexpr int I_IN = 32 * (IN_COLS / 32), I_MK = 32 * 32, I_BR = 16 * 64, I_O = 32 * 64;
    constexpr int NITEMS = I_IN + 2 * I_MK + 3 * I_BR + I_O;
    for (int it = gw; it < NITEMS; it += NGW) {
        int r = it;
        if (r < I_IN) { const int nb = IN_COLS / 32, kb = r / nb, n0 = 32 * (r % nb);
            if (n0 >= PC_G - 224) transpose_item_fp8_32(inp(I_WIN), IN_COLS, 64 * kb, n0, ws + WS_WIN8, D, n0 - (PC_G - 224), F.lane, 64.0f);
            else transpose_item<32>(inp(I_WIN), IN_COLS, 64 * kb, n0, (bf16*)(ws + WS_WIN), D, n0 + (n0 >= RWKV_COLS ? 224 : 0), F.lane);
            continue; } r -= I_IN;
        if (r < I_MK) { transpose_item<32>(inp(I_WMK), 1024, 64 * (r / 32), 32 * (r % 32), (bf16*)(ws + WS_WMKV), D, 32 * (r % 32), F.lane); continue; } r -= I_MK;
        if (r < I_MK) { transpose_item<32>(inp(I_WMV), 1024, 64 * (r / 32), 32 * (r % 32), (bf16*)(ws + WS_WMKV), D, 1024 + 32 * (r % 32), F.lane); continue; } r -= I_MK;
        if (r < I_BR) { transpose_item<32>(inp(I_WRO), 2048, 64 * (r / 64), 32 * (r % 64), (bf16*)(ws + WS_WBR), 3072, 32 * (r % 64), F.lane, 0); continue; } r -= I_BR;
        if (r < I_BR) { transpose_item<32>(inp(I_WLO), 2048, 64 * (r / 64), 32 * (r % 64), (bf16*)(ws + WS_WBR), 3072, 32 * (r % 64), F.lane, 1024); continue; } r -= I_BR;
        if (r < I_BR) { transpose_item<32>(inp(I_WXO), 2048, 64 * (r / 64), 32 * (r % 64), (bf16*)(ws + WS_WBR), 3072, 32 * (r % 64), F.lane, 2048); continue; } r -= I_BR;
        transpose_item<32>(inp(I_WOUT), 2048, 64 * (r / 64), 32 * (r % 64), (bf16*)(ws + WS_WO), D, 32 * (r % 64), F.lane);
    }
    for (int m = gw; m < T; m += NGW) rms_row_to_bf16(inp(I_X) + (size_t)m * D, inp(I_GMIX), (bf16*)(ws + WS_XN) + (size_t)m * D, F.lane, ws + WS_XN8 + (size_t)m * D);
    for (int m = gw; m < 512; m += NGW) rms_row_to_bf16(inp(I_MEM) + (size_t)m * D, inp(I_GMEM), (bf16*)(ws + WS_MN) + (size_t)m * D, F.lane);
    const int gt = F.vcu * (NWAVES * 64) + F.tid, NGT = F.G * NWAVES * 64;
    { bf16* wz = (bf16*)(ws + WS_WIN) + (size_t)RWKV_COLS * D; for (int i = gt; i < 224 * D / 2; i += NGT) ((GAS unsigned*)wz)[i] = 0u; }
    { bf16* wl = (bf16*)(ws + WS_WLORA);
      for (int i = gt; i < 3072 * LORA_K; i += NGT) { const int n = i / LORA_K, k = i % LORA_K; float v = 0.f;
          if (n < 1024) { if (k < 64) v = inp(I_W2)[k * 1024 + n]; }
          else if (n < 2048) { if (k >= 64 && k < 128) v = inp(I_A2)[(k - 64) * 1024 + (n - 1024)]; }
          else { if (k >= 128 && k < 288) v = inp(I_G2)[(k - 128) * 1024 + (n - 2048)]; }
          wl[i] = (bf16)f2bf(v); } }
    { const float* lam = inp(I_LAM); float* spl = (float*)(ws + WS_SPL); for (int i = gt; i < 1024; i += NGT) spl[i] = softplusf(-lam[i]); }
    { bf16* wr = (bf16*)(ws + WS_WR);
      for (int i = gt; i < 32 * D; i += NGT) { const int e = i / D, k = i % D; const float w = inp(I_WROUTER)[k * 32 + e]; const unsigned hi = f2bf(w); const float r = w - __builtin_bit_cast(float, hi << 16);
          wr[i] = (bf16)hi; wr[32 * D + i] = (bf16)f2bf(r); } }
    { const float* lwi_p = inp(I_LWI); const float* lwr_p = inp(I_LWR); bf16* lw = (bf16*)(ws + WS_LW);
      for (int i = gt; i < 2 * 16 * 4 * 2 * 64 * 8; i += NGT) { const int j = i & 7, ln = (i >> 3) & 63, ks = (i >> 9) & 1, vbo = (i >> 10) & 3, n = (i >> 12) & 15, mat = i >> 16;
          const int w = 32 * ks + 16 * (j >> 2) + 4 * (ln >> 4) + (j & 3), v = 16 * vbo + (ln & 15);
          lw[i] = (bf16)f2bf((mat ? lwi_p : lwr_p)[(n * 64 + w) * 64 + v]); } }
}

__device__ __forceinline__ void moe_weight_convert(const Frame& F, const Args& a, int gw, int NGW) {
    unsigned char* ws = a.ws;
    const float* wg = inp(I_WGATE); const float* wu = inp(I_WUP); const float* wd = inp(I_WDOWN);
    constexpr int PER = 1024;
    for (int it = gw; it < NE * 3 * PER; it += NGW) {
        const int e = it / (3 * PER), r = it % (3 * PER), which = r / PER, q = r % PER, k0 = 64 * (q / 32), n0 = 64 * (q % 32);
        if (which == 0) transpose_item_fp8(wg + (size_t)e * D * D, D, k0, n0, ws + WS_WGU + (size_t)e * 4096 * D, D, (n0 >> 7) * 256 + (n0 & 127), F.lane, 64.0f);
        else if (which == 1) transpose_item_fp8(wu + (size_t)e * D * D, D, k0, n0, ws + WS_WGU + (size_t)e * 4096 * D, D, (n0 >> 7) * 256 + 128 + (n0 & 127), F.lane, 64.0f);
        else transpose_item_fp8(wd + (size_t)e * D * D, D, k0, n0, ws + WS_WD + (size_t)e * 2048 * D, D, n0, F.lane, 64.0f);
    }
}

__device__ __forceinline__ void r1_lora_in(const Frame& F, const Args& a) {
    const bf16* P = (const bf16*)(a.ws + WS_P); bf16* L = (bf16*)(a.ws + WS_XN);
    const float* mu = inp(I_MU);
    const int gw = F.vcu * NWAVES + F.wave, NGW = F.G * NWAVES;
    for (int m = gw; m < T; m += NGW) {
        const bool first = (m % SEQ) == 0;
#pragma unroll
        for (int j = 0; j < 6; ++j) { const int k = F.lane + 64 * j; float o = 0.f;
            if (k < 288) { const int c = 3072 + k; const float cur = bf1(P[(size_t)m * NP + c]); const float prev = first ? 0.f : bf1(P[(size_t)(m - 1) * NP + c]);
                const float x = cur + (prev - cur) * mu[c]; o = k < 64 ? fast_tanh(x) : (k < 128 ? x : sigm(x)); }
            L[(size_t)m * LORA_K + k] = (bf16)f2bf(o); }
    }
}

constexpr int REC_F = 2816, REC_AT = 0, REC_RT = 512, REC_BKT = 1024, REC_WC = 2048, REC_N = 2112, REC_Q = 2176, REC_V8 = 2240;
__device__ __forceinline__ float wave_sum_fast(float v) { v = row16_sum(v); v += __shfl_xor(v, 16); v += __shfl_xor(v, 32); return v; }
__device__ __forceinline__ void r3_blocks(const Frame& F, const Args& a) {
    const GAS bf16* P = (const GAS bf16*)(a.ws + WS_P); const GAS float* LO = (const GAS float*)(a.ws + WS_LORAOUT);
    GAS float* REC = (GAS float*)(a.ws + WS_SCAN); GAS float* BON = (GAS float*)(a.ws + WS_BONUS);
    const GAS float* mu = (const GAS float*)inp(I_MU); const GAS float* w0 = (const GAS float*)inp(I_W0); const GAS float* a0 = (const GAS float*)inp(I_A0);
    const GAS float* kkp = (const GAS float*)inp(I_KK); const GAS float* kap = (const GAS float*)inp(I_KA); const GAS float* rkp = (const GAS float*)inp(I_RK);
    LAS float* G1 = (LAS float*)(F.lds + F.wave * 16384);
    LAS float* G2 = G1 + 2048;
    const int gw = F.vcu * NWAVES + F.wave, NGW = F.G * NWAVES, lane = F.lane;
#pragma unroll 1
    for (int it = gw; it < 32 * 1024; it += NGW) {
        const int bh = it >> 10, blk = it & 1023, b = bh >> 4, h = bh & 15, c = h * 64 + lane, m0 = b * SEQ + blk * 8;
        const float mur = mu[c], muk = mu[1024 + c], muv = mu[2048 + c], w0c = w0[c], a0c = a0[c], kkw = kkp[c], kaw = kap[c], rkw = rkp[c];
        float w[8], av[8], bv[8], kv[8], rv[8], vv[8], ag[8], kk[8], n2[8], bo[8];
        float pr = 0.f, pk = 0.f, pv = 0.f;
        if (blk > 0) { const GAS bf16* pp = P + (size_t)(m0 - 1) * NP; pr = bf1(pp[c]); pk = bf1(pp[1024 + c]); pv = bf1(pp[2048 + c]); }
#pragma unroll
        for (int t = 0; t < 8; ++t) { const GAS bf16* pc = P + (size_t)(m0 + t) * NP; const float cr = bf1(pc[c]), ck = bf1(pc[1024 + c]), cv = bf1(pc[2048 + c]);
            const float r = cr + (pr - cr) * mur, k = ck + (pk - ck) * muk, v = cv + (pv - cv) * muv; pr = cr; pk = ck; pv = cv;
            const float wpre = w0c + LO[(size_t)(m0 + t) * 3072 + c], apre = a0c + LO[(size_t)(m0 + t) * 3072 + 1024 + c];
            w[t] = __expf(-0.6065306597126334f * __builtin_amdgcn_rcpf(1.0f + __expf(-wpre)));
            ag[t] = __builtin_amdgcn_rcpf(1.0f + __expf(-apre));
            kk[t] = k * kkw; n2[t] = kk[t] * kk[t];
            kv[t] = k * (1.0f + (ag[t] - 1.0f) * kaw); rv[t] = r; vv[t] = v; bo[t] = r * kv[t] * rkw; }
#pragma unroll
        for (int t = 0; t < 8; ++t) { n2[t] = wave_sum_fast(n2[t]); bo[t] = wave_sum_fast(bo[t]); }
#pragma unroll
        for (int t = 0; t < 8; ++t) { const float kkn = kk[t] * (1.0f / sqrtf(fmaxf(n2[t], 1e-24f))); av[t] = -kkn; bv[t] = kkn * ag[t]; if (lane == 0) BON[(m0 + t) * 16 + h] = bo[t]; }
        float Pp[8]; Pp[0] = w[0];
#pragma unroll
        for (int t = 1; t < 8; ++t) Pp[t] = Pp[t - 1] * w[t];
        float bch[8], kch[8], ah[8], rh[8];
#pragma unroll
        for (int t = 0; t < 8; ++t) { const float pin = __builtin_amdgcn_rcpf(Pp[t]); bch[t] = bv[t] * pin; kch[t] = kv[t] * pin; ah[t] = av[t] * (t > 0 ? Pp[t - 1] : 1.0f); rh[t] = rv[t] * Pp[t]; }
        const int pos = (lane & 3) * 16 + (lane >> 2);
#pragma unroll
        for (int t = 0; t < 8; ++t) { G1[t * 64 + pos] = bch[t]; G1[(8 + t) * 64 + pos] = kch[t]; G1[(16 + t) * 64 + pos] = ah[t]; G1[(24 + t) * 64 + pos] = rh[t]; }
        LDS_WAIT(); asm volatile("" ::: "memory");
        f32x4 fa[4], fb[4];
#pragma unroll
        for (int q = 0; q < 4; ++q) { fa[q] = *(const LAS f32x4*)(G1 + (lane & 15) * 64 + (lane >> 4) * 16 + 4 * q); fb[q] = *(const LAS f32x4*)(G1 + (16 + (lane & 15)) * 64 + (lane >> 4) * 16 + 4 * q); }
        f32x4 dacc = {0.f, 0.f, 0.f, 0.f};
#pragma unroll
        for (int s2 = 0; s2 < 16; ++s2) dacc = __builtin_amdgcn_mfma_f32_16x16x4f32(fa[s2 >> 2][s2 & 3], fb[s2 >> 2][s2 & 3], dacc, 0, 0, 0);
        *(LAS f32x4*)(G2 + (lane & 15) * 16 + 4 * (lane >> 4)) = dacc;
        LDS_WAIT(); asm volatile("" ::: "memory");
        float M[8][8];
        { float Lm[8][8];
#pragma unroll
          for (int t = 1; t < 8; ++t) { const f32x4 l0 = *(const LAS f32x4*)(G2 + t * 16), l1 = *(const LAS f32x4*)(G2 + t * 16 + 4);
#pragma unroll
              for (int i = 0; i < 4; ++i) { Lm[t][i] = l0[i]; Lm[t][4 + i] = l1[i]; } }
#pragma unroll
          for (int t = 0; t < 8; ++t) { M[t][t] = 1.0f;
#pragma unroll
              for (int i = t - 1; i >= 0; --i) { float acc = 0.f;
#pragma unroll
                  for (int j = i; j < t; ++j) acc += Lm[t][j] * M[j][i];
                  M[t][i] = acc; } } }
        GAS float* rec = REC + ((size_t)bh * 1024 + blk) * REC_F;
#pragma unroll
        for (int t = 0; t < 8; ++t) { float acc = 0.f;
#pragma unroll
            for (int i = 0; i <= t; ++i) acc += M[t][i] * ah[i];
            rec[REC_AT + t * 64 + lane] = acc; }
        float Nm[8][8];
        { float Km[8][8];
#pragma unroll
          for (int t = 1; t < 8; ++t) { const f32x4 l0 = *(const LAS f32x4*)(G2 + t * 16 + 8), l1 = *(const LAS f32x4*)(G2 + t * 16 + 12);
#pragma unroll
              for (int i = 0; i < 4; ++i) { Km[t][i] = l0[i]; Km[t][4 + i] = l1[i]; } }
#pragma unroll
          for (int t = 0; t < 8; ++t)
#pragma unroll
              for (int i = 0; i < 8; ++i) { float acc = 0.f;
                  if (i < t) {
#pragma unroll
                      for (int j = i + 1; j <= t; ++j) acc += M[t][j] * Km[j][i]; }
                  Nm[t][i] = acc; } }
        float rb[8][8];
#pragma unroll
        for (int t = 0; t < 8; ++t) { const f32x4 l0 = *(const LAS f32x4*)(G2 + (8 + t) * 16), l1 = *(const LAS f32x4*)(G2 + (8 + t) * 16 + 4);
#pragma unroll
            for (int i = 0; i < 4; ++i) { rb[t][i] = l0[i]; rb[t][4 + i] = l1[i]; } }
#pragma unroll
        for (int t = 0; t < 8; ++t) { float acc = rh[t];
#pragma unroll
            for (int i = 0; i <= t; ++i) { float rm = 0.f;
#pragma unroll
                for (int j = i; j <= t; ++j) rm += rb[t][j] * M[j][i];
                acc += rm * ah[i]; }
            rec[REC_RT + t * 64 + lane] = acc; }
        float Qm[8][8];
#pragma unroll
        for (int t = 0; t < 8; ++t) { const f32x4 l0 = *(const LAS f32x4*)(G2 + (8 + t) * 16 + 8), l1 = *(const LAS f32x4*)(G2 + (8 + t) * 16 + 12);
#pragma unroll
            for (int i = 0; i < 8; ++i) { float acc = 0.f;
                if (i <= t) { acc = i < 4 ? l0[i & 3] : l1[i & 3];
#pragma unroll
                    for (int j = i + 1; j <= t; ++j) acc += rb[t][j] * Nm[j][i]; }
                Qm[t][i] = acc; } }
#pragma unroll
        for (int q4 = 0; q4 < 2; ++q4) { *(GAS f32x4*)(rec + REC_BKT + lane * 16 + 4 * q4) = (f32x4){bch[4 * q4] * Pp[7], bch[4 * q4 + 1] * Pp[7], bch[4 * q4 + 2] * Pp[7], bch[4 * q4 + 3] * Pp[7]};
            *(GAS f32x4*)(rec + REC_BKT + lane * 16 + 8 + 4 * q4) = (f32x4){kch[4 * q4] * Pp[7], kch[4 * q4 + 1] * Pp[7], kch[4 * q4 + 2] * Pp[7], kch[4 * q4 + 3] * Pp[7]}; }
        rec[REC_WC + lane] = Pp[7];
        if (lane == 0) {
#pragma unroll
            for (int t = 0; t < 8; ++t) { *(GAS f32x4*)(rec + REC_N + t * 8) = (f32x4){Nm[t][0], Nm[t][1], Nm[t][2], Nm[t][3]}; *(GAS f32x4*)(rec + REC_N + t * 8 + 4) = (f32x4){Nm[t][4], Nm[t][5], Nm[t][6], Nm[t][7]};
                *(GAS f32x4*)(rec + REC_Q + t * 8) = (f32x4){Qm[t][0], Qm[t][1], Qm[t][2], Qm[t][3]}; *(GAS f32x4*)(rec + REC_Q + t * 8 + 4) = (f32x4){Qm[t][4], Qm[t][5], Qm[t][6], Qm[t][7]}; } }
        *(GAS f32x4*)(rec + REC_V8 + lane * 8) = (f32x4){vv[0], vv[1], vv[2], vv[3]}; *(GAS f32x4*)(rec + REC_V8 + lane * 8 + 4) = (f32x4){vv[4], vv[5], vv[6], vv[7]};
        LDS_WAIT(); asm volatile("" ::: "memory");
    }
}

constexpr int SC_NS = 12, SC_RB = REC_F * 4, SC_SYNC = SC_NS * SC_RB;
__device__ __forceinline__ unsigned lds_word(const volatile LAS unsigned* p) { return (unsigned)__builtin_amdgcn_readfirstlane((int)*p); }
__device__ __forceinline__ bool scan_wg(int& bh, int& quarter) { const int bx = blockIdx.x; if (gridDim.x != 256 || ((bx >> 3) & 1)) return false; const int slot = bx >> 4; bh = (bx & 7) * 4 + (slot >> 2); quarter = slot & 3; return true; }
__device__ __forceinline__ void r4_feeder(const Frame& F, const Args& a, int bh) {
    const GAS char* gsrc = (const GAS char*)(a.ws + WS_SCAN) + (size_t)bh * 1024 * SC_RB + F.lane * 16;
    LAS unsigned char* ring = F.lds;
    volatile LAS unsigned* sync = (volatile LAS unsigned*)(F.lds + SC_SYNC);
    bool dead = false;
#pragma unroll 1
    for (int B = 0; B < 1024; ++B) {
        if (B >= SC_NS && !dead) { unsigned spins = 0; for (;;) { const unsigned d0 = lds_word(sync + 16); if ((int)d0 > B - SC_NS) break; if (++spins > (1u << 20)) { dead = true; break; } __builtin_amdgcn_s_sleep(2); } }
        LAS unsigned char* slot = ring + (B % SC_NS) * SC_RB;
#pragma unroll
        for (int q = 0; q < 11; ++q) __builtin_amdgcn_global_load_lds((const GAS unsigned*)(gsrc + (size_t)B * SC_RB + q * 1024), (LAS unsigned*)(slot + q * 1024), 16, 0, 0);
        asm volatile("s_waitcnt vmcnt(55)" ::: "memory");
        if (B >= 5 && F.lane == 0) sync[0] = (unsigned)(B - 4);
    }
    asm volatile("s_waitcnt vmcnt(0)" ::: "memory");
    if (F.lane == 0) sync[0] = 1024u;
}
template <int VAR> __device__ __forceinline__ void r4_scan(const Frame& F, const Args& a, int bh, int quarter) {
    float* YT = (float*)(a.ws + WS_XN);
    constexpr int RB = SC_RB;
    __builtin_amdgcn_s_setprio(3);
    const int r = F.lane & 15, q = F.lane >> 4, rowg = quarter * 16 + r;
    LAS unsigned char* ring = F.lds;
    volatile LAS unsigned* sync = (volatile LAS unsigned*)(F.lds + SC_SYNC);
    const LAS unsigned char* pA1 = ring + (REC_AT + r * 64 + 4 * q) * 4;
    const LAS unsigned char* pNQ = ring + (REC_N + r * 8 + 2 * q) * 4;
    const LAS unsigned char* pVb = ring + (REC_V8 + rowg * 8 + 2 * q) * 4;
    const LAS unsigned char* pV4 = ring + (REC_V8 + rowg * 8 + 4 * (q & 1)) * 4;
    const LAS unsigned char* pA2 = ring + (REC_BKT + r * 16 + 4 * q) * 4;
    const LAS unsigned char* pWC = ring + (REC_WC + 4 * q) * 4;
    unsigned have = 0; bool dead = (VAR == 1);
#define SC_NEED(n) do { unsigned spins_ = 0; while (have < (unsigned)(n) && !dead) { have = lds_word(sync); if (have >= (unsigned)(n)) break; if (++spins_ > (1u << 20)) { dead = true; break; } __builtin_amdgcn_s_sleep(1); } } while (0)
    f32x4 S[4];
#pragma unroll
    for (int kb = 0; kb < 4; ++kb) S[kb] = (f32x4){0.f, 0.f, 0.f, 0.f};
    GAS float* yrow = (GAS float*)YT + (size_t)(bh * 64 + rowg) * SEQ + 4 * (q & 1);
#define SC_LD(a1_, nq_, vb_, v4_, a2_, wc_, so_) do { _Pragma("unroll") for (int kb_ = 0; kb_ < 4; ++kb_) a1_[kb_] = *(const LAS f32x4*)(pA1 + (so_) + kb_ * 64); \
        nq_ = *(const LAS f32x2*)(pNQ + (so_)); vb_ = *(const LAS f32x2*)(pVb + (so_)); v4_ = *(const LAS f32x4*)(pV4 + (so_)); \
        _Pragma("unroll") for (int kb_ = 0; kb_ < 4; ++kb_) { a2_[kb_] = *(const LAS f32x4*)(pA2 + (so_) + kb_ * 1024); wc_[kb_] = *(const LAS f32x4*)(pWC + (so_) + kb_ * 64); } } while (0)
    f32x4 a1[4], a2[4], wc[4], v4; f32x2 nq, vb;
    SC_NEED(1); asm volatile("" ::: "memory");
    SC_LD(a1, nq, vb, v4, a2, wc, 0);
#pragma unroll 1
    for (int k0 = 0; k0 < 1024; k0 += SC_NS) {
#pragma unroll
        for (int u = 0; u < SC_NS; ++u) { if (k0 + u >= 1024) break; const int sn = ((u + 1) % SC_NS) * RB;
            f32x4 d0 = {0.f, 0.f, 0.f, 0.f}, d1 = {0.f, 0.f, 0.f, 0.f};
#pragma unroll
            for (int kb = 0; kb < 4; ++kb) { d0 = __builtin_amdgcn_mfma_f32_16x16x4f32(a1[kb][0], S[kb][0], d0, 0, 0, 0); d1 = __builtin_amdgcn_mfma_f32_16x16x4f32(a1[kb][1], S[kb][1], d1, 0, 0, 0);
                d0 = __builtin_amdgcn_mfma_f32_16x16x4f32(a1[kb][2], S[kb][2], d0, 0, 0, 0); d1 = __builtin_amdgcn_mfma_f32_16x16x4f32(a1[kb][3], S[kb][3], d1, 0, 0, 0); }
            d0 = __builtin_amdgcn_mfma_f32_16x16x4f32(nq[0], vb[0], d0, 0, 0, 0); d1 = __builtin_amdgcn_mfma_f32_16x16x4f32(nq[1], vb[1], d1, 0, 0, 0);
            f32x4 na1[4], na2[4], nwc[4], nv4; f32x2 nnq, nvb;
            SC_NEED(k0 + u + 2 <= 1024 ? k0 + u + 2 : 1024); asm volatile("" ::: "memory");
            SC_LD(na1, nnq, nvb, nv4, na2, nwc, sn);
            asm volatile("" ::: "memory");
            const f32x4 dd = d0 + d1;
            if (q >= 2) *(GAS f32x4*)(yrow + (k0 + u) * 8) = dd;
            const f32x4 b2 = q >= 2 ? v4 : dd;
            f32x4 n[4];
#pragma unroll
            for (int kb = 0; kb < 4; ++kb) n[kb] = S[kb] * wc[kb];
#pragma unroll
            for (int sp = 0; sp < 4; ++sp)
#pragma unroll
                for (int kb = 0; kb < 4; ++kb) n[kb] = __builtin_amdgcn_mfma_f32_16x16x4f32(a2[kb][sp], b2[sp], n[kb], 0, 0, 0);
#pragma unroll
            for (int kb = 0; kb < 4; ++kb) S[kb] = n[kb];
            asm volatile("" : "+v"(S[0]), "+v"(S[1]), "+v"(S[2]), "+v"(S[3]) :: "memory");
            if (F.lane == 0) sync[16] = (unsigned)(k0 + u + 1);
#pragma unroll
            for (int kb = 0; kb < 4; ++kb) { a1[kb] = na1[kb]; a2[kb] = na2[kb]; wc[kb] = nwc[kb]; }
            nq = nnq; vb = nvb; v4 = nv4;
        }
    }
#undef SC_LD
#undef SC_NEED
    __builtin_amdgcn_s_setprio(0);
}

__device__ __forceinline__ void r5_finish(const Frame& F, const Args& a) {
    const float* YT = (const float*)(a.ws + WS_XN); const float* LO = (const float*)(a.ws + WS_LORAOUT); const bf16* P = (const bf16*)(a.ws + WS_P); const float* BON = (const float*)(a.ws + WS_BONUS);
    bf16* YA = (bf16*)(a.ws + WS_YABC);
    LAS float* scr = (LAS float*)(F.lds + F.wave * 16640);
    const int gw = F.vcu * NWAVES + F.wave, NGW = F.G * NWAVES;
    for (int it = gw; it < 32 * 128; it += NGW) {
        const int bh = it >> 7, tt = it & 127, t0 = tt * 64, b = bh >> 4, h = bh & 15;
        float y[64]; float s = 0.f;
#pragma unroll
        for (int v = 0; v < 64; ++v) { y[v] = YT[(size_t)(bh * 64 + v) * SEQ + t0 + F.lane]; s += y[v]; }
        const float mean = s * (1.f / 64.f); float q = 0.f;
#pragma unroll
        for (int v = 0; v < 64; ++v) { const float d = y[v] - mean; q += d * d; }
        const float rstd = 1.0f / sqrtf(q * (1.f / 64.f) + GN_EPS);
#pragma unroll
        for (int v = 0; v < 64; ++v) scr[F.lane * 65 + v] = (y[v] - mean) * rstd;
        LDS_WAIT(); asm volatile("" ::: "memory");
        { const int ts = F.lane >> 4, cq = F.lane & 15, c = h * 64 + 4 * cq;
          const f32x4 lw = *(const GAS f32x4*)((const GAS float*)inp(I_LNW) + c), lb = *(const GAS f32x4*)((const GAS float*)inp(I_LNB) + c), muv = *(const GAS f32x4*)((const GAS float*)inp(I_MU) + 2048 + c);
#pragma unroll 4
          for (int tg = 0; tg < 16; ++tg) { const int ti = 4 * tg + ts, m = b * SEQ + t0 + ti;
              f32x4 yn; yn[0] = scr[ti * 65 + 4 * cq]; yn[1] = scr[ti * 65 + 4 * cq + 1]; yn[2] = scr[ti * 65 + 4 * cq + 2]; yn[3] = scr[ti * 65 + 4 * cq + 3];
              const v2u cw = *(const GAS v2u*)((const GAS bf16*)P + (size_t)m * NP + 2048 + c); v2u pw = cw; if (m % SEQ != 0) pw = *(const GAS v2u*)((const GAS bf16*)P + (size_t)(m - 1) * NP + 2048 + c);
              const f32x4 cv = {bflo(cw.x), bfhi(cw.x), bflo(cw.y), bfhi(cw.y)}; f32x4 pv = {bflo(pw.x), bfhi(pw.x), bflo(pw.y), bfhi(pw.y)}; if (m % SEQ == 0) pv = (f32x4){0.f, 0.f, 0.f, 0.f};
              const f32x4 vsh = cv + (pv - cv) * muv;
              const f32x4 g = *(const GAS f32x4*)((const GAS float*)LO + (size_t)m * 3072 + 2048 + c); const float bon = BON[m * 16 + h];
              const f32x4 o = (yn * lw + lb + vsh * bon) * g;
              v2u w; w.x = pk2(o[0], o[1]); w.y = pk2(o[2], o[3]); *(GAS v2u*)((GAS bf16*)YA + (size_t)m * 3072 + c) = w; } }
        LDS_WAIT(); asm volatile("" ::: "memory");
    }
}

__device__ __forceinline__ float gelu_tanh(float x) { const float u = 0.7978845608028654f * (x + 0.044715f * x * x * x); return 0.5f * x * (1.0f + fast_tanh(u)); }
template <int CTRL> __device__ __forceinline__ float dpp_keep(float old, float x) { return __builtin_bit_cast(float, __builtin_amdgcn_update_dpp(__builtin_bit_cast(int, old), __builtin_bit_cast(int, x), CTRL, 0xf, 0xf, false)); }
template <bool FINAL> __device__ __forceinline__ void lru_pass(const Frame& F, const Args& a, int gw, int NGW) {
    const bf16* P = (const bf16*)(a.ws + WS_P); const bf16* LW = (const bf16*)(a.ws + WS_LW);
    float* CA = (float*)(a.ws + WS_LRUC); float* CB = CA + 256 * 1024; const float* HIN = CB + 256 * 1024;
    bf16* YB = (bf16*)(a.ws + WS_YABC) + 1024;
    const GAS float* lbr_p = (const GAS float*)inp(I_LBR); const GAS float* lbi_p = (const GAS float*)inp(I_LBI); const GAS float* spl_p = (const GAS float*)(a.ws + WS_SPL);
    const GAS float* cvb_p = (const GAS float*)inp(I_CONVB); const GAS float* cvw_p = (const GAS float*)inp(I_CONVW);
    const int tq = F.lane & 15, kq = F.lane >> 4;
    for (int it = gw; it < 256 * 16; it += NGW) {
        const int tt = it >> 4, n = it & 15, m0 = tt * 64, cb = n * 64 + 4 * kq;
        const bool seq0 = (m0 % SEQ) == 0;
        float hcar[4][4];
        float aprod[4][4];
#pragma unroll
        for (int vb = 0; vb < 4; ++vb)
#pragma unroll
            for (int i = 0; i < 4; ++i) { hcar[vb][i] = FINAL ? HIN[tt * 1024 + cb + 16 * vb + i] : 0.f; aprod[vb][i] = 1.f; }
#pragma unroll 1
        for (int tb = 0; tb < 4; ++tb) {
            asm volatile("" ::: "memory");
            const int m = m0 + 16 * tb + tq, tseq = m % SEQ;
            f32x4 xc[4];
#pragma unroll
            for (int vb = 0; vb < 4; ++vb) { const int c = cb + 16 * vb; f32x4 acc = *(const GAS f32x4*)(cvb_p + c);
#pragma unroll
                for (int j = 0; j < 4; ++j) { if (tseq - j >= 0) { const v2u pw = *(const GAS v2u*)((const GAS bf16*)P + (size_t)(m - j) * NP + PC_LX + c); const f32x4 cw = *(const GAS f32x4*)(cvw_p + j * 1024 + c);
                        acc[0] += cw[0] * bflo(pw.x); acc[1] += cw[1] * bfhi(pw.x); acc[2] += cw[2] * bflo(pw.y); acc[3] += cw[3] * bfhi(pw.y); } }
                xc[vb] = acc; }
            bf16x8 bfrag[2];
#pragma unroll
            for (int ks = 0; ks < 2; ++ks) { v4u w; w.x = pk2(xc[2 * ks][0], xc[2 * ks][1]); w.y = pk2(xc[2 * ks][2], xc[2 * ks][3]); w.z = pk2(xc[2 * ks + 1][0], xc[2 * ks + 1][1]); w.w = pk2(xc[2 * ks + 1][2], xc[2 * ks + 1][3]); bfrag[ks] = __builtin_bit_cast(bf16x8, w); }
#pragma unroll
            for (int vb = 0; vb < 4; ++vb) {
                f32x4 gr = {0.f, 0.f, 0.f, 0.f}, gi = {0.f, 0.f, 0.f, 0.f};
#pragma unroll
                for (int ks = 0; ks < 2; ++ks) { const bf16x8 wr_ = *(const bf16x8*)(LW + ((((size_t)(0 * 16 + n) * 4 + vb) * 2 + ks) * 64 + F.lane) * 8); const bf16x8 wi_ = *(const bf16x8*)(LW + ((((size_t)(1 * 16 + n) * 4 + vb) * 2 + ks) * 64 + F.lane) * 8);
                    gr = __builtin_amdgcn_mfma_f32_16x16x32_bf16(wr_, bfrag[ks], gr, 0, 0, 0); gi = __builtin_amdgcn_mfma_f32_16x16x32_bf16(wi_, bfrag[ks], gi, 0, 0, 0); }
                const int c = cb + 16 * vb;
                const f32x4 brv = *(const GAS f32x4*)(lbr_p + c), biv = *(const GAS f32x4*)(lbi_p + c); const f32x4 spl = *(const GAS f32x4*)(spl_p + c);
                v2u pyw; if (FINAL) pyw = *(const v2u*)(P + (size_t)m * NP + PC_LY + c);
                float hout[4];
#pragma unroll
                for (int i = 0; i < 4; ++i) {
                    const float g_r = sigm(gr[i] + brv[i]), g_i = sigm(gi[i] + biv[i]);
                    const float log_a = -8.0f * g_r * spl[i];
                    float av = __expf(log_a); float mult = __builtin_amdgcn_sqrtf(fmaxf(1.0f - av * av, 0.f)); if (tseq == 0) mult = 1.0f;
                    float bv = mult * g_i * xc[vb][i];
                    { float pa = dpp_keep<0x111>(1.0f, av), pb = dpp_keep<0x111>(0.0f, bv); bv = av * pb + bv; av = av * pa; }
                    { float pa = dpp_keep<0x112>(1.0f, av), pb = dpp_keep<0x112>(0.0f, bv); bv = av * pb + bv; av = av * pa; }
                    { float pa = dpp_keep<0x114>(1.0f, av), pb = dpp_keep<0x114>(0.0f, bv); bv = av * pb + bv; av = av * pa; }
                    { float pa = dpp_keep<0x118>(1.0f, av), pb = dpp_keep<0x118>(0.0f, bv); bv = av * pb + bv; av = av * pa; }
                    const float hv = bv + av * hcar[vb][i];
                    const int l15 = (F.lane & 48) | 15;
                    const float hend = __shfl(hv, l15), aend = __shfl(av, l15);
                    hcar[vb][i] = hend; if (!FINAL) aprod[vb][i] *= aend; hout[i] = hv; }
                if (FINAL) { const float y0 = hout[0] * gelu_tanh(bflo(pyw.x)), y1 = hout[1] * gelu_tanh(bfhi(pyw.x)), y2 = hout[2] * gelu_tanh(bflo(pyw.y)), y3 = hout[3] * gelu_tanh(bfhi(pyw.y));
                    v2u w; w.x = pk2(y0, y1); w.y = pk2(y2, y3); *(v2u*)(YB + (size_t)m * 3072 + c) = w; }
            }
        }
        if (!FINAL && tq == 0) {
#pragma unroll
            for (int vb = 0; vb < 4; ++vb) { f32x4 pa, pb;
#pragma unroll
                for (int i = 0; i < 4; ++i) { pa[i] = aprod[vb][i]; pb[i] = hcar[vb][i]; }
                *(f32x4*)(CA + tt * 1024 + cb + 16 * vb) = pa; *(f32x4*)(CB + tt * 1024 + cb + 16 * vb) = pb; }
        }
        (void)seq0;
    }
}
__device__ __forceinline__ void lru_carry(const Frame& F, const Args& a) {
    const float* CA = (const float*)(a.ws + WS_LRUC); const float* CB = CA + 256 * 1024; float* HIN = (float*)CB + 256 * 1024;
    const int gt = F.vcu * (NWAVES * 64) + F.tid;
    if (gt < 2048) { const int b = gt >> 10, c = gt & 1023; float h = 0.f;
#pragma unroll 1
        for (int k0 = 0; k0 < 128; k0 += 32) { float ca[32], cb[32];
#pragma unroll
            for (int j = 0; j < 32; ++j) { const int tt = b * 128 + k0 + j; ca[j] = CA[tt * 1024 + c]; cb[j] = CB[tt * 1024 + c]; }
#pragma unroll
            for (int j = 0; j < 32; ++j) { const int tt = b * 128 + k0 + j; HIN[tt * 1024 + c] = h; h = ca[j] * h + cb[j]; } } }
}

__device__ __forceinline__ void xattn_phase(const Frame& F, const Args& a, int gw, int NGW) {
    const bf16* P = (const bf16*)(a.ws + WS_P); const bf16* KM = (const bf16*)(a.ws + WS_KMEM); const bf16* VT = (const bf16*)(a.ws + WS_VT);
    bf16* YC = (bf16*)(a.ws + WS_YABC) + 2048;
    const int tq = F.lane & 15, kq = F.lane >> 4;
    for (int it = gw; it < 4 * 512; it += NGW) {
        const int h = it >> 9, tg = it & 511, m0 = tg * 32, b = m0 / SEQ;
        bf16x8 qf[2][8];
#pragma unroll
        for (int g = 0; g < 2; ++g)
#pragma unroll
            for (int ks = 0; ks < 8; ++ks) qf[g][ks] = *(const bf16x8*)(P + (size_t)(m0 + 16 * g + tq) * NP + PC_Q + h * 256 + 32 * ks + 8 * kq);
        f32x4 s[2][16];
#pragma unroll
        for (int mb = 0; mb < 16; ++mb) { f32x4 acc0 = {0.f, 0.f, 0.f, 0.f}, acc1 = {0.f, 0.f, 0.f, 0.f}; const bf16* kp = KM + (size_t)(b * 256 + 16 * mb + tq) * 1024 + h * 256 + 8 * kq;
#pragma unroll
            for (int ks = 0; ks < 8; ++ks) { const bf16x8 kf = *(const bf16x8*)(kp + 32 * ks);
                acc0 = __builtin_amdgcn_mfma_f32_16x16x32_bf16(kf, qf[0][ks], acc0, 0, 0, 0); acc1 = __builtin_amdgcn_mfma_f32_16x16x32_bf16(kf, qf[1][ks], acc1, 0, 0, 0); }
            s[0][mb] = acc0; s[1][mb] = acc1; asm volatile("" ::: "memory"); }
        bf16x8 pf[2][8];
#pragma unroll
        for (int g = 0; g < 2; ++g) {
            float mx = -3.0e38f;
#pragma unroll
            for (int mb = 0; mb < 16; ++mb) { s[g][mb] = s[g][mb] * 0.0625f; mx = fmaxf(mx, fmaxf(fmaxf(s[g][mb][0], s[g][mb][1]), fmaxf(s[g][mb][2], s[g][mb][3]))); }
            mx = fmaxf(mx, __shfl_xor(mx, 16)); mx = fmaxf(mx, __shfl_xor(mx, 32));
            float sum = 0.f;
#pragma unroll
            for (int mb = 0; mb < 16; ++mb) {
#pragma unroll
                for (int i = 0; i < 4; ++i) { s[g][mb][i] = __expf(s[g][mb][i] - mx); sum += s[g][mb][i]; } }
            sum += __shfl_xor(sum, 16); sum += __shfl_xor(sum, 32);
            const float inv = 1.0f / sum;
#pragma unroll
            for (int ks = 0; ks < 8; ++ks) { v4u w; w.x = pk2(s[g][2 * ks][0] * inv, s[g][2 * ks][1] * inv); w.y = pk2(s[g][2 * ks][2] * inv, s[g][2 * ks][3] * inv); w.z = pk2(s[g][2 * ks + 1][0] * inv, s[g][2 * ks + 1][1] * inv); w.w = pk2(s[g][2 * ks + 1][2] * inv, s[g][2 * ks + 1][3] * inv); pf[g][ks] = __builtin_bit_cast(bf16x8, w); } }
#pragma unroll
        for (int db = 0; db < 16; ++db) { f32x4 acc0 = {0.f, 0.f, 0.f, 0.f}, acc1 = {0.f, 0.f, 0.f, 0.f}; const bf16* vp = VT + ((size_t)((b * 4 + h) * 256 + 16 * db + tq)) * 256 + 8 * kq;
#pragma unroll
            for (int ks = 0; ks < 8; ++ks) { const bf16x8 vf = *(const bf16x8*)(vp + 32 * ks);
                acc0 = __builtin_amdgcn_mfma_f32_16x16x32_bf16(vf, pf[0][ks], acc0, 0, 0, 0); acc1 = __builtin_amdgcn_mfma_f32_16x16x32_bf16(vf, pf[1][ks], acc1, 0, 0, 0); }
            v2u w0_, w1_; w0_.x = pk2(acc0[0], acc0[1]); w0_.y = pk2(acc0[2], acc0[3]); w1_.x = pk2(acc1[0], acc1[1]); w1_.y = pk2(acc1[2], acc1[3]);
            *(v2u*)(YC + (size_t)(m0 + tq) * 3072 + h * 256 + 16 * db + 4 * kq) = w0_; *(v2u*)(YC + (size_t)(m0 + 16 + tq) * 3072 + h * 256 + 16 * db + 4 * kq) = w1_; asm volatile("" ::: "memory"); }
    }
}

__device__ __forceinline__ void router_phase(const Frame& F, const Args& a) {
    const float* H1 = (const float*)(a.ws + WS_H1); bf16* XN2 = (bf16*)(a.ws + WS_XN); const bf16* WR = (const bf16*)(a.ws + WS_WR);
    int* pick_e = (int*)(a.ws + WS_PICK); int* pick_rank = pick_e + 65536; float* pick_gate = (float*)(pick_rank + 65536);
    unsigned* gcnt = (unsigned*)(a.ws + WS_CTL) + CW_CNT;
    LAS float* lg = (LAS float*)(F.lds + F.wave * 4096);
    LAS unsigned* lcnt = (LAS unsigned*)(F.lds + 65536);
    const int tq = F.lane & 15, kq = F.lane >> 4;
    for (int g0 = F.vcu * 4; g0 < 1024; g0 += F.G * 4) {
        if (F.tid < 64) lcnt[F.tid] = 0u;
        __syncthreads();
        int me = 0, mrank = 0; float mgate = 0.f; int e4[4]; float g4[4]; int r4[4];
        const int m0 = (g0 + F.wave) * 16;
        if (F.wave < 4) {
            float myr = 0.f;
            for (int j = 0; j < 16; ++j) { const GAS f32x4* xr = (const GAS f32x4*)(H1 + (size_t)(m0 + j) * D) + F.lane; float s = 0.f;
#pragma unroll
                for (int q = 0; q < 8; ++q) { const f32x4 v = xr[64 * q]; s += (v.x * v.x + v.y * v.y) + (v.z * v.z + v.w * v.w); }
                const float rs = 1.0f / sqrtf(wave_sum(s) * (1.f / D) + EPS); if (tq == j) myr = rs; }
            f32x4 acc[2] = {{0.f, 0.f, 0.f, 0.f}, {0.f, 0.f, 0.f, 0.f}};
            const float* hrow = H1 + (size_t)(m0 + tq) * D + 8 * kq; const float* grow = inp(I_GFFN) + 8 * kq; unsigned char* xrow = (unsigned char*)XN2 + (size_t)(m0 + tq) * D + 8 * kq;
            for (int ks = 0; ks < 64; ++ks) {
                const f32x4 x0 = *(const f32x4*)(hrow + 32 * ks), x1 = *(const f32x4*)(hrow + 32 * ks + 4), g0v = *(const f32x4*)(grow + 32 * ks), g1v = *(const f32x4*)(grow + 32 * ks + 4);
                v4u w; w.x = pk2(x0[0] * myr * g0v[0], x0[1] * myr * g0v[1]); w.y = pk2(x0[2] * myr * g0v[2], x0[3] * myr * g0v[3]); w.z = pk2(x1[0] * myr * g1v[0], x1[1] * myr * g1v[1]); w.w = pk2(x1[2] * myr * g1v[2], x1[3] * myr * g1v[3]);
                { v2u q8; q8.x = pk4_fp8(x0[0] * myr * g0v[0], x0[1] * myr * g0v[1], x0[2] * myr * g0v[2], x0[3] * myr * g0v[3]); q8.y = pk4_fp8(x1[0] * myr * g1v[0], x1[1] * myr * g1v[1], x1[2] * myr * g1v[2], x1[3] * myr * g1v[3]); *(v2u*)(xrow + 32 * ks) = q8; }
                const bf16x8 af = __builtin_bit_cast(bf16x8, w);
#pragma unroll
                for (int eh = 0; eh < 2; ++eh) { const bf16* wp = WR + (size_t)(16 * eh + tq) * D + 32 * ks + 8 * kq;
                    acc[eh] = __builtin_amdgcn_mfma_f32_16x16x32_bf16(af, *(const bf16x8*)wp, acc[eh], 0, 0, 0);
                    acc[eh] = __builtin_amdgcn_mfma_f32_16x16x32_bf16(af, *(const bf16x8*)(wp + 32 * D), acc[eh], 0, 0, 0); } }
#pragma unroll
            for (int eh = 0; eh < 2; ++eh)
#pragma unroll
                for (int i = 0; i < 4; ++i) lg[(4 * kq + i) * 33 + 16 * eh + tq] = acc[eh][i] + inp(I_BROUTER)[16 * eh + tq];
            LDS_WAIT(); asm volatile("" ::: "memory");
            if (F.lane < 16) { float v[32];
#pragma unroll
                for (int e = 0; e < 32; ++e) v[e] = lg[F.lane * 33 + e];
                float tv[4];
#pragma unroll
                for (int k = 0; k < 4; ++k) { float best = -3.0e38f; int bi = 0;
#pragma unroll
                    for (int e = 0; e < 32; ++e) { if (v[e] > best) { best = v[e]; bi = e; } }
                    tv[k] = best; e4[k] = bi;
#pragma unroll
                    for (int e = 0; e < 32; ++e) { if (e == bi) v[e] = -3.0e38f; } }
                float den = 0.f;
#pragma unroll
                for (int k = 0; k < 4; ++k) { g4[k] = __expf(tv[k] - tv[0]); den += g4[k]; }
#pragma unroll
                for (int k = 0; k < 4; ++k) { g4[k] = g4[k] / den; r4[k] = (int)atomicAdd((unsigned*)&lcnt[e4[k]], 1u); } }
        }
        __syncthreads();
        if (F.tid < 32) lcnt[32 + F.tid] = atomicAdd(&gcnt[F.tid], lcnt[F.tid]);
        __syncthreads();
        if (F.wave < 4 && F.lane < 16) {
#pragma unroll
            for (int k = 0; k < 4; ++k) { const int pi = (m0 + F.lane) * 4 + k; pick_e[pi] = e4[k]; pick_rank[pi] = (int)lcnt[32 + e4[k]] + r4[k]; pick_gate[pi] = g4[k]; } }
        __syncthreads();
        (void)me; (void)mrank; (void)mgate;
    }
}

__device__ __forceinline__ void scatter_phase(const Frame& F, const Args& a) {
    const int* pick_e = (const int*)(a.ws + WS_PICK); const int* pick_rank = pick_e + 65536; const float* pick_gate = (const float*)(pick_rank + 65536); int* pos = (int*)(pick_gate + 65536);
    float* gate_of_row = (float*)(a.ws + WS_ROWTAB); int* tok_of_row = (int*)(a.ws + WS_ROWTAB + 512 * 1024 + 8192);
    unsigned* ctl = (unsigned*)(a.ws + WS_CTL);
    LAS int* pst = (LAS int*)(F.lds);
    if (F.tid == 0) { int acc = 0; for (int e = 0; e < NE; ++e) { pst[e] = acc; const int c = (int)ctl[CW_CNT + e]; pst[32 + e] = c; const int nt = (c + 255) >> 8;
            if (blockIdx.x == 0) for (int k = 0; k < nt; ++k) ctl[CW_TILEE + (acc >> 8) + k] = (unsigned)e;
            acc += nt << 8; }
        if (blockIdx.x == 0) ctl[CW_NTILES] = (unsigned)(acc >> 8); }
    __syncthreads();
    { const int gw = F.vcu * NWAVES + F.wave, NGW = F.G * NWAVES; const unsigned char* X8 = a.ws + WS_XN; unsigned char* XS8 = a.ws + WS_XS;
      for (int pi = gw; pi < 65536; pi += NGW) {
        const int e = pick_e[pi], row = pst[e] + pick_rank[pi], tok = pi >> 2;
        if (F.lane == 0) { pos[pi] = row; gate_of_row[row] = pick_gate[pi]; tok_of_row[row] = tok; }
        const GAS v4u* src = (const GAS v4u*)(X8 + (size_t)tok * D) + F.lane; GAS v4u* dst = (GAS v4u*)(XS8 + (size_t)row * D) + F.lane;
        dst[0] = src[0]; dst[64] = src[64]; } }
    if (blockIdx.x == 0) for (int e = 0; e < NE; ++e) { const int r0 = pst[e] + pst[32 + e], r1 = pst[e] + (((pst[32 + e] + 255) >> 8) << 8);
        for (int r = r0 + F.tid; r < r1; r += NWAVES * 64) { tok_of_row[r] = 0; gate_of_row[r] = 0.f; } }
}

__device__ __forceinline__ void final_phase(const Frame& F, const Args& a) {
    const float* H1 = (const float*)(a.ws + WS_H1); const bf16* OR = (const bf16*)(a.ws + WS_OROW);
    const int* pos = (const int*)(a.ws + WS_PICK) + 3 * 65536;
    const int gw = F.vcu * NWAVES + F.wave, NGW = F.G * NWAVES;
    for (int m = gw; m < T; m += NGW) {
        const GAS f32x4* xr = (const GAS f32x4*)(H1 + (size_t)m * D) + F.lane; const GAS f32x4* gr = (const GAS f32x4*)inp(I_GFINAL) + F.lane;
        f32x4 v[8];
#pragma unroll
        for (int j = 0; j < 8; ++j) v[j] = xr[64 * j];
#pragma unroll
        for (int k = 0; k < 4; ++k) { const int row = pos[m * 4 + k]; const GAS v2u* orp = (const GAS v2u*)(OR + (size_t)row * D) + F.lane;
#pragma unroll
            for (int j = 0; j < 8; ++j) { const v2u w = orp[64 * j]; v[j].x += bflo(w.x); v[j].y += bfhi(w.x); v[j].z += bflo(w.y); v[j].w += bfhi(w.y); } }
        float s = 0.f;
#pragma unroll
        for (int j = 0; j < 8; ++j) s += (v[j].x * v[j].x + v[j].y * v[j].y) + (v[j].z * v[j].z + v[j].w * v[j].w);
        const float rstd = 1.0f / sqrtf(wave_sum(s) * (1.f / D) + EPS);
        GAS f32x4* o = (GAS f32x4*)(a.out + (size_t)m * D) + F.lane;
#pragma unroll
        for (int j = 0; j < 8; ++j) { const f32x4 g = gr[64 * j]; o[64 * j] = (f32x4){v[j].x * rstd * g.x, v[j].y * rstd * g.y, v[j].z * rstd * g.z, v[j].w * rstd * g.w}; }
    }
}

#ifndef MK_N_LAUNCHES
#define MK_N_LAUNCHES 1
#endif
constexpr int NPH = 14;
__global__ void __launch_bounds__(NWAVES * 64, 2) fwd(Args args) {
    extern __shared__ __attribute__((aligned(16))) unsigned char lds[];
#define NEWFRAME() Frame F; { int tz = threadIdx.x; asm volatile("" : "+v"(tz)); F.lds = (LAS unsigned char*)lds; F.MISC = (volatile LAS unsigned*)(F.lds + MISC_OFF); F.tid = tz; F.lane = tz & 63; F.wave = __builtin_amdgcn_readfirstlane(tz >> 6); \
        F.G = gridDim.x; const int bx = blockIdx.x; F.vcu = (F.G % 8 == 0) ? (bx % 8) * (F.G / 8) + bx / 8 : bx; }
    unsigned char* ws = args.ws;
    unsigned* ctl = (unsigned*)(ws + WS_CTL);
    for (int u = threadIdx.x; u < (LDS_BYTES - MISC_OFF) / 4; u += NWAVES * 64) ((LAS unsigned*)((LAS unsigned char*)lds + MISC_OFF))[u] = 0u;
    __syncthreads();
    const int lo = args.ph_lo, hi = args.ph_hi;
    XcdBarrier bar; bar.bar = ctl + CW_BAR; bar.x = 0; bar.st = nullptr;
    if (hi - lo > 1) bar = xcd_barrier_post(ctl + CW_BAR, (volatile LAS unsigned*)((LAS unsigned char*)lds + MISC_OFF) + 8);
#ifndef PHMASK
#define PHMASK 0xFFFF
#endif
#define IN(k) (((PHMASK >> (k)) & 1) && lo <= (k) && (k) < hi)
#define SEAM(k) do { if (IN(k) && IN((k) + 1)) xcd_barrier(bar); } while (0)

    if (IN(0)) { NEWFRAME(); p0_prologue(F, args); } SEAM(0);
    if (IN(1)) { NEWFRAME();
        const int c = (int)blockIdx.x, G = F.G;
        { pg8::Gemm g{(const bf16*)(ws + WS_XN), (const bf16*)(ws + WS_WIN), T, PC_G, D}; pg8::StaticOrder S; S.init(T, PC_G, G, c);
          pg8::EpiBf16<0> E{(bf16*)(ws + WS_P), NP, nullptr, 0, 0, 1.f};
          pg8::gemm_phase<pg8::EpiBf16<0>, pg8::StaticOrder, true, true>(F.lds, g, S, E); }
        __syncthreads();
        { pg8::Gemm g{(const bf16*)(ws + WS_MN), (const bf16*)(ws + WS_WMKV), 512, 2048, D}; pg8::StaticOrder S; S.init(512, 2048, G, (c + G - G / 2) % G);
          pg8::EpiKV E{(bf16*)(ws + WS_KMEM), (bf16*)(ws + WS_VT)};
          pg8::gemm_phase<pg8::EpiKV, pg8::StaticOrder, true, true>(F.lds, g, S, E); }
        __syncthreads();
        { int start, cnt;
          if (G == 256) { if (c < 144) { start = 5 * c; cnt = 5; } else if (c < 224) { start = 720 + 7 * (c - 144); cnt = 7; } else { start = 1280 + 8 * (c - 224); cnt = 8; } }
          else { const int per = (1536 + G - 1) / G; start = per * c; cnt = start >= 1536 ? 0 : (1536 - start < per ? 1536 - start : per); }
          pg8::Gemm g{(const bf16*)(ws + WS_XN8), (const bf16*)(ws + WS_WIN8), T, NP - PC_G, D}; pg8::RangeOrder S; S.init(T, NP - PC_G, start, cnt);
          pg8::EpiBf16<0> E{(bf16*)(ws + WS_P) + PC_G, NP, nullptr, 0, 0, 1.f};
          pg8::gemm_phase<pg8::EpiBf16<0>, pg8::RangeOrder, true, true, 1>(F.lds, g, S, E); }
    } SEAM(1);
    if (IN(2)) { NEWFRAME();
#ifndef NO_R1
 r1_lora_in(F, args);
#endif
#ifndef NO_LRU
 lru_pass<false>(F, args, F.vcu * NWAVES + F.wave, F.G * NWAVES);
#endif
 } SEAM(2);
    if (IN(3)) { NEWFRAME();
        lru_carry(F, args);
        { pg8::Gemm g{(const bf16*)(ws + WS_XN), (const bf16*)(ws + WS_WLORA), T, 3072, LORA_K}; pg8::StaticOrder S; S.init(T, 3072, F.G, (int)blockIdx.x);
          pg8::EpiF32 E{(float*)(ws + WS_LORAOUT), 3072};
          pg8::gemm_phase<pg8::EpiF32, pg8::StaticOrder, true, true>(F.lds, g, S, E); }
    } SEAM(3);
    if (IN(4)) { NEWFRAME(); r3_blocks(F, args); } SEAM(4);
    if (IN(5)) { NEWFRAME();
        if (F.tid < 64) ((LAS unsigned*)(F.lds + SC_SYNC))[F.tid] = 0u; __syncthreads();
        int bh = 0, quarter = 0; const bool sw = scan_wg(bh, quarter);
        int gw2, NGW2; { const int bx = blockIdx.x, G = F.G; if (G == 256) { NGW2 = 1792; gw2 = sw ? ((bx >> 4) * 8 + (bx & 7)) * 6 + (F.wave - 2) : 768 + ((bx >> 4) * 8 + (bx & 7)) * 8 + F.wave; } else { NGW2 = G * 8; gw2 = F.vcu * 8 + F.wave; } }
        if (sw && F.wave == 0) r4_scan<0>(F, args, bh, quarter);
        else if (sw && F.wave == 1) r4_feeder(F, args, bh);
        else {
            const int rot = F.wave % 3;
            if (rot == 0) { moe_weight_convert(F, args, gw2, NGW2); xattn_phase(F, args, gw2, NGW2); lru_pass<true>(F, args, gw2, NGW2); }
            else if (rot == 1) { xattn_phase(F, args, gw2, NGW2); lru_pass<true>(F, args, gw2, NGW2); moe_weight_convert(F, args, gw2, NGW2); }
            else { lru_pass<true>(F, args, gw2, NGW2); moe_weight_convert(F, args, gw2, NGW2); xattn_phase(F, args, gw2, NGW2); } }
    } SEAM(5);
    if (IN(6)) { NEWFRAME(); r5_finish(F, args); } SEAM(6);
    if (IN(7)) { NEWFRAME();
        pg8::Gemm g{(const bf16*)(ws + WS_YABC), (const bf16*)(ws + WS_WBR), T, 2048, 3072}; pg8::StaticOrder S; S.init(T, 2048, F.G, (int)blockIdx.x);
        pg8::EpiBranch2 E{(const bf16*)(ws + WS_P), NP, PC_G, (bf16*)(ws + WS_MERGED)};
        pg8::gemm_phase<pg8::EpiBranch2, pg8::StaticOrder, true, true>(F.lds, g, S, E);
    } SEAM(7);
    if (IN(8)) { NEWFRAME();
        pg8::Gemm g{(const bf16*)(ws + WS_MERGED), (const bf16*)(ws + WS_WO), T, D, D}; pg8::StaticOrder S; S.init(T, D, F.G, (int)blockIdx.x);
        pg8::EpiRes E{inp(I_X), (float*)(ws + WS_H1), D};
        pg8::gemm_phase<pg8::EpiRes, pg8::StaticOrder, true, true>(F.lds, g, S, E);
    } SEAM(8);
    if (IN(9)) { NEWFRAME(); router_phase(F, args); } SEAM(9);
    if (IN(10)) { NEWFRAME(); scatter_phase(F, args); } SEAM(10);
    if (IN(11)) { NEWFRAME();
        const int ntiles = __builtin_amdgcn_readfirstlane((int)__hip_atomic_load(ctl + CW_NTILES, __ATOMIC_RELAXED, __HIP_MEMORY_SCOPE_AGENT));
        pg8::Gemm g{(const bf16*)(ws + WS_XS), (const bf16*)(ws + WS_WGU), ntiles * 256, NE * 4096, D}; pg8::MoeOrder<false> S; S.init(ntiles, 16, F.G, (int)blockIdx.x, (const int*)(ctl + CW_TILEE), nullptr);
        pg8::EpiSwiglu E{ws + WS_HH, inp(I_BGATE), inp(I_BUP)};
        pg8::gemm_phase<pg8::EpiSwiglu, pg8::MoeOrder<false>, true, true, 1>(F.lds, g, S, E);
    } SEAM(11);
    if (IN(12)) { NEWFRAME();
        const int ntiles = __builtin_amdgcn_readfirstlane((int)__hip_atomic_load(ctl + CW_NTILES, __ATOMIC_RELAXED, __HIP_MEMORY_SCOPE_AGENT));
        pg8::Gemm g{(const bf16*)(ws + WS_HH), (const bf16*)(ws + WS_WD), ntiles * 256, NE * 2048, D}; pg8::MoeOrder<false> S; S.init(ntiles, 8, F.G, (int)blockIdx.x, (const int*)(ctl + CW_TILEE), nullptr);
        pg8::EpiDown E{(bf16*)(ws + WS_OROW), inp(I_BDOWN), (const float*)(ws + WS_ROWTAB)};
        pg8::gemm_phase<pg8::EpiDown, pg8::MoeOrder<false>, true, true, 1>(F.lds, g, S, E);
    } SEAM(12);
    if (IN(13)) { NEWFRAME(); final_phase(F, args); }
#ifdef PROBE_EXTRA_PHASE
    if (lo == 14) { NEWFRAME(); if (F.tid < 64) ((LAS unsigned*)(F.lds + SC_SYNC))[F.tid] = 0u; __syncthreads(); int bh = 0, quarter = 0; const bool sw = scan_wg(bh, quarter); if (sw && F.wave == 0) r4_scan<0>(F, args, bh, quarter); else if (sw && F.wave == 1) r4_feeder(F, args, bh); }
    if (lo == 17) { NEWFRAME(); int bh = 0, quarter = 0; const bool sw = scan_wg(bh, quarter); if (sw && F.wave == 0) r4_scan<1>(F, args, bh, quarter); }
    if (lo == 15) { NEWFRAME(); moe_weight_convert(F, args, F.vcu * 8 + F.wave, F.G * 8); }
#endif
#undef IN
#undef SEAM
}

extern "C" void kernel_launch(void* const* d_in, const int* in_sizes, int n_in, void* d_out, int out_size, void* d_ws, size_t ws_size, hipStream_t stream) {
    static int grid = 0;
    if (grid == 0) {
        if (n_in != 39 || out_size != T * D || ws_size < WS_END) { fprintf(stderr, "kernel_launch: built for 39 inputs, out of %d floats, >= %zu bytes of workspace; got n_in %d, out %d, ws %zu; nothing launched\n", T * D, (size_t)WS_END, n_in, out_size, ws_size); grid = -1; return; }
        int dev = 0, cus = 0, per_cu = 0;
        if (hipGetDevice(&dev) != hipSuccess || hipDeviceGetAttribute(&cus, hipDeviceAttributeMultiprocessorCount, dev) != hipSuccess) { fprintf(stderr, "kernel_launch: device query failed\n"); grid = -1; return; }
        if (hipFuncSetAttribute((const void*)fwd, hipFuncAttributeMaxDynamicSharedMemorySize, LDS_BYTES) != hipSuccess) { fprintf(stderr, "kernel_launch: hipFuncSetAttribute failed\n"); grid = -1; return; }
        if (hipOccupancyMaxActiveBlocksPerMultiprocessor(&per_cu, (const void*)fwd, NWAVES * 64, LDS_BYTES) != hipSuccess || per_cu < 1)
            fprintf(stderr, "kernel_launch: note: occupancy query reports %d workgroups per CU\n", per_cu);
        (void)hipGetLastError();
        grid = cus;
    }
    if (grid < 0) return;
    (void)in_sizes;
    if (hipMemsetAsync((char*)d_ws + WS_CTL, 0, CTL_ZERO_BYTES, stream) != hipSuccess) { fprintf(stderr, "kernel_launch: hipMemsetAsync failed\n"); return; }
    Args a{};
    for (int i = 0; i < 39; ++i) a.in[i] = (const float*)d_in[i];
    a.out = (float*)d_out; a.ws = (unsigned char*)d_ws;
#if MK_N_LAUNCHES == 1
    a.ph_lo = 0; a.ph_hi = NPH;
    hipLaunchKernelGGL(fwd, dim3(grid), dim3(NWAVES * 64), LDS_BYTES, stream, a);
#else
    for (int k = 0; k < NPH; ++k) { a.ph_lo = k; a.ph_hi = k + 1; int reps = 1;
#ifdef PROBE_REP_PHASE
        if (k == PROBE_REP_PHASE) reps = 1 + PROBE_REP_N;
#endif
        for (int r = 0; r < reps; ++r) hipLaunchKernelGGL(fwd, dim3(grid), dim3(NWAVES * 64), LDS_BYTES, stream, a); }
#ifdef PROBE_EXTRA_PHASE
    for (int r = 0; r < PROBE_REP_N; ++r) { a.ph_lo = PROBE_EXTRA_PHASE; a.ph_hi = PROBE_EXTRA_PHASE + 1; hipLaunchKernelGGL(fwd, dim3(grid), dim3(NWAVES * 64), LDS_BYTES, stream, a); }
#endif
#endif
    const hipError_t le = hipPeekAtLastError();
    if (le != hipSuccess) fprintf(stderr, "kernel_launch: launch failed: %s\n", hipGetErrorName(le));
}
```

```cpp
#include <hip/hip_runtime.h>
#include <cstdio>
#include <cstdint>
namespace pg8 {
#define PG8_LAS __attribute__((address_space(3)))
typedef unsigned short bf16_t;
typedef short bf16x8 __attribute__((ext_vector_type(8)));
typedef float f32x4 __attribute__((ext_vector_type(4)));
typedef unsigned u32x4 __attribute__((ext_vector_type(4)));
constexpr int BM = 256, BK = 64, HALF = 128, HTB = HALF * BK * 2  , STAGE_BYTES = 8 * HTB, NXCD = 8, WGM = 8;

__host__ __device__ __forceinline__ int lds_byte(int r, int c) { const int st = (r >> 4) * 2 + (c >> 5), rr = r & 15, cc = c & 31, ob = rr * 64 + cc * 2; return st * 1024 + (ob ^ (((ob >> 9) & 1) << 5)); }
__host__ __device__ __forceinline__ void stage_rc(int b, int& R, int& C) { const int st = b / 1024, sb = b % 1024, swz = sb ^ (((sb >> 9) & 1) << 5); R = (st >> 1) * 16 + swz / 64; C = (st & 1) * 32 + (swz % 64) / 2; }
__host__ __device__ __forceinline__ int perm32(int rho) { const int n = rho >> 4, i = rho & 15; return 8 * (i >> 2) + 4 * n + (i & 3); }

struct Unit { int pm, pn; };
struct Gemm { const bf16_t* A; const bf16_t* Bt; int M, N, K; };

struct StaticOrder {
    static constexpr bool GATHER = false; __device__ __forceinline__ int arow(const Unit&, int) const { return 0; }
    int nM, nN, nwg, G, c;
    __host__ __device__ void init(int M, int N, int G_, int c_) { nM = M / BM; nN = N / BM; nwg = nM * nN; G = G_; c = c_; }
    __host__ __device__ bool next(int i, Unit& u) const {
        const int L = i * G + c; if (L >= nwg) return false;
        int wgid = (int)L; { const int q = nwg / NXCD, r = nwg % NXCD, xcd = wgid % NXCD, off = wgid / NXCD; wgid = (xcd < r ? xcd * (q + 1) : r * (q + 1) + (xcd - r) * q) + off; }
        const int nig = WGM * nN, gid = wgid / nig, fm = gid * WGM, gsz = (nM - fm) < WGM ? (nM - fm) : WGM;
        u.pm = fm + ((wgid % nig) % gsz); u.pn = (wgid % nig) / gsz; return true;
    }
    __device__ __forceinline__ void a_ready(const Unit&) const {}
    __device__ __forceinline__ void done(const Unit&) const {}
};
struct RangeOrder {
    static constexpr bool GATHER = false; __device__ __forceinline__ int arow(const Unit&, int) const { return 0; }
    StaticOrder so; int start, cnt;
    __device__ void init(int M, int N, int start_, int cnt_) { so.init(M, N, 1, 0); start = start_; cnt = cnt_; }
    __device__ bool next(int i, Unit& u) const { if (i >= cnt) return false; return so.next(start + i, u); }
    __device__ __forceinline__ void a_ready(const Unit&) const {}
    __device__ __forceinline__ void done(const Unit&) const {}
};
__device__ __forceinline__ unsigned cvt_pk_bf16(float lo, float hi) { unsigned r; asm volatile("v_cvt_pk_bf16_f32 %0, %1, %2" : "=v"(r) : "v"(lo), "v"(hi)); return r; }
typedef float f32x2 __attribute__((ext_vector_type(2)));
__device__ __forceinline__ f32x2 gelu_pk(f32x2 v) {
    const f32x2 av = __builtin_elementwise_abs(v), d = av * 0.2316418882f + 1.0f;
    f32x2 t; t.x = __builtin_amdgcn_rcpf(d.x); t.y = __builtin_amdgcn_rcpf(d.y);
    f32x2 q = t * 0.5307027145f + (-0.7265760135f); q = q * t + 0.7107068705f; q = q * t + (-0.142248368f); q = q * t + 0.127414796f; q = q * t;
    const f32x2 s = (v * v) * (-0.72134752044f);
    f32x2 e; e.x = __builtin_amdgcn_exp2f(s.x); e.y = __builtin_amdgcn_exp2f(s.y);
    const f32x2 m = v * (q * e), r = v - m;
    f32x2 o; o.x = v.x < 0.f ? m.x : r.x; o.y = v.y < 0.f ? m.y : r.y; return o;
}

template <int ACT  > struct EpiBf16 {
    static constexpr bool PERM = true, AFTER_DRAIN = false; static constexpr int MIDK = 0; static constexpr int WSCALE = 0x79797979  ; static_assert(ACT == 0 || ACT == 1, "EpiBf16: ACT is 0 (none) or 1 (gelu_pk)");
    bf16_t* O; int ldc; const float* bias; int split_cols; size_t split_stride; float scale0;
    __device__ __forceinline__ void operator()(const f32x4 (&acc)[2][2][4][2], const Unit& u, int wr, int wc, int fr, int fq) const {
        int tz_ = threadIdx.x; asm volatile("" : "+v"(tz_)); { const int wid_ = tz_ >> 6, lane_ = tz_ & 63; wr = wid_ >> 2; wc = wid_ & 3; fr = lane_ & 15; fq = lane_ >> 4; }
        const int row0 = u.pm * BM + wr * 64 + fr; int colt = u.pn * BM; bf16_t* base = O;
        float sc = 1.f; if (split_cols) { const int t = colt / split_cols; base += (size_t)t * split_stride; colt -= t * split_cols; if (t == 0) sc = scale0; }
        const int col0 = colt + wc * 32 + 8 * fq, bcol0 = u.pn * BM + wc * 32 + 8 * fq;
        f32x4 bv[2][2];
#pragma unroll
        for (int bj = 0; bj < 2; ++bj)
#pragma unroll
            for (int n = 0; n < 2; ++n) bv[bj][n] = bias ? *(const f32x4*)(bias + bcol0 + bj * HALF + 4 * n) : (f32x4){0.f, 0.f, 0.f, 0.f};
#pragma unroll
        for (int ai = 0; ai < 2; ++ai)
#pragma unroll
            for (int m = 0; m < 4; ++m) { bf16_t* rowp = base + (size_t)(row0 + ai * HALF + m * 16) * ldc + col0;
#pragma unroll
                for (int bj = 0; bj < 2; ++bj) { f32x4 v0 = acc[ai][bj][m][0] + bv[bj][0], v1 = acc[ai][bj][m][1] + bv[bj][1];
                    if (ACT == 1) { f32x2 a = gelu_pk((f32x2){v0[0], v0[1]}), b = gelu_pk((f32x2){v0[2], v0[3]}), c = gelu_pk((f32x2){v1[0], v1[1]}), d = gelu_pk((f32x2){v1[2], v1[3]});
                        v0 = (f32x4){a.x, a.y, b.x, b.y}; v1 = (f32x4){c.x, c.y, d.x, d.y}; }
                    v0 = v0 * sc; v1 = v1 * sc; u32x4 w; w.x = cvt_pk_bf16(v0[0], v0[1]); w.y = cvt_pk_bf16(v0[2], v0[3]); w.z = cvt_pk_bf16(v1[0], v1[1]); w.w = cvt_pk_bf16(v1[2], v1[3]);
                    *(u32x4*)(rowp + bj * HALF) = w; } }
    }
};

__device__ __forceinline__ float bf_lo(unsigned w) { return __builtin_bit_cast(float, w << 16); }
__device__ __forceinline__ float bf_hi(unsigned w) { return __builtin_bit_cast(float, w & 0xffff0000u); }
__device__ __forceinline__ float fsigmoid(float x) { return __builtin_amdgcn_rcpf(1.0f + __expf(-x)); }
typedef unsigned u32x2 __attribute__((ext_vector_type(2)));

struct EpiF32 {
    static constexpr bool PERM = false, AFTER_DRAIN = false; static constexpr int MIDK = 0; static constexpr int WSCALE = 0x7f7f7f7f;
    float* C; int ldc;
    __device__ __forceinline__ void operator()(const f32x4 (&acc)[2][2][4][2], const Unit& u, int wr, int wc, int fr, int fq) const {
        const int row0 = u.pm * BM + wr * 64 + fr, col0 = u.pn * BM + wc * 32 + 4 * fq;
#pragma unroll
        for (int ai = 0; ai < 2; ++ai)
#pragma unroll
            for (int m = 0; m < 4; ++m) { float* rowp = C + (size_t)(row0 + ai * HALF + m * 16) * ldc + col0;
#pragma unroll
                for (int bj = 0; bj < 2; ++bj)
#pragma unroll
                    for (int n = 0; n < 2; ++n) *(f32x4*)(rowp + bj * HALF + n * 16) = acc[ai][bj][m][n]; }
    }
};
struct EpiRes {
    static constexpr bool PERM = false, AFTER_DRAIN = false; static constexpr int MIDK = 0; static constexpr int WSCALE = 0x7f7f7f7f;
    const float* X; bf16_t* C; int ldc;
    __device__ __forceinline__ void operator()(const f32x4 (&acc)[2][2][4][2], const Unit& u, int wr, int wc, int fr, int fq) const {
        const int row0 = u.pm * BM + wr * 64 + fr, col0 = u.pn * BM + wc * 32 + 4 * fq;
#pragma unroll
        for (int ai = 0; ai < 2; ++ai)
#pragma unroll
            for (int m = 0; m < 4; ++m) { const size_t off = (size_t)(row0 + ai * HALF + m * 16) * ldc + col0;
#pragma unroll
                for (int bj = 0; bj < 2; ++bj)
#pragma unroll
                    for (int n = 0; n < 2; ++n) { const f32x4 xv = *(const f32x4*)(X + off + bj * HALF + n * 16); const f32x4 v = acc[ai][bj][m][n] + xv;
                        u32x2 w; w.x = cvt_pk_bf16(v[0], v[1]); w.y = cvt_pk_bf16(v[2], v[3]); *(u32x2*)(C + off + bj * HALF + n * 16) = w; }
                asm volatile("" ::: "memory"); }
    }
};
struct EpiKV {
    static constexpr bool PERM = false, AFTER_DRAIN = false; static constexpr int MIDK = 0; static constexpr int WSCALE = 0x7f7f7f7f;
    bf16_t* Kb; bf16_t* VT;
    __device__ __forceinline__ void operator()(const f32x4 (&acc)[2][2][4][2], const Unit& u, int wr, int wc, int fr, int fq) const {
        const int row0 = u.pm * BM + wr * 64 + fr, col0 = u.pn * BM + wc * 32 + 4 * fq;
#pragma unroll
        for (int ai = 0; ai < 2; ++ai)
#pragma unroll
            for (int m = 0; m < 4; ++m) { const int r = row0 + ai * HALF + m * 16;
#pragma unroll
                for (int bj = 0; bj < 2; ++bj)
#pragma unroll
                    for (int n = 0; n < 2; ++n) { const f32x4 v = acc[ai][bj][m][n]; const int c = col0 + bj * HALF + n * 16;
                        if (u.pn < 4) { u32x2 w; w.x = cvt_pk_bf16(v[0], v[1]); w.y = cvt_pk_bf16(v[2], v[3]); *(u32x2*)(Kb + (size_t)r * 1024 + c) = w; }
                        else { const int cc = c - 1024, h = cc >> 8, d = cc & 255, b = r >> 8, mm = r & 255;
                            const int idx = (mm >> 5) * 32 + ((mm >> 2) & 3) * 8 + ((mm >> 4) & 1) * 4 + (mm & 3);
                            bf16_t* o = VT + ((size_t)((b * 4 + h) * 256 + d)) * 256 + idx;
                            const unsigned w0 = cvt_pk_bf16(v[0], v[1]), w1 = cvt_pk_bf16(v[2], v[3]);
                            o[0] = (bf16_t)(w0 & 0xffffu); o[256] = (bf16_t)(w0 >> 16); o[512] = (bf16_t)(w1 & 0xffffu); o[768] = (bf16_t)(w1 >> 16); } } }
    }
};
struct EpiBranch {
    static constexpr bool PERM = false, AFTER_DRAIN = false; static constexpr int MIDK = 0; static constexpr int WSCALE = 0x7f7f7f7f;
    const bf16_t* P; int ldp; int gcol0; float* macc; bf16_t* merged;
    __device__ __forceinline__ void operator()(const f32x4 (&acc)[2][2][4][2], const Unit& u, int wr, int wc, int fr, int fq) const {
        const int br = u.pm >> 6, pm = u.pm & 63, pn = u.pn & 7;
        const int row0 = pm * BM + wr * 64 + fr, col0 = pn * BM + wc * 32 + 4 * fq;
#pragma unroll
        for (int ai = 0; ai < 2; ++ai)
#pragma unroll
            for (int m = 0; m < 4; ++m) { const int r = row0 + ai * HALF + m * 16; const bf16_t* prow = P + (size_t)r * ldp + gcol0 + br * 2048;
#pragma unroll
                for (int bj = 0; bj < 2; ++bj)
#pragma unroll
                    for (int n = 0; n < 2; ++n) { const int c = col0 + bj * HALF + n * 16; const u32x2 gw = *(const u32x2*)(prow + c);
                        f32x4 g; g[0] = fsigmoid(bf_lo(gw.x)); g[1] = fsigmoid(bf_hi(gw.x)); g[2] = fsigmoid(bf_lo(gw.y)); g[3] = fsigmoid(bf_hi(gw.y));
                        f32x4 v = acc[ai][bj][m][n] * g; float* mp = macc + (size_t)r * 2048 + c;
                        if (br > 0) v = v + *(const f32x4*)mp;
                        if (br < 2) *(f32x4*)mp = v;
                        else { u32x2 w; w.x = cvt_pk_bf16(v[0], v[1]); w.y = cvt_pk_bf16(v[2], v[3]); *(u32x2*)(merged + (size_t)r * 2048 + c) = w; } }
                asm volatile("" ::: "memory"); }
    }
};
struct EpiSwiglu {
    static constexpr bool PERM = true, AFTER_DRAIN = false; static constexpr int MIDK = 0; static constexpr int WSCALE = 0x79797979;
    unsigned char* H; const float* bg; const float* bu;
    __device__ __forceinline__ void operator()(const f32x4 (&acc)[2][2][4][2], const Unit& u, int wr, int wc, int fr, int fq) const {
        int tz_ = threadIdx.x; asm volatile("" : "+v"(tz_)); { const int wid_ = tz_ >> 6, lane_ = tz_ & 63; wr = wid_ >> 2; wc = wid_ & 3; fr = lane_ & 15; fq = lane_ >> 4; }
        const int e = u.pn >> 4, ct = u.pn & 15;
        const int row0 = u.pm * BM + wr * 64 + fr, col0 = ct * 128 + wc * 32 + 8 * fq;
        f32x4 bgv[2], buv[2];
#pragma unroll
        for (int n = 0; n < 2; ++n) { bgv[n] = *(const f32x4*)(bg + (size_t)e * 2048 + col0 + 4 * n); buv[n] = *(const f32x4*)(bu + (size_t)e * 2048 + col0 + 4 * n); }
#pragma unroll
        for (int ai = 0; ai < 2; ++ai)
#pragma unroll
            for (int m = 0; m < 4; ++m) { unsigned char* rowp = H + (size_t)(row0 + ai * HALF + m * 16) * 2048 + col0;
                f32x4 o[2];
#pragma unroll
                for (int n = 0; n < 2; ++n) { const f32x4 g = acc[ai][0][m][n] + bgv[n], up = acc[ai][1][m][n] + buv[n];
#pragma unroll
                    for (int j = 0; j < 4; ++j) { const float hg = fminf(g[j], 7.0f), hu = fminf(fmaxf(up[j], -7.0f), 7.0f); o[n][j] = (hu + 1.0f) * hg * fsigmoid(1.702f * hg); } }
                u32x2 w; { int t0 = __builtin_amdgcn_cvt_pk_fp8_f32(o[0][0], o[0][1], 0, false); t0 = __builtin_amdgcn_cvt_pk_fp8_f32(o[0][2], o[0][3], t0, true); int t1 = __builtin_amdgcn_cvt_pk_fp8_f32(o[1][0], o[1][1], 0, false); t1 = __builtin_amdgcn_cvt_pk_fp8_f32(o[1][2], o[1][3], t1, true); w.x = (unsigned)t0; w.y = (unsigned)t1; }
                *(u32x2*)rowp = w; }
    }
};
struct EpiDown {
    static constexpr bool PERM = true, AFTER_DRAIN = false; static constexpr int MIDK = 0; static constexpr int WSCALE = 0x79797979;
    bf16_t* O; const float* bd; const float* rowgate;
    __device__ __forceinline__ void operator()(const f32x4 (&acc)[2][2][4][2], const Unit& u, int wr, int wc, int fr, int fq) const {
        int tz_ = threadIdx.x; asm volatile("" : "+v"(tz_)); { const int wid_ = tz_ >> 6, lane_ = tz_ & 63; wr = wid_ >> 2; wc = wid_ & 3; fr = lane_ & 15; fq = lane_ >> 4; }
        const int e = u.pn >> 3, ct = u.pn & 7;
        const int row0 = u.pm * BM + wr * 64 + fr, col0 = ct * BM + wc * 32 + 8 * fq;
        f32x4 bv[2][2];
#pragma unroll
        for (int bj = 0; bj < 2; ++bj)
#pragma unroll
            for (int n = 0; n < 2; ++n) bv[bj][n] = *(const f32x4*)(bd + (size_t)e * 2048 + col0 + bj * HALF + 4 * n);
#pragma unroll
        for (int ai = 0; ai < 2; ++ai)
#pragma unroll
            for (int m = 0; m < 4; ++m) { const int r = row0 + ai * HALF + m * 16; const float gs = rowgate[r]; bf16_t* rowp = O + (size_t)r * 2048 + col0;
#pragma unroll
                for (int bj = 0; bj < 2; ++bj) { const f32x4 v0 = (acc[ai][bj][m][0] + bv[bj][0]) * gs, v1 = (acc[ai][bj][m][1] + bv[bj][1]) * gs;
                    u32x4 w; w.x = cvt_pk_bf16(v0[0], v0[1]); w.y = cvt_pk_bf16(v0[2], v0[3]); w.z = cvt_pk_bf16(v1[0], v1[1]); w.w = cvt_pk_bf16(v1[2], v1[3]);
                    *(u32x4*)(rowp + bj * HALF) = w; } }
    }
};

struct EpiBranch2 {
    static constexpr bool PERM = false, AFTER_DRAIN = false; static constexpr int MIDK = 16; static constexpr int WSCALE = 0x7f7f7f7f;
    const bf16_t* P; int ldp; int gcol0; bf16_t* merged;
    __device__ __forceinline__ void mid(f32x4 (&acc)[2][2][4][2], const Unit& u, int which, int, int, int, int) const {
        int tz = threadIdx.x; asm volatile("" : "+v"(tz));
        const int wid_ = tz >> 6, lane_ = tz & 63, wr = wid_ >> 2, wc = wid_ & 3, fr = lane_ & 15, fq = lane_ >> 4;
        const int row0 = u.pm * BM + wr * 64 + fr, col0 = u.pn * BM + wc * 32 + 4 * fq;
#pragma unroll
        for (int ai = 0; ai < 2; ++ai)
#pragma unroll
            for (int m = 0; m < 4; ++m) { const bf16_t* prow = P + (size_t)(row0 + ai * HALF + m * 16) * ldp + gcol0 + (which - 1) * 2048;
#pragma unroll
                for (int bj = 0; bj < 2; ++bj)
#pragma unroll
                    for (int n = 0; n < 2; ++n) { const int c = col0 + bj * HALF + n * 16; const u32x2 ga = *(const u32x2*)(prow + c), gb = *(const u32x2*)(prow + 2048 + c);
                        const float a_[4] = {bf_lo(ga.x), bf_hi(ga.x), bf_lo(ga.y), bf_hi(ga.y)}, b_[4] = {bf_lo(gb.x), bf_hi(gb.x), bf_lo(gb.y), bf_hi(gb.y)};
#pragma unroll
                        for (int j = 0; j < 4; ++j) { const float ea = __expf(-fminf(fmaxf(a_[j], -30.f), 30.f)), eb = __expf(-fminf(fmaxf(b_[j], -30.f), 30.f));
                            acc[ai][bj][m][n][j] *= (1.0f + eb) * __builtin_amdgcn_rcpf(1.0f + ea); } }
                asm volatile("" ::: "memory"); }
    }
    __device__ __forceinline__ void operator()(const f32x4 (&acc)[2][2][4][2], const Unit& u, int wr, int wc, int fr, int fq) const {
        const int row0 = u.pm * BM + wr * 64 + fr, col0 = u.pn * BM + wc * 32 + 4 * fq;
#pragma unroll
        for (int ai = 0; ai < 2; ++ai)
#pragma unroll
            for (int m = 0; m < 4; ++m) { const int r = row0 + ai * HALF + m * 16; const bf16_t* prow = P + (size_t)r * ldp + gcol0 + 2 * 2048;
#pragma unroll
                for (int bj = 0; bj < 2; ++bj)
#pragma unroll
                    for (int n = 0; n < 2; ++n) { const int c = col0 + bj * HALF + n * 16; const u32x2 gw = *(const u32x2*)(prow + c);
                        const float g_[4] = {bf_lo(gw.x), bf_hi(gw.x), bf_lo(gw.y), bf_hi(gw.y)}; f32x4 v = acc[ai][bj][m][n];
#pragma unroll
                        for (int j = 0; j < 4; ++j) v[j] *= __builtin_amdgcn_rcpf(1.0f + __expf(-fminf(fmaxf(g_[j], -30.f), 30.f)));
                        u32x2 w; w.x = cvt_pk_bf16(v[0], v[1]); w.y = cvt_pk_bf16(v[2], v[3]); *(u32x2*)(merged + (size_t)r * 2048 + c) = w; }
                asm volatile("" ::: "memory"); }
    }
};
struct BranchOrder {                              static constexpr bool GATHER = false; __device__ __forceinline__ int arow(const Unit&, int) const { return 0; }
    StaticOrder so;
    __device__ void init(int G_, int c_) { so.init(16384, 2048, G_, c_); }
    __device__ bool next(int i, Unit& u) const { const int br = i % 3; Unit t; if (!so.next(i / 3, t)) return false; u.pm = br * 64 + t.pm; u.pn = br * 8 + t.pn; return true; }
    __device__ __forceinline__ void a_ready(const Unit&) const {}
    __device__ __forceinline__ void done(const Unit&) const {}
};
template <bool GATH> struct MoeOrder {
    static constexpr bool GATHER = GATH;
    StaticOrder so; const int* tile_e; const int* tok; int nN;
    __device__ void init(int ntiles, int nN_, int G_, int c_, const int* te, const int* tk) { so.init(ntiles * BM, nN_ * BM, G_, c_); tile_e = te; tok = tk; nN = nN_; }
    __device__ bool next(int i, Unit& u) const { Unit t; if (!so.next(i, t)) return false; u.pm = t.pm; u.pn = tile_e[t.pm] * nN + t.pn; return true; }
    __device__ __forceinline__ int arow(const Unit& u, int r) const { return tok[u.pm * BM + r]; }
    __device__ __forceinline__ void a_ready(const Unit&) const {}
    __device__ __forceinline__ void done(const Unit&) const {}
};
typedef int i32x4 __attribute__((ext_vector_type(4)));
typedef int i32x8 __attribute__((ext_vector_type(8)));
__device__ __forceinline__ i32x8 frag8(bf16x8 lo, bf16x8 hi) { return __builtin_shufflevector(__builtin_bit_cast(i32x4, lo), __builtin_bit_cast(i32x4, hi), 0, 1, 2, 3, 4, 5, 6, 7); }
template <class Epi, class Sched, bool ALIGN_EPI = false, bool SP2 = false, int ESZ = 2>
__device__ __forceinline__ void gemm_phase(PG8_LAS unsigned char* lds, const Gemm g, const Sched& S, const Epi& E) {
    int tid_ = threadIdx.x; asm volatile("" : "+v"(tid_));
    const int tid = tid_, wid = __builtin_amdgcn_readfirstlane(tid >> 6), lane = tid & 63, wr = wid >> 2, wc = wid & 3, fr = lane & 15, fq = lane >> 4;
    const int K = g.K, nt = K / (BK * 2 / ESZ);
    const __amdgpu_buffer_rsrc_t rsA = __builtin_amdgcn_make_buffer_rsrc((void*)g.A, 0, 0x7fffffff, 0x00020000), rsB = __builtin_amdgcn_make_buffer_rsrc((void*)g.Bt, 0, 0x7fffffff, 0x00020000);
    unsigned voffA[2], voffB[2];
#pragma unroll
    for (int i = 0; i < 2; ++i) { int R, C; stage_rc(tid * 16 + i * 8192, R, C); const int Rb = Epi::PERM ? ((R & ~31) + perm32(R & 31)) : R;
        voffA[i] = (unsigned)(R * K) * (unsigned)ESZ + (unsigned)C * 2u; voffB[i] = (unsigned)(Rb * K) * (unsigned)ESZ + (unsigned)C * 2u; }
    unsigned vc[2][2] = {{0u, 0u}, {0u, 0u}}, vn[2][2] = {{0u, 0u}, {0u, 0u}};
#define PG8_ROWS(dst, un) do { if constexpr (Sched::GATHER) { _Pragma("unroll") for (int _h = 0; _h < 2; ++_h) _Pragma("unroll") for (int _i = 0; _i < 2; ++_i) { int R_, C_; stage_rc(tid * 16 + _i * 8192, R_, C_); \
        dst[_h][_i] = (unsigned)(S.arow(un, _h * HALF + R_) * K) * (unsigned)ESZ + (unsigned)C_ * 2u; } } } while (0)
#define PG8_STAGE_A(bufoff, abase, half, nx) do { if constexpr (Sched::GATHER) { unsigned vo_[2]; vo_[0] = (nx) ? vn[half][0] : vc[half][0]; vo_[1] = (nx) ? vn[half][1] : vc[half][1]; PG8_STAGE_R(bufoff, rsA, g.A, abase, vo_); } \
        else { PG8_STAGE_R(bufoff, rsA, g.A, (abase) + (half) * hstep, voffA); } } while (0)
    const size_t kstep = (size_t)(BK * 2);
    const size_t hstep = (size_t)HALF * K * ESZ;
    const size_t tstep = 2 * hstep;
    const unsigned ldsw = (unsigned)wid * 1024u;
    const int aoff = lds_byte(wr * 64 + fr, fq * 8), boff = lds_byte(wc * 32 + fr, fq * 8);
    const int aoffE = lds_byte(wr * 64 + fr, fq * 16), boffE = lds_byte(wc * 32 + fr, fq * 16);
#define PG8_SA(b, h) (((b) * 2 + (h)) * HTB)
#define PG8_SB(b, h) ((4 + (b) * 2 + (h)) * HTB)
#define PG8_STAGE_R(bufoff, rs, b0, gbase, voff) do { const int so_ = (int)((const char*)(gbase) - (const char*)(b0)); _Pragma("unroll") for (int _i = 0; _i < 2; ++_i) \
        __builtin_amdgcn_raw_ptr_buffer_load_lds(rs, (PG8_LAS void*)(lds + (bufoff) + ldsw + _i * 8192), 16, (int)(voff)[_i], so_, 0, 0); } while (0)
#define PG8_STAGE(bufoff, gbase, voff) PG8_STAGE_R(bufoff, rsB, g.Bt, gbase, voff)
#define PG8_LDA(dst, b, h) do { if constexpr (ESZ == 2) { _Pragma("unroll") for (int m = 0; m < 4; ++m) _Pragma("unroll") for (int k = 0; k < 2; ++k) dst[m][k] = *(const PG8_LAS bf16x8*)(lds + PG8_SA(b, h) + aoff + m * 2048 + k * 1024); } \
        else { _Pragma("unroll") for (int m = 0; m < 4; ++m) { dst##8[m].lo = *(const PG8_LAS i32x4*)(lds + PG8_SA(b, h) + aoffE + m * 2048); dst##8[m].hi = *(const PG8_LAS i32x4*)(lds + PG8_SA(b, h) + aoffE + 16 + m * 2048); } } } while (0)
#define PG8_LDB(dst, b, h) do { if constexpr (ESZ == 2) { _Pragma("unroll") for (int n = 0; n < 2; ++n) _Pragma("unroll") for (int k = 0; k < 2; ++k) dst[n][k] = *(const PG8_LAS bf16x8*)(lds + PG8_SB(b, h) + boff + n * 2048 + k * 1024); } \
        else { _Pragma("unroll") for (int n = 0; n < 2; ++n) { dst##8[n].lo = *(const PG8_LAS i32x4*)(lds + PG8_SB(b, h) + boffE + n * 2048); dst##8[n].hi = *(const PG8_LAS i32x4*)(lds + PG8_SB(b, h) + boffE + 16 + n * 2048); } } } while (0)
#define PG8_MMA(ai, bj, At, Bt) do { __builtin_amdgcn_s_setprio(1); _Pragma("unroll") for (int m = 0; m < 4; ++m) _Pragma("unroll") for (int n = 0; n < 2; ++n) { if constexpr (ESZ == 2) { _Pragma("unroll") for (int k = 0; k < 2; ++k) \
        acc[ai][bj][m][n] = __builtin_amdgcn_mfma_f32_16x16x32_bf16(Bt[n][k], At[m][k], acc[ai][bj][m][n], 0, 0, 0); } else { \
        acc[ai][bj][m][n] = __builtin_amdgcn_mfma_scale_f32_16x16x128_f8f6f4(Bt##8[n], At##8[m], acc[ai][bj][m][n], 0, 0, 0, Epi::WSCALE, 0, 0x7f7f7f7f); } } __builtin_amdgcn_s_setprio(0); } while (0)
#define PG8_WAIT_V(n) asm volatile("s_waitcnt vmcnt(" #n ")" ::: "memory")
#define PG8_WAIT_L(n) asm volatile("s_waitcnt lgkmcnt(" #n ")" ::: "memory")
#define PG8_BAR __builtin_amdgcn_s_barrier()
#define PG8_SCHED __builtin_amdgcn_sched_barrier(0)
    Unit cur, nxt; int ui = 0;
    if (!S.next(0, cur)) return;
    f32x4 acc[2][2][4][2];
#pragma unroll
    for (int a = 0; a < 2; ++a)
#pragma unroll
        for (int b = 0; b < 2; ++b)
#pragma unroll
            for (int m = 0; m < 4; ++m)
#pragma unroll
                for (int n = 0; n < 2; ++n) acc[a][b][m][n] = (f32x4){0.f, 0.f, 0.f, 0.f};
    bf16x8 At[4][2], B0[2][2], B1[2][2];
    i32x8 At8[4], B08[2], B18[2];
    const char* cA = (const char*)g.A + (Sched::GATHER ? (size_t)0 : (size_t)cur.pm * tstep); const char* cB = (const char*)g.Bt + (size_t)cur.pn * tstep;
    PG8_ROWS(vc, cur);
    S.a_ready(cur);
    if constexpr (SP2) {
        PG8_STAGE(PG8_SB(0, 0), cB, voffB); PG8_STAGE(PG8_SB(0, 1), cB + hstep, voffB); PG8_STAGE_A(PG8_SA(0, 0), cA, 0, false); PG8_STAGE_A(PG8_SA(0, 1), cA, 1, false);
        if (wr == 1) PG8_BAR;
        PG8_WAIT_V(2); PG8_BAR;
        PG8_STAGE(PG8_SB(1, 0), cB + kstep, voffB); PG8_STAGE_A(PG8_SA(1, 0), cA + kstep, 0, false); PG8_STAGE(PG8_SB(1, 1), cB + hstep + kstep, voffB);
        PG8_WAIT_V(6); PG8_BAR;
    } else {
        PG8_STAGE(PG8_SB(0, 0), cB, voffB); PG8_STAGE_A(PG8_SA(0, 0), cA, 0, false); PG8_STAGE(PG8_SB(0, 1), cB + hstep, voffB); PG8_STAGE_A(PG8_SA(0, 1), cA, 1, false);
        if (wr == 1) PG8_BAR;
        PG8_WAIT_V(4); PG8_BAR;
        PG8_STAGE(PG8_SB(1, 0), cB + kstep, voffB); PG8_STAGE_A(PG8_SA(1, 0), cA + kstep, 0, false); PG8_STAGE(PG8_SB(1, 1), cB + hstep + kstep, voffB);
        PG8_WAIT_V(6); PG8_BAR;
    }
    for (;;) {
        const bool has_next = S.next(ui + 1, nxt);
        if (has_next) PG8_ROWS(vn, nxt);
        const char* nA = (has_next && !Sched::GATHER) ? (const char*)g.A + (size_t)nxt.pm * tstep : cA; const char* nB = has_next ? (const char*)g.Bt + (size_t)nxt.pn * tstep : cB;
        for (int t = 0; t < nt; t += 2) {
            const bool last = (t == nt - 2);
            const char* a1 = cA + (size_t)(t + 1) * kstep;
            const char* a2 = last ? nA : cA + (size_t)(t + 2) * kstep; const char* b2 = last ? nB : cB + (size_t)(t + 2) * kstep;
            const char* a3 = a2 + kstep; const char* b3 = b2 + kstep;
            if (last && has_next) S.a_ready(nxt);
            if constexpr (Epi::MIDK > 0) { if (t == Epi::MIDK || t == 2 * Epi::MIDK) E.mid(acc, cur, t / Epi::MIDK, wr, wc, fr, fq); }
            if constexpr (SP2) {
            PG8_LDB(B0, 0, 0); PG8_LDB(B1, 0, 1); PG8_SCHED; PG8_LDA(At, 0, 0); PG8_STAGE_A(PG8_SA(1, 1), a1, 1, false);
            PG8_WAIT_V(8); PG8_WAIT_L(0); PG8_BAR; PG8_MMA(0, 0, At, B0); PG8_MMA(0, 1, At, B1); PG8_BAR; PG8_SCHED;
            PG8_LDA(At, 0, 1); PG8_STAGE(PG8_SB(0, 0), b2, voffB); PG8_STAGE(PG8_SB(0, 1), b2 + hstep, voffB); PG8_STAGE_A(PG8_SA(0, 0), a2, 0, last);
            PG8_WAIT_V(8); PG8_WAIT_L(0); PG8_BAR; PG8_MMA(1, 0, At, B0); PG8_MMA(1, 1, At, B1); PG8_BAR; PG8_SCHED;
            PG8_LDB(B0, 1, 0); PG8_LDB(B1, 1, 1); PG8_SCHED; PG8_LDA(At, 1, 0); PG8_STAGE_A(PG8_SA(0, 1), a2, 1, last);
            PG8_WAIT_V(8); PG8_WAIT_L(0); PG8_BAR; PG8_MMA(0, 0, At, B0); PG8_MMA(0, 1, At, B1); PG8_BAR; PG8_SCHED;
            PG8_LDA(At, 1, 1); PG8_STAGE(PG8_SB(1, 0), b3, voffB); PG8_STAGE(PG8_SB(1, 1), b3 + hstep, voffB); PG8_STAGE_A(PG8_SA(1, 0), a3, 0, last);
            PG8_WAIT_V(8); PG8_WAIT_L(0); PG8_BAR; PG8_MMA(1, 0, At, B0); PG8_MMA(1, 1, At, B1); PG8_BAR; PG8_SCHED;
            } else {
            PG8_LDB(B0, 0, 0); PG8_SCHED; PG8_LDA(At, 0, 0); PG8_STAGE_A(PG8_SA(1, 1), a1, 1, false);
            PG8_WAIT_L(8); PG8_BAR; PG8_WAIT_L(0); PG8_MMA(0, 0, At, B0); PG8_BAR; PG8_SCHED;
            PG8_LDB(B1, 0, 1); PG8_STAGE(PG8_SB(0, 0), b2, voffB);
            PG8_BAR; PG8_WAIT_L(0); PG8_MMA(0, 1, At, B1); PG8_BAR;
            PG8_LDA(At, 0, 1); PG8_STAGE_A(PG8_SA(0, 0), a2, 0, last);
            PG8_BAR; PG8_WAIT_L(0); PG8_MMA(1, 0, At, B0); PG8_BAR; PG8_SCHED;
            PG8_STAGE(PG8_SB(0, 1), b2 + hstep, voffB);
            PG8_WAIT_V(6); PG8_BAR; PG8_MMA(1, 1, At, B1); PG8_BAR;
            PG8_LDB(B0, 1, 0); PG8_SCHED; PG8_LDA(At, 1, 0); PG8_STAGE_A(PG8_SA(0, 1), a2, 1, last);
            PG8_WAIT_L(8); PG8_BAR; PG8_WAIT_L(0); PG8_MMA(0, 0, At, B0); PG8_BAR; PG8_SCHED;
            PG8_LDB(B1, 1, 1); PG8_STAGE(PG8_SB(1, 0), b3, voffB);
            PG8_BAR; PG8_WAIT_L(0); PG8_MMA(0, 1, At, B1); PG8_BAR;
            PG8_LDA(At, 1, 1); PG8_STAGE_A(PG8_SA(1, 0), a3, 0, last);
            PG8_BAR; PG8_WAIT_L(0); PG8_MMA(1, 0, At, B0); PG8_BAR; PG8_SCHED;
            PG8_STAGE(PG8_SB(1, 1), b3 + hstep, voffB);
            PG8_WAIT_V(6); PG8_BAR; PG8_MMA(1, 1, At, B1); PG8_BAR;
            }
        }
        if constexpr (ALIGN_EPI) { if (wr == 0) PG8_BAR; }
        if constexpr (!Epi::AFTER_DRAIN) { E(acc, cur, wr, wc, fr, fq); S.done(cur); }
        if (!has_next) break;
#pragma unroll
        for (int a = 0; a < 2; ++a)
#pragma unroll
            for (int b = 0; b < 2; ++b)
#pragma unroll
                for (int m = 0; m < 4; ++m)
#pragma unroll
                    for (int n = 0; n < 2; ++n) acc[a][b][m][n] = (f32x4){0.f, 0.f, 0.f, 0.f};
        cur = nxt; cA = nA; cB = nB; ++ui;
        if constexpr (Sched::GATHER) { vc[0][0] = vn[0][0]; vc[0][1] = vn[0][1]; vc[1][0] = vn[1][0]; vc[1][1] = vn[1][1]; }
        if constexpr (ALIGN_EPI) { if (wr == 1) PG8_BAR; }
    }
    PG8_WAIT_V(0);
    if constexpr (!ALIGN_EPI) { if (wr == 0) PG8_BAR; }
    PG8_BAR;
    if constexpr (Epi::AFTER_DRAIN) { E.fused(acc, cur, wr, wc, fr, fq, lds, wid, lane); S.done(cur); }
#undef PG8_SA
#undef PG8_SB
#undef PG8_STAGE
#undef PG8_STAGE_R
#undef PG8_STAGE_A
#undef PG8_ROWS
#undef PG8_LDA
#undef PG8_LDB
#undef PG8_MMA
#undef PG8_WAIT_V
#undef PG8_WAIT_L
#undef PG8_BAR
#undef PG8_SCHED
}
}

constexpr int NWAVES = 8;
constexpr int BATCH = 2, SEQ = 8192, T = BATCH * SEQ, D = 2048;
constexpr int RWKV_COLS = 3360, IN_COLS = 12576;
constexpr int NP = 12800;
constexpr int PC_LX = 3584, PC_LY = 4608, PC_Q = 5632, PC_G = 6656;
constexpr int NE = 32, MAXROWS = 65536 + NE * 256;
constexpr int LORA_K = 384;
constexpr float EPS = 1e-6f, GN_EPS = 64e-5f;

constexpr size_t MiB = 1u << 20;
constexpr size_t WS_CTL = 0, CTL_ZERO_BYTES = 1 * MiB;
constexpr size_t WS_WIN = 1 * MiB, WS_WMKV = 51 * MiB, WS_WLORA = 59 * MiB, WS_WBR = 62 * MiB, WS_WO = 74 * MiB, WS_WR = 82 * MiB, WS_LW = 83 * MiB;
constexpr size_t WS_WGU = 84 * MiB, WS_WD = 596 * MiB;
constexpr size_t WS_WIN8 = WS_WIN + 27 * MiB;
constexpr size_t WS_XN8 = 1508 * MiB;
constexpr size_t WS_XN = 852 * MiB;
constexpr size_t WS_P = 916 * MiB;
constexpr size_t WS_LORAOUT = 1316 * MiB;
constexpr size_t WS_SCAN = 1508 * MiB;
constexpr size_t WS_YABC = 1892 * MiB;
constexpr size_t WS_MISC = 1988 * MiB;
constexpr size_t WS_MN = WS_MISC, WS_KMEM = WS_MISC + 2 * MiB, WS_VT = WS_MISC + 3 * MiB, WS_LRUC = WS_MISC + 4 * MiB  , WS_BONUS = WS_MISC + 7 * MiB;
constexpr size_t WS_PICK = WS_MISC + 8 * MiB  , WS_ROWTAB = WS_MISC + 9 * MiB  , WS_SPL = WS_ROWTAB + 512 * 1024  ;
constexpr size_t WS_END = 2000 * MiB;
constexpr size_t WS_MACC = WS_LORAOUT, WS_MERGED = 1444 * MiB, WS_H1 = WS_SCAN, WS_XS = WS_P, WS_OROW = WS_P, WS_HH = 1204 * MiB;
constexpr int CW_BAR = 4096, CW_CNT = 8192, CW_NTILES = 8192 + 64, CW_TILEE = 8192 + 128;

constexpr int LDS_BYTES = 147456;
constexpr int MISC_OFF = 143360;

#define GAS __attribute__((address_space(1)))
#define LAS __attribute__((address_space(3)))
typedef unsigned short bf16;
typedef unsigned v4u __attribute__((ext_vector_type(4)));
typedef unsigned v2u __attribute__((ext_vector_type(2)));
typedef float f32x4 __attribute__((ext_vector_type(4)));
typedef float f32x2 __attribute__((ext_vector_type(2)));
typedef short bf16x8 __attribute__((ext_vector_type(8)));
#define LDS_WAIT() asm volatile("s_waitcnt lgkmcnt(0)" ::: "memory")
#define VM_WAIT() asm volatile("s_waitcnt vmcnt(0)" ::: "memory")
__device__ __forceinline__ unsigned f2bf(float f) { unsigned u = __builtin_bit_cast(unsigned, f); return (u + 0x7fffu + ((u >> 16) & 1u)) >> 16; }
__device__ __forceinline__ unsigned pk2(float lo, float hi) { return f2bf(lo) | (f2bf(hi) << 16); }
__device__ __forceinline__ float bflo(unsigned w) { return __builtin_bit_cast(float, w << 16); }
__device__ __forceinline__ float bfhi(unsigned w) { return __builtin_bit_cast(float, w & 0xffff0000u); }
__device__ __forceinline__ float bf1(bf16 b) { return __builtin_bit_cast(float, (unsigned)b << 16); }
__device__ __forceinline__ float sigm(float x) { return __builtin_amdgcn_rcpf(1.0f + __expf(-x)); }
__device__ __forceinline__ float fast_tanh(float x) { const float e = __expf(2.0f * x); return 1.0f - 2.0f * __builtin_amdgcn_rcpf(e + 1.0f); }
__device__ __forceinline__ float softplusf(float x) { return fmaxf(x, 0.f) + log1pf(__expf(-fabsf(x))); }
__device__ __forceinline__ float wave_sum(float v) {
#pragma unroll
    for (int o = 1; o < 64; o <<= 1) v += __shfl_xor(v, o);
    return v;
}
template <int CTRL> __device__ __forceinline__ float dppf(float x) { return __builtin_bit_cast(float, __builtin_amdgcn_mov_dpp(__builtin_bit_cast(int, x), CTRL, 0xf, 0xf, true)); }
__device__ __forceinline__ float row16_sum(float v) {
    v += dppf<0xB1>(v); v += dppf<0x4E>(v); v += dppf<0x141>(v); v += dppf<0x140>(v); return v;
}
#define XB_TMO      128
#define XB_XCNT(j)  (256  + 64 * (j))
#define XB_XSUB(j)  (1280 + 64 * (j))
#define XB_XGEN(j)  (2304 + 64 * (j))
#define XB_TOP      3328
#define XB_TOPGEN   3392
#define XCD_BAR_WORDS 3456
#define XB_SPIN_CAP (1u << 18)

__device__ __forceinline__ unsigned xb_ld(unsigned* p)              { return __hip_atomic_load(p, __ATOMIC_RELAXED, __HIP_MEMORY_SCOPE_AGENT); }
__device__ __forceinline__ unsigned xb_add(unsigned* p, unsigned v) { return __hip_atomic_fetch_add(p, v, __ATOMIC_RELAXED, __HIP_MEMORY_SCOPE_AGENT); }
__device__ __forceinline__ unsigned xb_xcc_id() { return (unsigned)__builtin_amdgcn_s_getreg((3 << 11) | 20) & 0xFu; }
#define XB_SPIN(cond, bar) do { unsigned _sp = 0; while (cond) { __builtin_amdgcn_s_sleep(1); \
    if ((++_sp & 255u) == 0u) { if (xb_ld(&(bar)[XB_TMO])) break; if (_sp > XB_SPIN_CAP) { atomicAdd(&(bar)[XB_TMO], 1u); break; } } } } while (0)

struct XcdBarrier {
    unsigned* bar; unsigned x;
    volatile LAS unsigned* st;
};

__device__ __forceinline__ XcdBarrier xcd_barrier_post(unsigned* bar, volatile LAS unsigned* st) {
    XcdBarrier b; b.bar = bar; b.x = xb_xcc_id(); b.st = st;
    if (threadIdx.x == 0) (void)xb_add(&bar[XB_XCNT(b.x)], 1u);
    return b;
}
__device__ __forceinline__ void xcd_barrier_complete(unsigned* bar, unsigned x, unsigned& nloc, unsigned& nx) {
    const unsigned G = gridDim.x * gridDim.y * gridDim.z;
    unsigned sum, cnt, mine, sp = 0u;
    for (;;) {
        sum = 0u; cnt = 0u; mine = 0u;
#pragma unroll
        for (unsigned j = 0; j < 16; ++j) { const unsigned c = xb_ld(&bar[XB_XCNT(j)]); sum += c; cnt += (c > 0u) ? 1u : 0u; mine = (j == x) ? c : mine; }
        if (sum == G) break;
        __builtin_amdgcn_s_sleep(1);
        if ((++sp & 255u) == 0u) { if (xb_ld(&bar[XB_TMO])) break; if (sp > XB_SPIN_CAP) { atomicAdd(&bar[XB_TMO], 1u); break; } }
    }
    nloc = mine > 0u ? mine : 1u; nx = cnt > 0u ? cnt : 1u;
}

__device__ __forceinline__ void xcd_barrier(const XcdBarrier& b) {
    asm volatile("s_waitcnt vmcnt(0)" ::: "memory");
    __syncthreads();
    if (threadIdx.x == 0) {
        unsigned* bar = b.bar;
        __builtin_amdgcn_s_waitcnt(0);
        unsigned nloc = b.st[0], nx = b.st[1];
        if (nloc == 0u) { xcd_barrier_complete(bar, b.x, nloc, nx); b.st[0] = nloc; b.st[1] = nx; }
        const unsigned old = xb_add(&bar[XB_XSUB(b.x)], 1u);
        const unsigned gen = old / nloc;
        if (old + 1u == (gen + 1u) * nloc) {
            __builtin_amdgcn_fence(__ATOMIC_RELEASE, "agent");
            asm volatile("s_waitcnt vmcnt(0)" ::: "memory");
            const unsigned og = xb_add(&bar[XB_TOP], 1u);
            const unsigned tg = og / nx;
            if (og + 1u == (tg + 1u) * nx) xb_add(&bar[XB_TOPGEN], 1u);
            else XB_SPIN(xb_ld(&bar[XB_TOPGEN]) == tg, bar);
            __builtin_amdgcn_fence(__ATOMIC_ACQUIRE, "agent");
            xb_add(&bar[XB_XGEN(b.x)], 1u);
            asm volatile("s_waitcnt vmcnt(0)" ::: "memory");
        } else {
            XB_SPIN(xb_ld(&bar[XB_XGEN(b.x)]) == gen, bar);
            __builtin_amdgcn_fence(__ATOMIC_ACQUIRE, "agent");
            asm volatile("s_waitcnt vmcnt(0)" ::: "memory");
        }
    }
    __syncthreads();
}

struct Frame {
    LAS unsigned char* lds;
    volatile LAS unsigned* MISC;
    int tid, lane, wave, vcu, G;
};
struct Args { const float* in[39]; float* out; unsigned char* ws; int ph_lo, ph_hi; };
enum { I_X = 0, I_MEM, I_GMIX, I_WIN, I_MU, I_W0, I_W2, I_A0, I_A2, I_G2, I_KK, I_KA, I_RK, I_LNW, I_LNB, I_WRO, I_CONVW, I_CONVB, I_LWR, I_LBR, I_LWI, I_LBI, I_LAM, I_WLO,
       I_GMEM, I_WMK, I_WMV, I_WXO, I_WOUT, I_GFFN, I_WROUTER, I_BROUTER, I_WGATE, I_BGATE, I_WUP, I_BUP, I_WDOWN, I_BDOWN, I_GFINAL };


__device__ __forceinline__ const float* inp(int k) {
    typedef const volatile unsigned long long __attribute__((address_space(4))) ka_t;
    ka_t* ka = (ka_t*)__builtin_amdgcn_kernarg_segment_ptr();
    return (const float*)ka[k];
}
template <int NB> __device__ __forceinline__ void transpose_item(const float* W, int N, int k0, int n0, bf16* WT, int Kd, int drow0, int lane, int kdo = 0) {
    constexpr int LPR = NB / 4, G = 64 / LPR, KR = 64 / G;
    const int g = lane / LPR, c = lane % LPR;
    const GAS float* src = (const GAS float*)W + (size_t)(k0 + KR * g) * N + n0 + 4 * c;
    f32x4 ld[KR];
#pragma unroll
    for (int i = 0; i < KR; ++i) ld[i] = __builtin_nontemporal_load((const GAS f32x4*)(src + (size_t)i * N));
    GAS bf16* dst = (GAS bf16*)WT + (size_t)(drow0 + 4 * c) * Kd + kdo + k0 + KR * g;
#pragma unroll
    for (int j = 0; j < 4; ++j)
#pragma unroll
        for (int q = 0; q < KR / 8; ++q) { v4u o; o.x = pk2(ld[8 * q + 0][j], ld[8 * q + 1][j]); o.y = pk2(ld[8 * q + 2][j], ld[8 * q + 3][j]); o.z = pk2(ld[8 * q + 4][j], ld[8 * q + 5][j]); o.w = pk2(ld[8 * q + 6][j], ld[8 * q + 7][j]);
            *(GAS v4u*)(dst + (size_t)j * Kd + 8 * q) = o; }
}
__device__ __forceinline__ unsigned pk4_fp8(float a, float b, float c, float d) { int w = __builtin_amdgcn_cvt_pk_fp8_f32(a, b, 0, false); w = __builtin_amdgcn_cvt_pk_fp8_f32(c, d, w, true); return (unsigned)w; }
__device__ __forceinline__ void transpose_item_fp8(const float* W, int N, int k0, int n0, unsigned char* WT, int Kd, int drow0, int lane, float scale) {
    const int g = lane >> 4, c = lane & 15;
    const GAS float* src = (const GAS float*)W + (size_t)(k0 + 16 * g) * N + n0 + 4 * c;
    f32x4 ld[16];
#pragma unroll
    for (int i = 0; i < 16; ++i) ld[i] = __builtin_nontemporal_load((const GAS f32x4*)(src + (size_t)i * N)) * scale;
    GAS unsigned char* dst = (GAS unsigned char*)WT + (size_t)(drow0 + 4 * c) * Kd + k0 + 16 * g;
#pragma unroll
    for (int j = 0; j < 4; ++j) { v4u o; o.x = pk4_fp8(ld[0][j], ld[1][j], ld[2][j], ld[3][j]); o.y = pk4_fp8(ld[4][j], ld[5][j], ld[6][j], ld[7][j]); o.z = pk4_fp8(ld[8][j], ld[9][j], ld[10][j], ld[11][j]); o.w = pk4_fp8(ld[12][j], ld[13][j], ld[14][j], ld[15][j]);
        *(GAS v4u*)(dst + (size_t)j * Kd) = o; }
}
__device__ __forceinline__ void transpose_item_fp8_32(const float* W, int N, int k0, int n0, unsigned char* WT, int Kd, int drow0, int lane, float scale) {
    const int g = lane >> 3, c = lane & 7;
    const GAS float* src = (const GAS float*)W + (size_t)(k0 + 8 * g) * N + n0 + 4 * c;
    f32x4 ld[8];
#pragma unroll
    for (int i = 0; i < 8; ++i) ld[i] = __builtin_nontemporal_load((const GAS f32x4*)(src + (size_t)i * N)) * scale;
    GAS unsigned char* dst = (GAS unsigned char*)WT + (size_t)(drow0 + 4 * c) * Kd + k0 + 8 * g;
#pragma unroll
    for (int j = 0; j < 4; ++j) { v2u o; o.x = pk4_fp8(ld[0][j], ld[1][j], ld[2][j], ld[3][j]); o.y = pk4_fp8(ld[4][j], ld[5][j], ld[6][j], ld[7][j]); *(GAS v2u*)(dst + (size_t)j * Kd) = o; }
}
__device__ __forceinline__ void rms_row_to_bf16(const float* xrow, const float* gain, bf16* orow, int lane, unsigned char* orow8 = nullptr) {
    const GAS f32x4* xr = (const GAS f32x4*)xrow + lane; const GAS f32x4* gr = (const GAS f32x4*)gain + lane;
    f32x4 v[8]; float s = 0.f;
#pragma unroll
    for (int j = 0; j < 8; ++j) { v[j] = xr[64 * j]; s += (v[j].x * v[j].x + v[j].y * v[j].y) + (v[j].z * v[j].z + v[j].w * v[j].w); }
    const float rstd = 1.0f / sqrtf(wave_sum(s) * (1.f / D) + EPS);
    GAS v2u* o8 = (GAS v2u*)orow + lane;
#pragma unroll
    for (int j = 0; j < 8; ++j) { const f32x4 g = gr[64 * j]; v2u w; w.x = pk2(v[j].x * rstd * g.x, v[j].y * rstd * g.y); w.y = pk2(v[j].z * rstd * g.z, v[j].w * rstd * g.w); o8[64 * j] = w;
        if (orow8) ((GAS unsigned*)orow8)[lane + 64 * j] = pk4_fp8(v[j].x * rstd * g.x, v[j].y * rstd * g.y, v[j].z * rstd * g.z, v[j].w * rstd * g.w); }
}

__device__ __forceinline__ void p0_prologue(const Frame& F, const Args& a) {
    unsigned char* ws = a.ws;
    const int gw = F.vcu * NWAVES + F.wave, NGW = F.G * NWAVES;
    constexpr int I_IN = 32 * (IN_COLS / 32), I_MK = 32 * 32, I_BR = 16 * 64, I_O = 32 * 64;
    constexpr int NITEMS = I_IN + 2 * I_MK + 3 * I_BR + I_O;
    for (int it = gw; it < NITEMS; it += NGW) {
        int r = it;
        if (r < I_IN) { const int nb = IN_COLS / 32, kb = r / nb, n0 = 32 * (r % nb);
            if (n0 >= PC_G - 224) transpose_item_fp8_32(inp(I_WIN), IN_COLS, 64 * kb, n0, ws + WS_WIN8, D, n0 - (PC_G - 224), F.lane, 64.0f);
            else transpose_item<32>(inp(I_WIN), IN_COLS, 64 * kb, n0, (bf16*)(ws + WS_WIN), D, n0 + (n0 >= RWKV_COLS ? 224 : 0), F.lane);
            continue; } r -= I_IN;
        if (r < I_MK) { transpose_item<32>(inp(I_WMK), 1024, 64 * (r / 32), 32 * (r % 32), (bf16*)(ws + WS_WMKV), D, 32 * (r % 32), F.lane); continue; } r -= I_MK;
        if (r < I_MK) { transpose_item<32>(inp(I_WMV), 1024, 64 * (r / 32), 32 * (r % 32), (bf16*)(ws + WS_WMKV), D, 1024 + 32 * (r % 32), F.lane); continue; } r -= I_MK;
        if (r < I_BR) { transpose_item<32>(inp(I_WRO), 2048, 64 * (r / 64), 32 * (r % 64), (bf16*)(ws + WS_WBR), 3072, 32 * (r % 64), F.lane, 0); continue; } r -= I_BR;
        if (r < I_BR) { transpose_item<32>(inp(I_WLO), 2048, 64 * (r / 64), 32 * (r % 64), (bf16*)(ws + WS_WBR), 3072, 32 * (r % 64), F.lane, 1024); continue; } r -= I_BR;
        if (r < I_BR) { transpose_item<32>(inp(I_WXO), 2048, 64 * (r / 64), 32 * (r % 64), (bf16*)(ws + WS_WBR), 3072, 32 * (r % 64), F.lane, 2048); continue; } r -= I_BR;
        transpose_item<32>(inp(I_WOUT), 2048, 64 * (r / 64), 32 * (r % 64), (bf16*)(ws + WS_WO), D, 32 * (r % 64), F.lane);
    }
    for (int m = gw; m < T; m += NGW) rms_row_to_bf16(inp(I_X) + (size_t)m * D, inp(I_GMIX), (bf16*)(ws + WS_XN) + (size_t)m * D, F.lane, ws + WS_XN8 + (size_t)m * D);
    for (int m = gw; m < 512; m += NGW) rms_row_to_bf16(inp(I_MEM) + (size_t)m * D, inp(I_GMEM), (bf16*)(ws + WS_MN) + (size_t)m * D, F.lane);
    const int gt = F.vcu * (NWAVES * 64) + F.tid, NGT = F.G * NWAVES * 64;
    { bf16* wz = (bf16*)(ws + WS_WIN) + (size_t)RWKV_COLS * D; for (int i = gt; i < 224 * D / 2; i += NGT) ((GAS unsigned*)wz)[i] = 0u; }
    { bf16* wl = (bf16*)(ws + WS_WLORA);
      for (int i = gt; i < 3072 * LORA_K; i += NGT) { const int n = i / LORA_K, k = i % LORA_K; float v = 0.f;
          if (n < 1024) { if (k < 64) v = inp(I_W2)[k * 1024 + n]; }
          else if (n < 2048) { if (k >= 64 && k < 128) v = inp(I_A2)[(k - 64) * 1024 + (n - 1024)]; }
          else { if (k >= 128 && k < 288) v = inp(I_G2)[(k - 128) * 1024 + (n - 2048)]; }
          wl[i] = (bf16)f2bf(v); } }
    { const float* lam = inp(I_LAM); float* spl = (float*)(ws + WS_SPL); for (int i = gt; i < 1024; i += NGT) spl[i] = softplusf(-lam[i]); }
    { bf16* wr = (bf16*)(ws + WS_WR);
      for (int i = gt; i < 32 * D; i += NGT) { const int e = i / D, k = i % D; const float w = inp(I_WROUTER)[k * 32 + e]; const unsigned hi = f2bf(w); const float r = w - __builtin_bit_cast(float, hi << 16);
          wr[i] = (bf16)hi; wr[32 * D + i] = (bf16)f2bf(r); } }
    { const float* lwi_p = inp(I_LWI); const float* lwr_p = inp(I_LWR); bf16* lw = (bf16*)(ws + WS_LW);
      for (int i = gt; i < 2 * 16 * 4 * 2 * 64 * 8; i += NGT) { const int j = i & 7, ln = (i >> 3) & 63, ks = (i >> 9) & 1, vbo = (i >> 10) & 3, n = (i >> 12) & 15, mat = i >> 16;
          const int w = 32 * ks + 16 * (j >> 2) + 4 * (ln >> 4) + (j & 3), v = 16 * vbo + (ln & 15);
          lw[i] = (bf16)f2bf((mat ? lwi_p : lwr_p)[(n * 64 + w) * 64 + v]); } }
}

__device__ __forceinline__ void moe_weight_convert(const Frame& F, const Args& a, int gw, int NGW) {
    unsigned char* ws = a.ws;
    const float* wg = inp(I_WGATE); const float* wu = inp(I_WUP); const float* wd = inp(I_WDOWN);
    constexpr int PER = 1024;
    for (int it = gw; it < NE * 3 * PER; it += NGW) {
        const int e = it / (3 * PER), r = it % (3 * PER), which = r / PER, q = r % PER, k0 = 64 * (q / 32), n0 = 64 * (q % 32);
        if (which == 0) transpose_item_fp8(wg + (size_t)e * D * D, D, k0, n0, ws + WS_WGU + (size_t)e * 4096 * D, D, (n0 >> 7) * 256 + (n0 & 127), F.lane, 64.0f);
        else if (which == 1) transpose_item_fp8(wu + (size_t)e * D * D, D, k0, n0, ws + WS_WGU + (size_t)e * 4096 * D, D, (n0 >> 7) * 256 + 128 + (n0 & 127), F.lane, 64.0f);
        else transpose_item_fp8(wd + (size_t)e * D * D, D, k0, n0, ws + WS_WD + (size_t)e * 2048 * D, D, n0, F.lane, 64.0f);
    }
}

__device__ __forceinline__ void r1_lora_in(const Frame& F, const Args& a) {
    const bf16* P = (const bf16*)(a.ws + WS_P); bf16* L = (bf16*)(a.ws + WS_XN);
    const float* mu = inp(I_MU);
    const int gw = F.vcu * NWAVES + F.wave, NGW = F.G * NWAVES;
    for (int m = gw; m < T; m += NGW) {
        const bool first = (m % SEQ) == 0;
#pragma unroll
        for (int j = 0; j < 6; ++j) { const int k = F.lane + 64 * j; float o = 0.f;
            if (k < 288) { const int c = 3072 + k; const float cur = bf1(P[(size_t)m * NP + c]); const float prev = first ? 0.f : bf1(P[(size_t)(m - 1) * NP + c]);
                const float x = cur + (prev - cur) * mu[c]; o = k < 64 ? fast_tanh(x) : (k < 128 ? x : sigm(x)); }
            L[(size_t)m * LORA_K + k] = (bf16)f2bf(o); }
    }
}

constexpr int REC_F = 2816, REC_AT = 0, REC_RT = 512, REC_BKT = 1024, REC_WC = 2048, REC_N = 2112, REC_Q = 2176, REC_V8 = 2240;
__device__ __forceinline__ float wave_sum_fast(float v) { v = row16_sum(v); v += __shfl_xor(v, 16); v += __shfl_xor(v, 32); return v; }
__device__ __forceinline__ void r3_blocks(const Frame& F, const Args& a) {
    const GAS bf16* P = (const GAS bf16*)(a.ws + WS_P); const GAS float* LO = (const GAS float*)(a.ws + WS_LORAOUT);
    GAS float* REC = (GAS float*)(a.ws + WS_SCAN); GAS float* BON = (GAS float*)(a.ws + WS_BONUS);
    const GAS float* mu = (const GAS float*)inp(I_MU); const GAS float* w0 = (const GAS float*)inp(I_W0); const GAS float* a0 = (const GAS float*)inp(I_A0);
    const GAS float* kkp = (const GAS float*)inp(I_KK); const GAS float* kap = (const GAS float*)inp(I_KA); const GAS float* rkp = (const GAS float*)inp(I_RK);
    LAS float* G1 = (LAS float*)(F.lds + F.wave * 16384);
    LAS float* G2 = G1 + 2048;
    const int gw = F.vcu * NWAVES + F.wave, NGW = F.G * NWAVES, lane = F.lane;
#pragma unroll 1
    for (int it = gw; it < 32 * 1024; it += NGW) {
        const int bh = it >> 10, blk = it & 1023, b = bh >> 4, h = bh & 15, c = h * 64 + lane, m0 = b * SEQ + blk * 8;
        const float mur = mu[c], muk = mu[1024 + c], muv = mu[2048 + c], w0c = w0[c], a0c = a0[c], kkw = kkp[c], kaw = kap[c], rkw = rkp[c];
        float w[8], av[8], bv[8], kv[8], rv[8], vv[8], ag[8], kk[8], n2[8], bo[8];
        float pr = 0.f, pk = 0.f, pv = 0.f;
        if (blk > 0) { const GAS bf16* pp = P + (size_t)(m0 - 1) * NP; pr = bf1(pp[c]); pk = bf1(pp[1024 + c]); pv = bf1(pp[2048 + c]); }
#pragma unroll
        for (int t = 0; t < 8; ++t) { const GAS bf16* pc = P + (size_t)(m0 + t) * NP; const float cr = bf1(pc[c]), ck = bf1(pc[1024 + c]), cv = bf1(pc[2048 + c]);
            const float r = cr + (pr - cr) * mur, k = ck + (pk - ck) * muk, v = cv + (pv - cv) * muv; pr = cr; pk = ck; pv = cv;
            const float wpre = w0c + LO[(size_t)(m0 + t) * 3072 + c], apre = a0c + LO[(size_t)(m0 + t) * 3072 + 1024 + c];
            w[t] = __expf(-0.6065306597126334f * __builtin_amdgcn_rcpf(1.0f + __expf(-wpre)));
            ag[t] = __builtin_amdgcn_rcpf(1.0f + __expf(-apre));
            kk[t] = k * kkw; n2[t] = kk[t] * kk[t];
            kv[t] = k * (1.0f + (ag[t] - 1.0f) * kaw); rv[t] = r; vv[t] = v; bo[t] = r * kv[t] * rkw; }
#pragma unroll
        for (int t = 0; t < 8; ++t) { n2[t] = wave_sum_fast(n2[t]); bo[t] = wave_sum_fast(bo[t]); }
#pragma unroll
        for (int t = 0; t < 8; ++t) { const float kkn = kk[t] * (1.0f / sqrtf(fmaxf(n2[t], 1e-24f))); av[t] = -kkn; bv[t] = kkn * ag[t]; if (lane == 0) BON[(m0 + t) * 16 + h] = bo[t]; }
        float Pp[8]; Pp[0] = w[0];
#pragma unroll
        for (int t = 1; t < 8; ++t) Pp[t] = Pp[t - 1] * w[t];
        float bch[8], kch[8], ah[8], rh[8];
#pragma unroll
        for (int t = 0; t < 8; ++t) { const float pin = __builtin_amdgcn_rcpf(Pp[t]); bch[t] = bv[t] * pin; kch[t] = kv[t] * pin; ah[t] = av[t] * (t > 0 ? Pp[t - 1] : 1.0f); rh[t] = rv[t] * Pp[t]; }
        const int pos = (lane & 3) * 16 + (lane >> 2);
#pragma unroll
        for (int t = 0; t < 8; ++t) { G1[t * 64 + pos] = bch[t]; G1[(8 + t) * 64 + pos] = kch[t]; G1[(16 + t) * 64 + pos] = ah[t]; G1[(24 + t) * 64 + pos] = rh[t]; }
        LDS_WAIT(); asm volatile("" ::: "memory");
        f32x4 fa[4], fb[4];
#pragma unroll
        for (int q = 0; q < 4; ++q) { fa[q] = *(const LAS f32x4*)(G1 + (lane & 15) * 64 + (lane >> 4) * 16 + 4 * q); fb[q] = *(const LAS f32x4*)(G1 + (16 + (lane & 15)) * 64 + (lane >> 4) * 16 + 4 * q); }
        f32x4 dacc = {0.f, 0.f, 0.f, 0.f};
#pragma unroll
        for (int s2 = 0; s2 < 16; ++s2) dacc = __builtin_amdgcn_mfma_f32_16x16x4f32(fa[s2 >> 2][s2 & 3], fb[s2 >> 2][s2 & 3], dacc, 0, 0, 0);
        *(LAS f32x4*)(G2 + (lane & 15) * 16 + 4 * (lane >> 4)) = dacc;
        LDS_WAIT(); asm volatile("" ::: "memory");
        float M[8][8];
        { float Lm[8][8];
#pragma unroll
          for (int t = 1; t < 8; ++t) { const f32x4 l0 = *(const LAS f32x4*)(G2 + t * 16), l1 = *(const LAS f32x4*)(G2 + t * 16 + 4);
#pragma unroll
              for (int i = 0; i < 4; ++i) { Lm[t][i] = l0[i]; Lm[t][4 + i] = l1[i]; } }
#pragma unroll
          for (int t = 0; t < 8; ++t) { M[t][t] = 1.0f;
#pragma unroll
              for (int i = t - 1; i >= 0; --i) { float acc = 0.f;
#pragma unroll
                  for (int j = i; j < t; ++j) acc += Lm[t][j] * M[j][i];
                  M[t][i] = acc; } } }
        GAS float* rec = REC + ((size_t)bh * 1024 + blk) * REC_F; GAS bf16* recb = (GAS bf16*)rec;
#pragma unroll
        for (int t = 0; t < 8; ++t) { float acc = 0.f;
#pragma unroll
            for (int i = 0; i <= t; ++i) acc += M[t][i] * ah[i];
            { const unsigned hi = f2bf(acc); recb[t * 64 + lane] = (bf16)hi; recb[1024 + t * 64 + lane] = (bf16)f2bf(acc - __builtin_bit_cast(float, hi << 16)); } }
        float Nm[8][8];
        { float Km[8][8];
#pragma unroll
          for (int t = 1; t < 8; ++t) { const f32x4 l0 = *(const LAS f32x4*)(G2 + t * 16 + 8), l1 = *(const LAS f32x4*)(G2 + t * 16 + 12);
#pragma unroll
              for (int i = 0; i < 4; ++i) { Km[t][i] = l0[i]; Km[t][4 + i] = l1[i]; } }
#pragma unroll
          for (int t = 0; t < 8; ++t)
#pragma unroll
              for (int i = 0; i < 8; ++i) { float acc = 0.f;
                  if (i < t) {
#pragma unroll
                      for (int j = i + 1; j <= t; ++j) acc += M[t][j] * Km[j][i]; }
                  Nm[t][i] = acc; } }
        float rb[8][8];
#pragma unroll
        for (int t = 0; t < 8; ++t) { const f32x4 l0 = *(const LAS f32x4*)(G2 + (8 + t) * 16), l1 = *(const LAS f32x4*)(G2 + (8 + t) * 16 + 4);
#pragma unroll
            for (int i = 0; i < 4; ++i) { rb[t][i] = l0[i]; rb[t][4 + i] = l1[i]; } }
#pragma unroll
        for (int t = 0; t < 8; ++t) { float acc = rh[t];
#pragma unroll
            for (int i = 0; i <= t; ++i) { float rm = 0.f;
#pragma unroll
                for (int j = i; j <= t; ++j) rm += rb[t][j] * M[j][i];
                acc += rm * ah[i]; }
            { const unsigned hi = f2bf(acc); recb[(8 + t) * 64 + lane] = (bf16)hi; recb[1024 + (8 + t) * 64 + lane] = (bf16)f2bf(acc - __builtin_bit_cast(float, hi << 16)); } }
        float Qm[8][8];
#pragma unroll
        for (int t = 0; t < 8; ++t) { const f32x4 l0 = *(const LAS f32x4*)(G2 + (8 + t) * 16 + 8), l1 = *(const LAS f32x4*)(G2 + (8 + t) * 16 + 12);
#pragma unroll
            for (int i = 0; i < 8; ++i) { float acc = 0.f;
                if (i <= t) { acc = i < 4 ? l0[i & 3] : l1[i & 3];
#pragma unroll
                    for (int j = i + 1; j <= t; ++j) acc += rb[t][j] * Nm[j][i]; }
                Qm[t][i] = acc; } }
        { unsigned hw[8], lw[8];
#pragma unroll
          for (int i2 = 0; i2 < 8; ++i2) { const float x0 = (i2 < 4 ? bch[2 * i2] : kch[2 * i2 - 8]) * Pp[7], x1 = (i2 < 4 ? bch[2 * i2 + 1] : kch[2 * i2 - 7]) * Pp[7];
              const unsigned h0 = f2bf(x0), h1 = f2bf(x1); hw[i2] = h0 | (h1 << 16); lw[i2] = f2bf(x0 - __builtin_bit_cast(float, h0 << 16)) | (f2bf(x1 - __builtin_bit_cast(float, h1 << 16)) << 16); }
          GAS v4u* bh_ = (GAS v4u*)(recb + 2048 + lane * 16); GAS v4u* bl_ = (GAS v4u*)(recb + 3072 + lane * 16);
          bh_[0] = (v4u){hw[0], hw[1], hw[2], hw[3]}; bh_[1] = (v4u){hw[4], hw[5], hw[6], hw[7]}; bl_[0] = (v4u){lw[0], lw[1], lw[2], lw[3]}; bl_[1] = (v4u){lw[4], lw[5], lw[6], lw[7]}; }
        rec[REC_WC + lane] = Pp[7];
        if (lane == 0) {
#pragma unroll
            for (int t = 0; t < 8; ++t) { *(GAS f32x4*)(rec + REC_N + t * 8) = (f32x4){Nm[t][0], Nm[t][1], Nm[t][2], Nm[t][3]}; *(GAS f32x4*)(rec + REC_N + t * 8 + 4) = (f32x4){Nm[t][4], Nm[t][5], Nm[t][6], Nm[t][7]};
                *(GAS f32x4*)(rec + REC_Q + t * 8) = (f32x4){Qm[t][0], Qm[t][1], Qm[t][2], Qm[t][3]}; *(GAS f32x4*)(rec + REC_Q + t * 8 + 4) = (f32x4){Qm[t][4], Qm[t][5], Qm[t][6], Qm[t][7]}; } }
        *(GAS f32x4*)(rec + REC_V8 + lane * 8) = (f32x4){vv[0], vv[1], vv[2], vv[3]}; *(GAS f32x4*)(rec + REC_V8 + lane * 8 + 4) = (f32x4){vv[4], vv[5], vv[6], vv[7]};
        LDS_WAIT(); asm volatile("" ::: "memory");
    }
}

constexpr int SC_NS = 12, SC_RB = REC_F * 4, SC_SYNC = SC_NS * SC_RB;
__device__ __forceinline__ unsigned lds_word(const volatile LAS unsigned* p) { return (unsigned)__builtin_amdgcn_readfirstlane((int)*p); }
__device__ __forceinline__ bool scan_wg(int& bh, int& quarter) { const int bx = blockIdx.x; if (gridDim.x != 256 || ((bx >> 3) & 1)) return false; const int slot = bx >> 4; bh = (bx & 7) * 4 + (slot >> 2); quarter = slot & 3; return true; }
__device__ __forceinline__ void r4_feeder(const Frame& F, const Args& a, int bh) {
    const GAS char* gsrc = (const GAS char*)(a.ws + WS_SCAN) + (size_t)bh * 1024 * SC_RB + F.lane * 16;
    LAS unsigned char* ring = F.lds;
    volatile LAS unsigned* sync = (volatile LAS unsigned*)(F.lds + SC_SYNC);
    bool dead = false;
#pragma unroll 1
    for (int B = 0; B < 1024; ++B) {
        if (B >= SC_NS && !dead) { unsigned spins = 0; for (;;) { const unsigned d0 = lds_word(sync + 16); if ((int)d0 > B - SC_NS) break; if (++spins > (1u << 20)) { dead = true; break; } __builtin_amdgcn_s_sleep(2); } }
        LAS unsigned char* slot = ring + (B % SC_NS) * SC_RB;
#pragma unroll
        for (int q = 0; q < 11; ++q) __builtin_amdgcn_global_load_lds((const GAS unsigned*)(gsrc + (size_t)B * SC_RB + q * 1024), (LAS unsigned*)(slot + q * 1024), 16, 0, 0);
        asm volatile("s_waitcnt vmcnt(55)" ::: "memory");
        if (B >= 5 && F.lane == 0) sync[0] = (unsigned)(B - 4);
    }
    asm volatile("s_waitcnt vmcnt(0)" ::: "memory");
    if (F.lane == 0) sync[0] = 1024u;
}
template <int VAR> __device__ __forceinline__ void r4_scan(const Frame& F, const Args& a, int bh, int quarter) {
    float* YT = (float*)(a.ws + WS_XN);
    constexpr int RB = SC_RB;
    __builtin_amdgcn_s_setprio(3);
    const int r = F.lane & 15, q = F.lane >> 4, rowg = quarter * 16 + r;
    LAS unsigned char* ring = F.lds;
    volatile LAS unsigned* sync = (volatile LAS unsigned*)(F.lds + SC_SYNC);
    const LAS unsigned char* pVH = ring + (r * 64 + 4 * q) * 2;
    const LAS unsigned char* pNQ = ring + (REC_N + r * 8 + 2 * q) * 4;
    const LAS unsigned char* pVb = ring + (REC_V8 + rowg * 8 + 2 * q) * 4;
    const LAS unsigned char* pV4 = ring + (REC_V8 + rowg * 8 + 4 * (q & 1)) * 4;
    const LAS unsigned char* pBH = ring + 4096 + (r * 16 + 4 * q) * 2;
    const LAS unsigned char* pWC = ring + (REC_WC + 4 * q) * 4;
    unsigned have = 0; bool dead = (VAR == 1);
#define SC_NEED(n) do { unsigned spins_ = 0; while (have < (unsigned)(n) && !dead) { have = lds_word(sync); if (have >= (unsigned)(n)) break; if (++spins_ > (1u << 20)) { dead = true; break; } __builtin_amdgcn_s_sleep(1); } } while (0)
    f32x4 S[4];
#pragma unroll
    for (int kb = 0; kb < 4; ++kb) S[kb] = (f32x4){0.f, 0.f, 0.f, 0.f};
    GAS float* yrow = (GAS float*)YT + (size_t)(bh * 64 + rowg) * SEQ + 4 * (q & 1);
#define SC_LD(vh_, vl_, nq_, vb_, v4_, bh_, bl_, wc_, so_) do { _Pragma("unroll") for (int h_ = 0; h_ < 2; ++h_) { const v2u a_ = *(const LAS v2u*)(pVH + (so_) + 64 * h_), b_ = *(const LAS v2u*)(pVH + (so_) + 64 * h_ + 32); vh_[h_] = (v4u){a_.x, a_.y, b_.x, b_.y}; \
            const v2u c_ = *(const LAS v2u*)(pVH + (so_) + 2048 + 64 * h_), d_ = *(const LAS v2u*)(pVH + (so_) + 2048 + 64 * h_ + 32); vl_[h_] = (v4u){c_.x, c_.y, d_.x, d_.y}; } \
        nq_ = *(const LAS f32x2*)(pNQ + (so_)); vb_ = *(const LAS f32x2*)(pVb + (so_)); v4_ = *(const LAS f32x4*)(pV4 + (so_)); \
        _Pragma("unroll") for (int kb_ = 0; kb_ < 4; ++kb_) { bh_[kb_] = *(const LAS v2u*)(pBH + (so_) + kb_ * 512); bl_[kb_] = *(const LAS v2u*)(pBH + (so_) + 2048 + kb_ * 512); wc_[kb_] = *(const LAS f32x4*)(pWC + (so_) + kb_ * 64); } } while (0)
    v4u vh[2], vl[2]; v2u bkh[4], bkl[4]; f32x4 wc[4], v4; f32x2 nq, vb;
    SC_NEED(1); asm volatile("" ::: "memory");
    SC_LD(vh, vl, nq, vb, v4, bkh, bkl, wc, 0);
#pragma unroll 1
    for (int k0 = 0; k0 < 1024; k0 += SC_NS) {
#pragma unroll
        for (int u = 0; u < SC_NS; ++u) { if (k0 + u >= 1024) break; const int sn = ((u + 1) % SC_NS) * RB;
            v4u shi[2], slo[2];
#pragma unroll
            for (int h = 0; h < 2; ++h) {
                unsigned hw_[4], lw_[4];
#pragma unroll
                for (int p = 0; p < 4; ++p) { const f32x4 sv = S[2 * h + (p >> 1)]; const float x0 = sv[2 * (p & 1)], x1 = sv[2 * (p & 1) + 1];
                    hw_[p] = __builtin_amdgcn_perm(__builtin_bit_cast(unsigned, x1), __builtin_bit_cast(unsigned, x0), 0x07060302u);
                    const float l0 = x0 - __builtin_bit_cast(float, __builtin_bit_cast(unsigned, x0) & 0xffff0000u), l1 = x1 - __builtin_bit_cast(float, __builtin_bit_cast(unsigned, x1) & 0xffff0000u);
                    lw_[p] = pg8::cvt_pk_bf16(l0, l1); }
                shi[h] = (v4u){hw_[0], hw_[1], hw_[2], hw_[3]}; slo[h] = (v4u){lw_[0], lw_[1], lw_[2], lw_[3]}; }
            f32x4 a0 = {0.f, 0.f, 0.f, 0.f}, a1 = {0.f, 0.f, 0.f, 0.f}, a2 = {0.f, 0.f, 0.f, 0.f}, ac = {0.f, 0.f, 0.f, 0.f};
#pragma unroll
            for (int h = 0; h < 2; ++h) { a0 = __builtin_amdgcn_mfma_f32_16x16x32_bf16(__builtin_bit_cast(bf16x8, vh[h]), __builtin_bit_cast(bf16x8, shi[h]), a0, 0, 0, 0);
                a1 = __builtin_amdgcn_mfma_f32_16x16x32_bf16(__builtin_bit_cast(bf16x8, vl[h]), __builtin_bit_cast(bf16x8, shi[h]), a1, 0, 0, 0);
                a2 = __builtin_amdgcn_mfma_f32_16x16x32_bf16(__builtin_bit_cast(bf16x8, vh[h]), __builtin_bit_cast(bf16x8, slo[h]), a2, 0, 0, 0); }
            ac = __builtin_amdgcn_mfma_f32_16x16x4f32(nq[0], vb[0], ac, 0, 0, 0); ac = __builtin_amdgcn_mfma_f32_16x16x4f32(nq[1], vb[1], ac, 0, 0, 0);
            v4u nvh[2], nvl[2]; v2u nbkh[4], nbkl[4]; f32x4 nwc[4], nv4; f32x2 nnq, nvb;
            SC_NEED(k0 + u + 2 <= 1024 ? k0 + u + 2 : 1024); asm volatile("" ::: "memory");
            SC_LD(nvh, nvl, nnq, nvb, nv4, nbkh, nbkl, nwc, sn);
            asm volatile("" ::: "memory");
            const f32x4 dd = (a0 + ac) + (a1 + a2);
            if (q >= 2) *(GAS f32x4*)(yrow + (k0 + u) * 8) = dd;
            const f32x4 b2 = q >= 2 ? v4 : dd;
            v4u svh, svl;
            { const unsigned h01 = __builtin_amdgcn_perm(__builtin_bit_cast(unsigned, b2[1]), __builtin_bit_cast(unsigned, b2[0]), 0x07060302u), h23 = __builtin_amdgcn_perm(__builtin_bit_cast(unsigned, b2[3]), __builtin_bit_cast(unsigned, b2[2]), 0x07060302u);
              float l_[4];
#pragma unroll
              for (int i = 0; i < 4; ++i) l_[i] = b2[i] - __builtin_bit_cast(float, __builtin_bit_cast(unsigned, b2[i]) & 0xffff0000u);
              svh = (v4u){h01, h23, 0u, 0u}; svl = (v4u){pg8::cvt_pk_bf16(l_[0], l_[1]), pg8::cvt_pk_bf16(l_[2], l_[3]), 0u, 0u}; }
            f32x4 n[4];
#pragma unroll
            for (int kb = 0; kb < 4; ++kb) n[kb] = S[kb] * wc[kb];
#pragma unroll
            for (int kb = 0; kb < 4; ++kb) n[kb] = __builtin_amdgcn_mfma_f32_16x16x32_bf16(__builtin_bit_cast(bf16x8, (v4u){bkh[kb].x, bkh[kb].y, 0u, 0u}), __builtin_bit_cast(bf16x8, svh), n[kb], 0, 0, 0);
#pragma unroll
            for (int kb = 0; kb < 4; ++kb) n[kb] = __builtin_amdgcn_mfma_f32_16x16x32_bf16(__builtin_bit_cast(bf16x8, (v4u){bkl[kb].x, bkl[kb].y, 0u, 0u}), __builtin_bit_cast(bf16x8, svh), n[kb], 0, 0, 0);
#pragma unroll
            for (int kb = 0; kb < 4; ++kb) n[kb] = __builtin_amdgcn_mfma_f32_16x16x32_bf16(__builtin_bit_cast(bf16x8, (v4u){bkh[kb].x, bkh[kb].y, 0u, 0u}), __builtin_bit_cast(bf16x8, svl), n[kb], 0, 0, 0);
#pragma unroll
            for (int kb = 0; kb < 4; ++kb) S[kb] = n[kb];
            asm volatile("" : "+v"(S[0]), "+v"(S[1]), "+v"(S[2]), "+v"(S[3]) :: "memory");
            if (F.lane == 0) sync[16] = (unsigned)(k0 + u + 1);
#pragma unroll
            for (int h = 0; h < 2; ++h) { vh[h] = nvh[h]; vl[h] = nvl[h]; }
#pragma unroll
            for (int kb = 0; kb < 4; ++kb) { bkh[kb] = nbkh[kb]; bkl[kb] = nbkl[kb]; wc[kb] = nwc[kb]; }
            nq = nnq; vb = nvb; v4 = nv4;
        }
    }
#undef SC_LD
#undef SC_NEED
    __builtin_amdgcn_s_setprio(0);
}

__device__ __forceinline__ void r5_finish(const Frame& F, const Args& a) {
    const float* YT = (const float*)(a.ws + WS_XN); const float* LO = (const float*)(a.ws + WS_LORAOUT); const bf16* P = (const bf16*)(a.ws + WS_P); const float* BON = (const float*)(a.ws + WS_BONUS);
    bf16* YA = (bf16*)(a.ws + WS_YABC);
    LAS float* scr = (LAS float*)(F.lds + F.wave * 16640);
    const int gw = F.vcu * NWAVES + F.wave, NGW = F.G * NWAVES;
    for (int it = gw; it < 32 * 128; it += NGW) {
        const int bh = it >> 7, tt = it & 127, t0 = tt * 64, b = bh >> 4, h = bh & 15;
        float y[64]; float s = 0.f;
#pragma unroll
        for (int v = 0; v < 64; ++v) { y[v] = YT[(size_t)(bh * 64 + v) * SEQ + t0 + F.lane]; s += y[v]; }
        const float mean = s * (1.f / 64.f); float q = 0.f;
#pragma unroll
        for (int v = 0; v < 64; ++v) { const float d = y[v] - mean; q += d * d; }
        const float rstd = 1.0f / sqrtf(q * (1.f / 64.f) + GN_EPS);
#pragma unroll
        for (int v = 0; v < 64; ++v) scr[F.lane * 65 + v] = (y[v] - mean) * rstd;
        LDS_WAIT(); asm volatile("" ::: "memory");
        { const int ts = F.lane >> 4, cq = F.lane & 15, c = h * 64 + 4 * cq;
          const f32x4 lw = *(const GAS f32x4*)((const GAS float*)inp(I_LNW) + c), lb = *(const GAS f32x4*)((const GAS float*)inp(I_LNB) + c), muv = *(const GAS f32x4*)((const GAS float*)inp(I_MU) + 2048 + c);
#pragma unroll 4
          for (int tg = 0; tg < 16; ++tg) { const int ti = 4 * tg + ts, m = b * SEQ + t0 + ti;
              f32x4 yn; yn[0] = scr[ti * 65 + 4 * cq]; yn[1] = scr[ti * 65 + 4 * cq + 1]; yn[2] = scr[ti * 65 + 4 * cq + 2]; yn[3] = scr[ti * 65 + 4 * cq + 3];
              const v2u cw = *(const GAS v2u*)((const GAS bf16*)P + (size_t)m * NP + 2048 + c); v2u pw = cw; if (m % SEQ != 0) pw = *(const GAS v2u*)((const GAS bf16*)P + (size_t)(m - 1) * NP + 2048 + c);
              const f32x4 cv = {bflo(cw.x), bfhi(cw.x), bflo(cw.y), bfhi(cw.y)}; f32x4 pv = {bflo(pw.x), bfhi(pw.x), bflo(pw.y), bfhi(pw.y)}; if (m % SEQ == 0) pv = (f32x4){0.f, 0.f, 0.f, 0.f};
              const f32x4 vsh = cv + (pv - cv) * muv;
              const f32x4 g = *(const GAS f32x4*)((const GAS float*)LO + (size_t)m * 3072 + 2048 + c); const float bon = BON[m * 16 + h];
              const f32x4 o = (yn * lw + lb + vsh * bon) * g;
              v2u w; w.x = pk2(o[0], o[1]); w.y = pk2(o[2], o[3]); *(GAS v2u*)((GAS bf16*)YA + (size_t)m * 3072 + c) = w; } }
        LDS_WAIT(); asm volatile("" ::: "memory");
    }
}

__device__ __forceinline__ float gelu_tanh(float x) { const float u = 0.7978845608028654f * (x + 0.044715f * x * x * x); return 0.5f * x * (1.0f + fast_tanh(u)); }
template <int CTRL> __device__ __forceinline__ float dpp_keep(float old, float x) { return __builtin_bit_cast(float, __builtin_amdgcn_update_dpp(__builtin_bit_cast(int, old), __builtin_bit_cast(int, x), CTRL, 0xf, 0xf, false)); }
template <bool FINAL> __device__ __forceinline__ void lru_pass(const Frame& F, const Args& a, int gw, int NGW) {
    const bf16* P = (const bf16*)(a.ws + WS_P); const bf16* LW = (const bf16*)(a.ws + WS_LW);
    float* CA = (float*)(a.ws + WS_LRUC); float* CB = CA + 256 * 1024; const float* HIN = CB + 256 * 1024;
    bf16* YB = (bf16*)(a.ws + WS_YABC) + 1024;
    const GAS float* lbr_p = (const GAS float*)inp(I_LBR); const GAS float* lbi_p = (const GAS float*)inp(I_LBI); const GAS float* spl_p = (const GAS float*)(a.ws + WS_SPL);
    const GAS float* cvb_p = (const GAS float*)inp(I_CONVB); const GAS float* cvw_p = (const GAS float*)inp(I_CONVW);
    const int tq = F.lane & 15, kq = F.lane >> 4;
    for (int it = gw; it < 256 * 16; it += NGW) {
        const int tt = it >> 4, n = it & 15, m0 = tt * 64, cb = n * 64 + 4 * kq;
        const bool seq0 = (m0 % SEQ) == 0;
        float hcar[4][4];
        float aprod[4][4];
#pragma unroll
        for (int vb = 0; vb < 4; ++vb)
#pragma unroll
            for (int i = 0; i < 4; ++i) { hcar[vb][i] = FINAL ? HIN[tt * 1024 + cb + 16 * vb + i] : 0.f; aprod[vb][i] = 1.f; }
#pragma unroll 1
        for (int tb = 0; tb < 4; ++tb) {
            asm volatile("" ::: "memory");
            const int m = m0 + 16 * tb + tq, tseq = m % SEQ;
            f32x4 xc[4];
#pragma unroll
            for (int vb = 0; vb < 4; ++vb) { const int c = cb + 16 * vb; f32x4 acc = *(const GAS f32x4*)(cvb_p + c);
#pragma unroll
                for (int j = 0; j < 4; ++j) { if (tseq - j >= 0) { const v2u pw = *(const GAS v2u*)((const GAS bf16*)P + (size_t)(m - j) * NP + PC_LX + c); const f32x4 cw = *(const GAS f32x4*)(cvw_p + j * 1024 + c);
                        acc[0] += cw[0] * bflo(pw.x); acc[1] += cw[1] * bfhi(pw.x); acc[2] += cw[2] * bflo(pw.y); acc[3] += cw[3] * bfhi(pw.y); } }
                xc[vb] = acc; }
            bf16x8 bfrag[2];
#pragma unroll
            for (int ks = 0; ks < 2; ++ks) { v4u w; w.x = pk2(xc[2 * ks][0], xc[2 * ks][1]); w.y = pk2(xc[2 * ks][2], xc[2 * ks][3]); w.z = pk2(xc[2 * ks + 1][0], xc[2 * ks + 1][1]); w.w = pk2(xc[2 * ks + 1][2], xc[2 * ks + 1][3]); bfrag[ks] = __builtin_bit_cast(bf16x8, w); }
#pragma unroll
            for (int vb = 0; vb < 4; ++vb) {
                f32x4 gr = {0.f, 0.f, 0.f, 0.f}, gi = {0.f, 0.f, 0.f, 0.f};
#pragma unroll
                for (int ks = 0; ks < 2; ++ks) { const bf16x8 wr_ = *(const bf16x8*)(LW + ((((size_t)(0 * 16 + n) * 4 + vb) * 2 + ks) * 64 + F.lane) * 8); const bf16x8 wi_ = *(const bf16x8*)(LW + ((((size_t)(1 * 16 + n) * 4 + vb) * 2 + ks) * 64 + F.lane) * 8);
                    gr = __builtin_amdgcn_mfma_f32_16x16x32_bf16(wr_, bfrag[ks], gr, 0, 0, 0); gi = __builtin_amdgcn_mfma_f32_16x16x32_bf16(wi_, bfrag[ks], gi, 0, 0, 0); }
                const int c = cb + 16 * vb;
                const f32x4 brv = *(const GAS f32x4*)(lbr_p + c), biv = *(const GAS f32x4*)(lbi_p + c); const f32x4 spl = *(const GAS f32x4*)(spl_p + c);
                v2u pyw; if (FINAL) pyw = *(const v2u*)(P + (size_t)m * NP + PC_LY + c);
                float hout[4];
#pragma unroll
                for (int i = 0; i < 4; ++i) {
                    const float g_r = sigm(gr[i] + brv[i]), g_i = sigm(gi[i] + biv[i]);
                    const float log_a = -8.0f * g_r * spl[i];
                    float av = __expf(log_a); float mult = __builtin_amdgcn_sqrtf(fmaxf(1.0f - av * av, 0.f)); if (tseq == 0) mult = 1.0f;
                    float bv = mult * g_i * xc[vb][i];
                    { float pa = dpp_keep<0x111>(1.0f, av), pb = dpp_keep<0x111>(0.0f, bv); bv = av * pb + bv; av = av * pa; }
                    { float pa = dpp_keep<0x112>(1.0f, av), pb = dpp_keep<0x112>(0.0f, bv); bv = av * pb + bv; av = av * pa; }
                    { float pa = dpp_keep<0x114>(1.0f, av), pb = dpp_keep<0x114>(0.0f, bv); bv = av * pb + bv; av = av * pa; }
                    { float pa = dpp_keep<0x118>(1.0f, av), pb = dpp_keep<0x118>(0.0f, bv); bv = av * pb + bv; av = av * pa; }
                    const float hv = bv + av * hcar[vb][i];
                    const int l15 = (F.lane & 48) | 15;
                    const float hend = __shfl(hv, l15), aend = __shfl(av, l15);
                    hcar[vb][i] = hend; if (!FINAL) aprod[vb][i] *= aend; hout[i] = hv; }
                if (FINAL) { const float y0 = hout[0] * gelu_tanh(bflo(pyw.x)), y1 = hout[1] * gelu_tanh(bfhi(pyw.x)), y2 = hout[2] * gelu_tanh(bflo(pyw.y)), y3 = hout[3] * gelu_tanh(bfhi(pyw.y));
                    v2u w; w.x = pk2(y0, y1); w.y = pk2(y2, y3); *(v2u*)(YB + (size_t)m * 3072 + c) = w; }
            }
        }
        if (!FINAL && tq == 0) {
#pragma unroll
            for (int vb = 0; vb < 4; ++vb) { f32x4 pa, pb;
#pragma unroll
                for (int i = 0; i < 4; ++i) { pa[i] = aprod[vb][i]; pb[i] = hcar[vb][i]; }
                *(f32x4*)(CA + tt * 1024 + cb + 16 * vb) = pa; *(f32x4*)(CB + tt * 1024 + cb + 16 * vb) = pb; }
        }
        (void)seq0;
    }
}
__device__ __forceinline__ void lru_carry(const Frame& F, const Args& a) {
    const float* CA = (const float*)(a.ws + WS_LRUC); const float* CB = CA + 256 * 1024; float* HIN = (float*)CB + 256 * 1024;
    const int gt = F.vcu * (NWAVES * 64) + F.tid;
    if (gt < 2048) { const int b = gt >> 10, c = gt & 1023; float h = 0.f;
#pragma unroll 1
        for (int k0 = 0; k0 < 128; k0 += 32) { float ca[32], cb[32];
#pragma unroll
            for (int j = 0; j < 32; ++j) { const int tt = b * 128 + k0 + j; ca[j] = CA[tt * 1024 + c]; cb[j] = CB[tt * 1024 + c]; }
#pragma unroll
            for (int j = 0; j < 32; ++j) { const int tt = b * 128 + k0 + j; HIN[tt * 1024 + c] = h; h = ca[j] * h + cb[j]; } } }
}

__device__ __forceinline__ void xattn_phase(const Frame& F, const Args& a, int gw, int NGW) {
    const bf16* P = (const bf16*)(a.ws + WS_P); const bf16* KM = (const bf16*)(a.ws + WS_KMEM); const bf16* VT = (const bf16*)(a.ws + WS_VT);
    bf16* YC = (bf16*)(a.ws + WS_YABC) + 2048;
    const int tq = F.lane & 15, kq = F.lane >> 4;
    for (int it = gw; it < 4 * 512; it += NGW) {
        const int h = it >> 9, tg = it & 511, m0 = tg * 32, b = m0 / SEQ;
        bf16x8 qf[2][8];
#pragma unroll
        for (int g = 0; g < 2; ++g)
#pragma unroll
            for (int ks = 0; ks < 8; ++ks) qf[g][ks] = *(const bf16x8*)(P + (size_t)(m0 + 16 * g + tq) * NP + PC_Q + h * 256 + 32 * ks + 8 * kq);
        f32x4 s[2][16];
#pragma unroll
        for (int mb = 0; mb < 16; ++mb) { f32x4 acc0 = {0.f, 0.f, 0.f, 0.f}, acc1 = {0.f, 0.f, 0.f, 0.f}; const bf16* kp = KM + (size_t)(b * 256 + 16 * mb + tq) * 1024 + h * 256 + 8 * kq;
#pragma unroll
            for (int ks = 0; ks < 8; ++ks) { const bf16x8 kf = *(const bf16x8*)(kp + 32 * ks);
                acc0 = __builtin_amdgcn_mfma_f32_16x16x32_bf16(kf, qf[0][ks], acc0, 0, 0, 0); acc1 = __builtin_amdgcn_mfma_f32_16x16x32_bf16(kf, qf[1][ks], acc1, 0, 0, 0); }
            s[0][mb] = acc0; s[1][mb] = acc1; asm volatile("" ::: "memory"); }
        bf16x8 pf[2][8];
#pragma unroll
        for (int g = 0; g < 2; ++g) {
            float mx = -3.0e38f;
#pragma unroll
            for (int mb = 0; mb < 16; ++mb) { s[g][mb] = s[g][mb] * 0.0625f; mx = fmaxf(mx, fmaxf(fmaxf(s[g][mb][0], s[g][mb][1]), fmaxf(s[g][mb][2], s[g][mb][3]))); }
            mx = fmaxf(mx, __shfl_xor(mx, 16)); mx = fmaxf(mx, __shfl_xor(mx, 32));
            float sum = 0.f;
#pragma unroll
            for (int mb = 0; mb < 16; ++mb) {
#pragma unroll
                for (int i = 0; i < 4; ++i) { s[g][mb][i] = __expf(s[g][mb][i] - mx); sum += s[g][mb][i]; } }
            sum += __shfl_xor(sum, 16); sum += __shfl_xor(sum, 32);
            const float inv = 1.0f / sum;
#pragma unroll
            for (int ks = 0; ks < 8; ++ks) { v4u w; w.x = pk2(s[g][2 * ks][0] * inv, s[g][2 * ks][1] * inv); w.y = pk2(s[g][2 * ks][2] * inv, s[g][2 * ks][3] * inv); w.z = pk2(s[g][2 * ks + 1][0] * inv, s[g][2 * ks + 1][1] * inv); w.w = pk2(s[g][2 * ks + 1][2] * inv, s[g][2 * ks + 1][3] * inv); pf[g][ks] = __builtin_bit_cast(bf16x8, w); } }
#pragma unroll
        for (int db = 0; db < 16; ++db) { f32x4 acc0 = {0.f, 0.f, 0.f, 0.f}, acc1 = {0.f, 0.f, 0.f, 0.f}; const bf16* vp = VT + ((size_t)((b * 4 + h) * 256 + 16 * db + tq)) * 256 + 8 * kq;
#pragma unroll
            for (int ks = 0; ks < 8; ++ks) { const bf16x8 vf = *(const bf16x8*)(vp + 32 * ks);
                acc0 = __builtin_amdgcn_mfma_f32_16x16x32_bf16(vf, pf[0][ks], acc0, 0, 0, 0); acc1 = __builtin_amdgcn_mfma_f32_16x16x32_bf16(vf, pf[1][ks], acc1, 0, 0, 0); }
            v2u w0_, w1_; w0_.x = pk2(acc0[0], acc0[1]); w0_.y = pk2(acc0[2], acc0[3]); w1_.x = pk2(acc1[0], acc1[1]); w1_.y = pk2(acc1[2], acc1[3]);
            *(v2u*)(YC + (size_t)(m0 + tq) * 3072 + h * 256 + 16 * db + 4 * kq) = w0_; *(v2u*)(YC + (size_t)(m0 + 16 + tq) * 3072 + h * 256 + 16 * db + 4 * kq) = w1_; asm volatile("" ::: "memory"); }
    }
}

__device__ __forceinline__ void router_phase(const Frame& F, const Args& a) {
    const bf16* H1 = (const bf16*)(a.ws + WS_H1); bf16* XN2 = (bf16*)(a.ws + WS_XN); const bf16* WR = (const bf16*)(a.ws + WS_WR);
    int* pick_e = (int*)(a.ws + WS_PICK); int* pick_rank = pick_e + 65536; float* pick_gate = (float*)(pick_rank + 65536);
    unsigned* gcnt = (unsigned*)(a.ws + WS_CTL) + CW_CNT;
    LAS float* lg = (LAS float*)(F.lds + F.wave * 4096);
    LAS unsigned* lcnt = (LAS unsigned*)(F.lds + 65536);
    const int tq = F.lane & 15, kq = F.lane >> 4;
    for (int g0 = F.vcu * 4; g0 < 1024; g0 += F.G * 4) {
        if (F.tid < 64) lcnt[F.tid] = 0u;
        __syncthreads();
        int me = 0, mrank = 0; float mgate = 0.f; int e4[4]; float g4[4]; int r4[4];
        const int m0 = (g0 + F.wave) * 16;
        if (F.wave < 4) {
            float myr = 0.f;
            for (int j = 0; j < 16; ++j) { const GAS v4u* xr = (const GAS v4u*)(H1 + (size_t)(m0 + j) * D) + F.lane; float s = 0.f;
#pragma unroll
                for (int q = 0; q < 4; ++q) { const v4u w8 = xr[64 * q]; const float e0 = bflo(w8.x), e1 = bfhi(w8.x), e2 = bflo(w8.y), e3 = bfhi(w8.y), e4 = bflo(w8.z), e5 = bfhi(w8.z), e6 = bflo(w8.w), e7 = bfhi(w8.w);
                    s += ((e0 * e0 + e1 * e1) + (e2 * e2 + e3 * e3)) + ((e4 * e4 + e5 * e5) + (e6 * e6 + e7 * e7)); }
                const float rs = 1.0f / sqrtf(wave_sum(s) * (1.f / D) + EPS); if (tq == j) myr = rs; }
            f32x4 acc[2] = {{0.f, 0.f, 0.f, 0.f}, {0.f, 0.f, 0.f, 0.f}};
            const bf16* hrow = H1 + (size_t)(m0 + tq) * D + 8 * kq; const float* grow = inp(I_GFFN) + 8 * kq; unsigned char* xrow = (unsigned char*)XN2 + (size_t)(m0 + tq) * D + 8 * kq;
            for (int ks = 0; ks < 64; ++ks) {
                const v4u hw8 = *(const v4u*)(hrow + 32 * ks); const f32x4 x0 = {bflo(hw8.x), bfhi(hw8.x), bflo(hw8.y), bfhi(hw8.y)}, x1 = {bflo(hw8.z), bfhi(hw8.z), bflo(hw8.w), bfhi(hw8.w)}, g0v = *(const f32x4*)(grow + 32 * ks), g1v = *(const f32x4*)(grow + 32 * ks + 4);
                v4u w; w.x = pk2(x0[0] * myr * g0v[0], x0[1] * myr * g0v[1]); w.y = pk2(x0[2] * myr * g0v[2], x0[3] * myr * g0v[3]); w.z = pk2(x1[0] * myr * g1v[0], x1[1] * myr * g1v[1]); w.w = pk2(x1[2] * myr * g1v[2], x1[3] * myr * g1v[3]);
                { v2u q8; q8.x = pk4_fp8(x0[0] * myr * g0v[0], x0[1] * myr * g0v[1], x0[2] * myr * g0v[2], x0[3] * myr * g0v[3]); q8.y = pk4_fp8(x1[0] * myr * g1v[0], x1[1] * myr * g1v[1], x1[2] * myr * g1v[2], x1[3] * myr * g1v[3]); *(v2u*)(xrow + 32 * ks) = q8; }
                const bf16x8 af = __builtin_bit_cast(bf16x8, w);
#pragma unroll
                for (int eh = 0; eh < 2; ++eh) { const bf16* wp = WR + (size_t)(16 * eh + tq) * D + 32 * ks + 8 * kq;
                    acc[eh] = __builtin_amdgcn_mfma_f32_16x16x32_bf16(af, *(const bf16x8*)wp, acc[eh], 0, 0, 0);
                    acc[eh] = __builtin_amdgcn_mfma_f32_16x16x32_bf16(af, *(const bf16x8*)(wp + 32 * D), acc[eh], 0, 0, 0); } }
#pragma unroll
            for (int eh = 0; eh < 2; ++eh)
#pragma unroll
                for (int i = 0; i < 4; ++i) lg[(4 * kq + i) * 33 + 16 * eh + tq] = acc[eh][i] + inp(I_BROUTER)[16 * eh + tq];
            LDS_WAIT(); asm volatile("" ::: "memory");
            if (F.lane < 16) { float v[32];
#pragma unroll
                for (int e = 0; e < 32; ++e) v[e] = lg[F.lane * 33 + e];
                float tv[4];
#pragma unroll
                for (int k = 0; k < 4; ++k) { float best = -3.0e38f; int bi = 0;
#pragma unroll
                    for (int e = 0; e < 32; ++e) { if (v[e] > best) { best = v[e]; bi = e; } }
                    tv[k] = best; e4[k] = bi;
#pragma unroll
                    for (int e = 0; e < 32; ++e) { if (e == bi) v[e] = -3.0e38f; } }
                float den = 0.f;
#pragma unroll
                for (int k = 0; k < 4; ++k) { g4[k] = __expf(tv[k] - tv[0]); den += g4[k]; }
#pragma unroll
                for (int k = 0; k < 4; ++k) { g4[k] = g4[k] / den; r4[k] = (int)atomicAdd((unsigned*)&lcnt[e4[k]], 1u); } }
        }
        __syncthreads();
        if (F.tid < 32) lcnt[32 + F.tid] = atomicAdd(&gcnt[F.tid], lcnt[F.tid]);
        __syncthreads();
        if (F.wave < 4 && F.lane < 16) {
#pragma unroll
            for (int k = 0; k < 4; ++k) { const int pi = (m0 + F.lane) * 4 + k; pick_e[pi] = e4[k]; pick_rank[pi] = (int)lcnt[32 + e4[k]] + r4[k]; pick_gate[pi] = g4[k]; } }
        __syncthreads();
        (void)me; (void)mrank; (void)mgate;
    }
}

__device__ __forceinline__ void scatter_phase(const Frame& F, const Args& a) {
    const int* pick_e = (const int*)(a.ws + WS_PICK); const int* pick_rank = pick_e + 65536; const float* pick_gate = (const float*)(pick_rank + 65536); int* pos = (int*)(pick_gate + 65536);
    float* gate_of_row = (float*)(a.ws + WS_ROWTAB); int* tok_of_row = (int*)(a.ws + WS_ROWTAB + 512 * 1024 + 8192);
    unsigned* ctl = (unsigned*)(a.ws + WS_CTL);
    LAS int* pst = (LAS int*)(F.lds);
    if (F.tid == 0) { int acc = 0; for (int e = 0; e < NE; ++e) { pst[e] = acc; const int c = (int)ctl[CW_CNT + e]; pst[32 + e] = c; const int nt = (c + 255) >> 8;
            if (blockIdx.x == 0) for (int k = 0; k < nt; ++k) ctl[CW_TILEE + (acc >> 8) + k] = (unsigned)e;
            acc += nt << 8; }
        if (blockIdx.x == 0) ctl[CW_NTILES] = (unsigned)(acc >> 8); }
    __syncthreads();
    { const int gw = F.vcu * NWAVES + F.wave, NGW = F.G * NWAVES; const unsigned char* X8 = a.ws + WS_XN; unsigned char* XS8 = a.ws + WS_XS;
      for (int pi = gw; pi < 65536; pi += NGW) {
        const int e = pick_e[pi], row = pst[e] + pick_rank[pi], tok = pi >> 2;
        if (F.lane == 0) { pos[pi] = row; gate_of_row[row] = pick_gate[pi]; tok_of_row[row] = tok; }
        const GAS v4u* src = (const GAS v4u*)(X8 + (size_t)tok * D) + F.lane; GAS v4u* dst = (GAS v4u*)(XS8 + (size_t)row * D) + F.lane;
        dst[0] = src[0]; dst[64] = src[64]; } }
    if (blockIdx.x == 0) for (int e = 0; e < NE; ++e) { const int r0 = pst[e] + pst[32 + e], r1 = pst[e] + (((pst[32 + e] + 255) >> 8) << 8);
        for (int r = r0 + F.tid; r < r1; r += NWAVES * 64) { tok_of_row[r] = 0; gate_of_row[r] = 0.f; } }
}

__device__ __forceinline__ void final_phase(const Frame& F, const Args& a) {
    const bf16* H1 = (const bf16*)(a.ws + WS_H1); const bf16* OR = (const bf16*)(a.ws + WS_OROW);
    const int* pos = (const int*)(a.ws + WS_PICK) + 3 * 65536;
    const int gw = F.vcu * NWAVES + F.wave, NGW = F.G * NWAVES;
    for (int m = gw; m < T; m += NGW) {
        const GAS v2u* xr = (const GAS v2u*)(H1 + (size_t)m * D) + F.lane; const GAS f32x4* gr = (const GAS f32x4*)inp(I_GFINAL) + F.lane;
        f32x4 v[8];
#pragma unroll
        for (int j = 0; j < 8; ++j) { const v2u w = xr[64 * j]; v[j] = (f32x4){bflo(w.x), bfhi(w.x), bflo(w.y), bfhi(w.y)}; }
#pragma unroll
        for (int k = 0; k < 4; ++k) { const int row = pos[m * 4 + k]; const GAS v2u* orp = (const GAS v2u*)(OR + (size_t)row * D) + F.lane;
#pragma unroll
            for (int j = 0; j < 8; ++j) { const v2u w = orp[64 * j]; v[j].x += bflo(w.x); v[j].y += bfhi(w.x); v[j].z += bflo(w.y); v[j].w += bfhi(w.y); } }
        float s = 0.f;
#pragma unroll
        for (int j = 0; j < 8; ++j) s += (v[j].x * v[j].x + v[j].y * v[j].y) + (v[j].z * v[j].z + v[j].w * v[j].w);
        const float rstd = 1.0f / sqrtf(wave_sum(s) * (1.f / D) + EPS);
        GAS f32x4* o = (GAS f32x4*)(a.out + (size_t)m * D) + F.lane;
#pragma unroll
        for (int j = 0; j < 8; ++j) { const f32x4 g = gr[64 * j]; o[64 * j] = (f32x4){v[j].x * rstd * g.x, v[j].y * rstd * g.y, v[j].z * rstd * g.z, v[j].w * rstd * g.w}; }
    }
}

#ifndef MK_N_LAUNCHES
#define MK_N_LAUNCHES 1
#endif
constexpr int NPH = 14;
__global__ void __launch_bounds__(NWAVES * 64, 2) fwd(Args args) {
    extern __shared__ __attribute__((aligned(16))) unsigned char lds[];
#define NEWFRAME() Frame F; { int tz = threadIdx.x; asm volatile("" : "+v"(tz)); F.lds = (LAS unsigned char*)lds; F.MISC = (volatile LAS unsigned*)(F.lds + MISC_OFF); F.tid = tz; F.lane = tz & 63; F.wave = __builtin_amdgcn_readfirstlane(tz >> 6); \
        F.G = gridDim.x; const int bx = blockIdx.x; F.vcu = (F.G % 8 == 0) ? (bx % 8) * (F.G / 8) + bx / 8 : bx; }
    unsigned char* ws = args.ws;
    unsigned* ctl = (unsigned*)(ws + WS_CTL);
    for (int u = threadIdx.x; u < (LDS_BYTES - MISC_OFF) / 4; u += NWAVES * 64) ((LAS unsigned*)((LAS unsigned char*)lds + MISC_OFF))[u] = 0u;
    __syncthreads();
    const int lo = args.ph_lo, hi = args.ph_hi;
    XcdBarrier bar; bar.bar = ctl + CW_BAR; bar.x = 0; bar.st = nullptr;
    if (hi - lo > 1) bar = xcd_barrier_post(ctl + CW_BAR, (volatile LAS unsigned*)((LAS unsigned char*)lds + MISC_OFF) + 8);
#ifndef PHMASK
#define PHMASK 0xFFFF
#endif
#define IN(k) (((PHMASK >> (k)) & 1) && lo <= (k) && (k) < hi)
#define SEAM(k) do { if (IN(k) && IN((k) + 1)) xcd_barrier(bar); } while (0)

    if (IN(0)) { NEWFRAME(); p0_prologue(F, args); } SEAM(0);
    if (IN(1)) { NEWFRAME();
        const int c = (int)blockIdx.x, G = F.G;
        { pg8::Gemm g{(const bf16*)(ws + WS_XN), (const bf16*)(ws + WS_WIN), T, PC_G, D}; pg8::StaticOrder S; S.init(T, PC_G, G, c);
          pg8::EpiBf16<0> E{(bf16*)(ws + WS_P), NP, nullptr, 0, 0, 1.f};
          pg8::gemm_phase<pg8::EpiBf16<0>, pg8::StaticOrder, true, true>(F.lds, g, S, E); }
        __syncthreads();
        { pg8::Gemm g{(const bf16*)(ws + WS_MN), (const bf16*)(ws + WS_WMKV), 512, 2048, D}; pg8::StaticOrder S; S.init(512, 2048, G, (c + G - G / 2) % G);
          pg8::EpiKV E{(bf16*)(ws + WS_KMEM), (bf16*)(ws + WS_VT)};
          pg8::gemm_phase<pg8::EpiKV, pg8::StaticOrder, true, true>(F.lds, g, S, E); }
        __syncthreads();
        { int start, cnt;
          if (G == 256) { if (c < 144) { start = 5 * c; cnt = 5; } else if (c < 224) { start = 720 + 7 * (c - 144); cnt = 7; } else { start = 1280 + 8 * (c - 224); cnt = 8; } }
          else { const int per = (1536 + G - 1) / G; start = per * c; cnt = start >= 1536 ? 0 : (1536 - start < per ? 1536 - start : per); }
          pg8::Gemm g{(const bf16*)(ws + WS_XN8), (const bf16*)(ws + WS_WIN8), T, NP - PC_G, D}; pg8::RangeOrder S; S.init(T, NP - PC_G, start, cnt);
          pg8::EpiBf16<0> E{(bf16*)(ws + WS_P) + PC_G, NP, nullptr, 0, 0, 1.f};
          pg8::gemm_phase<pg8::EpiBf16<0>, pg8::RangeOrder, true, true, 1>(F.lds, g, S, E); }
    } SEAM(1);
    if (IN(2)) { NEWFRAME();
#ifndef NO_R1
 r1_lora_in(F, args);
#endif
#ifndef NO_LRU
 lru_pass<false>(F, args, F.vcu * NWAVES + F.wave, F.G * NWAVES);
#endif
 } SEAM(2);
    if (IN(3)) { NEWFRAME();
        lru_carry(F, args);
        { pg8::Gemm g{(const bf16*)(ws + WS_XN), (const bf16*)(ws + WS_WLORA), T, 3072, LORA_K}; pg8::StaticOrder S; S.init(T, 3072, F.G, (int)blockIdx.x);
          pg8::EpiF32 E{(float*)(ws + WS_LORAOUT), 3072};
          pg8::gemm_phase<pg8::EpiF32, pg8::StaticOrder, true, true>(F.lds, g, S, E); }
    } SEAM(3);
    if (IN(4)) { NEWFRAME(); r3_blocks(F, args); } SEAM(4);
    if (IN(5)) { NEWFRAME();
        if (F.tid < 64) ((LAS unsigned*)(F.lds + SC_SYNC))[F.tid] = 0u; __syncthreads();
        int bh = 0, quarter = 0; const bool sw = scan_wg(bh, quarter);
        int gw2, NGW2; { const int bx = blockIdx.x, G = F.G; if (G == 256) { NGW2 = 1792; gw2 = sw ? ((bx >> 4) * 8 + (bx & 7)) * 6 + (F.wave - 2) : 768 + ((bx >> 4) * 8 + (bx & 7)) * 8 + F.wave; } else { NGW2 = G * 8; gw2 = F.vcu * 8 + F.wave; } }
        if (sw && F.wave == 0) r4_scan<0>(F, args, bh, quarter);
        else if (sw && F.wave == 1) r4_feeder(F, args, bh);
        else {
            const int rot = F.wave % 3;
            if (rot == 0) { moe_weight_convert(F, args, gw2, NGW2); xattn_phase(F, args, gw2, NGW2); lru_pass<true>(F, args, gw2, NGW2); }
            else if (rot == 1) { xattn_phase(F, args, gw2, NGW2); lru_pass<true>(F, args, gw2, NGW2); moe_weight_convert(F, args, gw2, NGW2); }
            else { lru_pass<true>(F, args, gw2, NGW2); moe_weight_convert(F, args, gw2, NGW2); xattn_phase(F, args, gw2, NGW2); } }
    } SEAM(5);
    if (IN(6)) { NEWFRAME(); r5_finish(F, args); } SEAM(6);
    if (IN(7)) { NEWFRAME();
        pg8::Gemm g{(const bf16*)(ws + WS_YABC), (const bf16*)(ws + WS_WBR), T, 2048, 3072}; pg8::StaticOrder S; S.init(T, 2048, F.G, (int)blockIdx.x);
        pg8::EpiBranch2 E{(const bf16*)(ws + WS_P), NP, PC_G, (bf16*)(ws + WS_MERGED)};
        pg8::gemm_phase<pg8::EpiBranch2, pg8::StaticOrder, true, true>(F.lds, g, S, E);
    } SEAM(7);
    if (IN(8)) { NEWFRAME();
        pg8::Gemm g{(const bf16*)(ws + WS_MERGED), (const bf16*)(ws + WS_WO), T, D, D}; pg8::StaticOrder S; S.init(T, D, F.G, (int)blockIdx.x);
        pg8::EpiRes E{inp(I_X), (bf16*)(ws + WS_H1), D};
        pg8::gemm_phase<pg8::EpiRes, pg8::StaticOrder, true, true>(F.lds, g, S, E);
    } SEAM(8);
    if (IN(9)) { NEWFRAME(); router_phase(F, args); } SEAM(9);
    if (IN(10)) { NEWFRAME(); scatter_phase(F, args); } SEAM(10);
    if (IN(11)) { NEWFRAME();
        const int ntiles = __builtin_amdgcn_readfirstlane((int)__hip_atomic_load(ctl + CW_NTILES, __ATOMIC_RELAXED, __HIP_MEMORY_SCOPE_AGENT));
        pg8::Gemm g{(const bf16*)(ws + WS_XS), (const bf16*)(ws + WS_WGU), ntiles * 256, NE * 4096, D}; pg8::MoeOrder<false> S; S.init(ntiles, 16, F.G, (int)blockIdx.x, (const int*)(ctl + CW_TILEE), nullptr);
        pg8::EpiSwiglu E{ws + WS_HH, inp(I_BGATE), inp(I_BUP)};
        pg8::gemm_phase<pg8::EpiSwiglu, pg8::MoeOrder<false>, true, true, 1>(F.lds, g, S, E);
    } SEAM(11);
    if (IN(12)) { NEWFRAME();
        const int ntiles = __builtin_amdgcn_readfirstlane((int)__hip_atomic_load(ctl + CW_NTILES, __ATOMIC_RELAXED, __HIP_MEMORY_SCOPE_AGENT));
        pg8::Gemm g{(const bf16*)(ws + WS_HH), (const bf16*)(ws + WS_WD), ntiles * 256, NE * 2048, D}; pg8::MoeOrder<false> S; S.init(ntiles, 8, F.G, (int)blockIdx.x, (const int*)(ctl + CW_TILEE), nullptr);
        pg8::EpiDown E{(bf16*)(ws + WS_OROW), inp(I_BDOWN), (const float*)(ws + WS_ROWTAB)};
        pg8::gemm_phase<pg8::EpiDown, pg8::MoeOrder<false>, true, true, 1>(F.lds, g, S, E);
    } SEAM(12);
    if (IN(13)) { NEWFRAME(); final_phase(F, args); }
#ifdef PROBE_EXTRA_PHASE
    if (lo == 14) { NEWFRAME(); if (F.tid < 64) ((LAS unsigned*)(F.lds + SC_SYNC))[F.tid] = 0u; __syncthreads(); int bh = 0, quarter = 0; const bool sw = scan_wg(bh, quarter); if (sw && F.wave == 0) r4_scan<0>(F, args, bh, quarter); else if (sw && F.wave == 1) r4_feeder(F, args, bh); }
    if (lo == 17) { NEWFRAME(); int bh = 0, quarter = 0; const bool sw = scan_wg(bh, quarter); if (sw && F.wave == 0) r4_scan<1>(F, args, bh, quarter); }
    if (lo == 15) { NEWFRAME(); moe_weight_convert(F, args, F.vcu * 8 + F.wave, F.G * 8); }
#endif
#undef IN
#undef SEAM
}

extern "C" void kernel_launch(void* const* d_in, const int* in_sizes, int n_in, void* d_out, int out_size, void* d_ws, size_t ws_size, hipStream_t stream) {
    static int grid = 0;
    if (grid == 0) {
        if (n_in != 39 || out_size != T * D || ws_size < WS_END) { fprintf(stderr, "kernel_launch: built for 39 inputs, out of %d floats, >= %zu bytes of workspace; got n_in %d, out %d, ws %zu; nothing launched\n", T * D, (size_t)WS_END, n_in, out_size, ws_size); grid = -1; return; }
        int dev = 0, cus = 0, per_cu = 0;
        if (hipGetDevice(&dev) != hipSuccess || hipDeviceGetAttribute(&cus, hipDeviceAttributeMultiprocessorCount, dev) != hipSuccess) { fprintf(stderr, "kernel_launch: device query failed\n"); grid = -1; return; }
        if (hipFuncSetAttribute((const void*)fwd, hipFuncAttributeMaxDynamicSharedMemorySize, LDS_BYTES) != hipSuccess) { fprintf(stderr, "kernel_launch: hipFuncSetAttribute failed\n"); grid = -1; return; }
        if (hipOccupancyMaxActiveBlocksPerMultiprocessor(&per_cu, (const void*)fwd, NWAVES * 64, LDS_BYTES) != hipSuccess || per_cu < 1)
            fprintf(stderr, "kernel_launch: note: occupancy query reports %d workgroups per CU\n", per_cu);
        (void)hipGetLastError();
        grid = cus;
    }
    if (grid < 0) return;
    (void)in_sizes;
    if (hipMemsetAsync((char*)d_ws + WS_CTL, 0, CTL_ZERO_BYTES, stream) != hipSuccess) { fprintf(stderr, "kernel_launch: hipMemsetAsync failed\n"); return; }
    Args a{};
    for (int i = 0; i < 39; ++i) a.in[i] = (const float*)d_in[i];
    a.out = (float*)d_out; a.ws = (unsigned char*)d_ws;
#if MK_N_LAUNCHES == 1
    a.ph_lo = 0; a.ph_hi = NPH;
    hipLaunchKernelGGL(fwd, dim3(grid), dim3(NWAVES * 64), LDS_BYTES, stream, a);
#else
    for (int k = 0; k < NPH; ++k) { a.ph_lo = k; a.ph_hi = k + 1; int reps = 1;
#ifdef PROBE_REP_PHASE
        if (k == PROBE_REP_PHASE) reps = 1 + PROBE_REP_N;
#endif
        for (int r = 0; r < reps; ++r) hipLaunchKernelGGL(fwd, dim3(grid), dim3(NWAVES * 64), LDS_BYTES, stream, a); }
#ifdef PROBE_EXTRA_PHASE
    for (int r = 0; r < PROBE_REP_N; ++r) { a.ph_lo = PROBE_EXTRA_PHASE; a.ph_hi = PROBE_EXTRA_PHASE + 1; hipLaunchKernelGGL(fwd, dim3(grid), dim3(NWAVES * 64), LDS_BYTES, stream, a); }
#endif
#endif
    const hipError_t le = hipPeekAtLastError();
    if (le != hipSuccess) fprintf(stderr, "kernel_launch: launch failed: %s\n", hipGetErrorName(le));
}
```

```cpp
#include <hip/hip_runtime.h>
#include <cstdio>
#include <cstdint>
namespace pg8 {
#define PG8_LAS __attribute__((address_space(3)))
typedef unsigned short bf16_t;
typedef short bf16x8 __attribute__((ext_vector_type(8)));
typedef float f32x4 __attribute__((ext_vector_type(4)));
typedef unsigned u32x4 __attribute__((ext_vector_type(4)));
constexpr int BM = 256, BK = 64, HALF = 128, HTB = HALF * BK * 2  , STAGE_BYTES = 8 * HTB, NXCD = 8, WGM = 8;

__host__ __device__ __forceinline__ int lds_byte(int r, int c) { const int st = (r >> 4) * 2 + (c >> 5), rr = r & 15, cc = c & 31, ob = rr * 64 + cc * 2; return st * 1024 + (ob ^ (((ob >> 9) & 1) << 5)); }
__host__ __device__ __forceinline__ void stage_rc(int b, int& R, int& C) { const int st = b / 1024, sb = b % 1024, swz = sb ^ (((sb >> 9) & 1) << 5); R = (st >> 1) * 16 + swz / 64; C = (st & 1) * 32 + (swz % 64) / 2; }
__host__ __device__ __forceinline__ int perm32(int rho) { const int n = rho >> 4, i = rho & 15; return 8 * (i >> 2) + 4 * n + (i & 3); }

struct Unit { int pm, pn; };
struct Gemm { const bf16_t* A; const bf16_t* Bt; int M, N, K; };

struct StaticOrder {
    static constexpr bool GATHER = false; __device__ __forceinline__ int arow(const Unit&, int) const { return 0; }
    int nM, nN, nwg, G, c;
    __host__ __device__ void init(int M, int N, int G_, int c_) { nM = M / BM; nN = N / BM; nwg = nM * nN; G = G_; c = c_; }
    __host__ __device__ bool next(int i, Unit& u) const {
        const int L = i * G + c; if (L >= nwg) return false;
        int wgid = (int)L; { const int q = nwg / NXCD, r = nwg % NXCD, xcd = wgid % NXCD, off = wgid / NXCD; wgid = (xcd < r ? xcd * (q + 1) : r * (q + 1) + (xcd - r) * q) + off; }
        const int nig = WGM * nN, gid = wgid / nig, fm = gid * WGM, gsz = (nM - fm) < WGM ? (nM - fm) : WGM;
        u.pm = fm + ((wgid % nig) % gsz); u.pn = (wgid % nig) / gsz; return true;
    }
    __device__ __forceinline__ void a_ready(const Unit&) const {}
    __device__ __forceinline__ void done(const Unit&) const {}
};
struct RangeOrder {
    static constexpr bool GATHER = false; __device__ __forceinline__ int arow(const Unit&, int) const { return 0; }
    StaticOrder so; int start, cnt;
    __device__ void init(int M, int N, int start_, int cnt_) { so.init(M, N, 1, 0); start = start_; cnt = cnt_; }
    __device__ bool next(int i, Unit& u) const { if (i >= cnt) return false; return so.next(start + i, u); }
    __device__ __forceinline__ void a_ready(const Unit&) const {}
    __device__ __forceinline__ void done(const Unit&) const {}
};
__device__ __forceinline__ unsigned cvt_pk_bf16(float lo, float hi) { unsigned r; asm volatile("v_cvt_pk_bf16_f32 %0, %1, %2" : "=v"(r) : "v"(lo), "v"(hi)); return r; }
typedef float f32x2 __attribute__((ext_vector_type(2)));
__device__ __forceinline__ f32x2 gelu_pk(f32x2 v) {
    const f32x2 av = __builtin_elementwise_abs(v), d = av * 0.2316418882f + 1.0f;
    f32x2 t; t.x = __builtin_amdgcn_rcpf(d.x); t.y = __builtin_amdgcn_rcpf(d.y);
    f32x2 q = t * 0.5307027145f + (-0.7265760135f); q = q * t + 0.7107068705f; q = q * t + (-0.142248368f); q = q * t + 0.127414796f; q = q * t;
    const f32x2 s = (v * v) * (-0.72134752044f);
    f32x2 e; e.x = __builtin_amdgcn_exp2f(s.x); e.y = __builtin_amdgcn_exp2f(s.y);
    const f32x2 m = v * (q * e), r = v - m;
    f32x2 o; o.x = v.x < 0.f ? m.x : r.x; o.y = v.y < 0.f ? m.y : r.y; return o;
}

template <int ACT  > struct EpiBf16 {
    static constexpr bool PERM = true, AFTER_DRAIN = false; static constexpr int MIDK = 0; static constexpr int WSCALE = 0x79797979  ; static_assert(ACT == 0 || ACT == 1 || ACT == 2, "EpiBf16: ACT is 0 (none), 1 (gelu_pk) or 2 (sigmoid)");
    bf16_t* O; int ldc; const float* bias; int split_cols; size_t split_stride; float scale0;
    __device__ __forceinline__ void operator()(const f32x4 (&acc)[2][2][4][2], const Unit& u, int wr, int wc, int fr, int fq) const {
        int tz_ = threadIdx.x; asm volatile("" : "+v"(tz_)); { const int wid_ = tz_ >> 6, lane_ = tz_ & 63; wr = wid_ >> 2; wc = wid_ & 3; fr = lane_ & 15; fq = lane_ >> 4; }
        const int row0 = u.pm * BM + wr * 64 + fr; int colt = u.pn * BM; bf16_t* base = O;
        float sc = 1.f; if (split_cols) { const int t = colt / split_cols; base += (size_t)t * split_stride; colt -= t * split_cols; if (t == 0) sc = scale0; }
        const int col0 = colt + wc * 32 + 8 * fq, bcol0 = u.pn * BM + wc * 32 + 8 * fq;
        f32x4 bv[2][2];
#pragma unroll
        for (int bj = 0; bj < 2; ++bj)
#pragma unroll
            for (int n = 0; n < 2; ++n) bv[bj][n] = bias ? *(const f32x4*)(bias + bcol0 + bj * HALF + 4 * n) : (f32x4){0.f, 0.f, 0.f, 0.f};
#pragma unroll
        for (int ai = 0; ai < 2; ++ai)
#pragma unroll
            for (int m = 0; m < 4; ++m) { bf16_t* rowp = base + (size_t)(row0 + ai * HALF + m * 16) * ldc + col0;
#pragma unroll
                for (int bj = 0; bj < 2; ++bj) { f32x4 v0 = acc[ai][bj][m][0] + bv[bj][0], v1 = acc[ai][bj][m][1] + bv[bj][1];
                    if (ACT == 1) { f32x2 a = gelu_pk((f32x2){v0[0], v0[1]}), b = gelu_pk((f32x2){v0[2], v0[3]}), c = gelu_pk((f32x2){v1[0], v1[1]}), d = gelu_pk((f32x2){v1[2], v1[3]});
                        v0 = (f32x4){a.x, a.y, b.x, b.y}; v1 = (f32x4){c.x, c.y, d.x, d.y}; }
                    if (ACT == 2) {
#pragma unroll
                        for (int j = 0; j < 4; ++j) { v0[j] = fmaxf(__builtin_amdgcn_rcpf(1.0f + __expf(-v0[j])), 1e-30f); v1[j] = fmaxf(__builtin_amdgcn_rcpf(1.0f + __expf(-v1[j])), 1e-30f); } }
                    v0 = v0 * sc; v1 = v1 * sc; u32x4 w; w.x = cvt_pk_bf16(v0[0], v0[1]); w.y = cvt_pk_bf16(v0[2], v0[3]); w.z = cvt_pk_bf16(v1[0], v1[1]); w.w = cvt_pk_bf16(v1[2], v1[3]);
                    *(u32x4*)(rowp + bj * HALF) = w; } }
    }
};

__device__ __forceinline__ float bf_lo(unsigned w) { return __builtin_bit_cast(float, w << 16); }
__device__ __forceinline__ float bf_hi(unsigned w) { return __builtin_bit_cast(float, w & 0xffff0000u); }
__device__ __forceinline__ float fsigmoid(float x) { return __builtin_amdgcn_rcpf(1.0f + __expf(-x)); }
typedef unsigned u32x2 __attribute__((ext_vector_type(2)));

struct EpiF32 {
    static constexpr bool PERM = false, AFTER_DRAIN = false; static constexpr int MIDK = 0; static constexpr int WSCALE = 0x7f7f7f7f;
    float* C; int ldc;
    __device__ __forceinline__ void operator()(const f32x4 (&acc)[2][2][4][2], const Unit& u, int wr, int wc, int fr, int fq) const {
        const int row0 = u.pm * BM + wr * 64 + fr, col0 = u.pn * BM + wc * 32 + 4 * fq;
#pragma unroll
        for (int ai = 0; ai < 2; ++ai)
#pragma unroll
            for (int m = 0; m < 4; ++m) { float* rowp = C + (size_t)(row0 + ai * HALF + m * 16) * ldc + col0;
#pragma unroll
                for (int bj = 0; bj < 2; ++bj)
#pragma unroll
                    for (int n = 0; n < 2; ++n) *(f32x4*)(rowp + bj * HALF + n * 16) = acc[ai][bj][m][n]; }
    }
};
struct EpiRes {
    static constexpr bool PERM = false, AFTER_DRAIN = false; static constexpr int MIDK = 0; static constexpr int WSCALE = 0x7f7f7f7f;
    const float* X; bf16_t* C; int ldc;
    __device__ __forceinline__ void operator()(const f32x4 (&acc)[2][2][4][2], const Unit& u, int wr, int wc, int fr, int fq) const {
        const int row0 = u.pm * BM + wr * 64 + fr, col0 = u.pn * BM + wc * 32 + 4 * fq;
#pragma unroll
        for (int ai = 0; ai < 2; ++ai)
#pragma unroll
            for (int m = 0; m < 4; ++m) { const size_t off = (size_t)(row0 + ai * HALF + m * 16) * ldc + col0;
#pragma unroll
                for (int bj = 0; bj < 2; ++bj)
#pragma unroll
                    for (int n = 0; n < 2; ++n) { const f32x4 xv = *(const f32x4*)(X + off + bj * HALF + n * 16); const f32x4 v = acc[ai][bj][m][n] + xv;
                        u32x2 w; w.x = cvt_pk_bf16(v[0], v[1]); w.y = cvt_pk_bf16(v[2], v[3]); *(u32x2*)(C + off + bj * HALF + n * 16) = w; }
                asm volatile("" ::: "memory"); }
    }
};
struct EpiKV {
    static constexpr bool PERM = false, AFTER_DRAIN = false; static constexpr int MIDK = 0; static constexpr int WSCALE = 0x7f7f7f7f;
    bf16_t* Kb; bf16_t* VT;
    __device__ __forceinline__ void operator()(const f32x4 (&acc)[2][2][4][2], const Unit& u, int wr, int wc, int fr, int fq) const {
        const int row0 = u.pm * BM + wr * 64 + fr, col0 = u.pn * BM + wc * 32 + 4 * fq;
#pragma unroll
        for (int ai = 0; ai < 2; ++ai)
#pragma unroll
            for (int m = 0; m < 4; ++m) { const int r = row0 + ai * HALF + m * 16;
#pragma unroll
                for (int bj = 0; bj < 2; ++bj)
#pragma unroll
                    for (int n = 0; n < 2; ++n) { const f32x4 v = acc[ai][bj][m][n]; const int c = col0 + bj * HALF + n * 16;
                        if (u.pn < 4) { u32x2 w; w.x = cvt_pk_bf16(v[0], v[1]); w.y = cvt_pk_bf16(v[2], v[3]); *(u32x2*)(Kb + (size_t)r * 1024 + c) = w; }
                        else { const int cc = c - 1024, h = cc >> 8, d = cc & 255, b = r >> 8, mm = r & 255;
                            const int idx = (mm >> 5) * 32 + ((mm >> 2) & 3) * 8 + ((mm >> 4) & 1) * 4 + (mm & 3);
                            bf16_t* o = VT + ((size_t)((b * 4 + h) * 256 + d)) * 256 + idx;
                            const unsigned w0 = cvt_pk_bf16(v[0], v[1]), w1 = cvt_pk_bf16(v[2], v[3]);
                            o[0] = (bf16_t)(w0 & 0xffffu); o[256] = (bf16_t)(w0 >> 16); o[512] = (bf16_t)(w1 & 0xffffu); o[768] = (bf16_t)(w1 >> 16); } } }
    }
};
struct EpiBranch {
    static constexpr bool PERM = false, AFTER_DRAIN = false; static constexpr int MIDK = 0; static constexpr int WSCALE = 0x7f7f7f7f;
    const bf16_t* P; int ldp; int gcol0; float* macc; bf16_t* merged;
    __device__ __forceinline__ void operator()(const f32x4 (&acc)[2][2][4][2], const Unit& u, int wr, int wc, int fr, int fq) const {
        const int br = u.pm >> 6, pm = u.pm & 63, pn = u.pn & 7;
        const int row0 = pm * BM + wr * 64 + fr, col0 = pn * BM + wc * 32 + 4 * fq;
#pragma unroll
        for (int ai = 0; ai < 2; ++ai)
#pragma unroll
            for (int m = 0; m < 4; ++m) { const int r = row0 + ai * HALF + m * 16; const bf16_t* prow = P + (size_t)r * ldp + gcol0 + br * 2048;
#pragma unroll
                for (int bj = 0; bj < 2; ++bj)
#pragma unroll
                    for (int n = 0; n < 2; ++n) { const int c = col0 + bj * HALF + n * 16; const u32x2 gw = *(const u32x2*)(prow + c);
                        f32x4 g; g[0] = fsigmoid(bf_lo(gw.x)); g[1] = fsigmoid(bf_hi(gw.x)); g[2] = fsigmoid(bf_lo(gw.y)); g[3] = fsigmoid(bf_hi(gw.y));
                        f32x4 v = acc[ai][bj][m][n] * g; float* mp = macc + (size_t)r * 2048 + c;
                        if (br > 0) v = v + *(const f32x4*)mp;
                        if (br < 2) *(f32x4*)mp = v;
                        else { u32x2 w; w.x = cvt_pk_bf16(v[0], v[1]); w.y = cvt_pk_bf16(v[2], v[3]); *(u32x2*)(merged + (size_t)r * 2048 + c) = w; } }
                asm volatile("" ::: "memory"); }
    }
};
struct EpiSwiglu {
    static constexpr bool PERM = true, AFTER_DRAIN = false; static constexpr int MIDK = 0; static constexpr int WSCALE = 0x79797979;
    unsigned char* H; const float* bg; const float* bu;
    __device__ __forceinline__ void operator()(const f32x4 (&acc)[2][2][4][2], const Unit& u, int wr, int wc, int fr, int fq) const {
        int tz_ = threadIdx.x; asm volatile("" : "+v"(tz_)); { const int wid_ = tz_ >> 6, lane_ = tz_ & 63; wr = wid_ >> 2; wc = wid_ & 3; fr = lane_ & 15; fq = lane_ >> 4; }
        const int e = u.pn >> 4, ct = u.pn & 15;
        const int row0 = u.pm * BM + wr * 64 + fr, col0 = ct * 128 + wc * 32 + 8 * fq;
        f32x4 bgv[2], buv[2];
#pragma unroll
        for (int n = 0; n < 2; ++n) { bgv[n] = *(const f32x4*)(bg + (size_t)e * 2048 + col0 + 4 * n); buv[n] = *(const f32x4*)(bu + (size_t)e * 2048 + col0 + 4 * n); }
#pragma unroll
        for (int ai = 0; ai < 2; ++ai)
#pragma unroll
            for (int m = 0; m < 4; ++m) { unsigned char* rowp = H + (size_t)(row0 + ai * HALF + m * 16) * 2048 + col0;
                f32x4 o[2];
#pragma unroll
                for (int n = 0; n < 2; ++n) { const f32x4 g = acc[ai][0][m][n] + bgv[n], up = acc[ai][1][m][n] + buv[n];
#pragma unroll
                    for (int j = 0; j < 4; ++j) { const float hg = fminf(g[j], 7.0f), hu = fminf(fmaxf(up[j], -7.0f), 7.0f); o[n][j] = (hu + 1.0f) * hg * fsigmoid(1.702f * hg); } }
                u32x2 w; { int t0 = __builtin_amdgcn_cvt_pk_fp8_f32(o[0][0], o[0][1], 0, false); t0 = __builtin_amdgcn_cvt_pk_fp8_f32(o[0][2], o[0][3], t0, true); int t1 = __builtin_amdgcn_cvt_pk_fp8_f32(o[1][0], o[1][1], 0, false); t1 = __builtin_amdgcn_cvt_pk_fp8_f32(o[1][2], o[1][3], t1, true); w.x = (unsigned)t0; w.y = (unsigned)t1; }
                *(u32x2*)rowp = w; }
    }
};
struct EpiDown {
    static constexpr bool PERM = true, AFTER_DRAIN = false; static constexpr int MIDK = 0; static constexpr int WSCALE = 0x79797979;
    bf16_t* O; const float* bd; const float* rowgate;
    __device__ __forceinline__ void operator()(const f32x4 (&acc)[2][2][4][2], const Unit& u, int wr, int wc, int fr, int fq) const {
        int tz_ = threadIdx.x; asm volatile("" : "+v"(tz_)); { const int wid_ = tz_ >> 6, lane_ = tz_ & 63; wr = wid_ >> 2; wc = wid_ & 3; fr = lane_ & 15; fq = lane_ >> 4; }
        const int e = u.pn >> 3, ct = u.pn & 7;
        const int row0 = u.pm * BM + wr * 64 + fr, col0 = ct * BM + wc * 32 + 8 * fq;
        f32x4 bv[2][2];
#pragma unroll
        for (int bj = 0; bj < 2; ++bj)
#pragma unroll
            for (int n = 0; n < 2; ++n) bv[bj][n] = *(const f32x4*)(bd + (size_t)e * 2048 + col0 + bj * HALF + 4 * n);
#pragma unroll
        for (int ai = 0; ai < 2; ++ai)
#pragma unroll
            for (int m = 0; m < 4; ++m) { const int r = row0 + ai * HALF + m * 16; const float gs = rowgate[r]; bf16_t* rowp = O + (size_t)r * 2048 + col0;
#pragma unroll
                for (int bj = 0; bj < 2; ++bj) { const f32x4 v0 = (acc[ai][bj][m][0] + bv[bj][0]) * gs, v1 = (acc[ai][bj][m][1] + bv[bj][1]) * gs;
                    u32x4 w; w.x = cvt_pk_bf16(v0[0], v0[1]); w.y = cvt_pk_bf16(v0[2], v0[3]); w.z = cvt_pk_bf16(v1[0], v1[1]); w.w = cvt_pk_bf16(v1[2], v1[3]);
                    *(u32x4*)(rowp + bj * HALF) = w; } }
    }
};

struct EpiBranch2 {
    static constexpr bool PERM = false, AFTER_DRAIN = false; static constexpr int MIDK = 16; static constexpr int WSCALE = 0x7f7f7f7f;
    const bf16_t* P; int ldp; int gcol0; bf16_t* merged;
    __device__ __forceinline__ void mid(f32x4 (&acc)[2][2][4][2], const Unit& u, int which, int, int, int, int) const {
        int tz = threadIdx.x; asm volatile("" : "+v"(tz));
        const int wid_ = tz >> 6, lane_ = tz & 63, wr = wid_ >> 2, wc = wid_ & 3, fr = lane_ & 15, fq = lane_ >> 4;
        const int row0 = u.pm * BM + wr * 64 + fr, col0 = u.pn * BM + wc * 32 + 4 * fq;
#pragma unroll
        for (int ai = 0; ai < 2; ++ai)
#pragma unroll
            for (int m = 0; m < 4; ++m) { const bf16_t* prow = P + (size_t)(row0 + ai * HALF + m * 16) * ldp + gcol0 + (which - 1) * 2048;
#pragma unroll
                for (int bj = 0; bj < 2; ++bj)
#pragma unroll
                    for (int n = 0; n < 2; ++n) { const int c = col0 + bj * HALF + n * 16; const u32x2 ga = *(const u32x2*)(prow + c), gb = *(const u32x2*)(prow + 2048 + c);
                        const float a_[4] = {bf_lo(ga.x), bf_hi(ga.x), bf_lo(ga.y), bf_hi(ga.y)}, b_[4] = {bf_lo(gb.x), bf_hi(gb.x), bf_lo(gb.y), bf_hi(gb.y)};
#pragma unroll
                        for (int j = 0; j < 4; ++j) acc[ai][bj][m][n][j] *= a_[j] * __builtin_amdgcn_rcpf(b_[j]); }
                asm volatile("" ::: "memory"); }
    }
    __device__ __forceinline__ void operator()(const f32x4 (&acc)[2][2][4][2], const Unit& u, int wr, int wc, int fr, int fq) const {
        const int row0 = u.pm * BM + wr * 64 + fr, col0 = u.pn * BM + wc * 32 + 4 * fq;
#pragma unroll
        for (int ai = 0; ai < 2; ++ai)
#pragma unroll
            for (int m = 0; m < 4; ++m) { const int r = row0 + ai * HALF + m * 16; const bf16_t* prow = P + (size_t)r * ldp + gcol0 + 2 * 2048;
#pragma unroll
                for (int bj = 0; bj < 2; ++bj)
#pragma unroll
                    for (int n = 0; n < 2; ++n) { const int c = col0 + bj * HALF + n * 16; const u32x2 gw = *(const u32x2*)(prow + c);
                        const float g_[4] = {bf_lo(gw.x), bf_hi(gw.x), bf_lo(gw.y), bf_hi(gw.y)}; f32x4 v = acc[ai][bj][m][n];
#pragma unroll
                        for (int j = 0; j < 4; ++j) v[j] *= g_[j];
                        u32x2 w; w.x = cvt_pk_bf16(v[0], v[1]); w.y = cvt_pk_bf16(v[2], v[3]); *(u32x2*)(merged + (size_t)r * 2048 + c) = w; }
                asm volatile("" ::: "memory"); }
    }
};
struct BranchOrder {                              static constexpr bool GATHER = false; __device__ __forceinline__ int arow(const Unit&, int) const { return 0; }
    StaticOrder so;
    __device__ void init(int G_, int c_) { so.init(16384, 2048, G_, c_); }
    __device__ bool next(int i, Unit& u) const { const int br = i % 3; Unit t; if (!so.next(i / 3, t)) return false; u.pm = br * 64 + t.pm; u.pn = br * 8 + t.pn; return true; }
    __device__ __forceinline__ void a_ready(const Unit&) const {}
    __device__ __forceinline__ void done(const Unit&) const {}
};
template <bool GATH> struct MoeOrder {
    static constexpr bool GATHER = GATH;
    StaticOrder so; const int* tile_e; const int* tok; int nN;
    __device__ void init(int ntiles, int nN_, int G_, int c_, const int* te, const int* tk) { so.init(ntiles * BM, nN_ * BM, G_, c_); tile_e = te; tok = tk; nN = nN_; }
    __device__ bool next(int i, Unit& u) const { Unit t; if (!so.next(i, t)) return false; u.pm = t.pm; u.pn = tile_e[t.pm] * nN + t.pn; return true; }
    __device__ __forceinline__ int arow(const Unit& u, int r) const { return tok[u.pm * BM + r]; }
    __device__ __forceinline__ void a_ready(const Unit&) const {}
    __device__ __forceinline__ void done(const Unit&) const {}
};
typedef int i32x4 __attribute__((ext_vector_type(4)));
typedef int i32x8 __attribute__((ext_vector_type(8)));
__device__ __forceinline__ i32x8 frag8(bf16x8 lo, bf16x8 hi) { return __builtin_shufflevector(__builtin_bit_cast(i32x4, lo), __builtin_bit_cast(i32x4, hi), 0, 1, 2, 3, 4, 5, 6, 7); }
template <class Epi, class Sched, bool ALIGN_EPI = false, bool SP2 = false, int ESZ = 2>
__device__ __forceinline__ void gemm_phase(PG8_LAS unsigned char* lds, const Gemm g, const Sched& S, const Epi& E) {
    int tid_ = threadIdx.x; asm volatile("" : "+v"(tid_));
    const int tid = tid_, wid = __builtin_amdgcn_readfirstlane(tid >> 6), lane = tid & 63, wr = wid >> 2, wc = wid & 3, fr = lane & 15, fq = lane >> 4;
    const int K = g.K, nt = K / (BK * 2 / ESZ);
    const __amdgpu_buffer_rsrc_t rsA = __builtin_amdgcn_make_buffer_rsrc((void*)g.A, 0, 0x7fffffff, 0x00020000), rsB = __builtin_amdgcn_make_buffer_rsrc((void*)g.Bt, 0, 0x7fffffff, 0x00020000);
    unsigned voffA[2], voffB[2];
#pragma unroll
    for (int i = 0; i < 2; ++i) { int R, C; stage_rc(tid * 16 + i * 8192, R, C); const int Rb = Epi::PERM ? ((R & ~31) + perm32(R & 31)) : R;
        voffA[i] = (unsigned)(R * K) * (unsigned)ESZ + (unsigned)C * 2u; voffB[i] = (unsigned)(Rb * K) * (unsigned)ESZ + (unsigned)C * 2u; }
    unsigned vc[2][2] = {{0u, 0u}, {0u, 0u}}, vn[2][2] = {{0u, 0u}, {0u, 0u}};
#define PG8_ROWS(dst, un) do { if constexpr (Sched::GATHER) { _Pragma("unroll") for (int _h = 0; _h < 2; ++_h) _Pragma("unroll") for (int _i = 0; _i < 2; ++_i) { int R_, C_; stage_rc(tid * 16 + _i * 8192, R_, C_); \
        dst[_h][_i] = (unsigned)(S.arow(un, _h * HALF + R_) * K) * (unsigned)ESZ + (unsigned)C_ * 2u; } } } while (0)
#define PG8_STAGE_A(bufoff, abase, half, nx) do { if constexpr (Sched::GATHER) { unsigned vo_[2]; vo_[0] = (nx) ? vn[half][0] : vc[half][0]; vo_[1] = (nx) ? vn[half][1] : vc[half][1]; PG8_STAGE_R(bufoff, rsA, g.A, abase, vo_); } \
        else { PG8_STAGE_R(bufoff, rsA, g.A, (abase) + (half) * hstep, voffA); } } while (0)
    const size_t kstep = (size_t)(BK * 2);
    const size_t hstep = (size_t)HALF * K * ESZ;
    const size_t tstep = 2 * hstep;
    const unsigned ldsw = (unsigned)wid * 1024u;
    const int aoff = lds_byte(wr * 64 + fr, fq * 8), boff = lds_byte(wc * 32 + fr, fq * 8);
    const int aoffE = lds_byte(wr * 64 + fr, fq * 16), boffE = lds_byte(wc * 32 + fr, fq * 16);
#define PG8_SA(b, h) (((b) * 2 + (h)) * HTB)
#define PG8_SB(b, h) ((4 + (b) * 2 + (h)) * HTB)
#define PG8_STAGE_R(bufoff, rs, b0, gbase, voff) do { const int so_ = (int)((const char*)(gbase) - (const char*)(b0)); _Pragma("unroll") for (int _i = 0; _i < 2; ++_i) \
        __builtin_amdgcn_raw_ptr_buffer_load_lds(rs, (PG8_LAS void*)(lds + (bufoff) + ldsw + _i * 8192), 16, (int)(voff)[_i], so_, 0, 0); } while (0)
#define PG8_STAGE(bufoff, gbase, voff) PG8_STAGE_R(bufoff, rsB, g.Bt, gbase, voff)
#define PG8_LDA(dst, b, h) do { if constexpr (ESZ == 2) { _Pragma("unroll") for (int m = 0; m < 4; ++m) _Pragma("unroll") for (int k = 0; k < 2; ++k) dst[m][k] = *(const PG8_LAS bf16x8*)(lds + PG8_SA(b, h) + aoff + m * 2048 + k * 1024); } \
        else { _Pragma("unroll") for (int m = 0; m < 4; ++m) { dst##8[m].lo = *(const PG8_LAS i32x4*)(lds + PG8_SA(b, h) + aoffE + m * 2048); dst##8[m].hi = *(const PG8_LAS i32x4*)(lds + PG8_SA(b, h) + aoffE + 16 + m * 2048); } } } while (0)
#define PG8_LDB(dst, b, h) do { if constexpr (ESZ == 2) { _Pragma("unroll") for (int n = 0; n < 2; ++n) _Pragma("unroll") for (int k = 0; k < 2; ++k) dst[n][k] = *(const PG8_LAS bf16x8*)(lds + PG8_SB(b, h) + boff + n * 2048 + k * 1024); } \
        else { _Pragma("unroll") for (int n = 0; n < 2; ++n) { dst##8[n].lo = *(const PG8_LAS i32x4*)(lds + PG8_SB(b, h) + boffE + n * 2048); dst##8[n].hi = *(const PG8_LAS i32x4*)(lds + PG8_SB(b, h) + boffE + 16 + n * 2048); } } } while (0)
#define PG8_MMA(ai, bj, At, Bt) do { __builtin_amdgcn_s_setprio(1); _Pragma("unroll") for (int m = 0; m < 4; ++m) _Pragma("unroll") for (int n = 0; n < 2; ++n) { if constexpr (ESZ == 2) { _Pragma("unroll") for (int k = 0; k < 2; ++k) \
        acc[ai][bj][m][n] = __builtin_amdgcn_mfma_f32_16x16x32_bf16(Bt[n][k], At[m][k], acc[ai][bj][m][n], 0, 0, 0); } else { \
        acc[ai][bj][m][n] = __builtin_amdgcn_mfma_scale_f32_16x16x128_f8f6f4(Bt##8[n], At##8[m], acc[ai][bj][m][n], 0, 0, 0, Epi::WSCALE, 0, 0x7f7f7f7f); } } __builtin_amdgcn_s_setprio(0); } while (0)
#define PG8_WAIT_V(n) asm volatile("s_waitcnt vmcnt(" #n ")" ::: "memory")
#define PG8_WAIT_L(n) asm volatile("s_waitcnt lgkmcnt(" #n ")" ::: "memory")
#define PG8_BAR __builtin_amdgcn_s_barrier()
#define PG8_SCHED __builtin_amdgcn_sched_barrier(0)
    Unit cur, nxt; int ui = 0;
    if (!S.next(0, cur)) return;
    f32x4 acc[2][2][4][2];
#pragma unroll
    for (int a = 0; a < 2; ++a)
#pragma unroll
        for (int b = 0; b < 2; ++b)
#pragma unroll
            for (int m = 0; m < 4; ++m)
#pragma unroll
                for (int n = 0; n < 2; ++n) acc[a][b][m][n] = (f32x4){0.f, 0.f, 0.f, 0.f};
    bf16x8 At[4][2], B0[2][2], B1[2][2];
    i32x8 At8[4], B08[2], B18[2];
    const char* cA = (const char*)g.A + (Sched::GATHER ? (size_t)0 : (size_t)cur.pm * tstep); const char* cB = (const char*)g.Bt + (size_t)cur.pn * tstep;
    PG8_ROWS(vc, cur);
    S.a_ready(cur);
    if constexpr (SP2) {
        PG8_STAGE(PG8_SB(0, 0), cB, voffB); PG8_STAGE(PG8_SB(0, 1), cB + hstep, voffB); PG8_STAGE_A(PG8_SA(0, 0), cA, 0, false); PG8_STAGE_A(PG8_SA(0, 1), cA, 1, false);
        if (wr == 1) PG8_BAR;
        PG8_WAIT_V(2); PG8_BAR;
        PG8_STAGE(PG8_SB(1, 0), cB + kstep, voffB); PG8_STAGE_A(PG8_SA(1, 0), cA + kstep, 0, false); PG8_STAGE(PG8_SB(1, 1), cB + hstep + kstep, voffB);
        PG8_WAIT_V(6); PG8_BAR;
    } else {
        PG8_STAGE(PG8_SB(0, 0), cB, voffB); PG8_STAGE_A(PG8_SA(0, 0), cA, 0, false); PG8_STAGE(PG8_SB(0, 1), cB + hstep, voffB); PG8_STAGE_A(PG8_SA(0, 1), cA, 1, false);
        if (wr == 1) PG8_BAR;
        PG8_WAIT_V(4); PG8_BAR;
        PG8_STAGE(PG8_SB(1, 0), cB + kstep, voffB); PG8_STAGE_A(PG8_SA(1, 0), cA + kstep, 0, false); PG8_STAGE(PG8_SB(1, 1), cB + hstep + kstep, voffB);
        PG8_WAIT_V(6); PG8_BAR;
    }
    for (;;) {
        const bool has_next = S.next(ui + 1, nxt);
        if (has_next) PG8_ROWS(vn, nxt);
        const char* nA = (has_next && !Sched::GATHER) ? (const char*)g.A + (size_t)nxt.pm * tstep : cA; const char* nB = has_next ? (const char*)g.Bt + (size_t)nxt.pn * tstep : cB;
        for (int t = 0; t < nt; t += 2) {
            const bool last = (t == nt - 2);
            const char* a1 = cA + (size_t)(t + 1) * kstep;
            const char* a2 = last ? nA : cA + (size_t)(t + 2) * kstep; const char* b2 = last ? nB : cB + (size_t)(t + 2) * kstep;
            const char* a3 = a2 + kstep; const char* b3 = b2 + kstep;
            if (last && has_next) S.a_ready(nxt);
            if constexpr (Epi::MIDK > 0) { if (t == Epi::MIDK || t == 2 * Epi::MIDK) E.mid(acc, cur, t / Epi::MIDK, wr, wc, fr, fq); }
            if constexpr (SP2) {
            PG8_LDB(B0, 0, 0); PG8_LDB(B1, 0, 1); PG8_SCHED; PG8_LDA(At, 0, 0); PG8_STAGE_A(PG8_SA(1, 1), a1, 1, false);
            PG8_WAIT_V(8); PG8_WAIT_L(0); PG8_BAR; PG8_MMA(0, 0, At, B0); PG8_MMA(0, 1, At, B1); PG8_BAR; PG8_SCHED;
            PG8_LDA(At, 0, 1); PG8_STAGE(PG8_SB(0, 0), b2, voffB); PG8_STAGE(PG8_SB(0, 1), b2 + hstep, voffB); PG8_STAGE_A(PG8_SA(0, 0), a2, 0, last);
            PG8_WAIT_V(8); PG8_WAIT_L(0); PG8_BAR; PG8_MMA(1, 0, At, B0); PG8_MMA(1, 1, At, B1); PG8_BAR; PG8_SCHED;
            PG8_LDB(B0, 1, 0); PG8_LDB(B1, 1, 1); PG8_SCHED; PG8_LDA(At, 1, 0); PG8_STAGE_A(PG8_SA(0, 1), a2, 1, last);
            PG8_WAIT_V(8); PG8_WAIT_L(0); PG8_BAR; PG8_MMA(0, 0, At, B0); PG8_MMA(0, 1, At, B1); PG8_BAR; PG8_SCHED;
            PG8_LDA(At, 1, 1); PG8_STAGE(PG8_SB(1, 0), b3, voffB); PG8_STAGE(PG8_SB(1, 1), b3 + hstep, voffB); PG8_STAGE_A(PG8_SA(1, 0), a3, 0, last);
            PG8_WAIT_V(8); PG8_WAIT_L(0); PG8_BAR; PG8_MMA(1, 0, At, B0); PG8_MMA(1, 1, At, B1); PG8_BAR; PG8_SCHED;
            } else {
            PG8_LDB(B0, 0, 0); PG8_SCHED; PG8_LDA(At, 0, 0); PG8_STAGE_A(PG8_SA(1, 1), a1, 1, false);
            PG8_WAIT_L(8); PG8_BAR; PG8_WAIT_L(0); PG8_MMA(0, 0, At, B0); PG8_BAR; PG8_SCHED;
            PG8_LDB(B1, 0, 1); PG8_STAGE(PG8_SB(0, 0), b2, voffB);
            PG8_BAR; PG8_WAIT_L(0); PG8_MMA(0, 1, At, B1); PG8_BAR;
            PG8_LDA(At, 0, 1); PG8_STAGE_A(PG8_SA(0, 0), a2, 0, last);
            PG8_BAR; PG8_WAIT_L(0); PG8_MMA(1, 0, At, B0); PG8_BAR; PG8_SCHED;
            PG8_STAGE(PG8_SB(0, 1), b2 + hstep, voffB);
            PG8_WAIT_V(6); PG8_BAR; PG8_MMA(1, 1, At, B1); PG8_BAR;
            PG8_LDB(B0, 1, 0); PG8_SCHED; PG8_LDA(At, 1, 0); PG8_STAGE_A(PG8_SA(0, 1), a2, 1, last);
            PG8_WAIT_L(8); PG8_BAR; PG8_WAIT_L(0); PG8_MMA(0, 0, At, B0); PG8_BAR; PG8_SCHED;
            PG8_LDB(B1, 1, 1); PG8_STAGE(PG8_SB(1, 0), b3, voffB);
            PG8_BAR; PG8_WAIT_L(0); PG8_MMA(0, 1, At, B1); PG8_BAR;
            PG8_LDA(At, 1, 1); PG8_STAGE_A(PG8_SA(1, 0), a3, 0, last);
            PG8_BAR; PG8_WAIT_L(0); PG8_MMA(1, 0, At, B0); PG8_BAR; PG8_SCHED;
            PG8_STAGE(PG8_SB(1, 1), b3 + hstep, voffB);
            PG8_WAIT_V(6); PG8_BAR; PG8_MMA(1, 1, At, B1); PG8_BAR;
            }
        }
        if constexpr (ALIGN_EPI) { if (wr == 0) PG8_BAR; }
        if constexpr (!Epi::AFTER_DRAIN) { E(acc, cur, wr, wc, fr, fq); S.done(cur); }
        if (!has_next) break;
#pragma unroll
        for (int a = 0; a < 2; ++a)
#pragma unroll
            for (int b = 0; b < 2; ++b)
#pragma unroll
                for (int m = 0; m < 4; ++m)
#pragma unroll
                    for (int n = 0; n < 2; ++n) acc[a][b][m][n] = (f32x4){0.f, 0.f, 0.f, 0.f};
        cur = nxt; cA = nA; cB = nB; ++ui;
        if constexpr (Sched::GATHER) { vc[0][0] = vn[0][0]; vc[0][1] = vn[0][1]; vc[1][0] = vn[1][0]; vc[1][1] = vn[1][1]; }
        if constexpr (ALIGN_EPI) { if (wr == 1) PG8_BAR; }
    }
    PG8_WAIT_V(0);
    if constexpr (!ALIGN_EPI) { if (wr == 0) PG8_BAR; }
    PG8_BAR;
    if constexpr (Epi::AFTER_DRAIN) { E.fused(acc, cur, wr, wc, fr, fq, lds, wid, lane); S.done(cur); }
#undef PG8_SA
#undef PG8_SB
#undef PG8_STAGE
#undef PG8_STAGE_R
#undef PG8_STAGE_A
#undef PG8_ROWS
#undef PG8_LDA
#undef PG8_LDB
#undef PG8_MMA
#undef PG8_WAIT_V
#undef PG8_WAIT_L
#undef PG8_BAR
#undef PG8_SCHED
}
}

constexpr int NWAVES = 8;
constexpr int BATCH = 2, SEQ = 8192, T = BATCH * SEQ, D = 2048;
constexpr int RWKV_COLS = 3360, IN_COLS = 12576;
constexpr int NP = 12800;
constexpr int PC_LX = 3584, PC_LY = 4608, PC_Q = 5632, PC_G = 6656;
constexpr int NE = 32, MAXROWS = 65536 + NE * 256;
constexpr int LORA_K = 384;
constexpr float EPS = 1e-6f, GN_EPS = 64e-5f;

constexpr size_t MiB = 1u << 20;
constexpr size_t WS_CTL = 0, CTL_ZERO_BYTES = 1 * MiB;
constexpr size_t WS_WIN = 1 * MiB, WS_WMKV = 51 * MiB, WS_WLORA = 59 * MiB, WS_WBR = 62 * MiB, WS_WO = 74 * MiB, WS_WR = 82 * MiB, WS_LW = 83 * MiB;
constexpr size_t WS_WGU = 84 * MiB, WS_WD = 596 * MiB;
constexpr size_t WS_WIN8 = WS_WIN + 27 * MiB;
constexpr size_t WS_XN8 = 1508 * MiB;
constexpr size_t WS_XN = 852 * MiB;
constexpr size_t WS_P = 916 * MiB;
constexpr size_t WS_LORAOUT = 1316 * MiB;
constexpr size_t WS_SCAN = 1508 * MiB;
constexpr size_t WS_YABC = 1892 * MiB;
constexpr size_t WS_MISC = 1988 * MiB;
constexpr size_t WS_MN = WS_MISC, WS_KMEM = WS_MISC + 2 * MiB, WS_VT = WS_MISC + 3 * MiB, WS_LRUC = WS_MISC + 4 * MiB  , WS_BONUS = WS_MISC + 7 * MiB;
constexpr size_t WS_PICK = WS_MISC + 8 * MiB  , WS_ROWTAB = WS_MISC + 9 * MiB  , WS_SPL = WS_ROWTAB + 512 * 1024  ;
constexpr size_t WS_END = 2000 * MiB;
constexpr size_t WS_MACC = WS_LORAOUT, WS_MERGED = 1444 * MiB, WS_H1 = WS_SCAN, WS_XS = WS_P, WS_OROW = WS_P, WS_HH = 1204 * MiB;
constexpr int CW_BAR = 4096, CW_CNT = 8192, CW_NTILES = 8192 + 64, CW_TILEE = 8192 + 128;

constexpr int LDS_BYTES = 147456;
constexpr int MISC_OFF = 143360;

#define GAS __attribute__((address_space(1)))
#define LAS __attribute__((address_space(3)))
typedef unsigned short bf16;
typedef unsigned v4u __attribute__((ext_vector_type(4)));
typedef unsigned v2u __attribute__((ext_vector_type(2)));
typedef float f32x4 __attribute__((ext_vector_type(4)));
typedef float f32x2 __attribute__((ext_vector_type(2)));
typedef short bf16x8 __attribute__((ext_vector_type(8)));
#define LDS_WAIT() asm volatile("s_waitcnt lgkmcnt(0)" ::: "memory")
#define VM_WAIT() asm volatile("s_waitcnt vmcnt(0)" ::: "memory")
__device__ __forceinline__ unsigned f2bf(float f) { unsigned u = __builtin_bit_cast(unsigned, f); return (u + 0x7fffu + ((u >> 16) & 1u)) >> 16; }
__device__ __forceinline__ unsigned pk2(float lo, float hi) { return f2bf(lo) | (f2bf(hi) << 16); }
__device__ __forceinline__ float bflo(unsigned w) { return __builtin_bit_cast(float, w << 16); }
__device__ __forceinline__ float bfhi(unsigned w) { return __builtin_bit_cast(float, w & 0xffff0000u); }
__device__ __forceinline__ float bf1(bf16 b) { return __builtin_bit_cast(float, (unsigned)b << 16); }
__device__ __forceinline__ float sigm(float x) { return __builtin_amdgcn_rcpf(1.0f + __expf(-x)); }
__device__ __forceinline__ float fast_tanh(float x) { const float e = __expf(2.0f * x); return 1.0f - 2.0f * __builtin_amdgcn_rcpf(e + 1.0f); }
__device__ __forceinline__ float softplusf(float x) { return fmaxf(x, 0.f) + log1pf(__expf(-fabsf(x))); }
__device__ __forceinline__ float wave_sum(float v) {
#pragma unroll
    for (int o = 1; o < 64; o <<= 1) v += __shfl_xor(v, o);
    return v;
}
template <int CTRL> __device__ __forceinline__ float dppf(float x) { return __builtin_bit_cast(float, __builtin_amdgcn_mov_dpp(__builtin_bit_cast(int, x), CTRL, 0xf, 0xf, true)); }
__device__ __forceinline__ float row16_sum(float v) {
    v += dppf<0xB1>(v); v += dppf<0x4E>(v); v += dppf<0x141>(v); v += dppf<0x140>(v); return v;
}
#define XB_TMO      128
#define XB_XCNT(j)  (256  + 64 * (j))
#define XB_XSUB(j)  (1280 + 64 * (j))
#define XB_XGEN(j)  (2304 + 64 * (j))
#define XB_TOP      3328
#define XB_TOPGEN   3392
#define XCD_BAR_WORDS 3456
#define XB_SPIN_CAP (1u << 18)

__device__ __forceinline__ unsigned xb_ld(unsigned* p)              { return __hip_atomic_load(p, __ATOMIC_RELAXED, __HIP_MEMORY_SCOPE_AGENT); }
__device__ __forceinline__ unsigned xb_add(unsigned* p, unsigned v) { return __hip_atomic_fetch_add(p, v, __ATOMIC_RELAXED, __HIP_MEMORY_SCOPE_AGENT); }
__device__ __forceinline__ unsigned xb_xcc_id() { return (unsigned)__builtin_amdgcn_s_getreg((3 << 11) | 20) & 0xFu; }
#define XB_SPIN(cond, bar) do { unsigned _sp = 0; while (cond) { __builtin_amdgcn_s_sleep(1); \
    if ((++_sp & 255u) == 0u) { if (xb_ld(&(bar)[XB_TMO])) break; if (_sp > XB_SPIN_CAP) { atomicAdd(&(bar)[XB_TMO], 1u); break; } } } } while (0)

struct XcdBarrier {
    unsigned* bar; unsigned x;
    volatile LAS unsigned* st;
};

__device__ __forceinline__ XcdBarrier xcd_barrier_post(unsigned* bar, volatile LAS unsigned* st) {
    XcdBarrier b; b.bar = bar; b.x = xb_xcc_id(); b.st = st;
    if (threadIdx.x == 0) (void)xb_add(&bar[XB_XCNT(b.x)], 1u);
    return b;
}
__device__ __forceinline__ void xcd_barrier_complete(unsigned* bar, unsigned x, unsigned& nloc, unsigned& nx) {
    const unsigned G = gridDim.x * gridDim.y * gridDim.z;
    unsigned sum, cnt, mine, sp = 0u;
    for (;;) {
        sum = 0u; cnt = 0u; mine = 0u;
#pragma unroll
        for (unsigned j = 0; j < 16; ++j) { const unsigned c = xb_ld(&bar[XB_XCNT(j)]); sum += c; cnt += (c > 0u) ? 1u : 0u; mine = (j == x) ? c : mine; }
        if (sum == G) break;
        __builtin_amdgcn_s_sleep(1);
        if ((++sp & 255u) == 0u) { if (xb_ld(&bar[XB_TMO])) break; if (sp > XB_SPIN_CAP) { atomicAdd(&bar[XB_TMO], 1u); break; } }
    }
    nloc = mine > 0u ? mine : 1u; nx = cnt > 0u ? cnt : 1u;
}

__device__ __forceinline__ void xcd_barrier(const XcdBarrier& b) {
    asm volatile("s_waitcnt vmcnt(0)" ::: "memory");
    __syncthreads();
    if (threadIdx.x == 0) {
        unsigned* bar = b.bar;
        __builtin_amdgcn_s_waitcnt(0);
        unsigned nloc = b.st[0], nx = b.st[1];
        if (nloc == 0u) { xcd_barrier_complete(bar, b.x, nloc, nx); b.st[0] = nloc; b.st[1] = nx; }
        const unsigned old = xb_add(&bar[XB_XSUB(b.x)], 1u);
        const unsigned gen = old / nloc;
        if (old + 1u == (gen + 1u) * nloc) {
            __builtin_amdgcn_fence(__ATOMIC_RELEASE, "agent");
            asm volatile("s_waitcnt vmcnt(0)" ::: "memory");
            const unsigned og = xb_add(&bar[XB_TOP], 1u);
            const unsigned tg = og / nx;
            if (og + 1u == (tg + 1u) * nx) xb_add(&bar[XB_TOPGEN], 1u);
            else XB_SPIN(xb_ld(&bar[XB_TOPGEN]) == tg, bar);
            __builtin_amdgcn_fence(__ATOMIC_ACQUIRE, "agent");
            xb_add(&bar[XB_XGEN(b.x)], 1u);
            asm volatile("s_waitcnt vmcnt(0)" ::: "memory");
        } else {
            XB_SPIN(xb_ld(&bar[XB_XGEN(b.x)]) == gen, bar);
            __builtin_amdgcn_fence(__ATOMIC_ACQUIRE, "agent");
            asm volatile("s_waitcnt vmcnt(0)" ::: "memory");
        }
    }
    __syncthreads();
}

struct Frame {
    LAS unsigned char* lds;
    volatile LAS unsigned* MISC;
    int tid, lane, wave, vcu, G;
};
struct Args { const float* in[39]; float* out; unsigned char* ws; int ph_lo, ph_hi; };
enum { I_X = 0, I_MEM, I_GMIX, I_WIN, I_MU, I_W0, I_W2, I_A0, I_A2, I_G2, I_KK, I_KA, I_RK, I_LNW, I_LNB, I_WRO, I_CONVW, I_CONVB, I_LWR, I_LBR, I_LWI, I_LBI, I_LAM, I_WLO,
       I_GMEM, I_WMK, I_WMV, I_WXO, I_WOUT, I_GFFN, I_WROUTER, I_BROUTER, I_WGATE, I_BGATE, I_WUP, I_BUP, I_WDOWN, I_BDOWN, I_GFINAL };


__device__ __forceinline__ const float* inp(int k) {
    typedef const volatile unsigned long long __attribute__((address_space(4))) ka_t;
    ka_t* ka = (ka_t*)__builtin_amdgcn_kernarg_segment_ptr();
    return (const float*)ka[k];
}
template <int NB> __device__ __forceinline__ void transpose_item(const float* W, int N, int k0, int n0, bf16* WT, int Kd, int drow0, int lane, int kdo = 0) {
    constexpr int LPR = NB / 4, G = 64 / LPR, KR = 64 / G;
    const int g = lane / LPR, c = lane % LPR;
    const GAS float* src = (const GAS float*)W + (size_t)(k0 + KR * g) * N + n0 + 4 * c;
    f32x4 ld[KR];
#pragma unroll
    for (int i = 0; i < KR; ++i) ld[i] = __builtin_nontemporal_load((const GAS f32x4*)(src + (size_t)i * N));
    GAS bf16* dst = (GAS bf16*)WT + (size_t)(drow0 + 4 * c) * Kd + kdo + k0 + KR * g;
#pragma unroll
    for (int j = 0; j < 4; ++j)
#pragma unroll
        for (int q = 0; q < KR / 8; ++q) { v4u o; o.x = pk2(ld[8 * q + 0][j], ld[8 * q + 1][j]); o.y = pk2(ld[8 * q + 2][j], ld[8 * q + 3][j]); o.z = pk2(ld[8 * q + 4][j], ld[8 * q + 5][j]); o.w = pk2(ld[8 * q + 6][j], ld[8 * q + 7][j]);
            *(GAS v4u*)(dst + (size_t)j * Kd + 8 * q) = o; }
}
__device__ __forceinline__ unsigned pk4_fp8(float a, float b, float c, float d) { int w = __builtin_amdgcn_cvt_pk_fp8_f32(a, b, 0, false); w = __builtin_amdgcn_cvt_pk_fp8_f32(c, d, w, true); return (unsigned)w; }
__device__ __forceinline__ void transpose_item_fp8(const float* W, int N, int k0, int n0, unsigned char* WT, int Kd, int drow0, int lane, float scale) {
    const int g = lane >> 4, c = lane & 15;
    const GAS float* src = (const GAS float*)W + (size_t)(k0 + 16 * g) * N + n0 + 4 * c;
    f32x4 ld[16];
#pragma unroll
    for (int i = 0; i < 16; ++i) ld[i] = __builtin_nontemporal_load((const GAS f32x4*)(src + (size_t)i * N)) * scale;
    GAS unsigned char* dst = (GAS unsigned char*)WT + (size_t)(drow0 + 4 * c) * Kd + k0 + 16 * g;
#pragma unroll
    for (int j = 0; j < 4; ++j) { v4u o; o.x = pk4_fp8(ld[0][j], ld[1][j], ld[2][j], ld[3][j]); o.y = pk4_fp8(ld[4][j], ld[5][j], ld[6][j], ld[7][j]); o.z = pk4_fp8(ld[8][j], ld[9][j], ld[10][j], ld[11][j]); o.w = pk4_fp8(ld[12][j], ld[13][j], ld[14][j], ld[15][j]);
        *(GAS v4u*)(dst + (size_t)j * Kd) = o; }
}
__device__ __forceinline__ void transpose_item_fp8_32(const float* W, int N, int k0, int n0, unsigned char* WT, int Kd, int drow0, int lane, float scale) {
    const int g = lane >> 3, c = lane & 7;
    const GAS float* src = (const GAS float*)W + (size_t)(k0 + 8 * g) * N + n0 + 4 * c;
    f32x4 ld[8];
#pragma unroll
    for (int i = 0; i < 8; ++i) ld[i] = __builtin_nontemporal_load((const GAS f32x4*)(src + (size_t)i * N)) * scale;
    GAS unsigned char* dst = (GAS unsigned char*)WT + (size_t)(drow0 + 4 * c) * Kd + k0 + 8 * g;
#pragma unroll
    for (int j = 0; j < 4; ++j) { v2u o; o.x = pk4_fp8(ld[0][j], ld[1][j], ld[2][j], ld[3][j]); o.y = pk4_fp8(ld[4][j], ld[5][j], ld[6][j], ld[7][j]); *(GAS v2u*)(dst + (size_t)j * Kd) = o; }
}
__device__ __forceinline__ void rms_row_to_bf16(const float* xrow, const float* gain, bf16* orow, int lane, unsigned char* orow8 = nullptr) {
    const GAS f32x4* xr = (const GAS f32x4*)xrow + lane; const GAS f32x4* gr = (const GAS f32x4*)gain + lane;
    f32x4 v[8]; float s = 0.f;
#pragma unroll
    for (int j = 0; j < 8; ++j) { v[j] = xr[64 * j]; s += (v[j].x * v[j].x + v[j].y * v[j].y) + (v[j].z * v[j].z + v[j].w * v[j].w); }
    const float rstd = 1.0f / sqrtf(wave_sum(s) * (1.f / D) + EPS);
    GAS v2u* o8 = (GAS v2u*)orow + lane;
#pragma unroll
    for (int j = 0; j < 8; ++j) { const f32x4 g = gr[64 * j]; v2u w; w.x = pk2(v[j].x * rstd * g.x, v[j].y * rstd * g.y); w.y = pk2(v[j].z * rstd * g.z, v[j].w * rstd * g.w); o8[64 * j] = w;
        if (orow8) ((GAS unsigned*)orow8)[lane + 64 * j] = pk4_fp8(v[j].x * rstd * g.x, v[j].y * rstd * g.y, v[j].z * rstd * g.z, v[j].w * rstd * g.w); }
}

__device__ __forceinline__ void p0_prologue(const Frame& F, const Args& a) {
    unsigned char* ws = a.ws;
    const int gw = F.vcu * NWAVES + F.wave, NGW = F.G * NWAVES;
    constexpr int I_IN = 32 * (IN_COLS / 32), I_MK = 32 * 32, I_BR = 16 * 64, I_O = 32 * 64;
    constexpr int NITEMS = I_IN + 2 * I_MK + 3 * I_BR + I_O;
    for (int it = gw; it < NITEMS; it += NGW) {
        int r = it;
        if (r < I_IN) { const int nb = IN_COLS / 32, kb = r / nb, n0 = 32 * (r % nb);
            if (n0 >= PC_G - 224) transpose_item_fp8_32(inp(I_WIN), IN_COLS, 64 * kb, n0, ws + WS_WIN8, D, n0 - (PC_G - 224), F.lane, 64.0f);
            else transpose_item<32>(inp(I_WIN), IN_COLS, 64 * kb, n0, (bf16*)(ws + WS_WIN), D, n0 + (n0 >= RWKV_COLS ? 224 : 0), F.lane);
            continue; } r -= I_IN;
        if (r < I_MK) { transpose_item<32>(inp(I_WMK), 1024, 64 * (r / 32), 32 * (r % 32), (bf16*)(ws + WS_WMKV), D, 32 * (r % 32), F.lane); continue; } r -= I_MK;
        if (r < I_MK) { transpose_item<32>(inp(I_WMV), 1024, 64 * (r / 32), 32 * (r % 32), (bf16*)(ws + WS_WMKV), D, 1024 + 32 * (r % 32), F.lane); continue; } r -= I_MK;
        if (r < I_BR) { transpose_item<32>(inp(I_WRO), 2048, 64 * (r / 64), 32 * (r % 64), (bf16*)(ws + WS_WBR), 3072, 32 * (r % 64), F.lane, 0); continue; } r -= I_BR;
        if (r < I_BR) { transpose_item<32>(inp(I_WLO), 2048, 64 * (r / 64), 32 * (r % 64), (bf16*)(ws + WS_WBR), 3072, 32 * (r % 64), F.lane, 1024); continue; } r -= I_BR;
        if (r < I_BR) { transpose_item<32>(inp(I_WXO), 2048, 64 * (r / 64), 32 * (r % 64), (bf16*)(ws + WS_WBR), 3072, 32 * (r % 64), F.lane, 2048); continue; } r -= I_BR;
        transpose_item<32>(inp(I_WOUT), 2048, 64 * (r / 64), 32 * (r % 64), (bf16*)(ws + WS_WO), D, 32 * (r % 64), F.lane);
    }
    for (int m = gw; m < T; m += NGW) rms_row_to_bf16(inp(I_X) + (size_t)m * D, inp(I_GMIX), (bf16*)(ws + WS_XN) + (size_t)m * D, F.lane, ws + WS_XN8 + (size_t)m * D);
    for (int m = gw; m < 512; m += NGW) rms_row_to_bf16(inp(I_MEM) + (size_t)m * D, inp(I_GMEM), (bf16*)(ws + WS_MN) + (size_t)m * D, F.lane);
    const int gt = F.vcu * (NWAVES * 64) + F.tid, NGT = F.G * NWAVES * 64;
    { bf16* wz = (bf16*)(ws + WS_WIN) + (size_t)RWKV_COLS * D; for (int i = gt; i < 224 * D / 2; i += NGT) ((GAS unsigned*)wz)[i] = 0u; }
    { bf16* wl = (bf16*)(ws + WS_WLORA);
      for (int i = gt; i < 3072 * LORA_K; i += NGT) { const int n = i / LORA_K, k = i % LORA_K; float v = 0.f;
          if (n < 1024) { if (k < 64) v = inp(I_W2)[k * 1024 + n]; }
          else if (n < 2048) { if (k >= 64 && k < 128) v = inp(I_A2)[(k - 64) * 1024 + (n - 1024)]; }
          else { if (k >= 128 && k < 288) v = inp(I_G2)[(k - 128) * 1024 + (n - 2048)]; }
          wl[i] = (bf16)f2bf(v); } }
    { const float* lam = inp(I_LAM); float* spl = (float*)(ws + WS_SPL); for (int i = gt; i < 1024; i += NGT) spl[i] = softplusf(-lam[i]); }
    { bf16* wr = (bf16*)(ws + WS_WR);
      for (int i = gt; i < 32 * D; i += NGT) { const int e = i / D, k = i % D; const float w = inp(I_WROUTER)[k * 32 + e]; const unsigned hi = f2bf(w); const float r = w - __builtin_bit_cast(float, hi << 16);
          wr[i] = (bf16)hi; wr[32 * D + i] = (bf16)f2bf(r); } }
    { const float* lwi_p = inp(I_LWI); const float* lwr_p = inp(I_LWR); bf16* lw = (bf16*)(ws + WS_LW);
      for (int i = gt; i < 2 * 16 * 4 * 2 * 64 * 8; i += NGT) { const int j = i & 7, ln = (i >> 3) & 63, ks = (i >> 9) & 1, vbo = (i >> 10) & 3, n = (i >> 12) & 15, mat = i >> 16;
          const int w = 32 * ks + 16 * (j >> 2) + 4 * (ln >> 4) + (j & 3), v = 16 * vbo + (ln & 15);
          lw[i] = (bf16)f2bf((mat ? lwi_p : lwr_p)[(n * 64 + w) * 64 + v]); } }
}

__device__ __forceinline__ void moe_weight_convert(const Frame& F, const Args& a, int gw, int NGW) {
    unsigned char* ws = a.ws;
    const float* wg = inp(I_WGATE); const float* wu = inp(I_WUP); const float* wd = inp(I_WDOWN);
    constexpr int PER = 1024;
    for (int it = gw; it < NE * 3 * PER; it += NGW) {
        const int e = it / (3 * PER), r = it % (3 * PER), which = r / PER, q = r % PER, k0 = 64 * (q / 32), n0 = 64 * (q % 32);
        if (which == 0) transpose_item_fp8(wg + (size_t)e * D * D, D, k0, n0, ws + WS_WGU + (size_t)e * 4096 * D, D, (n0 >> 7) * 256 + (n0 & 127), F.lane, 64.0f);
        else if (which == 1) transpose_item_fp8(wu + (size_t)e * D * D, D, k0, n0, ws + WS_WGU + (size_t)e * 4096 * D, D, (n0 >> 7) * 256 + 128 + (n0 & 127), F.lane, 64.0f);
        else transpose_item_fp8(wd + (size_t)e * D * D, D, k0, n0, ws + WS_WD + (size_t)e * 2048 * D, D, n0, F.lane, 64.0f);
    }
}

__device__ __forceinline__ void r1_lora_in(const Frame& F, const Args& a) {
    const bf16* P = (const bf16*)(a.ws + WS_P); bf16* L = (bf16*)(a.ws + WS_XN);
    const float* mu = inp(I_MU);
    const int gw = F.vcu * NWAVES + F.wave, NGW = F.G * NWAVES;
    for (int m = gw; m < T; m += NGW) {
        const bool first = (m % SEQ) == 0;
#pragma unroll
        for (int j = 0; j < 6; ++j) { const int k = F.lane + 64 * j; float o = 0.f;
            if (k < 288) { const int c = 3072 + k; const float cur = bf1(P[(size_t)m * NP + c]); const float prev = first ? 0.f : bf1(P[(size_t)(m - 1) * NP + c]);
                const float x = cur + (prev - cur) * mu[c]; o = k < 64 ? fast_tanh(x) : (k < 128 ? x : sigm(x)); }
            L[(size_t)m * LORA_K + k] = (bf16)f2bf(o); }
    }
}

constexpr int REC_F = 2816, REC_AT = 0, REC_RT = 512, REC_BKT = 1024, REC_WC = 2048, REC_N = 2112, REC_Q = 2176, REC_V8 = 2240;
__device__ __forceinline__ float wave_sum_fast(float v) { v = row16_sum(v); v += __shfl_xor(v, 16); v += __shfl_xor(v, 32); return v; }
__device__ __forceinline__ void r3_blocks(const Frame& F, const Args& a) {
    const GAS bf16* P = (const GAS bf16*)(a.ws + WS_P); const GAS float* LO = (const GAS float*)(a.ws + WS_LORAOUT);
    GAS float* REC = (GAS float*)(a.ws + WS_SCAN); GAS float* BON = (GAS float*)(a.ws + WS_BONUS);
    const GAS float* mu = (const GAS float*)inp(I_MU); const GAS float* w0 = (const GAS float*)inp(I_W0); const GAS float* a0 = (const GAS float*)inp(I_A0);
    const GAS float* kkp = (const GAS float*)inp(I_KK); const GAS float* kap = (const GAS float*)inp(I_KA); const GAS float* rkp = (const GAS float*)inp(I_RK);
    LAS float* G1 = (LAS float*)(F.lds + F.wave * 16384);
    LAS float* G2 = G1 + 2048;
    const int gw = F.vcu * NWAVES + F.wave, NGW = F.G * NWAVES, lane = F.lane;
#pragma unroll 1
    for (int it = gw; it < 32 * 1024; it += NGW) {
        const int bh = it >> 10, blk = it & 1023, b = bh >> 4, h = bh & 15, c = h * 64 + lane, m0 = b * SEQ + blk * 8;
        const float mur = mu[c], muk = mu[1024 + c], muv = mu[2048 + c], w0c = w0[c], a0c = a0[c], kkw = kkp[c], kaw = kap[c], rkw = rkp[c];
        float w[8], av[8], bv[8], kv[8], rv[8], vv[8], ag[8], kk[8], n2[8], bo[8];
        float pr = 0.f, pk = 0.f, pv = 0.f;
        if (blk > 0) { const GAS bf16* pp = P + (size_t)(m0 - 1) * NP; pr = bf1(pp[c]); pk = bf1(pp[1024 + c]); pv = bf1(pp[2048 + c]); }
#pragma unroll
        for (int t = 0; t < 8; ++t) { const GAS bf16* pc = P + (size_t)(m0 + t) * NP; const float cr = bf1(pc[c]), ck = bf1(pc[1024 + c]), cv = bf1(pc[2048 + c]);
            const float r = cr + (pr - cr) * mur, k = ck + (pk - ck) * muk, v = cv + (pv - cv) * muv; pr = cr; pk = ck; pv = cv;
            const float wpre = w0c + LO[(size_t)(m0 + t) * 3072 + c], apre = a0c + LO[(size_t)(m0 + t) * 3072 + 1024 + c];
            w[t] = __expf(-0.6065306597126334f * __builtin_amdgcn_rcpf(1.0f + __expf(-wpre)));
            ag[t] = __builtin_amdgcn_rcpf(1.0f + __expf(-apre));
            kk[t] = k * kkw; n2[t] = kk[t] * kk[t];
            kv[t] = k * (1.0f + (ag[t] - 1.0f) * kaw); rv[t] = r; vv[t] = v; bo[t] = r * kv[t] * rkw; }
#pragma unroll
        for (int t = 0; t < 8; ++t) { n2[t] = wave_sum_fast(n2[t]); bo[t] = wave_sum_fast(bo[t]); }
#pragma unroll
        for (int t = 0; t < 8; ++t) { const float kkn = kk[t] * (1.0f / sqrtf(fmaxf(n2[t], 1e-24f))); av[t] = -kkn; bv[t] = kkn * ag[t]; if (lane == 0) BON[(m0 + t) * 16 + h] = bo[t]; }
        float Pp[8]; Pp[0] = w[0];
#pragma unroll
        for (int t = 1; t < 8; ++t) Pp[t] = Pp[t - 1] * w[t];
        float bch[8], kch[8], ah[8], rh[8];
#pragma unroll
        for (int t = 0; t < 8; ++t) { const float pin = __builtin_amdgcn_rcpf(Pp[t]); bch[t] = bv[t] * pin; kch[t] = kv[t] * pin; ah[t] = av[t] * (t > 0 ? Pp[t - 1] : 1.0f); rh[t] = rv[t] * Pp[t]; }
        const int pos = (lane & 3) * 16 + (lane >> 2);
#pragma unroll
        for (int t = 0; t < 8; ++t) { G1[t * 64 + pos] = bch[t]; G1[(8 + t) * 64 + pos] = kch[t]; G1[(16 + t) * 64 + pos] = ah[t]; G1[(24 + t) * 64 + pos] = rh[t]; }
        LDS_WAIT(); asm volatile("" ::: "memory");
        f32x4 fa[4], fb[4];
#pragma unroll
        for (int q = 0; q < 4; ++q) { fa[q] = *(const LAS f32x4*)(G1 + (lane & 15) * 64 + (lane >> 4) * 16 + 4 * q); fb[q] = *(const LAS f32x4*)(G1 + (16 + (lane & 15)) * 64 + (lane >> 4) * 16 + 4 * q); }
        f32x4 dacc = {0.f, 0.f, 0.f, 0.f};
#pragma unroll
        for (int s2 = 0; s2 < 16; ++s2) dacc = __builtin_amdgcn_mfma_f32_16x16x4f32(fa[s2 >> 2][s2 & 3], fb[s2 >> 2][s2 & 3], dacc, 0, 0, 0);
        *(LAS f32x4*)(G2 + (lane & 15) * 16 + 4 * (lane >> 4)) = dacc;
        LDS_WAIT(); asm volatile("" ::: "memory");
        float M[8][8];
        { float Lm[8][8];
#pragma unroll
          for (int t = 1; t < 8; ++t) { const f32x4 l0 = *(const LAS f32x4*)(G2 + t * 16), l1 = *(const LAS f32x4*)(G2 + t * 16 + 4);
#pragma unroll
              for (int i = 0; i < 4; ++i) { Lm[t][i] = l0[i]; Lm[t][4 + i] = l1[i]; } }
#pragma unroll
          for (int t = 0; t < 8; ++t) { M[t][t] = 1.0f;
#pragma unroll
              for (int i = t - 1; i >= 0; --i) { float acc = 0.f;
#pragma unroll
                  for (int j = i; j < t; ++j) acc += Lm[t][j] * M[j][i];
                  M[t][i] = acc; } } }
        GAS float* rec = REC + ((size_t)bh * 1024 + blk) * REC_F; GAS bf16* recb = (GAS bf16*)rec;
#pragma unroll
        for (int t = 0; t < 8; ++t) { float acc = 0.f;
#pragma unroll
            for (int i = 0; i <= t; ++i) acc += M[t][i] * ah[i];
            { const unsigned hi = f2bf(acc); recb[t * 64 + lane] = (bf16)hi; recb[1024 + t * 64 + lane] = (bf16)f2bf(acc - __builtin_bit_cast(float, hi << 16)); } }
        float Nm[8][8];
        { float Km[8][8];
#pragma unroll
          for (int t = 1; t < 8; ++t) { const f32x4 l0 = *(const LAS f32x4*)(G2 + t * 16 + 8), l1 = *(const LAS f32x4*)(G2 + t * 16 + 12);
#pragma unroll
              for (int i = 0; i < 4; ++i) { Km[t][i] = l0[i]; Km[t][4 + i] = l1[i]; } }
#pragma unroll
          for (int t = 0; t < 8; ++t)
#pragma unroll
              for (int i = 0; i < 8; ++i) { float acc = 0.f;
                  if (i < t) {
#pragma unroll
                      for (int j = i + 1; j <= t; ++j) acc += M[t][j] * Km[j][i]; }
                  Nm[t][i] = acc; } }
        float rb[8][8];
#pragma unroll
        for (int t = 0; t < 8; ++t) { const f32x4 l0 = *(const LAS f32x4*)(G2 + (8 + t) * 16), l1 = *(const LAS f32x4*)(G2 + (8 + t) * 16 + 4);
#pragma unroll
            for (int i = 0; i < 4; ++i) { rb[t][i] = l0[i]; rb[t][4 + i] = l1[i]; } }
#pragma unroll
        for (int t = 0; t < 8; ++t) { float acc = rh[t];
#pragma unroll
            for (int i = 0; i <= t; ++i) { float rm = 0.f;
#pragma unroll
                for (int j = i; j <= t; ++j) rm += rb[t][j] * M[j][i];
                acc += rm * ah[i]; }
            { const unsigned hi = f2bf(acc); recb[(8 + t) * 64 + lane] = (bf16)hi; recb[1024 + (8 + t) * 64 + lane] = (bf16)f2bf(acc - __builtin_bit_cast(float, hi << 16)); } }
        float Qm[8][8];
#pragma unroll
        for (int t = 0; t < 8; ++t) { const f32x4 l0 = *(const LAS f32x4*)(G2 + (8 + t) * 16 + 8), l1 = *(const LAS f32x4*)(G2 + (8 + t) * 16 + 12);
#pragma unroll
            for (int i = 0; i < 8; ++i) { float acc = 0.f;
                if (i <= t) { acc = i < 4 ? l0[i & 3] : l1[i & 3];
#pragma unroll
                    for (int j = i + 1; j <= t; ++j) acc += rb[t][j] * Nm[j][i]; }
                Qm[t][i] = acc; } }
        { unsigned hw[8], lw[8];
#pragma unroll
          for (int i2 = 0; i2 < 8; ++i2) { const float x0 = (i2 < 4 ? bch[2 * i2] : kch[2 * i2 - 8]) * Pp[7], x1 = (i2 < 4 ? bch[2 * i2 + 1] : kch[2 * i2 - 7]) * Pp[7];
              const unsigned h0 = f2bf(x0), h1 = f2bf(x1); hw[i2] = h0 | (h1 << 16); lw[i2] = f2bf(x0 - __builtin_bit_cast(float, h0 << 16)) | (f2bf(x1 - __builtin_bit_cast(float, h1 << 16)) << 16); }
          GAS v4u* bk_ = (GAS v4u*)(recb + 2048 + lane * 32);
#pragma unroll
          for (int q4 = 0; q4 < 4; ++q4) bk_[q4] = (v4u){hw[2 * q4], hw[2 * q4 + 1], lw[2 * q4], lw[2 * q4 + 1]}; }
        rec[REC_WC + lane] = Pp[7];
        if (lane == 0) {
#pragma unroll
            for (int t = 0; t < 8; ++t) { *(GAS f32x4*)(rec + REC_N + t * 8) = (f32x4){Nm[t][0], Nm[t][1], Nm[t][2], Nm[t][3]}; *(GAS f32x4*)(rec + REC_N + t * 8 + 4) = (f32x4){Nm[t][4], Nm[t][5], Nm[t][6], Nm[t][7]};
                *(GAS f32x4*)(rec + REC_Q + t * 8) = (f32x4){Qm[t][0], Qm[t][1], Qm[t][2], Qm[t][3]}; *(GAS f32x4*)(rec + REC_Q + t * 8 + 4) = (f32x4){Qm[t][4], Qm[t][5], Qm[t][6], Qm[t][7]}; } }
        *(GAS f32x4*)(rec + REC_V8 + lane * 8) = (f32x4){vv[0], vv[1], vv[2], vv[3]}; *(GAS f32x4*)(rec + REC_V8 + lane * 8 + 4) = (f32x4){vv[4], vv[5], vv[6], vv[7]};
        LDS_WAIT(); asm volatile("" ::: "memory");
    }
}

constexpr int SC_NS = 12, SC_RB = REC_F * 4, SC_SYNC = SC_NS * SC_RB;
__device__ __forceinline__ unsigned lds_word(const volatile LAS unsigned* p) { return (unsigned)__builtin_amdgcn_readfirstlane((int)*p); }
__device__ __forceinline__ bool scan_wg(int& bh, int& quarter) { const int bx = blockIdx.x; if (gridDim.x != 256 || ((bx >> 3) & 1)) return false; const int slot = bx >> 4; bh = (bx & 7) * 4 + (slot >> 2); quarter = slot & 3; return true; }
__device__ __forceinline__ void r4_feeder(const Frame& F, const Args& a, int bh) {
    const GAS char* gsrc = (const GAS char*)(a.ws + WS_SCAN) + (size_t)bh * 1024 * SC_RB + F.lane * 16;
    LAS unsigned char* ring = F.lds;
    volatile LAS unsigned* sync = (volatile LAS unsigned*)(F.lds + SC_SYNC);
    bool dead = false;
    __builtin_amdgcn_s_setprio(2);
#pragma unroll 1
    for (int B = 0; B < 1024; ++B) {
        if (B >= SC_NS && !dead) { unsigned spins = 0; for (;;) { const unsigned d0 = lds_word(sync + 16); if ((int)d0 > B - SC_NS) break; if (++spins > (1u << 20)) { dead = true; break; } __builtin_amdgcn_s_sleep(2); } }
        LAS unsigned char* slot = ring + (B % SC_NS) * SC_RB;
#pragma unroll
        for (int q = 0; q < 11; ++q) __builtin_amdgcn_global_load_lds((const GAS unsigned*)(gsrc + (size_t)B * SC_RB + q * 1024), (LAS unsigned*)(slot + q * 1024), 16, 0, 0);
        asm volatile("s_waitcnt vmcnt(55)" ::: "memory");
        if (B >= 5 && F.lane == 0) sync[0] = (unsigned)(B - 4);
    }
    asm volatile("s_waitcnt vmcnt(0)" ::: "memory");
    if (F.lane == 0) sync[0] = 1024u;
    __builtin_amdgcn_s_setprio(0);
}
template <int VAR> __device__ __forceinline__ void r4_scan(const Frame& F, const Args& a, int bh, int quarter) {
    float* YT = (float*)(a.ws + WS_XN);
    constexpr int RB = SC_RB;
    __builtin_amdgcn_s_setprio(3);
    const int r = F.lane & 15, q = F.lane >> 4, rowg = quarter * 16 + r;
    LAS unsigned char* ring = F.lds;
    volatile LAS unsigned* sync = (volatile LAS unsigned*)(F.lds + SC_SYNC);
    const LAS unsigned char* pVH = ring + (r * 64 + 4 * q) * 2;
    const LAS unsigned char* pNQ = ring + (REC_N + r * 8 + 2 * q) * 4;
    const LAS unsigned char* pVb = ring + (REC_V8 + rowg * 8 + 2 * q) * 4;
    const LAS unsigned char* pV4 = ring + (REC_V8 + rowg * 8 + 4 * (q & 1)) * 4;
    const LAS unsigned char* pBK = ring + 4096 + r * 64 + 16 * q;
    const LAS unsigned char* pWC = ring + (REC_WC + 4 * q) * 4;
    unsigned have = 0; bool dead = (VAR == 1);
#define SC_NEED(n) do { unsigned spins_ = 0; while (have < (unsigned)(n) && !dead) { have = lds_word(sync); if (have >= (unsigned)(n)) break; if (++spins_ > (1u << 20)) { dead = true; break; } __builtin_amdgcn_s_sleep(1); } } while (0)
    f32x4 S[4];
#pragma unroll
    for (int kb = 0; kb < 4; ++kb) S[kb] = (f32x4){0.f, 0.f, 0.f, 0.f};
    GAS float* yrow = (GAS float*)YT + (size_t)(bh * 64 + rowg) * SEQ + 4 * (q & 1);
#define SC_LD(vh_, vl_, nq_, vb_, v4_, bk_, wc_, so_) do { _Pragma("unroll") for (int h_ = 0; h_ < 2; ++h_) { const v2u a_ = *(const LAS v2u*)(pVH + (so_) + 64 * h_), b_ = *(const LAS v2u*)(pVH + (so_) + 64 * h_ + 32); vh_[h_] = (v4u){a_.x, a_.y, b_.x, b_.y}; \
            const v2u c_ = *(const LAS v2u*)(pVH + (so_) + 2048 + 64 * h_), d_ = *(const LAS v2u*)(pVH + (so_) + 2048 + 64 * h_ + 32); vl_[h_] = (v4u){c_.x, c_.y, d_.x, d_.y}; } \
        nq_ = *(const LAS f32x2*)(pNQ + (so_)); vb_ = *(const LAS f32x2*)(pVb + (so_)); v4_ = *(const LAS f32x4*)(pV4 + (so_)); \
        _Pragma("unroll") for (int kb_ = 0; kb_ < 4; ++kb_) { bk_[kb_] = *(const LAS v4u*)(pBK + (so_) + kb_ * 1024); wc_[kb_] = *(const LAS f32x4*)(pWC + (so_) + kb_ * 64); } } while (0)
    v4u vhS[2][2], vlS[2][2], bkS[2][4]; f32x4 wcS[2][4], v4S[2]; f32x2 nqS[2], vbS[2];
    SC_NEED(1); asm volatile("" ::: "memory");
    SC_LD(vhS[0], vlS[0], nqS[0], vbS[0], v4S[0], bkS[0], wcS[0], 0);
#pragma unroll 1
    for (int k0 = 0; k0 < 1024; k0 += SC_NS) {
#pragma unroll
        for (int u = 0; u < SC_NS; ++u) { if (k0 + u >= 1024) break; const int sn = ((u + 1) % SC_NS) * RB; constexpr int dummy_ = 0; (void)dummy_;
            v4u (&vh)[2] = vhS[u & 1]; v4u (&vl)[2] = vlS[u & 1]; v4u (&bk)[4] = bkS[u & 1]; f32x4 (&wc)[4] = wcS[u & 1]; const f32x4 v4 = v4S[u & 1]; const f32x2 nq = nqS[u & 1], vb = vbS[u & 1];
            v4u shi[2], slo[2];
#pragma unroll
            for (int h = 0; h < 2; ++h) {
                unsigned hw_[4], lw_[4];
#pragma unroll
                for (int p = 0; p < 4; ++p) { const f32x4 sv = S[2 * h + (p >> 1)]; const float x0 = sv[2 * (p & 1)], x1 = sv[2 * (p & 1) + 1];
                    hw_[p] = __builtin_amdgcn_perm(__builtin_bit_cast(unsigned, x1), __builtin_bit_cast(unsigned, x0), 0x07060302u);
                    const float l0 = x0 - __builtin_bit_cast(float, __builtin_bit_cast(unsigned, x0) & 0xffff0000u), l1 = x1 - __builtin_bit_cast(float, __builtin_bit_cast(unsigned, x1) & 0xffff0000u);
                    lw_[p] = pg8::cvt_pk_bf16(l0, l1); }
                shi[h] = (v4u){hw_[0], hw_[1], hw_[2], hw_[3]}; slo[h] = (v4u){lw_[0], lw_[1], lw_[2], lw_[3]}; }
            f32x4 a0 = {0.f, 0.f, 0.f, 0.f}, a1 = {0.f, 0.f, 0.f, 0.f}, a2 = {0.f, 0.f, 0.f, 0.f}, ac = {0.f, 0.f, 0.f, 0.f};
#pragma unroll
            for (int h = 0; h < 2; ++h) { a0 = __builtin_amdgcn_mfma_f32_16x16x32_bf16(__builtin_bit_cast(bf16x8, vh[h]), __builtin_bit_cast(bf16x8, shi[h]), a0, 0, 0, 0);
                a1 = __builtin_amdgcn_mfma_f32_16x16x32_bf16(__builtin_bit_cast(bf16x8, vl[h]), __builtin_bit_cast(bf16x8, shi[h]), a1, 0, 0, 0);
                a2 = __builtin_amdgcn_mfma_f32_16x16x32_bf16(__builtin_bit_cast(bf16x8, vh[h]), __builtin_bit_cast(bf16x8, slo[h]), a2, 0, 0, 0); }
            ac = __builtin_amdgcn_mfma_f32_16x16x4f32(nq[0], vb[0], ac, 0, 0, 0); ac = __builtin_amdgcn_mfma_f32_16x16x4f32(nq[1], vb[1], ac, 0, 0, 0);
            SC_NEED(k0 + u + 2 <= 1024 ? k0 + u + 2 : 1024); asm volatile("" ::: "memory");
            SC_LD(vhS[(u + 1) & 1], vlS[(u + 1) & 1], nqS[(u + 1) & 1], vbS[(u + 1) & 1], v4S[(u + 1) & 1], bkS[(u + 1) & 1], wcS[(u + 1) & 1], sn);
            asm volatile("" ::: "memory");
            const f32x4 dd = (a0 + ac) + (a1 + a2);
            if (q >= 2) *(GAS f32x4*)(yrow + (k0 + u) * 8) = dd;
            const f32x4 b2 = q >= 2 ? v4 : dd;
            v4u svh, svl;
            { const unsigned h01 = __builtin_amdgcn_perm(__builtin_bit_cast(unsigned, b2[1]), __builtin_bit_cast(unsigned, b2[0]), 0x07060302u), h23 = __builtin_amdgcn_perm(__builtin_bit_cast(unsigned, b2[3]), __builtin_bit_cast(unsigned, b2[2]), 0x07060302u);
              float l_[4];
#pragma unroll
              for (int i = 0; i < 4; ++i) l_[i] = b2[i] - __builtin_bit_cast(float, __builtin_bit_cast(unsigned, b2[i]) & 0xffff0000u);
              svh = (v4u){h01, h23, h01, h23}; svl = (v4u){pg8::cvt_pk_bf16(l_[0], l_[1]), pg8::cvt_pk_bf16(l_[2], l_[3]), 0u, 0u}; }
            f32x4 n[4];
#pragma unroll
            for (int kb = 0; kb < 4; ++kb) n[kb] = S[kb] * wc[kb];
#pragma unroll
            for (int kb = 0; kb < 4; ++kb) n[kb] = __builtin_amdgcn_mfma_f32_16x16x32_bf16(__builtin_bit_cast(bf16x8, bk[kb]), __builtin_bit_cast(bf16x8, svh), n[kb], 0, 0, 0);
#pragma unroll
            for (int kb = 0; kb < 4; ++kb) n[kb] = __builtin_amdgcn_mfma_f32_16x16x32_bf16(__builtin_bit_cast(bf16x8, bk[kb]), __builtin_bit_cast(bf16x8, svl), n[kb], 0, 0, 0);
#pragma unroll
            for (int kb = 0; kb < 4; ++kb) S[kb] = n[kb];
            asm volatile("" : "+v"(S[0]), "+v"(S[1]), "+v"(S[2]), "+v"(S[3]) :: "memory");
            if (F.lane == 0) sync[16] = (unsigned)(k0 + u + 1);
        }
    }
#undef SC_LD
#undef SC_NEED
    __builtin_amdgcn_s_setprio(0);
}

__device__ __forceinline__ void r5_finish(const Frame& F, const Args& a) {
    const float* YT = (const float*)(a.ws + WS_XN); const float* LO = (const float*)(a.ws + WS_LORAOUT); const bf16* P = (const bf16*)(a.ws + WS_P); const float* BON = (const float*)(a.ws + WS_BONUS);
    bf16* YA = (bf16*)(a.ws + WS_YABC);
    LAS float* scr = (LAS float*)(F.lds + F.wave * 16640);
    const int gw = F.vcu * NWAVES + F.wave, NGW = F.G * NWAVES;
    for (int it = gw; it < 32 * 128; it += NGW) {
        const int bh = it >> 7, tt = it & 127, t0 = tt * 64, b = bh >> 4, h = bh & 15;
        float y[64]; float s = 0.f;
#pragma unroll
        for (int v = 0; v < 64; ++v) { y[v] = YT[(size_t)(bh * 64 + v) * SEQ + t0 + F.lane]; s += y[v]; }
        const float mean = s * (1.f / 64.f); float q = 0.f;
#pragma unroll
        for (int v = 0; v < 64; ++v) { const float d = y[v] - mean; q += d * d; }
        const float rstd = 1.0f / sqrtf(q * (1.f / 64.f) + GN_EPS);
#pragma unroll
        for (int v = 0; v < 64; ++v) scr[F.lane * 65 + v] = (y[v] - mean) * rstd;
        LDS_WAIT(); asm volatile("" ::: "memory");
        { const int ts = F.lane >> 4, cq = F.lane & 15, c = h * 64 + 4 * cq;
          const f32x4 lw = *(const GAS f32x4*)((const GAS float*)inp(I_LNW) + c), lb = *(const GAS f32x4*)((const GAS float*)inp(I_LNB) + c), muv = *(const GAS f32x4*)((const GAS float*)inp(I_MU) + 2048 + c);
#pragma unroll 4
          for (int tg = 0; tg < 16; ++tg) { const int ti = 4 * tg + ts, m = b * SEQ + t0 + ti;
              f32x4 yn; yn[0] = scr[ti * 65 + 4 * cq]; yn[1] = scr[ti * 65 + 4 * cq + 1]; yn[2] = scr[ti * 65 + 4 * cq + 2]; yn[3] = scr[ti * 65 + 4 * cq + 3];
              const v2u cw = *(const GAS v2u*)((const GAS bf16*)P + (size_t)m * NP + 2048 + c); v2u pw = cw; if (m % SEQ != 0) pw = *(const GAS v2u*)((const GAS bf16*)P + (size_t)(m - 1) * NP + 2048 + c);
              const f32x4 cv = {bflo(cw.x), bfhi(cw.x), bflo(cw.y), bfhi(cw.y)}; f32x4 pv = {bflo(pw.x), bfhi(pw.x), bflo(pw.y), bfhi(pw.y)}; if (m % SEQ == 0) pv = (f32x4){0.f, 0.f, 0.f, 0.f};
              const f32x4 vsh = cv + (pv - cv) * muv;
              const f32x4 g = *(const GAS f32x4*)((const GAS float*)LO + (size_t)m * 3072 + 2048 + c); const float bon = BON[m * 16 + h];
              const f32x4 o = (yn * lw + lb + vsh * bon) * g;
              v2u w; w.x = pk2(o[0], o[1]); w.y = pk2(o[2], o[3]); *(GAS v2u*)((GAS bf16*)YA + (size_t)m * 3072 + c) = w; } }
        LDS_WAIT(); asm volatile("" ::: "memory");
    }
}

__device__ __forceinline__ float gelu_tanh(float x) { const float u = 0.7978845608028654f * (x + 0.044715f * x * x * x); return 0.5f * x * (1.0f + fast_tanh(u)); }
template <int CTRL> __device__ __forceinline__ float dpp_keep(float old, float x) { return __builtin_bit_cast(float, __builtin_amdgcn_update_dpp(__builtin_bit_cast(int, old), __builtin_bit_cast(int, x), CTRL, 0xf, 0xf, false)); }
template <bool FINAL> __device__ __forceinline__ void lru_pass(const Frame& F, const Args& a, int gw, int NGW) {
    const bf16* P = (const bf16*)(a.ws + WS_P); const bf16* LW = (const bf16*)(a.ws + WS_LW);
    float* CA = (float*)(a.ws + WS_LRUC); float* CB = CA + 256 * 1024; const float* HIN = CB + 256 * 1024;
    bf16* YB = (bf16*)(a.ws + WS_YABC) + 1024;
    const GAS float* lbr_p = (const GAS float*)inp(I_LBR); const GAS float* lbi_p = (const GAS float*)inp(I_LBI); const GAS float* spl_p = (const GAS float*)(a.ws + WS_SPL);
    const GAS float* cvb_p = (const GAS float*)inp(I_CONVB); const GAS float* cvw_p = (const GAS float*)inp(I_CONVW);
    const int tq = F.lane & 15, kq = F.lane >> 4;
    for (int it = gw; it < 256 * 16; it += NGW) {
        const int tt = it >> 4, n = it & 15, m0 = tt * 64, cb = n * 64 + 4 * kq;
        const bool seq0 = (m0 % SEQ) == 0;
        float hcar[4][4];
        float aprod[4][4];
#pragma unroll
        for (int vb = 0; vb < 4; ++vb)
#pragma unroll
            for (int i = 0; i < 4; ++i) { hcar[vb][i] = FINAL ? HIN[tt * 1024 + cb + 16 * vb + i] : 0.f; aprod[vb][i] = 1.f; }
#pragma unroll 1
        for (int tb = 0; tb < 4; ++tb) {
            asm volatile("" ::: "memory");
            const int m = m0 + 16 * tb + tq, tseq = m % SEQ;
            f32x4 xc[4];
#pragma unroll
            for (int vb = 0; vb < 4; ++vb) { const int c = cb + 16 * vb; f32x4 acc = *(const GAS f32x4*)(cvb_p + c);
#pragma unroll
                for (int j = 0; j < 4; ++j) { if (tseq - j >= 0) { const v2u pw = *(const GAS v2u*)((const GAS bf16*)P + (size_t)(m - j) * NP + PC_LX + c); const f32x4 cw = *(const GAS f32x4*)(cvw_p + j * 1024 + c);
                        acc[0] += cw[0] * bflo(pw.x); acc[1] += cw[1] * bfhi(pw.x); acc[2] += cw[2] * bflo(pw.y); acc[3] += cw[3] * bfhi(pw.y); } }
                xc[vb] = acc; }
            bf16x8 bfrag[2];
#pragma unroll
            for (int ks = 0; ks < 2; ++ks) { v4u w; w.x = pk2(xc[2 * ks][0], xc[2 * ks][1]); w.y = pk2(xc[2 * ks][2], xc[2 * ks][3]); w.z = pk2(xc[2 * ks + 1][0], xc[2 * ks + 1][1]); w.w = pk2(xc[2 * ks + 1][2], xc[2 * ks + 1][3]); bfrag[ks] = __builtin_bit_cast(bf16x8, w); }
#pragma unroll
            for (int vb = 0; vb < 4; ++vb) {
                f32x4 gr = {0.f, 0.f, 0.f, 0.f}, gi = {0.f, 0.f, 0.f, 0.f};
#pragma unroll
                for (int ks = 0; ks < 2; ++ks) { const bf16x8 wr_ = *(const bf16x8*)(LW + ((((size_t)(0 * 16 + n) * 4 + vb) * 2 + ks) * 64 + F.lane) * 8); const bf16x8 wi_ = *(const bf16x8*)(LW + ((((size_t)(1 * 16 + n) * 4 + vb) * 2 + ks) * 64 + F.lane) * 8);
                    gr = __builtin_amdgcn_mfma_f32_16x16x32_bf16(wr_, bfrag[ks], gr, 0, 0, 0); gi = __builtin_amdgcn_mfma_f32_16x16x32_bf16(wi_, bfrag[ks], gi, 0, 0, 0); }
                const int c = cb + 16 * vb;
                const f32x4 brv = *(const GAS f32x4*)(lbr_p + c), biv = *(const GAS f32x4*)(lbi_p + c); const f32x4 spl = *(const GAS f32x4*)(spl_p + c);
                v2u pyw; if (FINAL) pyw = *(const v2u*)(P + (size_t)m * NP + PC_LY + c);
                float hout[4];
#pragma unroll
                for (int i = 0; i < 4; ++i) {
                    const float g_r = sigm(gr[i] + brv[i]), g_i = sigm(gi[i] + biv[i]);
                    const float log_a = -8.0f * g_r * spl[i];
                    float av = __expf(log_a); float mult = __builtin_amdgcn_sqrtf(fmaxf(1.0f - av * av, 0.f)); if (tseq == 0) mult = 1.0f;
                    float bv = mult * g_i * xc[vb][i];
                    { float pa = dpp_keep<0x111>(1.0f, av), pb = dpp_keep<0x111>(0.0f, bv); bv = av * pb + bv; av = av * pa; }
                    { float pa = dpp_keep<0x112>(1.0f, av), pb = dpp_keep<0x112>(0.0f, bv); bv = av * pb + bv; av = av * pa; }
                    { float pa = dpp_keep<0x114>(1.0f, av), pb = dpp_keep<0x114>(0.0f, bv); bv = av * pb + bv; av = av * pa; }
                    { float pa = dpp_keep<0x118>(1.0f, av), pb = dpp_keep<0x118>(0.0f, bv); bv = av * pb + bv; av = av * pa; }
                    const float hv = bv + av * hcar[vb][i];
                    const int l15 = (F.lane & 48) | 15;
                    const float hend = __shfl(hv, l15), aend = __shfl(av, l15);
                    hcar[vb][i] = hend; if (!FINAL) aprod[vb][i] *= aend; hout[i] = hv; }
                if (FINAL) { const float y0 = hout[0] * gelu_tanh(bflo(pyw.x)), y1 = hout[1] * gelu_tanh(bfhi(pyw.x)), y2 = hout[2] * gelu_tanh(bflo(pyw.y)), y3 = hout[3] * gelu_tanh(bfhi(pyw.y));
                    v2u w; w.x = pk2(y0, y1); w.y = pk2(y2, y3); *(v2u*)(YB + (size_t)m * 3072 + c) = w; }
            }
        }
        if (!FINAL && tq == 0) {
#pragma unroll
            for (int vb = 0; vb < 4; ++vb) { f32x4 pa, pb;
#pragma unroll
                for (int i = 0; i < 4; ++i) { pa[i] = aprod[vb][i]; pb[i] = hcar[vb][i]; }
                *(f32x4*)(CA + tt * 1024 + cb + 16 * vb) = pa; *(f32x4*)(CB + tt * 1024 + cb + 16 * vb) = pb; }
        }
        (void)seq0;
    }
}
__device__ __forceinline__ void lru_carry(const Frame& F, const Args& a) {
    const float* CA = (const float*)(a.ws + WS_LRUC); const float* CB = CA + 256 * 1024; float* HIN = (float*)CB + 256 * 1024;
    const int gt = F.vcu * (NWAVES * 64) + F.tid;
    if (gt < 2048) { const int b = gt >> 10, c = gt & 1023; float h = 0.f;
#pragma unroll 1
        for (int k0 = 0; k0 < 128; k0 += 32) { float ca[32], cb[32];
#pragma unroll
            for (int j = 0; j < 32; ++j) { const int tt = b * 128 + k0 + j; ca[j] = CA[tt * 1024 + c]; cb[j] = CB[tt * 1024 + c]; }
#pragma unroll
            for (int j = 0; j < 32; ++j) { const int tt = b * 128 + k0 + j; HIN[tt * 1024 + c] = h; h = ca[j] * h + cb[j]; } } }
}

__device__ __forceinline__ void xattn_phase(const Frame& F, const Args& a, int gw, int NGW) {
    const bf16* P = (const bf16*)(a.ws + WS_P); const bf16* KM = (const bf16*)(a.ws + WS_KMEM); const bf16* VT = (const bf16*)(a.ws + WS_VT);
    bf16* YC = (bf16*)(a.ws + WS_YABC) + 2048;
    const int tq = F.lane & 15, kq = F.lane >> 4;
    for (int it = gw; it < 4 * 512; it += NGW) {
        const int h = it >> 9, tg = it & 511, m0 = tg * 32, b = m0 / SEQ;
        bf16x8 qf[2][8];
#pragma unroll
        for (int g = 0; g < 2; ++g)
#pragma unroll
            for (int ks = 0; ks < 8; ++ks) qf[g][ks] = *(const bf16x8*)(P + (size_t)(m0 + 16 * g + tq) * NP + PC_Q + h * 256 + 32 * ks + 8 * kq);
        f32x4 s[2][16];
#pragma unroll
        for (int mb = 0; mb < 16; ++mb) { f32x4 acc0 = {0.f, 0.f, 0.f, 0.f}, acc1 = {0.f, 0.f, 0.f, 0.f}; const bf16* kp = KM + (size_t)(b * 256 + 16 * mb + tq) * 1024 + h * 256 + 8 * kq;
#pragma unroll
            for (int ks = 0; ks < 8; ++ks) { const bf16x8 kf = *(const bf16x8*)(kp + 32 * ks);
                acc0 = __builtin_amdgcn_mfma_f32_16x16x32_bf16(kf, qf[0][ks], acc0, 0, 0, 0); acc1 = __builtin_amdgcn_mfma_f32_16x16x32_bf16(kf, qf[1][ks], acc1, 0, 0, 0); }
            s[0][mb] = acc0; s[1][mb] = acc1; asm volatile("" ::: "memory"); }
        bf16x8 pf[2][8];
#pragma unroll
        for (int g = 0; g < 2; ++g) {
            float mx = -3.0e38f;
#pragma unroll
            for (int mb = 0; mb < 16; ++mb) { s[g][mb] = s[g][mb] * 0.0625f; mx = fmaxf(mx, fmaxf(fmaxf(s[g][mb][0], s[g][mb][1]), fmaxf(s[g][mb][2], s[g][mb][3]))); }
            mx = fmaxf(mx, __shfl_xor(mx, 16)); mx = fmaxf(mx, __shfl_xor(mx, 32));
            float sum = 0.f;
#pragma unroll
            for (int mb = 0; mb < 16; ++mb) {
#pragma unroll
                for (int i = 0; i < 4; ++i) { s[g][mb][i] = __expf(s[g][mb][i] - mx); sum += s[g][mb][i]; } }
            sum += __shfl_xor(sum, 16); sum += __shfl_xor(sum, 32);
            const float inv = 1.0f / sum;
#pragma unroll
            for (int ks = 0; ks < 8; ++ks) { v4u w; w.x = pk2(s[g][2 * ks][0] * inv, s[g][2 * ks][1] * inv); w.y = pk2(s[g][2 * ks][2] * inv, s[g][2 * ks][3] * inv); w.z = pk2(s[g][2 * ks + 1][0] * inv, s[g][2 * ks + 1][1] * inv); w.w = pk2(s[g][2 * ks + 1][2] * inv, s[g][2 * ks + 1][3] * inv); pf[g][ks] = __builtin_bit_cast(bf16x8, w); } }
#pragma unroll
        for (int db = 0; db < 16; ++db) { f32x4 acc0 = {0.f, 0.f, 0.f, 0.f}, acc1 = {0.f, 0.f, 0.f, 0.f}; const bf16* vp = VT + ((size_t)((b * 4 + h) * 256 + 16 * db + tq)) * 256 + 8 * kq;
#pragma unroll
            for (int ks = 0; ks < 8; ++ks) { const bf16x8 vf = *(const bf16x8*)(vp + 32 * ks);
                acc0 = __builtin_amdgcn_mfma_f32_16x16x32_bf16(vf, pf[0][ks], acc0, 0, 0, 0); acc1 = __builtin_amdgcn_mfma_f32_16x16x32_bf16(vf, pf[1][ks], acc1, 0, 0, 0); }
            v2u w0_, w1_; w0_.x = pk2(acc0[0], acc0[1]); w0_.y = pk2(acc0[2], acc0[3]); w1_.x = pk2(acc1[0], acc1[1]); w1_.y = pk2(acc1[2], acc1[3]);
            *(v2u*)(YC + (size_t)(m0 + tq) * 3072 + h * 256 + 16 * db + 4 * kq) = w0_; *(v2u*)(YC + (size_t)(m0 + 16 + tq) * 3072 + h * 256 + 16 * db + 4 * kq) = w1_; asm volatile("" ::: "memory"); }
    }
}

__device__ __forceinline__ void router_phase(const Frame& F, const Args& a) {
    const bf16* H1 = (const bf16*)(a.ws + WS_H1); bf16* XN2 = (bf16*)(a.ws + WS_XN); const bf16* WR = (const bf16*)(a.ws + WS_WR);
    int* pick_e = (int*)(a.ws + WS_PICK); int* pick_rank = pick_e + 65536; float* pick_gate = (float*)(pick_rank + 65536);
    unsigned* gcnt = (unsigned*)(a.ws + WS_CTL) + CW_CNT;
    LAS float* lg = (LAS float*)(F.lds + F.wave * 4096);
    LAS unsigned* lcnt = (LAS unsigned*)(F.lds + 65536);
    const int tq = F.lane & 15, kq = F.lane >> 4;
    for (int g0 = F.vcu * 4; g0 < 1024; g0 += F.G * 4) {
        if (F.tid < 64) lcnt[F.tid] = 0u;
        __syncthreads();
        int me = 0, mrank = 0; float mgate = 0.f; int e4[4]; float g4[4]; int r4[4];
        const int m0 = (g0 + F.wave) * 16;
        if (F.wave < 4) {
            float myr = 0.f;
            for (int j = 0; j < 16; ++j) { const GAS v4u* xr = (const GAS v4u*)(H1 + (size_t)(m0 + j) * D) + F.lane; float s = 0.f;
#pragma unroll
                for (int q = 0; q < 4; ++q) { const v4u w8 = xr[64 * q]; const float e0 = bflo(w8.x), e1 = bfhi(w8.x), e2 = bflo(w8.y), e3 = bfhi(w8.y), e4 = bflo(w8.z), e5 = bfhi(w8.z), e6 = bflo(w8.w), e7 = bfhi(w8.w);
                    s += ((e0 * e0 + e1 * e1) + (e2 * e2 + e3 * e3)) + ((e4 * e4 + e5 * e5) + (e6 * e6 + e7 * e7)); }
                const float rs = 1.0f / sqrtf(wave_sum(s) * (1.f / D) + EPS); if (tq == j) myr = rs; }
            f32x4 acc[2] = {{0.f, 0.f, 0.f, 0.f}, {0.f, 0.f, 0.f, 0.f}};
            const bf16* hrow = H1 + (size_t)(m0 + tq) * D + 8 * kq; const float* grow = inp(I_GFFN) + 8 * kq; unsigned char* xrow = (unsigned char*)XN2 + (size_t)(m0 + tq) * D + 8 * kq;
            for (int ks = 0; ks < 64; ++ks) {
                const v4u hw8 = *(const v4u*)(hrow + 32 * ks); const f32x4 x0 = {bflo(hw8.x), bfhi(hw8.x), bflo(hw8.y), bfhi(hw8.y)}, x1 = {bflo(hw8.z), bfhi(hw8.z), bflo(hw8.w), bfhi(hw8.w)}, g0v = *(const f32x4*)(grow + 32 * ks), g1v = *(const f32x4*)(grow + 32 * ks + 4);
                v4u w; w.x = pk2(x0[0] * myr * g0v[0], x0[1] * myr * g0v[1]); w.y = pk2(x0[2] * myr * g0v[2], x0[3] * myr * g0v[3]); w.z = pk2(x1[0] * myr * g1v[0], x1[1] * myr * g1v[1]); w.w = pk2(x1[2] * myr * g1v[2], x1[3] * myr * g1v[3]);
                { v2u q8; q8.x = pk4_fp8(x0[0] * myr * g0v[0], x0[1] * myr * g0v[1], x0[2] * myr * g0v[2], x0[3] * myr * g0v[3]); q8.y = pk4_fp8(x1[0] * myr * g1v[0], x1[1] * myr * g1v[1], x1[2] * myr * g1v[2], x1[3] * myr * g1v[3]); *(v2u*)(xrow + 32 * ks) = q8; }
                const bf16x8 af = __builtin_bit_cast(bf16x8, w);
#pragma unroll
                for (int eh = 0; eh < 2; ++eh) { const bf16* wp = WR + (size_t)(16 * eh + tq) * D + 32 * ks + 8 * kq;
                    acc[eh] = __builtin_amdgcn_mfma_f32_16x16x32_bf16(af, *(const bf16x8*)wp, acc[eh], 0, 0, 0);
                    acc[eh] = __builtin_amdgcn_mfma_f32_16x16x32_bf16(af, *(const bf16x8*)(wp + 32 * D), acc[eh], 0, 0, 0); } }
#pragma unroll
            for (int eh = 0; eh < 2; ++eh)
#pragma unroll
                for (int i = 0; i < 4; ++i) lg[(4 * kq + i) * 33 + 16 * eh + tq] = acc[eh][i] + inp(I_BROUTER)[16 * eh + tq];
            LDS_WAIT(); asm volatile("" ::: "memory");
            if (F.lane < 16) { float v[32];
#pragma unroll
                for (int e = 0; e < 32; ++e) v[e] = lg[F.lane * 33 + e];
                float tv[4];
#pragma unroll
                for (int k = 0; k < 4; ++k) { float best = -3.0e38f; int bi = 0;
#pragma unroll
                    for (int e = 0; e < 32; ++e) { if (v[e] > best) { best = v[e]; bi = e; } }
                    tv[k] = best; e4[k] = bi;
#pragma unroll
                    for (int e = 0; e < 32; ++e) { if (e == bi) v[e] = -3.0e38f; } }
                float den = 0.f;
#pragma unroll
                for (int k = 0; k < 4; ++k) { g4[k] = __expf(tv[k] - tv[0]); den += g4[k]; }
#pragma unroll
                for (int k = 0; k < 4; ++k) { g4[k] = g4[k] / den; r4[k] = (int)atomicAdd((unsigned*)&lcnt[e4[k]], 1u); } }
        }
        __syncthreads();
        if (F.tid < 32) lcnt[32 + F.tid] = atomicAdd(&gcnt[F.tid], lcnt[F.tid]);
        __syncthreads();
        if (F.wave < 4 && F.lane < 16) {
#pragma unroll
            for (int k = 0; k < 4; ++k) { const int pi = (m0 + F.lane) * 4 + k; pick_e[pi] = e4[k]; pick_rank[pi] = (int)lcnt[32 + e4[k]] + r4[k]; pick_gate[pi] = g4[k]; } }
        __syncthreads();
        (void)me; (void)mrank; (void)mgate;
    }
}

__device__ __forceinline__ void scatter_phase(const Frame& F, const Args& a) {
    const int* pick_e = (const int*)(a.ws + WS_PICK); const int* pick_rank = pick_e + 65536; const float* pick_gate = (const float*)(pick_rank + 65536); int* pos = (int*)(pick_gate + 65536);
    float* gate_of_row = (float*)(a.ws + WS_ROWTAB); int* tok_of_row = (int*)(a.ws + WS_ROWTAB + 512 * 1024 + 8192);
    unsigned* ctl = (unsigned*)(a.ws + WS_CTL);
    LAS int* pst = (LAS int*)(F.lds);
    if (F.tid == 0) { int acc = 0; for (int e = 0; e < NE; ++e) { pst[e] = acc; const int c = (int)ctl[CW_CNT + e]; pst[32 + e] = c; const int nt = (c + 255) >> 8;
            if (blockIdx.x == 0) for (int k = 0; k < nt; ++k) ctl[CW_TILEE + (acc >> 8) + k] = (unsigned)e;
            acc += nt << 8; }
        if (blockIdx.x == 0) ctl[CW_NTILES] = (unsigned)(acc >> 8); }
    __syncthreads();
    { const int gw = F.vcu * NWAVES + F.wave, NGW = F.G * NWAVES; const unsigned char* X8 = a.ws + WS_XN; unsigned char* XS8 = a.ws + WS_XS;
      for (int pi = gw; pi < 65536; pi += NGW) {
        const int e = pick_e[pi], row = pst[e] + pick_rank[pi], tok = pi >> 2;
        if (F.lane == 0) { pos[pi] = row; gate_of_row[row] = pick_gate[pi]; tok_of_row[row] = tok; }
        const GAS v4u* src = (const GAS v4u*)(X8 + (size_t)tok * D) + F.lane; GAS v4u* dst = (GAS v4u*)(XS8 + (size_t)row * D) + F.lane;
        dst[0] = src[0]; dst[64] = src[64]; } }
    if (blockIdx.x == 0) for (int e = 0; e < NE; ++e) { const int r0 = pst[e] + pst[32 + e], r1 = pst[e] + (((pst[32 + e] + 255) >> 8) << 8);
        for (int r = r0 + F.tid; r < r1; r += NWAVES * 64) { tok_of_row[r] = 0; gate_of_row[r] = 0.f; } }
}

__device__ __forceinline__ void final_phase(const Frame& F, const Args& a) {
    const bf16* H1 = (const bf16*)(a.ws + WS_H1); const bf16* OR = (const bf16*)(a.ws + WS_OROW);
    const int* pos = (const int*)(a.ws + WS_PICK) + 3 * 65536;
    const int gw = F.vcu * NWAVES + F.wave, NGW = F.G * NWAVES;
    for (int m = gw; m < T; m += NGW) {
        const GAS v2u* xr = (const GAS v2u*)(H1 + (size_t)m * D) + F.lane; const GAS f32x4* gr = (const GAS f32x4*)inp(I_GFINAL) + F.lane;
        f32x4 v[8];
#pragma unroll
        for (int j = 0; j < 8; ++j) { const v2u w = xr[64 * j]; v[j] = (f32x4){bflo(w.x), bfhi(w.x), bflo(w.y), bfhi(w.y)}; }
#pragma unroll
        for (int k = 0; k < 4; ++k) { const int row = pos[m * 4 + k]; const GAS v2u* orp = (const GAS v2u*)(OR + (size_t)row * D) + F.lane;
#pragma unroll
            for (int j = 0; j < 8; ++j) { const v2u w = orp[64 * j]; v[j].x += bflo(w.x); v[j].y += bfhi(w.x); v[j].z += bflo(w.y); v[j].w += bfhi(w.y); } }
        float s = 0.f;
#pragma unroll
        for (int j = 0; j < 8; ++j) s += (v[j].x * v[j].x + v[j].y * v[j].y) + (v[j].z * v[j].z + v[j].w * v[j].w);
        const float rstd = 1.0f / sqrtf(wave_sum(s) * (1.f / D) + EPS);
        GAS f32x4* o = (GAS f32x4*)(a.out + (size_t)m * D) + F.lane;
#pragma unroll
        for (int j = 0; j < 8; ++j) { const f32x4 g = gr[64 * j]; o[64 * j] = (f32x4){v[j].x * rstd * g.x, v[j].y * rstd * g.y, v[j].z * rstd * g.z, v[j].w * rstd * g.w}; }
    }
}

#ifndef MK_N_LAUNCHES
#define MK_N_LAUNCHES 1
#endif
constexpr int NPH = 14;
__global__ void __launch_bounds__(NWAVES * 64, 2) fwd(Args args) {
    extern __shared__ __attribute__((aligned(16))) unsigned char lds[];
#define NEWFRAME() Frame F; { int tz = threadIdx.x; asm volatile("" : "+v"(tz)); F.lds = (LAS unsigned char*)lds; F.MISC = (volatile LAS unsigned*)(F.lds + MISC_OFF); F.tid = tz; F.lane = tz & 63; F.wave = __builtin_amdgcn_readfirstlane(tz >> 6); \
        F.G = gridDim.x; const int bx = blockIdx.x; F.vcu = (F.G % 8 == 0) ? (bx % 8) * (F.G / 8) + bx / 8 : bx; }
    unsigned char* ws = args.ws;
    unsigned* ctl = (unsigned*)(ws + WS_CTL);
    for (int u = threadIdx.x; u < (LDS_BYTES - MISC_OFF) / 4; u += NWAVES * 64) ((LAS unsigned*)((LAS unsigned char*)lds + MISC_OFF))[u] = 0u;
    __syncthreads();
    const int lo = args.ph_lo, hi = args.ph_hi;
    XcdBarrier bar; bar.bar = ctl + CW_BAR; bar.x = 0; bar.st = nullptr;
    if (hi - lo > 1) bar = xcd_barrier_post(ctl + CW_BAR, (volatile LAS unsigned*)((LAS unsigned char*)lds + MISC_OFF) + 8);
#ifndef PHMASK
#define PHMASK 0xFFFF
#endif
#define IN(k) (((PHMASK >> (k)) & 1) && lo <= (k) && (k) < hi)
#define SEAM(k) do { if (IN(k) && IN((k) + 1)) xcd_barrier(bar); } while (0)

    if (IN(0)) { NEWFRAME(); p0_prologue(F, args); } SEAM(0);
    if (IN(1)) { NEWFRAME();
        const int c = (int)blockIdx.x, G = F.G;
        { pg8::Gemm g{(const bf16*)(ws + WS_XN), (const bf16*)(ws + WS_WIN), T, PC_G, D}; pg8::StaticOrder S; S.init(T, PC_G, G, c);
          pg8::EpiBf16<0> E{(bf16*)(ws + WS_P), NP, nullptr, 0, 0, 1.f};
          pg8::gemm_phase<pg8::EpiBf16<0>, pg8::StaticOrder, true, true>(F.lds, g, S, E); }
        __syncthreads();
        { pg8::Gemm g{(const bf16*)(ws + WS_MN), (const bf16*)(ws + WS_WMKV), 512, 2048, D}; pg8::StaticOrder S; S.init(512, 2048, G, (c + G - G / 2) % G);
          pg8::EpiKV E{(bf16*)(ws + WS_KMEM), (bf16*)(ws + WS_VT)};
          pg8::gemm_phase<pg8::EpiKV, pg8::StaticOrder, true, true>(F.lds, g, S, E); }
        __syncthreads();
        { int start, cnt;
          if (G == 256) { if (c < 144) { start = 5 * c; cnt = 5; } else if (c < 224) { start = 720 + 7 * (c - 144); cnt = 7; } else { start = 1280 + 8 * (c - 224); cnt = 8; } }
          else { const int per = (1536 + G - 1) / G; start = per * c; cnt = start >= 1536 ? 0 : (1536 - start < per ? 1536 - start : per); }
          pg8::Gemm g{(const bf16*)(ws + WS_XN8), (const bf16*)(ws + WS_WIN8), T, NP - PC_G, D}; pg8::RangeOrder S; S.init(T, NP - PC_G, start, cnt);
          pg8::EpiBf16<2> E{(bf16*)(ws + WS_P) + PC_G, NP, nullptr, 0, 0, 1.f};
          pg8::gemm_phase<pg8::EpiBf16<2>, pg8::RangeOrder, true, true, 1>(F.lds, g, S, E); }
    } SEAM(1);
    if (IN(2)) { NEWFRAME();
#ifndef NO_R1
 r1_lora_in(F, args);
#endif
#ifndef NO_LRU
 lru_pass<false>(F, args, F.vcu * NWAVES + F.wave, F.G * NWAVES);
#endif
 } SEAM(2);
    if (IN(3)) { NEWFRAME();
        lru_carry(F, args);
        { pg8::Gemm g{(const bf16*)(ws + WS_XN), (const bf16*)(ws + WS_WLORA), T, 3072, LORA_K}; pg8::StaticOrder S; S.init(T, 3072, F.G, (int)blockIdx.x);
          pg8::EpiF32 E{(float*)(ws + WS_LORAOUT), 3072};
          pg8::gemm_phase<pg8::EpiF32, pg8::StaticOrder, true, true>(F.lds, g, S, E); }
    } SEAM(3);
    if (IN(4)) { NEWFRAME(); r3_blocks(F, args); } SEAM(4);
    if (IN(5)) { NEWFRAME();
        if (F.tid < 64) ((LAS unsigned*)(F.lds + SC_SYNC))[F.tid] = 0u; __syncthreads();
        int bh = 0, quarter = 0; const bool sw = scan_wg(bh, quarter);
        int gw2, NGW2; { const int bx = blockIdx.x, G = F.G; if (G == 256) { NGW2 = 1792; gw2 = sw ? ((bx >> 4) * 8 + (bx & 7)) * 6 + (F.wave - 2) : 768 + ((bx >> 4) * 8 + (bx & 7)) * 8 + F.wave; } else { NGW2 = G * 8; gw2 = F.vcu * 8 + F.wave; } }
        if (sw && F.wave == 0) r4_scan<0>(F, args, bh, quarter);
        else if (sw && F.wave == 1) r4_feeder(F, args, bh);
        else {
            const int rot = F.wave % 3;
            if (rot == 0) { moe_weight_convert(F, args, gw2, NGW2); xattn_phase(F, args, gw2, NGW2); lru_pass<true>(F, args, gw2, NGW2); }
            else if (rot == 1) { xattn_phase(F, args, gw2, NGW2); lru_pass<true>(F, args, gw2, NGW2); moe_weight_convert(F, args, gw2, NGW2); }
            else { lru_pass<true>(F, args, gw2, NGW2); moe_weight_convert(F, args, gw2, NGW2); xattn_phase(F, args, gw2, NGW2); } }
    } SEAM(5);
    if (IN(6)) { NEWFRAME(); r5_finish(F, args); } SEAM(6);
    if (IN(7)) { NEWFRAME();
        pg8::Gemm g{(const bf16*)(ws + WS_YABC), (const bf16*)(ws + WS_WBR), T, 2048, 3072}; pg8::StaticOrder S; S.init(T, 2048, F.G, (int)blockIdx.x);
        pg8::EpiBranch2 E{(const bf16*)(ws + WS_P), NP, PC_G, (bf16*)(ws + WS_MERGED)};
        pg8::gemm_phase<pg8::EpiBranch2, pg8::StaticOrder, true, true>(F.lds, g, S, E);
    } SEAM(7);
    if (IN(8)) { NEWFRAME();
        pg8::Gemm g{(const bf16*)(ws + WS_MERGED), (const bf16*)(ws + WS_WO), T, D, D}; pg8::StaticOrder S; S.init(T, D, F.G, (int)blockIdx.x);
        pg8::EpiRes E{inp(I_X), (bf16*)(ws + WS_H1), D};
        pg8::gemm_phase<pg8::EpiRes, pg8::StaticOrder, true, true>(F.lds, g, S, E);
    } SEAM(8);
    if (IN(9)) { NEWFRAME(); router_phase(F, args); } SEAM(9);
    if (IN(10)) { NEWFRAME(); scatter_phase(F, args); } SEAM(10);
    if (IN(11)) { NEWFRAME();
        const int ntiles = __builtin_amdgcn_readfirstlane((int)__hip_atomic_load(ctl + CW_NTILES, __ATOMIC_RELAXED, __HIP_MEMORY_SCOPE_AGENT));
        pg8::Gemm g{(const bf16*)(ws + WS_XS), (const bf16*)(ws + WS_WGU), ntiles * 256, NE * 4096, D}; pg8::MoeOrder<false> S; S.init(ntiles, 16, F.G, (int)blockIdx.x, (const int*)(ctl + CW_TILEE), nullptr);
        pg8::EpiSwiglu E{ws + WS_HH, inp(I_BGATE), inp(I_BUP)};
        pg8::gemm_phase<pg8::EpiSwiglu, pg8::MoeOrder<false>, true, true, 1>(F.lds, g, S, E);
    } SEAM(11);
    if (IN(12)) { NEWFRAME();
        const int ntiles = __builtin_amdgcn_readfirstlane((int)__hip_atomic_load(ctl + CW_NTILES, __ATOMIC_RELAXED, __HIP_MEMORY_SCOPE_AGENT));
        pg8::Gemm g{(const bf16*)(ws + WS_HH), (const bf16*)(ws + WS_WD), ntiles * 256, NE * 2048, D}; pg8::MoeOrder<false> S; S.init(ntiles, 8, F.G, (int)blockIdx.x, (const int*)(ctl + CW_TILEE), nullptr);
        pg8::EpiDown E{(bf16*)(ws + WS_OROW), inp(I_BDOWN), (const float*)(ws + WS_ROWTAB)};
        pg8::gemm_phase<pg8::EpiDown, pg8::MoeOrder<false>, true, true, 1>(F.lds, g, S, E);
    } SEAM(12);
    if (IN(13)) { NEWFRAME(); final_phase(F, args); }
#ifdef PROBE_EXTRA_PHASE
    if (lo == 14) { NEWFRAME(); if (F.tid < 64) ((LAS unsigned*)(F.lds + SC_SYNC))[F.tid] = 0u; __syncthreads(); int bh = 0, quarter = 0; const bool sw = scan_wg(bh, quarter); if (sw && F.wave == 0) r4_scan<0>(F, args, bh, quarter); else if (sw && F.wave == 1) r4_feeder(F, args, bh); }
    if (lo == 17) { NEWFRAME(); int bh = 0, quarter = 0; const bool sw = scan_wg(bh, quarter); if (sw && F.wave == 0) r4_scan<1>(F, args, bh, quarter); }
    if (lo == 18) { NEWFRAME(); const int gw2 = F.vcu * 8 + F.wave, NGW2 = F.G * 8; const int rot = F.wave % 3;
            if (rot == 0) { moe_weight_convert(F, args, gw2, NGW2); xattn_phase(F, args, gw2, NGW2); lru_pass<true>(F, args, gw2, NGW2); }
            else if (rot == 1) { xattn_phase(F, args, gw2, NGW2); lru_pass<true>(F, args, gw2, NGW2); moe_weight_convert(F, args, gw2, NGW2); }
            else { lru_pass<true>(F, args, gw2, NGW2); moe_weight_convert(F, args, gw2, NGW2); xattn_phase(F, args, gw2, NGW2); } }
    if (lo == 19) { NEWFRAME(); xattn_phase(F, args, F.vcu * 8 + F.wave, F.G * 8); }
    if (lo == 20) { NEWFRAME(); lru_pass<true>(F, args, F.vcu * 8 + F.wave, F.G * 8); }
    if (lo == 15) { NEWFRAME(); moe_weight_convert(F, args, F.vcu * 8 + F.wave, F.G * 8); }
#endif
#undef IN
#undef SEAM
}

extern "C" void kernel_launch(void* const* d_in, const int* in_sizes, int n_in, void* d_out, int out_size, void* d_ws, size_t ws_size, hipStream_t stream) {
    static int grid = 0;
    if (grid == 0) {
        if (n_in != 39 || out_size != T * D || ws_size < WS_END) { fprintf(stderr, "kernel_launch: built for 39 inputs, out of %d floats, >= %zu bytes of workspace; got n_in %d, out %d, ws %zu; nothing launched\n", T * D, (size_t)WS_END, n_in, out_size, ws_size); grid = -1; return; }
        int dev = 0, cus = 0, per_cu = 0;
        if (hipGetDevice(&dev) != hipSuccess || hipDeviceGetAttribute(&cus, hipDeviceAttributeMultiprocessorCount, dev) != hipSuccess) { fprintf(stderr, "kernel_launch: device query failed\n"); grid = -1; return; }
        if (hipFuncSetAttribute((const void*)fwd, hipFuncAttributeMaxDynamicSharedMemorySize, LDS_BYTES) != hipSuccess) { fprintf(stderr, "kernel_launch: hipFuncSetAttribute failed\n"); grid = -1; return; }
        if (hipOccupancyMaxActiveBlocksPerMultiprocessor(&per_cu, (const void*)fwd, NWAVES * 64, LDS_BYTES) != hipSuccess || per_cu < 1)
            fprintf(stderr, "kernel_launch: note: occupancy query reports %d workgroups per CU\n", per_cu);
        (void)hipGetLastError();
        grid = cus;
    }
    if (grid < 0) return;
    (void)in_sizes;
    if (hipMemsetAsync((char*)d_ws + WS_CTL, 0, CTL_ZERO_BYTES, stream) != hipSuccess) { fprintf(stderr, "kernel_launch: hipMemsetAsync failed\n"); return; }
    Args a{};
    for (int i = 0; i < 39; ++i) a.in[i] = (const float*)d_in[i];
    a.out = (float*)d_out; a.ws = (unsigned char*)d_ws;
#if MK_N_LAUNCHES == 1
    a.ph_lo = 0; a.ph_hi = NPH;
    hipLaunchKernelGGL(fwd, dim3(grid), dim3(NWAVES * 64), LDS_BYTES, stream, a);
#else
    for (int k = 0; k < NPH; ++k) { a.ph_lo = k; a.ph_hi = k + 1; int reps = 1;
#ifdef PROBE_REP_PHASE
        if (k == PROBE_REP_PHASE) reps = 1 + PROBE_REP_N;
#endif
        for (int r = 0; r < reps; ++r) hipLaunchKernelGGL(fwd, dim3(grid), dim3(NWAVES * 64), LDS_BYTES, stream, a); }
#ifdef PROBE_EXTRA_PHASE
    for (int r = 0; r < PROBE_REP_N; ++r) { a.ph_lo = PROBE_EXTRA_PHASE; a.ph_hi = PROBE_EXTRA_PHASE + 1; hipLaunchKernelGGL(fwd, dim3(grid), dim3(NWAVES * 64), LDS_BYTES, stream, a); }
#endif
#endif
    const hipError_t le = hipPeekAtLastError();
    if (le != hipSuccess) fprintf(stderr, "kernel_launch: launch failed: %s\n", hipGetErrorName(le));
}
```

```cpp
#include <hip/hip_runtime.h>
#include <cstdio>
#include <cstdint>
namespace pg8 {
#define PG8_LAS __attribute__((address_space(3)))
typedef unsigned short bf16_t;
typedef short bf16x8 __attribute__((ext_vector_type(8)));
typedef float f32x4 __attribute__((ext_vector_type(4)));
typedef unsigned u32x4 __attribute__((ext_vector_type(4)));
constexpr int BM = 256, BK = 64, HALF = 128, HTB = HALF * BK * 2  , STAGE_BYTES = 8 * HTB, NXCD = 8, WGM = 8;

__host__ __device__ __forceinline__ int lds_byte(int r, int c) { const int st = (r >> 4) * 2 + (c >> 5), rr = r & 15, cc = c & 31, ob = rr * 64 + cc * 2; return st * 1024 + (ob ^ (((ob >> 9) & 1) << 5)); }
__host__ __device__ __forceinline__ void stage_rc(int b, int& R, int& C) { const int st = b / 1024, sb = b % 1024, swz = sb ^ (((sb >> 9) & 1) << 5); R = (st >> 1) * 16 + swz / 64; C = (st & 1) * 32 + (swz % 64) / 2; }
__host__ __device__ __forceinline__ int perm32(int rho) { const int n = rho >> 4, i = rho & 15; return 8 * (i >> 2) + 4 * n + (i & 3); }

struct Unit { int pm, pn; };
struct Gemm { const bf16_t* A; const bf16_t* Bt; int M, N, K; };

struct StaticOrder {
    static constexpr bool GATHER = false; __device__ __forceinline__ int arow(const Unit&, int) const { return 0; }
    int nM, nN, nwg, G, c;
    __host__ __device__ void init(int M, int N, int G_, int c_) { nM = M / BM; nN = N / BM; nwg = nM * nN; G = G_; c = c_; }
    __host__ __device__ bool next(int i, Unit& u) const {
        const int L = i * G + c; if (L >= nwg) return false;
        int wgid = (int)L; { const int q = nwg / NXCD, r = nwg % NXCD, xcd = wgid % NXCD, off = wgid / NXCD; wgid = (xcd < r ? xcd * (q + 1) : r * (q + 1) + (xcd - r) * q) + off; }
        const int nig = WGM * nN, gid = wgid / nig, fm = gid * WGM, gsz = (nM - fm) < WGM ? (nM - fm) : WGM;
        u.pm = fm + ((wgid % nig) % gsz); u.pn = (wgid % nig) / gsz; return true;
    }
    __device__ __forceinline__ void a_ready(const Unit&) const {}
    __device__ __forceinline__ void done(const Unit&) const {}
};
struct RangeOrder {
    static constexpr bool GATHER = false; __device__ __forceinline__ int arow(const Unit&, int) const { return 0; }
    StaticOrder so; int start, cnt;
    __device__ void init(int M, int N, int start_, int cnt_) { so.init(M, N, 1, 0); start = start_; cnt = cnt_; }
    __device__ bool next(int i, Unit& u) const { if (i >= cnt) return false; return so.next(start + i, u); }
    __device__ __forceinline__ void a_ready(const Unit&) const {}
    __device__ __forceinline__ void done(const Unit&) const {}
};
__device__ __forceinline__ unsigned cvt_pk_bf16(float lo, float hi) { unsigned r; asm volatile("v_cvt_pk_bf16_f32 %0, %1, %2" : "=v"(r) : "v"(lo), "v"(hi)); return r; }
typedef float f32x2 __attribute__((ext_vector_type(2)));
__device__ __forceinline__ f32x2 gelu_pk(f32x2 v) {
    const f32x2 av = __builtin_elementwise_abs(v), d = av * 0.2316418882f + 1.0f;
    f32x2 t; t.x = __builtin_amdgcn_rcpf(d.x); t.y = __builtin_amdgcn_rcpf(d.y);
    f32x2 q = t * 0.5307027145f + (-0.7265760135f); q = q * t + 0.7107068705f; q = q * t + (-0.142248368f); q = q * t + 0.127414796f; q = q * t;
    const f32x2 s = (v * v) * (-0.72134752044f);
    f32x2 e; e.x = __builtin_amdgcn_exp2f(s.x); e.y = __builtin_amdgcn_exp2f(s.y);
    const f32x2 m = v * (q * e), r = v - m;
    f32x2 o; o.x = v.x < 0.f ? m.x : r.x; o.y = v.y < 0.f ? m.y : r.y; return o;
}

template <int ACT  > struct EpiBf16 {
    static constexpr bool PERM = true, AFTER_DRAIN = false; static constexpr int MIDK = 0; static constexpr int WSCALE = 0x79797979  ; static_assert(ACT == 0 || ACT == 1 || ACT == 2, "EpiBf16: ACT is 0 (none), 1 (gelu_pk) or 2 (sigmoid)");
    bf16_t* O; int ldc; const float* bias; int split_cols; size_t split_stride; float scale0;
    __device__ __forceinline__ void operator()(const f32x4 (&acc)[2][2][4][2], const Unit& u, int wr, int wc, int fr, int fq) const {
        int tz_ = threadIdx.x; asm volatile("" : "+v"(tz_)); { const int wid_ = tz_ >> 6, lane_ = tz_ & 63; wr = wid_ >> 2; wc = wid_ & 3; fr = lane_ & 15; fq = lane_ >> 4; }
        const int row0 = u.pm * BM + wr * 64 + fr; int colt = u.pn * BM; bf16_t* base = O;
        float sc = 1.f; if (split_cols) { const int t = colt / split_cols; base += (size_t)t * split_stride; colt -= t * split_cols; if (t == 0) sc = scale0; }
        const int col0 = colt + wc * 32 + 8 * fq, bcol0 = u.pn * BM + wc * 32 + 8 * fq;
        f32x4 bv[2][2];
#pragma unroll
        for (int bj = 0; bj < 2; ++bj)
#pragma unroll
            for (int n = 0; n < 2; ++n) bv[bj][n] = bias ? *(const f32x4*)(bias + bcol0 + bj * HALF + 4 * n) : (f32x4){0.f, 0.f, 0.f, 0.f};
#pragma unroll
        for (int ai = 0; ai < 2; ++ai)
#pragma unroll
            for (int m = 0; m < 4; ++m) { bf16_t* rowp = base + (size_t)(row0 + ai * HALF + m * 16) * ldc + col0;
#pragma unroll
                for (int bj = 0; bj < 2; ++bj) { f32x4 v0 = acc[ai][bj][m][0] + bv[bj][0], v1 = acc[ai][bj][m][1] + bv[bj][1];
                    if (ACT == 1) { f32x2 a = gelu_pk((f32x2){v0[0], v0[1]}), b = gelu_pk((f32x2){v0[2], v0[3]}), c = gelu_pk((f32x2){v1[0], v1[1]}), d = gelu_pk((f32x2){v1[2], v1[3]});
                        v0 = (f32x4){a.x, a.y, b.x, b.y}; v1 = (f32x4){c.x, c.y, d.x, d.y}; }
                    if (ACT == 2) {
#pragma unroll
                        for (int j = 0; j < 4; ++j) { v0[j] = fmaxf(__builtin_amdgcn_rcpf(1.0f + __expf(-v0[j])), 1e-30f); v1[j] = fmaxf(__builtin_amdgcn_rcpf(1.0f + __expf(-v1[j])), 1e-30f); } }
                    v0 = v0 * sc; v1 = v1 * sc; u32x4 w; w.x = cvt_pk_bf16(v0[0], v0[1]); w.y = cvt_pk_bf16(v0[2], v0[3]); w.z = cvt_pk_bf16(v1[0], v1[1]); w.w = cvt_pk_bf16(v1[2], v1[3]);
                    *(u32x4*)(rowp + bj * HALF) = w; } }
    }
};

__device__ __forceinline__ float bf_lo(unsigned w) { return __builtin_bit_cast(float, w << 16); }
__device__ __forceinline__ float bf_hi(unsigned w) { return __builtin_bit_cast(float, w & 0xffff0000u); }
__device__ __forceinline__ float fsigmoid(float x) { return __builtin_amdgcn_rcpf(1.0f + __expf(-x)); }
typedef unsigned u32x2 __attribute__((ext_vector_type(2)));

struct EpiF32 {
    static constexpr bool PERM = false, AFTER_DRAIN = false; static constexpr int MIDK = 0; static constexpr int WSCALE = 0x7f7f7f7f;
    float* C; int ldc;
    __device__ __forceinline__ void operator()(const f32x4 (&acc)[2][2][4][2], const Unit& u, int wr, int wc, int fr, int fq) const {
        const int row0 = u.pm * BM + wr * 64 + fr, col0 = u.pn * BM + wc * 32 + 4 * fq;
#pragma unroll
        for (int ai = 0; ai < 2; ++ai)
#pragma unroll
            for (int m = 0; m < 4; ++m) { float* rowp = C + (size_t)(row0 + ai * HALF + m * 16) * ldc + col0;
#pragma unroll
                for (int bj = 0; bj < 2; ++bj)
#pragma unroll
                    for (int n = 0; n < 2; ++n) *(f32x4*)(rowp + bj * HALF + n * 16) = acc[ai][bj][m][n]; }
    }
};
struct EpiRes {
    static constexpr bool PERM = false, AFTER_DRAIN = false; static constexpr int MIDK = 0; static constexpr int WSCALE = 0x7f7f7f7f;
    const float* X; bf16_t* C; int ldc;
    __device__ __forceinline__ void operator()(const f32x4 (&acc)[2][2][4][2], const Unit& u, int wr, int wc, int fr, int fq) const {
        const int row0 = u.pm * BM + wr * 64 + fr, col0 = u.pn * BM + wc * 32 + 4 * fq;
#pragma unroll
        for (int ai = 0; ai < 2; ++ai)
#pragma unroll
            for (int m = 0; m < 4; ++m) { const size_t off = (size_t)(row0 + ai * HALF + m * 16) * ldc + col0;
#pragma unroll
                for (int bj = 0; bj < 2; ++bj)
#pragma unroll
                    for (int n = 0; n < 2; ++n) { const f32x4 xv = *(const f32x4*)(X + off + bj * HALF + n * 16); const f32x4 v = acc[ai][bj][m][n] + xv;
                        u32x2 w; w.x = cvt_pk_bf16(v[0], v[1]); w.y = cvt_pk_bf16(v[2], v[3]); *(u32x2*)(C + off + bj * HALF + n * 16) = w; }
                asm volatile("" ::: "memory"); }
    }
};
struct EpiKV {
    static constexpr bool PERM = false, AFTER_DRAIN = false; static constexpr int MIDK = 0; static constexpr int WSCALE = 0x7f7f7f7f;
    bf16_t* Kb; bf16_t* VT;
    __device__ __forceinline__ void operator()(const f32x4 (&acc)[2][2][4][2], const Unit& u, int wr, int wc, int fr, int fq) const {
        const int row0 = u.pm * BM + wr * 64 + fr, col0 = u.pn * BM + wc * 32 + 4 * fq;
#pragma unroll
        for (int ai = 0; ai < 2; ++ai)
#pragma unroll
            for (int m = 0; m < 4; ++m) { const int r = row0 + ai * HALF + m * 16;
#pragma unroll
                for (int bj = 0; bj < 2; ++bj)
#pragma unroll
                    for (int n = 0; n < 2; ++n) { const f32x4 v = acc[ai][bj][m][n]; const int c = col0 + bj * HALF + n * 16;
                        if (u.pn < 4) { u32x2 w; w.x = cvt_pk_bf16(v[0], v[1]); w.y = cvt_pk_bf16(v[2], v[3]); *(u32x2*)(Kb + (size_t)r * 1024 + c) = w; }
                        else { const int cc = c - 1024, h = cc >> 8, d = cc & 255, b = r >> 8, mm = r & 255;
                            const int idx = (mm >> 5) * 32 + ((mm >> 2) & 3) * 8 + ((mm >> 4) & 1) * 4 + (mm & 3);
                            bf16_t* o = VT + ((size_t)((b * 4 + h) * 256 + d)) * 256 + idx;
                            const unsigned w0 = cvt_pk_bf16(v[0], v[1]), w1 = cvt_pk_bf16(v[2], v[3]);
                            o[0] = (bf16_t)(w0 & 0xffffu); o[256] = (bf16_t)(w0 >> 16); o[512] = (bf16_t)(w1 & 0xffffu); o[768] = (bf16_t)(w1 >> 16); } } }
    }
};
struct EpiBranch {
    static constexpr bool PERM = false, AFTER_DRAIN = false; static constexpr int MIDK = 0; static constexpr int WSCALE = 0x7f7f7f7f;
    const bf16_t* P; int ldp; int gcol0; float* macc; bf16_t* merged;
    __device__ __forceinline__ void operator()(const f32x4 (&acc)[2][2][4][2], const Unit& u, int wr, int wc, int fr, int fq) const {
        const int br = u.pm >> 6, pm = u.pm & 63, pn = u.pn & 7;
        const int row0 = pm * BM + wr * 64 + fr, col0 = pn * BM + wc * 32 + 4 * fq;
#pragma unroll
        for (int ai = 0; ai < 2; ++ai)
#pragma unroll
            for (int m = 0; m < 4; ++m) { const int r = row0 + ai * HALF + m * 16; const bf16_t* prow = P + (size_t)r * ldp + gcol0 + br * 2048;
#pragma unroll
                for (int bj = 0; bj < 2; ++bj)
#pragma unroll
                    for (int n = 0; n < 2; ++n) { const int c = col0 + bj * HALF + n * 16; const u32x2 gw = *(const u32x2*)(prow + c);
                        f32x4 g; g[0] = fsigmoid(bf_lo(gw.x)); g[1] = fsigmoid(bf_hi(gw.x)); g[2] = fsigmoid(bf_lo(gw.y)); g[3] = fsigmoid(bf_hi(gw.y));
                        f32x4 v = acc[ai][bj][m][n] * g; float* mp = macc + (size_t)r * 2048 + c;
                        if (br > 0) v = v + *(const f32x4*)mp;
                        if (br < 2) *(f32x4*)mp = v;
                        else { u32x2 w; w.x = cvt_pk_bf16(v[0], v[1]); w.y = cvt_pk_bf16(v[2], v[3]); *(u32x2*)(merged + (size_t)r * 2048 + c) = w; } }
                asm volatile("" ::: "memory"); }
    }
};
struct EpiSwiglu {
    static constexpr bool PERM = true, AFTER_DRAIN = false; static constexpr int MIDK = 0; static constexpr int WSCALE = 0x79797979;
    unsigned char* H; const float* bg; const float* bu;
    __device__ __forceinline__ void operator()(const f32x4 (&acc)[2][2][4][2], const Unit& u, int wr, int wc, int fr, int fq) const {
        int tz_ = threadIdx.x; asm volatile("" : "+v"(tz_)); { const int wid_ = tz_ >> 6, lane_ = tz_ & 63; wr = wid_ >> 2; wc = wid_ & 3; fr = lane_ & 15; fq = lane_ >> 4; }
        const int e = u.pn >> 4, ct = u.pn & 15;
        const int row0 = u.pm * BM + wr * 64 + fr, col0 = ct * 128 + wc * 32 + 8 * fq;
        f32x4 bgv[2], buv[2];
#pragma unroll
        for (int n = 0; n < 2; ++n) { bgv[n] = *(const f32x4*)(bg + (size_t)e * 2048 + col0 + 4 * n); buv[n] = *(const f32x4*)(bu + (size_t)e * 2048 + col0 + 4 * n); }
#pragma unroll
        for (int ai = 0; ai < 2; ++ai)
#pragma unroll
            for (int m = 0; m < 4; ++m) { unsigned char* rowp = H + (size_t)(row0 + ai * HALF + m * 16) * 2048 + col0;
                f32x4 o[2];
#pragma unroll
                for (int n = 0; n < 2; ++n) { const f32x4 g = acc[ai][0][m][n] + bgv[n], up = acc[ai][1][m][n] + buv[n];
#pragma unroll
                    for (int j = 0; j < 4; ++j) { const float hg = fminf(g[j], 7.0f), hu = fminf(fmaxf(up[j], -7.0f), 7.0f); o[n][j] = (hu + 1.0f) * hg * fsigmoid(1.702f * hg); } }
                u32x2 w; { int t0 = __builtin_amdgcn_cvt_pk_fp8_f32(o[0][0], o[0][1], 0, false); t0 = __builtin_amdgcn_cvt_pk_fp8_f32(o[0][2], o[0][3], t0, true); int t1 = __builtin_amdgcn_cvt_pk_fp8_f32(o[1][0], o[1][1], 0, false); t1 = __builtin_amdgcn_cvt_pk_fp8_f32(o[1][2], o[1][3], t1, true); w.x = (unsigned)t0; w.y = (unsigned)t1; }
                *(u32x2*)rowp = w; }
    }
};
struct EpiDown {
    static constexpr bool PERM = true, AFTER_DRAIN = false; static constexpr int MIDK = 0; static constexpr int WSCALE = 0x79797979;
    bf16_t* O; const float* bd; const float* rowgate;
    __device__ __forceinline__ void operator()(const f32x4 (&acc)[2][2][4][2], const Unit& u, int wr, int wc, int fr, int fq) const {
        int tz_ = threadIdx.x; asm volatile("" : "+v"(tz_)); { const int wid_ = tz_ >> 6, lane_ = tz_ & 63; wr = wid_ >> 2; wc = wid_ & 3; fr = lane_ & 15; fq = lane_ >> 4; }
        const int e = u.pn >> 3, ct = u.pn & 7;
        const int row0 = u.pm * BM + wr * 64 + fr, col0 = ct * BM + wc * 32 + 8 * fq;
        f32x4 bv[2][2];
#pragma unroll
        for (int bj = 0; bj < 2; ++bj)
#pragma unroll
            for (int n = 0; n < 2; ++n) bv[bj][n] = *(const f32x4*)(bd + (size_t)e * 2048 + col0 + bj * HALF + 4 * n);
#pragma unroll
        for (int ai = 0; ai < 2; ++ai)
#pragma unroll
            for (int m = 0; m < 4; ++m) { const int r = row0 + ai * HALF + m * 16; const float gs = rowgate[r]; bf16_t* rowp = O + (size_t)r * 2048 + col0;
#pragma unroll
                for (int bj = 0; bj < 2; ++bj) { const f32x4 v0 = (acc[ai][bj][m][0] + bv[bj][0]) * gs, v1 = (acc[ai][bj][m][1] + bv[bj][1]) * gs;
                    u32x4 w; w.x = cvt_pk_bf16(v0[0], v0[1]); w.y = cvt_pk_bf16(v0[2], v0[3]); w.z = cvt_pk_bf16(v1[0], v1[1]); w.w = cvt_pk_bf16(v1[2], v1[3]);
                    *(u32x4*)(rowp + bj * HALF) = w; } }
    }
};

struct EpiBranch2 {
    static constexpr bool PERM = false, AFTER_DRAIN = false; static constexpr int MIDK = 16; static constexpr int WSCALE = 0x7f7f7f7f;
    const bf16_t* P; int ldp; int gcol0; bf16_t* merged;
    __device__ __forceinline__ void mid(f32x4 (&acc)[2][2][4][2], const Unit& u, int which, int, int, int, int) const {
        int tz = threadIdx.x; asm volatile("" : "+v"(tz));
        const int wid_ = tz >> 6, lane_ = tz & 63, wr = wid_ >> 2, wc = wid_ & 3, fr = lane_ & 15, fq = lane_ >> 4;
        const int row0 = u.pm * BM + wr * 64 + fr, col0 = u.pn * BM + wc * 32 + 4 * fq;
#pragma unroll
        for (int ai = 0; ai < 2; ++ai)
#pragma unroll
            for (int m = 0; m < 4; ++m) { const bf16_t* prow = P + (size_t)(row0 + ai * HALF + m * 16) * ldp + gcol0 + (which - 1) * 2048;
#pragma unroll
                for (int bj = 0; bj < 2; ++bj)
#pragma unroll
                    for (int n = 0; n < 2; ++n) { const int c = col0 + bj * HALF + n * 16; const u32x2 ga = *(const u32x2*)(prow + c), gb = *(const u32x2*)(prow + 2048 + c);
                        const float a_[4] = {bf_lo(ga.x), bf_hi(ga.x), bf_lo(ga.y), bf_hi(ga.y)}, b_[4] = {bf_lo(gb.x), bf_hi(gb.x), bf_lo(gb.y), bf_hi(gb.y)};
#pragma unroll
                        for (int j = 0; j < 4; ++j) acc[ai][bj][m][n][j] *= a_[j] * __builtin_amdgcn_rcpf(b_[j]); }
                asm volatile("" ::: "memory"); }
    }
    __device__ __forceinline__ void operator()(const f32x4 (&acc)[2][2][4][2], const Unit& u, int wr, int wc, int fr, int fq) const {
        const int row0 = u.pm * BM + wr * 64 + fr, col0 = u.pn * BM + wc * 32 + 4 * fq;
#pragma unroll
        for (int ai = 0; ai < 2; ++ai)
#pragma unroll
            for (int m = 0; m < 4; ++m) { const int r = row0 + ai * HALF + m * 16; const bf16_t* prow = P + (size_t)r * ldp + gcol0 + 2 * 2048;
#pragma unroll
                for (int bj = 0; bj < 2; ++bj)
#pragma unroll
                    for (int n = 0; n < 2; ++n) { const int c = col0 + bj * HALF + n * 16; const u32x2 gw = *(const u32x2*)(prow + c);
                        const float g_[4] = {bf_lo(gw.x), bf_hi(gw.x), bf_lo(gw.y), bf_hi(gw.y)}; f32x4 v = acc[ai][bj][m][n];
#pragma unroll
                        for (int j = 0; j < 4; ++j) v[j] *= g_[j];
                        u32x2 w; w.x = cvt_pk_bf16(v[0], v[1]); w.y = cvt_pk_bf16(v[2], v[3]); *(u32x2*)(merged + (size_t)r * 2048 + c) = w; }
                asm volatile("" ::: "memory"); }
    }
};
struct BranchOrder {                              static constexpr bool GATHER = false; __device__ __forceinline__ int arow(const Unit&, int) const { return 0; }
    StaticOrder so;
    __device__ void init(int G_, int c_) { so.init(16384, 2048, G_, c_); }
    __device__ bool next(int i, Unit& u) const { const int br = i % 3; Unit t; if (!so.next(i / 3, t)) return false; u.pm = br * 64 + t.pm; u.pn = br * 8 + t.pn; return true; }
    __device__ __forceinline__ void a_ready(const Unit&) const {}
    __device__ __forceinline__ void done(const Unit&) const {}
};
template <bool GATH> struct MoeOrder {
    static constexpr bool GATHER = GATH;
    StaticOrder so; const int* tile_e; const int* tok; int nN;
    __device__ void init(int ntiles, int nN_, int G_, int c_, const int* te, const int* tk) { so.init(ntiles * BM, nN_ * BM, G_, c_); tile_e = te; tok = tk; nN = nN_; }
    __device__ bool next(int i, Unit& u) const { Unit t; if (!so.next(i, t)) return false; u.pm = t.pm; u.pn = tile_e[t.pm] * nN + t.pn; return true; }
    __device__ __forceinline__ int arow(const Unit& u, int r) const { return tok[u.pm * BM + r]; }
    __device__ __forceinline__ void a_ready(const Unit&) const {}
    __device__ __forceinline__ void done(const Unit&) const {}
};
typedef int i32x4 __attribute__((ext_vector_type(4)));
typedef int i32x8 __attribute__((ext_vector_type(8)));
__device__ __forceinline__ i32x8 frag8(bf16x8 lo, bf16x8 hi) { return __builtin_shufflevector(__builtin_bit_cast(i32x4, lo), __builtin_bit_cast(i32x4, hi), 0, 1, 2, 3, 4, 5, 6, 7); }
template <class Epi, class Sched, bool ALIGN_EPI = false, bool SP2 = false, int ESZ = 2>
__device__ __forceinline__ void gemm_phase(PG8_LAS unsigned char* lds, const Gemm g, const Sched& S, const Epi& E) {
    int tid_ = threadIdx.x; asm volatile("" : "+v"(tid_));
    const int tid = tid_, wid = __builtin_amdgcn_readfirstlane(tid >> 6), lane = tid & 63, wr = wid >> 2, wc = wid & 3, fr = lane & 15, fq = lane >> 4;
    const int K = g.K, nt = K / (BK * 2 / ESZ);
    const __amdgpu_buffer_rsrc_t rsA = __builtin_amdgcn_make_buffer_rsrc((void*)g.A, 0, 0x7fffffff, 0x00020000), rsB = __builtin_amdgcn_make_buffer_rsrc((void*)g.Bt, 0, 0x7fffffff, 0x00020000);
    unsigned voffA[2], voffB[2];
#pragma unroll
    for (int i = 0; i < 2; ++i) { int R, C; stage_rc(tid * 16 + i * 8192, R, C); const int Rb = Epi::PERM ? ((R & ~31) + perm32(R & 31)) : R;
        voffA[i] = (unsigned)(R * K) * (unsigned)ESZ + (unsigned)C * 2u; voffB[i] = (unsigned)(Rb * K) * (unsigned)ESZ + (unsigned)C * 2u; }
    unsigned vc[2][2] = {{0u, 0u}, {0u, 0u}}, vn[2][2] = {{0u, 0u}, {0u, 0u}};
#define PG8_ROWS(dst, un) do { if constexpr (Sched::GATHER) { _Pragma("unroll") for (int _h = 0; _h < 2; ++_h) _Pragma("unroll") for (int _i = 0; _i < 2; ++_i) { int R_, C_; stage_rc(tid * 16 + _i * 8192, R_, C_); \
        dst[_h][_i] = (unsigned)(S.arow(un, _h * HALF + R_) * K) * (unsigned)ESZ + (unsigned)C_ * 2u; } } } while (0)
#define PG8_STAGE_A(bufoff, abase, half, nx) do { if constexpr (Sched::GATHER) { unsigned vo_[2]; vo_[0] = (nx) ? vn[half][0] : vc[half][0]; vo_[1] = (nx) ? vn[half][1] : vc[half][1]; PG8_STAGE_R(bufoff, rsA, g.A, abase, vo_); } \
        else { PG8_STAGE_R(bufoff, rsA, g.A, (abase) + (half) * hstep, voffA); } } while (0)
    const size_t kstep = (size_t)(BK * 2);
    const size_t hstep = (size_t)HALF * K * ESZ;
    const size_t tstep = 2 * hstep;
    const unsigned ldsw = (unsigned)wid * 1024u;
    const int aoff = lds_byte(wr * 64 + fr, fq * 8), boff = lds_byte(wc * 32 + fr, fq * 8);
    const int aoffE = lds_byte(wr * 64 + fr, fq * 16), boffE = lds_byte(wc * 32 + fr, fq * 16);
#define PG8_SA(b, h) (((b) * 2 + (h)) * HTB)
#define PG8_SB(b, h) ((4 + (b) * 2 + (h)) * HTB)
#define PG8_STAGE_R(bufoff, rs, b0, gbase, voff) do { const int so_ = (int)((const char*)(gbase) - (const char*)(b0)); _Pragma("unroll") for (int _i = 0; _i < 2; ++_i) \
        __builtin_amdgcn_raw_ptr_buffer_load_lds(rs, (PG8_LAS void*)(lds + (bufoff) + ldsw + _i * 8192), 16, (int)(voff)[_i], so_, 0, 0); } while (0)
#define PG8_STAGE(bufoff, gbase, voff) PG8_STAGE_R(bufoff, rsB, g.Bt, gbase, voff)
#define PG8_LDA(dst, b, h) do { if constexpr (ESZ == 2) { _Pragma("unroll") for (int m = 0; m < 4; ++m) _Pragma("unroll") for (int k = 0; k < 2; ++k) dst[m][k] = *(const PG8_LAS bf16x8*)(lds + PG8_SA(b, h) + aoff + m * 2048 + k * 1024); } \
        else { _Pragma("unroll") for (int m = 0; m < 4; ++m) { dst##8[m].lo = *(const PG8_LAS i32x4*)(lds + PG8_SA(b, h) + aoffE + m * 2048); dst##8[m].hi = *(const PG8_LAS i32x4*)(lds + PG8_SA(b, h) + aoffE + 16 + m * 2048); } } } while (0)
#define PG8_LDB(dst, b, h) do { if constexpr (ESZ == 2) { _Pragma("unroll") for (int n = 0; n < 2; ++n) _Pragma("unroll") for (int k = 0; k < 2; ++k) dst[n][k] = *(const PG8_LAS bf16x8*)(lds + PG8_SB(b, h) + boff + n * 2048 + k * 1024); } \
        else { _Pragma("unroll") for (int n = 0; n < 2; ++n) { dst##8[n].lo = *(const PG8_LAS i32x4*)(lds + PG8_SB(b, h) + boffE + n * 2048); dst##8[n].hi = *(const PG8_LAS i32x4*)(lds + PG8_SB(b, h) + boffE + 16 + n * 2048); } } } while (0)
#define PG8_MMA(ai, bj, At, Bt) do { __builtin_amdgcn_s_setprio(1); _Pragma("unroll") for (int m = 0; m < 4; ++m) _Pragma("unroll") for (int n = 0; n < 2; ++n) { if constexpr (ESZ == 2) { _Pragma("unroll") for (int k = 0; k < 2; ++k) \
        acc[ai][bj][m][n] = __builtin_amdgcn_mfma_f32_16x16x32_bf16(Bt[n][k], At[m][k], acc[ai][bj][m][n], 0, 0, 0); } else { \
        acc[ai][bj][m][n] = __builtin_amdgcn_mfma_scale_f32_16x16x128_f8f6f4(Bt##8[n], At##8[m], acc[ai][bj][m][n], 0, 0, 0, Epi::WSCALE, 0, 0x7f7f7f7f); } } __builtin_amdgcn_s_setprio(0); } while (0)
#define PG8_WAIT_V(n) asm volatile("s_waitcnt vmcnt(" #n ")" ::: "memory")
#define PG8_WAIT_L(n) asm volatile("s_waitcnt lgkmcnt(" #n ")" ::: "memory")
#define PG8_BAR __builtin_amdgcn_s_barrier()
#define PG8_SCHED __builtin_amdgcn_sched_barrier(0)
    Unit cur, nxt; int ui = 0;
    if (!S.next(0, cur)) return;
    f32x4 acc[2][2][4][2];
#pragma unroll
    for (int a = 0; a < 2; ++a)
#pragma unroll
        for (int b = 0; b < 2; ++b)
#pragma unroll
            for (int m = 0; m < 4; ++m)
#pragma unroll
                for (int n = 0; n < 2; ++n) acc[a][b][m][n] = (f32x4){0.f, 0.f, 0.f, 0.f};
    bf16x8 At[4][2], B0[2][2], B1[2][2];
    i32x8 At8[4], B08[2], B18[2];
    const char* cA = (const char*)g.A + (Sched::GATHER ? (size_t)0 : (size_t)cur.pm * tstep); const char* cB = (const char*)g.Bt + (size_t)cur.pn * tstep;
    PG8_ROWS(vc, cur);
    S.a_ready(cur);
    if constexpr (SP2) {
        PG8_STAGE(PG8_SB(0, 0), cB, voffB); PG8_STAGE(PG8_SB(0, 1), cB + hstep, voffB); PG8_STAGE_A(PG8_SA(0, 0), cA, 0, false); PG8_STAGE_A(PG8_SA(0, 1), cA, 1, false);
        if (wr == 1) PG8_BAR;
        PG8_WAIT_V(2); PG8_BAR;
        PG8_STAGE(PG8_SB(1, 0), cB + kstep, voffB); PG8_STAGE_A(PG8_SA(1, 0), cA + kstep, 0, false); PG8_STAGE(PG8_SB(1, 1), cB + hstep + kstep, voffB);
        PG8_WAIT_V(6); PG8_BAR;
    } else {
        PG8_STAGE(PG8_SB(0, 0), cB, voffB); PG8_STAGE_A(PG8_SA(0, 0), cA, 0, false); PG8_STAGE(PG8_SB(0, 1), cB + hstep, voffB); PG8_STAGE_A(PG8_SA(0, 1), cA, 1, false);
        if (wr == 1) PG8_BAR;
        PG8_WAIT_V(4); PG8_BAR;
        PG8_STAGE(PG8_SB(1, 0), cB + kstep, voffB); PG8_STAGE_A(PG8_SA(1, 0), cA + kstep, 0, false); PG8_STAGE(PG8_SB(1, 1), cB + hstep + kstep, voffB);
        PG8_WAIT_V(6); PG8_BAR;
    }
    for (;;) {
        const bool has_next = S.next(ui + 1, nxt);
        if (has_next) PG8_ROWS(vn, nxt);
        const char* nA = (has_next && !Sched::GATHER) ? (const char*)g.A + (size_t)nxt.pm * tstep : cA; const char* nB = has_next ? (const char*)g.Bt + (size_t)nxt.pn * tstep : cB;
        for (int t = 0; t < nt; t += 2) {
            const bool last = (t == nt - 2);
            const char* a1 = cA + (size_t)(t + 1) * kstep;
            const char* a2 = last ? nA : cA + (size_t)(t + 2) * kstep; const char* b2 = last ? nB : cB + (size_t)(t + 2) * kstep;
            const char* a3 = a2 + kstep; const char* b3 = b2 + kstep;
            if (last && has_next) S.a_ready(nxt);
            if constexpr (Epi::MIDK > 0) { if (t == Epi::MIDK || t == 2 * Epi::MIDK) E.mid(acc, cur, t / Epi::MIDK, wr, wc, fr, fq); }
            if constexpr (SP2) {
            PG8_LDB(B0, 0, 0); PG8_LDB(B1, 0, 1); PG8_SCHED; PG8_LDA(At, 0, 0); PG8_STAGE_A(PG8_SA(1, 1), a1, 1, false);
            PG8_WAIT_V(8); PG8_WAIT_L(0); PG8_BAR; PG8_MMA(0, 0, At, B0); PG8_MMA(0, 1, At, B1); PG8_BAR; PG8_SCHED;
            PG8_LDA(At, 0, 1); PG8_STAGE(PG8_SB(0, 0), b2, voffB); PG8_STAGE(PG8_SB(0, 1), b2 + hstep, voffB); PG8_STAGE_A(PG8_SA(0, 0), a2, 0, last);
            PG8_WAIT_V(8); PG8_WAIT_L(0); PG8_BAR; PG8_MMA(1, 0, At, B0); PG8_MMA(1, 1, At, B1); PG8_BAR; PG8_SCHED;
            PG8_LDB(B0, 1, 0); PG8_LDB(B1, 1, 1); PG8_SCHED; PG8_LDA(At, 1, 0); PG8_STAGE_A(PG8_SA(0, 1), a2, 1, last);
            PG8_WAIT_V(8); PG8_WAIT_L(0); PG8_BAR; PG8_MMA(0, 0, At, B0); PG8_MMA(0, 1, At, B1); PG8_BAR; PG8_SCHED;
            PG8_LDA(At, 1, 1); PG8_STAGE(PG8_SB(1, 0), b3, voffB); PG8_STAGE(PG8_SB(1, 1), b3 + hstep, voffB); PG8_STAGE_A(PG8_SA(1, 0), a3, 0, last);
            PG8_WAIT_V(8); PG8_WAIT_L(0); PG8_BAR; PG8_MMA(1, 0, At, B0); PG8_MMA(1, 1, At, B1); PG8_BAR; PG8_SCHED;
            } else {
            PG8_LDB(B0, 0, 0); PG8_SCHED; PG8_LDA(At, 0, 0); PG8_STAGE_A(PG8_SA(1, 1), a1, 1, false);
            PG8_WAIT_L(8); PG8_BAR; PG8_WAIT_L(0); PG8_MMA(0, 0, At, B0); PG8_BAR; PG8_SCHED;
            PG8_LDB(B1, 0, 1); PG8_STAGE(PG8_SB(0, 0), b2, voffB);
            PG8_BAR; PG8_WAIT_L(0); PG8_MMA(0, 1, At, B1); PG8_BAR;
            PG8_LDA(At, 0, 1); PG8_STAGE_A(PG8_SA(0, 0), a2, 0, last);
            PG8_BAR; PG8_WAIT_L(0); PG8_MMA(1, 0, At, B0); PG8_BAR; PG8_SCHED;
            PG8_STAGE(PG8_SB(0, 1), b2 + hstep, voffB);
            PG8_WAIT_V(6); PG8_BAR; PG8_MMA(1, 1, At, B1); PG8_BAR;
            PG8_LDB(B0, 1, 0); PG8_SCHED; PG8_LDA(At, 1, 0); PG8_STAGE_A(PG8_SA(0, 1), a2, 1, last);
            PG8_WAIT_L(8); PG8_BAR; PG8_WAIT_L(0); PG8_MMA(0, 0, At, B0); PG8_BAR; PG8_SCHED;
            PG8_LDB(B1, 1, 1); PG8_STAGE(PG8_SB(1, 0), b3, voffB);
            PG8_BAR; PG8_WAIT_L(0); PG8_MMA(0, 1, At, B1); PG8_BAR;
            PG8_LDA(At, 1, 1); PG8_STAGE_A(PG8_SA(1, 0), a3, 0, last);
            PG8_BAR; PG8_WAIT_L(0); PG8_MMA(1, 0, At, B0); PG8_BAR; PG8_SCHED;
            PG8_STAGE(PG8_SB(1, 1), b3 + hstep, voffB);
            PG8_WAIT_V(6); PG8_BAR; PG8_MMA(1, 1, At, B1); PG8_BAR;
            }
        }
        if constexpr (ALIGN_EPI) { if (wr == 0) PG8_BAR; }
        if constexpr (!Epi::AFTER_DRAIN) { E(acc, cur, wr, wc, fr, fq); S.done(cur); }
        if (!has_next) break;
#pragma unroll
        for (int a = 0; a < 2; ++a)
#pragma unroll
            for (int b = 0; b < 2; ++b)
#pragma unroll
                for (int m = 0; m < 4; ++m)
#pragma unroll
                    for (int n = 0; n < 2; ++n) acc[a][b][m][n] = (f32x4){0.f, 0.f, 0.f, 0.f};
        cur = nxt; cA = nA; cB = nB; ++ui;
        if constexpr (Sched::GATHER) { vc[0][0] = vn[0][0]; vc[0][1] = vn[0][1]; vc[1][0] = vn[1][0]; vc[1][1] = vn[1][1]; }
        if constexpr (ALIGN_EPI) { if (wr == 1) PG8_BAR; }
    }
    PG8_WAIT_V(0);
    if constexpr (!ALIGN_EPI) { if (wr == 0) PG8_BAR; }
    PG8_BAR;
    if constexpr (Epi::AFTER_DRAIN) { E.fused(acc, cur, wr, wc, fr, fq, lds, wid, lane); S.done(cur); }
#undef PG8_SA
#undef PG8_SB
#undef PG8_STAGE
#undef PG8_STAGE_R
#undef PG8_STAGE_A
#undef PG8_ROWS
#undef PG8_LDA
#undef PG8_LDB
#undef PG8_MMA
#undef PG8_WAIT_V
#undef PG8_WAIT_L
#undef PG8_BAR
#undef PG8_SCHED
}
}

constexpr int NWAVES = 8;
constexpr int BATCH = 2, SEQ = 8192, T = BATCH * SEQ, D = 2048;
constexpr int RWKV_COLS = 3360, IN_COLS = 12576;
constexpr int NP = 12800;
constexpr int PC_LX = 3584, PC_LY = 4608, PC_Q = 5632, PC_G = 6656;
constexpr int NE = 32, MAXROWS = 65536 + NE * 256;
constexpr int LORA_K = 384;
constexpr float EPS = 1e-6f, GN_EPS = 64e-5f;

constexpr size_t MiB = 1u << 20;
constexpr size_t WS_CTL = 0, CTL_ZERO_BYTES = 1 * MiB;
constexpr size_t WS_WIN = 1 * MiB, WS_WMKV = 51 * MiB, WS_WLORA = 59 * MiB, WS_WBR = 62 * MiB, WS_WO = 74 * MiB, WS_WR = 82 * MiB, WS_LW = 83 * MiB;
constexpr size_t WS_WGU = 84 * MiB, WS_WD = 596 * MiB;
constexpr size_t WS_WIN8 = WS_WIN + 27 * MiB;
constexpr size_t WS_XN8 = 1508 * MiB;
constexpr size_t WS_XN = 852 * MiB;
constexpr size_t WS_P = 916 * MiB;
constexpr size_t WS_LORAOUT = 1316 * MiB;
constexpr size_t WS_SCAN = 1508 * MiB;
constexpr size_t WS_YABC = 1892 * MiB;
constexpr size_t WS_MISC = 1988 * MiB;
constexpr size_t WS_MN = WS_MISC, WS_KMEM = WS_MISC + 2 * MiB, WS_VT = WS_MISC + 3 * MiB, WS_LRUC = WS_MISC + 4 * MiB  , WS_BONUS = WS_MISC + 7 * MiB;
constexpr size_t WS_PICK = WS_MISC + 8 * MiB  , WS_ROWTAB = WS_MISC + 9 * MiB  , WS_SPL = WS_ROWTAB + 512 * 1024  ;
constexpr size_t WS_END = 2000 * MiB;
constexpr size_t WS_MACC = WS_LORAOUT, WS_MERGED = 1444 * MiB, WS_H1 = WS_SCAN, WS_XS = WS_P, WS_OROW = WS_P, WS_HH = 1204 * MiB;
constexpr int CW_BAR = 4096, CW_CNT = 8192, CW_NTILES = 8192 + 64, CW_TILEE = 8192 + 128;

constexpr int LDS_BYTES = 147456;
constexpr int MISC_OFF = 143360;

#define GAS __attribute__((address_space(1)))
#define LAS __attribute__((address_space(3)))
typedef unsigned short bf16;
typedef unsigned v4u __attribute__((ext_vector_type(4)));
typedef unsigned v2u __attribute__((ext_vector_type(2)));
typedef float f32x4 __attribute__((ext_vector_type(4)));
typedef float f32x2 __attribute__((ext_vector_type(2)));
typedef short bf16x8 __attribute__((ext_vector_type(8)));
#define LDS_WAIT() asm volatile("s_waitcnt lgkmcnt(0)" ::: "memory")
#define VM_WAIT() asm volatile("s_waitcnt vmcnt(0)" ::: "memory")
__device__ __forceinline__ unsigned f2bf(float f) { unsigned u = __builtin_bit_cast(unsigned, f); return (u + 0x7fffu + ((u >> 16) & 1u)) >> 16; }
__device__ __forceinline__ unsigned pk2(float lo, float hi) { return f2bf(lo) | (f2bf(hi) << 16); }
__device__ __forceinline__ float bflo(unsigned w) { return __builtin_bit_cast(float, w << 16); }
__device__ __forceinline__ float bfhi(unsigned w) { return __builtin_bit_cast(float, w & 0xffff0000u); }
__device__ __forceinline__ float bf1(bf16 b) { return __builtin_bit_cast(float, (unsigned)b << 16); }
__device__ __forceinline__ float sigm(float x) { return __builtin_amdgcn_rcpf(1.0f + __expf(-x)); }
__device__ __forceinline__ float fast_tanh(float x) { const float e = __expf(2.0f * x); return 1.0f - 2.0f * __builtin_amdgcn_rcpf(e + 1.0f); }
__device__ __forceinline__ float softplusf(float x) { return fmaxf(x, 0.f) + log1pf(__expf(-fabsf(x))); }
__device__ __forceinline__ float wave_sum(float v) {
#pragma unroll
    for (int o = 1; o < 64; o <<= 1) v += __shfl_xor(v, o);
    return v;
}
template <int CTRL> __device__ __forceinline__ float dppf(float x) { return __builtin_bit_cast(float, __builtin_amdgcn_mov_dpp(__builtin_bit_cast(int, x), CTRL, 0xf, 0xf, true)); }
__device__ __forceinline__ float row16_sum(float v) {
    v += dppf<0xB1>(v); v += dppf<0x4E>(v); v += dppf<0x141>(v); v += dppf<0x140>(v); return v;
}
#define XB_TMO      128
#define XB_XCNT(j)  (256  + 64 * (j))
#define XB_XSUB(j)  (1280 + 64 * (j))
#define XB_XGEN(j)  (2304 + 64 * (j))
#define XB_TOP      3328
#define XB_TOPGEN   3392
#define XCD_BAR_WORDS 3456
#define XB_SPIN_CAP (1u << 18)

__device__ __forceinline__ unsigned xb_ld(unsigned* p)              { return __hip_atomic_load(p, __ATOMIC_RELAXED, __HIP_MEMORY_SCOPE_AGENT); }
__device__ __forceinline__ unsigned xb_add(unsigned* p, unsigned v) { return __hip_atomic_fetch_add(p, v, __ATOMIC_RELAXED, __HIP_MEMORY_SCOPE_AGENT); }
__device__ __forceinline__ unsigned xb_xcc_id() { return (unsigned)__builtin_amdgcn_s_getreg((3 << 11) | 20) & 0xFu; }
#define XB_SPIN(cond, bar) do { unsigned _sp = 0; while (cond) { __builtin_amdgcn_s_sleep(1); \
    if ((++_sp & 255u) == 0u) { if (xb_ld(&(bar)[XB_TMO])) break; if (_sp > XB_SPIN_CAP) { atomicAdd(&(bar)[XB_TMO], 1u); break; } } } } while (0)

struct XcdBarrier {
    unsigned* bar; unsigned x;
    volatile LAS unsigned* st;
};

__device__ __forceinline__ XcdBarrier xcd_barrier_post(unsigned* bar, volatile LAS unsigned* st) {
    XcdBarrier b; b.bar = bar; b.x = xb_xcc_id(); b.st = st;
    if (threadIdx.x == 0) (void)xb_add(&bar[XB_XCNT(b.x)], 1u);
    return b;
}
__device__ __forceinline__ void xcd_barrier_complete(unsigned* bar, unsigned x, unsigned& nloc, unsigned& nx) {
    const unsigned G = gridDim.x * gridDim.y * gridDim.z;
    unsigned sum, cnt, mine, sp = 0u;
    for (;;) {
        sum = 0u; cnt = 0u; mine = 0u;
#pragma unroll
        for (unsigned j = 0; j < 16; ++j) { const unsigned c = xb_ld(&bar[XB_XCNT(j)]); sum += c; cnt += (c > 0u) ? 1u : 0u; mine = (j == x) ? c : mine; }
        if (sum == G) break;
        __builtin_amdgcn_s_sleep(1);
        if ((++sp & 255u) == 0u) { if (xb_ld(&bar[XB_TMO])) break; if (sp > XB_SPIN_CAP) { atomicAdd(&bar[XB_TMO], 1u); break; } }
    }
    nloc = mine > 0u ? mine : 1u; nx = cnt > 0u ? cnt : 1u;
}

__device__ __forceinline__ void xcd_barrier(const XcdBarrier& b) {
    asm volatile("s_waitcnt vmcnt(0)" ::: "memory");
    __syncthreads();
    if (threadIdx.x == 0) {
        unsigned* bar = b.bar;
        __builtin_amdgcn_s_waitcnt(0);
        unsigned nloc = b.st[0], nx = b.st[1];
        if (nloc == 0u) { xcd_barrier_complete(bar, b.x, nloc, nx); b.st[0] = nloc; b.st[1] = nx; }
        const unsigned old = xb_add(&bar[XB_XSUB(b.x)], 1u);
        const unsigned gen = old / nloc;
        if (old + 1u == (gen + 1u) * nloc) {
            __builtin_amdgcn_fence(__ATOMIC_RELEASE, "agent");
            asm volatile("s_waitcnt vmcnt(0)" ::: "memory");
            const unsigned og = xb_add(&bar[XB_TOP], 1u);
            const unsigned tg = og / nx;
            if (og + 1u == (tg + 1u) * nx) xb_add(&bar[XB_TOPGEN], 1u);
            else XB_SPIN(xb_ld(&bar[XB_TOPGEN]) == tg, bar);
            __builtin_amdgcn_fence(__ATOMIC_ACQUIRE, "agent");
            xb_add(&bar[XB_XGEN(b.x)], 1u);
            asm volatile("s_waitcnt vmcnt(0)" ::: "memory");
        } else {
            XB_SPIN(xb_ld(&bar[XB_XGEN(b.x)]) == gen, bar);
            __builtin_amdgcn_fence(__ATOMIC_ACQUIRE, "agent");
            asm volatile("s_waitcnt vmcnt(0)" ::: "memory");
        }
    }
    __syncthreads();
}

struct Frame {
    LAS unsigned char* lds;
    volatile LAS unsigned* MISC;
    int tid, lane, wave, vcu, G;
};
struct Args { const float* in[39]; float* out; unsigned char* ws; int ph_lo, ph_hi; };
enum { I_X = 0, I_MEM, I_GMIX, I_WIN, I_MU, I_W0, I_W2, I_A0, I_A2, I_G2, I_KK, I_KA, I_RK, I_LNW, I_LNB, I_WRO, I_CONVW, I_CONVB, I_LWR, I_LBR, I_LWI, I_LBI, I_LAM, I_WLO,
       I_GMEM, I_WMK, I_WMV, I_WXO, I_WOUT, I_GFFN, I_WROUTER, I_BROUTER, I_WGATE, I_BGATE, I_WUP, I_BUP, I_WDOWN, I_BDOWN, I_GFINAL };


__device__ __forceinline__ const float* inp(int k) {
    typedef const volatile unsigned long long __attribute__((address_space(4))) ka_t;
    ka_t* ka = (ka_t*)__builtin_amdgcn_kernarg_segment_ptr();
    return (const float*)ka[k];
}
template <int NB> __device__ __forceinline__ void transpose_item(const float* W, int N, int k0, int n0, bf16* WT, int Kd, int drow0, int lane, int kdo = 0) {
    constexpr int LPR = NB / 4, G = 64 / LPR, KR = 64 / G;
    const int g = lane / LPR, c = lane % LPR;
    const GAS float* src = (const GAS float*)W + (size_t)(k0 + KR * g) * N + n0 + 4 * c;
    f32x4 ld[KR];
#pragma unroll
    for (int i = 0; i < KR; ++i) ld[i] = __builtin_nontemporal_load((const GAS f32x4*)(src + (size_t)i * N));
    GAS bf16* dst = (GAS bf16*)WT + (size_t)(drow0 + 4 * c) * Kd + kdo + k0 + KR * g;
#pragma unroll
    for (int j = 0; j < 4; ++j)
#pragma unroll
        for (int q = 0; q < KR / 8; ++q) { v4u o; o.x = pk2(ld[8 * q + 0][j], ld[8 * q + 1][j]); o.y = pk2(ld[8 * q + 2][j], ld[8 * q + 3][j]); o.z = pk2(ld[8 * q + 4][j], ld[8 * q + 5][j]); o.w = pk2(ld[8 * q + 6][j], ld[8 * q + 7][j]);
            *(GAS v4u*)(dst + (size_t)j * Kd + 8 * q) = o; }
}
__device__ __forceinline__ unsigned pk4_fp8(float a, float b, float c, float d) { int w = __builtin_amdgcn_cvt_pk_fp8_f32(a, b, 0, false); w = __builtin_amdgcn_cvt_pk_fp8_f32(c, d, w, true); return (unsigned)w; }
__device__ __forceinline__ void transpose_item_fp8(const float* W, int N, int k0, int n0, unsigned char* WT, int Kd, int drow0, int lane, float scale) {
    const int g = lane >> 4, c = lane & 15;
    const GAS float* src = (const GAS float*)W + (size_t)(k0 + 16 * g) * N + n0 + 4 * c;
    f32x4 ld[16];
#pragma unroll
    for (int i = 0; i < 16; ++i) ld[i] = __builtin_nontemporal_load((const GAS f32x4*)(src + (size_t)i * N)) * scale;
    GAS unsigned char* dst = (GAS unsigned char*)WT + (size_t)(drow0 + 4 * c) * Kd + k0 + 16 * g;
#pragma unroll
    for (int j = 0; j < 4; ++j) { v4u o; o.x = pk4_fp8(ld[0][j], ld[1][j], ld[2][j], ld[3][j]); o.y = pk4_fp8(ld[4][j], ld[5][j], ld[6][j], ld[7][j]); o.z = pk4_fp8(ld[8][j], ld[9][j], ld[10][j], ld[11][j]); o.w = pk4_fp8(ld[12][j], ld[13][j], ld[14][j], ld[15][j]);
        *(GAS v4u*)(dst + (size_t)j * Kd) = o; }
}
__device__ __forceinline__ void transpose_item_fp8_32(const float* W, int N, int k0, int n0, unsigned char* WT, int Kd, int drow0, int lane, float scale) {
    const int g = lane >> 3, c = lane & 7;
    const GAS float* src = (const GAS float*)W + (size_t)(k0 + 8 * g) * N + n0 + 4 * c;
    f32x4 ld[8];
#pragma unroll
    for (int i = 0; i < 8; ++i) ld[i] = __builtin_nontemporal_load((const GAS f32x4*)(src + (size_t)i * N)) * scale;
    GAS unsigned char* dst = (GAS unsigned char*)WT + (size_t)(drow0 + 4 * c) * Kd + k0 + 8 * g;
#pragma unroll
    for (int j = 0; j < 4; ++j) { v2u o; o.x = pk4_fp8(ld[0][j], ld[1][j], ld[2][j], ld[3][j]); o.y = pk4_fp8(ld[4][j], ld[5][j], ld[6][j], ld[7][j]); *(GAS v2u*)(dst + (size_t)j * Kd) = o; }
}
__device__ __forceinline__ void rms_row_to_bf16(const float* xrow, const float* gain, bf16* orow, int lane, unsigned char* orow8 = nullptr) {
    const GAS f32x4* xr = (const GAS f32x4*)xrow + lane; const GAS f32x4* gr = (const GAS f32x4*)gain + lane;
    f32x4 v[8]; float s = 0.f;
#pragma unroll
    for (int j = 0; j < 8; ++j) { v[j] = xr[64 * j]; s += (v[j].x * v[j].x + v[j].y * v[j].y) + (v[j].z * v[j].z + v[j].w * v[j].w); }
    const float rstd = 1.0f / sqrtf(wave_sum(s) * (1.f / D) + EPS);
    GAS v2u* o8 = (GAS v2u*)orow + lane;
#pragma unroll
    for (int j = 0; j < 8; ++j) { const f32x4 g = gr[64 * j]; v2u w; w.x = pk2(v[j].x * rstd * g.x, v[j].y * rstd * g.y); w.y = pk2(v[j].z * rstd * g.z, v[j].w * rstd * g.w); o8[64 * j] = w;
        if (orow8) ((GAS unsigned*)orow8)[lane + 64 * j] = pk4_fp8(v[j].x * rstd * g.x, v[j].y * rstd * g.y, v[j].z * rstd * g.z, v[j].w * rstd * g.w); }
}

__device__ __forceinline__ void p0_prologue(const Frame& F, const Args& a) {
    unsigned char* ws = a.ws;
    const int gw = F.vcu * NWAVES + F.wave, NGW = F.G * NWAVES;
    constexpr int I_IN = 32 * (IN_COLS / 32), I_MK = 32 * 32, I_BR = 16 * 64, I_O = 32 * 64;
    constexpr int NITEMS = I_IN + 2 * I_MK + 3 * I_BR + I_O;
    for (int it = gw; it < NITEMS; it += NGW) {
        int r = it;
        if (r < I_IN) { const int nb = IN_COLS / 32, kb = r / nb, n0 = 32 * (r % nb);
            if (n0 >= PC_G - 224) transpose_item_fp8_32(inp(I_WIN), IN_COLS, 64 * kb, n0, ws + WS_WIN8, D, n0 - (PC_G - 224), F.lane, 64.0f);
            else transpose_item<32>(inp(I_WIN), IN_COLS, 64 * kb, n0, (bf16*)(ws + WS_WIN), D, n0 + (n0 >= RWKV_COLS ? 224 : 0), F.lane);
            continue; } r -= I_IN;
        if (r < I_MK) { transpose_item<32>(inp(I_WMK), 1024, 64 * (r / 32), 32 * (r % 32), (bf16*)(ws + WS_WMKV), D, 32 * (r % 32), F.lane); continue; } r -= I_MK;
        if (r < I_MK) { transpose_item<32>(inp(I_WMV), 1024, 64 * (r / 32), 32 * (r % 32), (bf16*)(ws + WS_WMKV), D, 1024 + 32 * (r % 32), F.lane); continue; } r -= I_MK;
        if (r < I_BR) { transpose_item<32>(inp(I_WRO), 2048, 64 * (r / 64), 32 * (r % 64), (bf16*)(ws + WS_WBR), 3072, 32 * (r % 64), F.lane, 0); continue; } r -= I_BR;
        if (r < I_BR) { transpose_item<32>(inp(I_WLO), 2048, 64 * (r / 64), 32 * (r % 64), (bf16*)(ws + WS_WBR), 3072, 32 * (r % 64), F.lane, 1024); continue; } r -= I_BR;
        if (r < I_BR) { transpose_item<32>(inp(I_WXO), 2048, 64 * (r / 64), 32 * (r % 64), (bf16*)(ws + WS_WBR), 3072, 32 * (r % 64), F.lane, 2048); continue; } r -= I_BR;
        transpose_item<32>(inp(I_WOUT), 2048, 64 * (r / 64), 32 * (r % 64), (bf16*)(ws + WS_WO), D, 32 * (r % 64), F.lane);
    }
    for (int m = gw; m < T; m += NGW) rms_row_to_bf16(inp(I_X) + (size_t)m * D, inp(I_GMIX), (bf16*)(ws + WS_XN) + (size_t)m * D, F.lane, ws + WS_XN8 + (size_t)m * D);
    for (int m = gw; m < 512; m += NGW) rms_row_to_bf16(inp(I_MEM) + (size_t)m * D, inp(I_GMEM), (bf16*)(ws + WS_MN) + (size_t)m * D, F.lane);
    const int gt = F.vcu * (NWAVES * 64) + F.tid, NGT = F.G * NWAVES * 64;
    { bf16* wz = (bf16*)(ws + WS_WIN) + (size_t)RWKV_COLS * D; for (int i = gt; i < 224 * D / 2; i += NGT) ((GAS unsigned*)wz)[i] = 0u; }
    { bf16* wl = (bf16*)(ws + WS_WLORA);
      for (int i = gt; i < 3072 * LORA_K; i += NGT) { const int n = i / LORA_K, k = i % LORA_K; float v = 0.f;
          if (n < 1024) { if (k < 64) v = inp(I_W2)[k * 1024 + n]; }
          else if (n < 2048) { if (k >= 64 && k < 128) v = inp(I_A2)[(k - 64) * 1024 + (n - 1024)]; }
          else { if (k >= 128 && k < 288) v = inp(I_G2)[(k - 128) * 1024 + (n - 2048)]; }
          wl[i] = (bf16)f2bf(v); } }
    { const float* lam = inp(I_LAM); float* spl = (float*)(ws + WS_SPL); for (int i = gt; i < 1024; i += NGT) spl[i] = softplusf(-lam[i]); }
    { bf16* wr = (bf16*)(ws + WS_WR);
      for (int i = gt; i < 32 * D; i += NGT) { const int e = i / D, k = i % D; const float w = inp(I_WROUTER)[k * 32 + e]; const unsigned hi = f2bf(w); const float r = w - __builtin_bit_cast(float, hi << 16);
          wr[i] = (bf16)hi; wr[32 * D + i] = (bf16)f2bf(r); } }
    { const float* lwi_p = inp(I_LWI); const float* lwr_p = inp(I_LWR); bf16* lw = (bf16*)(ws + WS_LW);
      for (int i = gt; i < 2 * 16 * 4 * 2 * 64 * 8; i += NGT) { const int j = i & 7, ln = (i >> 3) & 63, ks = (i >> 9) & 1, vbo = (i >> 10) & 3, n = (i >> 12) & 15, mat = i >> 16;
          const int w = 32 * ks + 16 * (j >> 2) + 4 * (ln >> 4) + (j & 3), v = 16 * vbo + (ln & 15);
          lw[i] = (bf16)f2bf((mat ? lwi_p : lwr_p)[(n * 64 + w) * 64 + v]); } }
}

__device__ __forceinline__ void moe_weight_convert(const Frame& F, const Args& a, int gw, int NGW) {
    unsigned char* ws = a.ws;
    const float* wg = inp(I_WGATE); const float* wu = inp(I_WUP); const float* wd = inp(I_WDOWN);
    constexpr int PER = 1024;
    for (int it = gw; it < NE * 3 * PER; it += NGW) {
        const int e = it / (3 * PER), r = it % (3 * PER), which = r / PER, q = r % PER, k0 = 64 * (q / 32), n0 = 64 * (q % 32);
        if (which == 0) transpose_item_fp8(wg + (size_t)e * D * D, D, k0, n0, ws + WS_WGU + (size_t)e * 4096 * D, D, (n0 >> 7) * 256 + (n0 & 127), F.lane, 64.0f);
        else if (which == 1) transpose_item_fp8(wu + (size_t)e * D * D, D, k0, n0, ws + WS_WGU + (size_t)e * 4096 * D, D, (n0 >> 7) * 256 + 128 + (n0 & 127), F.lane, 64.0f);
        else transpose_item_fp8(wd + (size_t)e * D * D, D, k0, n0, ws + WS_WD + (size_t)e * 2048 * D, D, n0, F.lane, 64.0f);
    }
}

__device__ __forceinline__ void r1_lora_in(const Frame& F, const Args& a) {
    const bf16* P = (const bf16*)(a.ws + WS_P); bf16* L = (bf16*)(a.ws + WS_XN);
    const float* mu = inp(I_MU);
    const int gw = F.vcu * NWAVES + F.wave, NGW = F.G * NWAVES;
    for (int m = gw; m < T; m += NGW) {
        const bool first = (m % SEQ) == 0;
#pragma unroll
        for (int j = 0; j < 6; ++j) { const int k = F.lane + 64 * j; float o = 0.f;
            if (k < 288) { const int c = 3072 + k; const float cur = bf1(P[(size_t)m * NP + c]); const float prev = first ? 0.f : bf1(P[(size_t)(m - 1) * NP + c]);
                const float x = cur + (prev - cur) * mu[c]; o = k < 64 ? fast_tanh(x) : (k < 128 ? x : sigm(x)); }
            L[(size_t)m * LORA_K + k] = (bf16)f2bf(o); }
    }
}

constexpr int REC_F = 2816, REC_AT = 0, REC_RT = 512, REC_BKT = 1024, REC_WC = 2048, REC_N = 2112, REC_Q = 2176, REC_V8 = 2240;
__device__ __forceinline__ float wave_sum_fast(float v) { v = row16_sum(v); v += __shfl_xor(v, 16); v += __shfl_xor(v, 32); return v; }
__device__ __forceinline__ void r3_blocks(const Frame& F, const Args& a) {
    const GAS bf16* P = (const GAS bf16*)(a.ws + WS_P); const GAS float* LO = (const GAS float*)(a.ws + WS_LORAOUT);
    GAS float* REC = (GAS float*)(a.ws + WS_SCAN); GAS float* BON = (GAS float*)(a.ws + WS_BONUS);
    const GAS float* mu = (const GAS float*)inp(I_MU); const GAS float* w0 = (const GAS float*)inp(I_W0); const GAS float* a0 = (const GAS float*)inp(I_A0);
    const GAS float* kkp = (const GAS float*)inp(I_KK); const GAS float* kap = (const GAS float*)inp(I_KA); const GAS float* rkp = (const GAS float*)inp(I_RK);
    LAS float* G1 = (LAS float*)(F.lds + F.wave * 16384);
    LAS float* G2 = G1 + 2048;
    const int gw = F.vcu * NWAVES + F.wave, NGW = F.G * NWAVES, lane = F.lane;
    struct Raw { bf16 pr0, pk0, pv0, cr[8], ck[8], cv[8]; float lw[8], la[8], mur, muk, muv, w0c, a0c, kkw, kaw, rkw; };
#define R3_LOAD(R, it_) do { const int bh_ = (it_) >> 10, blk_ = (it_) & 1023, c_ = (bh_ & 15) * 64 + lane, m0_ = (bh_ >> 4) * SEQ + blk_ * 8; \
        R.mur = mu[c_]; R.muk = mu[1024 + c_]; R.muv = mu[2048 + c_]; R.w0c = w0[c_]; R.a0c = a0[c_]; R.kkw = kkp[c_]; R.kaw = kap[c_]; R.rkw = rkp[c_]; \
        { const GAS bf16* pp_ = P + (size_t)(m0_ - (blk_ > 0 ? 1 : 0)) * NP; R.pr0 = pp_[c_]; R.pk0 = pp_[1024 + c_]; R.pv0 = pp_[2048 + c_]; } \
        _Pragma("unroll") for (int t_ = 0; t_ < 8; ++t_) { const GAS bf16* pc_ = P + (size_t)(m0_ + t_) * NP; R.cr[t_] = pc_[c_]; R.ck[t_] = pc_[1024 + c_]; R.cv[t_] = pc_[2048 + c_]; \
            R.lw[t_] = LO[(size_t)(m0_ + t_) * 3072 + c_]; R.la[t_] = LO[(size_t)(m0_ + t_) * 3072 + 1024 + c_]; } } while (0)
    Raw cur; if (gw < 32 * 1024) R3_LOAD(cur, gw);
#pragma unroll 1
    for (int it = gw; it < 32 * 1024; it += NGW) {
        const int bh = it >> 10, blk = it & 1023, b = bh >> 4, h = bh & 15, m0 = b * SEQ + blk * 8;
        Raw nxt = cur; if (it + NGW < 32 * 1024) R3_LOAD(nxt, it + NGW);
        const float mur = cur.mur, muk = cur.muk, muv = cur.muv, w0c = cur.w0c, a0c = cur.a0c, kkw = cur.kkw, kaw = cur.kaw, rkw = cur.rkw;
        float w[8], av[8], bv[8], kv[8], rv[8], vv[8], ag[8], kk[8], n2[8], bo[8];
        float pr = 0.f, pk = 0.f, pv = 0.f;
        if (blk > 0) { pr = bf1(cur.pr0); pk = bf1(cur.pk0); pv = bf1(cur.pv0); }
#pragma unroll
        for (int t = 0; t < 8; ++t) { const float cr = bf1(cur.cr[t]), ck = bf1(cur.ck[t]), cv = bf1(cur.cv[t]);
            const float r = cr + (pr - cr) * mur, k = ck + (pk - ck) * muk, v = cv + (pv - cv) * muv; pr = cr; pk = ck; pv = cv;
            const float wpre = w0c + cur.lw[t], apre = a0c + cur.la[t];
            w[t] = __expf(-0.6065306597126334f * __builtin_amdgcn_rcpf(1.0f + __expf(-wpre)));
            ag[t] = __builtin_amdgcn_rcpf(1.0f + __expf(-apre));
            kk[t] = k * kkw; n2[t] = kk[t] * kk[t];
            kv[t] = k * (1.0f + (ag[t] - 1.0f) * kaw); rv[t] = r; vv[t] = v; bo[t] = r * kv[t] * rkw; }
#pragma unroll
        for (int t = 0; t < 8; ++t) { n2[t] = wave_sum_fast(n2[t]); bo[t] = wave_sum_fast(bo[t]); }
#pragma unroll
        for (int t = 0; t < 8; ++t) { const float kkn = kk[t] * (1.0f / sqrtf(fmaxf(n2[t], 1e-24f))); av[t] = -kkn; bv[t] = kkn * ag[t]; if (lane == 0) BON[(m0 + t) * 16 + h] = bo[t]; }
        float Pp[8]; Pp[0] = w[0];
#pragma unroll
        for (int t = 1; t < 8; ++t) Pp[t] = Pp[t - 1] * w[t];
        float bch[8], kch[8], ah[8], rh[8];
#pragma unroll
        for (int t = 0; t < 8; ++t) { const float pin = __builtin_amdgcn_rcpf(Pp[t]); bch[t] = bv[t] * pin; kch[t] = kv[t] * pin; ah[t] = av[t] * (t > 0 ? Pp[t - 1] : 1.0f); rh[t] = rv[t] * Pp[t]; }
        const int pos = (lane & 3) * 16 + (lane >> 2);
#pragma unroll
        for (int t = 0; t < 8; ++t) { G1[t * 64 + pos] = bch[t]; G1[(8 + t) * 64 + pos] = kch[t]; G1[(16 + t) * 64 + pos] = ah[t]; G1[(24 + t) * 64 + pos] = rh[t]; }
        LDS_WAIT(); asm volatile("" ::: "memory");
        f32x4 fa[4], fb[4];
#pragma unroll
        for (int q = 0; q < 4; ++q) { fa[q] = *(const LAS f32x4*)(G1 + (lane & 15) * 64 + (lane >> 4) * 16 + 4 * q); fb[q] = *(const LAS f32x4*)(G1 + (16 + (lane & 15)) * 64 + (lane >> 4) * 16 + 4 * q); }
        f32x4 dacc = {0.f, 0.f, 0.f, 0.f};
#pragma unroll
        for (int s2 = 0; s2 < 16; ++s2) dacc = __builtin_amdgcn_mfma_f32_16x16x4f32(fa[s2 >> 2][s2 & 3], fb[s2 >> 2][s2 & 3], dacc, 0, 0, 0);
        *(LAS f32x4*)(G2 + (lane & 15) * 16 + 4 * (lane >> 4)) = dacc;
        LDS_WAIT(); asm volatile("" ::: "memory");
        float M[8][8];
        { float Lm[8][8];
#pragma unroll
          for (int t = 1; t < 8; ++t) { const f32x4 l0 = *(const LAS f32x4*)(G2 + t * 16), l1 = *(const LAS f32x4*)(G2 + t * 16 + 4);
#pragma unroll
              for (int i = 0; i < 4; ++i) { Lm[t][i] = l0[i]; Lm[t][4 + i] = l1[i]; } }
#pragma unroll
          for (int t = 0; t < 8; ++t) { M[t][t] = 1.0f;
#pragma unroll
              for (int i = t - 1; i >= 0; --i) { float acc = 0.f;
#pragma unroll
                  for (int j = i; j < t; ++j) acc += Lm[t][j] * M[j][i];
                  M[t][i] = acc; } } }
        GAS float* rec = REC + ((size_t)bh * 1024 + blk) * REC_F; GAS bf16* recb = (GAS bf16*)rec;
#pragma unroll
        for (int t = 0; t < 8; ++t) { float acc = 0.f;
#pragma unroll
            for (int i = 0; i <= t; ++i) acc += M[t][i] * ah[i];
            { const unsigned hi = f2bf(acc); recb[t * 64 + lane] = (bf16)hi; recb[1024 + t * 64 + lane] = (bf16)f2bf(acc - __builtin_bit_cast(float, hi << 16)); } }
        float Nm[8][8];
        { float Km[8][8];
#pragma unroll
          for (int t = 1; t < 8; ++t) { const f32x4 l0 = *(const LAS f32x4*)(G2 + t * 16 + 8), l1 = *(const LAS f32x4*)(G2 + t * 16 + 12);
#pragma unroll
              for (int i = 0; i < 4; ++i) { Km[t][i] = l0[i]; Km[t][4 + i] = l1[i]; } }
#pragma unroll
          for (int t = 0; t < 8; ++t)
#pragma unroll
              for (int i = 0; i < 8; ++i) { float acc = 0.f;
                  if (i < t) {
#pragma unroll
                      for (int j = i + 1; j <= t; ++j) acc += M[t][j] * Km[j][i]; }
                  Nm[t][i] = acc; } }
        float rb[8][8];
#pragma unroll
        for (int t = 0; t < 8; ++t) { const f32x4 l0 = *(const LAS f32x4*)(G2 + (8 + t) * 16), l1 = *(const LAS f32x4*)(G2 + (8 + t) * 16 + 4);
#pragma unroll
            for (int i = 0; i < 4; ++i) { rb[t][i] = l0[i]; rb[t][4 + i] = l1[i]; } }
#pragma unroll
        for (int t = 0; t < 8; ++t) { float acc = rh[t];
#pragma unroll
            for (int i = 0; i <= t; ++i) { float rm = 0.f;
#pragma unroll
                for (int j = i; j <= t; ++j) rm += rb[t][j] * M[j][i];
                acc += rm * ah[i]; }
            { const unsigned hi = f2bf(acc); recb[(8 + t) * 64 + lane] = (bf16)hi; recb[1024 + (8 + t) * 64 + lane] = (bf16)f2bf(acc - __builtin_bit_cast(float, hi << 16)); } }
        float Qm[8][8];
#pragma unroll
        for (int t = 0; t < 8; ++t) { const f32x4 l0 = *(const LAS f32x4*)(G2 + (8 + t) * 16 + 8), l1 = *(const LAS f32x4*)(G2 + (8 + t) * 16 + 12);
#pragma unroll
            for (int i = 0; i < 8; ++i) { float acc = 0.f;
                if (i <= t) { acc = i < 4 ? l0[i & 3] : l1[i & 3];
#pragma unroll
                    for (int j = i + 1; j <= t; ++j) acc += rb[t][j] * Nm[j][i]; }
                Qm[t][i] = acc; } }
        { unsigned hw[8], lw[8];
#pragma unroll
          for (int i2 = 0; i2 < 8; ++i2) { const float x0 = (i2 < 4 ? bch[2 * i2] : kch[2 * i2 - 8]) * Pp[7], x1 = (i2 < 4 ? bch[2 * i2 + 1] : kch[2 * i2 - 7]) * Pp[7];
              const unsigned h0 = f2bf(x0), h1 = f2bf(x1); hw[i2] = h0 | (h1 << 16); lw[i2] = f2bf(x0 - __builtin_bit_cast(float, h0 << 16)) | (f2bf(x1 - __builtin_bit_cast(float, h1 << 16)) << 16); }
          GAS v4u* bk_ = (GAS v4u*)(recb + 2048 + lane * 32);
#pragma unroll
          for (int q4 = 0; q4 < 4; ++q4) bk_[q4] = (v4u){hw[2 * q4], hw[2 * q4 + 1], lw[2 * q4], lw[2 * q4 + 1]}; }
        rec[REC_WC + lane] = Pp[7];
        if (lane == 0) {
#pragma unroll
            for (int t = 0; t < 8; ++t) { *(GAS f32x4*)(rec + REC_N + t * 8) = (f32x4){Nm[t][0], Nm[t][1], Nm[t][2], Nm[t][3]}; *(GAS f32x4*)(rec + REC_N + t * 8 + 4) = (f32x4){Nm[t][4], Nm[t][5], Nm[t][6], Nm[t][7]};
                *(GAS f32x4*)(rec + REC_Q + t * 8) = (f32x4){Qm[t][0], Qm[t][1], Qm[t][2], Qm[t][3]}; *(GAS f32x4*)(rec + REC_Q + t * 8 + 4) = (f32x4){Qm[t][4], Qm[t][5], Qm[t][6], Qm[t][7]}; } }
        *(GAS f32x4*)(rec + REC_V8 + lane * 8) = (f32x4){vv[0], vv[1], vv[2], vv[3]}; *(GAS f32x4*)(rec + REC_V8 + lane * 8 + 4) = (f32x4){vv[4], vv[5], vv[6], vv[7]};
        LDS_WAIT(); asm volatile("" ::: "memory");
        cur = nxt;
    }
#undef R3_LOAD
}

constexpr int SC_NS = 12, SC_RB = REC_F * 4, SC_SYNC = SC_NS * SC_RB;
__device__ __forceinline__ unsigned lds_word(const volatile LAS unsigned* p) { return (unsigned)__builtin_amdgcn_readfirstlane((int)*p); }
__device__ __forceinline__ bool scan_wg(int& bh, int& quarter) { const int bx = blockIdx.x; if (gridDim.x != 256 || ((bx >> 3) & 1)) return false; const int slot = bx >> 4; bh = (bx & 7) * 4 + (slot >> 2); quarter = slot & 3; return true; }
__device__ __forceinline__ void r4_feeder(const Frame& F, const Args& a, int bh) {
    const GAS char* gsrc = (const GAS char*)(a.ws + WS_SCAN) + (size_t)bh * 1024 * SC_RB + F.lane * 16;
    LAS unsigned char* ring = F.lds;
    volatile LAS unsigned* sync = (volatile LAS unsigned*)(F.lds + SC_SYNC);
    bool dead = false;
    __builtin_amdgcn_s_setprio(2);
#pragma unroll 1
    for (int B = 0; B < 1024; ++B) {
        if (B >= SC_NS && !dead) { unsigned spins = 0; for (;;) { const unsigned d0 = lds_word(sync + 16); if ((int)d0 > B - SC_NS) break; if (++spins > (1u << 20)) { dead = true; break; } __builtin_amdgcn_s_sleep(2); } }
        LAS unsigned char* slot = ring + (B % SC_NS) * SC_RB;
#pragma unroll
        for (int q = 0; q < 11; ++q) __builtin_amdgcn_global_load_lds((const GAS unsigned*)(gsrc + (size_t)B * SC_RB + q * 1024), (LAS unsigned*)(slot + q * 1024), 16, 0, 0);
        asm volatile("s_waitcnt vmcnt(55)" ::: "memory");
        if (B >= 5 && F.lane == 0) sync[0] = (unsigned)(B - 4);
    }
    asm volatile("s_waitcnt vmcnt(0)" ::: "memory");
    if (F.lane == 0) sync[0] = 1024u;
    __builtin_amdgcn_s_setprio(0);
}
template <int VAR> __device__ __forceinline__ void r4_scan(const Frame& F, const Args& a, int bh, int quarter) {
    float* YT = (float*)(a.ws + WS_XN);
    constexpr int RB = SC_RB;
    __builtin_amdgcn_s_setprio(3);
    const int r = F.lane & 15, q = F.lane >> 4, rowg = quarter * 16 + r;
    LAS unsigned char* ring = F.lds;
    volatile LAS unsigned* sync = (volatile LAS unsigned*)(F.lds + SC_SYNC);
    const LAS unsigned char* pVH = ring + (r * 64 + 4 * q) * 2;
    const LAS unsigned char* pNQ = ring + (REC_N + r * 8 + 2 * q) * 4;
    const LAS unsigned char* pVb = ring + (REC_V8 + rowg * 8 + 2 * q) * 4;
    const LAS unsigned char* pV4 = ring + (REC_V8 + rowg * 8 + 4 * (q & 1)) * 4;
    const LAS unsigned char* pBK = ring + 4096 + r * 64 + 16 * q;
    const LAS unsigned char* pWC = ring + (REC_WC + 4 * q) * 4;
    unsigned have = 0; bool dead = (VAR == 1);
#define SC_NEED(n) do { unsigned spins_ = 0; while (have < (unsigned)(n) && !dead) { have = lds_word(sync); if (have >= (unsigned)(n)) break; if (++spins_ > (1u << 20)) { dead = true; break; } __builtin_amdgcn_s_sleep(1); } } while (0)
    f32x4 S[4];
#pragma unroll
    for (int kb = 0; kb < 4; ++kb) S[kb] = (f32x4){0.f, 0.f, 0.f, 0.f};
    GAS float* yrow = (GAS float*)YT + (size_t)(bh * 64 + rowg) * SEQ + 4 * (q & 1);
#define SC_LD(vh_, vl_, nq_, vb_, v4_, bk_, wc_, so_) do { _Pragma("unroll") for (int h_ = 0; h_ < 2; ++h_) { const v2u a_ = *(const LAS v2u*)(pVH + (so_) + 64 * h_), b_ = *(const LAS v2u*)(pVH + (so_) + 64 * h_ + 32); vh_[h_] = (v4u){a_.x, a_.y, b_.x, b_.y}; \
            const v2u c_ = *(const LAS v2u*)(pVH + (so_) + 2048 + 64 * h_), d_ = *(const LAS v2u*)(pVH + (so_) + 2048 + 64 * h_ + 32); vl_[h_] = (v4u){c_.x, c_.y, d_.x, d_.y}; } \
        nq_ = *(const LAS f32x2*)(pNQ + (so_)); vb_ = *(const LAS f32x2*)(pVb + (so_)); v4_ = *(const LAS f32x4*)(pV4 + (so_)); \
        _Pragma("unroll") for (int kb_ = 0; kb_ < 4; ++kb_) { bk_[kb_] = *(const LAS v4u*)(pBK + (so_) + kb_ * 1024); wc_[kb_] = *(const LAS f32x4*)(pWC + (so_) + kb_ * 64); } } while (0)
    v4u vhS[2][2], vlS[2][2], bkS[2][4]; f32x4 wcS[2][4], v4S[2]; f32x2 nqS[2], vbS[2];
    SC_NEED(1); asm volatile("" ::: "memory");
    SC_LD(vhS[0], vlS[0], nqS[0], vbS[0], v4S[0], bkS[0], wcS[0], 0);
#pragma unroll 1
    for (int k0 = 0; k0 < 1024; k0 += SC_NS) {
#pragma unroll
        for (int u = 0; u < SC_NS; ++u) { if (k0 + u >= 1024) break; const int sn = ((u + 1) % SC_NS) * RB; constexpr int dummy_ = 0; (void)dummy_;
            v4u (&vh)[2] = vhS[u & 1]; v4u (&vl)[2] = vlS[u & 1]; v4u (&bk)[4] = bkS[u & 1]; f32x4 (&wc)[4] = wcS[u & 1]; const f32x4 v4 = v4S[u & 1]; const f32x2 nq = nqS[u & 1], vb = vbS[u & 1];
            v4u shi[2], slo[2];
#pragma unroll
            for (int h = 0; h < 2; ++h) {
                unsigned hw_[4], lw_[4];
#pragma unroll
                for (int p = 0; p < 4; ++p) { const f32x4 sv = S[2 * h + (p >> 1)]; const float x0 = sv[2 * (p & 1)], x1 = sv[2 * (p & 1) + 1];
                    hw_[p] = __builtin_amdgcn_perm(__builtin_bit_cast(unsigned, x1), __builtin_bit_cast(unsigned, x0), 0x07060302u);
                    const float l0 = x0 - __builtin_bit_cast(float, __builtin_bit_cast(unsigned, x0) & 0xffff0000u), l1 = x1 - __builtin_bit_cast(float, __builtin_bit_cast(unsigned, x1) & 0xffff0000u);
                    lw_[p] = pg8::cvt_pk_bf16(l0, l1); }
                shi[h] = (v4u){hw_[0], hw_[1], hw_[2], hw_[3]}; slo[h] = (v4u){lw_[0], lw_[1], lw_[2], lw_[3]}; }
            f32x4 a0 = {0.f, 0.f, 0.f, 0.f}, a1 = {0.f, 0.f, 0.f, 0.f}, a2 = {0.f, 0.f, 0.f, 0.f}, ac = {0.f, 0.f, 0.f, 0.f};
#pragma unroll
            for (int h = 0; h < 2; ++h) { a0 = __builtin_amdgcn_mfma_f32_16x16x32_bf16(__builtin_bit_cast(bf16x8, vh[h]), __builtin_bit_cast(bf16x8, shi[h]), a0, 0, 0, 0);
                a1 = __builtin_amdgcn_mfma_f32_16x16x32_bf16(__builtin_bit_cast(bf16x8, vl[h]), __builtin_bit_cast(bf16x8, shi[h]), a1, 0, 0, 0);
                a2 = __builtin_amdgcn_mfma_f32_16x16x32_bf16(__builtin_bit_cast(bf16x8, vh[h]), __builtin_bit_cast(bf16x8, slo[h]), a2, 0, 0, 0); }
            ac = __builtin_amdgcn_mfma_f32_16x16x4f32(nq[0], vb[0], ac, 0, 0, 0); ac = __builtin_amdgcn_mfma_f32_16x16x4f32(nq[1], vb[1], ac, 0, 0, 0);
            SC_NEED(k0 + u + 2 <= 1024 ? k0 + u + 2 : 1024); asm volatile("" ::: "memory");
            SC_LD(vhS[(u + 1) & 1], vlS[(u + 1) & 1], nqS[(u + 1) & 1], vbS[(u + 1) & 1], v4S[(u + 1) & 1], bkS[(u + 1) & 1], wcS[(u + 1) & 1], sn);
            asm volatile("" ::: "memory");
            const f32x4 dd = (a0 + ac) + (a1 + a2);
            if (q >= 2) *(GAS f32x4*)(yrow + (k0 + u) * 8) = dd;
            const f32x4 b2 = q >= 2 ? v4 : dd;
            v4u svh, svl;
            { const unsigned h01 = __builtin_amdgcn_perm(__builtin_bit_cast(unsigned, b2[1]), __builtin_bit_cast(unsigned, b2[0]), 0x07060302u), h23 = __builtin_amdgcn_perm(__builtin_bit_cast(unsigned, b2[3]), __builtin_bit_cast(unsigned, b2[2]), 0x07060302u);
              float l_[4];
#pragma unroll
              for (int i = 0; i < 4; ++i) l_[i] = b2[i] - __builtin_bit_cast(float, __builtin_bit_cast(unsigned, b2[i]) & 0xffff0000u);
              svh = (v4u){h01, h23, h01, h23}; svl = (v4u){pg8::cvt_pk_bf16(l_[0], l_[1]), pg8::cvt_pk_bf16(l_[2], l_[3]), 0u, 0u}; }
            f32x4 n[4];
#pragma unroll
            for (int kb = 0; kb < 4; ++kb) n[kb] = S[kb] * wc[kb];
#pragma unroll
            for (int kb = 0; kb < 4; ++kb) n[kb] = __builtin_amdgcn_mfma_f32_16x16x32_bf16(__builtin_bit_cast(bf16x8, bk[kb]), __builtin_bit_cast(bf16x8, svh), n[kb], 0, 0, 0);
#pragma unroll
            for (int kb = 0; kb < 4; ++kb) n[kb] = __builtin_amdgcn_mfma_f32_16x16x32_bf16(__builtin_bit_cast(bf16x8, bk[kb]), __builtin_bit_cast(bf16x8, svl), n[kb], 0, 0, 0);
#pragma unroll
            for (int kb = 0; kb < 4; ++kb) S[kb] = n[kb];
            asm volatile("" : "+v"(S[0]), "+v"(S[1]), "+v"(S[2]), "+v"(S[3]) :: "memory");
            if (F.lane == 0) sync[16] = (unsigned)(k0 + u + 1);
        }
    }
#undef SC_LD
#undef SC_NEED
    __builtin_amdgcn_s_setprio(0);
}

__device__ __forceinline__ void r5_finish(const Frame& F, const Args& a) {
    const float* YT = (const float*)(a.ws + WS_XN); const float* LO = (const float*)(a.ws + WS_LORAOUT); const bf16* P = (const bf16*)(a.ws + WS_P); const float* BON = (const float*)(a.ws + WS_BONUS);
    bf16* YA = (bf16*)(a.ws + WS_YABC);
    LAS float* scr = (LAS float*)(F.lds + F.wave * 16640);
    const int gw = F.vcu * NWAVES + F.wave, NGW = F.G * NWAVES;
    for (int it = gw; it < 32 * 128; it += NGW) {
        const int bh = it >> 7, tt = it & 127, t0 = tt * 64, b = bh >> 4, h = bh & 15;
        float y[64]; float s = 0.f;
#pragma unroll
        for (int v = 0; v < 64; ++v) { y[v] = YT[(size_t)(bh * 64 + v) * SEQ + t0 + F.lane]; s += y[v]; }
        const float mean = s * (1.f / 64.f); float q = 0.f;
#pragma unroll
        for (int v = 0; v < 64; ++v) { const float d = y[v] - mean; q += d * d; }
        const float rstd = 1.0f / sqrtf(q * (1.f / 64.f) + GN_EPS);
#pragma unroll
        for (int v = 0; v < 64; ++v) scr[F.lane * 65 + v] = (y[v] - mean) * rstd;
        LDS_WAIT(); asm volatile("" ::: "memory");
        { const int ts = F.lane >> 4, cq = F.lane & 15, c = h * 64 + 4 * cq;
          const f32x4 lw = *(const GAS f32x4*)((const GAS float*)inp(I_LNW) + c), lb = *(const GAS f32x4*)((const GAS float*)inp(I_LNB) + c), muv = *(const GAS f32x4*)((const GAS float*)inp(I_MU) + 2048 + c);
#pragma unroll 4
          for (int tg = 0; tg < 16; ++tg) { const int ti = 4 * tg + ts, m = b * SEQ + t0 + ti;
              f32x4 yn; yn[0] = scr[ti * 65 + 4 * cq]; yn[1] = scr[ti * 65 + 4 * cq + 1]; yn[2] = scr[ti * 65 + 4 * cq + 2]; yn[3] = scr[ti * 65 + 4 * cq + 3];
              const v2u cw = *(const GAS v2u*)((const GAS bf16*)P + (size_t)m * NP + 2048 + c); v2u pw = cw; if (m % SEQ != 0) pw = *(const GAS v2u*)((const GAS bf16*)P + (size_t)(m - 1) * NP + 2048 + c);
              const f32x4 cv = {bflo(cw.x), bfhi(cw.x), bflo(cw.y), bfhi(cw.y)}; f32x4 pv = {bflo(pw.x), bfhi(pw.x), bflo(pw.y), bfhi(pw.y)}; if (m % SEQ == 0) pv = (f32x4){0.f, 0.f, 0.f, 0.f};
              const f32x4 vsh = cv + (pv - cv) * muv;
              const f32x4 g = *(const GAS f32x4*)((const GAS float*)LO + (size_t)m * 3072 + 2048 + c); const float bon = BON[m * 16 + h];
              const f32x4 o = (yn * lw + lb + vsh * bon) * g;
              v2u w; w.x = pk2(o[0], o[1]); w.y = pk2(o[2], o[3]); *(GAS v2u*)((GAS bf16*)YA + (size_t)m * 3072 + c) = w; } }
        LDS_WAIT(); asm volatile("" ::: "memory");
    }
}

__device__ __forceinline__ float gelu_tanh(float x) { const float u = 0.7978845608028654f * (x + 0.044715f * x * x * x); return 0.5f * x * (1.0f + fast_tanh(u)); }
template <int CTRL> __device__ __forceinline__ float dpp_keep(float old, float x) { return __builtin_bit_cast(float, __builtin_amdgcn_update_dpp(__builtin_bit_cast(int, old), __builtin_bit_cast(int, x), CTRL, 0xf, 0xf, false)); }
template <bool FINAL> __device__ __forceinline__ void lru_pass(const Frame& F, const Args& a, int gw, int NGW) {
    const bf16* P = (const bf16*)(a.ws + WS_P); const bf16* LW = (const bf16*)(a.ws + WS_LW);
    float* CA = (float*)(a.ws + WS_LRUC); float* CB = CA + 256 * 1024; const float* HIN = CB + 256 * 1024;
    bf16* YB = (bf16*)(a.ws + WS_YABC) + 1024;
    const GAS float* lbr_p = (const GAS float*)inp(I_LBR); const GAS float* lbi_p = (const GAS float*)inp(I_LBI); const GAS float* spl_p = (const GAS float*)(a.ws + WS_SPL);
    const GAS float* cvb_p = (const GAS float*)inp(I_CONVB); const GAS float* cvw_p = (const GAS float*)inp(I_CONVW);
    const int tq = F.lane & 15, kq = F.lane >> 4;
    for (int it = gw; it < 256 * 16; it += NGW) {
        const int tt = it >> 4, n = it & 15, m0 = tt * 64, cb = n * 64 + 4 * kq;
        const bool seq0 = (m0 % SEQ) == 0;
        float hcar[4][4];
        float aprod[4][4];
#pragma unroll
        for (int vb = 0; vb < 4; ++vb)
#pragma unroll
            for (int i = 0; i < 4; ++i) { hcar[vb][i] = FINAL ? HIN[tt * 1024 + cb + 16 * vb + i] : 0.f; aprod[vb][i] = 1.f; }
#pragma unroll 1
        for (int tb = 0; tb < 4; ++tb) {
            asm volatile("" ::: "memory");
            const int m = m0 + 16 * tb + tq, tseq = m % SEQ;
            f32x4 xc[4];
#pragma unroll
            for (int vb = 0; vb < 4; ++vb) { const int c = cb + 16 * vb; f32x4 acc = *(const GAS f32x4*)(cvb_p + c);
#pragma unroll
                for (int j = 0; j < 4; ++j) { if (tseq - j >= 0) { const v2u pw = *(const GAS v2u*)((const GAS bf16*)P + (size_t)(m - j) * NP + PC_LX + c); const f32x4 cw = *(const GAS f32x4*)(cvw_p + j * 1024 + c);
                        acc[0] += cw[0] * bflo(pw.x); acc[1] += cw[1] * bfhi(pw.x); acc[2] += cw[2] * bflo(pw.y); acc[3] += cw[3] * bfhi(pw.y); } }
                xc[vb] = acc; }
            bf16x8 bfrag[2];
#pragma unroll
            for (int ks = 0; ks < 2; ++ks) { v4u w; w.x = pk2(xc[2 * ks][0], xc[2 * ks][1]); w.y = pk2(xc[2 * ks][2], xc[2 * ks][3]); w.z = pk2(xc[2 * ks + 1][0], xc[2 * ks + 1][1]); w.w = pk2(xc[2 * ks + 1][2], xc[2 * ks + 1][3]); bfrag[ks] = __builtin_bit_cast(bf16x8, w); }
#pragma unroll
            for (int vb = 0; vb < 4; ++vb) {
                f32x4 gr = {0.f, 0.f, 0.f, 0.f}, gi = {0.f, 0.f, 0.f, 0.f};
#pragma unroll
                for (int ks = 0; ks < 2; ++ks) { const bf16x8 wr_ = *(const bf16x8*)(LW + ((((size_t)(0 * 16 + n) * 4 + vb) * 2 + ks) * 64 + F.lane) * 8); const bf16x8 wi_ = *(const bf16x8*)(LW + ((((size_t)(1 * 16 + n) * 4 + vb) * 2 + ks) * 64 + F.lane) * 8);
                    gr = __builtin_amdgcn_mfma_f32_16x16x32_bf16(wr_, bfrag[ks], gr, 0, 0, 0); gi = __builtin_amdgcn_mfma_f32_16x16x32_bf16(wi_, bfrag[ks], gi, 0, 0, 0); }
                const int c = cb + 16 * vb;
                const f32x4 brv = *(const GAS f32x4*)(lbr_p + c), biv = *(const GAS f32x4*)(lbi_p + c); const f32x4 spl = *(const GAS f32x4*)(spl_p + c);
                v2u pyw; if (FINAL) pyw = *(const v2u*)(P + (size_t)m * NP + PC_LY + c);
                float hout[4];
#pragma unroll
                for (int i = 0; i < 4; ++i) {
                    const float g_r = sigm(gr[i] + brv[i]), g_i = sigm(gi[i] + biv[i]);
                    const float log_a = -8.0f * g_r * spl[i];
                    float av = __expf(log_a); float mult = __builtin_amdgcn_sqrtf(fmaxf(1.0f - av * av, 0.f)); if (tseq == 0) mult = 1.0f;
                    float bv = mult * g_i * xc[vb][i];
                    { float pa = dpp_keep<0x111>(1.0f, av), pb = dpp_keep<0x111>(0.0f, bv); bv = av * pb + bv; av = av * pa; }
                    { float pa = dpp_keep<0x112>(1.0f, av), pb = dpp_keep<0x112>(0.0f, bv); bv = av * pb + bv; av = av * pa; }
                    { float pa = dpp_keep<0x114>(1.0f, av), pb = dpp_keep<0x114>(0.0f, bv); bv = av * pb + bv; av = av * pa; }
                    { float pa = dpp_keep<0x118>(1.0f, av), pb = dpp_keep<0x118>(0.0f, bv); bv = av * pb + bv; av = av * pa; }
                    const float hv = bv + av * hcar[vb][i];
                    const int l15 = (F.lane & 48) | 15;
                    const float hend = __shfl(hv, l15), aend = __shfl(av, l15);
                    hcar[vb][i] = hend; if (!FINAL) aprod[vb][i] *= aend; hout[i] = hv; }
                if (FINAL) { const float y0 = hout[0] * gelu_tanh(bflo(pyw.x)), y1 = hout[1] * gelu_tanh(bfhi(pyw.x)), y2 = hout[2] * gelu_tanh(bflo(pyw.y)), y3 = hout[3] * gelu_tanh(bfhi(pyw.y));
                    v2u w; w.x = pk2(y0, y1); w.y = pk2(y2, y3); *(v2u*)(YB + (size_t)m * 3072 + c) = w; }
            }
        }
        if (!FINAL && tq == 0) {
#pragma unroll
            for (int vb = 0; vb < 4; ++vb) { f32x4 pa, pb;
#pragma unroll
                for (int i = 0; i < 4; ++i) { pa[i] = aprod[vb][i]; pb[i] = hcar[vb][i]; }
                *(f32x4*)(CA + tt * 1024 + cb + 16 * vb) = pa; *(f32x4*)(CB + tt * 1024 + cb + 16 * vb) = pb; }
        }
        (void)seq0;
    }
}
__device__ __forceinline__ void lru_carry(const Frame& F, const Args& a) {
    const float* CA = (const float*)(a.ws + WS_LRUC); const float* CB = CA + 256 * 1024; float* HIN = (float*)CB + 256 * 1024;
    const int gt = F.vcu * (NWAVES * 64) + F.tid;
    if (gt < 2048) { const int b = gt >> 10, c = gt & 1023; float h = 0.f;
#pragma unroll 1
        for (int k0 = 0; k0 < 128; k0 += 32) { float ca[32], cb[32];
#pragma unroll
            for (int j = 0; j < 32; ++j) { const int tt = b * 128 + k0 + j; ca[j] = CA[tt * 1024 + c]; cb[j] = CB[tt * 1024 + c]; }
#pragma unroll
            for (int j = 0; j < 32; ++j) { const int tt = b * 128 + k0 + j; HIN[tt * 1024 + c] = h; h = ca[j] * h + cb[j]; } } }
}

__device__ __forceinline__ void xattn_phase(const Frame& F, const Args& a, int gw, int NGW) {
    const bf16* P = (const bf16*)(a.ws + WS_P); const bf16* KM = (const bf16*)(a.ws + WS_KMEM); const bf16* VT = (const bf16*)(a.ws + WS_VT);
    bf16* YC = (bf16*)(a.ws + WS_YABC) + 2048;
    const int tq = F.lane & 15, kq = F.lane >> 4;
    for (int it = gw; it < 4 * 512; it += NGW) {
        const int h = it >> 9, tg = it & 511, m0 = tg * 32, b = m0 / SEQ;
        bf16x8 qf[2][8];
#pragma unroll
        for (int g = 0; g < 2; ++g)
#pragma unroll
            for (int ks = 0; ks < 8; ++ks) qf[g][ks] = *(const bf16x8*)(P + (size_t)(m0 + 16 * g + tq) * NP + PC_Q + h * 256 + 32 * ks + 8 * kq);
        f32x4 s[2][16];
#pragma unroll
        for (int mb = 0; mb < 16; ++mb) { f32x4 acc0 = {0.f, 0.f, 0.f, 0.f}, acc1 = {0.f, 0.f, 0.f, 0.f}; const bf16* kp = KM + (size_t)(b * 256 + 16 * mb + tq) * 1024 + h * 256 + 8 * kq;
#pragma unroll
            for (int ks = 0; ks < 8; ++ks) { const bf16x8 kf = *(const bf16x8*)(kp + 32 * ks);
                acc0 = __builtin_amdgcn_mfma_f32_16x16x32_bf16(kf, qf[0][ks], acc0, 0, 0, 0); acc1 = __builtin_amdgcn_mfma_f32_16x16x32_bf16(kf, qf[1][ks], acc1, 0, 0, 0); }
            s[0][mb] = acc0; s[1][mb] = acc1; asm volatile("" ::: "memory"); }
        bf16x8 pf[2][8];
#pragma unroll
        for (int g = 0; g < 2; ++g) {
            float mx = -3.0e38f;
#pragma unroll
            for (int mb = 0; mb < 16; ++mb) { s[g][mb] = s[g][mb] * 0.0625f; mx = fmaxf(mx, fmaxf(fmaxf(s[g][mb][0], s[g][mb][1]), fmaxf(s[g][mb][2], s[g][mb][3]))); }
            mx = fmaxf(mx, __shfl_xor(mx, 16)); mx = fmaxf(mx, __shfl_xor(mx, 32));
            float sum = 0.f;
#pragma unroll
            for (int mb = 0; mb < 16; ++mb) {
#pragma unroll
                for (int i = 0; i < 4; ++i) { s[g][mb][i] = __expf(s[g][mb][i] - mx); sum += s[g][mb][i]; } }
            sum += __shfl_xor(sum, 16); sum += __shfl_xor(sum, 32);
            const float inv = 1.0f / sum;
#pragma unroll
            for (int ks = 0; ks < 8; ++ks) { v4u w; w.x = pk2(s[g][2 * ks][0] * inv, s[g][2 * ks][1] * inv); w.y = pk2(s[g][2 * ks][2] * inv, s[g][2 * ks][3] * inv); w.z = pk2(s[g][2 * ks + 1][0] * inv, s[g][2 * ks + 1][1] * inv); w.w = pk2(s[g][2 * ks + 1][2] * inv, s[g][2 * ks + 1][3] * inv); pf[g][ks] = __builtin_bit_cast(bf16x8, w); } }
#pragma unroll
        for (int db = 0; db < 16; ++db) { f32x4 acc0 = {0.f, 0.f, 0.f, 0.f}, acc1 = {0.f, 0.f, 0.f, 0.f}; const bf16* vp = VT + ((size_t)((b * 4 + h) * 256 + 16 * db + tq)) * 256 + 8 * kq;
#pragma unroll
            for (int ks = 0; ks < 8; ++ks) { const bf16x8 vf = *(const bf16x8*)(vp + 32 * ks);
                acc0 = __builtin_amdgcn_mfma_f32_16x16x32_bf16(vf, pf[0][ks], acc0, 0, 0, 0); acc1 = __builtin_amdgcn_mfma_f32_16x16x32_bf16(vf, pf[1][ks], acc1, 0, 0, 0); }
            v2u w0_, w1_; w0_.x = pk2(acc0[0], acc0[1]); w0_.y = pk2(acc0[2], acc0[3]); w1_.x = pk2(acc1[0], acc1[1]); w1_.y = pk2(acc1[2], acc1[3]);
            *(v2u*)(YC + (size_t)(m0 + tq) * 3072 + h * 256 + 16 * db + 4 * kq) = w0_; *(v2u*)(YC + (size_t)(m0 + 16 + tq) * 3072 + h * 256 + 16 * db + 4 * kq) = w1_; asm volatile("" ::: "memory"); }
    }
}

__device__ __forceinline__ void router_phase(const Frame& F, const Args& a) {
    const bf16* H1 = (const bf16*)(a.ws + WS_H1); bf16* XN2 = (bf16*)(a.ws + WS_XN); const bf16* WR = (const bf16*)(a.ws + WS_WR);
    int* pick_e = (int*)(a.ws + WS_PICK); int* pick_rank = pick_e + 65536; float* pick_gate = (float*)(pick_rank + 65536);
    unsigned* gcnt = (unsigned*)(a.ws + WS_CTL) + CW_CNT;
    LAS float* lg = (LAS float*)(F.lds + F.wave * 4096);
    LAS unsigned* lcnt = (LAS unsigned*)(F.lds + 65536);
    const int tq = F.lane & 15, kq = F.lane >> 4;
    for (int g0 = F.vcu * 4; g0 < 1024; g0 += F.G * 4) {
        if (F.tid < 64) lcnt[F.tid] = 0u;
        __syncthreads();
        int me = 0, mrank = 0; float mgate = 0.f; int e4[4]; float g4[4]; int r4[4];
        const int m0 = (g0 + F.wave) * 16;
        if (F.wave < 4) {
            float myr = 0.f;
            for (int j = 0; j < 16; ++j) { const GAS v4u* xr = (const GAS v4u*)(H1 + (size_t)(m0 + j) * D) + F.lane; float s = 0.f;
#pragma unroll
                for (int q = 0; q < 4; ++q) { const v4u w8 = xr[64 * q]; const float e0 = bflo(w8.x), e1 = bfhi(w8.x), e2 = bflo(w8.y), e3 = bfhi(w8.y), e4 = bflo(w8.z), e5 = bfhi(w8.z), e6 = bflo(w8.w), e7 = bfhi(w8.w);
                    s += ((e0 * e0 + e1 * e1) + (e2 * e2 + e3 * e3)) + ((e4 * e4 + e5 * e5) + (e6 * e6 + e7 * e7)); }
                const float rs = 1.0f / sqrtf(wave_sum(s) * (1.f / D) + EPS); if (tq == j) myr = rs; }
            f32x4 acc[2] = {{0.f, 0.f, 0.f, 0.f}, {0.f, 0.f, 0.f, 0.f}};
            const bf16* hrow = H1 + (size_t)(m0 + tq) * D + 8 * kq; const float* grow = inp(I_GFFN) + 8 * kq; unsigned char* xrow = (unsigned char*)XN2 + (size_t)(m0 + tq) * D + 8 * kq;
            for (int ks = 0; ks < 64; ++ks) {
                const v4u hw8 = *(const v4u*)(hrow + 32 * ks); const f32x4 x0 = {bflo(hw8.x), bfhi(hw8.x), bflo(hw8.y), bfhi(hw8.y)}, x1 = {bflo(hw8.z), bfhi(hw8.z), bflo(hw8.w), bfhi(hw8.w)}, g0v = *(const f32x4*)(grow + 32 * ks), g1v = *(const f32x4*)(grow + 32 * ks + 4);
                v4u w; w.x = pk2(x0[0] * myr * g0v[0], x0[1] * myr * g0v[1]); w.y = pk2(x0[2] * myr * g0v[2], x0[3] * myr * g0v[3]); w.z = pk2(x1[0] * myr * g1v[0], x1[1] * myr * g1v[1]); w.w = pk2(x1[2] * myr * g1v[2], x1[3] * myr * g1v[3]);
                { v2u q8; q8.x = pk4_fp8(x0[0] * myr * g0v[0], x0[1] * myr * g0v[1], x0[2] * myr * g0v[2], x0[3] * myr * g0v[3]); q8.y = pk4_fp8(x1[0] * myr * g1v[0], x1[1] * myr * g1v[1], x1[2] * myr * g1v[2], x1[3] * myr * g1v[3]); *(v2u*)(xrow + 32 * ks) = q8; }
                const bf16x8 af = __builtin_bit_cast(bf16x8, w);
#pragma unroll
                for (int eh = 0; eh < 2; ++eh) { const bf16* wp = WR + (size_t)(16 * eh + tq) * D + 32 * ks + 8 * kq;
                    acc[eh] = __builtin_amdgcn_mfma_f32_16x16x32_bf16(af, *(const bf16x8*)wp, acc[eh], 0, 0, 0);
                    acc[eh] = __builtin_amdgcn_mfma_f32_16x16x32_bf16(af, *(const bf16x8*)(wp + 32 * D), acc[eh], 0, 0, 0); } }
#pragma unroll
            for (int eh = 0; eh < 2; ++eh)
#pragma unroll
                for (int i = 0; i < 4; ++i) lg[(4 * kq + i) * 33 + 16 * eh + tq] = acc[eh][i] + inp(I_BROUTER)[16 * eh + tq];
            LDS_WAIT(); asm volatile("" ::: "memory");
            if (F.lane < 16) { float v[32];
#pragma unroll
                for (int e = 0; e < 32; ++e) v[e] = lg[F.lane * 33 + e];
                float tv[4];
#pragma unroll
                for (int k = 0; k < 4; ++k) { float best = -3.0e38f; int bi = 0;
#pragma unroll
                    for (int e = 0; e < 32; ++e) { if (v[e] > best) { best = v[e]; bi = e; } }
                    tv[k] = best; e4[k] = bi;
#pragma unroll
                    for (int e = 0; e < 32; ++e) { if (e == bi) v[e] = -3.0e38f; } }
                float den = 0.f;
#pragma unroll
                for (int k = 0; k < 4; ++k) { g4[k] = __expf(tv[k] - tv[0]); den += g4[k]; }
#pragma unroll
                for (int k = 0; k < 4; ++k) { g4[k] = g4[k] / den; r4[k] = (int)atomicAdd((unsigned*)&lcnt[e4[k]], 1u); } }
        }
        __syncthreads();
        if (F.tid < 32) lcnt[32 + F.tid] = atomicAdd(&gcnt[F.tid], lcnt[F.tid]);
        __syncthreads();
        if (F.wave < 4 && F.lane < 16) {
#pragma unroll
            for (int k = 0; k < 4; ++k) { const int pi = (m0 + F.lane) * 4 + k; pick_e[pi] = e4[k]; pick_rank[pi] = (int)lcnt[32 + e4[k]] + r4[k]; pick_gate[pi] = g4[k]; } }
        __syncthreads();
        (void)me; (void)mrank; (void)mgate;
    }
}

__device__ __forceinline__ void scatter_phase(const Frame& F, const Args& a) {
    const int* pick_e = (const int*)(a.ws + WS_PICK); const int* pick_rank = pick_e + 65536; const float* pick_gate = (const float*)(pick_rank + 65536); int* pos = (int*)(pick_gate + 65536);
    float* gate_of_row = (float*)(a.ws + WS_ROWTAB); int* tok_of_row = (int*)(a.ws + WS_ROWTAB + 512 * 1024 + 8192);
    unsigned* ctl = (unsigned*)(a.ws + WS_CTL);
    LAS int* pst = (LAS int*)(F.lds);
    if (F.tid == 0) { int acc = 0; for (int e = 0; e < NE; ++e) { pst[e] = acc; const int c = (int)ctl[CW_CNT + e]; pst[32 + e] = c; const int nt = (c + 255) >> 8;
            if (blockIdx.x == 0) for (int k = 0; k < nt; ++k) ctl[CW_TILEE + (acc >> 8) + k] = (unsigned)e;
            acc += nt << 8; }
        if (blockIdx.x == 0) ctl[CW_NTILES] = (unsigned)(acc >> 8); }
    __syncthreads();
    { const int gw = F.vcu * NWAVES + F.wave, NGW = F.G * NWAVES; const unsigned char* X8 = a.ws + WS_XN; unsigned char* XS8 = a.ws + WS_XS;
      for (int pi = gw; pi < 65536; pi += NGW) {
        const int e = pick_e[pi], row = pst[e] + pick_rank[pi], tok = pi >> 2;
        if (F.lane == 0) { pos[pi] = row; gate_of_row[row] = pick_gate[pi]; tok_of_row[row] = tok; }
        const GAS v4u* src = (const GAS v4u*)(X8 + (size_t)tok * D) + F.lane; GAS v4u* dst = (GAS v4u*)(XS8 + (size_t)row * D) + F.lane;
        dst[0] = src[0]; dst[64] = src[64]; } }
    if (blockIdx.x == 0) for (int e = 0; e < NE; ++e) { const int r0 = pst[e] + pst[32 + e], r1 = pst[e] + (((pst[32 + e] + 255) >> 8) << 8);
        for (int r = r0 + F.tid; r < r1; r += NWAVES * 64) { tok_of_row[r] = 0; gate_of_row[r] = 0.f; } }
}

__device__ __forceinline__ void final_phase(const Frame& F, const Args& a) {
    const bf16* H1 = (const bf16*)(a.ws + WS_H1); const bf16* OR = (const bf16*)(a.ws + WS_OROW);
    const int* pos = (const int*)(a.ws + WS_PICK) + 3 * 65536;
    const int gw = F.vcu * NWAVES + F.wave, NGW = F.G * NWAVES;
    for (int m = gw; m < T; m += NGW) {
        const GAS v2u* xr = (const GAS v2u*)(H1 + (size_t)m * D) + F.lane; const GAS f32x4* gr = (const GAS f32x4*)inp(I_GFINAL) + F.lane;
        f32x4 v[8];
#pragma unroll
        for (int j = 0; j < 8; ++j) { const v2u w = xr[64 * j]; v[j] = (f32x4){bflo(w.x), bfhi(w.x), bflo(w.y), bfhi(w.y)}; }
#pragma unroll
        for (int k = 0; k < 4; ++k) { const int row = pos[m * 4 + k]; const GAS v2u* orp = (const GAS v2u*)(OR + (size_t)row * D) + F.lane;
#pragma unroll
            for (int j = 0; j < 8; ++j) { const v2u w = orp[64 * j]; v[j].x += bflo(w.x); v[j].y += bfhi(w.x); v[j].z += bflo(w.y); v[j].w += bfhi(w.y); } }
        float s = 0.f;
#pragma unroll
        for (int j = 0; j < 8; ++j) s += (v[j].x * v[j].x + v[j].y * v[j].y) + (v[j].z * v[j].z + v[j].w * v[j].w);
        const float rstd = 1.0f / sqrtf(wave_sum(s) * (1.f / D) + EPS);
        GAS f32x4* o = (GAS f32x4*)(a.out + (size_t)m * D) + F.lane;
#pragma unroll
        for (int j = 0; j < 8; ++j) { const f32x4 g = gr[64 * j]; o[64 * j] = (f32x4){v[j].x * rstd * g.x, v[j].y * rstd * g.y, v[j].z * rstd * g.z, v[j].w * rstd * g.w}; }
    }
}

#ifndef MK_N_LAUNCHES
#define MK_N_LAUNCHES 1
#endif
constexpr int NPH = 14;
__global__ void __launch_bounds__(NWAVES * 64, 2) fwd(Args args) {
    extern __shared__ __attribute__((aligned(16))) unsigned char lds[];
#define NEWFRAME() Frame F; { int tz = threadIdx.x; asm volatile("" : "+v"(tz)); F.lds = (LAS unsigned char*)lds; F.MISC = (volatile LAS unsigned*)(F.lds + MISC_OFF); F.tid = tz; F.lane = tz & 63; F.wave = __builtin_amdgcn_readfirstlane(tz >> 6); \
        F.G = gridDim.x; const int bx = blockIdx.x; F.vcu = (F.G % 8 == 0) ? (bx % 8) * (F.G / 8) + bx / 8 : bx; }
    unsigned char* ws = args.ws;
    unsigned* ctl = (unsigned*)(ws + WS_CTL);
    for (int u = threadIdx.x; u < (LDS_BYTES - MISC_OFF) / 4; u += NWAVES * 64) ((LAS unsigned*)((LAS unsigned char*)lds + MISC_OFF))[u] = 0u;
    __syncthreads();
    const int lo = args.ph_lo, hi = args.ph_hi;
    XcdBarrier bar; bar.bar = ctl + CW_BAR; bar.x = 0; bar.st = nullptr;
    if (hi - lo > 1) bar = xcd_barrier_post(ctl + CW_BAR, (volatile LAS unsigned*)((LAS unsigned char*)lds + MISC_OFF) + 8);
#ifndef PHMASK
#define PHMASK 0xFFFF
#endif
#define IN(k) (((PHMASK >> (k)) & 1) && lo <= (k) && (k) < hi)
#define SEAM(k) do { if (IN(k) && IN((k) + 1)) xcd_barrier(bar); } while (0)

    if (IN(0)) { NEWFRAME(); p0_prologue(F, args); } SEAM(0);
    if (IN(1)) { NEWFRAME();
        const int c = (int)blockIdx.x, G = F.G;
        { pg8::Gemm g{(const bf16*)(ws + WS_XN), (const bf16*)(ws + WS_WIN), T, PC_G, D}; pg8::StaticOrder S; S.init(T, PC_G, G, c);
          pg8::EpiBf16<0> E{(bf16*)(ws + WS_P), NP, nullptr, 0, 0, 1.f};
          pg8::gemm_phase<pg8::EpiBf16<0>, pg8::StaticOrder, true, true>(F.lds, g, S, E); }
        __syncthreads();
        { pg8::Gemm g{(const bf16*)(ws + WS_MN), (const bf16*)(ws + WS_WMKV), 512, 2048, D}; pg8::StaticOrder S; S.init(512, 2048, G, (c + G - G / 2) % G);
          pg8::EpiKV E{(bf16*)(ws + WS_KMEM), (bf16*)(ws + WS_VT)};
          pg8::gemm_phase<pg8::EpiKV, pg8::StaticOrder, true, true>(F.lds, g, S, E); }
        __syncthreads();
        { int start, cnt;
          if (G == 256) { if (c < 144) { start = 5 * c; cnt = 5; } else if (c < 224) { start = 720 + 7 * (c - 144); cnt = 7; } else { start = 1280 + 8 * (c - 224); cnt = 8; } }
          else { const int per = (1536 + G - 1) / G; start = per * c; cnt = start >= 1536 ? 0 : (1536 - start < per ? 1536 - start : per); }
          pg8::Gemm g{(const bf16*)(ws + WS_XN8), (const bf16*)(ws + WS_WIN8), T, NP - PC_G, D}; pg8::RangeOrder S; S.init(T, NP - PC_G, start, cnt);
          pg8::EpiBf16<2> E{(bf16*)(ws + WS_P) + PC_G, NP, nullptr, 0, 0, 1.f};
          pg8::gemm_phase<pg8::EpiBf16<2>, pg8::RangeOrder, true, true, 1>(F.lds, g, S, E); }
    } SEAM(1);
    if (IN(2)) { NEWFRAME();
#ifndef NO_R1
 r1_lora_in(F, args);
#endif
#ifndef NO_LRU
 lru_pass<false>(F, args, F.vcu * NWAVES + F.wave, F.G * NWAVES);
#endif
 } SEAM(2);
    if (IN(3)) { NEWFRAME();
        lru_carry(F, args);
        { pg8::Gemm g{(const bf16*)(ws + WS_XN), (const bf16*)(ws + WS_WLORA), T, 3072, LORA_K}; pg8::StaticOrder S; S.init(T, 3072, F.G, (int)blockIdx.x);
          pg8::EpiF32 E{(float*)(ws + WS_LORAOUT), 3072};
          pg8::gemm_phase<pg8::EpiF32, pg8::StaticOrder, true, true>(F.lds, g, S, E); }
    } SEAM(3);
    if (IN(4)) { NEWFRAME(); r3_blocks(F, args); } SEAM(4);
    if (IN(5)) { NEWFRAME();
        if (F.tid < 64) ((LAS unsigned*)(F.lds + SC_SYNC))[F.tid] = 0u; __syncthreads();
        int bh = 0, quarter = 0; const bool sw = scan_wg(bh, quarter);
        int gw2, NGW2; { const int bx = blockIdx.x, G = F.G; if (G == 256) { NGW2 = 1792; gw2 = sw ? ((bx >> 4) * 8 + (bx & 7)) * 6 + (F.wave - 2) : 768 + ((bx >> 4) * 8 + (bx & 7)) * 8 + F.wave; } else { NGW2 = G * 8; gw2 = F.vcu * 8 + F.wave; } }
        if (sw && F.wave == 0) r4_scan<0>(F, args, bh, quarter);
        else if (sw && F.wave == 1) r4_feeder(F, args, bh);
        else {
            const int rot = F.wave % 3;
            if (rot == 0) { moe_weight_convert(F, args, gw2, NGW2); xattn_phase(F, args, gw2, NGW2); lru_pass<true>(F, args, gw2, NGW2); }
            else if (rot == 1) { xattn_phase(F, args, gw2, NGW2); lru_pass<true>(F, args, gw2, NGW2); moe_weight_convert(F, args, gw2, NGW2); }
            else { lru_pass<true>(F, args, gw2, NGW2); moe_weight_convert(F, args, gw2, NGW2); xattn_phase(F, args, gw2, NGW2); } }
    } SEAM(5);
    if (IN(6)) { NEWFRAME(); r5_finish(F, args); } SEAM(6);
    if (IN(7)) { NEWFRAME();
        pg8::Gemm g{(const bf16*)(ws + WS_YABC), (const bf16*)(ws + WS_WBR), T, 2048, 3072}; pg8::StaticOrder S; S.init(T, 2048, F.G, (int)blockIdx.x);
        pg8::EpiBranch2 E{(const bf16*)(ws + WS_P), NP, PC_G, (bf16*)(ws + WS_MERGED)};
        pg8::gemm_phase<pg8::EpiBranch2, pg8::StaticOrder, true, true>(F.lds, g, S, E);
    } SEAM(7);
    if (IN(8)) { NEWFRAME();
        pg8::Gemm g{(const bf16*)(ws + WS_MERGED), (const bf16*)(ws + WS_WO), T, D, D}; pg8::StaticOrder S; S.init(T, D, F.G, (int)blockIdx.x);
        pg8::EpiRes E{inp(I_X), (bf16*)(ws + WS_H1), D};
        pg8::gemm_phase<pg8::EpiRes, pg8::StaticOrder, true, true>(F.lds, g, S, E);
    } SEAM(8);
    if (IN(9)) { NEWFRAME(); router_phase(F, args); } SEAM(9);
    if (IN(10)) { NEWFRAME(); scatter_phase(F, args); } SEAM(10);
    if (IN(11)) { NEWFRAME();
        const int ntiles = __builtin_amdgcn_readfirstlane((int)__hip_atomic_load(ctl + CW_NTILES, __ATOMIC_RELAXED, __HIP_MEMORY_SCOPE_AGENT));
        pg8::Gemm g{(const bf16*)(ws + WS_XS), (const bf16*)(ws + WS_WGU), ntiles * 256, NE * 4096, D}; pg8::MoeOrder<false> S; S.init(ntiles, 16, F.G, (int)blockIdx.x, (const int*)(ctl + CW_TILEE), nullptr);
        pg8::EpiSwiglu E{ws + WS_HH, inp(I_BGATE), inp(I_BUP)};
        pg8::gemm_phase<pg8::EpiSwiglu, pg8::MoeOrder<false>, true, true, 1>(F.lds, g, S, E);
    } SEAM(11);
    if (IN(12)) { NEWFRAME();
        const int ntiles = __builtin_amdgcn_readfirstlane((int)__hip_atomic_load(ctl + CW_NTILES, __ATOMIC_RELAXED, __HIP_MEMORY_SCOPE_AGENT));
        pg8::Gemm g{(const bf16*)(ws + WS_HH), (const bf16*)(ws + WS_WD), ntiles * 256, NE * 2048, D}; pg8::MoeOrder<false> S; S.init(ntiles, 8, F.G, (int)blockIdx.x, (const int*)(ctl + CW_TILEE), nullptr);
        pg8::EpiDown E{(bf16*)(ws + WS_OROW), inp(I_BDOWN), (const float*)(ws + WS_ROWTAB)};
        pg8::gemm_phase<pg8::EpiDown, pg8::MoeOrder<false>, true, true, 1>(F.lds, g, S, E);
    } SEAM(12);
    if (IN(13)) { NEWFRAME(); final_phase(F, args); }
#ifdef PROBE_EXTRA_PHASE
    if (lo == 14) { NEWFRAME(); if (F.tid < 64) ((LAS unsigned*)(F.lds + SC_SYNC))[F.tid] = 0u; __syncthreads(); int bh = 0, quarter = 0; const bool sw = scan_wg(bh, quarter); if (sw && F.wave == 0) r4_scan<0>(F, args, bh, quarter); else if (sw && F.wave == 1) r4_feeder(F, args, bh); }
    if (lo == 17) { NEWFRAME(); int bh = 0, quarter = 0; const bool sw = scan_wg(bh, quarter); if (sw && F.wave == 0) r4_scan<1>(F, args, bh, quarter); }
    if (lo == 18) { NEWFRAME(); const int gw2 = F.vcu * 8 + F.wave, NGW2 = F.G * 8; const int rot = F.wave % 3;
            if (rot == 0) { moe_weight_convert(F, args, gw2, NGW2); xattn_phase(F, args, gw2, NGW2); lru_pass<true>(F, args, gw2, NGW2); }
            else if (rot == 1) { xattn_phase(F, args, gw2, NGW2); lru_pass<true>(F, args, gw2, NGW2); moe_weight_convert(F, args, gw2, NGW2); }
            else { lru_pass<true>(F, args, gw2, NGW2); moe_weight_convert(F, args, gw2, NGW2); xattn_phase(F, args, gw2, NGW2); } }
    if (lo == 19) { NEWFRAME(); xattn_phase(F, args, F.vcu * 8 + F.wave, F.G * 8); }
    if (lo == 20) { NEWFRAME(); lru_pass<true>(F, args, F.vcu * 8 + F.wave, F.G * 8); }
    if (lo == 15) { NEWFRAME(); moe_weight_convert(F, args, F.vcu * 8 + F.wave, F.G * 8); }
#endif
#undef IN
#undef SEAM
}

extern "C" void kernel_launch(void* const* d_in, const int* in_sizes, int n_in, void* d_out, int out_size, void* d_ws, size_t ws_size, hipStream_t stream) {
    static int grid = 0;
    if (grid == 0) {
        if (n_in != 39 || out_size != T * D || ws_size < WS_END) { fprintf(stderr, "kernel_launch: built for 39 inputs, out of %d floats, >= %zu bytes of workspace; got n_in %d, out %d, ws %zu; nothing launched\n", T * D, (size_t)WS_END, n_in, out_size, ws_size); grid = -1; return; }
        int dev = 0, cus = 0, per_cu = 0;
        if (hipGetDevice(&dev) != hipSuccess || hipDeviceGetAttribute(&cus, hipDeviceAttributeMultiprocessorCount, dev) != hipSuccess) { fprintf(stderr, "kernel_launch: device query failed\n"); grid = -1; return; }
        if (hipFuncSetAttribute((const void*)fwd, hipFuncAttributeMaxDynamicSharedMemorySize, LDS_BYTES) != hipSuccess) { fprintf(stderr, "kernel_launch: hipFuncSetAttribute failed\n"); grid = -1; return; }
        if (hipOccupancyMaxActiveBlocksPerMultiprocessor(&per_cu, (const void*)fwd, NWAVES * 64, LDS_BYTES) != hipSuccess || per_cu < 1)
            fprintf(stderr, "kernel_launch: note: occupancy query reports %d workgroups per CU\n", per_cu);
        (void)hipGetLastError();
        grid = cus;
    }
    if (grid < 0) return;
    (void)in_sizes;
    if (hipMemsetAsync((char*)d_ws + WS_CTL, 0, CTL_ZERO_BYTES, stream) != hipSuccess) { fprintf(stderr, "kernel_launch: hipMemsetAsync failed\n"); return; }
    Args a{};
    for (int i = 0; i < 39; ++i) a.in[i] = (const float*)d_in[i];
    a.out = (float*)d_out; a.ws = (unsigned char*)d_ws;
#if MK_N_LAUNCHES == 1
    a.ph_lo = 0; a.ph_hi = NPH;
    hipLaunchKernelGGL(fwd, dim3(grid), dim3(NWAVES * 64), LDS_BYTES, stream, a);
#else
    for (int k = 0; k < NPH; ++k) { a.ph_lo = k; a.ph_hi = k + 1; int reps = 1;
#ifdef PROBE_REP_PHASE
        if (k == PROBE_REP_PHASE) reps = 1 + PROBE_REP_N;
#endif
        for (int r = 0; r < reps; ++r) hipLaunchKernelGGL(fwd, dim3(grid), dim3(NWAVES * 64), LDS_BYTES, stream, a); }
#ifdef PROBE_EXTRA_PHASE
    for (int r = 0; r < PROBE_REP_N; ++r) { a.ph_lo = PROBE_EXTRA_PHASE; a.ph_hi = PROBE_EXTRA_PHASE + 1; hipLaunchKernelGGL(fwd, dim3(grid), dim3(NWAVES * 64), LDS_BYTES, stream, a); }
#endif
#endif
    const hipError_t le = hipPeekAtLastError();
    if (le != hipSuccess) fprintf(stderr, "kernel_launch: launch failed: %s\n", hipGetErrorName(le));
}
```

```cpp
#include <hip/hip_runtime.h>
#include <cstdio>
#include <cstdint>
namespace pg8 {
#define PG8_LAS __attribute__((address_space(3)))
typedef unsigned short bf16_t;
typedef short bf16x8 __attribute__((ext_vector_type(8)));
typedef float f32x4 __attribute__((ext_vector_type(4)));
typedef unsigned u32x4 __attribute__((ext_vector_type(4)));
constexpr int BM = 256, BK = 64, HALF = 128, HTB = HALF * BK * 2  , STAGE_BYTES = 8 * HTB, NXCD = 8, WGM = 8;

__host__ __device__ __forceinline__ int lds_byte(int r, int c) { const int st = (r >> 4) * 2 + (c >> 5), rr = r & 15, cc = c & 31, ob = rr * 64 + cc * 2; return st * 1024 + (ob ^ (((ob >> 9) & 1) << 5)); }
__host__ __device__ __forceinline__ void stage_rc(int b, int& R, int& C) { const int st = b / 1024, sb = b % 1024, swz = sb ^ (((sb >> 9) & 1) << 5); R = (st >> 1) * 16 + swz / 64; C = (st & 1) * 32 + (swz % 64) / 2; }
__host__ __device__ __forceinline__ int perm32(int rho) { const int n = rho >> 4, i = rho & 15; return 8 * (i >> 2) + 4 * n + (i & 3); }

struct Unit { int pm, pn; };
struct Gemm { const bf16_t* A; const bf16_t* Bt; int M, N, K; };

struct StaticOrder {
    static constexpr bool GATHER = false; __device__ __forceinline__ int arow(const Unit&, int) const { return 0; }
    int nM, nN, nwg, G, c;
    __host__ __device__ void init(int M, int N, int G_, int c_) { nM = M / BM; nN = N / BM; nwg = nM * nN; G = G_; c = c_; }
    __host__ __device__ bool next(int i, Unit& u) const {
        const int L = i * G + c; if (L >= nwg) return false;
        int wgid = (int)L; { const int q = nwg / NXCD, r = nwg % NXCD, xcd = wgid % NXCD, off = wgid / NXCD; wgid = (xcd < r ? xcd * (q + 1) : r * (q + 1) + (xcd - r) * q) + off; }
        const int nig = WGM * nN, gid = wgid / nig, fm = gid * WGM, gsz = (nM - fm) < WGM ? (nM - fm) : WGM;
        u.pm = fm + ((wgid % nig) % gsz); u.pn = (wgid % nig) / gsz; return true;
    }
    __device__ __forceinline__ void a_ready(const Unit&) const {}
    __device__ __forceinline__ void done(const Unit&) const {}
};
struct RangeOrder {
    static constexpr bool GATHER = false; __device__ __forceinline__ int arow(const Unit&, int) const { return 0; }
    StaticOrder so; int start, cnt;
    __device__ void init(int M, int N, int start_, int cnt_) { so.init(M, N, 1, 0); start = start_; cnt = cnt_; }
    __device__ bool next(int i, Unit& u) const { if (i >= cnt) return false; return so.next(start + i, u); }
    __device__ __forceinline__ void a_ready(const Unit&) const {}
    __device__ __forceinline__ void done(const Unit&) const {}
};
typedef __bf16 bf16v2_t __attribute__((ext_vector_type(2))); typedef float f32v2_t __attribute__((ext_vector_type(2)));
__device__ __forceinline__ unsigned cvt_pk_bf16_v(float lo, float hi) { const f32v2_t v = {lo, hi}; return __builtin_bit_cast(unsigned, __builtin_convertvector(v, bf16v2_t)); }
__device__ __forceinline__ unsigned cvt_pk_bf16(float lo, float hi) { unsigned r; asm volatile("v_cvt_pk_bf16_f32 %0, %1, %2" : "=v"(r) : "v"(lo), "v"(hi)); return r; }
typedef float f32x2 __attribute__((ext_vector_type(2)));
__device__ __forceinline__ f32x2 gelu_pk(f32x2 v) {
    const f32x2 av = __builtin_elementwise_abs(v), d = av * 0.2316418882f + 1.0f;
    f32x2 t; t.x = __builtin_amdgcn_rcpf(d.x); t.y = __builtin_amdgcn_rcpf(d.y);
    f32x2 q = t * 0.5307027145f + (-0.7265760135f); q = q * t + 0.7107068705f; q = q * t + (-0.142248368f); q = q * t + 0.127414796f; q = q * t;
    const f32x2 s = (v * v) * (-0.72134752044f);
    f32x2 e; e.x = __builtin_amdgcn_exp2f(s.x); e.y = __builtin_amdgcn_exp2f(s.y);
    const f32x2 m = v * (q * e), r = v - m;
    f32x2 o; o.x = v.x < 0.f ? m.x : r.x; o.y = v.y < 0.f ? m.y : r.y; return o;
}

template <int ACT  > struct EpiBf16 {
    static constexpr bool PERM = true, AFTER_DRAIN = false; static constexpr int MIDK = 0; static constexpr int WSCALE = 0x79797979  ; static_assert(ACT >= 0 && ACT <= 3, "EpiBf16: ACT is 0 (none), 1 (gelu_pk), 2 (sigmoid) or 3 (sigmoid from column tile 12 on, none before)");
    bf16_t* O; int ldc; const float* bias; int split_cols; size_t split_stride; float scale0;
    __device__ __forceinline__ void operator()(const f32x4 (&acc)[2][2][4][2], const Unit& u, int wr, int wc, int fr, int fq) const {
        int tz_ = threadIdx.x; asm volatile("" : "+v"(tz_)); { const int wid_ = tz_ >> 6, lane_ = tz_ & 63; wr = wid_ >> 2; wc = wid_ & 3; fr = lane_ & 15; fq = lane_ >> 4; }
        const int row0 = u.pm * BM + wr * 64 + fr; int colt = u.pn * BM; bf16_t* base = O;
        float sc = 1.f; if (split_cols) { const int t = colt / split_cols; base += (size_t)t * split_stride; colt -= t * split_cols; if (t == 0) sc = scale0; }
        const int col0 = colt + wc * 32 + 8 * fq, bcol0 = u.pn * BM + wc * 32 + 8 * fq;
        f32x4 bv[2][2];
#pragma unroll
        for (int bj = 0; bj < 2; ++bj)
#pragma unroll
            for (int n = 0; n < 2; ++n) bv[bj][n] = bias ? *(const f32x4*)(bias + bcol0 + bj * HALF + 4 * n) : (f32x4){0.f, 0.f, 0.f, 0.f};
#pragma unroll
        for (int ai = 0; ai < 2; ++ai)
#pragma unroll
            for (int m = 0; m < 4; ++m) { bf16_t* rowp = base + (size_t)(row0 + ai * HALF + m * 16) * ldc + col0;
#pragma unroll
                for (int bj = 0; bj < 2; ++bj) { f32x4 v0 = acc[ai][bj][m][0] + bv[bj][0], v1 = acc[ai][bj][m][1] + bv[bj][1];
                    if (ACT == 1) { f32x2 a = gelu_pk((f32x2){v0[0], v0[1]}), b = gelu_pk((f32x2){v0[2], v0[3]}), c = gelu_pk((f32x2){v1[0], v1[1]}), d = gelu_pk((f32x2){v1[2], v1[3]});
                        v0 = (f32x4){a.x, a.y, b.x, b.y}; v1 = (f32x4){c.x, c.y, d.x, d.y}; }
                    if (ACT == 2 || (ACT == 3 && u.pn >= 12)) {
#pragma unroll
                        for (int j = 0; j < 4; ++j) { v0[j] = fmaxf(__builtin_amdgcn_rcpf(1.0f + __expf(-v0[j])), 1e-30f); v1[j] = fmaxf(__builtin_amdgcn_rcpf(1.0f + __expf(-v1[j])), 1e-30f); } }
                    v0 = v0 * sc; v1 = v1 * sc; u32x4 w; w.x = cvt_pk_bf16(v0[0], v0[1]); w.y = cvt_pk_bf16(v0[2], v0[3]); w.z = cvt_pk_bf16(v1[0], v1[1]); w.w = cvt_pk_bf16(v1[2], v1[3]);
                    *(u32x4*)(rowp + bj * HALF) = w; } }
    }
};

__device__ __forceinline__ float bf_lo(unsigned w) { return __builtin_bit_cast(float, w << 16); }
__device__ __forceinline__ float bf_hi(unsigned w) { return __builtin_bit_cast(float, w & 0xffff0000u); }
__device__ __forceinline__ float fsigmoid(float x) { return __builtin_amdgcn_rcpf(1.0f + __expf(-x)); }
typedef unsigned u32x2 __attribute__((ext_vector_type(2)));

struct EpiF32 {
    static constexpr bool PERM = false, AFTER_DRAIN = false; static constexpr int MIDK = 0; static constexpr int WSCALE = 0x7f7f7f7f;
    float* C; int ldc;
    __device__ __forceinline__ void operator()(const f32x4 (&acc)[2][2][4][2], const Unit& u, int wr, int wc, int fr, int fq) const {
        const int row0 = u.pm * BM + wr * 64 + fr, col0 = u.pn * BM + wc * 32 + 4 * fq;
#pragma unroll
        for (int ai = 0; ai < 2; ++ai)
#pragma unroll
            for (int m = 0; m < 4; ++m) { float* rowp = C + (size_t)(row0 + ai * HALF + m * 16) * ldc + col0;
#pragma unroll
                for (int bj = 0; bj < 2; ++bj)
#pragma unroll
                    for (int n = 0; n < 2; ++n) *(f32x4*)(rowp + bj * HALF + n * 16) = acc[ai][bj][m][n]; }
    }
};
struct EpiBfPlain {
    static constexpr bool PERM = false, AFTER_DRAIN = false; static constexpr int MIDK = 0; static constexpr int WSCALE = 0x7f7f7f7f;
    unsigned short* C; int ldc;
    __device__ __forceinline__ void operator()(const f32x4 (&acc)[2][2][4][2], const Unit& u, int wr, int wc, int fr, int fq) const {
        const int row0 = u.pm * BM + wr * 64 + fr, col0 = u.pn * BM + wc * 32 + 4 * fq;
#pragma unroll
        for (int ai = 0; ai < 2; ++ai)
#pragma unroll
            for (int m = 0; m < 4; ++m) { unsigned short* rowp = C + (size_t)(row0 + ai * HALF + m * 16) * ldc + col0;
#pragma unroll
                for (int bj = 0; bj < 2; ++bj)
#pragma unroll
                    for (int n = 0; n < 2; ++n) { const f32x4 v = acc[ai][bj][m][n]; u32x2 w; w.x = cvt_pk_bf16_v(v[0], v[1]); w.y = cvt_pk_bf16_v(v[2], v[3]); *(u32x2*)(rowp + bj * HALF + n * 16) = w; } }
    }
};
struct EpiRes {
    static constexpr bool PERM = false, AFTER_DRAIN = false; static constexpr int MIDK = 0; static constexpr int WSCALE = 0x7f7f7f7f;
    const float* X; bf16_t* C; int ldc;
    __device__ __forceinline__ void operator()(const f32x4 (&acc)[2][2][4][2], const Unit& u, int wr, int wc, int fr, int fq) const {
        const int row0 = u.pm * BM + wr * 64 + fr, col0 = u.pn * BM + wc * 32 + 4 * fq;
#pragma unroll
        for (int ai = 0; ai < 2; ++ai)
#pragma unroll
            for (int m = 0; m < 4; ++m) { const size_t off = (size_t)(row0 + ai * HALF + m * 16) * ldc + col0;
#pragma unroll
                for (int bj = 0; bj < 2; ++bj)
#pragma unroll
                    for (int n = 0; n < 2; ++n) { const f32x4 xv = *(const f32x4*)(X + off + bj * HALF + n * 16); const f32x4 v = acc[ai][bj][m][n] + xv;
                        u32x2 w; w.x = cvt_pk_bf16(v[0], v[1]); w.y = cvt_pk_bf16(v[2], v[3]); *(u32x2*)(C + off + bj * HALF + n * 16) = w; }
                asm volatile("" ::: "memory"); }
    }
};
struct EpiKV {
    static constexpr bool PERM = false, AFTER_DRAIN = false; static constexpr int MIDK = 0; static constexpr int WSCALE = 0x7f7f7f7f;
    bf16_t* Kb; bf16_t* VT;
    __device__ __forceinline__ void operator()(const f32x4 (&acc)[2][2][4][2], const Unit& u, int wr, int wc, int fr, int fq) const {
        const int row0 = u.pm * BM + wr * 64 + fr, col0 = u.pn * BM + wc * 32 + 4 * fq;
#pragma unroll
        for (int ai = 0; ai < 2; ++ai)
#pragma unroll
            for (int m = 0; m < 4; ++m) { const int r = row0 + ai * HALF + m * 16;
#pragma unroll
                for (int bj = 0; bj < 2; ++bj)
#pragma unroll
                    for (int n = 0; n < 2; ++n) { const f32x4 v = acc[ai][bj][m][n]; const int c = col0 + bj * HALF + n * 16;
                        if (u.pn < 4) { u32x2 w; w.x = cvt_pk_bf16_v(v[0], v[1]); w.y = cvt_pk_bf16_v(v[2], v[3]); *(u32x2*)(Kb + (size_t)r * 1024 + c) = w; }
                        else { const int cc = c - 1024, h = cc >> 8, d = cc & 255, b = r >> 8, mm = r & 255;
                            const int idx = (mm >> 5) * 32 + ((mm >> 2) & 3) * 8 + ((mm >> 4) & 1) * 4 + (mm & 3);
                            bf16_t* o = VT + ((size_t)((b * 4 + h) * 256 + d)) * 256 + idx;
                            const unsigned w0 = cvt_pk_bf16_v(v[0], v[1]), w1 = cvt_pk_bf16_v(v[2], v[3]);
                            o[0] = (bf16_t)(w0 & 0xffffu); o[256] = (bf16_t)(w0 >> 16); o[512] = (bf16_t)(w1 & 0xffffu); o[768] = (bf16_t)(w1 >> 16); } } }
    }
};
struct EpiBranch {
    static constexpr bool PERM = false, AFTER_DRAIN = false; static constexpr int MIDK = 0; static constexpr int WSCALE = 0x7f7f7f7f;
    const bf16_t* P; int ldp; int gcol0; float* macc; bf16_t* merged;
    __device__ __forceinline__ void operator()(const f32x4 (&acc)[2][2][4][2], const Unit& u, int wr, int wc, int fr, int fq) const {
        const int br = u.pm >> 6, pm = u.pm & 63, pn = u.pn & 7;
        const int row0 = pm * BM + wr * 64 + fr, col0 = pn * BM + wc * 32 + 4 * fq;
#pragma unroll
        for (int ai = 0; ai < 2; ++ai)
#pragma unroll
            for (int m = 0; m < 4; ++m) { const int r = row0 + ai * HALF + m * 16; const bf16_t* prow = P + (size_t)r * ldp + gcol0 + br * 2048;
#pragma unroll
                for (int bj = 0; bj < 2; ++bj)
#pragma unroll
                    for (int n = 0; n < 2; ++n) { const int c = col0 + bj * HALF + n * 16; const u32x2 gw = *(const u32x2*)(prow + c);
                        f32x4 g; g[0] = fsigmoid(bf_lo(gw.x)); g[1] = fsigmoid(bf_hi(gw.x)); g[2] = fsigmoid(bf_lo(gw.y)); g[3] = fsigmoid(bf_hi(gw.y));
                        f32x4 v = acc[ai][bj][m][n] * g; float* mp = macc + (size_t)r * 2048 + c;
                        if (br > 0) v = v + *(const f32x4*)mp;
                        if (br < 2) *(f32x4*)mp = v;
                        else { u32x2 w; w.x = cvt_pk_bf16(v[0], v[1]); w.y = cvt_pk_bf16(v[2], v[3]); *(u32x2*)(merged + (size_t)r * 2048 + c) = w; } }
                asm volatile("" ::: "memory"); }
    }
};
struct EpiSwiglu {
    static constexpr bool PERM = true, AFTER_DRAIN = false; static constexpr int MIDK = 0; static constexpr int WSCALE = 0x79797979;
    unsigned char* H; const float* bg; const float* bu;
    __device__ __forceinline__ void operator()(const f32x4 (&acc)[2][2][4][2], const Unit& u, int wr, int wc, int fr, int fq) const {
        int tz_ = threadIdx.x; asm volatile("" : "+v"(tz_)); { const int wid_ = tz_ >> 6, lane_ = tz_ & 63; wr = wid_ >> 2; wc = wid_ & 3; fr = lane_ & 15; fq = lane_ >> 4; }
        const int e = u.pn >> 4, ct = u.pn & 15;
        const int row0 = u.pm * BM + wr * 64 + fr, col0 = ct * 128 + wc * 32 + 8 * fq;
        f32x4 bgv[2], buv[2];
#pragma unroll
        for (int n = 0; n < 2; ++n) { bgv[n] = *(const f32x4*)(bg + (size_t)e * 2048 + col0 + 4 * n); buv[n] = *(const f32x4*)(bu + (size_t)e * 2048 + col0 + 4 * n); }
#pragma unroll
        for (int ai = 0; ai < 2; ++ai)
#pragma unroll
            for (int m = 0; m < 4; ++m) { unsigned char* rowp = H + (size_t)(row0 + ai * HALF + m * 16) * 2048 + col0;
                f32x4 o[2];
#pragma unroll
                for (int n = 0; n < 2; ++n) { const f32x4 g = acc[ai][0][m][n] + bgv[n], up = acc[ai][1][m][n] + buv[n];
#pragma unroll
                    for (int j = 0; j < 4; ++j) { const float hg = fminf(g[j], 7.0f), hu = fminf(fmaxf(up[j], -7.0f), 7.0f); o[n][j] = (hu + 1.0f) * hg * fsigmoid(1.702f * hg); } }
                u32x2 w; { int t0 = __builtin_amdgcn_cvt_pk_fp8_f32(o[0][0], o[0][1], 0, false); t0 = __builtin_amdgcn_cvt_pk_fp8_f32(o[0][2], o[0][3], t0, true); int t1 = __builtin_amdgcn_cvt_pk_fp8_f32(o[1][0], o[1][1], 0, false); t1 = __builtin_amdgcn_cvt_pk_fp8_f32(o[1][2], o[1][3], t1, true); w.x = (unsigned)t0; w.y = (unsigned)t1; }
                *(u32x2*)rowp = w; }
    }
};
struct EpiDown {
    static constexpr bool PERM = true, AFTER_DRAIN = false; static constexpr int MIDK = 0; static constexpr int WSCALE = 0x79797979;
    bf16_t* O; const float* bd; const float* rowgate;
    __device__ __forceinline__ void operator()(const f32x4 (&acc)[2][2][4][2], const Unit& u, int wr, int wc, int fr, int fq) const {
        int tz_ = threadIdx.x; asm volatile("" : "+v"(tz_)); { const int wid_ = tz_ >> 6, lane_ = tz_ & 63; wr = wid_ >> 2; wc = wid_ & 3; fr = lane_ & 15; fq = lane_ >> 4; }
        const int e = u.pn >> 3, ct = u.pn & 7;
        const int row0 = u.pm * BM + wr * 64 + fr, col0 = ct * BM + wc * 32 + 8 * fq;
        f32x4 bv[2][2];
#pragma unroll
        for (int bj = 0; bj < 2; ++bj)
#pragma unroll
            for (int n = 0; n < 2; ++n) bv[bj][n] = *(const f32x4*)(bd + (size_t)e * 2048 + col0 + bj * HALF + 4 * n);
#pragma unroll
        for (int ai = 0; ai < 2; ++ai)
#pragma unroll
            for (int m = 0; m < 4; ++m) { const int r = row0 + ai * HALF + m * 16; const float gs = rowgate[r]; bf16_t* rowp = O + (size_t)r * 2048 + col0;
#pragma unroll
                for (int bj = 0; bj < 2; ++bj) { const f32x4 v0 = (acc[ai][bj][m][0] + bv[bj][0]) * gs, v1 = (acc[ai][bj][m][1] + bv[bj][1]) * gs;
                    u32x4 w; w.x = cvt_pk_bf16(v0[0], v0[1]); w.y = cvt_pk_bf16(v0[2], v0[3]); w.z = cvt_pk_bf16(v1[0], v1[1]); w.w = cvt_pk_bf16(v1[2], v1[3]);
                    *(u32x4*)(rowp + bj * HALF) = w; } }
    }
};

struct EpiBranch2 {
    static constexpr bool PERM = false, AFTER_DRAIN = false; static constexpr int MIDK = 16; static constexpr int WSCALE = 0x7f7f7f7f;
    const bf16_t* P; int ldp; int gcol0; bf16_t* merged;
    __device__ __forceinline__ void mid(f32x4 (&acc)[2][2][4][2], const Unit& u, int which, int, int, int, int) const {
        int tz = threadIdx.x; asm volatile("" : "+v"(tz));
        const int wid_ = tz >> 6, lane_ = tz & 63, wr = wid_ >> 2, wc = wid_ & 3, fr = lane_ & 15, fq = lane_ >> 4;
        const int row0 = u.pm * BM + wr * 64 + fr, col0 = u.pn * BM + wc * 32 + 4 * fq;
#pragma unroll
        for (int ai = 0; ai < 2; ++ai)
#pragma unroll
            for (int m = 0; m < 4; ++m) { const bf16_t* prow = P + (size_t)(row0 + ai * HALF + m * 16) * ldp + gcol0 + (which - 1) * 2048;
#pragma unroll
                for (int bj = 0; bj < 2; ++bj)
#pragma unroll
                    for (int n = 0; n < 2; ++n) { const int c = col0 + bj * HALF + n * 16; const u32x2 ga = *(const u32x2*)(prow + c), gb = *(const u32x2*)(prow + 2048 + c);
                        const float a_[4] = {bf_lo(ga.x), bf_hi(ga.x), bf_lo(ga.y), bf_hi(ga.y)}, b_[4] = {bf_lo(gb.x), bf_hi(gb.x), bf_lo(gb.y), bf_hi(gb.y)};
#pragma unroll
                        for (int j = 0; j < 4; ++j) acc[ai][bj][m][n][j] *= a_[j] * __builtin_amdgcn_rcpf(b_[j]); }
                asm volatile("" ::: "memory"); }
    }
    __device__ __forceinline__ void operator()(const f32x4 (&acc)[2][2][4][2], const Unit& u, int wr, int wc, int fr, int fq) const {
        const int row0 = u.pm * BM + wr * 64 + fr, col0 = u.pn * BM + wc * 32 + 4 * fq;
#pragma unroll
        for (int ai = 0; ai < 2; ++ai)
#pragma unroll
            for (int m = 0; m < 4; ++m) { const int r = row0 + ai * HALF + m * 16; const bf16_t* prow = P + (size_t)r * ldp + gcol0 + 2 * 2048;
#pragma unroll
                for (int bj = 0; bj < 2; ++bj)
#pragma unroll
                    for (int n = 0; n < 2; ++n) { const int c = col0 + bj * HALF + n * 16; const u32x2 gw = *(const u32x2*)(prow + c);
                        const float g_[4] = {bf_lo(gw.x), bf_hi(gw.x), bf_lo(gw.y), bf_hi(gw.y)}; f32x4 v = acc[ai][bj][m][n];
#pragma unroll
                        for (int j = 0; j < 4; ++j) v[j] *= g_[j];
                        u32x2 w; w.x = cvt_pk_bf16(v[0], v[1]); w.y = cvt_pk_bf16(v[2], v[3]); *(u32x2*)(merged + (size_t)r * 2048 + c) = w; }
                asm volatile("" ::: "memory"); }
    }
};
struct BranchOrder {                              static constexpr bool GATHER = false; __device__ __forceinline__ int arow(const Unit&, int) const { return 0; }
    StaticOrder so;
    __device__ void init(int G_, int c_) { so.init(16384, 2048, G_, c_); }
    __device__ bool next(int i, Unit& u) const { const int br = i % 3; Unit t; if (!so.next(i / 3, t)) return false; u.pm = br * 64 + t.pm; u.pn = br * 8 + t.pn; return true; }
    __device__ __forceinline__ void a_ready(const Unit&) const {}
    __device__ __forceinline__ void done(const Unit&) const {}
};
template <bool GATH> struct MoeOrder {
    static constexpr bool GATHER = GATH;
    StaticOrder so; const int* tile_e; const int* tok; int nN;
    __device__ void init(int ntiles, int nN_, int G_, int c_, const int* te, const int* tk) { so.init(ntiles * BM, nN_ * BM, G_, c_); tile_e = te; tok = tk; nN = nN_; }
    __device__ bool next(int i, Unit& u) const { Unit t; if (!so.next(i, t)) return false; u.pm = t.pm; u.pn = tile_e[t.pm] * nN + t.pn; return true; }
    __device__ __forceinline__ int arow(const Unit& u, int r) const { return tok[u.pm * BM + r]; }
    __device__ __forceinline__ void a_ready(const Unit&) const {}
    __device__ __forceinline__ void done(const Unit&) const {}
};
typedef int i32x4 __attribute__((ext_vector_type(4)));
typedef int i32x8 __attribute__((ext_vector_type(8)));
__device__ __forceinline__ i32x8 frag8(bf16x8 lo, bf16x8 hi) { return __builtin_shufflevector(__builtin_bit_cast(i32x4, lo), __builtin_bit_cast(i32x4, hi), 0, 1, 2, 3, 4, 5, 6, 7); }
template <class Epi, class Sched, bool ALIGN_EPI = false, bool SP2 = false, int ESZ = 2>
__device__ __forceinline__ void gemm_phase(PG8_LAS unsigned char* lds, const Gemm g, const Sched& S, const Epi& E) {
    int tid_ = threadIdx.x; asm volatile("" : "+v"(tid_));
    const int tid = tid_, wid = __builtin_amdgcn_readfirstlane(tid >> 6), lane = tid & 63, wr = wid >> 2, wc = wid & 3, fr = lane & 15, fq = lane >> 4;
    const int K = g.K, nt = K / (BK * 2 / ESZ);
    const __amdgpu_buffer_rsrc_t rsA = __builtin_amdgcn_make_buffer_rsrc((void*)g.A, 0, 0x7fffffff, 0x00020000), rsB = __builtin_amdgcn_make_buffer_rsrc((void*)g.Bt, 0, 0x7fffffff, 0x00020000);
    unsigned voffA[2], voffB[2];
#pragma unroll
    for (int i = 0; i < 2; ++i) { int R, C; stage_rc(tid * 16 + i * 8192, R, C); const int Rb = Epi::PERM ? ((R & ~31) + perm32(R & 31)) : R;
        voffA[i] = (unsigned)(R * K) * (unsigned)ESZ + (unsigned)C * 2u; voffB[i] = (unsigned)(Rb * K) * (unsigned)ESZ + (unsigned)C * 2u; }
    unsigned vc[2][2] = {{0u, 0u}, {0u, 0u}}, vn[2][2] = {{0u, 0u}, {0u, 0u}};
#define PG8_ROWS(dst, un) do { if constexpr (Sched::GATHER) { _Pragma("unroll") for (int _h = 0; _h < 2; ++_h) _Pragma("unroll") for (int _i = 0; _i < 2; ++_i) { int R_, C_; stage_rc(tid * 16 + _i * 8192, R_, C_); \
        dst[_h][_i] = (unsigned)(S.arow(un, _h * HALF + R_) * K) * (unsigned)ESZ + (unsigned)C_ * 2u; } } } while (0)
#define PG8_STAGE_A(bufoff, abase, half, nx) do { if constexpr (Sched::GATHER) { unsigned vo_[2]; vo_[0] = (nx) ? vn[half][0] : vc[half][0]; vo_[1] = (nx) ? vn[half][1] : vc[half][1]; PG8_STAGE_R(bufoff, rsA, g.A, abase, vo_); } \
        else { PG8_STAGE_R(bufoff, rsA, g.A, (abase) + (half) * hstep, voffA); } } while (0)
    const size_t kstep = (size_t)(BK * 2);
    const size_t hstep = (size_t)HALF * K * ESZ;
    const size_t tstep = 2 * hstep;
    const unsigned ldsw = (unsigned)wid * 1024u;
    const int aoff = lds_byte(wr * 64 + fr, fq * 8), boff = lds_byte(wc * 32 + fr, fq * 8);
    const int aoffE = lds_byte(wr * 64 + fr, fq * 16), boffE = lds_byte(wc * 32 + fr, fq * 16);
#define PG8_SA(b, h) (((b) * 2 + (h)) * HTB)
#define PG8_SB(b, h) ((4 + (b) * 2 + (h)) * HTB)
#define PG8_STAGE_R(bufoff, rs, b0, gbase, voff) do { const int so_ = (int)((const char*)(gbase) - (const char*)(b0)); _Pragma("unroll") for (int _i = 0; _i < 2; ++_i) \
        __builtin_amdgcn_raw_ptr_buffer_load_lds(rs, (PG8_LAS void*)(lds + (bufoff) + ldsw + _i * 8192), 16, (int)(voff)[_i], so_, 0, 0); } while (0)
#define PG8_STAGE(bufoff, gbase, voff) PG8_STAGE_R(bufoff, rsB, g.Bt, gbase, voff)
#define PG8_LDA(dst, b, h) do { if constexpr (ESZ == 2) { _Pragma("unroll") for (int m = 0; m < 4; ++m) _Pragma("unroll") for (int k = 0; k < 2; ++k) dst[m][k] = *(const PG8_LAS bf16x8*)(lds + PG8_SA(b, h) + aoff + m * 2048 + k * 1024); } \
        else { _Pragma("unroll") for (int m = 0; m < 4; ++m) { dst##8[m].lo = *(const PG8_LAS i32x4*)(lds + PG8_SA(b, h) + aoffE + m * 2048); dst##8[m].hi = *(const PG8_LAS i32x4*)(lds + PG8_SA(b, h) + aoffE + 16 + m * 2048); } } } while (0)
#define PG8_LDB(dst, b, h) do { if constexpr (ESZ == 2) { _Pragma("unroll") for (int n = 0; n < 2; ++n) _Pragma("unroll") for (int k = 0; k < 2; ++k) dst[n][k] = *(const PG8_LAS bf16x8*)(lds + PG8_SB(b, h) + boff + n * 2048 + k * 1024); } \
        else { _Pragma("unroll") for (int n = 0; n < 2; ++n) { dst##8[n].lo = *(const PG8_LAS i32x4*)(lds + PG8_SB(b, h) + boffE + n * 2048); dst##8[n].hi = *(const PG8_LAS i32x4*)(lds + PG8_SB(b, h) + boffE + 16 + n * 2048); } } } while (0)
#define PG8_MMA(ai, bj, At, Bt) do { __builtin_amdgcn_s_setprio(1); _Pragma("unroll") for (int m = 0; m < 4; ++m) _Pragma("unroll") for (int n = 0; n < 2; ++n) { if constexpr (ESZ == 2) { _Pragma("unroll") for (int k = 0; k < 2; ++k) \
        acc[ai][bj][m][n] = __builtin_amdgcn_mfma_f32_16x16x32_bf16(Bt[n][k], At[m][k], acc[ai][bj][m][n], 0, 0, 0); } else { \
        acc[ai][bj][m][n] = __builtin_amdgcn_mfma_scale_f32_16x16x128_f8f6f4(Bt##8[n], At##8[m], acc[ai][bj][m][n], 0, 0, 0, Epi::WSCALE, 0, 0x7f7f7f7f); } } __builtin_amdgcn_s_setprio(0); } while (0)
#define PG8_WAIT_V(n) asm volatile("s_waitcnt vmcnt(" #n ")" ::: "memory")
#define PG8_WAIT_L(n) asm volatile("s_waitcnt lgkmcnt(" #n ")" ::: "memory")
#define PG8_BAR __builtin_amdgcn_s_barrier()
#define PG8_SCHED __builtin_amdgcn_sched_barrier(0)
    Unit cur, nxt; int ui = 0;
    if (!S.next(0, cur)) return;
    f32x4 acc[2][2][4][2];
#pragma unroll
    for (int a = 0; a < 2; ++a)
#pragma unroll
        for (int b = 0; b < 2; ++b)
#pragma unroll
            for (int m = 0; m < 4; ++m)
#pragma unroll
                for (int n = 0; n < 2; ++n) acc[a][b][m][n] = (f32x4){0.f, 0.f, 0.f, 0.f};
    bf16x8 At[4][2], B0[2][2], B1[2][2];
    i32x8 At8[4], B08[2], B18[2];
    const char* cA = (const char*)g.A + (Sched::GATHER ? (size_t)0 : (size_t)cur.pm * tstep); const char* cB = (const char*)g.Bt + (size_t)cur.pn * tstep;
    PG8_ROWS(vc, cur);
    S.a_ready(cur);
    if constexpr (SP2) {
        PG8_STAGE(PG8_SB(0, 0), cB, voffB); PG8_STAGE(PG8_SB(0, 1), cB + hstep, voffB); PG8_STAGE_A(PG8_SA(0, 0), cA, 0, false); PG8_STAGE_A(PG8_SA(0, 1), cA, 1, false);
        if (wr == 1) PG8_BAR;
        PG8_WAIT_V(2); PG8_BAR;
        PG8_STAGE(PG8_SB(1, 0), cB + kstep, voffB); PG8_STAGE_A(PG8_SA(1, 0), cA + kstep, 0, false); PG8_STAGE(PG8_SB(1, 1), cB + hstep + kstep, voffB);
        PG8_WAIT_V(6); PG8_BAR;
    } else {
        PG8_STAGE(PG8_SB(0, 0), cB, voffB); PG8_STAGE_A(PG8_SA(0, 0), cA, 0, false); PG8_STAGE(PG8_SB(0, 1), cB + hstep, voffB); PG8_STAGE_A(PG8_SA(0, 1), cA, 1, false);
        if (wr == 1) PG8_BAR;
        PG8_WAIT_V(4); PG8_BAR;
        PG8_STAGE(PG8_SB(1, 0), cB + kstep, voffB); PG8_STAGE_A(PG8_SA(1, 0), cA + kstep, 0, false); PG8_STAGE(PG8_SB(1, 1), cB + hstep + kstep, voffB);
        PG8_WAIT_V(6); PG8_BAR;
    }
    for (;;) {
        const bool has_next = S.next(ui + 1, nxt);
        if (has_next) PG8_ROWS(vn, nxt);
        const char* nA = (has_next && !Sched::GATHER) ? (const char*)g.A + (size_t)nxt.pm * tstep : cA; const char* nB = has_next ? (const char*)g.Bt + (size_t)nxt.pn * tstep : cB;
        for (int t = 0; t < nt; t += 2) {
            const bool last = (t == nt - 2);
            const char* a1 = cA + (size_t)(t + 1) * kstep;
            const char* a2 = last ? nA : cA + (size_t)(t + 2) * kstep; const char* b2 = last ? nB : cB + (size_t)(t + 2) * kstep;
            const char* a3 = a2 + kstep; const char* b3 = b2 + kstep;
            if (last && has_next) S.a_ready(nxt);
            if constexpr (Epi::MIDK > 0) { if (t == Epi::MIDK || t == 2 * Epi::MIDK) E.mid(acc, cur, t / Epi::MIDK, wr, wc, fr, fq); }
            if constexpr (SP2) {
            PG8_LDB(B0, 0, 0); PG8_LDB(B1, 0, 1); PG8_SCHED; PG8_LDA(At, 0, 0); PG8_STAGE_A(PG8_SA(1, 1), a1, 1, false);
            PG8_WAIT_V(8); PG8_WAIT_L(0); PG8_BAR; PG8_MMA(0, 0, At, B0); PG8_MMA(0, 1, At, B1); PG8_BAR; PG8_SCHED;
            PG8_LDA(At, 0, 1); PG8_STAGE(PG8_SB(0, 0), b2, voffB); PG8_STAGE(PG8_SB(0, 1), b2 + hstep, voffB); PG8_STAGE_A(PG8_SA(0, 0), a2, 0, last);
            PG8_WAIT_V(8); PG8_WAIT_L(0); PG8_BAR; PG8_MMA(1, 0, At, B0); PG8_MMA(1, 1, At, B1); PG8_BAR; PG8_SCHED;
            PG8_LDB(B0, 1, 0); PG8_LDB(B1, 1, 1); PG8_SCHED; PG8_LDA(At, 1, 0); PG8_STAGE_A(PG8_SA(0, 1), a2, 1, last);
            PG8_WAIT_V(8); PG8_WAIT_L(0); PG8_BAR; PG8_MMA(0, 0, At, B0); PG8_MMA(0, 1, At, B1); PG8_BAR; PG8_SCHED;
            PG8_LDA(At, 1, 1); PG8_STAGE(PG8_SB(1, 0), b3, voffB); PG8_STAGE(PG8_SB(1, 1), b3 + hstep, voffB); PG8_STAGE_A(PG8_SA(1, 0), a3, 0, last);
            PG8_WAIT_V(8); PG8_WAIT_L(0); PG8_BAR; PG8_MMA(1, 0, At, B0); PG8_MMA(1, 1, At, B1); PG8_BAR; PG8_SCHED;
            } else {
            PG8_LDB(B0, 0, 0); PG8_SCHED; PG8_LDA(At, 0, 0); PG8_STAGE_A(PG8_SA(1, 1), a1, 1, false);
            PG8_WAIT_L(8); PG8_BAR; PG8_WAIT_L(0); PG8_MMA(0, 0, At, B0); PG8_BAR; PG8_SCHED;
            PG8_LDB(B1, 0, 1); PG8_STAGE(PG8_SB(0, 0), b2, voffB);
            PG8_BAR; PG8_WAIT_L(0); PG8_MMA(0, 1, At, B1); PG8_BAR;
            PG8_LDA(At, 0, 1); PG8_STAGE_A(PG8_SA(0, 0), a2, 0, last);
            PG8_BAR; PG8_WAIT_L(0); PG8_MMA(1, 0, At, B0); PG8_BAR; PG8_SCHED;
            PG8_STAGE(PG8_SB(0, 1), b2 + hstep, voffB);
            PG8_WAIT_V(6); PG8_BAR; PG8_MMA(1, 1, At, B1); PG8_BAR;
            PG8_LDB(B0, 1, 0); PG8_SCHED; PG8_LDA(At, 1, 0); PG8_STAGE_A(PG8_SA(0, 1), a2, 1, last);
            PG8_WAIT_L(8); PG8_BAR; PG8_WAIT_L(0); PG8_MMA(0, 0, At, B0); PG8_BAR; PG8_SCHED;
            PG8_LDB(B1, 1, 1); PG8_STAGE(PG8_SB(1, 0), b3, voffB);
            PG8_BAR; PG8_WAIT_L(0); PG8_MMA(0, 1, At, B1); PG8_BAR;
            PG8_LDA(At, 1, 1); PG8_STAGE_A(PG8_SA(1, 0), a3, 0, last);
            PG8_BAR; PG8_WAIT_L(0); PG8_MMA(1, 0, At, B0); PG8_BAR; PG8_SCHED;
            PG8_STAGE(PG8_SB(1, 1), b3 + hstep, voffB);
            PG8_WAIT_V(6); PG8_BAR; PG8_MMA(1, 1, At, B1); PG8_BAR;
            }
        }
        if constexpr (ALIGN_EPI) { if (wr == 0) PG8_BAR; }
        if constexpr (!Epi::AFTER_DRAIN) { E(acc, cur, wr, wc, fr, fq); S.done(cur); }
        if (!has_next) break;
#pragma unroll
        for (int a = 0; a < 2; ++a)
#pragma unroll
            for (int b = 0; b < 2; ++b)
#pragma unroll
                for (int m = 0; m < 4; ++m)
#pragma unroll
                    for (int n = 0; n < 2; ++n) acc[a][b][m][n] = (f32x4){0.f, 0.f, 0.f, 0.f};
        cur = nxt; cA = nA; cB = nB; ++ui;
        if constexpr (Sched::GATHER) { vc[0][0] = vn[0][0]; vc[0][1] = vn[0][1]; vc[1][0] = vn[1][0]; vc[1][1] = vn[1][1]; }
        if constexpr (ALIGN_EPI) { if (wr == 1) PG8_BAR; }
    }
    PG8_WAIT_V(0);
    if constexpr (!ALIGN_EPI) { if (wr == 0) PG8_BAR; }
    PG8_BAR;
    if constexpr (Epi::AFTER_DRAIN) { E.fused(acc, cur, wr, wc, fr, fq, lds, wid, lane); S.done(cur); }
#undef PG8_SA
#undef PG8_SB
#undef PG8_STAGE
#undef PG8_STAGE_R
#undef PG8_STAGE_A
#undef PG8_ROWS
#undef PG8_LDA
#undef PG8_LDB
#undef PG8_MMA
#undef PG8_WAIT_V
#undef PG8_WAIT_L
#undef PG8_BAR
#undef PG8_SCHED
}
}

constexpr int NWAVES = 8;
constexpr int BATCH = 2, SEQ = 8192, T = BATCH * SEQ, D = 2048;
constexpr int RWKV_COLS = 3360, IN_COLS = 12576;
constexpr int NP = 12800;
constexpr int PC_LX = 3584, PC_LY = 4608, PC_Q = 5632, PC_G = 6656;
constexpr int NE = 32, MAXROWS = 65536 + NE * 256;
constexpr int LORA_K = 384;
constexpr float EPS = 1e-6f, GN_EPS = 64e-5f;

constexpr size_t MiB = 1u << 20;
constexpr size_t WS_CTL = 0, CTL_ZERO_BYTES = 1 * MiB;
constexpr size_t WS_WIN = 1 * MiB, WS_WMKV = 51 * MiB, WS_WLORA = 59 * MiB, WS_WBR = 62 * MiB, WS_WO = 74 * MiB, WS_WR = 82 * MiB, WS_LW = 83 * MiB;
constexpr size_t WS_WGU = 84 * MiB, WS_WD = 596 * MiB;
constexpr size_t WS_WIN8 = WS_WIN + 27 * MiB;
constexpr size_t WS_XN8 = 1508 * MiB;
constexpr size_t WS_XN = 852 * MiB;
constexpr size_t WS_P = 916 * MiB;
constexpr size_t WS_LORAOUT = 1316 * MiB;
constexpr size_t WS_SCAN = 1508 * MiB;
constexpr size_t WS_YABC = 1892 * MiB;
constexpr size_t WS_MISC = 1988 * MiB;
constexpr size_t WS_MN = WS_MISC, WS_KMEM = WS_MISC + 2 * MiB, WS_VT = WS_MISC + 3 * MiB, WS_LRUC = WS_MISC + 4 * MiB  , WS_BONUS = WS_MISC + 7 * MiB;
constexpr size_t WS_PICK = WS_MISC + 8 * MiB  , WS_ROWTAB = WS_MISC + 9 * MiB  , WS_SPL = WS_ROWTAB + 512 * 1024  ;
constexpr size_t WS_END = 2000 * MiB;
constexpr size_t WS_MACC = WS_LORAOUT, WS_MERGED = 1444 * MiB, WS_H1 = WS_SCAN, WS_XS = WS_P, WS_OROW = WS_P, WS_HH = 1204 * MiB;
constexpr int CW_BAR = 4096, CW_CNT = 8192, CW_NTILES = 8192 + 64, CW_TILEE = 8192 + 128;

constexpr int LDS_BYTES = 147456;
constexpr int MISC_OFF = 143360;

#define GAS __attribute__((address_space(1)))
#define LAS __attribute__((address_space(3)))
typedef unsigned short bf16;
typedef unsigned v4u __attribute__((ext_vector_type(4)));
typedef unsigned v2u __attribute__((ext_vector_type(2)));
typedef float f32x4 __attribute__((ext_vector_type(4)));
typedef float f32x2 __attribute__((ext_vector_type(2)));
typedef short bf16x8 __attribute__((ext_vector_type(8)));
typedef short bf16x4 __attribute__((ext_vector_type(4)));
#define LDS_WAIT() asm volatile("s_waitcnt lgkmcnt(0)" ::: "memory")
#define VM_WAIT() asm volatile("s_waitcnt vmcnt(0)" ::: "memory")
__device__ __forceinline__ unsigned f2bf(float f) { unsigned u = __builtin_bit_cast(unsigned, f); return (u + 0x7fffu + ((u >> 16) & 1u)) >> 16; }
typedef __bf16 bf16v2 __attribute__((ext_vector_type(2)));
__device__ __forceinline__ unsigned cvtpk(float lo, float hi) { const f32x2 v = {lo, hi}; const bf16v2 r = __builtin_convertvector(v, bf16v2); return __builtin_bit_cast(unsigned, r); }
__device__ __forceinline__ unsigned pk2(float lo, float hi) { return cvtpk(lo, hi); }
__device__ __forceinline__ float bflo(unsigned w) { return __builtin_bit_cast(float, w << 16); }
__device__ __forceinline__ float bfhi(unsigned w) { return __builtin_bit_cast(float, w & 0xffff0000u); }
__device__ __forceinline__ float bf1(bf16 b) { return __builtin_bit_cast(float, (unsigned)b << 16); }
__device__ __forceinline__ float sigm(float x) { return __builtin_amdgcn_rcpf(1.0f + __expf(-x)); }
__device__ __forceinline__ float fast_tanh(float x) { const float e = __expf(2.0f * x); return 1.0f - 2.0f * __builtin_amdgcn_rcpf(e + 1.0f); }
__device__ __forceinline__ float softplusf(float x) { return fmaxf(x, 0.f) + log1pf(__expf(-fabsf(x))); }
__device__ __forceinline__ float wave_sum(float v) {
#pragma unroll
    for (int o = 1; o < 64; o <<= 1) v += __shfl_xor(v, o);
    return v;
}
template <int CTRL> __device__ __forceinline__ float dppf(float x) { return __builtin_bit_cast(float, __builtin_amdgcn_mov_dpp(__builtin_bit_cast(int, x), CTRL, 0xf, 0xf, true)); }
__device__ __forceinline__ float row16_sum(float v) {
    v += dppf<0xB1>(v); v += dppf<0x4E>(v); v += dppf<0x141>(v); v += dppf<0x140>(v); return v;
}
#define XB_TMO      128
#define XB_XCNT(j)  (256  + 64 * (j))
#define XB_XSUB(j)  (1280 + 64 * (j))
#define XB_XGEN(j)  (2304 + 64 * (j))
#define XB_TOP      3328
#define XB_TOPGEN   3392
#define XCD_BAR_WORDS 3456
#define XB_SPIN_CAP (1u << 18)

__device__ __forceinline__ unsigned xb_ld(unsigned* p)              { return __hip_atomic_load(p, __ATOMIC_RELAXED, __HIP_MEMORY_SCOPE_AGENT); }
__device__ __forceinline__ unsigned xb_add(unsigned* p, unsigned v) { return __hip_atomic_fetch_add(p, v, __ATOMIC_RELAXED, __HIP_MEMORY_SCOPE_AGENT); }
__device__ __forceinline__ unsigned xb_xcc_id() { return (unsigned)__builtin_amdgcn_s_getreg((3 << 11) | 20) & 0xFu; }
#define XB_SPIN(cond, bar) do { unsigned _sp = 0; while (cond) { __builtin_amdgcn_s_sleep(1); \
    if ((++_sp & 255u) == 0u) { if (xb_ld(&(bar)[XB_TMO])) break; if (_sp > XB_SPIN_CAP) { atomicAdd(&(bar)[XB_TMO], 1u); break; } } } } while (0)

struct XcdBarrier {
    unsigned* bar; unsigned x;
    volatile LAS unsigned* st;
};

__device__ __forceinline__ XcdBarrier xcd_barrier_post(unsigned* bar, volatile LAS unsigned* st) {
    XcdBarrier b; b.bar = bar; b.x = xb_xcc_id(); b.st = st;
    if (threadIdx.x == 0) (void)xb_add(&bar[XB_XCNT(b.x)], 1u);
    return b;
}
__device__ __forceinline__ void xcd_barrier_complete(unsigned* bar, unsigned x, unsigned& nloc, unsigned& nx) {
    const unsigned G = gridDim.x * gridDim.y * gridDim.z;
    unsigned sum, cnt, mine, sp = 0u;
    for (;;) {
        sum = 0u; cnt = 0u; mine = 0u;
#pragma unroll
        for (unsigned j = 0; j < 16; ++j) { const unsigned c = xb_ld(&bar[XB_XCNT(j)]); sum += c; cnt += (c > 0u) ? 1u : 0u; mine = (j == x) ? c : mine; }
        if (sum == G) break;
        __builtin_amdgcn_s_sleep(1);
        if ((++sp & 255u) == 0u) { if (xb_ld(&bar[XB_TMO])) break; if (sp > XB_SPIN_CAP) { atomicAdd(&bar[XB_TMO], 1u); break; } }
    }
    nloc = mine > 0u ? mine : 1u; nx = cnt > 0u ? cnt : 1u;
}

__device__ __forceinline__ void xcd_barrier(const XcdBarrier& b) {
    asm volatile("s_waitcnt vmcnt(0)" ::: "memory");
    __syncthreads();
    if (threadIdx.x == 0) {
        unsigned* bar = b.bar;
        __builtin_amdgcn_s_waitcnt(0);
        unsigned nloc = b.st[0], nx = b.st[1];
        if (nloc == 0u) { xcd_barrier_complete(bar, b.x, nloc, nx); b.st[0] = nloc; b.st[1] = nx; }
        const unsigned old = xb_add(&bar[XB_XSUB(b.x)], 1u);
        const unsigned gen = old / nloc;
        if (old + 1u == (gen + 1u) * nloc) {
            __builtin_amdgcn_fence(__ATOMIC_RELEASE, "agent");
            asm volatile("s_waitcnt vmcnt(0)" ::: "memory");
            const unsigned og = xb_add(&bar[XB_TOP], 1u);
            const unsigned tg = og / nx;
            if (og + 1u == (tg + 1u) * nx) xb_add(&bar[XB_TOPGEN], 1u);
            else XB_SPIN(xb_ld(&bar[XB_TOPGEN]) == tg, bar);
            __builtin_amdgcn_fence(__ATOMIC_ACQUIRE, "agent");
            xb_add(&bar[XB_XGEN(b.x)], 1u);
            asm volatile("s_waitcnt vmcnt(0)" ::: "memory");
        } else {
            XB_SPIN(xb_ld(&bar[XB_XGEN(b.x)]) == gen, bar);
            __builtin_amdgcn_fence(__ATOMIC_ACQUIRE, "agent");
            asm volatile("s_waitcnt vmcnt(0)" ::: "memory");
        }
    }
    __syncthreads();
}

struct Frame {
    LAS unsigned char* lds;
    volatile LAS unsigned* MISC;
    int tid, lane, wave, vcu, G;
};
struct Args { const float* in[39]; float* out; unsigned char* ws; int ph_lo, ph_hi; };
enum { I_X = 0, I_MEM, I_GMIX, I_WIN, I_MU, I_W0, I_W2, I_A0, I_A2, I_G2, I_KK, I_KA, I_RK, I_LNW, I_LNB, I_WRO, I_CONVW, I_CONVB, I_LWR, I_LBR, I_LWI, I_LBI, I_LAM, I_WLO,
       I_GMEM, I_WMK, I_WMV, I_WXO, I_WOUT, I_GFFN, I_WROUTER, I_BROUTER, I_WGATE, I_BGATE, I_WUP, I_BUP, I_WDOWN, I_BDOWN, I_GFINAL };


__device__ __forceinline__ const float* inp(int k) {
    typedef const volatile unsigned long long __attribute__((address_space(4))) ka_t;
    ka_t* ka = (ka_t*)__builtin_amdgcn_kernarg_segment_ptr();
    return (const float*)ka[k];
}
template <int NB> __device__ __forceinline__ void transpose_item(const float* W, int N, int k0, int n0, bf16* WT, int Kd, int drow0, int lane, int kdo = 0) {
    constexpr int LPR = NB / 4, G = 64 / LPR, KR = 64 / G;
    const int g = lane / LPR, c = lane % LPR;
    const GAS float* src = (const GAS float*)W + (size_t)(k0 + KR * g) * N + n0 + 4 * c;
    f32x4 ld[KR];
#pragma unroll
    for (int i = 0; i < KR; ++i) ld[i] = __builtin_nontemporal_load((const GAS f32x4*)(src + (size_t)i * N));
    GAS bf16* dst = (GAS bf16*)WT + (size_t)(drow0 + 4 * c) * Kd + kdo + k0 + KR * g;
#pragma unroll
    for (int j = 0; j < 4; ++j)
#pragma unroll
        for (int q = 0; q < KR / 8; ++q) { v4u o; o.x = pk2(ld[8 * q + 0][j], ld[8 * q + 1][j]); o.y = pk2(ld[8 * q + 2][j], ld[8 * q + 3][j]); o.z = pk2(ld[8 * q + 4][j], ld[8 * q + 5][j]); o.w = pk2(ld[8 * q + 6][j], ld[8 * q + 7][j]);
            *(GAS v4u*)(dst + (size_t)j * Kd + 8 * q) = o; }
}
__device__ __forceinline__ unsigned pk4_fp8(float a, float b, float c, float d) { int w = __builtin_amdgcn_cvt_pk_fp8_f32(a, b, 0, false); w = __builtin_amdgcn_cvt_pk_fp8_f32(c, d, w, true); return (unsigned)w; }
__device__ __forceinline__ void transpose_item_fp8(const float* W, int N, int k0, int n0, unsigned char* WT, int Kd, int drow0, int lane, float scale) {
    const int g = lane >> 4, c = lane & 15;
    const GAS float* src = (const GAS float*)W + (size_t)(k0 + 16 * g) * N + n0 + 4 * c;
    f32x4 ld[16];
#pragma unroll
    for (int i = 0; i < 16; ++i) ld[i] = __builtin_nontemporal_load((const GAS f32x4*)(src + (size_t)i * N)) * scale;
    GAS unsigned char* dst = (GAS unsigned char*)WT + (size_t)(drow0 + 4 * c) * Kd + k0 + 16 * g;
#pragma unroll
    for (int j = 0; j < 4; ++j) { v4u o; o.x = pk4_fp8(ld[0][j], ld[1][j], ld[2][j], ld[3][j]); o.y = pk4_fp8(ld[4][j], ld[5][j], ld[6][j], ld[7][j]); o.z = pk4_fp8(ld[8][j], ld[9][j], ld[10][j], ld[11][j]); o.w = pk4_fp8(ld[12][j], ld[13][j], ld[14][j], ld[15][j]);
        *(GAS v4u*)(dst + (size_t)j * Kd) = o; }
}
__device__ __forceinline__ void transpose_item_fp8_k128(const float* W, int N, int k0, int n0, unsigned char* WT, int Kd, int drow0, int lane, float scale) {
    const int g = lane >> 3, c = lane & 7;
    const GAS float* src = (const GAS float*)W + (size_t)(k0 + 16 * g) * N + n0 + 4 * c;
    f32x4 ld[16];
#pragma unroll
    for (int i = 0; i < 16; ++i) ld[i] = __builtin_nontemporal_load((const GAS f32x4*)(src + (size_t)i * N)) * scale;
    GAS unsigned char* dst = (GAS unsigned char*)WT + (size_t)(drow0 + 4 * c) * Kd + k0 + 16 * g;
#pragma unroll
    for (int j = 0; j < 4; ++j) { v4u o; o.x = pk4_fp8(ld[0][j], ld[1][j], ld[2][j], ld[3][j]); o.y = pk4_fp8(ld[4][j], ld[5][j], ld[6][j], ld[7][j]); o.z = pk4_fp8(ld[8][j], ld[9][j], ld[10][j], ld[11][j]); o.w = pk4_fp8(ld[12][j], ld[13][j], ld[14][j], ld[15][j]);
        *(GAS v4u*)(dst + (size_t)j * Kd) = o; }
}
__device__ __forceinline__ void transpose_item_fp8_32(const float* W, int N, int k0, int n0, unsigned char* WT, int Kd, int drow0, int lane, float scale) {
    const int g = lane >> 3, c = lane & 7;
    const GAS float* src = (const GAS float*)W + (size_t)(k0 + 8 * g) * N + n0 + 4 * c;
    f32x4 ld[8];
#pragma unroll
    for (int i = 0; i < 8; ++i) ld[i] = __builtin_nontemporal_load((const GAS f32x4*)(src + (size_t)i * N)) * scale;
    GAS unsigned char* dst = (GAS unsigned char*)WT + (size_t)(drow0 + 4 * c) * Kd + k0 + 8 * g;
#pragma unroll
    for (int j = 0; j < 4; ++j) { v2u o; o.x = pk4_fp8(ld[0][j], ld[1][j], ld[2][j], ld[3][j]); o.y = pk4_fp8(ld[4][j], ld[5][j], ld[6][j], ld[7][j]); *(GAS v2u*)(dst + (size_t)j * Kd) = o; }
}
__device__ __forceinline__ void rms_row_to_bf16(const float* xrow, const float* gain, bf16* orow, int lane, unsigned char* orow8 = nullptr) {
    const GAS f32x4* xr = (const GAS f32x4*)xrow + lane; const GAS f32x4* gr = (const GAS f32x4*)gain + lane;
    f32x4 v[8]; float s = 0.f;
#pragma unroll
    for (int j = 0; j < 8; ++j) { v[j] = xr[64 * j]; s += (v[j].x * v[j].x + v[j].y * v[j].y) + (v[j].z * v[j].z + v[j].w * v[j].w); }
    const float rstd = 1.0f / sqrtf(wave_sum(s) * (1.f / D) + EPS);
    GAS v2u* o8 = (GAS v2u*)orow + lane;
#pragma unroll
    for (int j = 0; j < 8; ++j) { const f32x4 g = gr[64 * j]; v2u w; w.x = pk2(v[j].x * rstd * g.x, v[j].y * rstd * g.y); w.y = pk2(v[j].z * rstd * g.z, v[j].w * rstd * g.w); o8[64 * j] = w;
        if (orow8) ((GAS unsigned*)orow8)[lane + 64 * j] = pk4_fp8(v[j].x * rstd * g.x, v[j].y * rstd * g.y, v[j].z * rstd * g.z, v[j].w * rstd * g.w); }
}

__device__ __forceinline__ void p0_prologue(const Frame& F, const Args& a) {
    unsigned char* ws = a.ws;
    const int gw = F.vcu * NWAVES + F.wave, NGW = F.G * NWAVES;
    constexpr int I_IN = 32 * (IN_COLS / 32), I_MK = 32 * 32, I_BR = 16 * 64, I_O = 32 * 64;
    constexpr int NITEMS = I_IN + 2 * I_MK + 3 * I_BR + I_O;
    for (int it = gw; it < NITEMS; it += NGW) {
        int r = it;
        if (r < I_IN) { const int nb = IN_COLS / 32, kb = r / nb, n0 = 32 * (r % nb);
            if (n0 >= PC_LX - 224) { if (!(kb & 1)) transpose_item_fp8_k128(inp(I_WIN), IN_COLS, 64 * kb, n0, ws + WS_WIN8, D, n0 - (PC_LX - 224), F.lane, 64.0f); }
            else transpose_item<32>(inp(I_WIN), IN_COLS, 64 * kb, n0, (bf16*)(ws + WS_WIN), D, n0 + (n0 >= RWKV_COLS ? 224 : 0), F.lane);
            continue; } r -= I_IN;
        if (r < I_MK) { transpose_item<32>(inp(I_WMK), 1024, 64 * (r / 32), 32 * (r % 32), (bf16*)(ws + WS_WMKV), D, 32 * (r % 32), F.lane); continue; } r -= I_MK;
        if (r < I_MK) { transpose_item<32>(inp(I_WMV), 1024, 64 * (r / 32), 32 * (r % 32), (bf16*)(ws + WS_WMKV), D, 1024 + 32 * (r % 32), F.lane); continue; } r -= I_MK;
        if (r < I_BR) { transpose_item<32>(inp(I_WRO), 2048, 64 * (r / 64), 32 * (r % 64), (bf16*)(ws + WS_WBR), 3072, 32 * (r % 64), F.lane, 0); continue; } r -= I_BR;
        if (r < I_BR) { transpose_item<32>(inp(I_WLO), 2048, 64 * (r / 64), 32 * (r % 64), (bf16*)(ws + WS_WBR), 3072, 32 * (r % 64), F.lane, 1024); continue; } r -= I_BR;
        if (r < I_BR) { transpose_item<32>(inp(I_WXO), 2048, 64 * (r / 64), 32 * (r % 64), (bf16*)(ws + WS_WBR), 3072, 32 * (r % 64), F.lane, 2048); continue; } r -= I_BR;
        transpose_item<32>(inp(I_WOUT), 2048, 64 * (r / 64), 32 * (r % 64), (bf16*)(ws + WS_WO), D, 32 * (r % 64), F.lane);
    }
    for (int m = gw; m < T; m += NGW) rms_row_to_bf16(inp(I_X) + (size_t)m * D, inp(I_GMIX), (bf16*)(ws + WS_XN) + (size_t)m * D, F.lane, ws + WS_XN8 + (size_t)m * D);
    for (int m = gw; m < 512; m += NGW) rms_row_to_bf16(inp(I_MEM) + (size_t)m * D, inp(I_GMEM), (bf16*)(ws + WS_MN) + (size_t)m * D, F.lane);
    const int gt = F.vcu * (NWAVES * 64) + F.tid, NGT = F.G * NWAVES * 64;
    { bf16* wz = (bf16*)(ws + WS_WIN) + (size_t)RWKV_COLS * D; for (int i = gt; i < 224 * D / 2; i += NGT) ((GAS unsigned*)wz)[i] = 0u; }
    { bf16* wl = (bf16*)(ws + WS_WLORA);
      for (int i = gt; i < 3072 * LORA_K; i += NGT) { const int n = i / LORA_K, k = i % LORA_K; float v = 0.f;
          if (n < 1024) { if (k < 64) v = inp(I_W2)[k * 1024 + n]; }
          else if (n < 2048) { if (k >= 64 && k < 128) v = inp(I_A2)[(k - 64) * 1024 + (n - 1024)]; }
          else { if (k >= 128 && k < 288) v = inp(I_G2)[(k - 128) * 1024 + (n - 2048)]; }
          wl[i] = (bf16)f2bf(v); } }
    { const float* lam = inp(I_LAM); float* spl = (float*)(ws + WS_SPL); for (int i = gt; i < 1024; i += NGT) spl[i] = softplusf(-lam[i]); }
    { bf16* wr = (bf16*)(ws + WS_WR);
      for (int i = gt; i < 32 * D; i += NGT) { const int e = i / D, k = i % D; const float w = inp(I_WROUTER)[k * 32 + e]; const unsigned hi = f2bf(w); const float r = w - __builtin_bit_cast(float, hi << 16);
          wr[i] = (bf16)hi; wr[32 * D + i] = (bf16)f2bf(r); } }
    { const float* lwi_p = inp(I_LWI); const float* lwr_p = inp(I_LWR); bf16* lw = (bf16*)(ws + WS_LW);
      for (int i = gt; i < 2 * 16 * 4 * 2 * 64 * 8; i += NGT) { const int j = i & 7, ln = (i >> 3) & 63, ks = (i >> 9) & 1, vbo = (i >> 10) & 3, n = (i >> 12) & 15, mat = i >> 16;
          const int w = 32 * ks + 16 * (j >> 2) + 4 * (ln >> 4) + (j & 3), v = 16 * vbo + (ln & 15);
          lw[i] = (bf16)f2bf((mat ? lwi_p : lwr_p)[(n * 64 + w) * 64 + v]); } }
}

template <int PART  > __device__ __forceinline__ void moe_weight_convert(const Frame& F, const Args& a, int gw, int NGW) {
    unsigned char* ws = a.ws;
    const float* wg = inp(I_WGATE); const float* wu = inp(I_WUP); const float* wd = inp(I_WDOWN);
    constexpr int PER = 1024;
    for (int it = gw; it < NE * (PART == 0 ? 2 : 1) * PER; it += NGW) {
        const int e = it / ((PART == 0 ? 2 : 1) * PER), r = it % ((PART == 0 ? 2 : 1) * PER), which = PART == 0 ? r / PER : 2, q = r % PER, k0 = 128 * (q / 64), n0 = 32 * (q % 64);
        if (which == 0) transpose_item_fp8_k128(wg + (size_t)e * D * D, D, k0, n0, ws + WS_WGU + (size_t)e * 4096 * D, D, (n0 >> 7) * 256 + (n0 & 127), F.lane, 64.0f);
        else if (which == 1) transpose_item_fp8_k128(wu + (size_t)e * D * D, D, k0, n0, ws + WS_WGU + (size_t)e * 4096 * D, D, (n0 >> 7) * 256 + 128 + (n0 & 127), F.lane, 64.0f);
        else transpose_item_fp8_k128(wd + (size_t)e * D * D, D, k0, n0, ws + WS_WD + (size_t)e * 2048 * D, D, n0, F.lane, 64.0f);
    }
}

__device__ __forceinline__ void r1_lora_in(const Frame& F, const Args& a) {
    const bf16* P = (const bf16*)(a.ws + WS_P); bf16* L = (bf16*)(a.ws + WS_XN);
    const float* mu = inp(I_MU);
    const int gw = F.vcu * NWAVES + F.wave, NGW = F.G * NWAVES;
    for (int m0 = gw * 8; m0 < T; m0 += NGW * 8) {
        bf16 pv[9][5]; float muv[5];
#pragma unroll
        for (int j = 0; j < 5; ++j) { const int k = F.lane + 64 * j; muv[j] = k < 288 ? mu[3072 + k] : 0.f;
#pragma unroll
            for (int t = 0; t < 9; ++t) { const int m = m0 + t - 1; pv[t][j] = (k < 288 && m >= 0) ? P[(size_t)m * NP + 3072 + k] : (bf16)0; } }
#pragma unroll
        for (int t = 0; t < 8; ++t) { const int m = m0 + t; const bool first = (m % SEQ) == 0;
#pragma unroll
            for (int j = 0; j < 6; ++j) { const int k = F.lane + 64 * j; float o = 0.f;
                if (j < 5 && k < 288) { const float cur = bf1(pv[t + 1][j]); const float prev = first ? 0.f : bf1(pv[t][j]);
                    const float x = cur + (prev - cur) * muv[j]; o = k < 64 ? fast_tanh(x) : (k < 128 ? x : sigm(x)); }
                L[(size_t)m * LORA_K + k] = (bf16)f2bf(o); } }
    }
}

constexpr int REC_F = 1536, REC_AT = 0, REC_RT = 512, REC_BKT = 512, REC_WC = 1024, REC_N = 1088, REC_Q = 1152, REC_V8 = 1216;
__device__ __forceinline__ float wave_sum_fast(float v) { v = row16_sum(v); v += __shfl_xor(v, 16); v += __shfl_xor(v, 32); return v; }
__device__ __forceinline__ void r3_blocks(const Frame& F, const Args& a) {
    const GAS bf16* P = (const GAS bf16*)(a.ws + WS_P); const GAS bf16* LO = (const GAS bf16*)(a.ws + WS_LORAOUT);
    GAS float* REC = (GAS float*)(a.ws + WS_SCAN); GAS float* BON = (GAS float*)(a.ws + WS_BONUS);
    const GAS float* mu = (const GAS float*)inp(I_MU); const GAS float* w0 = (const GAS float*)inp(I_W0); const GAS float* a0 = (const GAS float*)inp(I_A0);
    const GAS float* kkp = (const GAS float*)inp(I_KK); const GAS float* kap = (const GAS float*)inp(I_KA); const GAS float* rkp = (const GAS float*)inp(I_RK);
    LAS float* G1 = (LAS float*)(F.lds + F.wave * 16384);
    LAS float* G2 = G1 + 2048;
    const int gw = F.vcu * NWAVES + F.wave, NGW = F.G * NWAVES, lane = F.lane;
    struct Raw { bf16 pr0, pk0, pv0, cr[8], ck[8], cv[8], lw[8], la[8]; float mur, muk, muv, w0c, a0c, kkw, kaw, rkw; };
#define R3_LOAD(R, it_) do { const int bh_ = (it_) >> 10, blk_ = (it_) & 1023, c_ = (bh_ & 15) * 64 + lane, m0_ = (bh_ >> 4) * SEQ + blk_ * 8; \
        R.mur = mu[c_]; R.muk = mu[1024 + c_]; R.muv = mu[2048 + c_]; R.w0c = w0[c_]; R.a0c = a0[c_]; R.kkw = kkp[c_]; R.kaw = kap[c_]; R.rkw = rkp[c_]; \
        { const GAS bf16* pp_ = P + (size_t)(m0_ - (blk_ > 0 ? 1 : 0)) * NP; R.pr0 = pp_[c_]; R.pk0 = pp_[1024 + c_]; R.pv0 = pp_[2048 + c_]; } \
        _Pragma("unroll") for (int t_ = 0; t_ < 8; ++t_) { const GAS bf16* pc_ = P + (size_t)(m0_ + t_) * NP; R.cr[t_] = pc_[c_]; R.ck[t_] = pc_[1024 + c_]; R.cv[t_] = pc_[2048 + c_]; \
            R.lw[t_] = LO[(size_t)(m0_ + t_) * 3072 + c_]; R.la[t_] = LO[(size_t)(m0_ + t_) * 3072 + 1024 + c_]; } } while (0)
    Raw cur; if (gw < 32 * 1024) R3_LOAD(cur, gw);
#pragma unroll 1
    for (int it = gw; it < 32 * 1024; it += NGW) {
        const int bh = it >> 10, blk = it & 1023, b = bh >> 4, h = bh & 15, m0 = b * SEQ + blk * 8;
        Raw nxt = cur; if (it + NGW < 32 * 1024) R3_LOAD(nxt, it + NGW);
        const float mur = cur.mur, muk = cur.muk, muv = cur.muv, w0c = cur.w0c, a0c = cur.a0c, kkw = cur.kkw, kaw = cur.kaw, rkw = cur.rkw;
        float w[8], av[8], bv[8], kv[8], rv[8], vv[8], ag[8], kk[8], n2[8], bo[8];
        float pr = 0.f, pk = 0.f, pv = 0.f;
        if (blk > 0) { pr = bf1(cur.pr0); pk = bf1(cur.pk0); pv = bf1(cur.pv0); }
#pragma unroll
        for (int t = 0; t < 8; ++t) { const float cr = bf1(cur.cr[t]), ck = bf1(cur.ck[t]), cv = bf1(cur.cv[t]);
            const float r = cr + (pr - cr) * mur, k = ck + (pk - ck) * muk, v = cv + (pv - cv) * muv; pr = cr; pk = ck; pv = cv;
            const float wpre = w0c + bf1(cur.lw[t]), apre = a0c + bf1(cur.la[t]);
            w[t] = __expf(-0.6065306597126334f * __builtin_amdgcn_rcpf(1.0f + __expf(-wpre)));
            ag[t] = __builtin_amdgcn_rcpf(1.0f + __expf(-apre));
            kk[t] = k * kkw; n2[t] = kk[t] * kk[t];
            kv[t] = k * (1.0f + (ag[t] - 1.0f) * kaw); rv[t] = r; vv[t] = v; bo[t] = r * kv[t] * rkw; }
#pragma unroll
        for (int t = 0; t < 8; ++t) { n2[t] = wave_sum_fast(n2[t]); bo[t] = wave_sum_fast(bo[t]); }
#pragma unroll
        for (int t = 0; t < 8; ++t) { const float kkn = kk[t] * (1.0f / sqrtf(fmaxf(n2[t], 1e-24f))); av[t] = -kkn; bv[t] = kkn * ag[t]; if (lane == 0) BON[(m0 + t) * 16 + h] = bo[t]; }
        float Pp[8]; Pp[0] = w[0];
#pragma unroll
        for (int t = 1; t < 8; ++t) Pp[t] = Pp[t - 1] * w[t];
        float bch[8], kch[8], ah[8], rh[8];
#pragma unroll
        for (int t = 0; t < 8; ++t) { const float pin = __builtin_amdgcn_rcpf(Pp[t]); bch[t] = bv[t] * pin; kch[t] = kv[t] * pin; ah[t] = av[t] * (t > 0 ? Pp[t - 1] : 1.0f); rh[t] = rv[t] * Pp[t]; }
        const int pos = (lane & 3) * 16 + (lane >> 2);
#pragma unroll
        for (int t = 0; t < 8; ++t) { G1[t * 64 + pos] = bch[t]; G1[(8 + t) * 64 + pos] = kch[t]; G1[(16 + t) * 64 + pos] = ah[t]; G1[(24 + t) * 64 + pos] = rh[t]; }
        LDS_WAIT(); asm volatile("" ::: "memory");
        f32x4 fa[4], fb[4];
#pragma unroll
        for (int q = 0; q < 4; ++q) { fa[q] = *(const LAS f32x4*)(G1 + (lane & 15) * 64 + (lane >> 4) * 16 + 4 * q); fb[q] = *(const LAS f32x4*)(G1 + (16 + (lane & 15)) * 64 + (lane >> 4) * 16 + 4 * q); }
        f32x4 dacc = {0.f, 0.f, 0.f, 0.f};
#pragma unroll
        for (int s2 = 0; s2 < 16; ++s2) dacc = __builtin_amdgcn_mfma_f32_16x16x4f32(fa[s2 >> 2][s2 & 3], fb[s2 >> 2][s2 & 3], dacc, 0, 0, 0);
        *(LAS f32x4*)(G2 + (lane & 15) * 16 + 4 * (lane >> 4)) = dacc;
        LDS_WAIT(); asm volatile("" ::: "memory");
        float M[8][8];
        { float Lm[8][8];
#pragma unroll
          for (int t = 1; t < 8; ++t) { const f32x4 l0 = *(const LAS f32x4*)(G2 + t * 16), l1 = *(const LAS f32x4*)(G2 + t * 16 + 4);
#pragma unroll
              for (int i = 0; i < 4; ++i) { Lm[t][i] = l0[i]; Lm[t][4 + i] = l1[i]; } }
#pragma unroll
          for (int t = 0; t < 8; ++t) { M[t][t] = 1.0f;
#pragma unroll
              for (int i = t - 1; i >= 0; --i) { float acc = 0.f;
#pragma unroll
                  for (int j = i; j < t; ++j) acc += Lm[t][j] * M[j][i];
                  M[t][i] = acc; } } }
        GAS float* rec = REC + ((size_t)bh * 1024 + blk) * REC_F; GAS bf16* recb = (GAS bf16*)rec;
#pragma unroll
        for (int t = 0; t < 8; ++t) { float acc = 0.f;
#pragma unroll
            for (int i = 0; i <= t; ++i) acc += M[t][i] * ah[i];
            recb[t * 64 + lane] = (bf16)(cvtpk(acc, 0.f) & 0xffffu); }
        float Nm[8][8];
        { float Km[8][8];
#pragma unroll
          for (int t = 1; t < 8; ++t) { const f32x4 l0 = *(const LAS f32x4*)(G2 + t * 16 + 8), l1 = *(const LAS f32x4*)(G2 + t * 16 + 12);
#pragma unroll
              for (int i = 0; i < 4; ++i) { Km[t][i] = l0[i]; Km[t][4 + i] = l1[i]; } }
#pragma unroll
          for (int t = 0; t < 8; ++t)
#pragma unroll
              for (int i = 0; i < 8; ++i) { float acc = 0.f;
                  if (i < t) {
#pragma unroll
                      for (int j = i + 1; j <= t; ++j) acc += M[t][j] * Km[j][i]; }
                  Nm[t][i] = acc; } }
        float rb[8][8];
#pragma unroll
        for (int t = 0; t < 8; ++t) { const f32x4 l0 = *(const LAS f32x4*)(G2 + (8 + t) * 16), l1 = *(const LAS f32x4*)(G2 + (8 + t) * 16 + 4);
#pragma unroll
            for (int i = 0; i < 4; ++i) { rb[t][i] = l0[i]; rb[t][4 + i] = l1[i]; } }
#pragma unroll
        for (int t = 0; t < 8; ++t) { float acc = rh[t];
#pragma unroll
            for (int i = 0; i <= t; ++i) { float rm = 0.f;
#pragma unroll
                for (int j = i; j <= t; ++j) rm += rb[t][j] * M[j][i];
                acc += rm * ah[i]; }
            recb[(8 + t) * 64 + lane] = (bf16)(cvtpk(acc, 0.f) & 0xffffu); }
        float Qm[8][8];
#pragma unroll
        for (int t = 0; t < 8; ++t) { const f32x4 l0 = *(const LAS f32x4*)(G2 + (8 + t) * 16 + 8), l1 = *(const LAS f32x4*)(G2 + (8 + t) * 16 + 12);
#pragma unroll
            for (int i = 0; i < 8; ++i) { float acc = 0.f;
                if (i <= t) { acc = i < 4 ? l0[i & 3] : l1[i & 3];
#pragma unroll
                    for (int j = i + 1; j <= t; ++j) acc += rb[t][j] * Nm[j][i]; }
                Qm[t][i] = acc; } }
        { unsigned hw[8];
#pragma unroll
          for (int i2 = 0; i2 < 8; ++i2) { const float x0 = (i2 < 4 ? bch[2 * i2] : kch[2 * i2 - 8]) * Pp[7], x1 = (i2 < 4 ? bch[2 * i2 + 1] : kch[2 * i2 - 7]) * Pp[7]; hw[i2] = cvtpk(x0, x1); }
          GAS v4u* bk_ = (GAS v4u*)(recb + 1024 + lane * 16);
          bk_[0] = (v4u){hw[0], hw[1], hw[2], hw[3]}; bk_[1] = (v4u){hw[4], hw[5], hw[6], hw[7]}; }
        rec[REC_WC + lane] = Pp[7];
        if (lane == 0) {
#pragma unroll
            for (int t = 0; t < 8; ++t) { *(GAS f32x4*)(rec + REC_N + t * 8) = (f32x4){Nm[t][0], Nm[t][1], Nm[t][2], Nm[t][3]}; *(GAS f32x4*)(rec + REC_N + t * 8 + 4) = (f32x4){Nm[t][4], Nm[t][5], Nm[t][6], Nm[t][7]};
                *(GAS f32x4*)(rec + REC_Q + t * 8) = (f32x4){Qm[t][0], Qm[t][1], Qm[t][2], Qm[t][3]}; *(GAS f32x4*)(rec + REC_Q + t * 8 + 4) = (f32x4){Qm[t][4], Qm[t][5], Qm[t][6], Qm[t][7]}; } }
        *(GAS v4u*)((GAS unsigned*)(rec + REC_V8) + lane * 4) = (v4u){cvtpk(vv[0], vv[1]), cvtpk(vv[2], vv[3]), cvtpk(vv[4], vv[5]), cvtpk(vv[6], vv[7])};
        LDS_WAIT(); asm volatile("" ::: "memory");
        cur = nxt;
    }
#undef R3_LOAD
}

constexpr int SC_NS = 16, SC_RB = REC_F * 4, SC_SYNC = SC_NS * SC_RB;
__device__ __forceinline__ unsigned lds_word(const volatile LAS unsigned* p) { return (unsigned)__builtin_amdgcn_readfirstlane((int)*p); }
__device__ __forceinline__ bool scan_wg(int& bh, int& quarter) { const int bx = blockIdx.x; if (gridDim.x != 256 || ((bx >> 3) & 1)) return false; const int slot = bx >> 4; bh = (bx & 7) * 4 + (slot >> 2); quarter = slot & 3; return true; }
__device__ __forceinline__ void r4_feeder(const Frame& F, const Args& a, int bh) {
    const GAS char* gsrc = (const GAS char*)(a.ws + WS_SCAN) + (size_t)bh * 1024 * SC_RB + F.lane * 16;
    LAS unsigned char* ring = F.lds;
    volatile LAS unsigned* sync = (volatile LAS unsigned*)(F.lds + SC_SYNC);
    bool dead = false;
    __builtin_amdgcn_s_setprio(2);
#pragma unroll 1
    for (int B = 0; B < 1024; ++B) {
        if (B >= SC_NS && !dead) { unsigned spins = 0; for (;;) { const unsigned d0 = lds_word(sync + 16); if ((int)d0 > B - SC_NS) break; if (++spins > (1u << 20)) { dead = true; break; } __builtin_amdgcn_s_sleep(2); } }
        LAS unsigned char* slot = ring + (B % SC_NS) * SC_RB;
#pragma unroll
        for (int q = 0; q < 6; ++q) __builtin_amdgcn_global_load_lds((const GAS unsigned*)(gsrc + (size_t)B * SC_RB + q * 1024), (LAS unsigned*)(slot + q * 1024), 16, 0, 0);
        asm volatile("s_waitcnt vmcnt(48)" ::: "memory");
        if (B >= 8 && F.lane == 0) sync[0] = (unsigned)(B - 7);
    }
    asm volatile("s_waitcnt vmcnt(0)" ::: "memory");
    if (F.lane == 0) sync[0] = 1024u;
    __builtin_amdgcn_s_setprio(0);
}
template <int VAR> __device__ __forceinline__ void r4_scan(const Frame& F, const Args& a, int bh, int quarter) {
    float* YT = (float*)(a.ws + WS_XN);
    constexpr int RB = SC_RB;
    __builtin_amdgcn_s_setprio(3);
    const int r = F.lane & 15, q = F.lane >> 4, rowg = quarter * 16 + r;
    LAS unsigned char* ring = F.lds;
    volatile LAS unsigned* sync = (volatile LAS unsigned*)(F.lds + SC_SYNC);
    const LAS unsigned char* pVH = ring + (r * 64 + 4 * q) * 2;
    const LAS unsigned char* pNQ = ring + (REC_N + r * 8 + 2 * q) * 4;
    const LAS unsigned char* pVb = ring + REC_V8 * 4 + rowg * 16 + 4 * q;
    const LAS unsigned char* pV4 = ring + REC_V8 * 4 + rowg * 16 + 8 * (q & 1);
    const LAS unsigned char* pBK = ring + 2048 + r * 32 + 8 * q;
    const LAS unsigned char* pWC = ring + (REC_WC + 4 * q) * 4;
    unsigned have = 0; bool dead = (VAR == 1);
#define SC_NEED(n) do { unsigned spins_ = 0; while (have < (unsigned)(n) && !dead) { have = lds_word(sync); if (have >= (unsigned)(n)) break; if (++spins_ > (1u << 20)) { dead = true; break; } __builtin_amdgcn_s_sleep(1); } } while (0)
    f32x4 S[4];
#pragma unroll
    for (int kb = 0; kb < 4; ++kb) S[kb] = (f32x4){0.f, 0.f, 0.f, 0.f};
    GAS bf16* yrow = (GAS bf16*)YT + (size_t)(bh * 64 + rowg) * SEQ + 8 * (q & 1);
    unsigned yp0 = 0u, yp1 = 0u;
#define SC_LD(vh_, nq_, vb_, v4_, bk_, wc_, so_) do { _Pragma("unroll") for (int m_ = 0; m_ < 4; ++m_) { vh_[m_] = *(const LAS v2u*)(pVH + (so_) + 32 * m_); bk_[m_] = *(const LAS v2u*)(pBK + (so_) + m_ * 512); wc_[m_] = *(const LAS f32x4*)(pWC + (so_) + m_ * 64); } \
        nq_ = *(const LAS f32x2*)(pNQ + (so_)); vb_ = *(const LAS unsigned*)(pVb + (so_)); v4_ = *(const LAS v2u*)(pV4 + (so_)); } while (0)
    v2u vhS[2][4], bkS[2][4], v4S[2]; f32x4 wcS[2][4]; f32x2 nqS[2]; unsigned vbS[2];
    SC_NEED(1); asm volatile("" ::: "memory");
    SC_LD(vhS[0], nqS[0], vbS[0], v4S[0], bkS[0], wcS[0], 0);
#pragma unroll 1
    for (int k0 = 0; k0 < 1024; k0 += SC_NS) {
#pragma unroll
        for (int u = 0; u < SC_NS; ++u) { if (k0 + u >= 1024) break; const int sn = ((u + 1) % SC_NS) * RB; constexpr int dummy_ = 0; (void)dummy_;
            v2u (&vh)[4] = vhS[u & 1]; v2u (&bk)[4] = bkS[u & 1]; f32x4 (&wc)[4] = wcS[u & 1]; const v2u v4 = v4S[u & 1]; const f32x2 nq = nqS[u & 1]; const f32x2 vb = {bflo(vbS[u & 1]), bfhi(vbS[u & 1])};
            v4u sb[2];
#pragma unroll
            for (int h = 0; h < 2; ++h) { const f32x4 s0_ = S[2 * h], s1_ = S[2 * h + 1]; const float x0 = s0_[0], x1 = s0_[1], x2 = s0_[2], x3 = s0_[3], x4 = s1_[0], x5 = s1_[1], x6 = s1_[2], x7 = s1_[3];
                sb[h] = (v4u){cvtpk(x0, x1), cvtpk(x2, x3), cvtpk(x4, x5), cvtpk(x6, x7)}; }
            f32x4 a0 = {0.f, 0.f, 0.f, 0.f}, a1 = {0.f, 0.f, 0.f, 0.f}, ac = {0.f, 0.f, 0.f, 0.f};
            { const v4u av0 = (v4u){vh[0].x, vh[0].y, vh[1].x, vh[1].y}, av1 = (v4u){vh[2].x, vh[2].y, vh[3].x, vh[3].y};
              a0 = __builtin_amdgcn_mfma_f32_16x16x32_bf16(__builtin_bit_cast(bf16x8, av0), __builtin_bit_cast(bf16x8, sb[0]), a0, 0, 0, 0);
              a1 = __builtin_amdgcn_mfma_f32_16x16x32_bf16(__builtin_bit_cast(bf16x8, av1), __builtin_bit_cast(bf16x8, sb[1]), a1, 0, 0, 0); }
            ac = __builtin_amdgcn_mfma_f32_16x16x4f32(nq[0], vb[0], ac, 0, 0, 0); ac = __builtin_amdgcn_mfma_f32_16x16x4f32(nq[1], vb[1], ac, 0, 0, 0);
            SC_NEED(k0 + u + 2 <= 1024 ? k0 + u + 2 : 1024); asm volatile("" ::: "memory");
            SC_LD(vhS[(u + 1) & 1], nqS[(u + 1) & 1], vbS[(u + 1) & 1], v4S[(u + 1) & 1], bkS[(u + 1) & 1], wcS[(u + 1) & 1], sn);
            asm volatile("" ::: "memory");
            const f32x4 dd = (a0 + ac) + a1;
            { const float y0_ = dd[0], y1_ = dd[1], y2_ = dd[2], y3_ = dd[3]; const unsigned yw0 = cvtpk(y0_, y1_), yw1 = cvtpk(y2_, y3_);
              if (u & 1) { if (q >= 2) *(GAS v4u*)(yrow + ((k0 + u) >> 1) * 16) = (v4u){yp0, yp1, yw0, yw1}; } else { yp0 = yw0; yp1 = yw1; } }
            v2u svp; { const float y0 = dd[0], y1 = dd[1], y2 = dd[2], y3 = dd[3]; const v2u sg = {cvtpk(y0, y1), cvtpk(y2, y3)}; svp = q >= 2 ? v4 : sg; }
            f32x4 n[4];
#pragma unroll
            for (int kb = 0; kb < 4; ++kb) n[kb] = S[kb] * wc[kb];
#pragma unroll
            for (int kb = 0; kb < 4; ++kb) n[kb] = __builtin_amdgcn_mfma_f32_16x16x16bf16_1k(__builtin_bit_cast(bf16x4, bk[kb]), __builtin_bit_cast(bf16x4, svp), n[kb], 0, 0, 0);
#pragma unroll
            for (int kb = 0; kb < 4; ++kb) S[kb] = n[kb];
            asm volatile("" : "+v"(S[0]), "+v"(S[1]), "+v"(S[2]), "+v"(S[3]) :: "memory");
            if (F.lane == 0) sync[16] = (unsigned)(k0 + u + 1);
        }
    }
#undef SC_LD
#undef SC_NEED
    __builtin_amdgcn_s_setprio(0);
}

__device__ __forceinline__ void r5_finish(const Frame& F, const Args& a) {
    const bf16* YT = (const bf16*)(a.ws + WS_XN); const bf16* LO = (const bf16*)(a.ws + WS_LORAOUT); const bf16* P = (const bf16*)(a.ws + WS_P); const float* BON = (const float*)(a.ws + WS_BONUS);
    bf16* YA = (bf16*)(a.ws + WS_YABC);
    LAS float* scr = (LAS float*)(F.lds + F.wave * 16640);
    const int gw = F.vcu * NWAVES + F.wave, NGW = F.G * NWAVES;
    for (int it = gw; it < 32 * 128; it += NGW) {
        const int bh = it >> 7, tt = it & 127, t0 = tt * 64, b = bh >> 4, h = bh & 15;
        float y[64]; float s = 0.f;
        const int tl = F.lane, tp = (tl & 48) + ((tl >> 2) & 1) * 8 + ((tl >> 3) & 1) * 4 + (tl & 3);
#pragma unroll
        for (int v = 0; v < 64; ++v) { y[v] = bf1(YT[(size_t)(bh * 64 + v) * SEQ + t0 + tp]); s += y[v]; }
        const float mean = s * (1.f / 64.f); float q = 0.f;
#pragma unroll
        for (int v = 0; v < 64; ++v) { const float d = y[v] - mean; q += d * d; }
        const float rstd = 1.0f / sqrtf(q * (1.f / 64.f) + GN_EPS);
#pragma unroll
        for (int v = 0; v < 64; ++v) scr[F.lane * 65 + v] = (y[v] - mean) * rstd;
        LDS_WAIT(); asm volatile("" ::: "memory");
        { const int ts = F.lane >> 4, cq = F.lane & 15, c = h * 64 + 4 * cq;
          const f32x4 lw = *(const GAS f32x4*)((const GAS float*)inp(I_LNW) + c), lb = *(const GAS f32x4*)((const GAS float*)inp(I_LNB) + c), muv = *(const GAS f32x4*)((const GAS float*)inp(I_MU) + 2048 + c);
#pragma unroll 4
          for (int tg = 0; tg < 16; ++tg) { const int ti = 4 * tg + ts, m = b * SEQ + t0 + ti;
              f32x4 yn; yn[0] = scr[ti * 65 + 4 * cq]; yn[1] = scr[ti * 65 + 4 * cq + 1]; yn[2] = scr[ti * 65 + 4 * cq + 2]; yn[3] = scr[ti * 65 + 4 * cq + 3];
              const v2u cw = *(const GAS v2u*)((const GAS bf16*)P + (size_t)m * NP + 2048 + c); v2u pw = cw; if (m % SEQ != 0) pw = *(const GAS v2u*)((const GAS bf16*)P + (size_t)(m - 1) * NP + 2048 + c);
              const f32x4 cv = {bflo(cw.x), bfhi(cw.x), bflo(cw.y), bfhi(cw.y)}; f32x4 pv = {bflo(pw.x), bfhi(pw.x), bflo(pw.y), bfhi(pw.y)}; if (m % SEQ == 0) pv = (f32x4){0.f, 0.f, 0.f, 0.f};
              const f32x4 vsh = cv + (pv - cv) * muv;
              const v2u gw_ = *(const GAS v2u*)((const GAS bf16*)LO + (size_t)m * 3072 + 2048 + c); const f32x4 g = {bflo(gw_.x), bfhi(gw_.x), bflo(gw_.y), bfhi(gw_.y)}; const float bon = BON[m * 16 + h];
              const f32x4 o = (yn * lw + lb + vsh * bon) * g;
              v2u w; w.x = pk2(o[0], o[1]); w.y = pk2(o[2], o[3]); *(GAS v2u*)((GAS bf16*)YA + (size_t)m * 3072 + c) = w; } }
        LDS_WAIT(); asm volatile("" ::: "memory");
    }
}

__device__ __forceinline__ float gelu_tanh(float x) { const float u = 0.7978845608028654f * (x + 0.044715f * x * x * x); return 0.5f * x * (1.0f + fast_tanh(u)); }
template <int CTRL> __device__ __forceinline__ float dpp_keep(float old, float x) { return __builtin_bit_cast(float, __builtin_amdgcn_update_dpp(__builtin_bit_cast(int, old), __builtin_bit_cast(int, x), CTRL, 0xf, 0xf, false)); }
template <bool FINAL> __device__ __forceinline__ void lru_pass(const Frame& F, const Args& a, int gw, int NGW) {
    const bf16* P = (const bf16*)(a.ws + WS_P); const bf16* LW = (const bf16*)(a.ws + WS_LW);
    float* CA = (float*)(a.ws + WS_LRUC); float* CB = CA + 256 * 1024; const float* HIN = CB + 256 * 1024;
    bf16* YB = (bf16*)(a.ws + WS_YABC) + 1024;
    const GAS float* lbr_p = (const GAS float*)inp(I_LBR); const GAS float* lbi_p = (const GAS float*)inp(I_LBI); const GAS float* spl_p = (const GAS float*)(a.ws + WS_SPL);
    const GAS float* cvb_p = (const GAS float*)inp(I_CONVB); const GAS float* cvw_p = (const GAS float*)inp(I_CONVW);
    const int tq = F.lane & 15, kq = F.lane >> 4;
    for (int it = gw; it < 256 * 16; it += NGW) {
        const int tt = it >> 4, n = it & 15, m0 = tt * 64, cb = n * 64 + 4 * kq;
        const bool seq0 = (m0 % SEQ) == 0;
        float hcar[4][4];
        float aprod[4][4];
#pragma unroll
        for (int vb = 0; vb < 4; ++vb)
#pragma unroll
            for (int i = 0; i < 4; ++i) { hcar[vb][i] = FINAL ? HIN[tt * 1024 + cb + 16 * vb + i] : 0.f; aprod[vb][i] = 1.f; }
#pragma unroll 1
        for (int tb = 0; tb < 4; ++tb) {
            asm volatile("" ::: "memory");
            const int m = m0 + 16 * tb + tq, tseq = m % SEQ;
            f32x4 xc[4];
#pragma unroll
            for (int vb = 0; vb < 4; ++vb) { const int c = cb + 16 * vb; f32x4 acc = *(const GAS f32x4*)(cvb_p + c);
#pragma unroll
                for (int j = 0; j < 4; ++j) { if (tseq - j >= 0) { const v2u pw = *(const GAS v2u*)((const GAS bf16*)P + (size_t)(m - j) * NP + PC_LX + c); const f32x4 cw = *(const GAS f32x4*)(cvw_p + j * 1024 + c);
                        acc[0] += cw[0] * bflo(pw.x); acc[1] += cw[1] * bfhi(pw.x); acc[2] += cw[2] * bflo(pw.y); acc[3] += cw[3] * bfhi(pw.y); } }
                xc[vb] = acc; }
            bf16x8 bfrag[2];
#pragma unroll
            for (int ks = 0; ks < 2; ++ks) { v4u w; w.x = pk2(xc[2 * ks][0], xc[2 * ks][1]); w.y = pk2(xc[2 * ks][2], xc[2 * ks][3]); w.z = pk2(xc[2 * ks + 1][0], xc[2 * ks + 1][1]); w.w = pk2(xc[2 * ks + 1][2], xc[2 * ks + 1][3]); bfrag[ks] = __builtin_bit_cast(bf16x8, w); }
#pragma unroll
            for (int vb = 0; vb < 4; ++vb) {
                f32x4 gr = {0.f, 0.f, 0.f, 0.f}, gi = {0.f, 0.f, 0.f, 0.f};
#pragma unroll
                for (int ks = 0; ks < 2; ++ks) { const bf16x8 wr_ = *(const bf16x8*)(LW + ((((size_t)(0 * 16 + n) * 4 + vb) * 2 + ks) * 64 + F.lane) * 8); const bf16x8 wi_ = *(const bf16x8*)(LW + ((((size_t)(1 * 16 + n) * 4 + vb) * 2 + ks) * 64 + F.lane) * 8);
                    gr = __builtin_amdgcn_mfma_f32_16x16x32_bf16(wr_, bfrag[ks], gr, 0, 0, 0); gi = __builtin_amdgcn_mfma_f32_16x16x32_bf16(wi_, bfrag[ks], gi, 0, 0, 0); }
                const int c = cb + 16 * vb;
                const f32x4 brv = *(const GAS f32x4*)(lbr_p + c), biv = *(const GAS f32x4*)(lbi_p + c); const f32x4 spl = *(const GAS f32x4*)(spl_p + c);
                v2u pyw; if (FINAL) pyw = *(const v2u*)(P + (size_t)m * NP + PC_LY + c);
                float hout[4];
#pragma unroll
                for (int i = 0; i < 4; ++i) {
                    const float g_r = sigm(gr[i] + brv[i]), g_i = sigm(gi[i] + biv[i]);
                    const float log_a = -8.0f * g_r * spl[i];
                    float av = __expf(log_a); float mult = __builtin_amdgcn_sqrtf(fmaxf(1.0f - av * av, 0.f)); if (tseq == 0) mult = 1.0f;
                    float bv = mult * g_i * xc[vb][i];
                    { float pa = dpp_keep<0x111>(1.0f, av), pb = dpp_keep<0x111>(0.0f, bv); bv = av * pb + bv; av = av * pa; }
                    { float pa = dpp_keep<0x112>(1.0f, av), pb = dpp_keep<0x112>(0.0f, bv); bv = av * pb + bv; av = av * pa; }
                    { float pa = dpp_keep<0x114>(1.0f, av), pb = dpp_keep<0x114>(0.0f, bv); bv = av * pb + bv; av = av * pa; }
                    { float pa = dpp_keep<0x118>(1.0f, av), pb = dpp_keep<0x118>(0.0f, bv); bv = av * pb + bv; av = av * pa; }
                    const float hv = bv + av * hcar[vb][i];
                    const int l15 = (F.lane & 48) | 15;
                    const float hend = __shfl(hv, l15), aend = __shfl(av, l15);
                    hcar[vb][i] = hend; if (!FINAL) aprod[vb][i] *= aend; hout[i] = hv; }
                if (FINAL) { const float y0 = hout[0] * gelu_tanh(bflo(pyw.x)), y1 = hout[1] * gelu_tanh(bfhi(pyw.x)), y2 = hout[2] * gelu_tanh(bflo(pyw.y)), y3 = hout[3] * gelu_tanh(bfhi(pyw.y));
                    v2u w; w.x = pk2(y0, y1); w.y = pk2(y2, y3); *(v2u*)(YB + (size_t)m * 3072 + c) = w; }
            }
        }
        if (!FINAL && tq == 0) {
#pragma unroll
            for (int vb = 0; vb < 4; ++vb) { f32x4 pa, pb;
#pragma unroll
                for (int i = 0; i < 4; ++i) { pa[i] = aprod[vb][i]; pb[i] = hcar[vb][i]; }
                *(f32x4*)(CA + tt * 1024 + cb + 16 * vb) = pa; *(f32x4*)(CB + tt * 1024 + cb + 16 * vb) = pb; }
        }
        (void)seq0;
    }
}
__device__ __forceinline__ void lru_carry(const Frame& F, const Args& a) {
    const float* CA = (const float*)(a.ws + WS_LRUC); const float* CB = CA + 256 * 1024; float* HIN = (float*)CB + 256 * 1024;
    const int gt = F.vcu * (NWAVES * 64) + F.tid;
    if (gt < 2048) { const int b = gt >> 10, c = gt & 1023; float h = 0.f;
#pragma unroll 1
        for (int k0 = 0; k0 < 128; k0 += 32) { float ca[32], cb[32];
#pragma unroll
            for (int j = 0; j < 32; ++j) { const int tt = b * 128 + k0 + j; ca[j] = CA[tt * 1024 + c]; cb[j] = CB[tt * 1024 + c]; }
#pragma unroll
            for (int j = 0; j < 32; ++j) { const int tt = b * 128 + k0 + j; HIN[tt * 1024 + c] = h; h = ca[j] * h + cb[j]; } } }
}

__device__ __forceinline__ void xattn_phase(const Frame& F, const Args& a, int gw, int NGW) {
    const bf16* P = (const bf16*)(a.ws + WS_P); const bf16* KM = (const bf16*)(a.ws + WS_KMEM); const bf16* VT = (const bf16*)(a.ws + WS_VT);
    bf16* YC = (bf16*)(a.ws + WS_YABC) + 2048;
    const int tq = F.lane & 15, kq = F.lane >> 4;
    for (int it = gw; it < 4 * 512; it += NGW) {
        const int h = it >> 9, tg = it & 511, m0 = tg * 32, b = m0 / SEQ;
        bf16x8 qf[2][8];
#pragma unroll
        for (int g = 0; g < 2; ++g)
#pragma unroll
            for (int ks = 0; ks < 8; ++ks) qf[g][ks] = *(const bf16x8*)(P + (size_t)(m0 + 16 * g + tq) * NP + PC_Q + h * 256 + 32 * ks + 8 * kq);
        f32x4 s[2][16];
#pragma unroll
        for (int mb = 0; mb < 16; ++mb) { f32x4 acc0 = {0.f, 0.f, 0.f, 0.f}, acc1 = {0.f, 0.f, 0.f, 0.f}; const bf16* kp = KM + (size_t)(b * 256 + 16 * mb + tq) * 1024 + h * 256 + 8 * kq;
#pragma unroll
            for (int ks = 0; ks < 8; ++ks) { const bf16x8 kf = *(const bf16x8*)(kp + 32 * ks);
                acc0 = __builtin_amdgcn_mfma_f32_16x16x32_bf16(kf, qf[0][ks], acc0, 0, 0, 0); acc1 = __builtin_amdgcn_mfma_f32_16x16x32_bf16(kf, qf[1][ks], acc1, 0, 0, 0); }
            s[0][mb] = acc0; s[1][mb] = acc1; asm volatile("" ::: "memory"); }
        bf16x8 pf[2][8];
#pragma unroll
        for (int g = 0; g < 2; ++g) {
            float mx = -3.0e38f;
#pragma unroll
            for (int mb = 0; mb < 16; ++mb) { s[g][mb] = s[g][mb] * 0.0625f; mx = fmaxf(mx, fmaxf(fmaxf(s[g][mb][0], s[g][mb][1]), fmaxf(s[g][mb][2], s[g][mb][3]))); }
            mx = fmaxf(mx, __shfl_xor(mx, 16)); mx = fmaxf(mx, __shfl_xor(mx, 32));
            float sum = 0.f;
#pragma unroll
            for (int mb = 0; mb < 16; ++mb) {
#pragma unroll
                for (int i = 0; i < 4; ++i) { s[g][mb][i] = __expf(s[g][mb][i] - mx); sum += s[g][mb][i]; } }
            sum += __shfl_xor(sum, 16); sum += __shfl_xor(sum, 32);
            const float inv = 1.0f / sum;
#pragma unroll
            for (int ks = 0; ks < 8; ++ks) { v4u w; w.x = pk2(s[g][2 * ks][0] * inv, s[g][2 * ks][1] * inv); w.y = pk2(s[g][2 * ks][2] * inv, s[g][2 * ks][3] * inv); w.z = pk2(s[g][2 * ks + 1][0] * inv, s[g][2 * ks + 1][1] * inv); w.w = pk2(s[g][2 * ks + 1][2] * inv, s[g][2 * ks + 1][3] * inv); pf[g][ks] = __builtin_bit_cast(bf16x8, w); } }
#pragma unroll
        for (int db = 0; db < 16; ++db) { f32x4 acc0 = {0.f, 0.f, 0.f, 0.f}, acc1 = {0.f, 0.f, 0.f, 0.f}; const bf16* vp = VT + ((size_t)((b * 4 + h) * 256 + 16 * db + tq)) * 256 + 8 * kq;
#pragma unroll
            for (int ks = 0; ks < 8; ++ks) { const bf16x8 vf = *(const bf16x8*)(vp + 32 * ks);
                acc0 = __builtin_amdgcn_mfma_f32_16x16x32_bf16(vf, pf[0][ks], acc0, 0, 0, 0); acc1 = __builtin_amdgcn_mfma_f32_16x16x32_bf16(vf, pf[1][ks], acc1, 0, 0, 0); }
            v2u w0_, w1_; w0_.x = pk2(acc0[0], acc0[1]); w0_.y = pk2(acc0[2], acc0[3]); w1_.x = pk2(acc1[0], acc1[1]); w1_.y = pk2(acc1[2], acc1[3]);
            *(v2u*)(YC + (size_t)(m0 + tq) * 3072 + h * 256 + 16 * db + 4 * kq) = w0_; *(v2u*)(YC + (size_t)(m0 + 16 + tq) * 3072 + h * 256 + 16 * db + 4 * kq) = w1_; asm volatile("" ::: "memory"); }
    }
}

__device__ __forceinline__ void xattn_coop(const Frame& F, const Args& a) {
    const bf16* P = (const bf16*)(a.ws + WS_P); const bf16* KM = (const bf16*)(a.ws + WS_KMEM); const bf16* VT = (const bf16*)(a.ws + WS_VT);
    bf16* YC = (bf16*)(a.ws + WS_YABC) + 2048;
    const int tq = F.lane & 15, kq = F.lane >> 4;
    const int pe = (kq ^ (tq & 7)) * 16;
    unsigned rb0 = (unsigned)(tq * 512 + pe), rb1 = (unsigned)(tq * 512 + (pe ^ 64)), rb2 = rb0 + 65536u, rb3 = rb1 + 65536u;
    asm volatile("" : "+v"(rb0), "+v"(rb1), "+v"(rb2), "+v"(rb3));
    const LAS unsigned char* rd0 = F.lds + rb0; const LAS unsigned char* rd1 = F.lds + rb1; const LAS unsigned char* rd2 = F.lds + rb2; const LAS unsigned char* rd3 = F.lds + rb3;
    for (int it = F.vcu; it < 256; it += F.G) {
        const int h = it >> 6, m0 = (it & 63) * 256 + F.wave * 32, b = m0 / SEQ;
        { const int rp = F.lane >> 5, p = F.lane & 31; const GAS char* src = (const GAS char*)KM + ((size_t)(b * 256 + F.wave * 32 + rp) * 1024 + h * 256) * 2;
#pragma unroll 1
          for (int j = 0; j < 16; ++j) { __builtin_amdgcn_global_load_lds((const GAS unsigned*)(src + ((p ^ ((2 * j + rp) & 7)) * 16)), (LAS unsigned*)(F.lds + (F.wave * 16 + j) * 1024), 16, 0, 0); src += 2 * 2048; asm volatile("" ::: "memory"); } }
        bf16x8 qf[2][8];
#pragma unroll
        for (int g = 0; g < 2; ++g)
#pragma unroll
            for (int ks = 0; ks < 8; ++ks) qf[g][ks] = *(const bf16x8*)(P + (size_t)(m0 + 16 * g + tq) * NP + PC_Q + h * 256 + 32 * ks + 8 * kq);
        VM_WAIT(); __syncthreads();
        f32x4 s[2][16];
#define XA_RD(dst_, gi_) do { _Pragma("unroll") for (int j_ = 0; j_ < 4; ++j_) { const int ks_ = ((gi_) & 1) * 4 + j_; dst_[j_] = *(const LAS bf16x8*)(((gi_) >= 16 ? ((ks_ & 1) ? rd3 : rd2) : ((ks_ & 1) ? rd1 : rd0)) + (((gi_) >> 1) & 7) * 8192 + (ks_ >> 1) * 128); } } while (0)
        { bf16x8 kf[2][4]; XA_RD(kf[0], 0); f32x4 acc0 = {0.f, 0.f, 0.f, 0.f}, acc1 = {0.f, 0.f, 0.f, 0.f};
#pragma unroll
          for (int gi = 0; gi < 32; ++gi) { if (gi + 1 < 32) XA_RD(kf[(gi + 1) & 1], gi + 1);
              if (!(gi & 1)) { acc0 = (f32x4){0.f, 0.f, 0.f, 0.f}; acc1 = (f32x4){0.f, 0.f, 0.f, 0.f}; }
#pragma unroll
              for (int j = 0; j < 4; ++j) { const int ks = (gi & 1) * 4 + j; acc0 = __builtin_amdgcn_mfma_f32_16x16x32_bf16(kf[gi & 1][j], qf[0][ks], acc0, 0, 0, 0); acc1 = __builtin_amdgcn_mfma_f32_16x16x32_bf16(kf[gi & 1][j], qf[1][ks], acc1, 0, 0, 0); }
              asm volatile("" : "+v"(acc0), "+v"(acc1) :: "memory");
              if (gi & 1) { s[0][gi >> 1] = acc0; s[1][gi >> 1] = acc1; } } }
        LDS_WAIT(); __syncthreads();
        { const int rp = F.lane >> 5, p = F.lane & 31; const GAS char* src = (const GAS char*)VT + ((size_t)((b * 4 + h) * 256 + F.wave * 32 + rp) * 256) * 2;
#pragma unroll 1
          for (int j = 0; j < 16; ++j) { __builtin_amdgcn_global_load_lds((const GAS unsigned*)(src + ((p ^ ((2 * j + rp) & 7)) * 16)), (LAS unsigned*)(F.lds + (F.wave * 16 + j) * 1024), 16, 0, 0); src += 2 * 512; asm volatile("" ::: "memory"); } }
        bf16x8 pf[2][8];
#pragma unroll
        for (int g = 0; g < 2; ++g) {
            float mx = -3.0e38f;
#pragma unroll
            for (int mb = 0; mb < 16; ++mb) { s[g][mb] = s[g][mb] * 0.0625f; mx = fmaxf(mx, fmaxf(fmaxf(s[g][mb][0], s[g][mb][1]), fmaxf(s[g][mb][2], s[g][mb][3]))); }
            mx = fmaxf(mx, __shfl_xor(mx, 16)); mx = fmaxf(mx, __shfl_xor(mx, 32));
            float sum = 0.f;
#pragma unroll
            for (int mb = 0; mb < 16; ++mb) {
#pragma unroll
                for (int i = 0; i < 4; ++i) { s[g][mb][i] = __expf(s[g][mb][i] - mx); sum += s[g][mb][i]; } }
            sum += __shfl_xor(sum, 16); sum += __shfl_xor(sum, 32);
            const float inv = 1.0f / sum;
#pragma unroll
            for (int ks = 0; ks < 8; ++ks) { v4u w; w.x = pk2(s[g][2 * ks][0] * inv, s[g][2 * ks][1] * inv); w.y = pk2(s[g][2 * ks][2] * inv, s[g][2 * ks][3] * inv); w.z = pk2(s[g][2 * ks + 1][0] * inv, s[g][2 * ks + 1][1] * inv); w.w = pk2(s[g][2 * ks + 1][2] * inv, s[g][2 * ks + 1][3] * inv); pf[g][ks] = __builtin_bit_cast(bf16x8, w); } }
        VM_WAIT(); __syncthreads();
        { bf16x8 vf[2][4]; XA_RD(vf[0], 0); f32x4 acc0 = {0.f, 0.f, 0.f, 0.f}, acc1 = {0.f, 0.f, 0.f, 0.f};
#pragma unroll
          for (int gi = 0; gi < 32; ++gi) { if (gi + 1 < 32) XA_RD(vf[(gi + 1) & 1], gi + 1);
              if (!(gi & 1)) { acc0 = (f32x4){0.f, 0.f, 0.f, 0.f}; acc1 = (f32x4){0.f, 0.f, 0.f, 0.f}; }
#pragma unroll
              for (int j = 0; j < 4; ++j) { const int ks = (gi & 1) * 4 + j; acc0 = __builtin_amdgcn_mfma_f32_16x16x32_bf16(vf[gi & 1][j], pf[0][ks], acc0, 0, 0, 0); acc1 = __builtin_amdgcn_mfma_f32_16x16x32_bf16(vf[gi & 1][j], pf[1][ks], acc1, 0, 0, 0); }
              asm volatile("" : "+v"(acc0), "+v"(acc1) :: "memory");
              if (gi & 1) { const int db = gi >> 1; v2u w0_, w1_; w0_.x = pk2(acc0[0], acc0[1]); w0_.y = pk2(acc0[2], acc0[3]); w1_.x = pk2(acc1[0], acc1[1]); w1_.y = pk2(acc1[2], acc1[3]);
                  *(v2u*)(YC + (size_t)(m0 + tq) * 3072 + h * 256 + 16 * db + 4 * kq) = w0_; *(v2u*)(YC + (size_t)(m0 + 16 + tq) * 3072 + h * 256 + 16 * db + 4 * kq) = w1_; } } }
#undef XA_RD
        LDS_WAIT(); __syncthreads();
    }
}

__device__ __forceinline__ void router_phase(const Frame& F, const Args& a) {
    const bf16* H1 = (const bf16*)(a.ws + WS_H1); bf16* XN2 = (bf16*)(a.ws + WS_XN); const bf16* WR = (const bf16*)(a.ws + WS_WR);
    int* pick_e = (int*)(a.ws + WS_PICK); int* pick_rank = pick_e + 65536; float* pick_gate = (float*)(pick_rank + 65536);
    unsigned* gcnt = (unsigned*)(a.ws + WS_CTL) + CW_CNT;
    LAS float* lg = (LAS float*)(F.lds + F.wave * 4096);
    LAS unsigned* lcnt = (LAS unsigned*)(F.lds + 65536);
    const int tq = F.lane & 15, kq = F.lane >> 4;
    for (int g0 = F.vcu * 4; g0 < 1024; g0 += F.G * 4) {
        if (F.tid < 64) lcnt[F.tid] = 0u;
        __syncthreads();
        int me = 0, mrank = 0; float mgate = 0.f; int e4[4]; float g4[4]; int r4[4];
        const int m0 = (g0 + F.wave) * 16;
        if (F.wave < 4) {
            float myr = 0.f;
#pragma unroll 4
            for (int j = 0; j < 16; ++j) { const GAS v4u* xr = (const GAS v4u*)(H1 + (size_t)(m0 + j) * D) + F.lane; float s = 0.f;
#pragma unroll
                for (int q = 0; q < 4; ++q) { const v4u w8 = xr[64 * q]; const float e0 = bflo(w8.x), e1 = bfhi(w8.x), e2 = bflo(w8.y), e3 = bfhi(w8.y), e4 = bflo(w8.z), e5 = bfhi(w8.z), e6 = bflo(w8.w), e7 = bfhi(w8.w);
                    s += ((e0 * e0 + e1 * e1) + (e2 * e2 + e3 * e3)) + ((e4 * e4 + e5 * e5) + (e6 * e6 + e7 * e7)); }
                const float rs = 1.0f / sqrtf(wave_sum(s) * (1.f / D) + EPS); if (tq == j) myr = rs; }
            f32x4 acc[2] = {{0.f, 0.f, 0.f, 0.f}, {0.f, 0.f, 0.f, 0.f}};
            const bf16* hrow = H1 + (size_t)(m0 + tq) * D + 8 * kq; const float* grow = inp(I_GFFN) + 8 * kq; unsigned char* xrow = (unsigned char*)XN2 + (size_t)(m0 + tq) * D + 8 * kq;
#pragma unroll 1
            for (int ks0 = 0; ks0 < 64; ks0 += 4) {
                v4u hw8a[4]; f32x4 g0a[4], g1a[4]; bf16x8 wfa[4][4];
#pragma unroll
                for (int u = 0; u < 4; ++u) { const int ks = ks0 + u; hw8a[u] = *(const v4u*)(hrow + 32 * ks); g0a[u] = *(const f32x4*)(grow + 32 * ks); g1a[u] = *(const f32x4*)(grow + 32 * ks + 4);
#pragma unroll
                    for (int eh = 0; eh < 2; ++eh) { const bf16* wp = WR + (size_t)(16 * eh + tq) * D + 32 * ks + 8 * kq; wfa[u][2 * eh] = *(const bf16x8*)wp; wfa[u][2 * eh + 1] = *(const bf16x8*)(wp + 32 * D); } }
#pragma unroll
                for (int u = 0; u < 4; ++u) { const int ks = ks0 + u; const v4u hw8 = hw8a[u]; const f32x4 g0v = g0a[u], g1v = g1a[u];
                    const f32x4 x0 = {bflo(hw8.x), bfhi(hw8.x), bflo(hw8.y), bfhi(hw8.y)}, x1 = {bflo(hw8.z), bfhi(hw8.z), bflo(hw8.w), bfhi(hw8.w)};
                    v4u w; w.x = pk2(x0[0] * myr * g0v[0], x0[1] * myr * g0v[1]); w.y = pk2(x0[2] * myr * g0v[2], x0[3] * myr * g0v[3]); w.z = pk2(x1[0] * myr * g1v[0], x1[1] * myr * g1v[1]); w.w = pk2(x1[2] * myr * g1v[2], x1[3] * myr * g1v[3]);
                    { v2u q8; q8.x = pk4_fp8(x0[0] * myr * g0v[0], x0[1] * myr * g0v[1], x0[2] * myr * g0v[2], x0[3] * myr * g0v[3]); q8.y = pk4_fp8(x1[0] * myr * g1v[0], x1[1] * myr * g1v[1], x1[2] * myr * g1v[2], x1[3] * myr * g1v[3]); *(v2u*)(xrow + 32 * ks) = q8; }
                    const bf16x8 af = __builtin_bit_cast(bf16x8, w);
#pragma unroll
                    for (int eh = 0; eh < 2; ++eh) { acc[eh] = __builtin_amdgcn_mfma_f32_16x16x32_bf16(af, wfa[u][2 * eh], acc[eh], 0, 0, 0); acc[eh] = __builtin_amdgcn_mfma_f32_16x16x32_bf16(af, wfa[u][2 * eh + 1], acc[eh], 0, 0, 0); } } }
#pragma unroll
            for (int eh = 0; eh < 2; ++eh)
#pragma unroll
                for (int i = 0; i < 4; ++i) lg[(4 * kq + i) * 33 + 16 * eh + tq] = acc[eh][i] + inp(I_BROUTER)[16 * eh + tq];
            LDS_WAIT(); asm volatile("" ::: "memory");
            if (F.lane < 16) { float v[32];
#pragma unroll
                for (int e = 0; e < 32; ++e) v[e] = lg[F.lane * 33 + e];
                float tv[4];
#pragma unroll
                for (int k = 0; k < 4; ++k) { float best = -3.0e38f; int bi = 0;
#pragma unroll
                    for (int e = 0; e < 32; ++e) { if (v[e] > best) { best = v[e]; bi = e; } }
                    tv[k] = best; e4[k] = bi;
#pragma unroll
                    for (int e = 0; e < 32; ++e) { if (e == bi) v[e] = -3.0e38f; } }
                float den = 0.f;
#pragma unroll
                for (int k = 0; k < 4; ++k) { g4[k] = __expf(tv[k] - tv[0]); den += g4[k]; }
#pragma unroll
                for (int k = 0; k < 4; ++k) { g4[k] = g4[k] / den; r4[k] = (int)atomicAdd((unsigned*)&lcnt[e4[k]], 1u); } }
        }
        __syncthreads();
        if (F.tid < 32) lcnt[32 + F.tid] = atomicAdd(&gcnt[F.tid], lcnt[F.tid]);
        __syncthreads();
        if (F.wave < 4 && F.lane < 16) {
#pragma unroll
            for (int k = 0; k < 4; ++k) { const int pi = (m0 + F.lane) * 4 + k; pick_e[pi] = e4[k]; pick_rank[pi] = (int)lcnt[32 + e4[k]] + r4[k]; pick_gate[pi] = g4[k]; } }
        __syncthreads();
        (void)me; (void)mrank; (void)mgate;
    }
}

__device__ __forceinline__ void scatter_phase(const Frame& F, const Args& a) {
    const int* pick_e = (const int*)(a.ws + WS_PICK); const int* pick_rank = pick_e + 65536; const float* pick_gate = (const float*)(pick_rank + 65536); int* pos = (int*)(pick_gate + 65536);
    float* gate_of_row = (float*)(a.ws + WS_ROWTAB); int* tok_of_row = (int*)(a.ws + WS_ROWTAB + 512 * 1024 + 8192);
    unsigned* ctl = (unsigned*)(a.ws + WS_CTL);
    LAS int* pst = (LAS int*)(F.lds);
    if (F.tid < NE) pst[32 + F.tid] = (int)ctl[CW_CNT + F.tid];
    __syncthreads();
    if (F.tid == 0) { int acc = 0; for (int e = 0; e < NE; ++e) { pst[e] = acc; const int c = pst[32 + e]; const int nt = (c + 255) >> 8;
            if (blockIdx.x == 0) for (int k = 0; k < nt; ++k) ctl[CW_TILEE + (acc >> 8) + k] = (unsigned)e;
            acc += nt << 8; }
        if (blockIdx.x == 0) ctl[CW_NTILES] = (unsigned)(acc >> 8); }
    __syncthreads();
    { const int gw = F.vcu * NWAVES + F.wave, NGW = F.G * NWAVES; const unsigned char* X8 = a.ws + WS_XN; unsigned char* XS8 = a.ws + WS_XS;
#pragma unroll 1
      for (int pi0 = gw; pi0 < 65536; pi0 += 8 * NGW) {
        int row[8]; float gt[8]; v4u d0[8], d1[8];
#pragma unroll
        for (int u = 0; u < 8; ++u) { const int pi = pi0 + u * NGW; row[u] = -1; if (pi < 65536) { row[u] = pst[pick_e[pi]] + pick_rank[pi]; gt[u] = pick_gate[pi]; } }
#pragma unroll
        for (int u = 0; u < 8; ++u) { const int pi = pi0 + u * NGW; if (row[u] >= 0) { const GAS v4u* src = (const GAS v4u*)(X8 + (size_t)(pi >> 2) * D) + F.lane; d0[u] = src[0]; d1[u] = src[64]; } }
#pragma unroll
        for (int u = 0; u < 8; ++u) { const int pi = pi0 + u * NGW; if (row[u] >= 0) { if (F.lane == 0) { pos[pi] = row[u]; gate_of_row[row[u]] = gt[u]; tok_of_row[row[u]] = pi >> 2; }
                GAS v4u* dst = (GAS v4u*)(XS8 + (size_t)row[u] * D) + F.lane; dst[0] = d0[u]; dst[64] = d1[u]; } } } }
    if (blockIdx.x == 0) for (int e = 0; e < NE; ++e) { const int r0 = pst[e] + pst[32 + e], r1 = pst[e] + (((pst[32 + e] + 255) >> 8) << 8);
        for (int r = r0 + F.tid; r < r1; r += NWAVES * 64) { tok_of_row[r] = 0; gate_of_row[r] = 0.f; } }
}

__device__ __forceinline__ void final_phase(const Frame& F, const Args& a) {
    const bf16* H1 = (const bf16*)(a.ws + WS_H1); const bf16* OR = (const bf16*)(a.ws + WS_OROW);
    const int* pos = (const int*)(a.ws + WS_PICK) + 3 * 65536;
    const int gw = F.vcu * NWAVES + F.wave, NGW = F.G * NWAVES;
    for (int m = gw; m < T; m += NGW) {
        const GAS v2u* xr = (const GAS v2u*)(H1 + (size_t)m * D) + F.lane; const GAS f32x4* gr = (const GAS f32x4*)inp(I_GFINAL) + F.lane;
        f32x4 v[8];
#pragma unroll
        for (int j = 0; j < 8; ++j) { const v2u w = xr[64 * j]; v[j] = (f32x4){bflo(w.x), bfhi(w.x), bflo(w.y), bfhi(w.y)}; }
#pragma unroll
        for (int k = 0; k < 4; ++k) { const int row = pos[m * 4 + k]; const GAS v2u* orp = (const GAS v2u*)(OR + (size_t)row * D) + F.lane;
#pragma unroll
            for (int j = 0; j < 8; ++j) { const v2u w = orp[64 * j]; v[j].x += bflo(w.x); v[j].y += bfhi(w.x); v[j].z += bflo(w.y); v[j].w += bfhi(w.y); } }
        float s = 0.f;
#pragma unroll
        for (int j = 0; j < 8; ++j) s += (v[j].x * v[j].x + v[j].y * v[j].y) + (v[j].z * v[j].z + v[j].w * v[j].w);
        const float rstd = 1.0f / sqrtf(wave_sum(s) * (1.f / D) + EPS);
        GAS f32x4* o = (GAS f32x4*)(a.out + (size_t)m * D) + F.lane;
#pragma unroll
        for (int j = 0; j < 8; ++j) { const f32x4 g = gr[64 * j]; o[64 * j] = (f32x4){v[j].x * rstd * g.x, v[j].y * rstd * g.y, v[j].z * rstd * g.z, v[j].w * rstd * g.w}; }
    }
}

#ifndef MK_N_LAUNCHES
#define MK_N_LAUNCHES 1
#endif
constexpr int NPH = 14;
__global__ void __launch_bounds__(NWAVES * 64, 2) fwd(Args args) {
    extern __shared__ __attribute__((aligned(16))) unsigned char lds[];
#define NEWFRAME() Frame F; { int tz = threadIdx.x; asm volatile("" : "+v"(tz)); F.lds = (LAS unsigned char*)lds; F.MISC = (volatile LAS unsigned*)(F.lds + MISC_OFF); F.tid = tz; F.lane = tz & 63; F.wave = __builtin_amdgcn_readfirstlane(tz >> 6); \
        F.G = gridDim.x; const int bx = blockIdx.x; F.vcu = (F.G % 8 == 0) ? (bx % 8) * (F.G / 8) + bx / 8 : bx; }
    unsigned char* ws = args.ws;
    unsigned* ctl = (unsigned*)(ws + WS_CTL);
    for (int u = threadIdx.x; u < (LDS_BYTES - MISC_OFF) / 4; u += NWAVES * 64) ((LAS unsigned*)((LAS unsigned char*)lds + MISC_OFF))[u] = 0u;
    __syncthreads();
    const int lo = args.ph_lo, hi = args.ph_hi;
    XcdBarrier bar; bar.bar = ctl + CW_BAR; bar.x = 0; bar.st = nullptr;
    if (hi - lo > 1) bar = xcd_barrier_post(ctl + CW_BAR, (volatile LAS unsigned*)((LAS unsigned char*)lds + MISC_OFF) + 8);
#ifndef PHMASK
#define PHMASK 0xFFFF
#endif
#define IN(k) (((PHMASK >> (k)) & 1) && lo <= (k) && (k) < hi)
#define SEAM(k) do { if (IN(k) && IN((k) + 1)) xcd_barrier(bar); } while (0)

    if (IN(0)) { NEWFRAME(); p0_prologue(F, args); } SEAM(0);
    if (IN(1)) { NEWFRAME();
        const int c = (int)blockIdx.x, G = F.G;
        { pg8::Gemm g{(const bf16*)(ws + WS_XN), (const bf16*)(ws + WS_WIN), T, PC_LX, D}; pg8::StaticOrder S; S.init(T, PC_LX, G, c);
          pg8::EpiBf16<0> E{(bf16*)(ws + WS_P), NP, nullptr, 0, 0, 1.f};
          pg8::gemm_phase<pg8::EpiBf16<0>, pg8::StaticOrder, true, true>(F.lds, g, S, E); }
        __syncthreads();
        { pg8::Gemm g{(const bf16*)(ws + WS_MN), (const bf16*)(ws + WS_WMKV), 512, 2048, D}; pg8::StaticOrder S; S.init(512, 2048, G, (c + G - G / 2) % G);
          pg8::EpiKV E{(bf16*)(ws + WS_KMEM), (bf16*)(ws + WS_VT)};
          pg8::gemm_phase<pg8::EpiKV, pg8::StaticOrder, true, true>(F.lds, g, S, E); }
        __syncthreads();
        { int start, cnt; constexpr int NB = 64 * ((NP - PC_LX) / 256);
          if (G == 256) { if (c < 144) { start = 8 * c; cnt = 8; } else if (c < 224) { start = 1152 + 10 * (c - 144); cnt = 10; } else { start = 1952 + 11 * (c - 224); cnt = 11; } }
          else { const int per = (NB + G - 1) / G; start = per * c; cnt = start >= NB ? 0 : (NB - start < per ? NB - start : per); }
          pg8::Gemm g{(const bf16*)(ws + WS_XN8), (const bf16*)(ws + WS_WIN8), T, NP - PC_LX, D}; pg8::RangeOrder S; S.init(T, NP - PC_LX, start, cnt);
          pg8::EpiBf16<3> E{(bf16*)(ws + WS_P) + PC_LX, NP, nullptr, 0, 0, 1.f};
          pg8::gemm_phase<pg8::EpiBf16<3>, pg8::RangeOrder, true, true, 1>(F.lds, g, S, E); }
    } SEAM(1);
    if (IN(2)) { { NEWFRAME(); xattn_coop(F, args); }
 NEWFRAME();
#ifndef NO_R1
 r1_lora_in(F, args);
#endif
#ifndef NO_LRU
 lru_pass<false>(F, args, F.vcu * NWAVES + F.wave, F.G * NWAVES);
#endif
 } SEAM(2);
    if (IN(3)) { NEWFRAME();
        lru_carry(F, args);
        { pg8::Gemm g{(const bf16*)(ws + WS_XN), (const bf16*)(ws + WS_WLORA), T, 3072, LORA_K}; pg8::StaticOrder S; S.init(T, 3072, F.G, (int)blockIdx.x);
          pg8::EpiBfPlain E{(bf16*)(ws + WS_LORAOUT), 3072};
          pg8::gemm_phase<pg8::EpiBfPlain, pg8::StaticOrder, true, true>(F.lds, g, S, E); }
    } SEAM(3);
    if (IN(4)) { NEWFRAME(); const int gw4 = F.vcu * NWAVES + F.wave, NGW4 = F.G * NWAVES;
        if (F.wave & 1) { moe_weight_convert<1>(F, args, gw4, NGW4); r3_blocks(F, args); } else { r3_blocks(F, args); moe_weight_convert<1>(F, args, gw4, NGW4); } } SEAM(4);
    if (IN(5)) { NEWFRAME();
        if (F.tid < 64) ((LAS unsigned*)(F.lds + SC_SYNC))[F.tid] = 0u; __syncthreads();
        int bh = 0, quarter = 0; const bool sw = scan_wg(bh, quarter);
        int gw2, NGW2; { const int bx = blockIdx.x, G = F.G; if (G == 256) { NGW2 = 1792; gw2 = sw ? ((bx >> 4) * 8 + (bx & 7)) * 6 + (F.wave - 2) : 768 + ((bx >> 4) * 8 + (bx & 7)) * 8 + F.wave; } else { NGW2 = G * 8; gw2 = F.vcu * 8 + F.wave; } }
        if (sw && F.wave == 0) r4_scan<0>(F, args, bh, quarter);
        else if (sw && F.wave == 1) r4_feeder(F, args, bh);
        else {
            if (F.wave & 1) { moe_weight_convert<0>(F, args, gw2, NGW2); lru_pass<true>(F, args, gw2, NGW2); }
            else { lru_pass<true>(F, args, gw2, NGW2); moe_weight_convert<0>(F, args, gw2, NGW2); } }
    } SEAM(5);
    if (IN(6)) { NEWFRAME(); r5_finish(F, args); } SEAM(6);
    if (IN(7)) { NEWFRAME();
        pg8::Gemm g{(const bf16*)(ws + WS_YABC), (const bf16*)(ws + WS_WBR), T, 2048, 3072}; pg8::StaticOrder S; S.init(T, 2048, F.G, (int)blockIdx.x);
        pg8::EpiBranch2 E{(const bf16*)(ws + WS_P), NP, PC_G, (bf16*)(ws + WS_MERGED)};
        pg8::gemm_phase<pg8::EpiBranch2, pg8::StaticOrder, true, true>(F.lds, g, S, E);
    } SEAM(7);
    if (IN(8)) { NEWFRAME();
        pg8::Gemm g{(const bf16*)(ws + WS_MERGED), (const bf16*)(ws + WS_WO), T, D, D}; pg8::StaticOrder S; S.init(T, D, F.G, (int)blockIdx.x);
        pg8::EpiRes E{inp(I_X), (bf16*)(ws + WS_H1), D};
        pg8::gemm_phase<pg8::EpiRes, pg8::StaticOrder, true, true>(F.lds, g, S, E);
    } SEAM(8);
    if (IN(9)) { NEWFRAME(); router_phase(F, args); } SEAM(9);
    if (IN(10)) { NEWFRAME(); scatter_phase(F, args); } SEAM(10);
    if (IN(11)) { NEWFRAME();
        const int ntiles = __builtin_amdgcn_readfirstlane((int)__hip_atomic_load(ctl + CW_NTILES, __ATOMIC_RELAXED, __HIP_MEMORY_SCOPE_AGENT));
        pg8::Gemm g{(const bf16*)(ws + WS_XS), (const bf16*)(ws + WS_WGU), ntiles * 256, NE * 4096, D}; pg8::MoeOrder<false> S; S.init(ntiles, 16, F.G, (int)blockIdx.x, (const int*)(ctl + CW_TILEE), nullptr);
        pg8::EpiSwiglu E{ws + WS_HH, inp(I_BGATE), inp(I_BUP)};
        pg8::gemm_phase<pg8::EpiSwiglu, pg8::MoeOrder<false>, true, true, 1>(F.lds, g, S, E);
    } SEAM(11);
    if (IN(12)) { NEWFRAME();
        const int ntiles = __builtin_amdgcn_readfirstlane((int)__hip_atomic_load(ctl + CW_NTILES, __ATOMIC_RELAXED, __HIP_MEMORY_SCOPE_AGENT));
        pg8::Gemm g{(const bf16*)(ws + WS_HH), (const bf16*)(ws + WS_WD), ntiles * 256, NE * 2048, D}; pg8::MoeOrder<false> S; S.init(ntiles, 8, F.G, (int)blockIdx.x, (const int*)(ctl + CW_TILEE), nullptr);
        pg8::EpiDown E{(bf16*)(ws + WS_OROW), inp(I_BDOWN), (const float*)(ws + WS_ROWTAB)};
        pg8::gemm_phase<pg8::EpiDown, pg8::MoeOrder<false>, true, true, 1>(F.lds, g, S, E);
    } SEAM(12);
    if (IN(13)) { NEWFRAME(); final_phase(F, args); }
#ifdef PROBE_EXTRA_PHASE
    if (lo == 14) { NEWFRAME(); if (F.tid < 64) ((LAS unsigned*)(F.lds + SC_SYNC))[F.tid] = 0u; __syncthreads(); int bh = 0, quarter = 0; const bool sw = scan_wg(bh, quarter); if (sw && F.wave == 0) r4_scan<0>(F, args, bh, quarter); else if (sw && F.wave == 1) r4_feeder(F, args, bh); }
    if (lo == 17) { NEWFRAME(); int bh = 0, quarter = 0; const bool sw = scan_wg(bh, quarter); if (sw && F.wave == 0) r4_scan<1>(F, args, bh, quarter); }
    if (lo == 18) { NEWFRAME(); const int gw2 = F.vcu * 8 + F.wave, NGW2 = F.G * 8; const int rot = F.wave % 3;
            if (rot == 0) { moe_weight_convert<0>(F, args, gw2, NGW2); xattn_phase(F, args, gw2, NGW2); lru_pass<true>(F, args, gw2, NGW2); }
            else if (rot == 1) { xattn_phase(F, args, gw2, NGW2); lru_pass<true>(F, args, gw2, NGW2); moe_weight_convert<0>(F, args, gw2, NGW2); }
            else { lru_pass<true>(F, args, gw2, NGW2); moe_weight_convert<0>(F, args, gw2, NGW2); xattn_phase(F, args, gw2, NGW2); } }
    if (lo == 19) { NEWFRAME(); xattn_phase(F, args, F.vcu * 8 + F.wave, F.G * 8); }
    if (lo == 20) { NEWFRAME(); lru_pass<true>(F, args, F.vcu * 8 + F.wave, F.G * 8); }
    if (lo == 15) { NEWFRAME(); moe_weight_convert<0>(F, args, F.vcu * 8 + F.wave, F.G * 8); moe_weight_convert<1>(F, args, F.vcu * 8 + F.wave, F.G * 8); }
#endif
#undef IN
#undef SEAM
}

extern "C" void kernel_launch(void* const* d_in, const int* in_sizes, int n_in, void* d_out, int out_size, void* d_ws, size_t ws_size, hipStream_t stream) {
    static int grid = 0;
    if (grid == 0) {
        if (n_in != 39 || out_size != T * D || ws_size < WS_END) { fprintf(stderr, "kernel_launch: built for 39 inputs, out of %d floats, >= %zu bytes of workspace; got n_in %d, out %d, ws %zu; nothing launched\n", T * D, (size_t)WS_END, n_in, out_size, ws_size); grid = -1; return; }
        int dev = 0, cus = 0, per_cu = 0;
        if (hipGetDevice(&dev) != hipSuccess || hipDeviceGetAttribute(&cus, hipDeviceAttributeMultiprocessorCount, dev) != hipSuccess) { fprintf(stderr, "kernel_launch: device query failed\n"); grid = -1; return; }
        if (hipFuncSetAttribute((const void*)fwd, hipFuncAttributeMaxDynamicSharedMemorySize, LDS_BYTES) != hipSuccess) { fprintf(stderr, "kernel_launch: hipFuncSetAttribute failed\n"); grid = -1; return; }
        if (hipOccupancyMaxActiveBlocksPerMultiprocessor(&per_cu, (const void*)fwd, NWAVES * 64, LDS_BYTES) != hipSuccess || per_cu < 1)
            fprintf(stderr, "kernel_launch: note: occupancy query reports %d workgroups per CU\n", per_cu);
        (void)hipGetLastError();
        grid = cus;
    }
    if (grid < 0) return;
    (void)in_sizes;
    if (hipMemsetAsync((char*)d_ws + WS_CTL, 0, CTL_ZERO_BYTES, stream) != hipSuccess) { fprintf(stderr, "kernel_launch: hipMemsetAsync failed\n"); return; }
    Args a{};
    for (int i = 0; i < 39; ++i) a.in[i] = (const float*)d_in[i];
    a.out = (float*)d_out; a.ws = (unsigned char*)d_ws;
#if MK_N_LAUNCHES == 1
    a.ph_lo = 0; a.ph_hi = NPH;
    hipLaunchKernelGGL(fwd, dim3(grid), dim3(NWAVES * 64), LDS_BYTES, stream, a);
#else
    for (int k = 0; k < NPH; ++k) { a.ph_lo = k; a.ph_hi = k + 1; int reps = 1;
#ifdef PROBE_REP_PHASE
        if (k == PROBE_REP_PHASE) reps = 1 + PROBE_REP_N;
#endif
        for (int r = 0; r < reps; ++r) hipLaunchKernelGGL(fwd, dim3(grid), dim3(NWAVES * 64), LDS_BYTES, stream, a); }
#ifdef PROBE_EXTRA_PHASE
    for (int r = 0; r < PROBE_REP_N; ++r) { a.ph_lo = PROBE_EXTRA_PHASE; a.ph_hi = PROBE_EXTRA_PHASE + 1; hipLaunchKernelGGL(fwd, dim3(grid), dim3(NWAVES * 64), LDS_BYTES, stream, a); }
#endif
#endif
    const hipError_t le = hipPeekAtLastError();
    if (le != hipSuccess) fprintf(stderr, "kernel_launch: launch failed: %s\n", hipGetErrorName(le));
}
```
